# Optimizing an MI355X kernel written in HIP

```python
import math
import jax
import jax.numpy as jnp
from jax import lax
import numpy as np

D_MODEL = 1024
BATCH = 4
SEQ = 8192
DEPTH = 2

N_MIXERS = 2
N_SWA_LAYERS = (DEPTH + 1) // 2
N_DIFF_LAYERS = DEPTH // 2

HEAD_DIM = 64
QBLK = 128

SWA_HEADS = D_MODEL // HEAD_DIM
SWA_KV_HEADS = SWA_HEADS // 4
SWA_GROUP = SWA_HEADS // SWA_KV_HEADS
WINDOW = 128
KBLK = QBLK + 2 * WINDOW
SWA_QKV_WIDTH = (SWA_HEADS + 2 * SWA_KV_HEADS) * HEAD_DIM

DIFF_HEADS = D_MODEL // (2 * HEAD_DIM)
DIFF_VDIM = 2 * HEAD_DIM
DIFF_QKV_WIDTH = 2 * DIFF_HEADS * HEAD_DIM * 2 + DIFF_HEADS * DIFF_VDIM

N_GROUPS = 4
EXPERTS_PER_GROUP = 8
N_EXPERTS = N_GROUPS * EXPERTS_PER_GROUP
TOP_K = 2
D_EXPERT = D_MODEL // 2
MOE_BLK = 128

NORM_EPS = 1e-6
SUBLN_EPS = 1e-5

kernel_name = "hybrid_swa_diffattn_hmoe_encoder"


def rmsnorm(x, g, eps=NORM_EPS):
    xf = x.astype(jnp.float32)
    y = xf * lax.rsqrt(jnp.mean(xf * xf, axis=-1, keepdims=True) + eps)
    return y.astype(x.dtype) * g


def alibi_slopes(n_heads):
    h = jnp.arange(1, n_heads + 1, dtype=jnp.float32)
    return jnp.exp2(-8.0 * h / n_heads)


def lambda_init_fn(layer_idx):
    return 0.8 - 0.6 * math.exp(-0.3 * layer_idx)


def windowed_gqa_attention(h, w_qkv, w_o, sink):
    b, s, _ = h.shape
    nb = s // QBLK
    qkv = h @ w_qkv
    q = qkv[..., :SWA_HEADS * HEAD_DIM]
    k = qkv[..., SWA_HEADS * HEAD_DIM:(SWA_HEADS + SWA_KV_HEADS) * HEAD_DIM]
    v = qkv[..., (SWA_HEADS + SWA_KV_HEADS) * HEAD_DIM:]
    q = q.reshape(b, s, SWA_KV_HEADS, SWA_GROUP, HEAD_DIM) * (HEAD_DIM ** -0.5)
    k = k.reshape(b, s, SWA_KV_HEADS, HEAD_DIM)
    v = v.reshape(b, s, SWA_KV_HEADS, HEAD_DIM)
    pad = ((0, 0), (WINDOW, WINDOW), (0, 0), (0, 0))
    kp = jnp.pad(k, pad)
    vp = jnp.pad(v, pad)
    qb = q.reshape(b, nb, QBLK, SWA_KV_HEADS, SWA_GROUP, HEAD_DIM).transpose(1, 0, 2, 3, 4, 5)
    slopes = alibi_slopes(SWA_HEADS).reshape(SWA_KV_HEADS, SWA_GROUP)[:, :, None, None]
    sink_l = sink.astype(jnp.float32).reshape(SWA_KV_HEADS, SWA_GROUP)[:, :, None, None]

    def block(args):
        qi, i = args
        start = i * QBLK
        kb = lax.dynamic_slice_in_dim(kp, start, KBLK, axis=1)
        vb = lax.dynamic_slice_in_dim(vp, start, KBLK, axis=1)
        qpos = start + jnp.arange(QBLK)
        kpos = start - WINDOW + jnp.arange(KBLK)
        dist = jnp.abs(qpos[:, None] - kpos[None, :])
        valid = (kpos[None, :] >= 0) & (kpos[None, :] < s) & (dist <= WINDOW)
        logits = jnp.einsum('bqkgd,bskd->bkgqs', qi, kb).astype(jnp.float32)
        logits = logits - slopes * dist.astype(jnp.float32)
        logits = jnp.where(valid, logits, -jnp.inf)
        m = jnp.maximum(jnp.max(logits, axis=-1, keepdims=True), sink_l)
        p = jnp.exp(logits - m)
        denom = jnp.sum(p, axis=-1, keepdims=True) + jnp.exp(sink_l - m)
        probs = (p / denom).astype(vb.dtype)
        return jnp.einsum('bkgqs,bskd->bqkgd', probs, vb)

    out = lax.map(block, (qb, jnp.arange(nb)))
    out = out.transpose(1, 0, 2, 3, 4, 5).reshape(b, s, SWA_HEADS * HEAD_DIM)
    return out @ w_o


def differential_attention(h, w_qkv, w_o, lam, subln_g, lambda_init):
    b, s, _ = h.shape
    nb = s // QBLK
    qk_w = 2 * DIFF_HEADS * HEAD_DIM
    qkv = h @ w_qkv
    q = qkv[..., :qk_w].reshape(b, s, DIFF_HEADS, 2, HEAD_DIM) * (HEAD_DIM ** -0.5)
    k = qkv[..., qk_w:2 * qk_w].reshape(b, s, DIFF_HEADS, 2, HEAD_DIM)
    v = qkv[..., 2 * qk_w:].reshape(b, s, DIFF_HEADS, DIFF_VDIM)
    lamf = lam.astype(jnp.float32)
    lam_full = (jnp.exp(jnp.sum(lamf[0] * lamf[1])) - jnp.exp(jnp.sum(lamf[2] * lamf[3]))
                + lambda_init)
    slopes = alibi_slopes(DIFF_HEADS)[None, :, None, None, None]
    kpos = jnp.arange(s)
    qb = q.reshape(b, nb, QBLK, DIFF_HEADS, 2, HEAD_DIM).transpose(1, 0, 2, 3, 4, 5)

    def block(args):
        qi, i = args
        qpos = i * QBLK + jnp.arange(QBLK)
        dist = jnp.abs(qpos[:, None] - kpos[None, :]).astype(jnp.float32)
        logits = jnp.einsum('bqhcd,bshcd->bhcqs', qi, k).astype(jnp.float32) - slopes * dist
        a = jax.nn.softmax(logits, axis=-1)
        wmap = a[:, :, 0] - lam_full * a[:, :, 1]
        return jnp.einsum('bhqs,bshe->bqhe', wmap.astype(v.dtype), v)

    o = lax.map(block, (qb, jnp.arange(nb)))
    o = o.transpose(1, 0, 2, 3, 4).reshape(b, s, DIFF_HEADS, DIFF_VDIM)
    o = rmsnorm(o, subln_g, eps=SUBLN_EPS) * (1.0 - lambda_init)
    return o.reshape(b, s, DIFF_HEADS * DIFF_VDIM) @ w_o


def hierarchical_moe(h, w_group, b_group, w_router, b_router, w_gate, w_up, w_down):
    b, s, d = h.shape
    x2 = h.reshape(b * s, d)
    n = x2.shape[0]
    lg = (x2 @ w_group + b_group).astype(jnp.float32)
    pg_all = jax.nn.softmax(lg, axis=-1)
    g = jnp.argmax(lg, axis=-1)
    pg = jnp.take_along_axis(pg_all, g[:, None], axis=1)[:, 0]
    le = (x2 @ w_router + b_router).astype(jnp.float32).reshape(n, N_GROUPS, EXPERTS_PER_GROUP)
    le = jnp.take_along_axis(le, g[:, None, None], axis=1)[:, 0]
    pe = jax.nn.softmax(le, axis=-1)
    top_p, top_i = lax.top_k(pe, TOP_K)
    top_p = top_p / jnp.sum(top_p, axis=-1, keepdims=True)
    weights = pg[:, None] * top_p
    eid = g[:, None] * EXPERTS_PER_GROUP + top_i

    flat_e = eid.reshape(-1)
    flat_w = weights.reshape(-1)
    flat_t = jnp.arange(n * TOP_K) // TOP_K
    order = jnp.argsort(flat_e)
    se, st, sw = flat_e[order], flat_t[order], flat_w[order]
    counts = jnp.zeros((N_EXPERTS,), jnp.int32).at[flat_e].add(1)
    padded = ((counts + MOE_BLK - 1) // MOE_BLK) * MOE_BLK
    start = jnp.cumsum(counts) - counts
    pend = jnp.cumsum(padded)
    pstart = pend - padded
    dest = pstart[se] + (jnp.arange(n * TOP_K) - start[se])
    cap = n * TOP_K + N_EXPERTS * MOE_BLK
    n_blocks = cap // MOE_BLK
    slot_tok = jnp.zeros((cap,), jnp.int32).at[dest].set(st)
    slot_w = jnp.zeros((cap,), x2.dtype).at[dest].set(sw.astype(x2.dtype))
    block_e = jnp.minimum(jnp.searchsorted(pend, jnp.arange(n_blocks) * MOE_BLK, side='right'),
                          N_EXPERTS - 1)
    xs = x2[slot_tok].reshape(n_blocks, MOE_BLK, d)

    def expert_block(args):
        xb, e = args
        hid = jax.nn.silu(xb @ w_gate[e]) * (xb @ w_up[e])
        return hid @ w_down[e]

    ys = lax.map(expert_block, (xs, block_e)).reshape(cap, d)
    out = jnp.zeros_like(x2).at[slot_tok].add(ys * slot_w[:, None])
    return out.reshape(b, s, d)


def setup_inputs(seed: int = 0) -> dict:
    key = jax.random.key(seed)
    ks = jax.random.split(key, 20)
    f32 = jnp.float32
    nrm = lambda k, shape, scale: jax.random.normal(k, shape, f32) * scale
    return {
        "x": jax.random.normal(ks[0], (BATCH, SEQ, D_MODEL), f32),
        "norm_mix": 1.0 + nrm(ks[1], (DEPTH, D_MODEL), 0.02),
        "norm_ffn": 1.0 + nrm(ks[2], (DEPTH, D_MODEL), 0.02),
        "swa_w_qkv": nrm(ks[3], (N_SWA_LAYERS, D_MODEL, SWA_QKV_WIDTH), D_MODEL ** -0.5),
        "swa_w_o": nrm(ks[4], (N_SWA_LAYERS, SWA_HEADS * HEAD_DIM, D_MODEL), (SWA_HEADS * HEAD_DIM) ** -0.5),
        "swa_sink": nrm(ks[5], (N_SWA_LAYERS, SWA_HEADS), 0.5),
        "diff_w_qkv": nrm(ks[6], (N_DIFF_LAYERS, D_MODEL, DIFF_QKV_WIDTH), D_MODEL ** -0.5),
        "diff_w_o": nrm(ks[7], (N_DIFF_LAYERS, DIFF_HEADS * DIFF_VDIM, D_MODEL), (DIFF_HEADS * DIFF_VDIM) ** -0.5),
        "diff_lambda": nrm(ks[8], (N_DIFF_LAYERS, 4, HEAD_DIM), 0.1),
        "diff_subln": 1.0 + nrm(ks[9], (N_DIFF_LAYERS, DIFF_VDIM), 0.02),
        "moe_w_group": nrm(ks[10], (DEPTH, D_MODEL, N_GROUPS), D_MODEL ** -0.5),
        "moe_b_group": nrm(ks[11], (DEPTH, N_GROUPS), 0.01),
        "moe_w_router": nrm(ks[12], (DEPTH, D_MODEL, N_EXPERTS), D_MODEL ** -0.5),
        "moe_b_router": nrm(ks[13], (DEPTH, N_EXPERTS), 0.01),
        "moe_w_gate": nrm(ks[14], (DEPTH, N_EXPERTS, D_MODEL, D_EXPERT), D_MODEL ** -0.5),
        "moe_w_up": nrm(ks[15], (DEPTH, N_EXPERTS, D_MODEL, D_EXPERT), D_MODEL ** -0.5),
        "moe_w_down": nrm(ks[16], (DEPTH, N_EXPERTS, D_EXPERT, D_MODEL), D_EXPERT ** -0.5),
        "final_norm": 1.0 + nrm(ks[17], (D_MODEL,), 0.02),
    }


def reference(x, norm_mix, norm_ffn, swa_w_qkv, swa_w_o, swa_sink, diff_w_qkv, diff_w_o,
              diff_lambda, diff_subln, moe_w_group, moe_b_group, moe_w_router, moe_b_router,
              moe_w_gate, moe_w_up, moe_w_down, final_norm):
    for i in range(DEPTH):
        hn = rmsnorm(x, norm_mix[i])
        j = i // N_MIXERS
        if i % N_MIXERS == 0:
            x = x + windowed_gqa_attention(hn, swa_w_qkv[j], swa_w_o[j], swa_sink[j])
        else:
            x = x + differential_attention(hn, diff_w_qkv[j], diff_w_o[j], diff_lambda[j],
                                           diff_subln[j], lambda_init_fn(i))
        x = x + hierarchical_moe(rmsnorm(x, norm_ffn[i]), moe_w_group[i], moe_b_group[i],
                                 moe_w_router[i], moe_b_router[i], moe_w_gate[i],
                                 moe_w_up[i], moe_w_down[i])
    return rmsnorm(x, final_norm)
```

```cpp
#include <hip/hip_runtime.h>
#include <hip/hip_cooperative_groups.h>
#include <cstdio>
#include <cstdint>
namespace cg = cooperative_groups;

#ifndef MK_N_LAUNCHES
#define MK_N_LAUNCHES 15
#endif
constexpr int N_PHASES = 15;
constexpr int N_LAUNCHES = MK_N_LAUNCHES;

#define LAS __attribute__((address_space(3)))
#define GAS __attribute__((address_space(1)))
typedef unsigned short bf16_t;
typedef short bf16x8 __attribute__((ext_vector_type(8)));
typedef short s16x4 __attribute__((ext_vector_type(4)));
typedef float f32x2 __attribute__((ext_vector_type(2)));
typedef float f32x4 __attribute__((ext_vector_type(4)));
typedef float f32x16 __attribute__((ext_vector_type(16)));
typedef unsigned u32x2 __attribute__((ext_vector_type(2)));
typedef unsigned u32x4 __attribute__((ext_vector_type(4)));
typedef int i32x4 __attribute__((ext_vector_type(4)));
typedef __bf16 bf16x2_t __attribute__((ext_vector_type(2)));

constexpr int D = 1024, BATCH = 4, SEQ = 8192, M = BATCH * SEQ;
constexpr int SWA_N = 1536, DIFF_N = 3072;
constexpr int NEXP = 32, DEXP = 512;
constexpr float LOG2E = 1.4426950408889634f;
constexpr float QSCALE = 0.125f * LOG2E;
constexpr float LAMBDA_INIT = 0.35550906759f;
constexpr int NWAVES = 8;

constexpr size_t MiB = 1u << 20;
constexpr size_t WS_CTL = 0, CTL_ZERO_BYTES = 1 * MiB;
constexpr size_t WS_SWA_QKV_T = 1 * MiB, WS_SWA_WO_T = 4 * MiB, WS_DIFF_QKV_T = 6 * MiB, WS_DIFF_WO_T = 12 * MiB;
constexpr size_t WS_WR = 14 * MiB;
constexpr size_t WS_LTOK = 15 * MiB, WS_LW = 19 * MiB, WS_TINFO = 23 * MiB;
constexpr size_t WS_WMOE = 24 * MiB;
constexpr size_t WS_XN = 216 * MiB;
constexpr size_t WS_SCR = 280 * MiB;
constexpr size_t WS_QKV = WS_SCR, WS_O = WS_SCR + 192 * MiB, WS_Y = WS_SCR, WS_H = WS_SCR + 144 * MiB;
constexpr size_t WS_END = 536 * MiB;
constexpr int CW_BAR = 4096;
constexpr int CW_CNT = 16384;

constexpr int RING_BYTES = 131072;
constexpr int LDSCTL_OFF = RING_BYTES;
constexpr int MISC_OFF = LDSCTL_OFF + 320;
constexpr int TP_OFF = LDSCTL_OFF + 1024;
constexpr int LDS_BYTES = 147456;

__device__ __forceinline__ unsigned f2bf(float f) { unsigned u = __builtin_bit_cast(unsigned, f); return (u + 0x7fffu + ((u >> 16) & 1u)) >> 16; }
__device__ __forceinline__ unsigned pk2(float lo, float hi) { return f2bf(lo) | (f2bf(hi) << 16); }
__device__ __forceinline__ unsigned cvtpk(float lo, float hi) { f32x2 v = {lo, hi}; bf16x2_t b = __builtin_convertvector(v, bf16x2_t); return __builtin_bit_cast(unsigned, b); }
__device__ __forceinline__ float bf2f(unsigned short h) { return __builtin_bit_cast(float, (unsigned)h << 16); }
__device__ __forceinline__ int lane_id() { return (int)__builtin_amdgcn_mbcnt_hi(~0u, __builtin_amdgcn_mbcnt_lo(~0u, 0u)); }
__device__ __forceinline__ float wave_sum(float v) {
#pragma unroll
    for (int o = 1; o < 64; o <<= 1) v += __shfl_xor(v, o);
    return v;
}

namespace pg8 {
constexpr int BM = 256, BK = 64, HALF = 128, HTB = HALF * BK * 2, STAGE_BYTES = 8 * HTB, NXCD = 8, WGM = 8;
__host__ __device__ __forceinline__ int lds_byte(int r, int c) { const int st = (r >> 4) * 2 + (c >> 5), rr = r & 15, cc = c & 31, ob = rr * 64 + cc * 2; return st * 1024 + (ob ^ (((ob >> 9) & 1) << 5)); }
__host__ __device__ __forceinline__ void stage_rc(int b, int& R, int& C) { const int st = b / 1024, sb = b % 1024, swz = sb ^ (((sb >> 9) & 1) << 5); R = (st >> 1) * 16 + swz / 64; C = (st & 1) * 32 + (swz % 64) / 2; }
__host__ __device__ __forceinline__ int perm32(int rho) { const int n = rho >> 4, i = rho & 15; return 8 * (i >> 2) + 4 * n + (i & 3); }

struct Unit { int pm, pn, e, t, pnl; };
struct Gemm { const bf16_t* A; const bf16_t* Bt; int K; };

struct DenseOrder {
    int nM, nN, nwg, G, c;
    __device__ void init(int Mr, int N, int G_, int c_) { nM = Mr / BM; nN = N / BM; nwg = nM * nN; G = G_; c = c_; }
    __device__ bool next(int i, Unit& u) const {
        const long L = (long)i * G + c; if (L >= nwg) return false;
        int wgid = (int)L; { const int q = nwg / NXCD, r = nwg % NXCD, xcd = wgid % NXCD, off = wgid / NXCD; wgid = (xcd < r ? xcd * (q + 1) : r * (q + 1) + (xcd - r) * q) + off; }
        const int nig = WGM * nN, gid = wgid / nig, fm = gid * WGM, gsz = (nM - fm) < WGM ? (nM - fm) : WGM;
        u.pm = fm + ((wgid % nig) % gsz); u.pn = (wgid % nig) / gsz; u.e = 0; u.t = 0; u.pnl = u.pn; return true;
    }
    __device__ __forceinline__ int token(const Unit&, int) const { return 0; }
};
struct MoeOrder {
    const LAS int* TP; const LAS int* CNT; const int* ltok; int G, c, pn_mul, pn_add;
    __device__ bool next(int i, Unit& u) const {
        const int ntile = __builtin_amdgcn_readfirstlane(TP[32]); const int nwg = ntile * 4;
        const long L = (long)i * G + c; if (L >= nwg) return false;
        int wgid = (int)L; { const int q = nwg / NXCD, r = nwg % NXCD, xcd = wgid % NXCD, off = wgid / NXCD; wgid = (xcd < r ? xcd * (q + 1) : r * (q + 1) + (xcd - r) * q) + off; }
        const int tau = wgid >> 2; int e = 0;
        while (e < 31 && __builtin_amdgcn_readfirstlane(TP[e + 1]) <= tau) ++e;
        u.pm = tau; u.e = e; u.t = tau - __builtin_amdgcn_readfirstlane(TP[e]); u.pnl = wgid & 3; u.pn = e * pn_mul + pn_add + u.pnl; return true;
    }
    __device__ __forceinline__ int token(const Unit& u, int r) const { const int idx = u.t * 256 + r; return idx < CNT[u.e] ? ltok[(size_t)u.e * M + idx] : 0; }
};

struct EpiQKV {
    static constexpr bool PERM = true;
    bf16_t* O; int ldc; int qcols; float qscale;
    __device__ __forceinline__ void operator()(const f32x4 (&acc)[2][2][4][2], const Unit& u, int wr, int wc, int fr, int fq) const {
        const int row0 = u.pm * BM + wr * 64 + fr, colt = u.pn * BM; const float sc = colt < qcols ? qscale : 1.f;
        const int col0 = colt + wc * 32 + 8 * fq;
#pragma unroll
        for (int ai = 0; ai < 2; ++ai)
#pragma unroll
            for (int m = 0; m < 4; ++m) { bf16_t* rowp = O + (size_t)(row0 + ai * HALF + m * 16) * ldc + col0;
#pragma unroll
                for (int bj = 0; bj < 2; ++bj) { const f32x4 v0 = acc[ai][bj][m][0] * sc, v1 = acc[ai][bj][m][1] * sc;
                    u32x4 w; w.x = cvtpk(v0[0], v0[1]); w.y = cvtpk(v0[2], v0[3]); w.z = cvtpk(v1[0], v1[1]); w.w = cvtpk(v1[2], v1[3]);
                    *(u32x4*)(rowp + bj * HALF) = w; } }
    }
};
struct EpiResid {
    static constexpr bool PERM = false;
    const float* base; float* out;
    __device__ __forceinline__ void operator()(const f32x4 (&acc)[2][2][4][2], const Unit& u, int wr, int wc, int fr, int fq) const {
        const int col0 = u.pn * BM + wc * 32 + 4 * fq;
#pragma unroll
        for (int ai = 0; ai < 2; ++ai)
#pragma unroll
            for (int m = 0; m < 4; ++m) { const size_t off = (size_t)(u.pm * BM + ai * HALF + wr * 64 + m * 16 + fr) * D + col0;
#pragma unroll
                for (int bj = 0; bj < 2; ++bj)
#pragma unroll
                    for (int n = 0; n < 2; ++n) { const size_t idx = off + bj * HALF + n * 16; const f32x4 b = *(const f32x4*)(base + idx); *(f32x4*)(out + idx) = b + acc[ai][bj][m][n]; } }
    }
};
__device__ __forceinline__ float silu_mul(float g, float u) { return g * u * __builtin_amdgcn_rcpf(1.f + __builtin_amdgcn_exp2f(-g * LOG2E)); }
struct EpiSwiGLU {
    static constexpr bool PERM = true;
    bf16_t* H;
    __device__ __forceinline__ void operator()(const f32x4 (&acc)[2][2][4][2], const Unit& u, int wr, int wc, int fr, int fq) const {
        const int colh = u.pnl * 128 + wc * 32 + 8 * fq;
#pragma unroll
        for (int ai = 0; ai < 2; ++ai)
#pragma unroll
            for (int m = 0; m < 4; ++m) { const size_t row = (size_t)u.pm * BM + ai * HALF + wr * 64 + m * 16 + fr;
                const f32x4 g0 = acc[ai][0][m][0], g1 = acc[ai][0][m][1], u0 = acc[ai][1][m][0], u1 = acc[ai][1][m][1];
                u32x4 w; w.x = cvtpk(silu_mul(g0[0], u0[0]), silu_mul(g0[1], u0[1])); w.y = cvtpk(silu_mul(g0[2], u0[2]), silu_mul(g0[3], u0[3]));
                w.z = cvtpk(silu_mul(g1[0], u1[0]), silu_mul(g1[1], u1[1])); w.w = cvtpk(silu_mul(g1[2], u1[2]), silu_mul(g1[3], u1[3]));
                *(u32x4*)(H + row * DEXP + colh) = w; }
    }
};
struct EpiDown {
    static constexpr bool PERM = true;
    bf16_t* Y; const float* lw;
    __device__ __forceinline__ void operator()(const f32x4 (&acc)[2][2][4][2], const Unit& u, int wr, int wc, int fr, int fq) const {
        const int col0 = u.pnl * BM + wc * 32 + 8 * fq;
#pragma unroll
        for (int ai = 0; ai < 2; ++ai)
#pragma unroll
            for (int m = 0; m < 4; ++m) { const int rl = ai * HALF + wr * 64 + m * 16 + fr; const size_t row = (size_t)u.pm * BM + rl;
                const float sc = lw[(size_t)u.e * M + u.t * 256 + rl];
#pragma unroll
                for (int bj = 0; bj < 2; ++bj) { const f32x4 v0 = acc[ai][bj][m][0] * sc, v1 = acc[ai][bj][m][1] * sc;
                    u32x4 w; w.x = cvtpk(v0[0], v0[1]); w.y = cvtpk(v0[2], v0[3]); w.z = cvtpk(v1[0], v1[1]); w.w = cvtpk(v1[2], v1[3]);
                    *(u32x4*)(Y + row * D + col0 + bj * HALF) = w; } }
    }
};

template <class Epi, class Sched, bool GATHER, bool ALIGN_EPI>
__device__ __forceinline__ void gemm_phase(LAS unsigned char* lds, const Gemm g, const Sched& S, const Epi& E, const int wid, const int lane) {
    const int tid = wid * 64 + lane, wr = wid >> 2, wc = wid & 3, fr = lane & 15, fq = lane >> 4;
    const int K = g.K, nt = K / BK;
    int Rr[2], Cc[2]; unsigned voffB[2];
#pragma unroll
    for (int i = 0; i < 2; ++i) { int R, C; stage_rc(tid * 16 + i * 8192, R, C); Rr[i] = R; Cc[i] = C; const int Rb = Epi::PERM ? ((R & ~31) + perm32(R & 31)) : R; voffB[i] = (unsigned)(Rb * K + C) * 2u; }
    const size_t kstep = (size_t)(BK * 2);
    const size_t hstep = (size_t)HALF * K * 2;
    const size_t tstep = 2 * hstep;
    const unsigned ldsw = (unsigned)wid * 1024u;
    const int aoff = lds_byte(wr * 64 + fr, fq * 8), boff = lds_byte(wc * 32 + fr, fq * 8);
#define PG8_SA(b, h) (((b) * 2 + (h)) * HTB)
#define PG8_SB(b, h) ((4 + (b) * 2 + (h)) * HTB)
#define PG8_STAGE2(bufoff, gbase, o0, o1) do { \
        __builtin_amdgcn_global_load_lds((const unsigned*)((const char*)(gbase) + (o0)), (LAS unsigned*)(lds + (bufoff) + ldsw), 16, 0, 0); \
        __builtin_amdgcn_global_load_lds((const unsigned*)((const char*)(gbase) + (o1)), (LAS unsigned*)(lds + (bufoff) + ldsw + 8192), 16, 0, 0); } while (0)
#define PG8_STAGEB(bufoff, gbase) PG8_STAGE2(bufoff, gbase, voffB[0], voffB[1])
#define PG8_LDA(dst, b, h) do { _Pragma("unroll") for (int m = 0; m < 4; ++m) _Pragma("unroll") for (int k = 0; k < 2; ++k) dst[m][k] = *(const LAS bf16x8*)(lds + PG8_SA(b, h) + aoff + m * 2048 + k * 1024); } while (0)
#define PG8_LDB(dst, b, h) do { _Pragma("unroll") for (int n = 0; n < 2; ++n) _Pragma("unroll") for (int k = 0; k < 2; ++k) dst[n][k] = *(const LAS bf16x8*)(lds + PG8_SB(b, h) + boff + n * 2048 + k * 1024); } while (0)
#define PG8_MMA(ai, bj, At, Bt) do { __builtin_amdgcn_s_setprio(1); _Pragma("unroll") for (int m = 0; m < 4; ++m) _Pragma("unroll") for (int n = 0; n < 2; ++n) _Pragma("unroll") for (int k = 0; k < 2; ++k) \
        acc[ai][bj][m][n] = __builtin_amdgcn_mfma_f32_16x16x32_bf16(Bt[n][k], At[m][k], acc[ai][bj][m][n], 0, 0, 0); __builtin_amdgcn_s_setprio(0); } while (0)
#define PG8_WAIT_V(n) asm volatile("s_waitcnt vmcnt(" #n ")" ::: "memory")
#define PG8_WAIT_L(n) asm volatile("s_waitcnt lgkmcnt(" #n ")" ::: "memory")
#define PG8_BAR __builtin_amdgcn_s_barrier()
#define PG8_SCHED __builtin_amdgcn_sched_barrier(0)
    Unit cur, nxt; int ui = 0;
    if (!S.next(0, cur)) return;
    unsigned oc00, oc01, oc10, oc11, on00, on01, on10, on11;
    if constexpr (GATHER) {
        oc00 = (unsigned)(S.token(cur, Rr[0]) * K + Cc[0]) * 2u; oc01 = (unsigned)(S.token(cur, Rr[1]) * K + Cc[1]) * 2u;
        oc10 = (unsigned)(S.token(cur, 128 + Rr[0]) * K + Cc[0]) * 2u; oc11 = (unsigned)(S.token(cur, 128 + Rr[1]) * K + Cc[1]) * 2u;
    } else {
        oc00 = (unsigned)(Rr[0] * K + Cc[0]) * 2u; oc01 = (unsigned)(Rr[1] * K + Cc[1]) * 2u; oc10 = oc00 + (unsigned)hstep; oc11 = oc01 + (unsigned)hstep;
    }
    on00 = oc00; on01 = oc01; on10 = oc10; on11 = oc11;
    f32x4 acc[2][2][4][2];
#pragma unroll
    for (int a = 0; a < 2; ++a)
#pragma unroll
        for (int b = 0; b < 2; ++b)
#pragma unroll
            for (int m = 0; m < 4; ++m)
#pragma unroll
                for (int n = 0; n < 2; ++n) acc[a][b][m][n] = (f32x4){0.f, 0.f, 0.f, 0.f};
    bf16x8 At[4][2], B0[2][2], B1[2][2];
    const char* cA = GATHER ? (const char*)g.A : (const char*)g.A + (size_t)cur.pm * tstep; const char* cB = (const char*)g.Bt + (size_t)cur.pn * tstep;
    PG8_STAGEB(PG8_SB(0, 0), cB); PG8_STAGEB(PG8_SB(0, 1), cB + hstep); PG8_STAGE2(PG8_SA(0, 0), cA, oc00, oc01); PG8_STAGE2(PG8_SA(0, 1), cA, oc10, oc11);
    if (wr == 1) PG8_BAR;
    PG8_WAIT_V(2); PG8_BAR;
    PG8_STAGEB(PG8_SB(1, 0), cB + kstep); PG8_STAGE2(PG8_SA(1, 0), cA + kstep, oc00, oc01); PG8_STAGEB(PG8_SB(1, 1), cB + hstep + kstep);
    PG8_WAIT_V(6); PG8_BAR;
    for (;;) {
        const bool has_next = S.next(ui + 1, nxt);
        const char* nA = has_next ? (GATHER ? (const char*)g.A : (const char*)g.A + (size_t)nxt.pm * tstep) : cA; const char* nB = has_next ? (const char*)g.Bt + (size_t)nxt.pn * tstep : cB;
        if constexpr (GATHER) {
            if (has_next) {
                on00 = (unsigned)(S.token(nxt, Rr[0]) * K + Cc[0]) * 2u; on01 = (unsigned)(S.token(nxt, Rr[1]) * K + Cc[1]) * 2u;
                on10 = (unsigned)(S.token(nxt, 128 + Rr[0]) * K + Cc[0]) * 2u; on11 = (unsigned)(S.token(nxt, 128 + Rr[1]) * K + Cc[1]) * 2u;
            } else { on00 = oc00; on01 = oc01; on10 = oc10; on11 = oc11; }
        }
        for (int t = 0; t < nt; t += 2) {
            const bool last = (t == nt - 2);
            const char* a1 = cA + (size_t)(t + 1) * kstep;
            const char* a2 = last ? nA : cA + (size_t)(t + 2) * kstep; const char* b2 = last ? nB : cB + (size_t)(t + 2) * kstep;
            const char* a3 = a2 + kstep; const char* b3 = b2 + kstep;
            const unsigned x00 = (GATHER && last) ? on00 : oc00, x01 = (GATHER && last) ? on01 : oc01, x10 = (GATHER && last) ? on10 : oc10, x11 = (GATHER && last) ? on11 : oc11;
            PG8_LDB(B0, 0, 0); PG8_LDB(B1, 0, 1); PG8_SCHED; PG8_LDA(At, 0, 0); PG8_STAGE2(PG8_SA(1, 1), a1, oc10, oc11);
            PG8_WAIT_V(8); PG8_WAIT_L(0); PG8_BAR; PG8_MMA(0, 0, At, B0); PG8_MMA(0, 1, At, B1); PG8_BAR; PG8_SCHED;
            PG8_LDA(At, 0, 1); PG8_STAGEB(PG8_SB(0, 0), b2); PG8_STAGEB(PG8_SB(0, 1), b2 + hstep); PG8_STAGE2(PG8_SA(0, 0), a2, x00, x01);
            PG8_WAIT_V(8); PG8_WAIT_L(0); PG8_BAR; PG8_MMA(1, 0, At, B0); PG8_MMA(1, 1, At, B1); PG8_BAR; PG8_SCHED;
            PG8_LDB(B0, 1, 0); PG8_LDB(B1, 1, 1); PG8_SCHED; PG8_LDA(At, 1, 0); PG8_STAGE2(PG8_SA(0, 1), a2, x10, x11);
            PG8_WAIT_V(8); PG8_WAIT_L(0); PG8_BAR; PG8_MMA(0, 0, At, B0); PG8_MMA(0, 1, At, B1); PG8_BAR; PG8_SCHED;
            PG8_LDA(At, 1, 1); PG8_STAGEB(PG8_SB(1, 0), b3); PG8_STAGEB(PG8_SB(1, 1), b3 + hstep); PG8_STAGE2(PG8_SA(1, 0), a3, x00, x01);
            PG8_WAIT_V(8); PG8_WAIT_L(0); PG8_BAR; PG8_MMA(1, 0, At, B0); PG8_MMA(1, 1, At, B1); PG8_BAR; PG8_SCHED;
        }
        if constexpr (ALIGN_EPI) { if (wr == 0) PG8_BAR; }
        E(acc, cur, wr, wc, fr, fq);
        if (!has_next) break;
#pragma unroll
        for (int a = 0; a < 2; ++a)
#pragma unroll
            for (int b = 0; b < 2; ++b)
#pragma unroll
                for (int m = 0; m < 4; ++m)
#pragma unroll
                    for (int n = 0; n < 2; ++n) acc[a][b][m][n] = (f32x4){0.f, 0.f, 0.f, 0.f};
        cur = nxt; cA = nA; cB = nB; ++ui; oc00 = on00; oc01 = on01; oc10 = on10; oc11 = on11;
        if constexpr (ALIGN_EPI) { if (wr == 1) PG8_BAR; }
    }
    PG8_WAIT_V(0);
    if constexpr (!ALIGN_EPI) { if (wr == 0) PG8_BAR; }
    PG8_BAR;
#undef PG8_SA
#undef PG8_SB
#undef PG8_STAGE2
#undef PG8_STAGEB
#undef PG8_LDA
#undef PG8_LDB
#undef PG8_MMA
#undef PG8_WAIT_V
#undef PG8_WAIT_L
#undef PG8_BAR
#undef PG8_SCHED
}
}

namespace att {
constexpr int NSLOT = 3;
constexpr float THR = 8.0f;
__device__ __forceinline__ void glds16(const void* gsrc, unsigned lds_dst) { unsigned keep;
    asm volatile("s_mov_b32 %0, m0\n\ts_mov_b32 m0, %2\n\ts_nop 0\n\tglobal_load_lds_dwordx4 %1, off\n\ts_mov_b32 m0, %0" : "=&s"(keep) : "v"(gsrc), "s"(lds_dst) : "memory"); }
#define ATT_WAIT_BAR(N) asm volatile("s_waitcnt vmcnt(" #N ") lgkmcnt(0)\n\ts_barrier" ::: "memory")
typedef LAS const char* lds_cptr;
typedef short v4i16_t __attribute__((ext_vector_type(4)));
__device__ __forceinline__ s16x4 vtr(lds_cptr p) { return __builtin_bit_cast(s16x4, __builtin_amdgcn_ds_read_tr16_b64_v4i16((LAS v4i16_t*)p)); }
__device__ __forceinline__ float swap_max(float m) { auto rr = __builtin_amdgcn_permlane32_swap(__float_as_uint(m), __float_as_uint(m), false, false); return __builtin_fmaxf(__uint_as_float(rr[0]), __uint_as_float(rr[1])); }
__device__ __forceinline__ float swap_sum(float m) { auto rr = __builtin_amdgcn_permlane32_swap(__float_as_uint(m), __float_as_uint(m), false, false); return __uint_as_float(rr[0]) + __uint_as_float(rr[1]); }
#define CRF(r) ((float)(((r) & 3) + 8 * ((r) >> 2)))
#define CRI(r) (((r) & 3) + 8 * ((r) >> 2))

template <int MODE> struct Cfg;
template <> struct Cfg<0> { static constexpr int DV32 = 2, NK = 1, SLOTB = 16384, VOFF = 8192, PITCH = SWA_N, NVP = 1; };
template <> struct Cfg<1> { static constexpr int DV32 = 4, NK = 2, SLOTB = 32768, VOFF = 16384, PITCH = DIFF_N, NVP = 2; };

template <int MODE>
__device__ __forceinline__ void tile_step(lds_cptr kp, lds_cptr vp, const bf16x8 (&qr)[4], f32x16 (&o)[Cfg<MODE>::DV32], float& mhat, float& l, bool& first,
                                          const float slope2, const int dq_i, const int kind, const int hi) {
    constexpr int DV32 = Cfg<MODE>::DV32;
    f32x16 p0, p1;
    const float dq = (float)dq_i, nm = -mhat;
    {
        const float sl = kind == 2 ? 0.f : (kind == 0 ? slope2 : -slope2); const float base0 = __builtin_fmaf(-sl, dq, nm);
#pragma unroll
        for (int r = 0; r < 16; ++r) { p0[r] = __builtin_fmaf(sl, CRF(r), base0); p1[r] = __builtin_fmaf(sl, CRF(r) + 32.f, base0); }
    }
#pragma unroll
    for (int d0 = 0; d0 < 4; ++d0) {
        const bf16x8 b0 = *(const LAS bf16x8*)(kp + d0 * 2048);
        const bf16x8 b1 = *(const LAS bf16x8*)(kp + d0 * 2048 + 512);
        p0 = __builtin_amdgcn_mfma_f32_32x32x16_bf16(b0, qr[d0], p0, 0, 0, 0);
        p1 = __builtin_amdgcn_mfma_f32_32x32x16_bf16(b1, qr[d0], p1, 0, 0, 0);
    }
    if (kind == 2) {
#pragma unroll
        for (int r = 0; r < 16; ++r) {
            const float e0 = __builtin_fabsf(dq - CRF(r)), e1 = __builtin_fabsf(dq - CRF(r) - 32.f);
            if (MODE == 0) { p0[r] = e0 <= 128.f ? __builtin_fmaf(-slope2, e0, p0[r]) : -INFINITY; p1[r] = e1 <= 128.f ? __builtin_fmaf(-slope2, e1, p1[r]) : -INFINITY; }
            else { p0[r] = __builtin_fmaf(-slope2, e0, p0[r]); p1[r] = __builtin_fmaf(-slope2, e1, p1[r]); }
        }
    }
    float rm = __builtin_fmaxf(p0[0], p1[0]);
#pragma unroll
    for (int r = 1; r < 16; ++r) rm = __builtin_fmaxf(rm, __builtin_fmaxf(p0[r], p1[r]));
    rm = swap_max(rm);
    if (first || __any(rm > THR)) {
        const float dl = first ? rm : __builtin_fmaxf(rm, 0.f);
        mhat += dl;
#pragma unroll
        for (int r = 0; r < 16; ++r) { p0[r] -= dl; p1[r] -= dl; }
        if (!first) {
            const float f = __builtin_amdgcn_exp2f(-dl); l *= f;
#pragma unroll
            for (int r = 0; r < 16; ++r) { const float fr_ = __shfl(f, CRI(r) + 4 * hi);
#pragma unroll
                for (int d0 = 0; d0 < DV32; ++d0) o[d0][r] *= fr_; }
        }
        first = false;
    }
    float sacc = 0.f;
    u32x4 pw[4];
#pragma unroll
    for (int s = 0; s < 2; ++s) {
        float e[8];
#pragma unroll
        for (int j = 0; j < 8; ++j) { e[j] = __builtin_amdgcn_exp2f(p0[8 * s + j]); sacc += e[j]; }
        pw[s] = (u32x4){cvtpk(e[0], e[1]), cvtpk(e[2], e[3]), cvtpk(e[4], e[5]), cvtpk(e[6], e[7])};
    }
#pragma unroll
    for (int s = 0; s < 2; ++s) {
        float e[8];
#pragma unroll
        for (int j = 0; j < 8; ++j) { e[j] = __builtin_amdgcn_exp2f(p1[8 * s + j]); sacc += e[j]; }
        pw[2 + s] = (u32x4){cvtpk(e[0], e[1]), cvtpk(e[2], e[3]), cvtpk(e[4], e[5]), cvtpk(e[6], e[7])};
    }
    l += sacc;
#pragma unroll
    for (int d0 = 0; d0 < DV32; ++d0) {
#pragma unroll
        for (int ks = 0; ks < 4; ++ks) {
            const s16x4 lo = vtr(vp + d0 * 4096 + ks * 1024), hh = vtr(vp + d0 * 4096 + ks * 1024 + 512);
            const bf16x8 vf = (bf16x8){lo[0], lo[1], lo[2], lo[3], hh[0], hh[1], hh[2], hh[3]};
            o[d0] = __builtin_amdgcn_mfma_f32_32x32x16_bf16(__builtin_bit_cast(bf16x8, pw[ks]), vf, o[d0], 0, 0, 0);
        }
    }
}

struct DiffConsts { float lam_full; const float* subln; };

template <int MODE>
__device__ __forceinline__ void attn_unit(const int b, const int hh, const int qb, const bf16_t* __restrict__ QKV, bf16_t* __restrict__ O, const float* __restrict__ sink,
                                          const DiffConsts dc, LAS unsigned char* shm, const int wid, const int lane) {
    typedef Cfg<MODE> C;
    constexpr int DV32 = C::DV32, PITCH = C::PITCH;
    const int r32 = lane & 31, hi = lane >> 5;
    int iw, qcol, kcol, vcol, t_lo, NT, hq = 0, cmap = 0, qs;
    float slope2;
    if (MODE == 0) { const int g = wid >> 1; qs = wid & 1; hq = hh * 4 + g; iw = qb * 64 + qs * 32; qcol = hq * 64; kcol = 1024 + hh * 64; vcol = 1280 + hh * 64;
        t_lo = qb - 2 < 0 ? 0 : qb - 2; const int t_hi = qb + 2 > 127 ? 127 : qb + 2; NT = t_hi - t_lo + 1; slope2 = __builtin_amdgcn_exp2f(-0.5f * (float)(hq + 1)) * LOG2E; }
    else { qs = wid & 3; cmap = wid >> 2; iw = qb * 128 + qs * 32; qcol = (hh * 2 + cmap) * 64; kcol = 1024 + hh * 128; vcol = 2048 + hh * 128; t_lo = 0; NT = SEQ / 64;
        slope2 = __builtin_amdgcn_exp2f(-(float)(hh + 1)) * LOG2E; }
    const bf16_t* base = QKV + (size_t)b * SEQ * PITCH;
    const unsigned lds0 = (unsigned)(uintptr_t)shm;
    const unsigned koff = (unsigned)(lane * PITCH + kcol + wid * 8) * 2u;
    const unsigned voff = (unsigned)((16 * (wid & 3) + (lane >> 2)) * PITCH + vcol + (wid >> 2) * 32 + (lane & 3) * 8) * 2u;
    const unsigned kdst = lds0 + wid * 1024, vdst = lds0 + C::VOFF + wid * 1024;
#define ATT_DMA(t, slot) do { const char* tb_ = (const char*)base + (size_t)(t) * 64 * PITCH * 2; const unsigned so_ = (unsigned)(slot) * C::SLOTB; \
        glds16(tb_ + koff, (unsigned)__builtin_amdgcn_readfirstlane(kdst + so_)); \
        if (MODE == 1) glds16(tb_ + koff + 128, (unsigned)__builtin_amdgcn_readfirstlane(kdst + so_ + 8192)); \
        glds16(tb_ + voff, (unsigned)__builtin_amdgcn_readfirstlane(vdst + so_)); \
        if (MODE == 1) glds16(tb_ + voff + 128, (unsigned)__builtin_amdgcn_readfirstlane(vdst + so_ + 8192)); } while (0)
    ATT_DMA(t_lo, 0);
    if (NT > 1) ATT_DMA(t_lo + 1, 1);
    bf16x8 qr[4];
    { const bf16_t* Qw = base + (size_t)(iw + r32) * PITCH + qcol;
#pragma unroll
      for (int d0 = 0; d0 < 4; ++d0) qr[d0] = *(const bf16x8*)(Qw + d0 * 16 + hi * 8); }
    f32x16 o[DV32];
#pragma unroll
    for (int d0 = 0; d0 < DV32; ++d0)
#pragma unroll
        for (int r = 0; r < 16; ++r) o[d0][r] = 0.f;
    float mhat = 0.f, l = 0.f; bool first = true;
    if (MODE == 0) { mhat = sink[hq] * LOG2E; l = (hi == 0) ? 1.f : 0.f; first = false; }
    const lds_cptr shm3 = (lds_cptr)shm;
    const lds_cptr kp0 = shm3 + (MODE == 1 ? cmap * 8192 : 0) + hi * 1024 + r32 * 16;
    const lds_cptr vp0 = shm3 + C::VOFF + ((lane >> 4) & 1) * 32 + (lane & 3) * 8 + (4 * hi + ((lane & 15) >> 2)) * 64;
    int slot = 0;
    for (int it = 0; it < NT; ++it) {
        if (it + 1 < NT) { if (MODE == 1) { ATT_WAIT_BAR(4); } else { ATT_WAIT_BAR(2); } } else { ATT_WAIT_BAR(0); }
        if (it + 2 < NT) { const int s2 = slot == 0 ? 2 : slot - 1; ATT_DMA(t_lo + it + 2, s2); }
        const int k0 = (t_lo + it) * 64;
        const int kind = (MODE == 0) ? 2 : ((k0 + 63 < iw) ? 0 : ((k0 > iw + 31) ? 1 : 2));
        tile_step<MODE>(kp0 + slot * C::SLOTB, vp0 + slot * C::SLOTB, qr, o, mhat, l, first, slope2, iw + r32 - k0 - 4 * hi, kind, hi);
        slot = slot == 2 ? 0 : slot + 1;
    }
#undef ATT_DMA
    l = swap_sum(l);
    const float rl = 1.f / l;
    if (MODE == 0) {
        bf16_t* Ow = O + (size_t)(b * SEQ + iw) * D + hq * 64 + r32;
#pragma unroll
        for (int r = 0; r < 16; ++r) { const int row = CRI(r) + 4 * hi; const float rr = __shfl(rl, row);
#pragma unroll
            for (int d0 = 0; d0 < DV32; ++d0) Ow[(size_t)row * D + d0 * 32] = (bf16_t)f2bf(o[d0][r] * rr); }
        ATT_WAIT_BAR(0);
    } else {
        LAS float* cb = (LAS float*)shm + qs * 4096;
        ATT_WAIT_BAR(0);
        if (cmap == 1) {
#pragma unroll
            for (int r = 0; r < 16; ++r) { const int row = CRI(r) + 4 * hi; const float rr = __shfl(rl, row) * dc.lam_full;
#pragma unroll
                for (int d0 = 0; d0 < DV32; ++d0) cb[row * 128 + d0 * 32 + r32] = o[d0][r] * rr; }
        }
        ATT_WAIT_BAR(0);
        if (cmap == 0) {
            bf16_t* Ow = O + (size_t)(b * SEQ + iw) * D + hh * 128 + r32;
            float gsub[DV32];
#pragma unroll
            for (int d0 = 0; d0 < DV32; ++d0) gsub[d0] = dc.subln[d0 * 32 + r32] * (1.f - LAMBDA_INIT);
#pragma unroll
            for (int r = 0; r < 16; ++r) { const int row = CRI(r) + 4 * hi; const float rr = __shfl(rl, row);
                float v[DV32]; float ss = 0.f;
#pragma unroll
                for (int d0 = 0; d0 < DV32; ++d0) { v[d0] = o[d0][r] * rr - cb[row * 128 + d0 * 32 + r32]; ss += v[d0] * v[d0]; }
                ss += __shfl_xor(ss, 1); ss += __shfl_xor(ss, 2); ss += __shfl_xor(ss, 4); ss += __shfl_xor(ss, 8); ss += __shfl_xor(ss, 16);
                const float sc = __builtin_amdgcn_rsqf(ss * (1.f / 128.f) + 1e-5f);
#pragma unroll
                for (int d0 = 0; d0 < DV32; ++d0) Ow[(size_t)row * D + d0 * 32] = (bf16_t)f2bf(v[d0] * sc * gsub[d0]); }
        }
        ATT_WAIT_BAR(0);
    }
}
#undef ATT_WAIT_BAR
}

typedef GAS unsigned gu32;
#define RLX_AGENT __ATOMIC_RELAXED, __HIP_MEMORY_SCOPE_AGENT
#define LDS_WAIT() asm volatile("s_waitcnt lgkmcnt(0)" ::: "memory")
#define VM_WAIT() asm volatile("s_waitcnt vmcnt(0)" ::: "memory")
#define XB_TMO      128
#define XB_XCNT(j)  (256  + 64 * (j))
#define XB_XSUB(j)  (1280 + 64 * (j))
#define XB_XGEN(j)  (2304 + 64 * (j))
#define XB_TOP      3328
#define XB_TOPGEN   3392
#define XCD_BAR_WORDS 3456
#define XB_SPIN_CAP (1u << 18)
__device__ __forceinline__ unsigned xb_ld(unsigned* p)              { return __hip_atomic_load(p, __ATOMIC_RELAXED, __HIP_MEMORY_SCOPE_AGENT); }
__device__ __forceinline__ unsigned xb_add(unsigned* p, unsigned v) { return __hip_atomic_fetch_add(p, v, __ATOMIC_RELAXED, __HIP_MEMORY_SCOPE_AGENT); }
__device__ __forceinline__ unsigned xb_xcc_id() { return (unsigned)__builtin_amdgcn_s_getreg((3 << 11) | 20) & 0xFu; }
#define XB_SPIN(cond, bar) do { unsigned _sp = 0; while (cond) { __builtin_amdgcn_s_sleep(1); \
    if ((++_sp & 255u) == 0u) { if (xb_ld(&(bar)[XB_TMO])) break; if (_sp > XB_SPIN_CAP) { atomicAdd(&(bar)[XB_TMO], 1u); break; } } } } while (0)
struct XcdBarrier { unsigned* bar; unsigned x; volatile LAS unsigned* st; };
__device__ __forceinline__ XcdBarrier xcd_barrier_post(unsigned* bar, volatile LAS unsigned* st, const bool leader) {
    XcdBarrier b; b.bar = bar; b.x = xb_xcc_id(); b.st = st;
    if (leader) (void)xb_add(&bar[XB_XCNT(b.x)], 1u);
    return b;
}
__device__ __forceinline__ void xcd_barrier_complete(unsigned* bar, unsigned x, unsigned& nloc, unsigned& nx) {
    const unsigned G = gridDim.x * gridDim.y * gridDim.z;
    unsigned sum, cnt, mine, sp = 0u;
    for (;;) {
        sum = 0u; cnt = 0u; mine = 0u;
#pragma unroll
        for (unsigned j = 0; j < 16; ++j) { const unsigned c = xb_ld(&bar[XB_XCNT(j)]); sum += c; cnt += (c > 0u) ? 1u : 0u; mine = (j == x) ? c : mine; }
        if (sum == G) break;
        __builtin_amdgcn_s_sleep(1);
        if ((++sp & 255u) == 0u) { if (xb_ld(&bar[XB_TMO])) break; if (sp > XB_SPIN_CAP) { atomicAdd(&bar[XB_TMO], 1u); break; } }
    }
    nloc = mine > 0u ? mine : 1u; nx = cnt > 0u ? cnt : 1u;
}
__device__ __forceinline__ void xcd_barrier(const XcdBarrier& b, const bool leader) {
    asm volatile("s_waitcnt vmcnt(0)" ::: "memory");
    __syncthreads();
    if (leader) {
        unsigned* bar = b.bar;
        __builtin_amdgcn_s_waitcnt(0);
        unsigned nloc = b.st[0], nx = b.st[1];
        if (nloc == 0u) { xcd_barrier_complete(bar, b.x, nloc, nx); b.st[0] = nloc; b.st[1] = nx; }
        const unsigned old = xb_add(&bar[XB_XSUB(b.x)], 1u);
        const unsigned gen = old / nloc;
        if (old + 1u == (gen + 1u) * nloc) {
            __builtin_amdgcn_fence(__ATOMIC_RELEASE, "agent");
            asm volatile("s_waitcnt vmcnt(0)" ::: "memory");
            const unsigned og = xb_add(&bar[XB_TOP], 1u);
            const unsigned tg = og / nx;
            if (og + 1u == (tg + 1u) * nx) xb_add(&bar[XB_TOPGEN], 1u);
            else XB_SPIN(xb_ld(&bar[XB_TOPGEN]) == tg, bar);
            __builtin_amdgcn_fence(__ATOMIC_ACQUIRE, "agent");
            xb_add(&bar[XB_XGEN(b.x)], 1u);
            asm volatile("s_waitcnt vmcnt(0)" ::: "memory");
        } else {
            XB_SPIN(xb_ld(&bar[XB_XGEN(b.x)]) == gen, bar);
            __builtin_amdgcn_fence(__ATOMIC_ACQUIRE, "agent");
            asm volatile("s_waitcnt vmcnt(0)" ::: "memory");
        }
    }
    __syncthreads();
}

struct Args { const float* in[18]; float* out; unsigned char* ws; int ph_lo, ph_hi, use_cg, pad; };
enum { I_X = 0, I_NMIX, I_NFFN, I_SWA_QKV, I_SWA_WO, I_SWA_SINK, I_DIFF_QKV, I_DIFF_WO, I_DIFF_LAM, I_DIFF_SUBLN, I_WG, I_BG, I_WR, I_BR, I_GATE, I_UP, I_DOWN, I_FNORM };
typedef const __attribute__((address_space(4))) Args* CArgs;
__device__ __forceinline__ CArgs kargs() { CArgs p = (CArgs)__builtin_amdgcn_kernarg_segment_ptr(); asm volatile("" : "+s"(p)); return p; }
__device__ __forceinline__ int vcu_of(int G) { const int bx = blockIdx.x; return (G % 8 == 0) ? (bx % 8) * (G / 8) + bx / 8 : bx; }

__device__ __forceinline__ void tr_item(const float* W, int N, int k0, int n0, bf16_t* dst, int ldd, LAS float* scr, int lane) {
#pragma unroll 8
    for (int i = 0; i < 32; ++i) { const int kk = 2 * i + (lane >> 5); scr[kk * 33 + (lane & 31)] = W[(size_t)(k0 + kk) * N + n0 + (lane & 31)]; }
    LDS_WAIT(); asm volatile("" ::: "memory");
    const int c = lane & 7;
#pragma unroll
    for (int j = 0; j < 4; ++j) { const int n = (lane >> 3) + 8 * j; const LAS float* s = scr + (8 * c) * 33 + n;
        u32x4 o; o.x = pk2(s[0 * 33], s[1 * 33]); o.y = pk2(s[2 * 33], s[3 * 33]); o.z = pk2(s[4 * 33], s[5 * 33]); o.w = pk2(s[6 * 33], s[7 * 33]);
        *(GAS u32x4*)(dst + (size_t)n * ldd + k0 + 8 * c) = o; }
    LDS_WAIT(); asm volatile("" ::: "memory");
}
__device__ __forceinline__ void rms_row_to_bf16(const float* xrow, const float* g, bf16_t* orow, int lane) {
    const GAS f32x4* xr = (const GAS f32x4*)xrow + lane; const GAS f32x4* gr = (const GAS f32x4*)g + lane;
    f32x4 v[4]; float s = 0.f;
#pragma unroll
    for (int j = 0; j < 4; ++j) { v[j] = xr[64 * j]; s += (v[j].x * v[j].x + v[j].y * v[j].y) + (v[j].z * v[j].z + v[j].w * v[j].w); }
    const float rstd = 1.f / sqrtf(wave_sum(s) * (1.f / D) + 1e-6f);
    GAS u32x2* o8 = (GAS u32x2*)orow + lane;
#pragma unroll
    for (int j = 0; j < 4; ++j) { const f32x4 gg = gr[64 * j]; u32x2 w; w.x = pk2(v[j].x * rstd * gg.x, v[j].y * rstd * gg.y); w.y = pk2(v[j].z * rstd * gg.z, v[j].w * rstd * gg.w); o8[64 * j] = w; }
}

__device__ __forceinline__ void phase_prologue(LAS unsigned char* lds_in, const int wave_in) {
    int lane = lane_id(); asm volatile("" : "+v"(lane)); int wave = wave_in; asm volatile("" : "+s"(wave)); LAS unsigned char* lds = lds_in; asm volatile("" : "+s"(lds));
    const CArgs a = kargs(); unsigned char* ws = a->ws;
    const int G = gridDim.x, vcu = vcu_of(G);
    LAS float* scr = (LAS float*)(lds + wave * 16384);
    const int gw = vcu * NWAVES + wave, NGW = G * NWAVES;
    bf16_t* swa_qkv_t = (bf16_t*)(ws + WS_SWA_QKV_T); bf16_t* swa_wo_t = (bf16_t*)(ws + WS_SWA_WO_T);
    bf16_t* diff_qkv_t = (bf16_t*)(ws + WS_DIFF_QKV_T); bf16_t* diff_wo_t = (bf16_t*)(ws + WS_DIFF_WO_T);
    constexpr int I0 = 16 * 48, I1 = 16 * 32, I2 = 16 * 96, I3 = 16 * 32, IM = 64 * 768, NITEMS = I0 + I1 + I2 + I3 + IM;
    for (int it = gw; it < NITEMS; it += NGW) {
        int r = it;
        if (r < I0) { const int kb = r / 48, nb = r % 48; tr_item(a->in[I_SWA_QKV], SWA_N, 64 * kb, 32 * nb, swa_qkv_t + (size_t)(32 * nb) * D, D, scr, lane); continue; } r -= I0;
        if (r < I1) { const int kb = r / 32, nb = r % 32; tr_item(a->in[I_SWA_WO], D, 64 * kb, 32 * nb, swa_wo_t + (size_t)(32 * nb) * D, D, scr, lane); continue; } r -= I1;
        if (r < I2) { const int kb = r / 96, nb = r % 96; tr_item(a->in[I_DIFF_QKV], DIFF_N, 64 * kb, 32 * nb, diff_qkv_t + (size_t)(32 * nb) * D, D, scr, lane); continue; } r -= I2;
        if (r < I3) { const int kb = r / 32, nb = r % 32; tr_item(a->in[I_DIFF_WO], D, 64 * kb, 32 * nb, diff_wo_t + (size_t)(32 * nb) * D, D, scr, lane); continue; } r -= I3;
        const int le = r / 768, q = r % 768;
        bf16_t* gu = (bf16_t*)(ws + WS_WMOE + (size_t)le * 3 * MiB); bf16_t* dn = gu + (size_t)D * D;
        if (q < 256) { const int kb = q / 16, c0 = 32 * (q % 16); const int drow = (c0 >> 7) * 256 + (c0 & 127);
            tr_item(a->in[I_GATE] + (size_t)le * D * DEXP, DEXP, 64 * kb, c0, gu + (size_t)drow * D, D, scr, lane); }
        else if (q < 512) { const int qq = q - 256; const int kb = qq / 16, c0 = 32 * (qq % 16); const int drow = (c0 >> 7) * 256 + 128 + (c0 & 127);
            tr_item(a->in[I_UP] + (size_t)le * D * DEXP, DEXP, 64 * kb, c0, gu + (size_t)drow * D, D, scr, lane); }
        else { const int qq = q - 512; const int kb = qq / 32, nb = qq % 32;
            tr_item(a->in[I_DOWN] + (size_t)le * DEXP * D, D, 64 * kb, 32 * nb, dn + (size_t)(32 * nb) * DEXP, DEXP, scr, lane); }
    }
    { float* wr_t = (float*)(ws + WS_WR); const int gt = gw * 64 + lane, NGT = NGW * 64;
      for (int i = gt; i < 2 * 36 * D; i += NGT) { const int l = i / (36 * D), rem = i % (36 * D), c = rem / D, k = rem % D;
          wr_t[i] = c < 4 ? a->in[I_WG][(size_t)l * D * 4 + k * 4 + c] : a->in[I_WR][(size_t)l * D * 32 + k * 32 + (c - 4)]; } }
    bf16_t* XN = (bf16_t*)(ws + WS_XN);
    for (int m = gw; m < M; m += NGW) rms_row_to_bf16(a->in[I_X] + (size_t)m * D, a->in[I_NMIX], XN + (size_t)m * D, lane);
}

__device__ __forceinline__ void phase_router(LAS unsigned char* lds_in, int layer, const int wave_in) {
    int lane = lane_id(); asm volatile("" : "+v"(lane)); int wave = wave_in; asm volatile("" : "+s"(wave)); LAS unsigned char* lds = lds_in; asm volatile("" : "+s"(lds));
    const CArgs a = kargs(); unsigned char* ws = a->ws;
    const int G = gridDim.x, vcu = vcu_of(G);
    const int gw = vcu * NWAVES + wave, NGW = G * NWAVES;
    const float* g = a->in[I_NFFN] + layer * D; const float* wr_t = (const float*)(ws + WS_WR) + (size_t)layer * 36 * D;
    const float* bg = a->in[I_BG] + layer * 4; const float* br = a->in[I_BR] + layer * 32;
    bf16_t* XN = (bf16_t*)(ws + WS_XN); const float* xin = a->out;
    unsigned* cnt = (unsigned*)(ws + WS_CTL) + CW_CNT + layer * 32;
    int* ltok = (int*)(ws + WS_LTOK); float* lw = (float*)(ws + WS_LW); i32x4* tinfo = (i32x4*)(ws + WS_TINFO);
    LAS f32x4* lg4 = (LAS f32x4*)(lds + wave * 256);
    const unsigned loff = (unsigned)lane * 16u;
#pragma unroll 1
    for (int t = gw; t < M; t += NGW) {
        const char* xrow = (const char*)(xin + (size_t)t * D);
        f32x4 v[4]; float s = 0.f;
#pragma unroll
        for (int j = 0; j < 4; ++j) { v[j] = *(const f32x4*)(xrow + loff + j * 1024); s += (v[j].x * v[j].x + v[j].y * v[j].y) + (v[j].z * v[j].z + v[j].w * v[j].w); }
        const float rstd = 1.f / sqrtf(wave_sum(s) * (1.f / D) + 1e-6f);
        char* orow = (char*)(XN + (size_t)t * D);
#pragma unroll
        for (int j = 0; j < 4; ++j) { const f32x4 gg = *(const f32x4*)((const char*)g + loff + j * 1024); v[j] = v[j] * rstd * gg; u32x2 w; w.x = pk2(v[j].x, v[j].y); w.y = pk2(v[j].z, v[j].w);
            *(u32x2*)(orow + (loff >> 1) + j * 512) = w; }
#pragma unroll 1
        for (int cg = 0; cg < 9; ++cg) {
            const char* wb = (const char*)(wr_t + (size_t)cg * 4 * D);
            float sc[4];
#pragma unroll
            for (int c4 = 0; c4 < 4; ++c4) { float sacc = 0.f;
#pragma unroll
                for (int j = 0; j < 4; ++j) { const f32x4 w = *(const f32x4*)(wb + loff + c4 * 4096 + j * 1024); sacc += (v[j].x * w.x + v[j].y * w.y) + (v[j].z * w.z + v[j].w * w.w); }
                sc[c4] = wave_sum(sacc); }
            if (lane == 0) lg4[cg] = (f32x4){sc[0], sc[1], sc[2], sc[3]};
        }
        LDS_WAIT(); asm volatile("" ::: "memory");
        float acc[36];
#pragma unroll
        for (int q = 0; q < 9; ++q) { const f32x4 x = lg4[q]; acc[4 * q] = x.x; acc[4 * q + 1] = x.y; acc[4 * q + 2] = x.z; acc[4 * q + 3] = x.w; }
        LDS_WAIT(); asm volatile("" ::: "memory");
        float lgv[4]; int gs = 0;
#pragma unroll
        for (int c = 0; c < 4; ++c) lgv[c] = acc[c] + bg[c];
        float mx = lgv[0];
#pragma unroll
        for (int c = 1; c < 4; ++c) if (lgv[c] > mx) { mx = lgv[c]; gs = c; }
        float den = 0.f;
#pragma unroll
        for (int c = 0; c < 4; ++c) den += __expf(lgv[c] - mx);
        const float pg = 1.f / den;
        float le[8];
#pragma unroll
        for (int k = 0; k < 8; ++k) { const float a0 = acc[4 + k] + br[k], a1 = acc[12 + k] + br[8 + k], a2 = acc[20 + k] + br[16 + k], a3 = acc[28 + k] + br[24 + k];
            le[k] = gs == 0 ? a0 : (gs == 1 ? a1 : (gs == 2 ? a2 : a3)); }
        int i1 = 0; float m1 = le[0];
#pragma unroll
        for (int k = 1; k < 8; ++k) if (le[k] > m1) { m1 = le[k]; i1 = k; }
        int i2 = -1; float m2 = -INFINITY;
#pragma unroll
        for (int k = 0; k < 8; ++k) if (k != i1 && (i2 < 0 || le[k] > m2)) { m2 = le[k]; i2 = k; }
        const float ex = __expf(m2 - m1); const float tp1 = 1.f / (1.f + ex), tp2 = ex * tp1;
        const float w1 = pg * tp1, w2 = pg * tp2; const int e1 = gs * 8 + i1, e2 = gs * 8 + i2;
        if (lane == 0) {
            const int p1 = (int)atomicAdd(&cnt[e1], 1u), p2 = (int)atomicAdd(&cnt[e2], 1u);
            ltok[(size_t)e1 * M + p1] = t; lw[(size_t)e1 * M + p1] = w1; ltok[(size_t)e2 * M + p2] = t; lw[(size_t)e2 * M + p2] = w2;
            tinfo[t] = (i32x4){e1, p1, e2, p2};
        }
    }
}

__device__ __forceinline__ void moe_tables(LAS unsigned char* lds, unsigned char* ws, int layer, const int wave, const int lane) {
    LAS int* TP = (LAS int*)(lds + TP_OFF); LAS int* CNT = TP + 40;
    unsigned* cnt = (unsigned*)(ws + WS_CTL) + CW_CNT + layer * 32;
    const int tid = wave * 64 + lane;
    __syncthreads();
    if (tid < 32) CNT[tid] = (int)__hip_atomic_load(cnt + tid, RLX_AGENT);
    __syncthreads();
    if (tid == 0) { int s = 0; for (int e = 0; e < 32; ++e) { TP[e] = s; s += (CNT[e] + 255) >> 8; } TP[32] = s; }
    __syncthreads();
}

__device__ __forceinline__ void phase_combine(LAS unsigned char* lds_in, int layer, const int wave_in) {
    int lane = lane_id(); asm volatile("" : "+v"(lane)); int wave = wave_in; asm volatile("" : "+s"(wave)); LAS unsigned char* lds = lds_in; asm volatile("" : "+s"(lds));
    const CArgs a = kargs(); unsigned char* ws = a->ws;
    moe_tables(lds, ws, layer, wave, lane);
    const bool final_ = layer == 1; const float* gnext = layer == 0 ? a->in[I_NMIX] + D : a->in[I_FNORM]; float* xio = a->out;
    const int G = gridDim.x, vcu = vcu_of(G);
    const int gw = vcu * NWAVES + wave, NGW = G * NWAVES;
    const LAS int* TP = (const LAS int*)(lds + TP_OFF);
    const bf16_t* Y = (const bf16_t*)(ws + WS_Y); const i32x4* tinfo = (const i32x4*)(ws + WS_TINFO); bf16_t* XN = (bf16_t*)(ws + WS_XN);
    for (int t = gw; t < M; t += NGW) {
        const i32x4 ti = tinfo[t];
        const size_t s1 = (size_t)TP[ti.x] * 256 + ti.y, s2 = (size_t)TP[ti.z] * 256 + ti.w;
        GAS f32x4* xr = (GAS f32x4*)(xio + (size_t)t * D) + lane; const GAS f32x4* gr = (const GAS f32x4*)gnext + lane;
        const GAS u32x2* y1 = (const GAS u32x2*)(Y + s1 * D) + lane; const GAS u32x2* y2 = (const GAS u32x2*)(Y + s2 * D) + lane;
        f32x4 v[4]; float s = 0.f;
#pragma unroll
        for (int j = 0; j < 4; ++j) { const f32x4 x = xr[64 * j]; const u32x2 p = y1[64 * j], q = y2[64 * j];
            f32x4 ya, yb; ya.x = __uint_as_float(p.x << 16); ya.y = __uint_as_float(p.x & 0xffff0000u); ya.z = __uint_as_float(p.y << 16); ya.w = __uint_as_float(p.y & 0xffff0000u);
            yb.x = __uint_as_float(q.x << 16); yb.y = __uint_as_float(q.x & 0xffff0000u); yb.z = __uint_as_float(q.y << 16); yb.w = __uint_as_float(q.y & 0xffff0000u);
            v[j] = x + (ya + yb); s += (v[j].x * v[j].x + v[j].y * v[j].y) + (v[j].z * v[j].z + v[j].w * v[j].w); }
        const float rstd = 1.f / sqrtf(wave_sum(s) * (1.f / D) + 1e-6f);
        if (final_) {
#pragma unroll
            for (int j = 0; j < 4; ++j) xr[64 * j] = v[j] * rstd * gr[64 * j];
        } else {
            GAS u32x2* o8 = (GAS u32x2*)(XN + (size_t)t * D) + lane;
#pragma unroll
            for (int j = 0; j < 4; ++j) { xr[64 * j] = v[j]; const f32x4 n = v[j] * rstd * gr[64 * j]; u32x2 w; w.x = pk2(n.x, n.y); w.y = pk2(n.z, n.w); o8[64 * j] = w; }
        }
    }
}

__device__ __forceinline__ float diff_lambda_full(const float* lam, int lane) {
    const float a = wave_sum(lam[lane] * lam[64 + lane]), b = wave_sum(lam[128 + lane] * lam[192 + lane]);
    return __expf(a) - __expf(b) + LAMBDA_INIT;
}

__device__ __forceinline__ void phase_qkv(LAS unsigned char* lds_in, int layer, const int wave_in) {
    int lane = lane_id(); asm volatile("" : "+v"(lane)); int wave = wave_in; asm volatile("" : "+s"(wave)); LAS unsigned char* lds = lds_in; asm volatile("" : "+s"(lds));
    const CArgs a = kargs(); unsigned char* ws = a->ws;
    const int N = layer == 0 ? SWA_N : DIFF_N;
    pg8::Gemm g{(const bf16_t*)(ws + WS_XN), (const bf16_t*)(ws + (layer == 0 ? WS_SWA_QKV_T : WS_DIFF_QKV_T)), D};
    pg8::DenseOrder S; S.init(M, N, (int)gridDim.x, (int)blockIdx.x);
    pg8::EpiQKV E{(bf16_t*)(ws + WS_QKV), N, 1024, QSCALE};
    pg8::gemm_phase<pg8::EpiQKV, pg8::DenseOrder, false, true>(lds, g, S, E, wave, lane);
}
__device__ __forceinline__ void phase_oproj(LAS unsigned char* lds_in, int layer, const int wave_in) {
    int lane = lane_id(); asm volatile("" : "+v"(lane)); int wave = wave_in; asm volatile("" : "+s"(wave)); LAS unsigned char* lds = lds_in; asm volatile("" : "+s"(lds));
    const CArgs a = kargs(); unsigned char* ws = a->ws;
    pg8::Gemm g{(const bf16_t*)(ws + WS_O), (const bf16_t*)(ws + (layer == 0 ? WS_SWA_WO_T : WS_DIFF_WO_T)), D};
    pg8::DenseOrder S; S.init(M, D, (int)gridDim.x, (int)blockIdx.x);
    pg8::EpiResid E{layer == 0 ? a->in[I_X] : (const float*)a->out, a->out};
    pg8::gemm_phase<pg8::EpiResid, pg8::DenseOrder, false, true>(lds, g, S, E, wave, lane);
}
__device__ __forceinline__ void phase_moe1(LAS unsigned char* lds_in, int layer, const int wave_in) {
    int lane = lane_id(); asm volatile("" : "+v"(lane)); int wave = wave_in; asm volatile("" : "+s"(wave)); LAS unsigned char* lds = lds_in; asm volatile("" : "+s"(lds));
    const CArgs a = kargs(); unsigned char* ws = a->ws;
    moe_tables(lds, ws, layer, wave, lane);
    const LAS int* TP = (const LAS int*)(lds + TP_OFF); const LAS int* CNT = TP + 40;
    pg8::Gemm g{(const bf16_t*)(ws + WS_XN), (const bf16_t*)(ws + WS_WMOE + (size_t)layer * 96 * MiB), D};
    pg8::MoeOrder S{TP, CNT, (const int*)(ws + WS_LTOK), (int)gridDim.x, (int)blockIdx.x, 6, 0};
    pg8::EpiSwiGLU E{(bf16_t*)(ws + WS_H)};
    pg8::gemm_phase<pg8::EpiSwiGLU, pg8::MoeOrder, true, true>(lds, g, S, E, wave, lane);
}
__device__ __forceinline__ void phase_moe2(LAS unsigned char* lds_in, int layer, const int wave_in) {
    int lane = lane_id(); asm volatile("" : "+v"(lane)); int wave = wave_in; asm volatile("" : "+s"(wave)); LAS unsigned char* lds = lds_in; asm volatile("" : "+s"(lds));
    const CArgs a = kargs(); unsigned char* ws = a->ws;
    moe_tables(lds, ws, layer, wave, lane);
    const LAS int* TP = (const LAS int*)(lds + TP_OFF); const LAS int* CNT = TP + 40;
    pg8::Gemm g{(const bf16_t*)(ws + WS_H), (const bf16_t*)(ws + WS_WMOE + (size_t)layer * 96 * MiB), DEXP};
    pg8::MoeOrder S{TP, CNT, (const int*)(ws + WS_LTOK), (int)gridDim.x, (int)blockIdx.x, 12, 8};
    pg8::EpiDown E{(bf16_t*)(ws + WS_Y), (const float*)(ws + WS_LW)};
    pg8::gemm_phase<pg8::EpiDown, pg8::MoeOrder, false, true>(lds, g, S, E, wave, lane);
}
__device__ __forceinline__ void phase_attn(LAS unsigned char* lds_in, int layer, const int wave_in) {
    int lane = lane_id(); asm volatile("" : "+v"(lane)); int wave = wave_in; asm volatile("" : "+s"(wave)); LAS unsigned char* lds = lds_in; asm volatile("" : "+s"(lds));
    const CArgs a = kargs(); unsigned char* ws = a->ws;
    const int G = gridDim.x, vcu = vcu_of(G);
    const bf16_t* QKV = (const bf16_t*)(ws + WS_QKV); bf16_t* OB = (bf16_t*)(ws + WS_O);
    if (layer == 0) {
        att::DiffConsts dc{0.f, nullptr}; const float* sink = a->in[I_SWA_SINK];
#pragma unroll 1
        for (int i = 0; i < 2048; ++i) { const int id = vcu + G * i; if (id >= 2048) break; const int bk = id >> 7, qb = id & 127;
            att::attn_unit<0>(bk >> 2, bk & 3, qb, QKV, OB, sink, dc, lds, wave, lane); }
    } else {
        att::DiffConsts dc{diff_lambda_full(a->in[I_DIFF_LAM], lane), a->in[I_DIFF_SUBLN]};
#pragma unroll 1
        for (int i = 0; i < 2048; ++i) { const int id = vcu + G * i; if (id >= 2048) break; const int bh = id >> 6, qb = id & 63;
            att::attn_unit<1>(bh >> 3, bh & 7, qb, QKV, OB, nullptr, dc, lds, wave, lane); }
    }
}

__global__ void __launch_bounds__(NWAVES * 64, 2) mega_fwd(Args args_by_value) {
    extern __shared__ __attribute__((aligned(16))) unsigned char lds_raw[];
    LAS unsigned char* lds = (LAS unsigned char*)lds_raw;
    const int wave = __builtin_amdgcn_readfirstlane((int)(threadIdx.x >> 6));
    int lo, hi;
    { const CArgs a = kargs(); lo = a->ph_lo; hi = a->ph_hi;
      if (a->use_cg) cg::this_grid().sync(); }
    { const int tid = wave * 64 + lane_id();
      for (int u = tid; u < (LDS_BYTES - LDSCTL_OFF) / 4; u += NWAVES * 64) ((LAS unsigned*)(lds + LDSCTL_OFF))[u] = 0u; }
    __syncthreads();
    if (N_LAUNCHES == 1) { const CArgs a = kargs(); (void)xcd_barrier_post((unsigned*)(a->ws + WS_CTL) + CW_BAR, (volatile LAS unsigned*)(lds + MISC_OFF) + 8, wave == 0 && lane_id() == 0); }
#pragma unroll 1
    for (int ph = lo; ph < hi; ++ph) {
        const int layer = ph >= 8 ? 1 : 0, kind = ph == 0 ? 0 : ph - 7 * layer;
        switch (kind) {
            case 0: phase_prologue(lds, wave); break;
            case 1: phase_qkv(lds, layer, wave); break;
            case 2: phase_attn(lds, layer, wave); break;
            case 3: phase_oproj(lds, layer, wave); break;
            case 4: phase_router(lds, layer, wave); break;
            case 5: phase_moe1(lds, layer, wave); break;
            case 6: phase_moe2(lds, layer, wave); break;
            default: phase_combine(lds, layer, wave); break;
        }
        if (ph + 1 < hi) { const CArgs a = kargs(); XcdBarrier bar; bar.bar = (unsigned*)(a->ws + WS_CTL) + CW_BAR; bar.x = xb_xcc_id(); bar.st = (volatile LAS unsigned*)(lds + MISC_OFF) + 8;
            xcd_barrier(bar, wave == 0 && lane_id() == 0); }
    }
}

extern "C" void kernel_launch(void* const* d_in, const int* in_sizes, int n_in, void* d_out, int out_size, void* d_ws, size_t ws_size, hipStream_t stream) {
    static int grid = 0;
    if (grid == 0) {
        if (n_in != 18 || in_sizes[0] != M * D || out_size != M * D || ws_size < WS_END) {
            fprintf(stderr, "kernel_launch: unexpected shapes: n_in %d in0 %d out %d ws %zu (need %zu)\n", n_in, n_in > 0 ? in_sizes[0] : -1, out_size, ws_size, (size_t)WS_END); grid = -1; return; }
        int dev = 0, cus = 0, per_cu = 0;
        if (hipGetDevice(&dev) != hipSuccess || hipDeviceGetAttribute(&cus, hipDeviceAttributeMultiprocessorCount, dev) != hipSuccess) { fprintf(stderr, "kernel_launch: device query failed\n"); grid = -1; return; }
        if (hipFuncSetAttribute((const void*)mega_fwd, hipFuncAttributeMaxDynamicSharedMemorySize, LDS_BYTES) != hipSuccess) { fprintf(stderr, "kernel_launch: hipFuncSetAttribute failed\n"); grid = -1; return; }
        if (hipOccupancyMaxActiveBlocksPerMultiprocessor(&per_cu, (const void*)mega_fwd, NWAVES * 64, LDS_BYTES) != hipSuccess || per_cu < 1) { fprintf(stderr, "kernel_launch: occupancy query says %d\n", per_cu); per_cu = 1; }
        (void)hipGetLastError();
        grid = cus;
    }
    if (grid < 0) return;
    (void)hipMemsetAsync((char*)d_ws + WS_CTL, 0, CTL_ZERO_BYTES, stream);
    Args a{};
    for (int i = 0; i < 18; ++i) a.in[i] = (const float*)d_in[i];
    a.out = (float*)d_out; a.ws = (unsigned char*)d_ws; a.use_cg = 0; a.pad = 0;
    if (N_LAUNCHES == 1) {
        a.ph_lo = 0; a.ph_hi = N_PHASES;
        void* kargs_[] = {&a};
        hipError_t e = hipLaunchCooperativeKernel((const void*)mega_fwd, dim3(grid), dim3(NWAVES * 64), kargs_, LDS_BYTES, stream);
        if (e != hipSuccess) fprintf(stderr, "kernel_launch: cooperative launch failed: %s (grid %d)\n", hipGetErrorString(e), grid);
    } else {
        for (int p = 0; p < N_PHASES; ++p) { a.ph_lo = p; a.ph_hi = p + 1; hipLaunchKernelGGL(mega_fwd, dim3(grid), dim3(NWAVES * 64), LDS_BYTES, stream, a); }
    }
}
```

```cpp
#include <hip/hip_runtime.h>
#include <hip/hip_cooperative_groups.h>
#include <cstdio>
#include <cstdint>
namespace cg = cooperative_groups;

#ifndef MK_N_LAUNCHES
#define MK_N_LAUNCHES 1
#endif
constexpr int N_PHASES = 15;
constexpr int N_LAUNCHES = MK_N_LAUNCHES;

#define LAS __attribute__((address_space(3)))
#define GAS __attribute__((address_space(1)))
typedef unsigned short bf16_t;
typedef short bf16x8 __attribute__((ext_vector_type(8)));
typedef short s16x4 __attribute__((ext_vector_type(4)));
typedef float f32x2 __attribute__((ext_vector_type(2)));
typedef float f32x4 __attribute__((ext_vector_type(4)));
typedef float f32x16 __attribute__((ext_vector_type(16)));
typedef unsigned u32x2 __attribute__((ext_vector_type(2)));
typedef unsigned u32x4 __attribute__((ext_vector_type(4)));
typedef int i32x4 __attribute__((ext_vector_type(4)));
typedef __bf16 bf16x2_t __attribute__((ext_vector_type(2)));

constexpr int D = 1024, BATCH = 4, SEQ = 8192, M = BATCH * SEQ;
constexpr int SWA_N = 1536, DIFF_N = 3072;
constexpr int NEXP = 32, DEXP = 512;
constexpr float LOG2E = 1.4426950408889634f;
constexpr float QSCALE = 0.125f * LOG2E;
constexpr float LAMBDA_INIT = 0.35550906759f;
constexpr int NWAVES = 8;

constexpr size_t MiB = 1u << 20;
constexpr size_t WS_CTL = 0, CTL_ZERO_BYTES = 1 * MiB;
constexpr size_t WS_SWA_QKV_T = 1 * MiB, WS_SWA_WO_T = 4 * MiB, WS_DIFF_QKV_T = 6 * MiB, WS_DIFF_WO_T = 12 * MiB;
constexpr size_t WS_WR = 14 * MiB;
constexpr size_t WS_LTOK = 15 * MiB, WS_LW = 19 * MiB, WS_TINFO = 23 * MiB;
constexpr size_t WS_WMOE = 24 * MiB;
constexpr size_t WS_XN = 216 * MiB;
constexpr size_t WS_SCR = 280 * MiB;
constexpr size_t WS_QKV = WS_SCR, WS_O = WS_SCR + 192 * MiB, WS_Y = WS_SCR, WS_H = WS_SCR + 144 * MiB;
constexpr size_t WS_END = 536 * MiB;
constexpr int CW_BAR = 4096;
constexpr int CW_CNT = 16384;

constexpr int RING_BYTES = 131072;
constexpr int LDSCTL_OFF = RING_BYTES;
constexpr int MISC_OFF = LDSCTL_OFF + 320;
constexpr int TP_OFF = LDSCTL_OFF + 1024;
constexpr int LDS_BYTES = 147456;

__device__ __forceinline__ unsigned f2bf(float f) { unsigned u = __builtin_bit_cast(unsigned, f); return (u + 0x7fffu + ((u >> 16) & 1u)) >> 16; }
__device__ __forceinline__ unsigned pk2(float lo, float hi) { return f2bf(lo) | (f2bf(hi) << 16); }
__device__ __forceinline__ unsigned cvtpk(float lo, float hi) { f32x2 v = {lo, hi}; bf16x2_t b = __builtin_convertvector(v, bf16x2_t); return __builtin_bit_cast(unsigned, b); }
__device__ __forceinline__ float bf2f(unsigned short h) { return __builtin_bit_cast(float, (unsigned)h << 16); }
__device__ __forceinline__ int lane_id() { return (int)__builtin_amdgcn_mbcnt_hi(~0u, __builtin_amdgcn_mbcnt_lo(~0u, 0u)); }
__device__ __forceinline__ float wave_sum(float v) {
#pragma unroll
    for (int o = 1; o < 64; o <<= 1) v += __shfl_xor(v, o);
    return v;
}

namespace pg8 {
constexpr int BM = 256, BK = 64, HALF = 128, HTB = HALF * BK * 2, STAGE_BYTES = 8 * HTB, NXCD = 8, WGM = 8;
__host__ __device__ __forceinline__ int lds_byte(int r, int c) { const int st = (r >> 4) * 2 + (c >> 5), rr = r & 15, cc = c & 31, ob = rr * 64 + cc * 2; return st * 1024 + (ob ^ (((ob >> 9) & 1) << 5)); }
__host__ __device__ __forceinline__ void stage_rc(int b, int& R, int& C) { const int st = b / 1024, sb = b % 1024, swz = sb ^ (((sb >> 9) & 1) << 5); R = (st >> 1) * 16 + swz / 64; C = (st & 1) * 32 + (swz % 64) / 2; }
__host__ __device__ __forceinline__ int perm32(int rho) { const int n = rho >> 4, i = rho & 15; return 8 * (i >> 2) + 4 * n + (i & 3); }

struct Unit { int pm, pn, e, t, pnl; };
struct Gemm { const bf16_t* A; const bf16_t* Bt; int K; };

struct DenseOrder {
    int nM, nN, nwg, G, c;
    __device__ void init(int Mr, int N, int G_, int c_) { nM = Mr / BM; nN = N / BM; nwg = nM * nN; G = G_; c = c_; }
    __device__ bool next(int i, Unit& u) const {
        const long L = (long)i * G + c; if (L >= nwg) return false;
        int wgid = (int)L; { const int q = nwg / NXCD, r = nwg % NXCD, xcd = wgid % NXCD, off = wgid / NXCD; wgid = (xcd < r ? xcd * (q + 1) : r * (q + 1) + (xcd - r) * q) + off; }
        const int nig = WGM * nN, gid = wgid / nig, fm = gid * WGM, gsz = (nM - fm) < WGM ? (nM - fm) : WGM;
        u.pm = fm + ((wgid % nig) % gsz); u.pn = (wgid % nig) / gsz; u.e = 0; u.t = 0; u.pnl = u.pn; return true;
    }
    __device__ __forceinline__ int token(const Unit&, int) const { return 0; }
};
struct MoeOrder {
    const LAS int* TP; const LAS int* CNT; const int* ltok; int G, c, pn_mul, pn_add;
    __device__ bool next(int i, Unit& u) const {
        const int ntile = __builtin_amdgcn_readfirstlane(TP[32]); const int nwg = ntile * 4;
        const long L = (long)i * G + c; if (L >= nwg) return false;
        int wgid = (int)L; { const int q = nwg / NXCD, r = nwg % NXCD, xcd = wgid % NXCD, off = wgid / NXCD; wgid = (xcd < r ? xcd * (q + 1) : r * (q + 1) + (xcd - r) * q) + off; }
        const int tau = wgid >> 2; int e = 0;
        while (e < 31 && __builtin_amdgcn_readfirstlane(TP[e + 1]) <= tau) ++e;
        u.pm = tau; u.e = e; u.t = tau - __builtin_amdgcn_readfirstlane(TP[e]); u.pnl = wgid & 3; u.pn = e * pn_mul + pn_add + u.pnl; return true;
    }
    __device__ __forceinline__ int token(const Unit& u, int r) const { const int idx = u.t * 256 + r; return idx < CNT[u.e] ? ltok[(size_t)u.e * M + idx] : 0; }
};

struct EpiQKV {
    static constexpr bool PERM = true;
    bf16_t* O; int ldc; int qcols; float qscale;
    __device__ __forceinline__ void operator()(const f32x4 (&acc)[2][2][4][2], const Unit& u, int wr, int wc, int fr, int fq) const {
        const int row0 = u.pm * BM + wr * 64 + fr, colt = u.pn * BM; const float sc = colt < qcols ? qscale : 1.f;
        const int col0 = colt + wc * 32 + 8 * fq;
#pragma unroll
        for (int ai = 0; ai < 2; ++ai)
#pragma unroll
            for (int m = 0; m < 4; ++m) { bf16_t* rowp = O + (size_t)(row0 + ai * HALF + m * 16) * ldc + col0;
#pragma unroll
                for (int bj = 0; bj < 2; ++bj) { const f32x4 v0 = acc[ai][bj][m][0] * sc, v1 = acc[ai][bj][m][1] * sc;
                    u32x4 w; w.x = cvtpk(v0[0], v0[1]); w.y = cvtpk(v0[2], v0[3]); w.z = cvtpk(v1[0], v1[1]); w.w = cvtpk(v1[2], v1[3]);
                    *(u32x4*)(rowp + bj * HALF) = w; } }
    }
};
struct EpiResid {
    static constexpr bool PERM = false;
    const float* base; float* out;
    __device__ __forceinline__ void operator()(const f32x4 (&acc)[2][2][4][2], const Unit& u, int wr, int wc, int fr, int fq) const {
        const int col0 = u.pn * BM + wc * 32 + 4 * fq;
#pragma unroll
        for (int ai = 0; ai < 2; ++ai)
#pragma unroll
            for (int m = 0; m < 4; ++m) { const size_t off = (size_t)(u.pm * BM + ai * HALF + wr * 64 + m * 16 + fr) * D + col0;
#pragma unroll
                for (int bj = 0; bj < 2; ++bj)
#pragma unroll
                    for (int n = 0; n < 2; ++n) { const size_t idx = off + bj * HALF + n * 16; const f32x4 b = *(const f32x4*)(base + idx); *(f32x4*)(out + idx) = b + acc[ai][bj][m][n]; } }
    }
};
__device__ __forceinline__ float silu_mul(float g, float u) { return g * u * __builtin_amdgcn_rcpf(1.f + __builtin_amdgcn_exp2f(-g * LOG2E)); }
struct EpiSwiGLU {
    static constexpr bool PERM = true;
    bf16_t* H;
    __device__ __forceinline__ void operator()(const f32x4 (&acc)[2][2][4][2], const Unit& u, int wr, int wc, int fr, int fq) const {
        const int colh = u.pnl * 128 + wc * 32 + 8 * fq;
#pragma unroll
        for (int ai = 0; ai < 2; ++ai)
#pragma unroll
            for (int m = 0; m < 4; ++m) { const size_t row = (size_t)u.pm * BM + ai * HALF + wr * 64 + m * 16 + fr;
                const f32x4 g0 = acc[ai][0][m][0], g1 = acc[ai][0][m][1], u0 = acc[ai][1][m][0], u1 = acc[ai][1][m][1];
                u32x4 w; w.x = cvtpk(silu_mul(g0[0], u0[0]), silu_mul(g0[1], u0[1])); w.y = cvtpk(silu_mul(g0[2], u0[2]), silu_mul(g0[3], u0[3]));
                w.z = cvtpk(silu_mul(g1[0], u1[0]), silu_mul(g1[1], u1[1])); w.w = cvtpk(silu_mul(g1[2], u1[2]), silu_mul(g1[3], u1[3]));
                *(u32x4*)(H + row * DEXP + colh) = w; }
    }
};
struct EpiDown {
    static constexpr bool PERM = true;
    bf16_t* Y; const float* lw;
    __device__ __forceinline__ void operator()(const f32x4 (&acc)[2][2][4][2], const Unit& u, int wr, int wc, int fr, int fq) const {
        const int col0 = u.pnl * BM + wc * 32 + 8 * fq;
#pragma unroll
        for (int ai = 0; ai < 2; ++ai)
#pragma unroll
            for (int m = 0; m < 4; ++m) { const int rl = ai * HALF + wr * 64 + m * 16 + fr; const size_t row = (size_t)u.pm * BM + rl;
                const float sc = lw[(size_t)u.e * M + u.t * 256 + rl];
#pragma unroll
                for (int bj = 0; bj < 2; ++bj) { const f32x4 v0 = acc[ai][bj][m][0] * sc, v1 = acc[ai][bj][m][1] * sc;
                    u32x4 w; w.x = cvtpk(v0[0], v0[1]); w.y = cvtpk(v0[2], v0[3]); w.z = cvtpk(v1[0], v1[1]); w.w = cvtpk(v1[2], v1[3]);
                    *(u32x4*)(Y + row * D + col0 + bj * HALF) = w; } }
    }
};

template <class Epi, class Sched, bool GATHER, bool ALIGN_EPI>
__device__ __forceinline__ void gemm_phase(LAS unsigned char* lds, const Gemm g, const Sched& S, const Epi& E, const int wid, const int lane) {
    const int tid = wid * 64 + lane, wr = wid >> 2, wc = wid & 3, fr = lane & 15, fq = lane >> 4;
    const int K = g.K, nt = K / BK;
    int Rr[2], Cc[2]; unsigned voffB[2];
#pragma unroll
    for (int i = 0; i < 2; ++i) { int R, C; stage_rc(tid * 16 + i * 8192, R, C); Rr[i] = R; Cc[i] = C; const int Rb = Epi::PERM ? ((R & ~31) + perm32(R & 31)) : R; voffB[i] = (unsigned)(Rb * K + C) * 2u; }
    const size_t kstep = (size_t)(BK * 2);
    const size_t hstep = (size_t)HALF * K * 2;
    const size_t tstep = 2 * hstep;
    const unsigned ldsw = (unsigned)wid * 1024u;
    const int aoff = lds_byte(wr * 64 + fr, fq * 8), boff = lds_byte(wc * 32 + fr, fq * 8);
#define PG8_SA(b, h) (((b) * 2 + (h)) * HTB)
#define PG8_SB(b, h) ((4 + (b) * 2 + (h)) * HTB)
#define PG8_STAGE2(bufoff, gbase, o0, o1) do { \
        __builtin_amdgcn_global_load_lds((const unsigned*)((const char*)(gbase) + (o0)), (LAS unsigned*)(lds + (bufoff) + ldsw), 16, 0, 0); \
        __builtin_amdgcn_global_load_lds((const unsigned*)((const char*)(gbase) + (o1)), (LAS unsigned*)(lds + (bufoff) + ldsw + 8192), 16, 0, 0); } while (0)
#define PG8_STAGEB(bufoff, gbase) PG8_STAGE2(bufoff, gbase, voffB[0], voffB[1])
#define PG8_LDA(dst, b, h) do { _Pragma("unroll") for (int m = 0; m < 4; ++m) _Pragma("unroll") for (int k = 0; k < 2; ++k) dst[m][k] = *(const LAS bf16x8*)(lds + PG8_SA(b, h) + aoff + m * 2048 + k * 1024); } while (0)
#define PG8_LDB(dst, b, h) do { _Pragma("unroll") for (int n = 0; n < 2; ++n) _Pragma("unroll") for (int k = 0; k < 2; ++k) dst[n][k] = *(const LAS bf16x8*)(lds + PG8_SB(b, h) + boff + n * 2048 + k * 1024); } while (0)
#define PG8_MMA(ai, bj, At, Bt) do { __builtin_amdgcn_s_setprio(1); _Pragma("unroll") for (int m = 0; m < 4; ++m) _Pragma("unroll") for (int n = 0; n < 2; ++n) _Pragma("unroll") for (int k = 0; k < 2; ++k) \
        acc[ai][bj][m][n] = __builtin_amdgcn_mfma_f32_16x16x32_bf16(Bt[n][k], At[m][k], acc[ai][bj][m][n], 0, 0, 0); __builtin_amdgcn_s_setprio(0); } while (0)
#define PG8_WAIT_V(n) asm volatile("s_waitcnt vmcnt(" #n ")" ::: "memory")
#define PG8_WAIT_L(n) asm volatile("s_waitcnt lgkmcnt(" #n ")" ::: "memory")
#define PG8_BAR __builtin_amdgcn_s_barrier()
#define PG8_SCHED __builtin_amdgcn_sched_barrier(0)
    Unit cur, nxt; int ui = 0;
    if (!S.next(0, cur)) return;
    unsigned oc00, oc01, oc10, oc11, on00, on01, on10, on11;
    if constexpr (GATHER) {
        oc00 = (unsigned)(S.token(cur, Rr[0]) * K + Cc[0]) * 2u; oc01 = (unsigned)(S.token(cur, Rr[1]) * K + Cc[1]) * 2u;
        oc10 = (unsigned)(S.token(cur, 128 + Rr[0]) * K + Cc[0]) * 2u; oc11 = (unsigned)(S.token(cur, 128 + Rr[1]) * K + Cc[1]) * 2u;
    } else {
        oc00 = (unsigned)(Rr[0] * K + Cc[0]) * 2u; oc01 = (unsigned)(Rr[1] * K + Cc[1]) * 2u; oc10 = oc00 + (unsigned)hstep; oc11 = oc01 + (unsigned)hstep;
    }
    on00 = oc00; on01 = oc01; on10 = oc10; on11 = oc11;
    f32x4 acc[2][2][4][2];
#pragma unroll
    for (int a = 0; a < 2; ++a)
#pragma unroll
        for (int b = 0; b < 2; ++b)
#pragma unroll
            for (int m = 0; m < 4; ++m)
#pragma unroll
                for (int n = 0; n < 2; ++n) acc[a][b][m][n] = (f32x4){0.f, 0.f, 0.f, 0.f};
    bf16x8 At[4][2], B0[2][2], B1[2][2];
    const char* cA = GATHER ? (const char*)g.A : (const char*)g.A + (size_t)cur.pm * tstep; const char* cB = (const char*)g.Bt + (size_t)cur.pn * tstep;
    PG8_STAGEB(PG8_SB(0, 0), cB); PG8_STAGEB(PG8_SB(0, 1), cB + hstep); PG8_STAGE2(PG8_SA(0, 0), cA, oc00, oc01); PG8_STAGE2(PG8_SA(0, 1), cA, oc10, oc11);
    if (wr == 1) PG8_BAR;
    PG8_WAIT_V(2); PG8_BAR;
    PG8_STAGEB(PG8_SB(1, 0), cB + kstep); PG8_STAGE2(PG8_SA(1, 0), cA + kstep, oc00, oc01); PG8_STAGEB(PG8_SB(1, 1), cB + hstep + kstep);
    PG8_WAIT_V(6); PG8_BAR;
    for (;;) {
        const bool has_next = S.next(ui + 1, nxt);
        const char* nA = has_next ? (GATHER ? (const char*)g.A : (const char*)g.A + (size_t)nxt.pm * tstep) : cA; const char* nB = has_next ? (const char*)g.Bt + (size_t)nxt.pn * tstep : cB;
        if constexpr (GATHER) {
            if (has_next) {
                on00 = (unsigned)(S.token(nxt, Rr[0]) * K + Cc[0]) * 2u; on01 = (unsigned)(S.token(nxt, Rr[1]) * K + Cc[1]) * 2u;
                on10 = (unsigned)(S.token(nxt, 128 + Rr[0]) * K + Cc[0]) * 2u; on11 = (unsigned)(S.token(nxt, 128 + Rr[1]) * K + Cc[1]) * 2u;
            } else { on00 = oc00; on01 = oc01; on10 = oc10; on11 = oc11; }
        }
        for (int t = 0; t < nt; t += 2) {
            const bool last = (t == nt - 2);
            const char* a1 = cA + (size_t)(t + 1) * kstep;
            const char* a2 = last ? nA : cA + (size_t)(t + 2) * kstep; const char* b2 = last ? nB : cB + (size_t)(t + 2) * kstep;
            const char* a3 = a2 + kstep; const char* b3 = b2 + kstep;
            const unsigned x00 = (GATHER && last) ? on00 : oc00, x01 = (GATHER && last) ? on01 : oc01, x10 = (GATHER && last) ? on10 : oc10, x11 = (GATHER && last) ? on11 : oc11;
            PG8_LDB(B0, 0, 0); PG8_LDB(B1, 0, 1); PG8_SCHED; PG8_LDA(At, 0, 0); PG8_STAGE2(PG8_SA(1, 1), a1, oc10, oc11);
            PG8_WAIT_V(8); PG8_WAIT_L(0); PG8_BAR; PG8_MMA(0, 0, At, B0); PG8_MMA(0, 1, At, B1); PG8_BAR; PG8_SCHED;
            PG8_LDA(At, 0, 1); PG8_STAGEB(PG8_SB(0, 0), b2); PG8_STAGEB(PG8_SB(0, 1), b2 + hstep); PG8_STAGE2(PG8_SA(0, 0), a2, x00, x01);
            PG8_WAIT_V(8); PG8_WAIT_L(0); PG8_BAR; PG8_MMA(1, 0, At, B0); PG8_MMA(1, 1, At, B1); PG8_BAR; PG8_SCHED;
            PG8_LDB(B0, 1, 0); PG8_LDB(B1, 1, 1); PG8_SCHED; PG8_LDA(At, 1, 0); PG8_STAGE2(PG8_SA(0, 1), a2, x10, x11);
            PG8_WAIT_V(8); PG8_WAIT_L(0); PG8_BAR; PG8_MMA(0, 0, At, B0); PG8_MMA(0, 1, At, B1); PG8_BAR; PG8_SCHED;
            PG8_LDA(At, 1, 1); PG8_STAGEB(PG8_SB(1, 0), b3); PG8_STAGEB(PG8_SB(1, 1), b3 + hstep); PG8_STAGE2(PG8_SA(1, 0), a3, x00, x01);
            PG8_WAIT_V(8); PG8_WAIT_L(0); PG8_BAR; PG8_MMA(1, 0, At, B0); PG8_MMA(1, 1, At, B1); PG8_BAR; PG8_SCHED;
        }
        if constexpr (ALIGN_EPI) { if (wr == 0) PG8_BAR; }
        E(acc, cur, wr, wc, fr, fq);
        if (!has_next) break;
#pragma unroll
        for (int a = 0; a < 2; ++a)
#pragma unroll
            for (int b = 0; b < 2; ++b)
#pragma unroll
                for (int m = 0; m < 4; ++m)
#pragma unroll
                    for (int n = 0; n < 2; ++n) acc[a][b][m][n] = (f32x4){0.f, 0.f, 0.f, 0.f};
        cur = nxt; cA = nA; cB = nB; ++ui; oc00 = on00; oc01 = on01; oc10 = on10; oc11 = on11;
        if constexpr (ALIGN_EPI) { if (wr == 1) PG8_BAR; }
    }
    PG8_WAIT_V(0);
    if constexpr (!ALIGN_EPI) { if (wr == 0) PG8_BAR; }
    PG8_BAR;
#undef PG8_SA
#undef PG8_SB
#undef PG8_STAGE2
#undef PG8_STAGEB
#undef PG8_LDA
#undef PG8_LDB
#undef PG8_MMA
#undef PG8_WAIT_V
#undef PG8_WAIT_L
#undef PG8_BAR
#undef PG8_SCHED
}
}

namespace att {
constexpr int NSLOT = 3;
constexpr float THR = 8.0f;
__device__ __forceinline__ void glds16(const void* gsrc, unsigned lds_dst) { unsigned keep;
    asm volatile("s_mov_b32 %0, m0\n\ts_mov_b32 m0, %2\n\ts_nop 0\n\tglobal_load_lds_dwordx4 %1, off\n\ts_mov_b32 m0, %0" : "=&s"(keep) : "v"(gsrc), "s"(lds_dst) : "memory"); }
#define ATT_WAIT_BAR(N) asm volatile("s_waitcnt vmcnt(" #N ") lgkmcnt(0)\n\ts_barrier" ::: "memory")
typedef LAS const char* lds_cptr;
typedef short v4i16_t __attribute__((ext_vector_type(4)));
__device__ __forceinline__ s16x4 vtr(lds_cptr p) { return __builtin_bit_cast(s16x4, __builtin_amdgcn_ds_read_tr16_b64_v4i16((LAS v4i16_t*)p)); }
__device__ __forceinline__ float swap_max(float m) { auto rr = __builtin_amdgcn_permlane32_swap(__float_as_uint(m), __float_as_uint(m), false, false); return __builtin_fmaxf(__uint_as_float(rr[0]), __uint_as_float(rr[1])); }
__device__ __forceinline__ float swap_sum(float m) { auto rr = __builtin_amdgcn_permlane32_swap(__float_as_uint(m), __float_as_uint(m), false, false); return __uint_as_float(rr[0]) + __uint_as_float(rr[1]); }
#define CRF(r) ((float)(((r) & 3) + 8 * ((r) >> 2)))
#define CRI(r) (((r) & 3) + 8 * ((r) >> 2))

template <int MODE> struct Cfg;
template <> struct Cfg<0> { static constexpr int DV32 = 2, NK = 1, SLOTB = 16384, VOFF = 8192, PITCH = SWA_N, NVP = 1; };
template <> struct Cfg<1> { static constexpr int DV32 = 4, NK = 2, SLOTB = 32768, VOFF = 16384, PITCH = DIFF_N, NVP = 2; };

template <int MODE>
__device__ __forceinline__ void tile_step(lds_cptr kp, lds_cptr vp, const bf16x8 (&qr)[4], f32x16 (&o)[Cfg<MODE>::DV32], float& mhat, float& l, bool& first,
                                          const float slope2, const int dq_i, const int kind, const int hi) {
    constexpr int DV32 = Cfg<MODE>::DV32;
    f32x16 p0, p1;
    const float dq = (float)dq_i, nm = -mhat;
    {
        const float sl = kind == 2 ? 0.f : (kind == 0 ? slope2 : -slope2); const float base0 = __builtin_fmaf(-sl, dq, nm);
#pragma unroll
        for (int r = 0; r < 16; ++r) { p0[r] = __builtin_fmaf(sl, CRF(r), base0); p1[r] = __builtin_fmaf(sl, CRF(r) + 32.f, base0); }
    }
#pragma unroll
    for (int d0 = 0; d0 < 4; ++d0) {
        const bf16x8 b0 = *(const LAS bf16x8*)(kp + d0 * 2048);
        const bf16x8 b1 = *(const LAS bf16x8*)(kp + d0 * 2048 + 512);
        p0 = __builtin_amdgcn_mfma_f32_32x32x16_bf16(b0, qr[d0], p0, 0, 0, 0);
        p1 = __builtin_amdgcn_mfma_f32_32x32x16_bf16(b1, qr[d0], p1, 0, 0, 0);
    }
    if (kind == 2) {
#pragma unroll
        for (int r = 0; r < 16; ++r) {
            const float e0 = __builtin_fabsf(dq - CRF(r)), e1 = __builtin_fabsf(dq - CRF(r) - 32.f);
            if (MODE == 0) { p0[r] = e0 <= 128.f ? __builtin_fmaf(-slope2, e0, p0[r]) : -INFINITY; p1[r] = e1 <= 128.f ? __builtin_fmaf(-slope2, e1, p1[r]) : -INFINITY; }
            else { p0[r] = __builtin_fmaf(-slope2, e0, p0[r]); p1[r] = __builtin_fmaf(-slope2, e1, p1[r]); }
        }
    }
    float rm = __builtin_fmaxf(p0[0], p1[0]);
#pragma unroll
    for (int r = 1; r < 16; ++r) rm = __builtin_fmaxf(rm, __builtin_fmaxf(p0[r], p1[r]));
    rm = swap_max(rm);
    if (first || __any(rm > THR)) {
        const float dl = first ? rm : __builtin_fmaxf(rm, 0.f);
        mhat += dl;
#pragma unroll
        for (int r = 0; r < 16; ++r) { p0[r] -= dl; p1[r] -= dl; }
        if (!first) {
            const float f = __builtin_amdgcn_exp2f(-dl); l *= f;
#pragma unroll
            for (int r = 0; r < 16; ++r) { const float fr_ = __shfl(f, CRI(r) + 4 * hi);
#pragma unroll
                for (int d0 = 0; d0 < DV32; ++d0) o[d0][r] *= fr_; }
        }
        first = false;
    }
    float sacc = 0.f;
    u32x4 pw[4];
#pragma unroll
    for (int s = 0; s < 2; ++s) {
        float e[8];
#pragma unroll
        for (int j = 0; j < 8; ++j) { e[j] = __builtin_amdgcn_exp2f(p0[8 * s + j]); sacc += e[j]; }
        pw[s] = (u32x4){cvtpk(e[0], e[1]), cvtpk(e[2], e[3]), cvtpk(e[4], e[5]), cvtpk(e[6], e[7])};
    }
#pragma unroll
    for (int s = 0; s < 2; ++s) {
        float e[8];
#pragma unroll
        for (int j = 0; j < 8; ++j) { e[j] = __builtin_amdgcn_exp2f(p1[8 * s + j]); sacc += e[j]; }
        pw[2 + s] = (u32x4){cvtpk(e[0], e[1]), cvtpk(e[2], e[3]), cvtpk(e[4], e[5]), cvtpk(e[6], e[7])};
    }
    l += sacc;
#pragma unroll
    for (int d0 = 0; d0 < DV32; ++d0) {
#pragma unroll
        for (int ks = 0; ks < 4; ++ks) {
            const s16x4 lo = vtr(vp + d0 * 4096 + ks * 1024), hh = vtr(vp + d0 * 4096 + ks * 1024 + 512);
            const bf16x8 vf = (bf16x8){lo[0], lo[1], lo[2], lo[3], hh[0], hh[1], hh[2], hh[3]};
            o[d0] = __builtin_amdgcn_mfma_f32_32x32x16_bf16(__builtin_bit_cast(bf16x8, pw[ks]), vf, o[d0], 0, 0, 0);
        }
    }
}

struct DiffConsts { float lam_full; const float* subln; };

template <int MODE>
__device__ __forceinline__ void attn_unit(const int b, const int hh, const int qb, const bf16_t* __restrict__ QKV, bf16_t* __restrict__ O, const float* __restrict__ sink,
                                          const DiffConsts dc, LAS unsigned char* shm, const int wid, const int lane) {
    typedef Cfg<MODE> C;
    constexpr int DV32 = C::DV32, PITCH = C::PITCH;
    const int r32 = lane & 31, hi = lane >> 5;
    int iw, qcol, kcol, vcol, t_lo, NT, hq = 0, cmap = 0, qs;
    float slope2;
    if (MODE == 0) { const int g = wid >> 1; qs = wid & 1; hq = hh * 4 + g; iw = qb * 64 + qs * 32; qcol = hq * 64; kcol = 1024 + hh * 64; vcol = 1280 + hh * 64;
        t_lo = qb - 2 < 0 ? 0 : qb - 2; const int t_hi = qb + 2 > 127 ? 127 : qb + 2; NT = t_hi - t_lo + 1; slope2 = __builtin_amdgcn_exp2f(-0.5f * (float)(hq + 1)) * LOG2E; }
    else { qs = wid & 3; cmap = wid >> 2; iw = qb * 128 + qs * 32; qcol = (hh * 2 + cmap) * 64; kcol = 1024 + hh * 128; vcol = 2048 + hh * 128; t_lo = 0; NT = SEQ / 64;
        slope2 = __builtin_amdgcn_exp2f(-(float)(hh + 1)) * LOG2E; }
    const bf16_t* base = QKV + (size_t)b * SEQ * PITCH;
    const unsigned lds0 = (unsigned)(uintptr_t)shm;
    const unsigned koff = (unsigned)(lane * PITCH + kcol + wid * 8) * 2u;
    const unsigned voff = (unsigned)((16 * (wid & 3) + (lane >> 2)) * PITCH + vcol + (wid >> 2) * 32 + (lane & 3) * 8) * 2u;
    const unsigned kdst = lds0 + wid * 1024, vdst = lds0 + C::VOFF + wid * 1024;
#define ATT_DMA(t, slot) do { const char* tb_ = (const char*)base + (size_t)(t) * 64 * PITCH * 2; const unsigned so_ = (unsigned)(slot) * C::SLOTB; \
        glds16(tb_ + koff, (unsigned)__builtin_amdgcn_readfirstlane(kdst + so_)); \
        if (MODE == 1) glds16(tb_ + koff + 128, (unsigned)__builtin_amdgcn_readfirstlane(kdst + so_ + 8192)); \
        glds16(tb_ + voff, (unsigned)__builtin_amdgcn_readfirstlane(vdst + so_)); \
        if (MODE == 1) glds16(tb_ + voff + 128, (unsigned)__builtin_amdgcn_readfirstlane(vdst + so_ + 8192)); } while (0)
    ATT_DMA(t_lo, 0);
    if (NT > 1) ATT_DMA(t_lo + 1, 1);
    bf16x8 qr[4];
    { const bf16_t* Qw = base + (size_t)(iw + r32) * PITCH + qcol;
#pragma unroll
      for (int d0 = 0; d0 < 4; ++d0) qr[d0] = *(const bf16x8*)(Qw + d0 * 16 + hi * 8); }
    f32x16 o[DV32];
#pragma unroll
    for (int d0 = 0; d0 < DV32; ++d0)
#pragma unroll
        for (int r = 0; r < 16; ++r) o[d0][r] = 0.f;
    float mhat = 0.f, l = 0.f; bool first = true;
    if (MODE == 0) { mhat = sink[hq] * LOG2E; l = (hi == 0) ? 1.f : 0.f; first = false; }
    const lds_cptr shm3 = (lds_cptr)shm;
    const lds_cptr kp0 = shm3 + (MODE == 1 ? cmap * 8192 : 0) + hi * 1024 + r32 * 16;
    const lds_cptr vp0 = shm3 + C::VOFF + ((lane >> 4) & 1) * 32 + (lane & 3) * 8 + (4 * hi + ((lane & 15) >> 2)) * 64;
    int slot = 0;
    for (int it = 0; it < NT; ++it) {
        if (it + 1 < NT) { if (MODE == 1) { ATT_WAIT_BAR(4); } else { ATT_WAIT_BAR(2); } } else { ATT_WAIT_BAR(0); }
        if (it + 2 < NT) { const int s2 = slot == 0 ? 2 : slot - 1; ATT_DMA(t_lo + it + 2, s2); }
        const int k0 = (t_lo + it) * 64;
        const int kind = (MODE == 0) ? 2 : ((k0 + 63 < iw) ? 0 : ((k0 > iw + 31) ? 1 : 2));
        tile_step<MODE>(kp0 + slot * C::SLOTB, vp0 + slot * C::SLOTB, qr, o, mhat, l, first, slope2, iw + r32 - k0 - 4 * hi, kind, hi);
        slot = slot == 2 ? 0 : slot + 1;
    }
#undef ATT_DMA
    l = swap_sum(l);
    const float rl = 1.f / l;
    if (MODE == 0) {
        bf16_t* Ow = O + (size_t)(b * SEQ + iw) * D + hq * 64 + r32;
#pragma unroll
        for (int r = 0; r < 16; ++r) { const int row = CRI(r) + 4 * hi; const float rr = __shfl(rl, row);
#pragma unroll
            for (int d0 = 0; d0 < DV32; ++d0) Ow[(size_t)row * D + d0 * 32] = (bf16_t)f2bf(o[d0][r] * rr); }
        ATT_WAIT_BAR(0);
    } else {
        LAS float* cb = (LAS float*)shm + qs * 4096;
        ATT_WAIT_BAR(0);
        if (cmap == 1) {
#pragma unroll
            for (int r = 0; r < 16; ++r) { const int row = CRI(r) + 4 * hi; const float rr = __shfl(rl, row) * dc.lam_full;
#pragma unroll
                for (int d0 = 0; d0 < DV32; ++d0) cb[row * 128 + d0 * 32 + r32] = o[d0][r] * rr; }
        }
        ATT_WAIT_BAR(0);
        if (cmap == 0) {
            bf16_t* Ow = O + (size_t)(b * SEQ + iw) * D + hh * 128 + r32;
            float gsub[DV32];
#pragma unroll
            for (int d0 = 0; d0 < DV32; ++d0) gsub[d0] = dc.subln[d0 * 32 + r32] * (1.f - LAMBDA_INIT);
#pragma unroll
            for (int r = 0; r < 16; ++r) { const int row = CRI(r) + 4 * hi; const float rr = __shfl(rl, row);
                float v[DV32]; float ss = 0.f;
#pragma unroll
                for (int d0 = 0; d0 < DV32; ++d0) { v[d0] = o[d0][r] * rr - cb[row * 128 + d0 * 32 + r32]; ss += v[d0] * v[d0]; }
                ss += __shfl_xor(ss, 1); ss += __shfl_xor(ss, 2); ss += __shfl_xor(ss, 4); ss += __shfl_xor(ss, 8); ss += __shfl_xor(ss, 16);
                const float sc = __builtin_amdgcn_rsqf(ss * (1.f / 128.f) + 1e-5f);
#pragma unroll
                for (int d0 = 0; d0 < DV32; ++d0) Ow[(size_t)row * D + d0 * 32] = (bf16_t)f2bf(v[d0] * sc * gsub[d0]); }
        }
        ATT_WAIT_BAR(0);
    }
}
#undef ATT_WAIT_BAR
}

typedef GAS unsigned gu32;
#define RLX_AGENT __ATOMIC_RELAXED, __HIP_MEMORY_SCOPE_AGENT
#define LDS_WAIT() asm volatile("s_waitcnt lgkmcnt(0)" ::: "memory")
#define VM_WAIT() asm volatile("s_waitcnt vmcnt(0)" ::: "memory")
#define XB_TMO      128
#define XB_XCNT(j)  (256  + 64 * (j))
#define XB_XSUB(j)  (1280 + 64 * (j))
#define XB_XGEN(j)  (2304 + 64 * (j))
#define XB_TOP      3328
#define XB_TOPGEN   3392
#define XCD_BAR_WORDS 3456
#define XB_SPIN_CAP (1u << 18)
__device__ __forceinline__ unsigned xb_ld(unsigned* p)              { return __hip_atomic_load(p, __ATOMIC_RELAXED, __HIP_MEMORY_SCOPE_AGENT); }
__device__ __forceinline__ unsigned xb_add(unsigned* p, unsigned v) { return __hip_atomic_fetch_add(p, v, __ATOMIC_RELAXED, __HIP_MEMORY_SCOPE_AGENT); }
__device__ __forceinline__ unsigned xb_xcc_id() { return (unsigned)__builtin_amdgcn_s_getreg((3 << 11) | 20) & 0xFu; }
#define XB_SPIN(cond, bar) do { unsigned _sp = 0; while (cond) { __builtin_amdgcn_s_sleep(1); \
    if ((++_sp & 255u) == 0u) { if (xb_ld(&(bar)[XB_TMO])) break; if (_sp > XB_SPIN_CAP) { atomicAdd(&(bar)[XB_TMO], 1u); break; } } } } while (0)
struct XcdBarrier { unsigned* bar; unsigned x; volatile LAS unsigned* st; };
__device__ __forceinline__ XcdBarrier xcd_barrier_post(unsigned* bar, volatile LAS unsigned* st, const bool leader) {
    XcdBarrier b; b.bar = bar; b.x = xb_xcc_id(); b.st = st;
    if (leader) (void)xb_add(&bar[XB_XCNT(b.x)], 1u);
    return b;
}
__device__ __forceinline__ void xcd_barrier_complete(unsigned* bar, unsigned x, unsigned& nloc, unsigned& nx) {
    const unsigned G = gridDim.x * gridDim.y * gridDim.z;
    unsigned sum, cnt, mine, sp = 0u;
    for (;;) {
        sum = 0u; cnt = 0u; mine = 0u;
#pragma unroll
        for (unsigned j = 0; j < 16; ++j) { const unsigned c = xb_ld(&bar[XB_XCNT(j)]); sum += c; cnt += (c > 0u) ? 1u : 0u; mine = (j == x) ? c : mine; }
        if (sum == G) break;
        __builtin_amdgcn_s_sleep(1);
        if ((++sp & 255u) == 0u) { if (xb_ld(&bar[XB_TMO])) break; if (sp > XB_SPIN_CAP) { atomicAdd(&bar[XB_TMO], 1u); break; } }
    }
    nloc = mine > 0u ? mine : 1u; nx = cnt > 0u ? cnt : 1u;
}
__device__ __forceinline__ void xcd_barrier(const XcdBarrier& b, const bool leader) {
    asm volatile("s_waitcnt vmcnt(0)" ::: "memory");
    __syncthreads();
    if (leader) {
        unsigned* bar = b.bar;
        __builtin_amdgcn_s_waitcnt(0);
        unsigned nloc = b.st[0], nx = b.st[1];
        if (nloc == 0u) { xcd_barrier_complete(bar, b.x, nloc, nx); b.st[0] = nloc; b.st[1] = nx; }
        const unsigned old = xb_add(&bar[XB_XSUB(b.x)], 1u);
        const unsigned gen = old / nloc;
        if (old + 1u == (gen + 1u) * nloc) {
            __builtin_amdgcn_fence(__ATOMIC_RELEASE, "agent");
            asm volatile("s_waitcnt vmcnt(0)" ::: "memory");
            const unsigned og = xb_add(&bar[XB_TOP], 1u);
            const unsigned tg = og / nx;
            if (og + 1u == (tg + 1u) * nx) xb_add(&bar[XB_TOPGEN], 1u);
            else XB_SPIN(xb_ld(&bar[XB_TOPGEN]) == tg, bar);
            __builtin_amdgcn_fence(__ATOMIC_ACQUIRE, "agent");
            xb_add(&bar[XB_XGEN(b.x)], 1u);
            asm volatile("s_waitcnt vmcnt(0)" ::: "memory");
        } else {
            XB_SPIN(xb_ld(&bar[XB_XGEN(b.x)]) == gen, bar);
            __builtin_amdgcn_fence(__ATOMIC_ACQUIRE, "agent");
            asm volatile("s_waitcnt vmcnt(0)" ::: "memory");
        }
    }
    __syncthreads();
}

struct Args { const float* in[18]; float* out; unsigned char* ws; int ph_lo, ph_hi, use_cg, pad; };
enum { I_X = 0, I_NMIX, I_NFFN, I_SWA_QKV, I_SWA_WO, I_SWA_SINK, I_DIFF_QKV, I_DIFF_WO, I_DIFF_LAM, I_DIFF_SUBLN, I_WG, I_BG, I_WR, I_BR, I_GATE, I_UP, I_DOWN, I_FNORM };
typedef const __attribute__((address_space(4))) Args* CArgs;
__device__ __forceinline__ CArgs kargs() { CArgs p = (CArgs)__builtin_amdgcn_kernarg_segment_ptr(); asm volatile("" : "+s"(p)); return p; }
__device__ __forceinline__ int vcu_of(int G) { const int bx = blockIdx.x; return (G % 8 == 0) ? (bx % 8) * (G / 8) + bx / 8 : bx; }

__device__ __forceinline__ void tr_item(const float* W, int N, int k0, int n0, bf16_t* dst, int ldd, LAS float* scr, int lane) {
#pragma unroll 8
    for (int i = 0; i < 32; ++i) { const int kk = 2 * i + (lane >> 5); scr[kk * 33 + (lane & 31)] = W[(size_t)(k0 + kk) * N + n0 + (lane & 31)]; }
    LDS_WAIT(); asm volatile("" ::: "memory");
    const int c = lane & 7;
#pragma unroll
    for (int j = 0; j < 4; ++j) { const int n = (lane >> 3) + 8 * j; const LAS float* s = scr + (8 * c) * 33 + n;
        u32x4 o; o.x = pk2(s[0 * 33], s[1 * 33]); o.y = pk2(s[2 * 33], s[3 * 33]); o.z = pk2(s[4 * 33], s[5 * 33]); o.w = pk2(s[6 * 33], s[7 * 33]);
        *(GAS u32x4*)(dst + (size_t)n * ldd + k0 + 8 * c) = o; }
    LDS_WAIT(); asm volatile("" ::: "memory");
}
__device__ __forceinline__ void rms_row_to_bf16(const float* xrow, const float* g, bf16_t* orow, int lane) {
    const GAS f32x4* xr = (const GAS f32x4*)xrow + lane; const GAS f32x4* gr = (const GAS f32x4*)g + lane;
    f32x4 v[4]; float s = 0.f;
#pragma unroll
    for (int j = 0; j < 4; ++j) { v[j] = xr[64 * j]; s += (v[j].x * v[j].x + v[j].y * v[j].y) + (v[j].z * v[j].z + v[j].w * v[j].w); }
    const float rstd = 1.f / sqrtf(wave_sum(s) * (1.f / D) + 1e-6f);
    GAS u32x2* o8 = (GAS u32x2*)orow + lane;
#pragma unroll
    for (int j = 0; j < 4; ++j) { const f32x4 gg = gr[64 * j]; u32x2 w; w.x = pk2(v[j].x * rstd * gg.x, v[j].y * rstd * gg.y); w.y = pk2(v[j].z * rstd * gg.z, v[j].w * rstd * gg.w); o8[64 * j] = w; }
}

__device__ __forceinline__ void phase_prologue(LAS unsigned char* lds_in, const int wave_in) {
    int lane = lane_id(); asm volatile("" : "+v"(lane)); int wave = wave_in; asm volatile("" : "+s"(wave)); LAS unsigned char* lds = lds_in; asm volatile("" : "+s"(lds));
    const CArgs a = kargs(); unsigned char* ws = a->ws;
    const int G = gridDim.x, vcu = vcu_of(G);
    LAS float* scr = (LAS float*)(lds + wave * 16384);
    const int gw = vcu * NWAVES + wave, NGW = G * NWAVES;
    bf16_t* swa_qkv_t = (bf16_t*)(ws + WS_SWA_QKV_T); bf16_t* swa_wo_t = (bf16_t*)(ws + WS_SWA_WO_T);
    bf16_t* diff_qkv_t = (bf16_t*)(ws + WS_DIFF_QKV_T); bf16_t* diff_wo_t = (bf16_t*)(ws + WS_DIFF_WO_T);
    constexpr int I0 = 16 * 48, I1 = 16 * 32, I2 = 16 * 96, I3 = 16 * 32, IM = 64 * 768, NITEMS = I0 + I1 + I2 + I3 + IM;
    for (int it = gw; it < NITEMS; it += NGW) {
        int r = it;
        if (r < I0) { const int kb = r / 48, nb = r % 48; tr_item(a->in[I_SWA_QKV], SWA_N, 64 * kb, 32 * nb, swa_qkv_t + (size_t)(32 * nb) * D, D, scr, lane); continue; } r -= I0;
        if (r < I1) { const int kb = r / 32, nb = r % 32; tr_item(a->in[I_SWA_WO], D, 64 * kb, 32 * nb, swa_wo_t + (size_t)(32 * nb) * D, D, scr, lane); continue; } r -= I1;
        if (r < I2) { const int kb = r / 96, nb = r % 96; tr_item(a->in[I_DIFF_QKV], DIFF_N, 64 * kb, 32 * nb, diff_qkv_t + (size_t)(32 * nb) * D, D, scr, lane); continue; } r -= I2;
        if (r < I3) { const int kb = r / 32, nb = r % 32; tr_item(a->in[I_DIFF_WO], D, 64 * kb, 32 * nb, diff_wo_t + (size_t)(32 * nb) * D, D, scr, lane); continue; } r -= I3;
        const int le = r / 768, q = r % 768;
        bf16_t* gu = (bf16_t*)(ws + WS_WMOE + (size_t)le * 3 * MiB); bf16_t* dn = gu + (size_t)D * D;
        if (q < 256) { const int kb = q / 16, c0 = 32 * (q % 16); const int drow = (c0 >> 7) * 256 + (c0 & 127);
            tr_item(a->in[I_GATE] + (size_t)le * D * DEXP, DEXP, 64 * kb, c0, gu + (size_t)drow * D, D, scr, lane); }
        else if (q < 512) { const int qq = q - 256; const int kb = qq / 16, c0 = 32 * (qq % 16); const int drow = (c0 >> 7) * 256 + 128 + (c0 & 127);
            tr_item(a->in[I_UP] + (size_t)le * D * DEXP, DEXP, 64 * kb, c0, gu + (size_t)drow * D, D, scr, lane); }
        else { const int qq = q - 512; const int kb = qq / 32, nb = qq % 32;
            tr_item(a->in[I_DOWN] + (size_t)le * DEXP * D, D, 64 * kb, 32 * nb, dn + (size_t)(32 * nb) * DEXP, DEXP, scr, lane); }
    }
    { float* wr_t = (float*)(ws + WS_WR); const int gt = gw * 64 + lane, NGT = NGW * 64;
      for (int i = gt; i < 2 * 36 * D; i += NGT) { const int l = i / (36 * D), rem = i % (36 * D), c = rem / D, k = rem % D;
          wr_t[i] = c < 4 ? a->in[I_WG][(size_t)l * D * 4 + k * 4 + c] : a->in[I_WR][(size_t)l * D * 32 + k * 32 + (c - 4)]; } }
    bf16_t* XN = (bf16_t*)(ws + WS_XN);
    for (int m = gw; m < M; m += NGW) rms_row_to_bf16(a->in[I_X] + (size_t)m * D, a->in[I_NMIX], XN + (size_t)m * D, lane);
}

__device__ __forceinline__ void phase_router(LAS unsigned char* lds_in, int layer, const int wave_in) {
    int lane = lane_id(); asm volatile("" : "+v"(lane)); int wave = wave_in; asm volatile("" : "+s"(wave)); LAS unsigned char* lds = lds_in; asm volatile("" : "+s"(lds));
    const CArgs a = kargs(); unsigned char* ws = a->ws;
    const int G = gridDim.x, vcu = vcu_of(G);
    const int gw = vcu * NWAVES + wave, NGW = G * NWAVES;
    const float* g = a->in[I_NFFN] + layer * D; const float* wr_t = (const float*)(ws + WS_WR) + (size_t)layer * 36 * D;
    const float* bg = a->in[I_BG] + layer * 4; const float* br = a->in[I_BR] + layer * 32;
    bf16_t* XN = (bf16_t*)(ws + WS_XN); const float* xin = a->out;
    unsigned* cnt = (unsigned*)(ws + WS_CTL) + CW_CNT + layer * 32;
    int* ltok = (int*)(ws + WS_LTOK); float* lw = (float*)(ws + WS_LW); i32x4* tinfo = (i32x4*)(ws + WS_TINFO);
    LAS f32x4* lg4 = (LAS f32x4*)(lds + wave * 256);
    const unsigned loff = (unsigned)lane * 16u;
#pragma unroll 1
    for (int t = gw; t < M; t += NGW) {
        const char* xrow = (const char*)(xin + (size_t)t * D);
        f32x4 v[4]; float s = 0.f;
#pragma unroll
        for (int j = 0; j < 4; ++j) { v[j] = *(const f32x4*)(xrow + loff + j * 1024); s += (v[j].x * v[j].x + v[j].y * v[j].y) + (v[j].z * v[j].z + v[j].w * v[j].w); }
        const float rstd = 1.f / sqrtf(wave_sum(s) * (1.f / D) + 1e-6f);
        char* orow = (char*)(XN + (size_t)t * D);
#pragma unroll
        for (int j = 0; j < 4; ++j) { const f32x4 gg = *(const f32x4*)((const char*)g + loff + j * 1024); v[j] = v[j] * rstd * gg; u32x2 w; w.x = pk2(v[j].x, v[j].y); w.y = pk2(v[j].z, v[j].w);
            *(u32x2*)(orow + (loff >> 1) + j * 512) = w; }
#pragma unroll 1
        for (int cg = 0; cg < 9; ++cg) {
            const char* wb = (const char*)(wr_t + (size_t)cg * 4 * D);
            float sc[4];
#pragma unroll
            for (int c4 = 0; c4 < 4; ++c4) { float sacc = 0.f;
#pragma unroll
                for (int j = 0; j < 4; ++j) { const f32x4 w = *(const f32x4*)(wb + loff + c4 * 4096 + j * 1024); sacc += (v[j].x * w.x + v[j].y * w.y) + (v[j].z * w.z + v[j].w * w.w); }
                sc[c4] = wave_sum(sacc); }
            if (lane == 0) lg4[cg] = (f32x4){sc[0], sc[1], sc[2], sc[3]};
        }
        LDS_WAIT(); asm volatile("" ::: "memory");
        float acc[36];
#pragma unroll
        for (int q = 0; q < 9; ++q) { const f32x4 x = lg4[q]; acc[4 * q] = x.x; acc[4 * q + 1] = x.y; acc[4 * q + 2] = x.z; acc[4 * q + 3] = x.w; }
        LDS_WAIT(); asm volatile("" ::: "memory");
        float lgv[4]; int gs = 0;
#pragma unroll
        for (int c = 0; c < 4; ++c) lgv[c] = acc[c] + bg[c];
        float mx = lgv[0];
#pragma unroll
        for (int c = 1; c < 4; ++c) if (lgv[c] > mx) { mx = lgv[c]; gs = c; }
        float den = 0.f;
#pragma unroll
        for (int c = 0; c < 4; ++c) den += __expf(lgv[c] - mx);
        const float pg = 1.f / den;
        float le[8];
#pragma unroll
        for (int k = 0; k < 8; ++k) { const float a0 = acc[4 + k] + br[k], a1 = acc[12 + k] + br[8 + k], a2 = acc[20 + k] + br[16 + k], a3 = acc[28 + k] + br[24 + k];
            le[k] = gs == 0 ? a0 : (gs == 1 ? a1 : (gs == 2 ? a2 : a3)); }
        int i1 = 0; float m1 = le[0];
#pragma unroll
        for (int k = 1; k < 8; ++k) if (le[k] > m1) { m1 = le[k]; i1 = k; }
        int i2 = -1; float m2 = -INFINITY;
#pragma unroll
        for (int k = 0; k < 8; ++k) if (k != i1 && (i2 < 0 || le[k] > m2)) { m2 = le[k]; i2 = k; }
        const float ex = __expf(m2 - m1); const float tp1 = 1.f / (1.f + ex), tp2 = ex * tp1;
        const float w1 = pg * tp1, w2 = pg * tp2; const int e1 = gs * 8 + i1, e2 = gs * 8 + i2;
        if (lane == 0) {
            const int p1 = (int)atomicAdd(&cnt[e1], 1u), p2 = (int)atomicAdd(&cnt[e2], 1u);
            ltok[(size_t)e1 * M + p1] = t; lw[(size_t)e1 * M + p1] = w1; ltok[(size_t)e2 * M + p2] = t; lw[(size_t)e2 * M + p2] = w2;
            tinfo[t] = (i32x4){e1, p1, e2, p2};
        }
    }
}

__device__ __forceinline__ void moe_tables(LAS unsigned char* lds, unsigned char* ws, int layer, const int wave, const int lane) {
    LAS int* TP = (LAS int*)(lds + TP_OFF); LAS int* CNT = TP + 40;
    unsigned* cnt = (unsigned*)(ws + WS_CTL) + CW_CNT + layer * 32;
    const int tid = wave * 64 + lane;
    __syncthreads();
    if (tid < 32) CNT[tid] = (int)__hip_atomic_load(cnt + tid, RLX_AGENT);
    __syncthreads();
    if (tid == 0) { int s = 0; for (int e = 0; e < 32; ++e) { TP[e] = s; s += (CNT[e] + 255) >> 8; } TP[32] = s; }
    __syncthreads();
}

__device__ __forceinline__ void phase_combine(LAS unsigned char* lds_in, int layer, const int wave_in) {
    int lane = lane_id(); asm volatile("" : "+v"(lane)); int wave = wave_in; asm volatile("" : "+s"(wave)); LAS unsigned char* lds = lds_in; asm volatile("" : "+s"(lds));
    const CArgs a = kargs(); unsigned char* ws = a->ws;
    moe_tables(lds, ws, layer, wave, lane);
    const bool final_ = layer == 1; const float* gnext = layer == 0 ? a->in[I_NMIX] + D : a->in[I_FNORM]; float* xio = a->out;
    const int G = gridDim.x, vcu = vcu_of(G);
    const int gw = vcu * NWAVES + wave, NGW = G * NWAVES;
    const LAS int* TP = (const LAS int*)(lds + TP_OFF);
    const bf16_t* Y = (const bf16_t*)(ws + WS_Y); const i32x4* tinfo = (const i32x4*)(ws + WS_TINFO); bf16_t* XN = (bf16_t*)(ws + WS_XN);
    for (int t = gw; t < M; t += NGW) {
        const i32x4 ti = tinfo[t];
        const size_t s1 = (size_t)TP[ti.x] * 256 + ti.y, s2 = (size_t)TP[ti.z] * 256 + ti.w;
        GAS f32x4* xr = (GAS f32x4*)(xio + (size_t)t * D) + lane; const GAS f32x4* gr = (const GAS f32x4*)gnext + lane;
        const GAS u32x2* y1 = (const GAS u32x2*)(Y + s1 * D) + lane; const GAS u32x2* y2 = (const GAS u32x2*)(Y + s2 * D) + lane;
        f32x4 v[4]; float s = 0.f;
#pragma unroll
        for (int j = 0; j < 4; ++j) { const f32x4 x = xr[64 * j]; const u32x2 p = y1[64 * j], q = y2[64 * j];
            f32x4 ya, yb; ya.x = __uint_as_float(p.x << 16); ya.y = __uint_as_float(p.x & 0xffff0000u); ya.z = __uint_as_float(p.y << 16); ya.w = __uint_as_float(p.y & 0xffff0000u);
            yb.x = __uint_as_float(q.x << 16); yb.y = __uint_as_float(q.x & 0xffff0000u); yb.z = __uint_as_float(q.y << 16); yb.w = __uint_as_float(q.y & 0xffff0000u);
            v[j] = x + (ya + yb); s += (v[j].x * v[j].x + v[j].y * v[j].y) + (v[j].z * v[j].z + v[j].w * v[j].w); }
        const float rstd = 1.f / sqrtf(wave_sum(s) * (1.f / D) + 1e-6f);
        if (final_) {
#pragma unroll
            for (int j = 0; j < 4; ++j) xr[64 * j] = v[j] * rstd * gr[64 * j];
        } else {
            GAS u32x2* o8 = (GAS u32x2*)(XN + (size_t)t * D) + lane;
#pragma unroll
            for (int j = 0; j < 4; ++j) { xr[64 * j] = v[j]; const f32x4 n = v[j] * rstd * gr[64 * j]; u32x2 w; w.x = pk2(n.x, n.y); w.y = pk2(n.z, n.w); o8[64 * j] = w; }
        }
    }
}

__device__ __forceinline__ float diff_lambda_full(const float* lam, int lane) {
    const float a = wave_sum(lam[lane] * lam[64 + lane]), b = wave_sum(lam[128 + lane] * lam[192 + lane]);
    return __expf(a) - __expf(b) + LAMBDA_INIT;
}

__device__ __forceinline__ void phase_qkv(LAS unsigned char* lds_in, int layer, const int wave_in) {
    int lane = lane_id(); asm volatile("" : "+v"(lane)); int wave = wave_in; asm volatile("" : "+s"(wave)); LAS unsigned char* lds = lds_in; asm volatile("" : "+s"(lds));
    const CArgs a = kargs(); unsigned char* ws = a->ws;
    const int N = layer == 0 ? SWA_N : DIFF_N;
    pg8::Gemm g{(const bf16_t*)(ws + WS_XN), (const bf16_t*)(ws + (layer == 0 ? WS_SWA_QKV_T : WS_DIFF_QKV_T)), D};
    pg8::DenseOrder S; S.init(M, N, (int)gridDim.x, (int)blockIdx.x);
    pg8::EpiQKV E{(bf16_t*)(ws + WS_QKV), N, 1024, QSCALE};
    pg8::gemm_phase<pg8::EpiQKV, pg8::DenseOrder, false, true>(lds, g, S, E, wave, lane);
}
__device__ __forceinline__ void phase_oproj(LAS unsigned char* lds_in, int layer, const int wave_in) {
    int lane = lane_id(); asm volatile("" : "+v"(lane)); int wave = wave_in; asm volatile("" : "+s"(wave)); LAS unsigned char* lds = lds_in; asm volatile("" : "+s"(lds));
    const CArgs a = kargs(); unsigned char* ws = a->ws;
    pg8::Gemm g{(const bf16_t*)(ws + WS_O), (const bf16_t*)(ws + (layer == 0 ? WS_SWA_WO_T : WS_DIFF_WO_T)), D};
    pg8::DenseOrder S; S.init(M, D, (int)gridDim.x, (int)blockIdx.x);
    pg8::EpiResid E{layer == 0 ? a->in[I_X] : (const float*)a->out, a->out};
    pg8::gemm_phase<pg8::EpiResid, pg8::DenseOrder, false, true>(lds, g, S, E, wave, lane);
}
__device__ __forceinline__ void phase_moe1(LAS unsigned char* lds_in, int layer, const int wave_in) {
    int lane = lane_id(); asm volatile("" : "+v"(lane)); int wave = wave_in; asm volatile("" : "+s"(wave)); LAS unsigned char* lds = lds_in; asm volatile("" : "+s"(lds));
    const CArgs a = kargs(); unsigned char* ws = a->ws;
    moe_tables(lds, ws, layer, wave, lane);
    const LAS int* TP = (const LAS int*)(lds + TP_OFF); const LAS int* CNT = TP + 40;
    pg8::Gemm g{(const bf16_t*)(ws + WS_XN), (const bf16_t*)(ws + WS_WMOE + (size_t)layer * 96 * MiB), D};
    pg8::MoeOrder S{TP, CNT, (const int*)(ws + WS_LTOK), (int)gridDim.x, (int)blockIdx.x, 6, 0};
    pg8::EpiSwiGLU E{(bf16_t*)(ws + WS_H)};
    pg8::gemm_phase<pg8::EpiSwiGLU, pg8::MoeOrder, true, true>(lds, g, S, E, wave, lane);
}
__device__ __forceinline__ void phase_moe2(LAS unsigned char* lds_in, int layer, const int wave_in) {
    int lane = lane_id(); asm volatile("" : "+v"(lane)); int wave = wave_in; asm volatile("" : "+s"(wave)); LAS unsigned char* lds = lds_in; asm volatile("" : "+s"(lds));
    const CArgs a = kargs(); unsigned char* ws = a->ws;
    moe_tables(lds, ws, layer, wave, lane);
    const LAS int* TP = (const LAS int*)(lds + TP_OFF); const LAS int* CNT = TP + 40;
    pg8::Gemm g{(const bf16_t*)(ws + WS_H), (const bf16_t*)(ws + WS_WMOE + (size_t)layer * 96 * MiB), DEXP};
    pg8::MoeOrder S{TP, CNT, (const int*)(ws + WS_LTOK), (int)gridDim.x, (int)blockIdx.x, 12, 8};
    pg8::EpiDown E{(bf16_t*)(ws + WS_Y), (const float*)(ws + WS_LW)};
    pg8::gemm_phase<pg8::EpiDown, pg8::MoeOrder, false, true>(lds, g, S, E, wave, lane);
}
__device__ __forceinline__ void phase_attn(LAS unsigned char* lds_in, int layer, const int wave_in) {
    int lane = lane_id(); asm volatile("" : "+v"(lane)); int wave = wave_in; asm volatile("" : "+s"(wave)); LAS unsigned char* lds = lds_in; asm volatile("" : "+s"(lds));
    const CArgs a = kargs(); unsigned char* ws = a->ws;
    const int G = gridDim.x, vcu = vcu_of(G);
    const bf16_t* QKV = (const bf16_t*)(ws + WS_QKV); bf16_t* OB = (bf16_t*)(ws + WS_O);
    if (layer == 0) {
        att::DiffConsts dc{0.f, nullptr}; const float* sink = a->in[I_SWA_SINK];
#pragma unroll 1
        for (int i = 0; i < 2048; ++i) { const int id = vcu + G * i; if (id >= 2048) break; const int bk = id >> 7, qb = id & 127;
            att::attn_unit<0>(bk >> 2, bk & 3, qb, QKV, OB, sink, dc, lds, wave, lane); }
    } else {
        att::DiffConsts dc{diff_lambda_full(a->in[I_DIFF_LAM], lane), a->in[I_DIFF_SUBLN]};
#pragma unroll 1
        for (int i = 0; i < 2048; ++i) { const int id = vcu + G * i; if (id >= 2048) break; const int bh = id >> 6, qb = id & 63;
            att::attn_unit<1>(bh >> 3, bh & 7, qb, QKV, OB, nullptr, dc, lds, wave, lane); }
    }
}

__global__ void __launch_bounds__(NWAVES * 64, 2) mega_fwd(Args args_by_value) {
    extern __shared__ __attribute__((aligned(16))) unsigned char lds_raw[];
    LAS unsigned char* lds = (LAS unsigned char*)lds_raw;
    const int wave = __builtin_amdgcn_readfirstlane((int)(threadIdx.x >> 6));
    int lo, hi;
    { const CArgs a = kargs(); lo = a->ph_lo; hi = a->ph_hi;
      if (a->use_cg) cg::this_grid().sync(); }
    { const int tid = wave * 64 + lane_id();
      for (int u = tid; u < (LDS_BYTES - LDSCTL_OFF) / 4; u += NWAVES * 64) ((LAS unsigned*)(lds + LDSCTL_OFF))[u] = 0u; }
    __syncthreads();
    if (N_LAUNCHES == 1) { const CArgs a = kargs(); (void)xcd_barrier_post((unsigned*)(a->ws + WS_CTL) + CW_BAR, (volatile LAS unsigned*)(lds + MISC_OFF) + 8, wave == 0 && lane_id() == 0); }
#pragma unroll 1
    for (int ph = lo; ph < hi; ++ph) {
        const int layer = ph >= 8 ? 1 : 0, kind = ph == 0 ? 0 : ph - 7 * layer;
        switch (kind) {
            case 0: phase_prologue(lds, wave); break;
            case 1: phase_qkv(lds, layer, wave); break;
            case 2: phase_attn(lds, layer, wave); break;
            case 3: phase_oproj(lds, layer, wave); break;
            case 4: phase_router(lds, layer, wave); break;
            case 5: phase_moe1(lds, layer, wave); break;
            case 6: phase_moe2(lds, layer, wave); break;
            default: phase_combine(lds, layer, wave); break;
        }
        if (ph + 1 < hi) { const CArgs a = kargs(); XcdBarrier bar; bar.bar = (unsigned*)(a->ws + WS_CTL) + CW_BAR; bar.x = xb_xcc_id(); bar.st = (volatile LAS unsigned*)(lds + MISC_OFF) + 8;
            xcd_barrier(bar, wave == 0 && lane_id() == 0); }
    }
}

extern "C" void kernel_launch(void* const* d_in, const int* in_sizes, int n_in, void* d_out, int out_size, void* d_ws, size_t ws_size, hipStream_t stream) {
    static int grid = 0;
    if (grid == 0) {
        if (n_in != 18 || in_sizes[0] != M * D || out_size != M * D || ws_size < WS_END) {
            fprintf(stderr, "kernel_launch: unexpected shapes: n_in %d in0 %d out %d ws %zu (need %zu)\n", n_in, n_in > 0 ? in_sizes[0] : -1, out_size, ws_size, (size_t)WS_END); grid = -1; return; }
        int dev = 0, cus = 0, per_cu = 0;
        if (hipGetDevice(&dev) != hipSuccess || hipDeviceGetAttribute(&cus, hipDeviceAttributeMultiprocessorCount, dev) != hipSuccess) { fprintf(stderr, "kernel_launch: device query failed\n"); grid = -1; return; }
        if (hipFuncSetAttribute((const void*)mega_fwd, hipFuncAttributeMaxDynamicSharedMemorySize, LDS_BYTES) != hipSuccess) { fprintf(stderr, "kernel_launch: hipFuncSetAttribute failed\n"); grid = -1; return; }
        if (hipOccupancyMaxActiveBlocksPerMultiprocessor(&per_cu, (const void*)mega_fwd, NWAVES * 64, LDS_BYTES) != hipSuccess || per_cu < 1) { fprintf(stderr, "kernel_launch: occupancy query says %d\n", per_cu); per_cu = 1; }
        (void)hipGetLastError();
        grid = cus;
    }
    if (grid < 0) return;
    (void)hipMemsetAsync((char*)d_ws + WS_CTL, 0, CTL_ZERO_BYTES, stream);
    Args a{};
    for (int i = 0; i < 18; ++i) a.in[i] = (const float*)d_in[i];
    a.out = (float*)d_out; a.ws = (unsigned char*)d_ws; a.use_cg = 0; a.pad = 0;
    if (N_LAUNCHES == 1) {
        a.ph_lo = 0; a.ph_hi = N_PHASES;
        void* kargs_[] = {&a};
        hipError_t e = hipLaunchCooperativeKernel((const void*)mega_fwd, dim3(grid), dim3(NWAVES * 64), kargs_, LDS_BYTES, stream);
        if (e != hipSuccess) fprintf(stderr, "kernel_launch: cooperative launch failed: %s (grid %d)\n", hipGetErrorString(e), grid);
    } else {
        for (int p = 0; p < N_PHASES; ++p) { a.ph_lo = p; a.ph_hi = p + 1; hipLaunchKernelGGL(mega_fwd, dim3(grid), dim3(NWAVES * 64), LDS_BYTES, stream, a); }
    }
}
```

```cpp
#include <hip/hip_runtime.h>
#include <hip/hip_cooperative_groups.h>
#include <cstdio>
#include <cstdint>
namespace cg = cooperative_groups;

#ifndef MK_N_LAUNCHES
#define MK_N_LAUNCHES 1
#endif
constexpr int N_PHASES = 15;
#define F8_STAGE 2
#define REP_PHASE -1
#define REP_COUNT 0
#define ATT_PROBE_VARIANT 0
#define EXTRA_BARRIERS 0
#define ROUTER_PROBE 0
#define TPROBE_MASK 0
#define TPROBE_K 4
constexpr int N_LAUNCHES = MK_N_LAUNCHES;

#define LAS __attribute__((address_space(3)))
#define GAS __attribute__((address_space(1)))
typedef unsigned short bf16_t;
typedef short bf16x8 __attribute__((ext_vector_type(8)));
typedef short s16x4 __attribute__((ext_vector_type(4)));
typedef float f32x2 __attribute__((ext_vector_type(2)));
typedef float f32x4 __attribute__((ext_vector_type(4)));
typedef float f32x16 __attribute__((ext_vector_type(16)));
typedef unsigned u32x2 __attribute__((ext_vector_type(2)));
typedef unsigned u32x4 __attribute__((ext_vector_type(4)));
typedef int i32x4 __attribute__((ext_vector_type(4)));
typedef int i32x8 __attribute__((ext_vector_type(8)));
typedef __bf16 bf16x2_t __attribute__((ext_vector_type(2)));

constexpr int D = 1024, BATCH = 4, SEQ = 8192, M = BATCH * SEQ;
constexpr int SWA_N = 1536, DIFF_N = 3072;
constexpr int NEXP = 32, DEXP = 512;
constexpr float LOG2E = 1.4426950408889634f;
constexpr float QSCALE = 0.125f * LOG2E;
constexpr float LAMBDA_INIT = 0.35550906759f;
constexpr int NWAVES = 8;

constexpr size_t MiB = 1u << 20;
constexpr size_t WS_CTL = 0, CTL_ZERO_BYTES = 1 * MiB;
constexpr size_t WS_SWA_QKV_T = 1 * MiB, WS_SWA_WO_T = 4 * MiB, WS_DIFF_QKV_T = 6 * MiB, WS_DIFF_WO_T = 12 * MiB;
constexpr size_t WS_WR = 14 * MiB;
constexpr size_t WS_RSTD = 14 * MiB + 512 * 1024;
constexpr size_t WS_LTOK = 15 * MiB, WS_LW = 19 * MiB, WS_TINFO = 23 * MiB;
constexpr size_t WS_WMOE = 24 * MiB;
constexpr size_t WS_XN = 216 * MiB;
constexpr size_t WS_SCR = 280 * MiB;
constexpr size_t WS_QKV = WS_SCR, WS_O = WS_SCR + 192 * MiB, WS_Y = WS_SCR, WS_H = WS_SCR + 144 * MiB;
constexpr size_t WS_END = 536 * MiB;
constexpr int CW_BAR = 4096;
constexpr int CW_CNT = 16384;
constexpr int CW_KMAX = 24576;

constexpr int RING_BYTES = 131072;
constexpr int LDSCTL_OFF = RING_BYTES;
constexpr int MISC_OFF = LDSCTL_OFF + 320;
constexpr int TP_OFF = LDSCTL_OFF + 1024;
constexpr int STASH_OFF = LDSCTL_OFF + 2048;
constexpr int LDS_BYTES = 147456;

__device__ __forceinline__ unsigned f2bf(float f) { unsigned u = __builtin_bit_cast(unsigned, f); return (u + 0x7fffu + ((u >> 16) & 1u)) >> 16; }
__device__ __forceinline__ unsigned pk2(float lo, float hi) { return f2bf(lo) | (f2bf(hi) << 16); }
__device__ __forceinline__ unsigned cvtpk(float lo, float hi) { f32x2 v = {lo, hi}; bf16x2_t b = __builtin_convertvector(v, bf16x2_t); return __builtin_bit_cast(unsigned, b); }
__device__ __forceinline__ unsigned pk4_fp8(float a, float b, float c, float d) {
    a = __builtin_fminf(__builtin_fmaxf(a, -448.f), 448.f); b = __builtin_fminf(__builtin_fmaxf(b, -448.f), 448.f); c = __builtin_fminf(__builtin_fmaxf(c, -448.f), 448.f); d = __builtin_fminf(__builtin_fmaxf(d, -448.f), 448.f);
    int r = 0; r = __builtin_amdgcn_cvt_pk_fp8_f32(a, b, r, false); r = __builtin_amdgcn_cvt_pk_fp8_f32(c, d, r, true); return (unsigned)r; }
__device__ __forceinline__ float bf2f(unsigned short h) { return __builtin_bit_cast(float, (unsigned)h << 16); }
__device__ __forceinline__ int relaunder(int x) { asm volatile("" : "+v"(x)); return x; }
__device__ __forceinline__ int lane_id() { return (int)__builtin_amdgcn_mbcnt_hi(~0u, __builtin_amdgcn_mbcnt_lo(~0u, 0u)); }
__device__ __forceinline__ float wave_sum(float v) {
#pragma unroll
    for (int o = 1; o < 64; o <<= 1) v += __shfl_xor(v, o);
    return v;
}

namespace pg8 {
constexpr int BM = 256, BK = 64, HALF = 128, HTB = HALF * BK * 2, STAGE_BYTES = 8 * HTB, NXCD = 8, WGM = 8;
__host__ __device__ __forceinline__ int lds_byte(int r, int c) { const int st = (r >> 4) * 2 + (c >> 5), rr = r & 15, cc = c & 31, ob = rr * 64 + cc * 2; return st * 1024 + (ob ^ (((ob >> 9) & 1) << 5)); }
__host__ __device__ __forceinline__ void stage_rc(int b, int& R, int& C) { const int st = b / 1024, sb = b % 1024, swz = sb ^ (((sb >> 9) & 1) << 5); R = (st >> 1) * 16 + swz / 64; C = (st & 1) * 32 + (swz % 64) / 2; }
__host__ __device__ __forceinline__ int perm32(int rho) { const int n = rho >> 4, i = rho & 15; return 8 * (i >> 2) + 4 * n + (i & 3); }

struct Unit { int pm, pn, e, t, pnl; };
struct Gemm { const bf16_t* A; const bf16_t* Bt; int K; unsigned sw = 0x7f7f7f7fu, sx = 0x7f7f7f7fu; };

struct DenseOrder {
    int nM, nN, nwg, G, c;
    __device__ void init(int Mr, int N, int G_, int c_) { nM = Mr / BM; nN = N / BM; nwg = nM * nN; G = G_; c = c_; }
    __device__ bool next(int i, Unit& u) const {
        const long L = (long)i * G + c; if (L >= nwg) return false;
        int wgid = (int)L; { const int q = nwg / NXCD, r = nwg % NXCD, xcd = wgid % NXCD, off = wgid / NXCD; wgid = (xcd < r ? xcd * (q + 1) : r * (q + 1) + (xcd - r) * q) + off; }
        const int nig = WGM * nN, gid = wgid / nig, fm = gid * WGM, gsz = (nM - fm) < WGM ? (nM - fm) : WGM;
        u.pm = fm + ((wgid % nig) % gsz); u.pn = (wgid % nig) / gsz; u.e = 0; u.t = 0; u.pnl = u.pn; return true;
    }
    __device__ __forceinline__ int token(const Unit&, int) const { return 0; }
};
struct MoeOrder {
    const LAS int* TP; const LAS int* CNT; const int* ltok; int G, c, pn_mul, pn_add;
    __device__ bool next(int i, Unit& u) const {
        const int ntile = __builtin_amdgcn_readfirstlane(TP[32]); const int nwg = ntile * 4;
        const long L = (long)i * G + c; if (L >= nwg) return false;
        int wgid = (int)L; { const int q = nwg / NXCD, r = nwg % NXCD, xcd = wgid % NXCD, off = wgid / NXCD; wgid = (xcd < r ? xcd * (q + 1) : r * (q + 1) + (xcd - r) * q) + off; }
        const int tau = wgid >> 2; int e = 0;
#pragma nounroll
        while (e < 31 && __builtin_amdgcn_readfirstlane(TP[e + 1]) <= tau) ++e;
        u.pm = tau; u.e = e; u.t = tau - __builtin_amdgcn_readfirstlane(TP[e]); u.pnl = wgid & 3; u.pn = e * pn_mul + pn_add + u.pnl; return true;
    }
    __device__ __forceinline__ int token(const Unit& u, int r) const { const int idx = u.t * 256 + r; return idx < CNT[u.e] ? ltok[(size_t)u.e * M + idx] : 0; }
};

struct EpiQKV {
    static constexpr bool PERM = true;
    bf16_t* O; int ldc; int qcols; float qscale; unsigned* kmaxsq;
    __device__ __forceinline__ void operator()(const f32x4 (&acc)[2][2][4][2], const Unit& u, int wr, int wc, int fr, int fq) const {
        asm volatile("" : "+v"(fr), "+v"(fq));
        const int row0 = u.pm * BM + wr * 64 + fr, colt = u.pn * BM; const float sc = colt < qcols ? qscale : 1.f;
        const int col0 = colt + wc * 32 + 8 * fq;
#pragma unroll
        for (int ai = 0; ai < 2; ++ai)
#pragma unroll
            for (int m = 0; m < 4; ++m) { bf16_t* rowp = O + (size_t)(row0 + ai * HALF + m * 16) * ldc + col0;
#pragma unroll
                for (int bj = 0; bj < 2; ++bj) { const f32x4 v0 = acc[ai][bj][m][0] * sc, v1 = acc[ai][bj][m][1] * sc;
                    u32x4 w; w.x = cvtpk(v0[0], v0[1]); w.y = cvtpk(v0[2], v0[3]); w.z = cvtpk(v1[0], v1[1]); w.w = cvtpk(v1[2], v1[3]);
                    *(u32x4*)(rowp + bj * HALF) = w; } }
        if (kmaxsq != nullptr && colt >= 1024 && colt < 2048) {
#pragma unroll
            for (int bj = 0; bj < 2; ++bj) { float mx = 0.f;
#pragma unroll
                for (int ai = 0; ai < 2; ++ai)
#pragma unroll
                    for (int m = 0; m < 4; ++m) { const f32x4 v0 = acc[ai][bj][m][0], v1 = acc[ai][bj][m][1];
                        float ss = (v0[0] * v0[0] + v0[1] * v0[1]) + (v0[2] * v0[2] + v0[3] * v0[3]) + (v1[0] * v1[0] + v1[1] * v1[1]) + (v1[2] * v1[2] + v1[3] * v1[3]);
                        ss += __shfl_xor(ss, 16); ss += __shfl_xor(ss, 32); mx = __builtin_fmaxf(mx, ss); }
                mx = __builtin_fmaxf(mx, __shfl_xor(mx, 1)); mx = __builtin_fmaxf(mx, __shfl_xor(mx, 2)); mx = __builtin_fmaxf(mx, __shfl_xor(mx, 4)); mx = __builtin_fmaxf(mx, __shfl_xor(mx, 8));
                if (fr == 0 && fq == 0) atomicMax(kmaxsq + (u.pm >> 5) * 32 + ((colt - 1024 + bj * HALF + wc * 32) >> 5), __float_as_uint(mx)); }
        }
    }
};
struct EpiResid {
    static constexpr bool PERM = false;
    const float* base; float* out;
    __device__ __forceinline__ void operator()(const f32x4 (&acc)[2][2][4][2], const Unit& u, int wr, int wc, int fr, int fq) const {
        asm volatile("" : "+v"(fr), "+v"(fq));
        const int col0 = u.pn * BM + wc * 32 + 4 * fq;
#pragma unroll
        for (int ai = 0; ai < 2; ++ai)
#pragma unroll
            for (int m = 0; m < 4; ++m) { const size_t off = (size_t)(u.pm * BM + ai * HALF + wr * 64 + m * 16 + fr) * D + col0;
#pragma unroll
                for (int bj = 0; bj < 2; ++bj)
#pragma unroll
                    for (int n = 0; n < 2; ++n) { const size_t idx = off + bj * HALF + n * 16; const f32x4 b = *(const f32x4*)(base + idx); *(f32x4*)(out + idx) = b + acc[ai][bj][m][n]; } }
    }
};
__device__ __forceinline__ float silu_mul(float g, float u) { return g * u * __builtin_amdgcn_rcpf(1.f + __builtin_amdgcn_exp2f(-g * LOG2E)); }
template <bool F8>
struct EpiSwiGLU {
    static constexpr bool PERM = true;
    bf16_t* H; const int* ltok; const float* rstd_tok; const LAS int* CNT;
    __device__ __forceinline__ void operator()(const f32x4 (&acc)[2][2][4][2], const Unit& u, int wr, int wc, int fr, int fq) const {
        asm volatile("" : "+v"(fr), "+v"(fq));
        const int colh = u.pnl * 128 + wc * 32 + 8 * fq; const int cnt = CNT[u.e];
#pragma unroll
        for (int ai = 0; ai < 2; ++ai)
#pragma unroll
            for (int m = 0; m < 4; ++m) { const int rl = ai * HALF + wr * 64 + m * 16 + fr; const size_t row = (size_t)u.pm * BM + rl;
                const int idx = u.t * 256 + rl; const int tok = idx < cnt ? ltok[(size_t)u.e * M + idx] : 0; const float rs = rstd_tok[tok];
                const f32x4 g0 = acc[ai][0][m][0] * rs, g1 = acc[ai][0][m][1] * rs, u0 = acc[ai][1][m][0] * rs, u1 = acc[ai][1][m][1] * rs;
                if constexpr (F8) {
                    u32x2 w; w.x = pk4_fp8(8.f * silu_mul(g0[0], u0[0]), 8.f * silu_mul(g0[1], u0[1]), 8.f * silu_mul(g0[2], u0[2]), 8.f * silu_mul(g0[3], u0[3]));
                    w.y = pk4_fp8(8.f * silu_mul(g1[0], u1[0]), 8.f * silu_mul(g1[1], u1[1]), 8.f * silu_mul(g1[2], u1[2]), 8.f * silu_mul(g1[3], u1[3]));
                    *(u32x2*)((unsigned char*)H + row * DEXP + colh) = w;
                } else {
                    u32x4 w; w.x = cvtpk(silu_mul(g0[0], u0[0]), silu_mul(g0[1], u0[1])); w.y = cvtpk(silu_mul(g0[2], u0[2]), silu_mul(g0[3], u0[3]));
                    w.z = cvtpk(silu_mul(g1[0], u1[0]), silu_mul(g1[1], u1[1])); w.w = cvtpk(silu_mul(g1[2], u1[2]), silu_mul(g1[3], u1[3]));
                    *(u32x4*)(H + row * DEXP + colh) = w; }
            }
    }
};
struct EpiDown {
    static constexpr bool PERM = true;
    bf16_t* Y; const float* lw;
    __device__ __forceinline__ void operator()(const f32x4 (&acc)[2][2][4][2], const Unit& u, int wr, int wc, int fr, int fq) const {
        asm volatile("" : "+v"(fr), "+v"(fq));
        const int col0 = u.pnl * BM + wc * 32 + 8 * fq;
#pragma unroll
        for (int ai = 0; ai < 2; ++ai)
#pragma unroll
            for (int m = 0; m < 4; ++m) { const int rl = ai * HALF + wr * 64 + m * 16 + fr; const size_t row = (size_t)u.pm * BM + rl;
                const float sc = lw[(size_t)u.e * M + u.t * 256 + rl];
#pragma unroll
                for (int bj = 0; bj < 2; ++bj) { const f32x4 v0 = acc[ai][bj][m][0] * sc, v1 = acc[ai][bj][m][1] * sc;
                    u32x4 w; w.x = cvtpk(v0[0], v0[1]); w.y = cvtpk(v0[2], v0[3]); w.z = cvtpk(v1[0], v1[1]); w.w = cvtpk(v1[2], v1[3]);
                    *(u32x4*)(Y + row * D + col0 + bj * HALF) = w; } }
    }
};

template <class Epi, class Sched, bool GATHER, bool ALIGN_EPI, bool FP8 = false>
__device__ __forceinline__ void gemm_phase(LAS unsigned char* lds, const Gemm g, const Sched& S, const Epi& E, const int wid, const int lane) {
    const int tid = wid * 64 + lane, wr = wid >> 2, wc = wid & 3, fr = lane & 15, fq = lane >> 4;
    const int K = g.K, nt = K / BK;
    int Rr[2], Cc[2]; unsigned voffB[2];
#pragma unroll
    for (int i = 0; i < 2; ++i) { int R, C; stage_rc(tid * 16 + i * 8192, R, C); Rr[i] = R; Cc[i] = C; const int Rb = Epi::PERM ? ((R & ~31) + perm32(R & 31)) : R; voffB[i] = (unsigned)(Rb * K + C) * 2u; }
    const size_t kstep = (size_t)(BK * 2);
    const size_t hstep = (size_t)HALF * K * 2;
    const size_t tstep = 2 * hstep;
    const unsigned ldsw = (unsigned)wid * 1024u;
    const size_t R64 = (size_t)64 * K * 2;
    const size_t H1 = GATHER ? 0 : hstep;
    const int aoff = FP8 ? lds_byte(wr * 64 + fr, (fq >> 1) * 32 + (fq & 1) * 16) : lds_byte(wr * 64 + fr, fq * 8), boff = FP8 ? lds_byte(wc * 32 + fr, (fq >> 1) * 32 + (fq & 1) * 16) : lds_byte(wc * 32 + fr, fq * 8);

#define PG8_SA(b, h) (((b) * 2 + (h)) * HTB)
#define PG8_SB(b, h) ((4 + (b) * 2 + (h)) * HTB)
#define PG8_STAGE2(bufoff, gbase, o0, o1) do { \
        __builtin_amdgcn_global_load_lds((const unsigned*)((const char*)(gbase) + (o0)), (LAS unsigned*)(lds + (bufoff) + ldsw), 16, 0, 0); \
        __builtin_amdgcn_global_load_lds((const unsigned*)((const char*)(gbase) + (o1)), (LAS unsigned*)(lds + (bufoff) + ldsw + 8192), 16, 0, 0); } while (0)
#define PG8_STAGEB(bufoff, gbase) do {   \
        __builtin_amdgcn_global_load_lds((const unsigned*)((const char*)(gbase) + voffB[0]), (LAS unsigned*)(lds + (bufoff) + ldsw), 16, 0, 0); \
        __builtin_amdgcn_global_load_lds((const unsigned*)((const char*)(gbase) + R64 + voffB[0]), (LAS unsigned*)(lds + (bufoff) + ldsw + 8192), 16, 0, 0); } while (0)
#define PG8_LDA(dst, b, h) do { if constexpr (FP8) { _Pragma("unroll") for (int m = 0; m < 4; ++m) dst##8[m] = *(const LAS i32x8*)(lds + PG8_SA(b, h) + aoff + m * 2048); } \
        else { _Pragma("unroll") for (int m = 0; m < 4; ++m) _Pragma("unroll") for (int k = 0; k < 2; ++k) dst[m][k] = *(const LAS bf16x8*)(lds + PG8_SA(b, h) + aoff + m * 2048 + k * 1024); } } while (0)
#define PG8_LDB(dst, b, h) do { if constexpr (FP8) { _Pragma("unroll") for (int n = 0; n < 2; ++n) dst##8[n] = *(const LAS i32x8*)(lds + PG8_SB(b, h) + boff + n * 2048); } \
        else { _Pragma("unroll") for (int n = 0; n < 2; ++n) _Pragma("unroll") for (int k = 0; k < 2; ++k) dst[n][k] = *(const LAS bf16x8*)(lds + PG8_SB(b, h) + boff + n * 2048 + k * 1024); } } while (0)
#define PG8_CAT8(x) __builtin_shufflevector(__builtin_bit_cast(i32x4, (x)[0]), __builtin_bit_cast(i32x4, (x)[1]), 0, 1, 2, 3, 4, 5, 6, 7)
#define PG8_MMA(ai, bj, At, Bt) do { if constexpr (FP8) __builtin_amdgcn_sched_barrier(0); __builtin_amdgcn_s_setprio(1); _Pragma("unroll") for (int m = 0; m < 4; ++m) _Pragma("unroll") for (int n = 0; n < 2; ++n) { \
        if constexpr (FP8) acc[ai][bj][m][n] = __builtin_amdgcn_mfma_scale_f32_16x16x128_f8f6f4(Bt##8[n], At##8[m], acc[ai][bj][m][n], 0, 0, 0, (int)g.sw, 0, (int)g.sx); \
        else { _Pragma("unroll") for (int k = 0; k < 2; ++k) acc[ai][bj][m][n] = __builtin_amdgcn_mfma_f32_16x16x32_bf16(Bt[n][k], At[m][k], acc[ai][bj][m][n], 0, 0, 0); } } \
        if constexpr (FP8) { _Pragma("unroll") for (int m = 0; m < 4; ++m) _Pragma("unroll") for (int n = 0; n < 2; ++n) asm volatile("" : "+v"(acc[ai][bj][m][n])); }   \
        __builtin_amdgcn_s_setprio(0); if constexpr (FP8) __builtin_amdgcn_sched_barrier(0); } while (0)
#define PG8_WAIT_V(n) asm volatile("s_waitcnt vmcnt(" #n ")" ::: "memory")
#define PG8_WAIT_L(n) asm volatile("s_waitcnt lgkmcnt(" #n ")" ::: "memory")
#define PG8_BAR __builtin_amdgcn_s_barrier()
#define PG8_SCHED __builtin_amdgcn_sched_barrier(0)
    Unit cur, nxt; int ui = 0;
    if (!S.next(0, cur)) return;
    unsigned oc00, oc01, oc10, oc11;
    LAS u32x4* stash = (LAS u32x4*)(lds + (STASH_OFF - 0) ) + tid;
    if constexpr (GATHER) {
        oc00 = (unsigned)(S.token(cur, Rr[0]) * K + Cc[0]) * 2u; oc01 = (unsigned)(S.token(cur, Rr[1]) * K + Cc[1]) * 2u;
        oc10 = (unsigned)(S.token(cur, 128 + Rr[0]) * K + Cc[0]) * 2u; oc11 = (unsigned)(S.token(cur, 128 + Rr[1]) * K + Cc[1]) * 2u;
    } else {
        oc00 = (unsigned)(Rr[0] * K + Cc[0]) * 2u; oc01 = (unsigned)(Rr[1] * K + Cc[1]) * 2u; oc10 = oc00; oc11 = oc01;
    }
    f32x4 acc[2][2][4][2];
#pragma unroll
    for (int a = 0; a < 2; ++a)
#pragma unroll
        for (int b = 0; b < 2; ++b)
#pragma unroll
            for (int m = 0; m < 4; ++m)
#pragma unroll
                for (int n = 0; n < 2; ++n) acc[a][b][m][n] = (f32x4){0.f, 0.f, 0.f, 0.f};
    bf16x8 At[4][2], B0[2][2], B1[2][2];
    i32x8 At8[4], B08[2], B18[2];
    const char* cA = GATHER ? (const char*)g.A : (const char*)g.A + (size_t)cur.pm * tstep; const char* cB = (const char*)g.Bt + (size_t)cur.pn * tstep;
    PG8_STAGEB(PG8_SB(0, 0), cB); PG8_STAGEB(PG8_SB(0, 1), cB + hstep); PG8_STAGE2(PG8_SA(0, 0), cA, oc00, oc01); PG8_STAGE2(PG8_SA(0, 1), cA + H1, oc10, oc11);
    if (wr == 1) PG8_BAR;
    PG8_WAIT_V(2); PG8_BAR;
    PG8_STAGEB(PG8_SB(1, 0), cB + kstep); PG8_STAGE2(PG8_SA(1, 0), cA + kstep, oc00, oc01); PG8_STAGEB(PG8_SB(1, 1), cB + hstep + kstep);
    PG8_WAIT_V(6); PG8_BAR;
    for (;;) {
        const bool has_next = S.next(ui + 1, nxt);
        const char* nA = has_next ? (GATHER ? (const char*)g.A : (const char*)g.A + (size_t)nxt.pm * tstep) : cA; const char* nB = has_next ? (const char*)g.Bt + (size_t)nxt.pn * tstep : cB;
        if constexpr (GATHER) {
            u32x4 nx = {oc00, oc01, oc10, oc11};
            if (has_next) { int R0, C0, R1, C1; stage_rc(tid * 16, R0, C0); stage_rc(tid * 16 + 8192, R1, C1);
                nx.x = (unsigned)(S.token(nxt, R0) * K + C0) * 2u; nx.y = (unsigned)(S.token(nxt, R1) * K + C1) * 2u;
                nx.z = (unsigned)(S.token(nxt, 128 + R0) * K + C0) * 2u; nx.w = (unsigned)(S.token(nxt, 128 + R1) * K + C1) * 2u; }
            *stash = nx;
        }
        for (int t = 0; t < nt; t += 2) {
            const bool last = (t == nt - 2);
            const char* a1 = cA + (size_t)(t + 1) * kstep;
            const char* a2 = last ? nA : cA + (size_t)(t + 2) * kstep; const char* b2 = last ? nB : cB + (size_t)(t + 2) * kstep;
            const char* a3 = a2 + kstep; const char* b3 = b2 + kstep;
            unsigned x00 = oc00, x01 = oc01, x10 = oc10, x11 = oc11;
            if constexpr (GATHER) { if (last) { const u32x4 nx = *stash; x00 = nx.x; x01 = nx.y; x10 = nx.z; x11 = nx.w; } }
            PG8_LDB(B0, 0, 0); PG8_LDB(B1, 0, 1); PG8_SCHED; PG8_LDA(At, 0, 0); PG8_STAGE2(PG8_SA(1, 1), a1 + H1, oc10, oc11);
            PG8_WAIT_V(8); PG8_WAIT_L(0); PG8_BAR; PG8_MMA(0, 0, At, B0); PG8_MMA(0, 1, At, B1); PG8_BAR; PG8_SCHED;
            PG8_LDA(At, 0, 1); PG8_STAGEB(PG8_SB(0, 0), b2); PG8_STAGEB(PG8_SB(0, 1), b2 + hstep); PG8_STAGE2(PG8_SA(0, 0), a2, x00, x01);
            PG8_WAIT_V(8); PG8_WAIT_L(0); PG8_BAR; PG8_MMA(1, 0, At, B0); PG8_MMA(1, 1, At, B1); PG8_BAR; PG8_SCHED;
            PG8_LDB(B0, 1, 0); PG8_LDB(B1, 1, 1); PG8_SCHED; PG8_LDA(At, 1, 0); PG8_STAGE2(PG8_SA(0, 1), a2 + H1, x10, x11);
            PG8_WAIT_V(8); PG8_WAIT_L(0); PG8_BAR; PG8_MMA(0, 0, At, B0); PG8_MMA(0, 1, At, B1); PG8_BAR; PG8_SCHED;
            PG8_LDA(At, 1, 1); PG8_STAGEB(PG8_SB(1, 0), b3); PG8_STAGEB(PG8_SB(1, 1), b3 + hstep); PG8_STAGE2(PG8_SA(1, 0), a3, x00, x01);
            PG8_WAIT_V(8); PG8_WAIT_L(0); PG8_BAR; PG8_MMA(1, 0, At, B0); PG8_MMA(1, 1, At, B1); PG8_BAR; PG8_SCHED;
        }
        if constexpr (ALIGN_EPI) { if (wr == 0) PG8_BAR; }
        E(acc, cur, wr, wc, fr, fq);
        if (!has_next) break;
#pragma unroll
        for (int a = 0; a < 2; ++a)
#pragma unroll
            for (int b = 0; b < 2; ++b)
#pragma unroll
                for (int m = 0; m < 4; ++m)
#pragma unroll
                    for (int n = 0; n < 2; ++n) acc[a][b][m][n] = (f32x4){0.f, 0.f, 0.f, 0.f};
        cur = nxt; cA = nA; cB = nB; ++ui;
        if constexpr (GATHER) { const u32x4 nx = *stash; oc00 = nx.x; oc01 = nx.y; oc10 = nx.z; oc11 = nx.w; }
        if constexpr (ALIGN_EPI) { if (wr == 1) PG8_BAR; }
    }
    PG8_WAIT_V(0);
    if constexpr (!ALIGN_EPI) { if (wr == 0) PG8_BAR; }
    PG8_BAR;
#undef PG8_SA
#undef PG8_SB
#undef PG8_STAGE2
#undef PG8_STAGEB
#undef PG8_LDA
#undef PG8_LDB
#undef PG8_MMA
#undef PG8_CAT8
#undef PG8_WAIT_V
#undef PG8_WAIT_L
#undef PG8_BAR
#undef PG8_SCHED
}
}

namespace att {
constexpr int NSLOT = 3;
constexpr float THR = 8.0f;
__device__ __forceinline__ void glds16(const void* gsrc, unsigned lds_dst) { unsigned keep;
    asm volatile("s_mov_b32 %0, m0\n\ts_mov_b32 m0, %2\n\ts_nop 0\n\tglobal_load_lds_dwordx4 %1, off\n\ts_mov_b32 m0, %0" : "=&s"(keep) : "v"(gsrc), "s"(lds_dst) : "memory"); }
#define ATT_WAIT_BAR(N) asm volatile("s_waitcnt vmcnt(" #N ") lgkmcnt(0)\n\ts_barrier" ::: "memory")
typedef LAS const char* lds_cptr;
typedef short v4i16_t __attribute__((ext_vector_type(4)));
__device__ __forceinline__ s16x4 vtr(lds_cptr p) { return __builtin_bit_cast(s16x4, __builtin_amdgcn_ds_read_tr16_b64_v4i16((LAS v4i16_t*)p)); }
__device__ __forceinline__ float swap_max(float m) { auto rr = __builtin_amdgcn_permlane32_swap(__float_as_uint(m), __float_as_uint(m), false, false); return __builtin_fmaxf(__uint_as_float(rr[0]), __uint_as_float(rr[1])); }
__device__ __forceinline__ float swap_sum(float m) { auto rr = __builtin_amdgcn_permlane32_swap(__float_as_uint(m), __float_as_uint(m), false, false); return __uint_as_float(rr[0]) + __uint_as_float(rr[1]); }
__device__ __forceinline__ float max3f(float a, float b, float c) { float r; asm("v_max3_f32 %0, %1, %2, %3" : "=v"(r) : "v"(a), "v"(b), "v"(c)); return r; }
template <unsigned KB> __device__ __forceinline__ float fmamk(float a, float c) { float r; asm("v_fmamk_f32 %0, %1, %2, %3" : "=v"(r) : "v"(a), "i"(KB), "v"(c)); return r; }
#define CRF(r) ((float)(((r) & 3) + 8 * ((r) >> 2)))
#define CRI(r) (((r) & 3) + 8 * ((r) >> 2))

template <int MODE> struct Cfg;
template <> struct Cfg<0> { static constexpr int DV32 = 2, NK = 1, SLOTB = 16384, VOFF = 8192, PITCH = SWA_N, NVP = 1; };
template <> struct Cfg<1> { static constexpr int DV32 = 4, NK = 2, SLOTB = 32768, VOFF = 16384, PITCH = DIFF_N, NVP = 2; };

template <int MODE>
__device__ __forceinline__ void tile_step(lds_cptr kp, lds_cptr vp, const bf16x8 (&qr)[4], f32x16 (&o)[Cfg<MODE>::DV32], float& mhat, float& l, bool& first,
                                          const float slope2, const int dq_i, const int kind, const int hi) {
    constexpr int DV32 = Cfg<MODE>::DV32;
    f32x16 p0, p1;
    const float dq = (float)dq_i, nm = -mhat;
    {
        const float sl = kind == 2 ? 0.f : (kind == 0 ? slope2 : -slope2); const float base0 = __builtin_fmaf(-sl, dq, nm);
#pragma unroll
        for (int r = 0; r < 16; ++r) { p0[r] = __builtin_fmaf(sl, CRF(r), base0); p1[r] = __builtin_fmaf(sl, CRF(r) + 32.f, base0); }
    }
#pragma unroll
    for (int d0 = 0; d0 < 4; ++d0) {
        const bf16x8 b0 = *(const LAS bf16x8*)(kp + d0 * 2048);
        const bf16x8 b1 = *(const LAS bf16x8*)(kp + d0 * 2048 + 512);
        p0 = __builtin_amdgcn_mfma_f32_32x32x16_bf16(b0, qr[d0], p0, 0, 0, 0);
        p1 = __builtin_amdgcn_mfma_f32_32x32x16_bf16(b1, qr[d0], p1, 0, 0, 0);
    }
    if (kind == 2) {
#pragma unroll
        for (int r = 0; r < 16; ++r) {
            const float e0 = __builtin_fabsf(dq - CRF(r)), e1 = __builtin_fabsf(dq - CRF(r) - 32.f);
            if (MODE == 0) { p0[r] = e0 <= 128.f ? __builtin_fmaf(-slope2, e0, p0[r]) : -INFINITY; p1[r] = e1 <= 128.f ? __builtin_fmaf(-slope2, e1, p1[r]) : -INFINITY; }
            else { p0[r] = __builtin_fmaf(-slope2, e0, p0[r]); p1[r] = __builtin_fmaf(-slope2, e1, p1[r]); }
        }
    }
    float rm = __builtin_fmaxf(p0[0], p1[0]);
#pragma unroll
    for (int r = 1; r < 16; ++r) rm = __builtin_fmaxf(rm, __builtin_fmaxf(p0[r], p1[r]));
    rm = swap_max(rm);
    if (first || __any(rm > THR)) {
        const float dl = first ? rm : __builtin_fmaxf(rm, 0.f);
        mhat += dl;
#pragma unroll
        for (int r = 0; r < 16; ++r) { p0[r] -= dl; p1[r] -= dl; }
        if (!first) {
            const float f = __builtin_amdgcn_exp2f(-dl); l *= f;
#pragma unroll
            for (int r = 0; r < 16; ++r) { int h4_ = 4 * hi; asm volatile("" : "+v"(h4_)); const float fr_ = __shfl(f, CRI(r) + h4_);
#pragma unroll
                for (int d0 = 0; d0 < DV32; ++d0) o[d0][r] *= fr_; }
        }
        first = false;
    }
    float sacc = 0.f;
    u32x4 pw[4];
#pragma unroll
    for (int s = 0; s < 2; ++s) {
        float e[8];
#pragma unroll
        for (int j = 0; j < 8; ++j) { e[j] = __builtin_amdgcn_exp2f(p0[8 * s + j]); sacc += e[j]; }
        pw[s] = (u32x4){cvtpk(e[0], e[1]), cvtpk(e[2], e[3]), cvtpk(e[4], e[5]), cvtpk(e[6], e[7])};
    }
#pragma unroll
    for (int s = 0; s < 2; ++s) {
        float e[8];
#pragma unroll
        for (int j = 0; j < 8; ++j) { e[j] = __builtin_amdgcn_exp2f(p1[8 * s + j]); sacc += e[j]; }
        pw[2 + s] = (u32x4){cvtpk(e[0], e[1]), cvtpk(e[2], e[3]), cvtpk(e[4], e[5]), cvtpk(e[6], e[7])};
    }
    l += sacc;
#pragma unroll
    for (int d0 = 0; d0 < DV32; ++d0) {
#pragma unroll
        for (int ks = 0; ks < 4; ++ks) {
            const s16x4 lo = vtr(vp + d0 * 4096 + ks * 1024), hh = vtr(vp + d0 * 4096 + ks * 1024 + 512);
            const bf16x8 vf = (bf16x8){lo[0], lo[1], lo[2], lo[3], hh[0], hh[1], hh[2], hh[3]};
            o[d0] = __builtin_amdgcn_mfma_f32_32x32x16_bf16(__builtin_bit_cast(bf16x8, pw[ks]), vf, o[d0], 0, 0, 0);
        }
    }
}

struct DiffConsts { float lam_full; const float* subln; };

template <int MODE>
__device__ __forceinline__ void attn_unit(const int b, const int hh, const int qb, const bf16_t* __restrict__ QKV, bf16_t* __restrict__ O, const float* __restrict__ sink,
                                          const DiffConsts dc, LAS unsigned char* shm, const int wid, const int lane_in) {
    typedef Cfg<MODE> C;
    constexpr int DV32 = C::DV32, PITCH = C::PITCH;
    int lane = lane_in; asm volatile("" : "+v"(lane));
    const int r32 = lane & 31, hi = lane >> 5;
    int iw, qcol, kcol, vcol, t_lo, NT, hq = 0, cmap = 0, qs;
    float slope2;
    if (MODE == 0) { const int g = wid >> 1; qs = wid & 1; hq = hh * 4 + g; iw = qb * 64 + qs * 32; qcol = hq * 64; kcol = 1024 + hh * 64; vcol = 1280 + hh * 64;
        t_lo = qb - 2 < 0 ? 0 : qb - 2; const int t_hi = qb + 2 > 127 ? 127 : qb + 2; NT = t_hi - t_lo + 1; slope2 = __builtin_amdgcn_exp2f(-0.5f * (float)(hq + 1)) * LOG2E; }
    else { qs = wid & 3; cmap = wid >> 2; iw = qb * 128 + qs * 32; qcol = (hh * 2 + cmap) * 64; kcol = 1024 + hh * 128; vcol = 2048 + hh * 128; t_lo = 0; NT = SEQ / 64;
        slope2 = __builtin_amdgcn_exp2f(-(float)(hh + 1)) * LOG2E; }
    const bf16_t* base = QKV + (size_t)b * SEQ * PITCH;
    const unsigned lds0 = (unsigned)(uintptr_t)shm;
    const unsigned koff = (unsigned)(lane * PITCH + kcol + wid * 8) * 2u;
    const unsigned voff = (unsigned)((16 * (wid & 3) + (lane >> 2)) * PITCH + vcol + (wid >> 2) * 32 + (lane & 3) * 8) * 2u;
    const unsigned kdst = lds0 + wid * 1024, vdst = lds0 + C::VOFF + wid * 1024;
#define ATT_DMA(t, slot) do { const char* tb_ = (const char*)base + (size_t)(t) * 64 * PITCH * 2; const unsigned so_ = (unsigned)(slot) * C::SLOTB; \
        glds16(tb_ + koff, (unsigned)__builtin_amdgcn_readfirstlane(kdst + so_)); \
        if (MODE == 1) glds16(tb_ + koff + 128, (unsigned)__builtin_amdgcn_readfirstlane(kdst + so_ + 8192)); \
        glds16(tb_ + voff, (unsigned)__builtin_amdgcn_readfirstlane(vdst + so_)); \
        if (MODE == 1) glds16(tb_ + voff + 128, (unsigned)__builtin_amdgcn_readfirstlane(vdst + so_ + 8192)); } while (0)
    ATT_DMA(t_lo, 0);
    if (NT > 1) ATT_DMA(t_lo + 1, 1);
    bf16x8 qr[4];
    { const bf16_t* Qw = base + (size_t)(iw + r32) * PITCH + qcol;
#pragma unroll
      for (int d0 = 0; d0 < 4; ++d0) qr[d0] = *(const bf16x8*)(Qw + d0 * 16 + hi * 8); }
    f32x16 o[DV32];
#pragma unroll
    for (int d0 = 0; d0 < DV32; ++d0)
#pragma unroll
        for (int r = 0; r < 16; ++r) o[d0][r] = 0.f;
    float mhat = 0.f, l = 0.f; bool first = true;
    if (MODE == 0) { mhat = sink[hq] * LOG2E; l = (hi == 0) ? 1.f : 0.f; first = false; }
    const lds_cptr shm3 = (lds_cptr)shm;
    const lds_cptr kp0 = shm3 + (MODE == 1 ? cmap * 8192 : 0) + hi * 1024 + r32 * 16;
    const lds_cptr vp0 = shm3 + C::VOFF + ((lane >> 4) & 1) * 32 + (lane & 3) * 8 + (4 * hi + ((lane & 15) >> 2)) * 64;
    int slot = 0;
    for (int it = 0; it < NT; ++it) {
        if (it + 1 < NT) { if (MODE == 1) { ATT_WAIT_BAR(4); } else { ATT_WAIT_BAR(2); } } else { ATT_WAIT_BAR(0); }
        if (it + 2 < NT) { const int s2 = slot == 0 ? 2 : slot - 1; ATT_DMA(t_lo + it + 2, s2); }
        const int k0 = (t_lo + it) * 64;
        const int kind = (MODE == 0) ? ((t_lo + it == qb - 1) ? 0 : ((t_lo + it == qb + 1) ? 1 : 2)) : ((k0 + 63 < iw) ? 0 : ((k0 > iw + 31) ? 1 : 2));
        tile_step<MODE>(kp0 + slot * C::SLOTB, vp0 + slot * C::SLOTB, qr, o, mhat, l, first, slope2, iw + r32 - k0 - 4 * hi, kind, hi);
        slot = slot == 2 ? 0 : slot + 1;
    }
#undef ATT_DMA
    l = swap_sum(l);
    const float rl = 1.f / l;
    if (MODE == 0) {
        bf16_t* Ow = O + (size_t)(b * SEQ + iw) * D + hq * 64 + r32;
#pragma unroll
        for (int r = 0; r < 16; ++r) { const int row = CRI(r) + 4 * hi; const float rr = __shfl(rl, row);
#pragma unroll
            for (int d0 = 0; d0 < DV32; ++d0) Ow[(size_t)row * D + d0 * 32] = (bf16_t)f2bf(o[d0][r] * rr); }
        ATT_WAIT_BAR(0);
    } else {
        LAS float* cb = (LAS float*)shm + qs * 4096;
        ATT_WAIT_BAR(0);
        if (cmap == 1) {
#pragma unroll
            for (int r = 0; r < 16; ++r) { const int row = CRI(r) + 4 * hi; const float rr = __shfl(rl, row) * dc.lam_full;
#pragma unroll
                for (int d0 = 0; d0 < DV32; ++d0) cb[row * 128 + d0 * 32 + r32] = o[d0][r] * rr; }
        }
        ATT_WAIT_BAR(0);
        if (cmap == 0) {
            bf16_t* Ow = O + (size_t)(b * SEQ + iw) * D + hh * 128 + r32;
            float gsub[DV32];
#pragma unroll
            for (int d0 = 0; d0 < DV32; ++d0) gsub[d0] = dc.subln[d0 * 32 + r32] * (1.f - LAMBDA_INIT);
#pragma unroll
            for (int r = 0; r < 16; ++r) { const int row = CRI(r) + 4 * hi; const float rr = __shfl(rl, row);
                float v[DV32]; float ss = 0.f;
#pragma unroll
                for (int d0 = 0; d0 < DV32; ++d0) { v[d0] = o[d0][r] * rr - cb[row * 128 + d0 * 32 + r32]; ss += v[d0] * v[d0]; }
                ss += __shfl_xor(ss, 1); ss += __shfl_xor(ss, 2); ss += __shfl_xor(ss, 4); ss += __shfl_xor(ss, 8); ss += __shfl_xor(ss, 16);
                const float sc = __builtin_amdgcn_rsqf(ss * (1.f / 128.f) + 1e-5f);
#pragma unroll
                for (int d0 = 0; d0 < DV32; ++d0) Ow[(size_t)row * D + d0 * 32] = (bf16_t)f2bf(v[d0] * sc * gsub[d0]); }
        }
        ATT_WAIT_BAR(0);
    }
}

#define SBAR() __builtin_amdgcn_sched_barrier(0)
#define PIN(x) asm volatile("" : "+v"(x))
#define MF(a, b, c) __builtin_amdgcn_mfma_f32_32x32x16_bf16(a, b, c, 0, 0, 0)
template <int VAR>
__device__ __forceinline__ void diff_unit(const int b, const int hh, const int qb, const bf16_t* __restrict__ QKV, bf16_t* __restrict__ O, const float kmax,
                                          const DiffConsts dc, LAS unsigned char* shm, const int wid, const int lane_in) {
    constexpr int DV32 = 4, PITCH = DIFF_N, KSLOT = 16384, VRING = 4 * 16384;
    int lane = lane_in; asm volatile("" : "+v"(lane));
    const int r32 = lane & 31, hi = lane >> 5;
    const int qs = wid & 3, cmap = wid >> 2, i0 = qb * 128, iw = i0 + qs * 32, qcol = (hh * 2 + cmap) * 64, kcol = 1024 + hh * 128, vcol = 2048 + hh * 128;
    const float slope2 = __builtin_amdgcn_exp2f(-(float)(hh + 1)) * LOG2E;
    const bf16_t* base = QKV + (size_t)b * SEQ * PITCH;
    const unsigned lds0 = (unsigned)(uintptr_t)shm;
    const unsigned koff = (unsigned)(lane * PITCH + kcol + wid * 8) * 2u;
    const unsigned voff = (unsigned)((16 * (wid & 3) + (lane >> 2)) * PITCH + vcol + (wid >> 2) * 32 + (lane & 3) * 8) * 2u;
    const unsigned kdst = lds0 + wid * 1024, vdst = lds0 + VRING + wid * 1024;
#define DMA_K(t, slot) do { const char* tb_ = (const char*)base + (size_t)(t) * 64 * PITCH * 2; const unsigned so_ = (unsigned)(slot) * KSLOT; \
        glds16(tb_ + koff, (unsigned)__builtin_amdgcn_readfirstlane(kdst + so_)); glds16(tb_ + koff + 128, (unsigned)__builtin_amdgcn_readfirstlane(kdst + so_ + 8192)); } while (0)
#define DMA_V(t, slot) do { const char* tb_ = (const char*)base + (size_t)(t) * 64 * PITCH * 2; const unsigned so_ = (unsigned)(slot) * KSLOT; \
        glds16(tb_ + voff, (unsigned)__builtin_amdgcn_readfirstlane(vdst + so_)); glds16(tb_ + voff + 128, (unsigned)__builtin_amdgcn_readfirstlane(vdst + so_ + 8192)); } while (0)
    const int td0 = 2 * qb;
    int nL = td0;
#define TILE_OF(idx) ((idx) < 2 ? td0 + (idx) : ((idx) - 2 < nL ? td0 - 1 - ((idx) - 2) : td0 + 2 + ((idx) - 2 - nL)))
    DMA_K(td0, 0); DMA_V(td0, 0); DMA_K(td0 + 1, 1); DMA_V(td0 + 1, 1); DMA_K(TILE_OF(2), 2);
    bf16x8 qr[4]; float nq2 = 0.f;
    { const bf16_t* Qw = base + (size_t)(iw + r32) * PITCH + qcol;
#pragma unroll
      for (int d0 = 0; d0 < 4; ++d0) { qr[d0] = *(const bf16x8*)(Qw + d0 * 16 + hi * 8);
#pragma unroll
          for (int j = 0; j < 8; ++j) { const float f = bf2f((unsigned short)qr[d0][j]); nq2 += f * f; } } }
    nq2 = swap_sum(nq2);
    f32x16 o[DV32];
#pragma unroll
    for (int d0 = 0; d0 < DV32; ++d0)
#pragma unroll
        for (int r = 0; r < 16; ++r) o[d0][r] = 0.f;
    float mhat = 0.f, l = 0.f; bool first = true;
    const lds_cptr shm3 = (lds_cptr)shm;
    const lds_cptr kp0 = shm3 + cmap * 8192 + hi * 1024 + r32 * 16;
    const lds_cptr vp0 = shm3 + VRING + ((lane >> 4) & 1) * 32 + (lane & 3) * 8 + (4 * hi + ((lane & 15) >> 2)) * 64;
    LAS float* wsf = (LAS float*)(shm + 7 * KSLOT);
    ATT_WAIT_BAR(6);
    DMA_K(TILE_OF(3), 3);
    { const int k0 = td0 * 64; const int kind = (k0 + 63 < iw) ? 0 : ((k0 > iw + 31) ? 1 : 2);
      tile_step<1>(kp0, vp0, qr, o, mhat, l, first, slope2, iw + r32 - k0 - 4 * hi, kind, hi); }
    ATT_WAIT_BAR(4);
    DMA_K(TILE_OF(4), 0); DMA_V(TILE_OF(2), 2);
    { const int k0 = (td0 + 1) * 64; const int kind = (k0 + 63 < iw) ? 0 : ((k0 > iw + 31) ? 1 : 2);
      tile_step<1>(kp0 + KSLOT, vp0 + KSLOT, qr, o, mhat, l, first, slope2, iw + r32 - k0 - 4 * hi, kind, hi); }
    { float a = sqrtf(nq2) * kmax - mhat;
#pragma unroll
      for (int o_ = 1; o_ < 32; o_ <<= 1) a = __builtin_fmaxf(a, __shfl_xor(a, o_));
      if (lane == 0) wsf[wid] = a; }
    ATT_WAIT_BAR(4);
    int NT;
    { float amax = wsf[0];
#pragma unroll
      for (int w = 1; w < 8; ++w) amax = __builtin_fmaxf(amax, wsf[w]);
      const float dist = (64.f + __builtin_fmaxf(amax, 0.f)) / slope2;
      const float lo_f = ((float)(i0 - 63) - dist) * (1.f / 64.f), hi_f = ((float)(i0 + 127) + dist) * (1.f / 64.f);
      int t_lo = lo_f <= 0.f ? 0 : (int)lo_f, t_hi = hi_f >= 127.f ? 127 : (int)hi_f;
      if (t_lo > td0 - 2) t_lo = td0 - 2 < 0 ? 0 : td0 - 2; if (t_hi < td0 + 3) t_hi = td0 + 3 > 127 ? 127 : td0 + 3;
      t_lo = __builtin_amdgcn_readfirstlane(t_lo); t_hi = __builtin_amdgcn_readfirstlane(t_hi);
      nL = td0 - t_lo; NT = 2 + nL + (t_hi - (td0 + 1)); if (VAR & 256) NT = 2; }
    f32x16 xa0, xa1, xb0, xb1; u32x4 pw0, pw1, pw2, pw3; bf16x8 kf0, kf1, kf2, kf3; s16x4 vl0, vh0, vl1, vh1, vl2, vh2, vl3, vh3;
    float sl_n, base_n, rf = 1.f; bool resc = false;
#define KRD(dst, f) do { if ((VAR & 4) && (f) >= 4) break; dst = *(const LAS bf16x8*)(kp_ + ((f) >> 1) * 2048 + ((f) & 1) * 512); } while (0)
#define VRD(lo, hh_, i) do { if ((VAR & 2) && (i) >= 4) break; lo = vtr(vp_ + ((i) >> 2) * 4096 + ((i) & 3) * 1024); hh_ = vtr(vp_ + ((i) >> 2) * 4096 + ((i) & 3) * 1024 + 512); } while (0)
#define KRN(dst, f) dst = *(const LAS bf16x8*)(kn_ + ((f) >> 1) * 2048 + ((f) & 1) * 512)
#define VFR(lo, hh_) (bf16x8){lo[0], lo[1], lo[2], lo[3], hh_[0], hh_[1], hh_[2], hh_[3]}
#define SET_NEXT(idx) do { const int tn_ = TILE_OF(idx); const bool left_ = (idx) - 2 < nL; sl_n = left_ ? slope2 : -slope2; \
        base_n = __builtin_fmaf(-sl_n, (float)(iw + r32 - tn_ * 64 - 4 * hi), -mhat); } while (0)
#define CINIT(X0, X1) do { _Pragma("unroll") for (int r = 0; r < 16; ++r) { X0[r] = __builtin_fmaf(sl_n, CRF(r), base_n); X1[r] = __builtin_fmaf(sl_n, CRF(r) + 32.f, base_n); } } while (0)
#define GA(Sx, KF, qf, RD, P, e, PW, w0, w1) do { Sx = MF(KF, qf, Sx); RD; if (!(VAR & 32)) { sacc += P[e]; sacc += P[e + 1]; sacc += P[e + 2]; sacc += P[e + 3]; PIN(sacc); \
        PW[w0] = cvtpk(P[e], P[e + 1]); PW[w1] = cvtpk(P[e + 2], P[e + 3]); } PIN(PW); SBAR(); } while (0)
#define PHASE_A(S0, S1, P0, P1) do { float sacc = 0.f; \
        GA(S0, kf0, qr[0], KRD(kf0, 4), P0, 0,  pw0, 0, 1); GA(S1, kf1, qr[0], KRD(kf1, 5), P0, 4,  pw0, 2, 3); \
        GA(S0, kf2, qr[1], KRD(kf2, 6), P0, 8,  pw1, 0, 1); GA(S1, kf3, qr[1], KRD(kf3, 7), P0, 12, pw1, 2, 3); \
        GA(S0, kf0, qr[2], VRD(vl0, vh0, 0), P1, 0,  pw2, 0, 1); GA(S1, kf1, qr[2], VRD(vl1, vh1, 1), P1, 4,  pw2, 2, 3); \
        GA(S0, kf2, qr[3], VRD(vl2, vh2, 2), P1, 8,  pw3, 0, 1); GA(S1, kf3, qr[3], VRD(vl3, vh3, 3), P1, 12, pw3, 2, 3); \
        l += sacc; } while (0)
#define QK_ONLY(S0, S1) do { \
        S0 = MF(kf0, qr[0], S0); KRD(kf0, 4); S1 = MF(kf1, qr[0], S1); KRD(kf1, 5); S0 = MF(kf2, qr[1], S0); KRD(kf2, 6); S1 = MF(kf3, qr[1], S1); KRD(kf3, 7); SBAR(); \
        S0 = MF(kf0, qr[2], S0); S1 = MF(kf1, qr[2], S1); S0 = MF(kf2, qr[3], S0); S1 = MF(kf3, qr[3], S1); SBAR(); } while (0)
#define DECIDE(S0, S1) do { if (VAR & 64) break; asm volatile("s_nop 15\n\ts_nop 7" : "+v"(S0), "+v"(S1));   \
        float ma_ = max3f(S0[0], S0[1], S1[0]), mb_ = max3f(S0[2], S0[3], S1[1]); ma_ = max3f(ma_, S1[2], S1[3]); \
        _Pragma("unroll") for (int r = 4; r < 16; r += 4) { ma_ = max3f(ma_, S0[r], S0[r + 1]); mb_ = max3f(mb_, S0[r + 2], S0[r + 3]); ma_ = max3f(ma_, S1[r], S1[r + 1]); mb_ = max3f(mb_, S1[r + 2], S1[r + 3]); } \
        float rm_ = max3f(ma_, mb_, mb_); rm_ = swap_max(rm_); resc = false; \
        if (__builtin_expect(__any(rm_ > THR), 0)) { const float dl_ = __builtin_fmaxf(rm_, 0.f); mhat += dl_; \
            _Pragma("unroll") for (int r = 0; r < 16; ++r) { S0[r] -= dl_; S1[r] -= dl_; } \
            rf = __builtin_amdgcn_exp2f(-dl_); l *= rf; resc = true; } } while (0)
#define RESCALE_O() do { if (resc) { int h4_ = 4 * hi; asm volatile("" : "+v"(h4_)); _Pragma("unroll") for (int r = 0; r < 16; ++r) { const float fr_ = __shfl(rf, CRI(r) + h4_); \
            _Pragma("unroll") for (int d0 = 0; d0 < DV32; ++d0) o[d0][r] *= fr_; } resc = false; } } while (0)
#define EXP2(x) ((VAR & 1) ? (x) * 0.001f : __builtin_amdgcn_exp2f(x))
#define GB(Ox, PW, VL, VH, RD, S, e, C, crf) do { Ox = MF(__builtin_bit_cast(bf16x8, PW), VFR(VL, VH), Ox); RD; S[e] = EXP2(S[e]); S[e + 1] = EXP2(S[e + 1]); PIN(S); \
        if (!(VAR & 16)) { C[e] = fmamk<__builtin_bit_cast(unsigned, CRF(e) + (crf))>(sl_n, base_n); C[e + 1] = fmamk<__builtin_bit_cast(unsigned, CRF(e + 1) + (crf))>(sl_n, base_n); } PIN(C); SBAR(); } while (0)
#define PHASE_B(S0, S1, C0, C1) do { \
        GB(o[0], pw0, vl0, vh0, VRD(vl0, vh0, 4),  S0, 0,  C0, 0.f);  GB(o[0], pw1, vl1, vh1, VRD(vl1, vh1, 5),  S0, 2,  C0, 0.f); \
        GB(o[0], pw2, vl2, vh2, VRD(vl2, vh2, 6),  S0, 4,  C0, 0.f);  GB(o[0], pw3, vl3, vh3, VRD(vl3, vh3, 7),  S0, 6,  C0, 0.f); \
        GB(o[1], pw0, vl0, vh0, VRD(vl0, vh0, 8),  S0, 8,  C0, 0.f);  GB(o[1], pw1, vl1, vh1, VRD(vl1, vh1, 9),  S0, 10, C0, 0.f); \
        GB(o[1], pw2, vl2, vh2, VRD(vl2, vh2, 10), S0, 12, C0, 0.f);  GB(o[1], pw3, vl3, vh3, VRD(vl3, vh3, 11), S0, 14, C0, 0.f); \
        GB(o[2], pw0, vl0, vh0, VRD(vl0, vh0, 12), S1, 0,  C1, 32.f); GB(o[2], pw1, vl1, vh1, VRD(vl1, vh1, 13), S1, 2,  C1, 32.f); \
        GB(o[2], pw2, vl2, vh2, VRD(vl2, vh2, 14), S1, 4,  C1, 32.f); GB(o[2], pw3, vl3, vh3, VRD(vl3, vh3, 15), S1, 6,  C1, 32.f); \
        GB(o[3], pw0, vl0, vh0, KRN(kf0, 0),       S1, 8,  C1, 32.f); GB(o[3], pw1, vl1, vh1, KRN(kf1, 1),       S1, 10, C1, 32.f); \
        GB(o[3], pw2, vl2, vh2, KRN(kf2, 2),       S1, 12, C1, 32.f); GB(o[3], pw3, vl3, vh3, KRN(kf3, 3),       S1, 14, C1, 32.f); } while (0)
#define ROT3(s) ((s) == 2 ? 0 : (s) + 1)
#define ROT4(s) (((s) + 1) & 3)
#define STEP(S0, S1, P0, P1, it) do { \
        asm volatile("" : "+s"(sk), "+s"(sv)); \
        const int skm_ = (sk + 3) & 3, skp_ = ROT4(sk), svpp_ = sv == 0 ? 2 : sv - 1;   \
        const lds_cptr kp_ = kp0 + sk * KSLOT; const lds_cptr kn_ = kp0 + skp_ * KSLOT; const lds_cptr vp_ = vp0 + sv * KSLOT; \
        if (!(VAR & 8) && (it) + 3 < NT) DMA_K(TILE_OF((it) + 3), skm_); \
        SET_NEXT((it) + 1); SBAR(); \
        __builtin_amdgcn_s_setprio(1); PHASE_A(S0, S1, P0, P1); __builtin_amdgcn_s_setprio(0); \
        if (!(VAR & 8) && (it) + 1 < NT) DMA_V(TILE_OF((it) + 1), svpp_); \
        DECIDE(S0, S1); if (resc) SET_NEXT((it) + 1); SBAR(); \
        __builtin_amdgcn_s_setprio(1); PHASE_B(S0, S1, P0, P1); __builtin_amdgcn_s_setprio(0); \
        RESCALE_O(); sk = skp_; sv = ROT3(sv); } while (0)
    if (NT > 2) {
        { const lds_cptr kp_ = kp0 + 2 * KSLOT; const lds_cptr kn_ = kp0 + 3 * KSLOT;
          KRD(kf0, 0); KRD(kf1, 1); KRD(kf2, 2); KRD(kf3, 3);
          if (5 < NT) DMA_K(TILE_OF(5), 1); if (3 < NT) DMA_V(TILE_OF(3), 0);
          SET_NEXT(2); CINIT(xa0, xa1); SBAR();
          QK_ONLY(xa0, xa1);
          DECIDE(xa0, xa1); RESCALE_O();
#pragma unroll
          for (int r = 0; r < 16; ++r) { xa0[r] = EXP2(xa0[r]); xa1[r] = EXP2(xa1[r]); }
          SET_NEXT(3); CINIT(xb0, xb1);
          KRN(kf0, 0); KRN(kf1, 1); KRN(kf2, 2); KRN(kf3, 3); }
        int it = 3, sk = 3, sv = 2;
#pragma unroll 1
        for (; it + 1 < NT; it += 2) {
            if (!(VAR & 128)) { if (it + 2 < NT) { ATT_WAIT_BAR(4); } else { ATT_WAIT_BAR(2); } }
            STEP(xb0, xb1, xa0, xa1, it);
            if (!(VAR & 128)) { if (it + 3 < NT) { ATT_WAIT_BAR(4); } else { ATT_WAIT_BAR(2); } }
            STEP(xa0, xa1, xb0, xb1, it + 1);
        }
        if (it < NT) {
            ATT_WAIT_BAR(2);
            STEP(xb0, xb1, xa0, xa1, it);
            { float sacc = 0.f;
#pragma unroll
              for (int r = 0; r < 16; ++r) sacc += xb0[r] + xb1[r];
              l += sacc;
              pw0 = (u32x4){cvtpk(xb0[0], xb0[1]), cvtpk(xb0[2], xb0[3]), cvtpk(xb0[4], xb0[5]), cvtpk(xb0[6], xb0[7])}; pw1 = (u32x4){cvtpk(xb0[8], xb0[9]), cvtpk(xb0[10], xb0[11]), cvtpk(xb0[12], xb0[13]), cvtpk(xb0[14], xb0[15])};
              pw2 = (u32x4){cvtpk(xb1[0], xb1[1]), cvtpk(xb1[2], xb1[3]), cvtpk(xb1[4], xb1[5]), cvtpk(xb1[6], xb1[7])}; pw3 = (u32x4){cvtpk(xb1[8], xb1[9]), cvtpk(xb1[10], xb1[11]), cvtpk(xb1[12], xb1[13]), cvtpk(xb1[14], xb1[15])}; }
        } else {
            { float sacc = 0.f;
#pragma unroll
              for (int r = 0; r < 16; ++r) sacc += xa0[r] + xa1[r];
              l += sacc;
              pw0 = (u32x4){cvtpk(xa0[0], xa0[1]), cvtpk(xa0[2], xa0[3]), cvtpk(xa0[4], xa0[5]), cvtpk(xa0[6], xa0[7])}; pw1 = (u32x4){cvtpk(xa0[8], xa0[9]), cvtpk(xa0[10], xa0[11]), cvtpk(xa0[12], xa0[13]), cvtpk(xa0[14], xa0[15])};
              pw2 = (u32x4){cvtpk(xa1[0], xa1[1]), cvtpk(xa1[2], xa1[3]), cvtpk(xa1[4], xa1[5]), cvtpk(xa1[6], xa1[7])}; pw3 = (u32x4){cvtpk(xa1[8], xa1[9]), cvtpk(xa1[10], xa1[11]), cvtpk(xa1[12], xa1[13]), cvtpk(xa1[14], xa1[15])}; }
        }
        ATT_WAIT_BAR(0);
        { const int sl_ = (NT - 1) % 3; const lds_cptr vp_ = vp0 + sl_ * KSLOT;
#pragma unroll
          for (int d0 = 0; d0 < DV32; ++d0) {
              VRD(vl0, vh0, d0 * 4); VRD(vl1, vh1, d0 * 4 + 1); VRD(vl2, vh2, d0 * 4 + 2); VRD(vl3, vh3, d0 * 4 + 3);
              o[d0] = MF(__builtin_bit_cast(bf16x8, pw0), VFR(vl0, vh0), o[d0]); o[d0] = MF(__builtin_bit_cast(bf16x8, pw1), VFR(vl1, vh1), o[d0]);
              o[d0] = MF(__builtin_bit_cast(bf16x8, pw2), VFR(vl2, vh2), o[d0]); o[d0] = MF(__builtin_bit_cast(bf16x8, pw3), VFR(vl3, vh3), o[d0]); } }
    }
#undef TILE_OF
#undef DMA_K
#undef DMA_V
#undef KRD
#undef VRD
#undef VFR
#undef SET_NEXT
#undef CINIT
#undef GA
#undef PHASE_A
#undef QK_ONLY
#undef DECIDE
#undef RESCALE_O
#undef EXP2
#undef GB
#undef PHASE_B
#undef STEP
#undef ROT3
#undef ROT4
#undef KRN
    l = swap_sum(l);
    const float rl = 1.f / l;
    LAS float* cb = (LAS float*)shm + qs * 4096;
    ATT_WAIT_BAR(0);
    if (VAR & 1024) { if (lane == 0 && rl == 12345.f) O[0] = 0; return; }
    if (cmap == 1) {
#pragma unroll
        for (int r = 0; r < 16; ++r) { const int row = CRI(r) + 4 * hi; const float rr = __shfl(rl, row) * dc.lam_full;
#pragma unroll
            for (int d0 = 0; d0 < DV32; ++d0) cb[row * 128 + d0 * 32 + r32] = o[d0][r] * rr; }
    }
    ATT_WAIT_BAR(0);
    if (cmap == 0) {
        bf16_t* Ow = O + (size_t)(b * SEQ + iw) * D + hh * 128 + r32;
        float gsub[DV32];
#pragma unroll
        for (int d0 = 0; d0 < DV32; ++d0) gsub[d0] = dc.subln[d0 * 32 + r32] * (1.f - LAMBDA_INIT);
#pragma unroll
        for (int r = 0; r < 16; ++r) { const int row = CRI(r) + 4 * hi; const float rr = __shfl(rl, row);
            float v[DV32]; float ss = 0.f;
#pragma unroll
            for (int d0 = 0; d0 < DV32; ++d0) { v[d0] = o[d0][r] * rr - cb[row * 128 + d0 * 32 + r32]; ss += v[d0] * v[d0]; }
            ss += __shfl_xor(ss, 1); ss += __shfl_xor(ss, 2); ss += __shfl_xor(ss, 4); ss += __shfl_xor(ss, 8); ss += __shfl_xor(ss, 16);
            const float sc = __builtin_amdgcn_rsqf(ss * (1.f / 128.f) + 1e-5f);
#pragma unroll
            for (int d0 = 0; d0 < DV32; ++d0) Ow[(size_t)row * D + d0 * 32] = (bf16_t)f2bf(v[d0] * sc * gsub[d0]); }
    }
    asm volatile("s_waitcnt lgkmcnt(0)\n\ts_barrier" ::: "memory");
}
#undef SBAR
#undef PIN
#undef MF
#undef ATT_WAIT_BAR
}

typedef GAS unsigned gu32;
#define RLX_AGENT __ATOMIC_RELAXED, __HIP_MEMORY_SCOPE_AGENT
#define LDS_WAIT() asm volatile("s_waitcnt lgkmcnt(0)" ::: "memory")
#define VM_WAIT() asm volatile("s_waitcnt vmcnt(0)" ::: "memory")
#define XB_TMO      128
#define XB_XCNT(j)  (256  + 64 * (j))
#define XB_XSUB(j)  (1280 + 64 * (j))
#define XB_XGEN(j)  (2304 + 64 * (j))
#define XB_TOP      3328
#define XB_TOPGEN   3392
#define XCD_BAR_WORDS 3456
#define XB_SPIN_CAP (1u << 18)
__device__ __forceinline__ unsigned xb_ld(unsigned* p)              { return __hip_atomic_load(p, __ATOMIC_RELAXED, __HIP_MEMORY_SCOPE_AGENT); }
__device__ __forceinline__ unsigned xb_add(unsigned* p, unsigned v) { return __hip_atomic_fetch_add(p, v, __ATOMIC_RELAXED, __HIP_MEMORY_SCOPE_AGENT); }
__device__ __forceinline__ unsigned xb_xcc_id() { return (unsigned)__builtin_amdgcn_s_getreg((3 << 11) | 20) & 0xFu; }
#define XB_SPIN(cond, bar) do { unsigned _sp = 0; while (cond) { __builtin_amdgcn_s_sleep(1); \
    if ((++_sp & 255u) == 0u) { if (xb_ld(&(bar)[XB_TMO])) break; if (_sp > XB_SPIN_CAP) { atomicAdd(&(bar)[XB_TMO], 1u); break; } } } } while (0)
struct XcdBarrier { unsigned* bar; unsigned x; volatile LAS unsigned* st; };
__device__ __forceinline__ XcdBarrier xcd_barrier_post(unsigned* bar, volatile LAS unsigned* st, const bool leader) {
    XcdBarrier b; b.bar = bar; b.x = xb_xcc_id(); b.st = st;
    if (leader) (void)xb_add(&bar[XB_XCNT(b.x)], 1u);
    return b;
}
__device__ __forceinline__ void xcd_barrier_complete(unsigned* bar, unsigned x, unsigned& nloc, unsigned& nx) {
    const unsigned G = gridDim.x * gridDim.y * gridDim.z;
    unsigned sum, cnt, mine, sp = 0u;
    for (;;) {
        sum = 0u; cnt = 0u; mine = 0u;
#pragma unroll
        for (unsigned j = 0; j < 16; ++j) { const unsigned c = xb_ld(&bar[XB_XCNT(j)]); sum += c; cnt += (c > 0u) ? 1u : 0u; mine = (j == x) ? c : mine; }
        if (sum == G) break;
        __builtin_amdgcn_s_sleep(1);
        if ((++sp & 255u) == 0u) { if (xb_ld(&bar[XB_TMO])) break; if (sp > XB_SPIN_CAP) { atomicAdd(&bar[XB_TMO], 1u); break; } }
    }
    nloc = mine > 0u ? mine : 1u; nx = cnt > 0u ? cnt : 1u;
}
__device__ __forceinline__ void xcd_barrier(const XcdBarrier& b, const bool leader) {
    asm volatile("s_waitcnt vmcnt(0)" ::: "memory");
    __syncthreads();
    if (leader) {
        unsigned* bar = b.bar;
        __builtin_amdgcn_s_waitcnt(0);
        unsigned nloc = b.st[0], nx = b.st[1];
        if (nloc == 0u) { xcd_barrier_complete(bar, b.x, nloc, nx); b.st[0] = nloc; b.st[1] = nx; }
        const unsigned old = xb_add(&bar[XB_XSUB(b.x)], 1u);
        const unsigned gen = old / nloc;
        if (old + 1u == (gen + 1u) * nloc) {
            __builtin_amdgcn_fence(__ATOMIC_RELEASE, "agent");
            asm volatile("s_waitcnt vmcnt(0)" ::: "memory");
            const unsigned og = xb_add(&bar[XB_TOP], 1u);
            const unsigned tg = og / nx;
            if (og + 1u == (tg + 1u) * nx) xb_add(&bar[XB_TOPGEN], 1u);
            else XB_SPIN(xb_ld(&bar[XB_TOPGEN]) == tg, bar);
            __builtin_amdgcn_fence(__ATOMIC_ACQUIRE, "agent");
            xb_add(&bar[XB_XGEN(b.x)], 1u);
            asm volatile("s_waitcnt vmcnt(0)" ::: "memory");
        } else {
            XB_SPIN(xb_ld(&bar[XB_XGEN(b.x)]) == gen, bar);
            __builtin_amdgcn_fence(__ATOMIC_ACQUIRE, "agent");
            asm volatile("s_waitcnt vmcnt(0)" ::: "memory");
        }
    }
    __syncthreads();
}

struct Args { const float* in[18]; float* out; unsigned char* ws; int ph_lo, ph_hi, use_cg, pad; };
enum { I_X = 0, I_NMIX, I_NFFN, I_SWA_QKV, I_SWA_WO, I_SWA_SINK, I_DIFF_QKV, I_DIFF_WO, I_DIFF_LAM, I_DIFF_SUBLN, I_WG, I_BG, I_WR, I_BR, I_GATE, I_UP, I_DOWN, I_FNORM };
typedef const __attribute__((address_space(4))) Args* CArgs;
__device__ __forceinline__ CArgs kargs() { CArgs p = (CArgs)__builtin_amdgcn_kernarg_segment_ptr(); asm volatile("" : "+s"(p)); return p; }
__device__ __forceinline__ int vcu_of(int G) { const int bx = blockIdx.x; return (G % 8 == 0) ? (bx % 8) * (G / 8) + bx / 8 : bx; }

__device__ __forceinline__ void tr_item(const float* W, int N, int k0, int n0, bf16_t* dst, int ldd, LAS float* scr, int lane) {
    f32x4 v[8];
#pragma unroll
    for (int i = 0; i < 8; ++i) v[i] = *(const f32x4*)(W + (size_t)(k0 + 8 * i + (lane >> 3)) * N + n0 + (lane & 7) * 4);
#pragma unroll
    for (int i = 0; i < 8; ++i) { LAS float* p = scr + (8 * i + (lane >> 3)) * 33 + (lane & 7) * 4; p[0] = v[i].x; p[1] = v[i].y; p[2] = v[i].z; p[3] = v[i].w; }
    LDS_WAIT(); asm volatile("" ::: "memory");
    const int c = lane & 7;
#pragma unroll
    for (int j = 0; j < 4; ++j) { const int n = (lane >> 3) + 8 * j; const LAS float* s = scr + (8 * c) * 33 + n;
        u32x4 o; o.x = pk2(s[0 * 33], s[1 * 33]); o.y = pk2(s[2 * 33], s[3 * 33]); o.z = pk2(s[4 * 33], s[5 * 33]); o.w = pk2(s[6 * 33], s[7 * 33]);
        *(GAS u32x4*)(dst + (size_t)n * ldd + k0 + 8 * c) = o; }
    LDS_WAIT(); asm volatile("" ::: "memory");
}
__device__ __forceinline__ void rms_row_to_bf16(const float* xrow, const float* g, bf16_t* orow, int lane) {
    const GAS f32x4* xr = (const GAS f32x4*)xrow + lane; const GAS f32x4* gr = (const GAS f32x4*)g + lane;
    f32x4 v[4]; float s = 0.f;
#pragma unroll
    for (int j = 0; j < 4; ++j) { v[j] = xr[64 * j]; s += (v[j].x * v[j].x + v[j].y * v[j].y) + (v[j].z * v[j].z + v[j].w * v[j].w); }
    const float rstd = 1.f / sqrtf(wave_sum(s) * (1.f / D) + 1e-6f);
    GAS u32x2* o8 = (GAS u32x2*)orow + lane;
#pragma unroll
    for (int j = 0; j < 4; ++j) { const f32x4 gg = gr[64 * j]; u32x2 w; w.x = pk2(v[j].x * rstd * gg.x, v[j].y * rstd * gg.y); w.y = pk2(v[j].z * rstd * gg.z, v[j].w * rstd * gg.w); o8[64 * j] = w; }
}

__device__ __forceinline__ void phase_prologue(LAS unsigned char* lds_in, const int wave_in) {
    int lane = lane_id(); asm volatile("" : "+v"(lane)); int wave = wave_in; asm volatile("" : "+s"(wave)); LAS unsigned char* lds = lds_in; asm volatile("" : "+s"(lds));
    const CArgs a = kargs(); unsigned char* ws = a->ws;
    const int G = gridDim.x, vcu = vcu_of(G);
    LAS float* scr = (LAS float*)(lds + wave * 16384);
    const int gw = vcu * NWAVES + wave, NGW = G * NWAVES;
    bf16_t* swa_qkv_t = (bf16_t*)(ws + WS_SWA_QKV_T); bf16_t* swa_wo_t = (bf16_t*)(ws + WS_SWA_WO_T);
    bf16_t* diff_qkv_t = (bf16_t*)(ws + WS_DIFF_QKV_T); bf16_t* diff_wo_t = (bf16_t*)(ws + WS_DIFF_WO_T);
    constexpr int I0 = 16 * 48, I1 = 16 * 32, I2 = 16 * 96, I3 = 16 * 32, IM = 64 * 768, NITEMS = I0 + I1 + I2 + I3 + IM;
    struct TrItem { const float* src; int N; unsigned char* dstb; int ldb; int f8; };
    auto decode = [&](int it) -> TrItem {
        int r = it; const float* W; int N, k0, n0, ldd; bf16_t* dst; bf16_t* mbase = nullptr; int f8 = 0;
        if (r < I0) { const int kb = r / 48, nb = r % 48; W = a->in[I_SWA_QKV]; N = SWA_N; k0 = 64 * kb; n0 = 32 * nb; dst = swa_qkv_t + (size_t)n0 * D; ldd = D; }
        else if ((r -= I0) < I1) { const int kb = r / 32, nb = r % 32; W = a->in[I_SWA_WO]; N = D; k0 = 64 * kb; n0 = 32 * nb; dst = swa_wo_t + (size_t)n0 * D; ldd = D; }
        else if ((r -= I1) < I2) { const int kb = r / 96, nb = r % 96; W = a->in[I_DIFF_QKV]; N = DIFF_N; k0 = 64 * kb; n0 = 32 * nb; dst = diff_qkv_t + (size_t)n0 * D; ldd = D; }
        else if ((r -= I2) < I3) { const int kb = r / 32, nb = r % 32; W = a->in[I_DIFF_WO]; N = D; k0 = 64 * kb; n0 = 32 * nb; dst = diff_wo_t + (size_t)n0 * D; ldd = D; }
        else { r -= I3; const int le = r / 768, q = r % 768;
            bf16_t* gu = (bf16_t*)(ws + WS_WMOE + (size_t)le * 3 * MiB); bf16_t* dn = gu + (size_t)D * D;
            const bool l1 = le >= 32;
            if (q < 256) { const int kb = q / 16, c0 = 32 * (q % 16); W = a->in[I_GATE] + (size_t)le * D * DEXP; N = DEXP; k0 = 64 * kb; n0 = c0; dst = gu + (size_t)((c0 >> 7) * 256 + (c0 & 127)) * D; ldd = D; mbase = gu; f8 = ((F8_STAGE & 2) && l1); }
            else if (q < 512) { const int qq = q - 256; const int kb = qq / 16, c0 = 32 * (qq % 16); W = a->in[I_UP] + (size_t)le * D * DEXP; N = DEXP; k0 = 64 * kb; n0 = c0; dst = gu + (size_t)((c0 >> 7) * 256 + 128 + (c0 & 127)) * D; ldd = D; mbase = gu; f8 = ((F8_STAGE & 2) && l1); }
            else { const int qq = q - 512; const int kb = qq / 32, nb = qq % 32; W = a->in[I_DOWN] + (size_t)le * DEXP * D; N = D; k0 = 64 * kb; n0 = 32 * nb; dst = dn + (size_t)n0 * DEXP; ldd = DEXP; mbase = dn; f8 = ((F8_STAGE & 1) && l1); } }
        TrItem t; t.src = W + (size_t)(k0 + (lane >> 3)) * N + n0 + (lane & 7) * 4; t.N = N; t.f8 = f8;
        t.dstb = f8 ? (unsigned char*)mbase + (size_t)(dst - mbase) + k0 + 8 * (lane & 7) : (unsigned char*)(dst + k0 + 8 * (lane & 7)); t.ldb = f8 ? ldd : 2 * ldd; return t;
    };
    {
        f32x4 va[8], vb[8]; TrItem ca, cb;
#define TR_LOAD(v, t) do { _Pragma("unroll") for (int i = 0; i < 8; ++i) v[i] = *(const f32x4*)((t).src + (size_t)(8 * i) * (t).N); } while (0)
#define TR_FINISH(v, t) do { \
            _Pragma("unroll") for (int i = 0; i < 8; ++i) { LAS float* p = scr + (8 * i + (lane >> 3)) * 33 + (lane & 7) * 4; p[0] = v[i].x; p[1] = v[i].y; p[2] = v[i].z; p[3] = v[i].w; } \
            LDS_WAIT(); asm volatile("" ::: "memory"); \
            _Pragma("unroll") for (int j = 0; j < 4; ++j) { const int n = (lane >> 3) + 8 * j; const LAS float* s = scr + (8 * (lane & 7)) * 33 + n; \
                if ((t).f8) { u32x2 o8; o8.x = pk4_fp8(64.f * s[0 * 33], 64.f * s[1 * 33], 64.f * s[2 * 33], 64.f * s[3 * 33]); o8.y = pk4_fp8(64.f * s[4 * 33], 64.f * s[5 * 33], 64.f * s[6 * 33], 64.f * s[7 * 33]); \
                    *(GAS u32x2*)((t).dstb + (size_t)n * (t).ldb) = o8; } \
                else { u32x4 o; o.x = pk2(s[0 * 33], s[1 * 33]); o.y = pk2(s[2 * 33], s[3 * 33]); o.z = pk2(s[4 * 33], s[5 * 33]); o.w = pk2(s[6 * 33], s[7 * 33]); \
                    *(GAS u32x4*)((t).dstb + (size_t)n * (t).ldb) = o; } } \
            LDS_WAIT(); asm volatile("" ::: "memory"); } while (0)
        int it = gw;
        if (it < NITEMS) { ca = decode(it); TR_LOAD(va, ca); }
#pragma unroll 1
        for (; it < NITEMS; it += 2 * NGW) {
            const bool hb = it + NGW < NITEMS;
            if (hb) { cb = decode(it + NGW); TR_LOAD(vb, cb); }
            TR_FINISH(va, ca);
            const bool ha = it + 2 * NGW < NITEMS;
            if (ha) { ca = decode(it + 2 * NGW); TR_LOAD(va, ca); }
            if (hb) { TR_FINISH(vb, cb); }
        }
#undef TR_LOAD
#undef TR_FINISH
    }
    { bf16_t* wr_t = (bf16_t*)(ws + WS_WR); const int gt = gw * 64 + lane, NGT = NGW * 64;
      for (int i = gt; i < 2 * 36 * D; i += NGT) { const int l = i / (36 * D), rem = i % (36 * D), c = rem / D, k = rem % D;
          const float w = c < 4 ? a->in[I_WG][(size_t)l * D * 4 + k * 4 + c] : a->in[I_WR][(size_t)l * D * 32 + k * 32 + (c - 4)];
          const unsigned h = f2bf(w); const float r = w - __uint_as_float(h << 16);
          wr_t[(size_t)l * 2 * 36 * D + rem] = (bf16_t)h; wr_t[(size_t)l * 2 * 36 * D + 36 * D + rem] = (bf16_t)f2bf(r); } }
    bf16_t* XN = (bf16_t*)(ws + WS_XN);
#pragma unroll 1
    for (int mb = gw * 4; mb < M; mb += NGW * 4) {
        const float* xb = a->in[I_X] + (size_t)mb * D; const GAS f32x4* gr = (const GAS f32x4*)a->in[I_NMIX] + lane;
        f32x4 v[4][4];
#pragma unroll
        for (int r = 0; r < 4; ++r)
#pragma unroll
            for (int j = 0; j < 4; ++j) v[r][j] = ((const GAS f32x4*)(xb + (size_t)r * D) + lane)[64 * j];
        f32x4 gg[4];
#pragma unroll
        for (int j = 0; j < 4; ++j) gg[j] = gr[64 * j];
#pragma unroll
        for (int r = 0; r < 4; ++r) { float s = 0.f;
#pragma unroll
            for (int j = 0; j < 4; ++j) s += (v[r][j].x * v[r][j].x + v[r][j].y * v[r][j].y) + (v[r][j].z * v[r][j].z + v[r][j].w * v[r][j].w);
            const float rstd = 1.f / sqrtf(wave_sum(s) * (1.f / D) + 1e-6f);
            GAS u32x2* o8 = (GAS u32x2*)(XN + (size_t)(mb + r) * D) + lane;
#pragma unroll
            for (int j = 0; j < 4; ++j) { const f32x4 n = v[r][j] * rstd * gg[j]; u32x2 w; w.x = pk2(n.x, n.y); w.y = pk2(n.z, n.w); o8[64 * j] = w; } }
    }
}

template <int RV, bool F8OUT>
__device__ __forceinline__ void phase_router(LAS unsigned char* lds_in, int layer, const int wave_in, const bool dry) {
    int lane = lane_id(); asm volatile("" : "+v"(lane)); int wave = wave_in; asm volatile("" : "+s"(wave)); LAS unsigned char* lds = lds_in; asm volatile("" : "+s"(lds));
    const CArgs a = kargs(); unsigned char* ws = a->ws;
    const int G = gridDim.x, vcu = vcu_of(G);
    const int gw = vcu * NWAVES + wave, NGW = G * NWAVES;
    const float* g = a->in[I_NFFN] + layer * D;
    const bf16_t* wth = (const bf16_t*)(ws + WS_WR) + (size_t)layer * 2 * 36 * D; const bf16_t* wtl = wth + 36 * D;
    const float* bg = a->in[I_BG] + layer * 4; const float* br = a->in[I_BR] + layer * 32;
    bf16_t* XN = (bf16_t*)(ws + (dry ? WS_SCR : WS_XN)); const float* xin = a->out; float* rstd_tok = (float*)(ws + (dry ? WS_SCR + 80 * MiB : WS_RSTD));
    unsigned* cnt = (unsigned*)(ws + WS_CTL) + CW_CNT + (dry ? 2 : layer) * 1024;
    int* ltok = (int*)(ws + (dry ? WS_SCR + 64 * MiB : WS_LTOK)); float* lw = (float*)(ws + (dry ? WS_SCR + 68 * MiB : WS_LW)); i32x4* tinfo = (i32x4*)(ws + (dry ? WS_SCR + 72 * MiB : WS_TINFO));
    LAS float* lgs = (LAS float*)(lds + 98304 + wave * 4096);
    LAS float* rsl = lgs + 768;
    const int row = lane & 15, kg = lane >> 4;
    const bool c2ok = row < 4;
    LAS unsigned* lcnt = (LAS unsigned*)(lds + TP_OFF); LAS unsigned* lbase = lcnt + 32;
    const int tid = wave * 64 + lane;
#pragma unroll 1
    for (int bt0 = 0; bt0 < M / 16; bt0 += NGW) {
        const int bt = bt0 + gw; const bool live = bt < M / 16;
        const int t0 = (live ? bt : 0) * 16;
        if (tid < 32) lcnt[tid] = 0u;
        const char* xrow = (const char*)(xin + (size_t)(t0 + row) * D) + kg * 32;
        const char* grow = (const char*)g + kg * 32;
        char* orow = (char*)(XN + (size_t)(t0 + row) * D) + kg * 16;
        const char* w0 = (const char*)(wth + (size_t)row * D) + kg * 16;
        f32x4 acc0 = {0.f, 0.f, 0.f, 0.f}, acc1 = acc0, acc2 = acc0; float ss = 0.f;
        const unsigned m2 = c2ok ? 0xffffffffu : 0u;
        {
            f32x4 xa[3] = {}, xb[3] = {}, ga[3] = {}, gb[3] = {};
            const char* xbase = (const char*)(xin + (size_t)t0 * D); const unsigned xoff = (unsigned)(row * D * 4 + kg * 32);
            const char* gbase = (const char*)g; const unsigned goff = (unsigned)(kg * 32);
            const char* wb0h = (const char*)wth; const char* wb0l = wb0h + 36 * D * 2; const char* wb1h = wb0h + 16 * D * 2; const char* wb1l = wb0h + 52 * D * 2;
            char* obase = live ? (char*)XN + (size_t)t0 * D * (F8OUT ? 1 : 2) : (char*)(ws + WS_SCR + 100 * MiB); const unsigned ooff = F8OUT ? (unsigned)(row * D + kg * 8) : (unsigned)(row * D * 2 + kg * 16);
            const unsigned woff = (unsigned)((row * D + kg * 8) * 2) + (unsigned)wave * 64u, woff2 = (unsigned)(((32 + (row & 3)) * D + kg * 8) * 2) + (unsigned)wave * 64u;
            LAS unsigned char* bfill = lds + wave * 6144 + lane * 16;
            const LAS unsigned char* bread = lds + lane * 16;
            u32x4 fr0, fr1, fr2, fr3, fr4, fr5;
#define RT_BLOAD(c) do { fr0 = *(const u32x4*)(wb0h + woff + (c) * 512); fr1 = *(const u32x4*)(wb0l + woff + (c) * 512); fr2 = *(const u32x4*)(wb1h + woff + (c) * 512); \
            fr3 = *(const u32x4*)(wb1l + woff + (c) * 512); fr4 = *(const u32x4*)(wb0h + woff2 + (c) * 512); fr5 = *(const u32x4*)(wb0l + woff2 + (c) * 512); } while (0)
#define RT_BWRITE(buf) do { fr4.x &= m2; fr4.y &= m2; fr4.z &= m2; fr4.w &= m2; fr5.x &= m2; fr5.y &= m2; fr5.z &= m2; fr5.w &= m2; \
            *(LAS u32x4*)(bfill + (buf) * 49152) = fr0; *(LAS u32x4*)(bfill + (buf) * 49152 + 1024) = fr1; *(LAS u32x4*)(bfill + (buf) * 49152 + 2048) = fr2; \
            *(LAS u32x4*)(bfill + (buf) * 49152 + 3072) = fr3; *(LAS u32x4*)(bfill + (buf) * 49152 + 4096) = fr4; *(LAS u32x4*)(bfill + (buf) * 49152 + 5120) = fr5; } while (0)
#define RT_BAR() asm volatile("s_waitcnt lgkmcnt(0)\n\ts_barrier" ::: "memory")
#define RT_LOAD(st, s) do { if (!(RV & 2)) { xa[st] = *(const f32x4*)(xbase + xoff + (s) * 128); xb[st] = *(const f32x4*)(xbase + xoff + (s) * 128 + 16); } \
            ga[st] = *(const f32x4*)(gbase + goff + (s) * 128); gb[st] = *(const f32x4*)(gbase + goff + (s) * 128 + 16); } while (0)
            RT_BLOAD(0); RT_LOAD(0, 0); RT_LOAD(1, 1);
            RT_BWRITE(0); RT_BLOAD(1);
            RT_BAR();
#pragma unroll
            for (int s = 0; s < 32; ++s) {
                const int st = s % 3, c = s >> 3, sl = s & 7;
                if (sl == 0 && c + 1 < 4) { RT_BWRITE((c + 1) & 1); if (c + 2 < 4) { RT_BLOAD(c + 2); } }
                if (s + 2 < 32) { RT_LOAD((s + 2) % 3, s + 2); }
                __builtin_amdgcn_sched_barrier(0);
                const LAS unsigned char* bp = bread + (c & 1) * 49152 + sl * 6144;
                const bf16x8 b0h = *(const LAS bf16x8*)(bp), b0l = *(const LAS bf16x8*)(bp + 1024), b1h = *(const LAS bf16x8*)(bp + 2048), b1l = *(const LAS bf16x8*)(bp + 3072),
                             b2h = *(const LAS bf16x8*)(bp + 4096), b2l = *(const LAS bf16x8*)(bp + 5120);
                const f32x4 xa_ = xa[st], xb_ = xb[st];
                ss += (xa_.x * xa_.x + xa_.y * xa_.y) + (xa_.z * xa_.z + xa_.w * xa_.w) + (xb_.x * xb_.x + xb_.y * xb_.y) + (xb_.z * xb_.z + xb_.w * xb_.w);
                const f32x4 ya = xa_ * ga[st], yb = xb_ * gb[st];
                u32x4 hi; hi.x = cvtpk(ya.x, ya.y); hi.y = cvtpk(ya.z, ya.w); hi.z = cvtpk(yb.x, yb.y); hi.w = cvtpk(yb.z, yb.w);
                u32x4 lo; lo.x = cvtpk(ya.x - __uint_as_float(hi.x << 16), ya.y - __uint_as_float(hi.x & 0xffff0000u)); lo.y = cvtpk(ya.z - __uint_as_float(hi.y << 16), ya.w - __uint_as_float(hi.y & 0xffff0000u));
                lo.z = cvtpk(yb.x - __uint_as_float(hi.z << 16), yb.y - __uint_as_float(hi.z & 0xffff0000u)); lo.w = cvtpk(yb.z - __uint_as_float(hi.w << 16), yb.w - __uint_as_float(hi.w & 0xffff0000u));
                if constexpr (F8OUT) { u32x2 q8; q8.x = pk4_fp8(4.f * ya.x, 4.f * ya.y, 4.f * ya.z, 4.f * ya.w); q8.y = pk4_fp8(4.f * yb.x, 4.f * yb.y, 4.f * yb.z, 4.f * yb.w); *(u32x2*)(obase + ooff + s * 32) = q8; }
                else if (!(RV & 1)) *(u32x4*)(obase + ooff + s * 64) = hi;
                const bf16x8 ah = __builtin_bit_cast(bf16x8, hi), al = __builtin_bit_cast(bf16x8, lo);
                acc0 = __builtin_amdgcn_mfma_f32_16x16x32_bf16(ah, b0h, acc0, 0, 0, 0); acc0 = __builtin_amdgcn_mfma_f32_16x16x32_bf16(ah, b0l, acc0, 0, 0, 0); acc0 = __builtin_amdgcn_mfma_f32_16x16x32_bf16(al, b0h, acc0, 0, 0, 0);
                acc1 = __builtin_amdgcn_mfma_f32_16x16x32_bf16(ah, b1h, acc1, 0, 0, 0); acc1 = __builtin_amdgcn_mfma_f32_16x16x32_bf16(ah, b1l, acc1, 0, 0, 0); acc1 = __builtin_amdgcn_mfma_f32_16x16x32_bf16(al, b1h, acc1, 0, 0, 0);
                acc2 = __builtin_amdgcn_mfma_f32_16x16x32_bf16(ah, b2h, acc2, 0, 0, 0); acc2 = __builtin_amdgcn_mfma_f32_16x16x32_bf16(ah, b2l, acc2, 0, 0, 0); acc2 = __builtin_amdgcn_mfma_f32_16x16x32_bf16(al, b2h, acc2, 0, 0, 0);
                __builtin_amdgcn_sched_barrier(0);
                if (sl == 7 && c + 1 < 4) { RT_BAR(); }
            }
            RT_BAR();
#undef RT_LOAD
#undef RT_BLOAD
#undef RT_BWRITE
#undef RT_BAR
        }
        ss += __shfl_xor(ss, 16); ss += __shfl_xor(ss, 32);
        const float rstd = 1.f / sqrtf(ss * (1.f / D) + 1e-6f);
        if (kg == 0) { rsl[row] = rstd; if (live) rstd_tok[t0 + row] = rstd; }
#pragma unroll
        for (int j = 0; j < 4; ++j) { lgs[(4 * kg + j) * 48 + row] = acc0[j]; lgs[(4 * kg + j) * 48 + 16 + row] = acc1[j]; lgs[(4 * kg + j) * 48 + 32 + row] = acc2[j]; }
        LDS_WAIT(); asm volatile("" ::: "memory");
        int e1 = 0, e2 = 0, lp1 = 0, lp2 = 0; float w1 = 0.f, w2 = 0.f;
        const bool act = live && lane < 16 && !(RV & 4);
        __syncthreads();
        if (act) {
            const float rs = rsl[lane];
            float acc[36];
#pragma unroll
            for (int q = 0; q < 9; ++q) { const f32x4 x = *(const LAS f32x4*)(lgs + lane * 48 + 4 * q); acc[4 * q] = x.x * rs; acc[4 * q + 1] = x.y * rs; acc[4 * q + 2] = x.z * rs; acc[4 * q + 3] = x.w * rs; }
            float lgv[4]; int gs = 0;
#pragma unroll
            for (int c = 0; c < 4; ++c) lgv[c] = acc[c] + bg[c];
            float mx = lgv[0];
#pragma unroll
            for (int c = 1; c < 4; ++c) if (lgv[c] > mx) { mx = lgv[c]; gs = c; }
            float den = 0.f;
#pragma unroll
            for (int c = 0; c < 4; ++c) den += __expf(lgv[c] - mx);
            const float pg = 1.f / den;
            float le[8];
#pragma unroll
            for (int k = 0; k < 8; ++k) { const float a0 = acc[4 + k] + br[k], a1 = acc[12 + k] + br[8 + k], a2 = acc[20 + k] + br[16 + k], a3 = acc[28 + k] + br[24 + k];
                le[k] = gs == 0 ? a0 : (gs == 1 ? a1 : (gs == 2 ? a2 : a3)); }
            int i1 = 0; float m1 = le[0];
#pragma unroll
            for (int k = 1; k < 8; ++k) if (le[k] > m1) { m1 = le[k]; i1 = k; }
            int i2 = -1; float m2 = -INFINITY;
#pragma unroll
            for (int k = 0; k < 8; ++k) if (k != i1 && (i2 < 0 || le[k] > m2)) { m2 = le[k]; i2 = k; }
            const float ex = __expf(m2 - m1); const float tp1 = 1.f / (1.f + ex), tp2 = ex * tp1;
            w1 = pg * tp1; w2 = pg * tp2; e1 = gs * 8 + i1; e2 = gs * 8 + i2;
            lp1 = (int)__hip_atomic_fetch_add(lcnt + e1, 1u, __ATOMIC_RELAXED, __HIP_MEMORY_SCOPE_WORKGROUP);
            lp2 = (int)__hip_atomic_fetch_add(lcnt + e2, 1u, __ATOMIC_RELAXED, __HIP_MEMORY_SCOPE_WORKGROUP);
        }
        __syncthreads();
        if (tid < 32) { const unsigned c = lcnt[tid]; lbase[tid] = c ? __hip_atomic_fetch_add(cnt + 32 * tid, c, __ATOMIC_RELAXED, __HIP_MEMORY_SCOPE_AGENT) : 0u; }
        __syncthreads();
        if (act) {
            const int t = t0 + lane; const int p1 = (int)lbase[e1] + lp1, p2 = (int)lbase[e2] + lp2;
            ltok[(size_t)e1 * M + p1] = t; lw[(size_t)e1 * M + p1] = w1; ltok[(size_t)e2 * M + p2] = t; lw[(size_t)e2 * M + p2] = w2;
            tinfo[t] = (i32x4){e1, p1, e2, p2};
        }
        LDS_WAIT(); asm volatile("" ::: "memory");
        __syncthreads();
    }
}

__device__ __forceinline__ void moe_tables(LAS unsigned char* lds, unsigned char* ws, int layer, const int wave, const int lane) {
    LAS int* TP = (LAS int*)(lds + TP_OFF); LAS int* CNT = TP + 40;
    unsigned* cnt = (unsigned*)(ws + WS_CTL) + CW_CNT + layer * 1024;
    const int tid = wave * 64 + lane;
    __syncthreads();
    if (tid < 32) CNT[tid] = (int)__hip_atomic_load(cnt + 32 * tid, RLX_AGENT);
    __syncthreads();
    if (tid == 0) { int s = 0; for (int e = 0; e < 32; ++e) { TP[e] = s; s += (CNT[e] + 255) >> 8; } TP[32] = s; }
    __syncthreads();
}

__device__ __forceinline__ void phase_combine(LAS unsigned char* lds_in, int layer, const int wave_in, const bool dry) {
    int lane = lane_id(); asm volatile("" : "+v"(lane)); int wave = wave_in; asm volatile("" : "+s"(wave)); LAS unsigned char* lds = lds_in; asm volatile("" : "+s"(lds));
    const CArgs a = kargs(); unsigned char* ws = a->ws;
    moe_tables(lds, ws, layer, wave, lane);
    const bool final_ = layer == 1; const float* gnext = layer == 0 ? a->in[I_NMIX] + D : a->in[I_FNORM]; float* xio = a->out;
    const int G = gridDim.x, vcu = vcu_of(G);
    const int gw = vcu * NWAVES + wave, NGW = G * NWAVES;
    const LAS int* TP = (const LAS int*)(lds + TP_OFF);
    const bf16_t* Y = (const bf16_t*)(ws + WS_Y); const i32x4* tinfo = (const i32x4*)(ws + WS_TINFO); bf16_t* XN = (bf16_t*)(ws + WS_XN);
#pragma unroll 1
    for (int tb = gw * 4; tb < M; tb += NGW * 4) {
        size_t s1[4], s2[4];
#pragma unroll
        for (int r = 0; r < 4; ++r) { const i32x4 ti = tinfo[tb + r]; s1[r] = (size_t)TP[ti.x] * 256 + ti.y; s2[r] = (size_t)TP[ti.z] * 256 + ti.w; }
        f32x4 v[4][4]; u32x2 p[4][4], q[4][4];
#pragma unroll
        for (int r = 0; r < 4; ++r) {
            const GAS f32x4* xr = (const GAS f32x4*)(xio + (size_t)(tb + r) * D) + lane;
            const GAS u32x2* y1 = (const GAS u32x2*)(Y + s1[r] * D) + lane; const GAS u32x2* y2 = (const GAS u32x2*)(Y + s2[r] * D) + lane;
#pragma unroll
            for (int j = 0; j < 4; ++j) { v[r][j] = xr[64 * j]; p[r][j] = y1[64 * j]; q[r][j] = y2[64 * j]; }
        }
        f32x4 gg[4];
#pragma unroll
        for (int j = 0; j < 4; ++j) gg[j] = ((const GAS f32x4*)gnext + lane)[64 * j];
#pragma unroll
        for (int r = 0; r < 4; ++r) {
            float s = 0.f;
#pragma unroll
            for (int j = 0; j < 4; ++j) { const u32x2 pp = p[r][j], qq = q[r][j];
                f32x4 ya, yb; ya.x = __uint_as_float(pp.x << 16); ya.y = __uint_as_float(pp.x & 0xffff0000u); ya.z = __uint_as_float(pp.y << 16); ya.w = __uint_as_float(pp.y & 0xffff0000u);
                yb.x = __uint_as_float(qq.x << 16); yb.y = __uint_as_float(qq.x & 0xffff0000u); yb.z = __uint_as_float(qq.y << 16); yb.w = __uint_as_float(qq.y & 0xffff0000u);
                v[r][j] = v[r][j] + (ya + yb); s += (v[r][j].x * v[r][j].x + v[r][j].y * v[r][j].y) + (v[r][j].z * v[r][j].z + v[r][j].w * v[r][j].w); }
            const float rstd = 1.f / sqrtf(wave_sum(s) * (1.f / D) + 1e-6f);
            GAS f32x4* xw = (GAS f32x4*)(xio + (size_t)(tb + r) * D) + lane;
            if (final_) {
#pragma unroll
                for (int j = 0; j < 4; ++j) if (!dry) xw[64 * j] = v[r][j] * rstd * gg[j];
            } else {
                GAS u32x2* o8 = (GAS u32x2*)(XN + (size_t)(tb + r) * D) + lane;
#pragma unroll
                for (int j = 0; j < 4; ++j) { if (!dry) xw[64 * j] = v[r][j]; const f32x4 n = v[r][j] * rstd * gg[j]; u32x2 w; w.x = pk2(n.x, n.y); w.y = pk2(n.z, n.w); o8[64 * j] = w; }
            }
        }
    }
}

__device__ __forceinline__ float diff_lambda_full(const float* lam, int lane) {
    const float a = wave_sum(lam[lane] * lam[64 + lane]), b = wave_sum(lam[128 + lane] * lam[192 + lane]);
    return __expf(a) - __expf(b) + LAMBDA_INIT;
}

__device__ __forceinline__ void phase_qkv(LAS unsigned char* lds_in, int layer, const int wave_in) {
    int lane = lane_id(); asm volatile("" : "+v"(lane)); int wave = wave_in; asm volatile("" : "+s"(wave)); LAS unsigned char* lds = lds_in; asm volatile("" : "+s"(lds));
    const CArgs a = kargs(); unsigned char* ws = a->ws;
    const int N = layer == 0 ? SWA_N : DIFF_N;
    pg8::Gemm g{(const bf16_t*)(ws + WS_XN), (const bf16_t*)(ws + (layer == 0 ? WS_SWA_QKV_T : WS_DIFF_QKV_T)), D};
    pg8::DenseOrder S; S.init(M, N, (int)gridDim.x, (int)blockIdx.x);
    pg8::EpiQKV E{(bf16_t*)(ws + WS_QKV), N, 1024, QSCALE, layer == 1 ? (unsigned*)(ws + WS_CTL) + CW_KMAX : nullptr};
    pg8::gemm_phase<pg8::EpiQKV, pg8::DenseOrder, false, true>(lds, g, S, E, wave, lane);
}
__device__ __forceinline__ void phase_oproj(LAS unsigned char* lds_in, int layer, const int wave_in) {
    int lane = lane_id(); asm volatile("" : "+v"(lane)); int wave = wave_in; asm volatile("" : "+s"(wave)); LAS unsigned char* lds = lds_in; asm volatile("" : "+s"(lds));
    const CArgs a = kargs(); unsigned char* ws = a->ws;
    pg8::Gemm g{(const bf16_t*)(ws + WS_O), (const bf16_t*)(ws + (layer == 0 ? WS_SWA_WO_T : WS_DIFF_WO_T)), D};
    pg8::DenseOrder S; S.init(M, D, (int)gridDim.x, (int)blockIdx.x);
    pg8::EpiResid E{layer == 0 ? a->in[I_X] : (const float*)a->out, a->out};
    pg8::gemm_phase<pg8::EpiResid, pg8::DenseOrder, false, true>(lds, g, S, E, wave, lane);
}
__device__ __forceinline__ void phase_moe1(LAS unsigned char* lds_in, int layer, const int wave_in) {
    int lane = lane_id(); asm volatile("" : "+v"(lane)); int wave = wave_in; asm volatile("" : "+s"(wave)); LAS unsigned char* lds = lds_in; asm volatile("" : "+s"(lds));
    const CArgs a = kargs(); unsigned char* ws = a->ws;
    moe_tables(lds, ws, layer, wave, lane);
    const LAS int* TP = (const LAS int*)(lds + TP_OFF); const LAS int* CNT = TP + 40;
    if ((F8_STAGE & 2) && layer == 1) {
        pg8::Gemm g{(const bf16_t*)(ws + WS_XN), (const bf16_t*)(ws + WS_WMOE + (size_t)layer * 96 * MiB), D / 2, 0x79797979u, 0x7d7d7d7du};
        pg8::MoeOrder S{TP, CNT, (const int*)(ws + WS_LTOK), (int)gridDim.x, (int)blockIdx.x, 12, 0};
        if (F8_STAGE & 1) { pg8::EpiSwiGLU<true> E{(bf16_t*)(ws + WS_H), (const int*)(ws + WS_LTOK), (const float*)(ws + WS_RSTD), CNT};
            pg8::gemm_phase<pg8::EpiSwiGLU<true>, pg8::MoeOrder, true, true, true>(lds, g, S, E, wave, relaunder(lane)); }
        else { pg8::EpiSwiGLU<false> E{(bf16_t*)(ws + WS_H), (const int*)(ws + WS_LTOK), (const float*)(ws + WS_RSTD), CNT};
            pg8::gemm_phase<pg8::EpiSwiGLU<false>, pg8::MoeOrder, true, true, true>(lds, g, S, E, wave, relaunder(lane)); }
    } else if ((F8_STAGE & 1) && layer == 1) {
        pg8::Gemm g{(const bf16_t*)(ws + WS_XN), (const bf16_t*)(ws + WS_WMOE + (size_t)layer * 96 * MiB), D};
        pg8::MoeOrder S{TP, CNT, (const int*)(ws + WS_LTOK), (int)gridDim.x, (int)blockIdx.x, 6, 0};
        pg8::EpiSwiGLU<true> E{(bf16_t*)(ws + WS_H), (const int*)(ws + WS_LTOK), (const float*)(ws + WS_RSTD), CNT};
        pg8::gemm_phase<pg8::EpiSwiGLU<true>, pg8::MoeOrder, true, true>(lds, g, S, E, wave, relaunder(lane));
    } else {
        pg8::Gemm g{(const bf16_t*)(ws + WS_XN), (const bf16_t*)(ws + WS_WMOE + (size_t)layer * 96 * MiB), D};
        pg8::MoeOrder S{TP, CNT, (const int*)(ws + WS_LTOK), (int)gridDim.x, (int)blockIdx.x, 6, 0};
        pg8::EpiSwiGLU<false> E{(bf16_t*)(ws + WS_H), (const int*)(ws + WS_LTOK), (const float*)(ws + WS_RSTD), CNT};
        pg8::gemm_phase<pg8::EpiSwiGLU<false>, pg8::MoeOrder, true, true>(lds, g, S, E, wave, relaunder(lane));
    }
}
__device__ __forceinline__ void phase_moe2(LAS unsigned char* lds_in, int layer, const int wave_in) {
    int lane = lane_id(); asm volatile("" : "+v"(lane)); int wave = wave_in; asm volatile("" : "+s"(wave)); LAS unsigned char* lds = lds_in; asm volatile("" : "+s"(lds));
    const CArgs a = kargs(); unsigned char* ws = a->ws;
    moe_tables(lds, ws, layer, wave, lane);
    const LAS int* TP = (const LAS int*)(lds + TP_OFF); const LAS int* CNT = TP + 40;
    pg8::EpiDown E{(bf16_t*)(ws + WS_Y), (const float*)(ws + WS_LW)};
    if ((F8_STAGE & 1) && layer == 1) {
        pg8::Gemm g{(const bf16_t*)(ws + WS_H), (const bf16_t*)(ws + WS_WMOE + (size_t)layer * 96 * MiB), DEXP / 2, 0x79797979u, 0x7c7c7c7cu};
        pg8::MoeOrder S{TP, CNT, (const int*)(ws + WS_LTOK), (int)gridDim.x, (int)blockIdx.x, 24, 16};
        pg8::gemm_phase<pg8::EpiDown, pg8::MoeOrder, false, true, true>(lds, g, S, E, wave, relaunder(lane));
    } else {
        pg8::Gemm g{(const bf16_t*)(ws + WS_H), (const bf16_t*)(ws + WS_WMOE + (size_t)layer * 96 * MiB), DEXP};
        pg8::MoeOrder S{TP, CNT, (const int*)(ws + WS_LTOK), (int)gridDim.x, (int)blockIdx.x, 12, 8};
        pg8::gemm_phase<pg8::EpiDown, pg8::MoeOrder, false, true>(lds, g, S, E, wave, relaunder(lane));
    }
}
__device__ __forceinline__ void phase_attn(LAS unsigned char* lds_in, int layer, const int wave_in, const bool dry) {
    int lane = lane_id(); asm volatile("" : "+v"(lane)); int wave = wave_in; asm volatile("" : "+s"(wave)); LAS unsigned char* lds = lds_in; asm volatile("" : "+s"(lds));
    const CArgs a = kargs(); unsigned char* ws = a->ws;
    const int G = gridDim.x, vcu = vcu_of(G);
    const bf16_t* QKV = (const bf16_t*)(ws + WS_QKV); bf16_t* OB = (bf16_t*)(ws + WS_O);
    if (layer == 0) {
        att::DiffConsts dc{0.f, nullptr}; const float* sink = a->in[I_SWA_SINK];
#pragma unroll 1
        for (int i = 0; i < 2048; ++i) { const int id = vcu + G * i; if (id >= 2048) break; const int bk = id >> 7, qb = id & 127;
            att::attn_unit<0>(bk >> 2, bk & 3, qb, QKV, OB, sink, dc, lds, wave, lane); }
    } else {
        att::DiffConsts dc{diff_lambda_full(a->in[I_DIFF_LAM], lane), a->in[I_DIFF_SUBLN]};
        const unsigned* kmaxsq = (const unsigned*)(ws + WS_CTL) + CW_KMAX;
#pragma unroll 1
        for (int i = 0; i < 2048; ++i) { const int id = vcu + G * i; if (id >= 2048) break; const int h = id >> 8, bq = id & 255, b = bq >> 6;
            const int qb = ((0xD8 >> h) & 1) ? ((bq + 32) & 63) : (bq & 63);
            const int cm = wave >> 2, gi = b * 32 + 2 * (2 * h + cm);
            const float kmax = sqrtf(__uint_as_float(__hip_atomic_load(kmaxsq + gi, RLX_AGENT)) + __uint_as_float(__hip_atomic_load(kmaxsq + gi + 1, RLX_AGENT))) * 1.01f;
            if (ATT_PROBE_VARIANT != 0 && dry) att::diff_unit<ATT_PROBE_VARIANT>(b, h, qb, QKV, (bf16_t*)(ws + WS_XN), kmax, dc, lds, wave, lane);
            else att::diff_unit<0>(b, h, qb, QKV, OB, kmax, dc, lds, wave, lane); }
    }
}

__global__ void __launch_bounds__(NWAVES * 64, 2) mega_fwd(Args args_by_value) {
    extern __shared__ __attribute__((aligned(16))) unsigned char lds_raw[];
    LAS unsigned char* lds = (LAS unsigned char*)lds_raw;
    const int wave = __builtin_amdgcn_readfirstlane((int)(threadIdx.x >> 6));
    int lo, hi;
    { const CArgs a = kargs(); lo = a->ph_lo; hi = a->ph_hi;
      if (a->use_cg) cg::this_grid().sync(); }
    { const int tid = wave * 64 + lane_id();
      for (int u = tid; u < (LDS_BYTES - LDSCTL_OFF) / 4; u += NWAVES * 64) ((LAS unsigned*)(lds + LDSCTL_OFF))[u] = 0u; }
    __syncthreads();
    if (N_LAUNCHES == 1) { const CArgs a = kargs(); (void)xcd_barrier_post((unsigned*)(a->ws + WS_CTL) + CW_BAR, (volatile LAS unsigned*)(lds + MISC_OFF) + 8, wave == 0 && lane_id() == 0); }
    int rep_left = REP_COUNT;
    unsigned long long tp_prev = 0, tp_acc = 0;
    if (TPROBE_MASK != 0) tp_prev = __builtin_amdgcn_s_memrealtime();
#pragma unroll 1
    for (int ph = lo; ph < hi; ++ph) {
        const int layer = ph >= 8 ? 1 : 0, kind = ph == 0 ? 0 : ph - 7 * layer;
        const bool dry = REP_COUNT > 0 && ph == REP_PHASE && rep_left > 0;
        switch (kind) {
            case 0: phase_prologue(lds, wave); break;
            case 1: phase_qkv(lds, layer, wave); break;
            case 2: phase_attn(lds, layer, wave, dry); break;
            case 3: phase_oproj(lds, layer, wave); break;
            case 4: if (ROUTER_PROBE != 0 && dry) phase_router<ROUTER_PROBE, false>(lds, layer, wave, dry); else if ((F8_STAGE & 2) && layer == 1) phase_router<0, true>(lds, layer, wave, dry); else phase_router<0, false>(lds, layer, wave, dry); break;
            case 5: phase_moe1(lds, layer, wave); break;
            case 6: phase_moe2(lds, layer, wave); break;
            default: phase_combine(lds, layer, wave, dry); break;
        }
        if (ph + 1 < hi) { const CArgs a = kargs(); XcdBarrier bar; bar.bar = (unsigned*)(a->ws + WS_CTL) + CW_BAR; bar.x = xb_xcc_id(); bar.st = (volatile LAS unsigned*)(lds + MISC_OFF) + 8;
            xcd_barrier(bar, wave == 0 && lane_id() == 0);
        }
        if (TPROBE_MASK != 0) { const unsigned long long tn = __builtin_amdgcn_s_memrealtime(); if ((TPROBE_MASK >> ph) & 1) tp_acc += tn - tp_prev; tp_prev = tn; }
        if (REP_COUNT > 0 && ph == REP_PHASE && rep_left > 0) { --rep_left; --ph; }
        if (EXTRA_BARRIERS > 0 && ph == 3) { for (int xb = 0; xb < EXTRA_BARRIERS; ++xb) { const CArgs a = kargs(); XcdBarrier bar; bar.bar = (unsigned*)(a->ws + WS_CTL) + CW_BAR; bar.x = xb_xcc_id(); bar.st = (volatile LAS unsigned*)(lds + MISC_OFF) + 8; xcd_barrier(bar, wave == 0 && lane_id() == 0); } }
    }
    if (TPROBE_MASK != 0 && blockIdx.x == 0 && wave == 0) { const unsigned long long t0 = __builtin_amdgcn_s_memrealtime(); while (__builtin_amdgcn_s_memrealtime() - t0 < TPROBE_K * tp_acc) __builtin_amdgcn_s_sleep(8); }
}

extern "C" void kernel_launch(void* const* d_in, const int* in_sizes, int n_in, void* d_out, int out_size, void* d_ws, size_t ws_size, hipStream_t stream) {
    static int grid = 0;
    if (grid == 0) {
        if (n_in != 18 || in_sizes[0] != M * D || out_size != M * D || ws_size < WS_END) {
            fprintf(stderr, "kernel_launch: unexpected shapes: n_in %d in0 %d out %d ws %zu (need %zu)\n", n_in, n_in > 0 ? in_sizes[0] : -1, out_size, ws_size, (size_t)WS_END); grid = -1; return; }
        int dev = 0, cus = 0, per_cu = 0;
        if (hipGetDevice(&dev) != hipSuccess || hipDeviceGetAttribute(&cus, hipDeviceAttributeMultiprocessorCount, dev) != hipSuccess) { fprintf(stderr, "kernel_launch: device query failed\n"); grid = -1; return; }
        if (hipFuncSetAttribute((const void*)mega_fwd, hipFuncAttributeMaxDynamicSharedMemorySize, LDS_BYTES) != hipSuccess) { fprintf(stderr, "kernel_launch: hipFuncSetAttribute failed\n"); grid = -1; return; }
        if (hipOccupancyMaxActiveBlocksPerMultiprocessor(&per_cu, (const void*)mega_fwd, NWAVES * 64, LDS_BYTES) != hipSuccess || per_cu < 1) { fprintf(stderr, "kernel_launch: occupancy query says %d\n", per_cu); per_cu = 1; }
        (void)hipGetLastError();
        grid = cus;
    }
    if (grid < 0) return;
    (void)hipMemsetAsync((char*)d_ws + WS_CTL, 0, CTL_ZERO_BYTES, stream);
    Args a{};
    for (int i = 0; i < 18; ++i) a.in[i] = (const float*)d_in[i];
    a.out = (float*)d_out; a.ws = (unsigned char*)d_ws; a.use_cg = 0; a.pad = 0;
    if (N_LAUNCHES == 1) {
        a.ph_lo = 0; a.ph_hi = N_PHASES;
        void* kargs_[] = {&a};
        hipError_t e = hipLaunchCooperativeKernel((const void*)mega_fwd, dim3(grid), dim3(NWAVES * 64), kargs_, LDS_BYTES, stream);
        if (e != hipSuccess) fprintf(stderr, "kernel_launch: cooperative launch failed: %s (grid %d)\n", hipGetErrorString(e), grid);
    } else {
        for (int p = 0; p < N_PHASES; ++p) { a.ph_lo = p; a.ph_hi = p + 1; hipLaunchKernelGGL(mega_fwd, dim3(grid), dim3(NWAVES * 64), LDS_BYTES, stream, a); }
    }
}
```

```cpp
#include <hip/hip_runtime.h>
#include <hip/hip_cooperative_groups.h>
#include <cstdio>
#include <cstdint>
namespace cg = cooperative_groups;

#ifndef MK_N_LAUNCHES
#define MK_N_LAUNCHES 1
#endif
constexpr int N_PHASES = 15;
#define F8_STAGE 2
#define REP_PHASE -1
#define REP_COUNT 0
#define ATT_PROBE_VARIANT 0
#define EXTRA_BARRIERS 0
#define ROUTER_PROBE 0
#define TPROBE_MASK 0
#define TPROBE_K 4
constexpr int N_LAUNCHES = MK_N_LAUNCHES;

#define LAS __attribute__((address_space(3)))
#define GAS __attribute__((address_space(1)))
typedef unsigned short bf16_t;
typedef short bf16x8 __attribute__((ext_vector_type(8)));
typedef short s16x4 __attribute__((ext_vector_type(4)));
typedef float f32x2 __attribute__((ext_vector_type(2)));
typedef float f32x4 __attribute__((ext_vector_type(4)));
typedef float f32x16 __attribute__((ext_vector_type(16)));
typedef unsigned u32x2 __attribute__((ext_vector_type(2)));
typedef unsigned u32x4 __attribute__((ext_vector_type(4)));
typedef int i32x4 __attribute__((ext_vector_type(4)));
typedef int i32x8 __attribute__((ext_vector_type(8)));
typedef __bf16 bf16x2_t __attribute__((ext_vector_type(2)));

constexpr int D = 1024, BATCH = 4, SEQ = 8192, M = BATCH * SEQ;
constexpr int SWA_N = 1536, DIFF_N = 3072;
constexpr int NEXP = 32, DEXP = 512;
constexpr float LOG2E = 1.4426950408889634f;
constexpr float QSCALE = 0.125f * LOG2E;
constexpr float LAMBDA_INIT = 0.35550906759f;
constexpr int NWAVES = 8;

constexpr size_t MiB = 1u << 20;
constexpr size_t WS_CTL = 0, CTL_ZERO_BYTES = 1 * MiB;
constexpr size_t WS_SWA_QKV_T = 1 * MiB, WS_SWA_WO_T = 4 * MiB, WS_DIFF_QKV_T = 6 * MiB, WS_DIFF_WO_T = 12 * MiB;
constexpr size_t WS_WR = 14 * MiB;
constexpr size_t WS_RSTD = 14 * MiB + 512 * 1024;
constexpr size_t WS_LTOK = 15 * MiB, WS_LW = 19 * MiB, WS_TINFO = 23 * MiB;
constexpr size_t WS_WMOE = 24 * MiB;
constexpr size_t WS_XN = 216 * MiB;
constexpr size_t WS_SCR = 280 * MiB;
constexpr size_t WS_QKV = WS_SCR, WS_O = WS_SCR + 192 * MiB, WS_Y = WS_SCR, WS_H = WS_SCR + 144 * MiB;
constexpr size_t WS_END = 536 * MiB;
constexpr int CW_BAR = 4096;
constexpr int CW_CNT = 16384;
constexpr int CW_KMAX = 24576;

constexpr int RING_BYTES = 131072;
constexpr int LDSCTL_OFF = RING_BYTES;
constexpr int MISC_OFF = LDSCTL_OFF + 320;
constexpr int TP_OFF = LDSCTL_OFF + 1024;
constexpr int STASH_OFF = LDSCTL_OFF + 2048;
constexpr int LDS_BYTES = 147456;

__device__ __forceinline__ unsigned f2bf(float f) { unsigned u = __builtin_bit_cast(unsigned, f); return (u + 0x7fffu + ((u >> 16) & 1u)) >> 16; }
__device__ __forceinline__ unsigned pk2(float lo, float hi) { return f2bf(lo) | (f2bf(hi) << 16); }
__device__ __forceinline__ unsigned cvtpk(float lo, float hi) { f32x2 v = {lo, hi}; bf16x2_t b = __builtin_convertvector(v, bf16x2_t); return __builtin_bit_cast(unsigned, b); }
__device__ __forceinline__ unsigned pk4_fp8(float a, float b, float c, float d) {
    a = __builtin_fminf(__builtin_fmaxf(a, -448.f), 448.f); b = __builtin_fminf(__builtin_fmaxf(b, -448.f), 448.f); c = __builtin_fminf(__builtin_fmaxf(c, -448.f), 448.f); d = __builtin_fminf(__builtin_fmaxf(d, -448.f), 448.f);
    int r = 0; r = __builtin_amdgcn_cvt_pk_fp8_f32(a, b, r, false); r = __builtin_amdgcn_cvt_pk_fp8_f32(c, d, r, true); return (unsigned)r; }
__device__ __forceinline__ float bf2f(unsigned short h) { return __builtin_bit_cast(float, (unsigned)h << 16); }
__device__ __forceinline__ int relaunder(int x) { asm volatile("" : "+v"(x)); return x; }
__device__ __forceinline__ int lane_id() { return (int)__builtin_amdgcn_mbcnt_hi(~0u, __builtin_amdgcn_mbcnt_lo(~0u, 0u)); }
__device__ __forceinline__ float wave_sum(float v) {
#pragma unroll
    for (int o = 1; o < 64; o <<= 1) v += __shfl_xor(v, o);
    return v;
}

namespace pg8 {
constexpr int BM = 256, BK = 64, HALF = 128, HTB = HALF * BK * 2, STAGE_BYTES = 8 * HTB, NXCD = 8, WGM = 8;
__host__ __device__ __forceinline__ int lds_byte(int r, int c) { const int st = (r >> 4) * 2 + (c >> 5), rr = r & 15, cc = c & 31, ob = rr * 64 + cc * 2; return st * 1024 + (ob ^ (((ob >> 9) & 1) << 5)); }
__host__ __device__ __forceinline__ void stage_rc(int b, int& R, int& C) { const int st = b / 1024, sb = b % 1024, swz = sb ^ (((sb >> 9) & 1) << 5); R = (st >> 1) * 16 + swz / 64; C = (st & 1) * 32 + (swz % 64) / 2; }
__host__ __device__ __forceinline__ int perm32(int rho) { const int n = rho >> 4, i = rho & 15; return 8 * (i >> 2) + 4 * n + (i & 3); }

struct Unit { int pm, pn, e, t, pnl; };
struct Gemm { const bf16_t* A; const bf16_t* Bt; int K; unsigned sw = 0x7f7f7f7fu, sx = 0x7f7f7f7fu; };

struct DenseOrder {
    int nM, nN, nwg, G, c;
    __device__ void init(int Mr, int N, int G_, int c_) { nM = Mr / BM; nN = N / BM; nwg = nM * nN; G = G_; c = c_; }
    __device__ bool next(int i, Unit& u) const {
        const long L = (long)i * G + c; if (L >= nwg) return false;
        int wgid = (int)L; { const int q = nwg / NXCD, r = nwg % NXCD, xcd = wgid % NXCD, off = wgid / NXCD; wgid = (xcd < r ? xcd * (q + 1) : r * (q + 1) + (xcd - r) * q) + off; }
        const int nig = WGM * nN, gid = wgid / nig, fm = gid * WGM, gsz = (nM - fm) < WGM ? (nM - fm) : WGM;
        u.pm = fm + ((wgid % nig) % gsz); u.pn = (wgid % nig) / gsz; u.e = 0; u.t = 0; u.pnl = u.pn; return true;
    }
    __device__ __forceinline__ int token(const Unit&, int) const { return 0; }
};
struct MoeOrder {
    const LAS int* TP; const LAS int* CNT; const int* ltok; int G, c, pn_mul, pn_add;
    __device__ bool next(int i, Unit& u) const {
        const int ntile = __builtin_amdgcn_readfirstlane(TP[32]); const int nwg = ntile * 4;
        const long L = (long)i * G + c; if (L >= nwg) return false;
        int wgid = (int)L; { const int q = nwg / NXCD, r = nwg % NXCD, xcd = wgid % NXCD, off = wgid / NXCD; wgid = (xcd < r ? xcd * (q + 1) : r * (q + 1) + (xcd - r) * q) + off; }
        const int tau = wgid >> 2; int e = 0;
#pragma nounroll
        while (e < 31 && __builtin_amdgcn_readfirstlane(TP[e + 1]) <= tau) ++e;
        u.pm = tau; u.e = e; u.t = tau - __builtin_amdgcn_readfirstlane(TP[e]); u.pnl = wgid & 3; u.pn = e * pn_mul + pn_add + u.pnl; return true;
    }
    __device__ __forceinline__ int token(const Unit& u, int r) const { const int idx = u.t * 256 + r; return idx < CNT[u.e] ? ltok[(size_t)u.e * M + idx] : 0; }
};

struct EpiQKV {
    static constexpr bool PERM = true;
    bf16_t* O; int ldc; int qcols; float qscale; unsigned* kmaxsq;
    __device__ __forceinline__ void operator()(const f32x4 (&acc)[2][2][4][2], const Unit& u, int wr, int wc, int fr, int fq) const {
        asm volatile("" : "+v"(fr), "+v"(fq));
        const int row0 = u.pm * BM + wr * 64 + fr, colt = u.pn * BM; const float sc = colt < qcols ? qscale : 1.f;
        const int col0 = colt + wc * 32 + 8 * fq;
#pragma unroll
        for (int ai = 0; ai < 2; ++ai)
#pragma unroll
            for (int m = 0; m < 4; ++m) { bf16_t* rowp = O + (size_t)(row0 + ai * HALF + m * 16) * ldc + col0;
#pragma unroll
                for (int bj = 0; bj < 2; ++bj) { const f32x4 v0 = acc[ai][bj][m][0] * sc, v1 = acc[ai][bj][m][1] * sc;
                    u32x4 w; w.x = cvtpk(v0[0], v0[1]); w.y = cvtpk(v0[2], v0[3]); w.z = cvtpk(v1[0], v1[1]); w.w = cvtpk(v1[2], v1[3]);
                    *(u32x4*)(rowp + bj * HALF) = w; } }
        if (kmaxsq != nullptr && colt >= 1024 && colt < 2048) {
#pragma unroll
            for (int bj = 0; bj < 2; ++bj) { float mx = 0.f;
#pragma unroll
                for (int ai = 0; ai < 2; ++ai)
#pragma unroll
                    for (int m = 0; m < 4; ++m) { const f32x4 v0 = acc[ai][bj][m][0], v1 = acc[ai][bj][m][1];
                        float ss = (v0[0] * v0[0] + v0[1] * v0[1]) + (v0[2] * v0[2] + v0[3] * v0[3]) + (v1[0] * v1[0] + v1[1] * v1[1]) + (v1[2] * v1[2] + v1[3] * v1[3]);
                        ss += __shfl_xor(ss, 16); ss += __shfl_xor(ss, 32); mx = __builtin_fmaxf(mx, ss); }
                mx = __builtin_fmaxf(mx, __shfl_xor(mx, 1)); mx = __builtin_fmaxf(mx, __shfl_xor(mx, 2)); mx = __builtin_fmaxf(mx, __shfl_xor(mx, 4)); mx = __builtin_fmaxf(mx, __shfl_xor(mx, 8));
                if (fr == 0 && fq == 0) atomicMax(kmaxsq + (u.pm >> 5) * 32 + ((colt - 1024 + bj * HALF + wc * 32) >> 5), __float_as_uint(mx)); }
        }
    }
};
struct EpiResid {
    static constexpr bool PERM = false;
    const float* base; float* out;
    __device__ __forceinline__ void operator()(const f32x4 (&acc)[2][2][4][2], const Unit& u, int wr, int wc, int fr, int fq) const {
        asm volatile("" : "+v"(fr), "+v"(fq));
        const int col0 = u.pn * BM + wc * 32 + 4 * fq;
#pragma unroll
        for (int ai = 0; ai < 2; ++ai) {
            f32x4 b[4][2][2];
#pragma unroll
            for (int m = 0; m < 4; ++m) { const size_t off = (size_t)(u.pm * BM + ai * HALF + wr * 64 + m * 16 + fr) * D + col0;
#pragma unroll
                for (int bj = 0; bj < 2; ++bj)
#pragma unroll
                    for (int n = 0; n < 2; ++n) b[m][bj][n] = *(const f32x4*)(base + off + bj * HALF + n * 16); }
            asm volatile("" ::: "memory");
#pragma unroll
            for (int m = 0; m < 4; ++m) { const size_t off = (size_t)(u.pm * BM + ai * HALF + wr * 64 + m * 16 + fr) * D + col0;
#pragma unroll
                for (int bj = 0; bj < 2; ++bj)
#pragma unroll
                    for (int n = 0; n < 2; ++n) *(f32x4*)(out + off + bj * HALF + n * 16) = b[m][bj][n] + acc[ai][bj][m][n]; }
            asm volatile("" ::: "memory");
        }
    }
};
__device__ __forceinline__ float silu_mul(float g, float u) { return g * u * __builtin_amdgcn_rcpf(1.f + __builtin_amdgcn_exp2f(-g * LOG2E)); }
template <bool F8>
struct EpiSwiGLU {
    static constexpr bool PERM = true;
    bf16_t* H; const int* ltok; const float* rstd_tok; const LAS int* CNT;
    __device__ __forceinline__ void operator()(const f32x4 (&acc)[2][2][4][2], const Unit& u, int wr, int wc, int fr, int fq) const {
        asm volatile("" : "+v"(fr), "+v"(fq));
        const int colh = u.pnl * 128 + wc * 32 + 8 * fq; const int cnt = CNT[u.e];
        int toks[2][4]; float rss[2][4];
#pragma unroll
        for (int ai = 0; ai < 2; ++ai)
#pragma unroll
            for (int m = 0; m < 4; ++m) { const int idx = u.t * 256 + ai * HALF + wr * 64 + m * 16 + fr; toks[ai][m] = ltok[(size_t)u.e * M + (idx < cnt ? idx : 0)]; }
#pragma unroll
        for (int ai = 0; ai < 2; ++ai)
#pragma unroll
            for (int m = 0; m < 4; ++m) rss[ai][m] = rstd_tok[toks[ai][m]];
        asm volatile("" ::: "memory");
#pragma unroll
        for (int ai = 0; ai < 2; ++ai)
#pragma unroll
            for (int m = 0; m < 4; ++m) { const int rl = ai * HALF + wr * 64 + m * 16 + fr; const size_t row = (size_t)u.pm * BM + rl;
                const float rs = rss[ai][m];
                const f32x4 g0 = acc[ai][0][m][0] * rs, g1 = acc[ai][0][m][1] * rs, u0 = acc[ai][1][m][0] * rs, u1 = acc[ai][1][m][1] * rs;
                if constexpr (F8) {
                    u32x2 w; w.x = pk4_fp8(8.f * silu_mul(g0[0], u0[0]), 8.f * silu_mul(g0[1], u0[1]), 8.f * silu_mul(g0[2], u0[2]), 8.f * silu_mul(g0[3], u0[3]));
                    w.y = pk4_fp8(8.f * silu_mul(g1[0], u1[0]), 8.f * silu_mul(g1[1], u1[1]), 8.f * silu_mul(g1[2], u1[2]), 8.f * silu_mul(g1[3], u1[3]));
                    *(u32x2*)((unsigned char*)H + row * DEXP + colh) = w;
                } else {
                    u32x4 w; w.x = cvtpk(silu_mul(g0[0], u0[0]), silu_mul(g0[1], u0[1])); w.y = cvtpk(silu_mul(g0[2], u0[2]), silu_mul(g0[3], u0[3]));
                    w.z = cvtpk(silu_mul(g1[0], u1[0]), silu_mul(g1[1], u1[1])); w.w = cvtpk(silu_mul(g1[2], u1[2]), silu_mul(g1[3], u1[3]));
                    *(u32x4*)(H + row * DEXP + colh) = w; }
            }
    }
};
struct EpiDown {
    static constexpr bool PERM = true;
    bf16_t* Y; const float* lw;
    __device__ __forceinline__ void operator()(const f32x4 (&acc)[2][2][4][2], const Unit& u, int wr, int wc, int fr, int fq) const {
        asm volatile("" : "+v"(fr), "+v"(fq));
        const int col0 = u.pnl * BM + wc * 32 + 8 * fq;
        float scs[2][4];
#pragma unroll
        for (int ai = 0; ai < 2; ++ai)
#pragma unroll
            for (int m = 0; m < 4; ++m) scs[ai][m] = lw[(size_t)u.e * M + u.t * 256 + ai * HALF + wr * 64 + m * 16 + fr];
        asm volatile("" ::: "memory");
#pragma unroll
        for (int ai = 0; ai < 2; ++ai)
#pragma unroll
            for (int m = 0; m < 4; ++m) { const int rl = ai * HALF + wr * 64 + m * 16 + fr; const size_t row = (size_t)u.pm * BM + rl;
                const float sc = scs[ai][m];
#pragma unroll
                for (int bj = 0; bj < 2; ++bj) { const f32x4 v0 = acc[ai][bj][m][0] * sc, v1 = acc[ai][bj][m][1] * sc;
                    u32x4 w; w.x = cvtpk(v0[0], v0[1]); w.y = cvtpk(v0[2], v0[3]); w.z = cvtpk(v1[0], v1[1]); w.w = cvtpk(v1[2], v1[3]);
                    *(u32x4*)(Y + row * D + col0 + bj * HALF) = w; } }
    }
};

template <class Epi, class Sched, bool GATHER, bool ALIGN_EPI, bool FP8 = false>
__device__ __forceinline__ void gemm_phase(LAS unsigned char* lds, const Gemm g, const Sched& S, const Epi& E, const int wid, const int lane) {
    const int tid = wid * 64 + lane, wr = wid >> 2, wc = wid & 3, fr = lane & 15, fq = lane >> 4;
    const int K = g.K, nt = K / BK;
    int Rr[2], Cc[2]; unsigned voffB[2];
#pragma unroll
    for (int i = 0; i < 2; ++i) { int R, C; stage_rc(tid * 16 + i * 8192, R, C); Rr[i] = R; Cc[i] = C; const int Rb = Epi::PERM ? ((R & ~31) + perm32(R & 31)) : R; voffB[i] = (unsigned)(Rb * K + C) * 2u; }
    const size_t kstep = (size_t)(BK * 2);
    const size_t hstep = (size_t)HALF * K * 2;
    const size_t tstep = 2 * hstep;
    const unsigned ldsw = (unsigned)wid * 1024u;
    const size_t R64 = (size_t)64 * K * 2;
    const size_t H1 = GATHER ? 0 : hstep;
    const int aoff = FP8 ? lds_byte(wr * 64 + fr, (fq >> 1) * 32 + (fq & 1) * 16) : lds_byte(wr * 64 + fr, fq * 8), boff = FP8 ? lds_byte(wc * 32 + fr, (fq >> 1) * 32 + (fq & 1) * 16) : lds_byte(wc * 32 + fr, fq * 8);

#define PG8_SA(b, h) (((b) * 2 + (h)) * HTB)
#define PG8_SB(b, h) ((4 + (b) * 2 + (h)) * HTB)
#define PG8_STAGE2(bufoff, gbase, o0, o1) do { \
        __builtin_amdgcn_global_load_lds((const unsigned*)((const char*)(gbase) + (o0)), (LAS unsigned*)(lds + (bufoff) + ldsw), 16, 0, 0); \
        __builtin_amdgcn_global_load_lds((const unsigned*)((const char*)(gbase) + (o1)), (LAS unsigned*)(lds + (bufoff) + ldsw + 8192), 16, 0, 0); } while (0)
#define PG8_STAGEB(bufoff, gbase) do {   \
        __builtin_amdgcn_global_load_lds((const unsigned*)((const char*)(gbase) + voffB[0]), (LAS unsigned*)(lds + (bufoff) + ldsw), 16, 0, 0); \
        __builtin_amdgcn_global_load_lds((const unsigned*)((const char*)(gbase) + R64 + voffB[0]), (LAS unsigned*)(lds + (bufoff) + ldsw + 8192), 16, 0, 0); } while (0)
#define PG8_LDA(dst, b, h) do { if constexpr (FP8) { _Pragma("unroll") for (int m = 0; m < 4; ++m) dst##8[m] = *(const LAS i32x8*)(lds + PG8_SA(b, h) + aoff + m * 2048); } \
        else { _Pragma("unroll") for (int m = 0; m < 4; ++m) _Pragma("unroll") for (int k = 0; k < 2; ++k) dst[m][k] = *(const LAS bf16x8*)(lds + PG8_SA(b, h) + aoff + m * 2048 + k * 1024); } } while (0)
#define PG8_LDB(dst, b, h) do { if constexpr (FP8) { _Pragma("unroll") for (int n = 0; n < 2; ++n) dst##8[n] = *(const LAS i32x8*)(lds + PG8_SB(b, h) + boff + n * 2048); } \
        else { _Pragma("unroll") for (int n = 0; n < 2; ++n) _Pragma("unroll") for (int k = 0; k < 2; ++k) dst[n][k] = *(const LAS bf16x8*)(lds + PG8_SB(b, h) + boff + n * 2048 + k * 1024); } } while (0)
#define PG8_CAT8(x) __builtin_shufflevector(__builtin_bit_cast(i32x4, (x)[0]), __builtin_bit_cast(i32x4, (x)[1]), 0, 1, 2, 3, 4, 5, 6, 7)
#define PG8_MMA(ai, bj, At, Bt) do { if constexpr (FP8) __builtin_amdgcn_sched_barrier(0); __builtin_amdgcn_s_setprio(1); _Pragma("unroll") for (int m = 0; m < 4; ++m) _Pragma("unroll") for (int n = 0; n < 2; ++n) { \
        if constexpr (FP8) acc[ai][bj][m][n] = __builtin_amdgcn_mfma_scale_f32_16x16x128_f8f6f4(Bt##8[n], At##8[m], acc[ai][bj][m][n], 0, 0, 0, (int)g.sw, 0, (int)g.sx); \
        else { _Pragma("unroll") for (int k = 0; k < 2; ++k) acc[ai][bj][m][n] = __builtin_amdgcn_mfma_f32_16x16x32_bf16(Bt[n][k], At[m][k], acc[ai][bj][m][n], 0, 0, 0); } } \
        if constexpr (FP8) { _Pragma("unroll") for (int m = 0; m < 4; ++m) _Pragma("unroll") for (int n = 0; n < 2; ++n) asm volatile("" : "+v"(acc[ai][bj][m][n])); }   \
        __builtin_amdgcn_s_setprio(0); if constexpr (FP8) __builtin_amdgcn_sched_barrier(0); } while (0)
#define PG8_WAIT_V(n) asm volatile("s_waitcnt vmcnt(" #n ")" ::: "memory")
#define PG8_WAIT_L(n) asm volatile("s_waitcnt lgkmcnt(" #n ")" ::: "memory")
#define PG8_BAR __builtin_amdgcn_s_barrier()
#define PG8_SCHED __builtin_amdgcn_sched_barrier(0)
    Unit cur, nxt; int ui = 0;
    if (!S.next(0, cur)) return;
    unsigned oc00, oc01, oc10, oc11;
    LAS u32x4* stash = (LAS u32x4*)(lds + (STASH_OFF - 0) ) + tid;
    if constexpr (GATHER) {
        oc00 = (unsigned)(S.token(cur, Rr[0]) * K + Cc[0]) * 2u; oc01 = (unsigned)(S.token(cur, Rr[1]) * K + Cc[1]) * 2u;
        oc10 = (unsigned)(S.token(cur, 128 + Rr[0]) * K + Cc[0]) * 2u; oc11 = (unsigned)(S.token(cur, 128 + Rr[1]) * K + Cc[1]) * 2u;
    } else {
        oc00 = (unsigned)(Rr[0] * K + Cc[0]) * 2u; oc01 = (unsigned)(Rr[1] * K + Cc[1]) * 2u; oc10 = oc00; oc11 = oc01;
    }
    f32x4 acc[2][2][4][2];
#pragma unroll
    for (int a = 0; a < 2; ++a)
#pragma unroll
        for (int b = 0; b < 2; ++b)
#pragma unroll
            for (int m = 0; m < 4; ++m)
#pragma unroll
                for (int n = 0; n < 2; ++n) acc[a][b][m][n] = (f32x4){0.f, 0.f, 0.f, 0.f};
    bf16x8 At[4][2], B0[2][2], B1[2][2];
    i32x8 At8[4], B08[2], B18[2];
    const char* cA = GATHER ? (const char*)g.A : (const char*)g.A + (size_t)cur.pm * tstep; const char* cB = (const char*)g.Bt + (size_t)cur.pn * tstep;
    PG8_STAGEB(PG8_SB(0, 0), cB); PG8_STAGEB(PG8_SB(0, 1), cB + hstep); PG8_STAGE2(PG8_SA(0, 0), cA, oc00, oc01); PG8_STAGE2(PG8_SA(0, 1), cA + H1, oc10, oc11);
    if (wr == 1) PG8_BAR;
    PG8_WAIT_V(2); PG8_BAR;
    PG8_STAGEB(PG8_SB(1, 0), cB + kstep); PG8_STAGE2(PG8_SA(1, 0), cA + kstep, oc00, oc01); PG8_STAGEB(PG8_SB(1, 1), cB + hstep + kstep);
    PG8_WAIT_V(6); PG8_BAR;
    for (;;) {
        const bool has_next = S.next(ui + 1, nxt);
        const char* nA = has_next ? (GATHER ? (const char*)g.A : (const char*)g.A + (size_t)nxt.pm * tstep) : cA; const char* nB = has_next ? (const char*)g.Bt + (size_t)nxt.pn * tstep : cB;
        if constexpr (GATHER) {
            u32x4 nx = {oc00, oc01, oc10, oc11};
            if (has_next) { int R0, C0, R1, C1; stage_rc(tid * 16, R0, C0); stage_rc(tid * 16 + 8192, R1, C1);
                nx.x = (unsigned)(S.token(nxt, R0) * K + C0) * 2u; nx.y = (unsigned)(S.token(nxt, R1) * K + C1) * 2u;
                nx.z = (unsigned)(S.token(nxt, 128 + R0) * K + C0) * 2u; nx.w = (unsigned)(S.token(nxt, 128 + R1) * K + C1) * 2u; }
            *stash = nx;
        }
        for (int t = 0; t < nt; t += 2) {
            const bool last = (t == nt - 2);
            const char* a1 = cA + (size_t)(t + 1) * kstep;
            const char* a2 = last ? nA : cA + (size_t)(t + 2) * kstep; const char* b2 = last ? nB : cB + (size_t)(t + 2) * kstep;
            const char* a3 = a2 + kstep; const char* b3 = b2 + kstep;
            unsigned x00 = oc00, x01 = oc01, x10 = oc10, x11 = oc11;
            if constexpr (GATHER) { if (last) { const u32x4 nx = *stash; x00 = nx.x; x01 = nx.y; x10 = nx.z; x11 = nx.w; } }
            PG8_LDB(B0, 0, 0); PG8_LDB(B1, 0, 1); PG8_SCHED; PG8_LDA(At, 0, 0); PG8_STAGE2(PG8_SA(1, 1), a1 + H1, oc10, oc11);
            PG8_WAIT_V(8); PG8_WAIT_L(0); PG8_BAR; PG8_MMA(0, 0, At, B0); PG8_MMA(0, 1, At, B1); PG8_BAR; PG8_SCHED;
            PG8_LDA(At, 0, 1); PG8_STAGEB(PG8_SB(0, 0), b2); PG8_STAGEB(PG8_SB(0, 1), b2 + hstep); PG8_STAGE2(PG8_SA(0, 0), a2, x00, x01);
            PG8_WAIT_V(8); PG8_WAIT_L(0); PG8_BAR; PG8_MMA(1, 0, At, B0); PG8_MMA(1, 1, At, B1); PG8_BAR; PG8_SCHED;
            PG8_LDB(B0, 1, 0); PG8_LDB(B1, 1, 1); PG8_SCHED; PG8_LDA(At, 1, 0); PG8_STAGE2(PG8_SA(0, 1), a2 + H1, x10, x11);
            PG8_WAIT_V(8); PG8_WAIT_L(0); PG8_BAR; PG8_MMA(0, 0, At, B0); PG8_MMA(0, 1, At, B1); PG8_BAR; PG8_SCHED;
            PG8_LDA(At, 1, 1); PG8_STAGEB(PG8_SB(1, 0), b3); PG8_STAGEB(PG8_SB(1, 1), b3 + hstep); PG8_STAGE2(PG8_SA(1, 0), a3, x00, x01);
            PG8_WAIT_V(8); PG8_WAIT_L(0); PG8_BAR; PG8_MMA(1, 0, At, B0); PG8_MMA(1, 1, At, B1); PG8_BAR; PG8_SCHED;
        }
        if constexpr (ALIGN_EPI) { if (wr == 0) PG8_BAR; }
        E(acc, cur, wr, wc, fr, fq);
        if (!has_next) break;
#pragma unroll
        for (int a = 0; a < 2; ++a)
#pragma unroll
            for (int b = 0; b < 2; ++b)
#pragma unroll
                for (int m = 0; m < 4; ++m)
#pragma unroll
                    for (int n = 0; n < 2; ++n) acc[a][b][m][n] = (f32x4){0.f, 0.f, 0.f, 0.f};
        cur = nxt; cA = nA; cB = nB; ++ui;
        if constexpr (GATHER) { const u32x4 nx = *stash; oc00 = nx.x; oc01 = nx.y; oc10 = nx.z; oc11 = nx.w; }
        if constexpr (ALIGN_EPI) { if (wr == 1) PG8_BAR; }
    }
    PG8_WAIT_V(0);
    if constexpr (!ALIGN_EPI) { if (wr == 0) PG8_BAR; }
    PG8_BAR;
#undef PG8_SA
#undef PG8_SB
#undef PG8_STAGE2
#undef PG8_STAGEB
#undef PG8_LDA
#undef PG8_LDB
#undef PG8_MMA
#undef PG8_CAT8
#undef PG8_WAIT_V
#undef PG8_WAIT_L
#undef PG8_BAR
#undef PG8_SCHED
}
}

namespace att {
constexpr int NSLOT = 3;
constexpr float THR = 8.0f;
__device__ __forceinline__ void glds16(const void* gsrc, unsigned lds_dst) { unsigned keep;
    asm volatile("s_mov_b32 %0, m0\n\ts_mov_b32 m0, %2\n\ts_nop 0\n\tglobal_load_lds_dwordx4 %1, off\n\ts_mov_b32 m0, %0" : "=&s"(keep) : "v"(gsrc), "s"(lds_dst) : "memory"); }
#define ATT_WAIT_BAR(N) asm volatile("s_waitcnt vmcnt(" #N ") lgkmcnt(0)\n\ts_barrier" ::: "memory")
typedef LAS const char* lds_cptr;
typedef short v4i16_t __attribute__((ext_vector_type(4)));
__device__ __forceinline__ s16x4 vtr(lds_cptr p) { return __builtin_bit_cast(s16x4, __builtin_amdgcn_ds_read_tr16_b64_v4i16((LAS v4i16_t*)p)); }
__device__ __forceinline__ float swap_max(float m) { auto rr = __builtin_amdgcn_permlane32_swap(__float_as_uint(m), __float_as_uint(m), false, false); return __builtin_fmaxf(__uint_as_float(rr[0]), __uint_as_float(rr[1])); }
__device__ __forceinline__ float swap_sum(float m) { auto rr = __builtin_amdgcn_permlane32_swap(__float_as_uint(m), __float_as_uint(m), false, false); return __uint_as_float(rr[0]) + __uint_as_float(rr[1]); }
__device__ __forceinline__ float max3f(float a, float b, float c) { float r; asm("v_max3_f32 %0, %1, %2, %3" : "=v"(r) : "v"(a), "v"(b), "v"(c)); return r; }
template <unsigned KB> __device__ __forceinline__ float fmamk(float a, float c) { float r; asm("v_fmamk_f32 %0, %1, %2, %3" : "=v"(r) : "v"(a), "i"(KB), "v"(c)); return r; }
#define CRF(r) ((float)(((r) & 3) + 8 * ((r) >> 2)))
#define CRI(r) (((r) & 3) + 8 * ((r) >> 2))

template <int MODE> struct Cfg;
template <> struct Cfg<0> { static constexpr int DV32 = 2, NK = 1, SLOTB = 16384, VOFF = 8192, PITCH = SWA_N, NVP = 1; };
template <> struct Cfg<1> { static constexpr int DV32 = 4, NK = 2, SLOTB = 32768, VOFF = 16384, PITCH = DIFF_N, NVP = 2; };

template <int MODE>
__device__ __forceinline__ void tile_step(lds_cptr kp, lds_cptr vp, const bf16x8 (&qr)[4], f32x16 (&o)[Cfg<MODE>::DV32], float& mhat, float& l, bool& first,
                                          const float slope2, const int dq_i, const int kind, const int hi) {
    constexpr int DV32 = Cfg<MODE>::DV32;
    f32x16 p0, p1;
    const float dq = (float)dq_i, nm = -mhat;
    {
        const float sl = kind == 2 ? 0.f : (kind == 0 ? slope2 : -slope2); const float base0 = __builtin_fmaf(-sl, dq, nm);
#pragma unroll
        for (int r = 0; r < 16; ++r) { p0[r] = __builtin_fmaf(sl, CRF(r), base0); p1[r] = __builtin_fmaf(sl, CRF(r) + 32.f, base0); }
    }
#pragma unroll
    for (int d0 = 0; d0 < 4; ++d0) {
        const bf16x8 b0 = *(const LAS bf16x8*)(kp + d0 * 2048);
        const bf16x8 b1 = *(const LAS bf16x8*)(kp + d0 * 2048 + 512);
        p0 = __builtin_amdgcn_mfma_f32_32x32x16_bf16(b0, qr[d0], p0, 0, 0, 0);
        p1 = __builtin_amdgcn_mfma_f32_32x32x16_bf16(b1, qr[d0], p1, 0, 0, 0);
    }
    if (kind == 2) {
#pragma unroll
        for (int r = 0; r < 16; ++r) {
            const float e0 = __builtin_fabsf(dq - CRF(r)), e1 = __builtin_fabsf(dq - CRF(r) - 32.f);
            if (MODE == 0) { p0[r] = e0 <= 128.f ? __builtin_fmaf(-slope2, e0, p0[r]) : -INFINITY; p1[r] = e1 <= 128.f ? __builtin_fmaf(-slope2, e1, p1[r]) : -INFINITY; }
            else { p0[r] = __builtin_fmaf(-slope2, e0, p0[r]); p1[r] = __builtin_fmaf(-slope2, e1, p1[r]); }
        }
    }
    float rm = __builtin_fmaxf(p0[0], p1[0]);
#pragma unroll
    for (int r = 1; r < 16; ++r) rm = __builtin_fmaxf(rm, __builtin_fmaxf(p0[r], p1[r]));
    rm = swap_max(rm);
    if (first || __any(rm > THR)) {
        const float dl = first ? rm : __builtin_fmaxf(rm, 0.f);
        mhat += dl;
#pragma unroll
        for (int r = 0; r < 16; ++r) { p0[r] -= dl; p1[r] -= dl; }
        if (!first) {
            const float f = __builtin_amdgcn_exp2f(-dl); l *= f;
#pragma unroll
            for (int r = 0; r < 16; ++r) { int h4_ = 4 * hi; asm volatile("" : "+v"(h4_)); const float fr_ = __shfl(f, CRI(r) + h4_);
#pragma unroll
                for (int d0 = 0; d0 < DV32; ++d0) o[d0][r] *= fr_; }
        }
        first = false;
    }
    float sacc = 0.f;
    u32x4 pw[4];
#pragma unroll
    for (int s = 0; s < 2; ++s) {
        float e[8];
#pragma unroll
        for (int j = 0; j < 8; ++j) { e[j] = __builtin_amdgcn_exp2f(p0[8 * s + j]); sacc += e[j]; }
        pw[s] = (u32x4){cvtpk(e[0], e[1]), cvtpk(e[2], e[3]), cvtpk(e[4], e[5]), cvtpk(e[6], e[7])};
    }
#pragma unroll
    for (int s = 0; s < 2; ++s) {
        float e[8];
#pragma unroll
        for (int j = 0; j < 8; ++j) { e[j] = __builtin_amdgcn_exp2f(p1[8 * s + j]); sacc += e[j]; }
        pw[2 + s] = (u32x4){cvtpk(e[0], e[1]), cvtpk(e[2], e[3]), cvtpk(e[4], e[5]), cvtpk(e[6], e[7])};
    }
    l += sacc;
#pragma unroll
    for (int d0 = 0; d0 < DV32; ++d0) {
#pragma unroll
        for (int ks = 0; ks < 4; ++ks) {
            const s16x4 lo = vtr(vp + d0 * 4096 + ks * 1024), hh = vtr(vp + d0 * 4096 + ks * 1024 + 512);
            const bf16x8 vf = (bf16x8){lo[0], lo[1], lo[2], lo[3], hh[0], hh[1], hh[2], hh[3]};
            o[d0] = __builtin_amdgcn_mfma_f32_32x32x16_bf16(__builtin_bit_cast(bf16x8, pw[ks]), vf, o[d0], 0, 0, 0);
        }
    }
}

struct DiffConsts { float lam_full; const float* subln; };

template <int MODE>
__device__ __forceinline__ void attn_unit(const int b, const int hh, const int qb, const bf16_t* __restrict__ QKV, bf16_t* __restrict__ O, const float* __restrict__ sink,
                                          const DiffConsts dc, LAS unsigned char* shm, const int wid, const int lane_in) {
    typedef Cfg<MODE> C;
    constexpr int DV32 = C::DV32, PITCH = C::PITCH;
    int lane = lane_in; asm volatile("" : "+v"(lane));
    const int r32 = lane & 31, hi = lane >> 5;
    int iw, qcol, kcol, vcol, t_lo, NT, hq = 0, cmap = 0, qs;
    float slope2;
    if (MODE == 0) { const int g = wid >> 1; qs = wid & 1; hq = hh * 4 + g; iw = qb * 64 + qs * 32; qcol = hq * 64; kcol = 1024 + hh * 64; vcol = 1280 + hh * 64;
        t_lo = qb - 2 < 0 ? 0 : qb - 2; const int t_hi = qb + 2 > 127 ? 127 : qb + 2; NT = t_hi - t_lo + 1; slope2 = __builtin_amdgcn_exp2f(-0.5f * (float)(hq + 1)) * LOG2E; }
    else { qs = wid & 3; cmap = wid >> 2; iw = qb * 128 + qs * 32; qcol = (hh * 2 + cmap) * 64; kcol = 1024 + hh * 128; vcol = 2048 + hh * 128; t_lo = 0; NT = SEQ / 64;
        slope2 = __builtin_amdgcn_exp2f(-(float)(hh + 1)) * LOG2E; }
    const bf16_t* base = QKV + (size_t)b * SEQ * PITCH;
    const unsigned lds0 = (unsigned)(uintptr_t)shm;
    const unsigned koff = (unsigned)(lane * PITCH + kcol + wid * 8) * 2u;
    const unsigned voff = (unsigned)((16 * (wid & 3) + (lane >> 2)) * PITCH + vcol + (wid >> 2) * 32 + (lane & 3) * 8) * 2u;
    const unsigned kdst = lds0 + wid * 1024, vdst = lds0 + C::VOFF + wid * 1024;
#define ATT_DMA(t, slot) do { const char* tb_ = (const char*)base + (size_t)(t) * 64 * PITCH * 2; const unsigned so_ = (unsigned)(slot) * C::SLOTB; \
        glds16(tb_ + koff, (unsigned)__builtin_amdgcn_readfirstlane(kdst + so_)); \
        if (MODE == 1) glds16(tb_ + koff + 128, (unsigned)__builtin_amdgcn_readfirstlane(kdst + so_ + 8192)); \
        glds16(tb_ + voff, (unsigned)__builtin_amdgcn_readfirstlane(vdst + so_)); \
        if (MODE == 1) glds16(tb_ + voff + 128, (unsigned)__builtin_amdgcn_readfirstlane(vdst + so_ + 8192)); } while (0)
    ATT_DMA(t_lo, 0);
    if (NT > 1) ATT_DMA(t_lo + 1, 1);
    bf16x8 qr[4];
    { const bf16_t* Qw = base + (size_t)(iw + r32) * PITCH + qcol;
#pragma unroll
      for (int d0 = 0; d0 < 4; ++d0) qr[d0] = *(const bf16x8*)(Qw + d0 * 16 + hi * 8); }
    f32x16 o[DV32];
#pragma unroll
    for (int d0 = 0; d0 < DV32; ++d0)
#pragma unroll
        for (int r = 0; r < 16; ++r) o[d0][r] = 0.f;
    float mhat = 0.f, l = 0.f; bool first = true;
    if (MODE == 0) { mhat = sink[hq] * LOG2E; l = (hi == 0) ? 1.f : 0.f; first = false; }
    const lds_cptr shm3 = (lds_cptr)shm;
    const lds_cptr kp0 = shm3 + (MODE == 1 ? cmap * 8192 : 0) + hi * 1024 + r32 * 16;
    const lds_cptr vp0 = shm3 + C::VOFF + ((lane >> 4) & 1) * 32 + (lane & 3) * 8 + (4 * hi + ((lane & 15) >> 2)) * 64;
    int slot = 0;
    for (int it = 0; it < NT; ++it) {
        if (it + 1 < NT) { if (MODE == 1) { ATT_WAIT_BAR(4); } else { ATT_WAIT_BAR(2); } } else { ATT_WAIT_BAR(0); }
        if (it + 2 < NT) { const int s2 = slot == 0 ? 2 : slot - 1; ATT_DMA(t_lo + it + 2, s2); }
        const int k0 = (t_lo + it) * 64;
        const int kind = (MODE == 0) ? ((t_lo + it == qb - 1) ? 0 : ((t_lo + it == qb + 1) ? 1 : 2)) : ((k0 + 63 < iw) ? 0 : ((k0 > iw + 31) ? 1 : 2));
        tile_step<MODE>(kp0 + slot * C::SLOTB, vp0 + slot * C::SLOTB, qr, o, mhat, l, first, slope2, iw + r32 - k0 - 4 * hi, kind, hi);
        slot = slot == 2 ? 0 : slot + 1;
    }
#undef ATT_DMA
    l = swap_sum(l);
    const float rl = 1.f / l;
    if (MODE == 0) {
        bf16_t* Ow = O + (size_t)(b * SEQ + iw) * D + hq * 64 + r32;
#pragma unroll
        for (int r = 0; r < 16; ++r) { const int row = CRI(r) + 4 * hi; const float rr = __shfl(rl, row);
#pragma unroll
            for (int d0 = 0; d0 < DV32; ++d0) Ow[(size_t)row * D + d0 * 32] = (bf16_t)f2bf(o[d0][r] * rr); }
        ATT_WAIT_BAR(0);
    } else {
        LAS float* cb = (LAS float*)shm + qs * 4096;
        ATT_WAIT_BAR(0);
        if (cmap == 1) {
#pragma unroll
            for (int r = 0; r < 16; ++r) { const int row = CRI(r) + 4 * hi; const float rr = __shfl(rl, row) * dc.lam_full;
#pragma unroll
                for (int d0 = 0; d0 < DV32; ++d0) cb[row * 128 + d0 * 32 + r32] = o[d0][r] * rr; }
        }
        ATT_WAIT_BAR(0);
        if (cmap == 0) {
            bf16_t* Ow = O + (size_t)(b * SEQ + iw) * D + hh * 128 + r32;
            float gsub[DV32];
#pragma unroll
            for (int d0 = 0; d0 < DV32; ++d0) gsub[d0] = dc.subln[d0 * 32 + r32] * (1.f - LAMBDA_INIT);
#pragma unroll
            for (int r = 0; r < 16; ++r) { const int row = CRI(r) + 4 * hi; const float rr = __shfl(rl, row);
                float v[DV32]; float ss = 0.f;
#pragma unroll
                for (int d0 = 0; d0 < DV32; ++d0) { v[d0] = o[d0][r] * rr - cb[row * 128 + d0 * 32 + r32]; ss += v[d0] * v[d0]; }
                ss += __shfl_xor(ss, 1); ss += __shfl_xor(ss, 2); ss += __shfl_xor(ss, 4); ss += __shfl_xor(ss, 8); ss += __shfl_xor(ss, 16);
                const float sc = __builtin_amdgcn_rsqf(ss * (1.f / 128.f) + 1e-5f);
#pragma unroll
                for (int d0 = 0; d0 < DV32; ++d0) Ow[(size_t)row * D + d0 * 32] = (bf16_t)f2bf(v[d0] * sc * gsub[d0]); }
        }
        ATT_WAIT_BAR(0);
    }
}

#define SBAR() __builtin_amdgcn_sched_barrier(0)
#define PIN(x) asm volatile("" : "+v"(x))
#define MF(a, b, c) __builtin_amdgcn_mfma_f32_32x32x16_bf16(a, b, c, 0, 0, 0)
template <int VAR>
__device__ __forceinline__ void diff_unit(const int b, const int hh, const int qb, const bf16_t* __restrict__ QKV, bf16_t* __restrict__ O, const float kmax,
                                          const DiffConsts dc, LAS unsigned char* shm, const int wid, const int lane_in) {
    constexpr int DV32 = 4, PITCH = DIFF_N, KSLOT = 16384, VRING = 4 * 16384;
    int lane = lane_in; asm volatile("" : "+v"(lane));
    const int r32 = lane & 31, hi = lane >> 5;
    const int qs = wid & 3, cmap = wid >> 2, i0 = qb * 128, iw = i0 + qs * 32, qcol = (hh * 2 + cmap) * 64, kcol = 1024 + hh * 128, vcol = 2048 + hh * 128;
    const float slope2 = __builtin_amdgcn_exp2f(-(float)(hh + 1)) * LOG2E;
    const bf16_t* base = QKV + (size_t)b * SEQ * PITCH;
    const unsigned lds0 = (unsigned)(uintptr_t)shm;
    const unsigned koff = (unsigned)(lane * PITCH + kcol + wid * 8) * 2u;
    const unsigned voff = (unsigned)((16 * (wid & 3) + (lane >> 2)) * PITCH + vcol + (wid >> 2) * 32 + (lane & 3) * 8) * 2u;
    const unsigned kdst = lds0 + wid * 1024, vdst = lds0 + VRING + wid * 1024;
#define DMA_K(t, slot) do { const char* tb_ = (const char*)base + (size_t)(t) * 64 * PITCH * 2; const unsigned so_ = (unsigned)(slot) * KSLOT; \
        glds16(tb_ + koff, (unsigned)__builtin_amdgcn_readfirstlane(kdst + so_)); glds16(tb_ + koff + 128, (unsigned)__builtin_amdgcn_readfirstlane(kdst + so_ + 8192)); } while (0)
#define DMA_V(t, slot) do { const char* tb_ = (const char*)base + (size_t)(t) * 64 * PITCH * 2; const unsigned so_ = (unsigned)(slot) * KSLOT; \
        glds16(tb_ + voff, (unsigned)__builtin_amdgcn_readfirstlane(vdst + so_)); glds16(tb_ + voff + 128, (unsigned)__builtin_amdgcn_readfirstlane(vdst + so_ + 8192)); } while (0)
    const int td0 = 2 * qb;
    int nL = td0;
#define TILE_OF(idx) ((idx) < 2 ? td0 + (idx) : ((idx) - 2 < nL ? td0 - 1 - ((idx) - 2) : td0 + 2 + ((idx) - 2 - nL)))
    DMA_K(td0, 0); DMA_V(td0, 0); DMA_K(td0 + 1, 1); DMA_V(td0 + 1, 1); DMA_K(TILE_OF(2), 2);
    bf16x8 qr[4]; float nq2 = 0.f;
    { const bf16_t* Qw = base + (size_t)(iw + r32) * PITCH + qcol;
#pragma unroll
      for (int d0 = 0; d0 < 4; ++d0) { qr[d0] = *(const bf16x8*)(Qw + d0 * 16 + hi * 8);
#pragma unroll
          for (int j = 0; j < 8; ++j) { const float f = bf2f((unsigned short)qr[d0][j]); nq2 += f * f; } } }
    nq2 = swap_sum(nq2);
    f32x16 o[DV32];
#pragma unroll
    for (int d0 = 0; d0 < DV32; ++d0)
#pragma unroll
        for (int r = 0; r < 16; ++r) o[d0][r] = 0.f;
    float mhat = 0.f, l = 0.f; bool first = true;
    const lds_cptr shm3 = (lds_cptr)shm;
    const lds_cptr kp0 = shm3 + cmap * 8192 + hi * 1024 + r32 * 16;
    const lds_cptr vp0 = shm3 + VRING + ((lane >> 4) & 1) * 32 + (lane & 3) * 8 + (4 * hi + ((lane & 15) >> 2)) * 64;
    LAS float* wsf = (LAS float*)(shm + 7 * KSLOT);
    ATT_WAIT_BAR(6);
    DMA_K(TILE_OF(3), 3);
    { const int k0 = td0 * 64; const int kind = (k0 + 63 < iw) ? 0 : ((k0 > iw + 31) ? 1 : 2);
      tile_step<1>(kp0, vp0, qr, o, mhat, l, first, slope2, iw + r32 - k0 - 4 * hi, kind, hi); }
    ATT_WAIT_BAR(4);
    DMA_K(TILE_OF(4), 0); DMA_V(TILE_OF(2), 2);
    { const int k0 = (td0 + 1) * 64; const int kind = (k0 + 63 < iw) ? 0 : ((k0 > iw + 31) ? 1 : 2);
      tile_step<1>(kp0 + KSLOT, vp0 + KSLOT, qr, o, mhat, l, first, slope2, iw + r32 - k0 - 4 * hi, kind, hi); }
    { float a = sqrtf(nq2) * kmax - mhat;
#pragma unroll
      for (int o_ = 1; o_ < 32; o_ <<= 1) a = __builtin_fmaxf(a, __shfl_xor(a, o_));
      if (lane == 0) wsf[wid] = a; }
    ATT_WAIT_BAR(4);
    int NT;
    { float amax = wsf[0];
#pragma unroll
      for (int w = 1; w < 8; ++w) amax = __builtin_fmaxf(amax, wsf[w]);
      const float dist = (64.f + __builtin_fmaxf(amax, 0.f)) / slope2;
      const float lo_f = ((float)(i0 - 63) - dist) * (1.f / 64.f), hi_f = ((float)(i0 + 127) + dist) * (1.f / 64.f);
      int t_lo = lo_f <= 0.f ? 0 : (int)lo_f, t_hi = hi_f >= 127.f ? 127 : (int)hi_f;
      if (t_lo > td0 - 2) t_lo = td0 - 2 < 0 ? 0 : td0 - 2; if (t_hi < td0 + 3) t_hi = td0 + 3 > 127 ? 127 : td0 + 3;
      t_lo = __builtin_amdgcn_readfirstlane(t_lo); t_hi = __builtin_amdgcn_readfirstlane(t_hi);
      nL = td0 - t_lo; NT = 2 + nL + (t_hi - (td0 + 1)); if (VAR & 256) NT = 2; }
    f32x16 xa0, xa1, xb0, xb1; u32x4 pw0, pw1, pw2, pw3; bf16x8 kf0, kf1, kf2, kf3; s16x4 vl0, vh0, vl1, vh1, vl2, vh2, vl3, vh3;
    float sl_n, base_n, rf = 1.f; bool resc = false;
#define KRD(dst, f) do { if ((VAR & 4) && (f) >= 4) break; dst = *(const LAS bf16x8*)(kp_ + ((f) >> 1) * 2048 + ((f) & 1) * 512); } while (0)
#define VRD(lo, hh_, i) do { if ((VAR & 2) && (i) >= 4) break; lo = vtr(vp_ + ((i) >> 2) * 4096 + ((i) & 3) * 1024); hh_ = vtr(vp_ + ((i) >> 2) * 4096 + ((i) & 3) * 1024 + 512); } while (0)
#define KRN(dst, f) dst = *(const LAS bf16x8*)(kn_ + ((f) >> 1) * 2048 + ((f) & 1) * 512)
#define VFR(lo, hh_) (bf16x8){lo[0], lo[1], lo[2], lo[3], hh_[0], hh_[1], hh_[2], hh_[3]}
#define SET_NEXT(idx) do { const int tn_ = TILE_OF(idx); const bool left_ = (idx) - 2 < nL; sl_n = left_ ? slope2 : -slope2; \
        base_n = __builtin_fmaf(-sl_n, (float)(iw + r32 - tn_ * 64 - 4 * hi), -mhat); } while (0)
#define CINIT(X0, X1) do { _Pragma("unroll") for (int r = 0; r < 16; ++r) { X0[r] = __builtin_fmaf(sl_n, CRF(r), base_n); X1[r] = __builtin_fmaf(sl_n, CRF(r) + 32.f, base_n); } } while (0)
#define GA(Sx, KF, qf, RD, P, e, PW, w0, w1) do { Sx = MF(KF, qf, Sx); RD; if (!(VAR & 32)) { sacc += P[e]; sacc += P[e + 1]; sacc += P[e + 2]; sacc += P[e + 3]; PIN(sacc); \
        PW[w0] = cvtpk(P[e], P[e + 1]); PW[w1] = cvtpk(P[e + 2], P[e + 3]); } PIN(PW); SBAR(); } while (0)
#define PHASE_A(S0, S1, P0, P1) do { float sacc = 0.f; \
        GA(S0, kf0, qr[0], KRD(kf0, 4), P0, 0,  pw0, 0, 1); GA(S1, kf1, qr[0], KRD(kf1, 5), P0, 4,  pw0, 2, 3); \
        GA(S0, kf2, qr[1], KRD(kf2, 6), P0, 8,  pw1, 0, 1); GA(S1, kf3, qr[1], KRD(kf3, 7), P0, 12, pw1, 2, 3); \
        GA(S0, kf0, qr[2], VRD(vl0, vh0, 0), P1, 0,  pw2, 0, 1); GA(S1, kf1, qr[2], VRD(vl1, vh1, 1), P1, 4,  pw2, 2, 3); \
        GA(S0, kf2, qr[3], VRD(vl2, vh2, 2), P1, 8,  pw3, 0, 1); GA(S1, kf3, qr[3], VRD(vl3, vh3, 3), P1, 12, pw3, 2, 3); \
        l += sacc; } while (0)
#define QK_ONLY(S0, S1) do { \
        S0 = MF(kf0, qr[0], S0); KRD(kf0, 4); S1 = MF(kf1, qr[0], S1); KRD(kf1, 5); S0 = MF(kf2, qr[1], S0); KRD(kf2, 6); S1 = MF(kf3, qr[1], S1); KRD(kf3, 7); SBAR(); \
        S0 = MF(kf0, qr[2], S0); S1 = MF(kf1, qr[2], S1); S0 = MF(kf2, qr[3], S0); S1 = MF(kf3, qr[3], S1); SBAR(); } while (0)
#define DECIDE(S0, S1) do { if (VAR & 64) break; asm volatile("s_nop 15\n\ts_nop 7" : "+v"(S0), "+v"(S1));   \
        float ma_ = max3f(S0[0], S0[1], S1[0]), mb_ = max3f(S0[2], S0[3], S1[1]); ma_ = max3f(ma_, S1[2], S1[3]); \
        _Pragma("unroll") for (int r = 4; r < 16; r += 4) { ma_ = max3f(ma_, S0[r], S0[r + 1]); mb_ = max3f(mb_, S0[r + 2], S0[r + 3]); ma_ = max3f(ma_, S1[r], S1[r + 1]); mb_ = max3f(mb_, S1[r + 2], S1[r + 3]); } \
        float rm_ = max3f(ma_, mb_, mb_); rm_ = swap_max(rm_); resc = false; \
        if (__builtin_expect(__any(rm_ > THR), 0)) { const float dl_ = __builtin_fmaxf(rm_, 0.f); mhat += dl_; \
            _Pragma("unroll") for (int r = 0; r < 16; ++r) { S0[r] -= dl_; S1[r] -= dl_; } \
            rf = __builtin_amdgcn_exp2f(-dl_); l *= rf; resc = true; } } while (0)
#define RESCALE_O() do { if (resc) { int h4_ = 4 * hi; asm volatile("" : "+v"(h4_)); _Pragma("unroll") for (int r = 0; r < 16; ++r) { const float fr_ = __shfl(rf, CRI(r) + h4_); \
            _Pragma("unroll") for (int d0 = 0; d0 < DV32; ++d0) o[d0][r] *= fr_; } resc = false; } } while (0)
#define EXP2(x) ((VAR & 1) ? (x) * 0.001f : __builtin_amdgcn_exp2f(x))
#define GB(Ox, PW, VL, VH, RD, S, e, C, crf) do { Ox = MF(__builtin_bit_cast(bf16x8, PW), VFR(VL, VH), Ox); RD; S[e] = EXP2(S[e]); S[e + 1] = EXP2(S[e + 1]); PIN(S); \
        if (!(VAR & 16)) { C[e] = fmamk<__builtin_bit_cast(unsigned, CRF(e) + (crf))>(sl_n, base_n); C[e + 1] = fmamk<__builtin_bit_cast(unsigned, CRF(e + 1) + (crf))>(sl_n, base_n); } PIN(C); SBAR(); } while (0)
#define PHASE_B(S0, S1, C0, C1) do { \
        GB(o[0], pw0, vl0, vh0, VRD(vl0, vh0, 4),  S0, 0,  C0, 0.f);  GB(o[0], pw1, vl1, vh1, VRD(vl1, vh1, 5),  S0, 2,  C0, 0.f); \
        GB(o[0], pw2, vl2, vh2, VRD(vl2, vh2, 6),  S0, 4,  C0, 0.f);  GB(o[0], pw3, vl3, vh3, VRD(vl3, vh3, 7),  S0, 6,  C0, 0.f); \
        GB(o[1], pw0, vl0, vh0, VRD(vl0, vh0, 8),  S0, 8,  C0, 0.f);  GB(o[1], pw1, vl1, vh1, VRD(vl1, vh1, 9),  S0, 10, C0, 0.f); \
        GB(o[1], pw2, vl2, vh2, VRD(vl2, vh2, 10), S0, 12, C0, 0.f);  GB(o[1], pw3, vl3, vh3, VRD(vl3, vh3, 11), S0, 14, C0, 0.f); \
        GB(o[2], pw0, vl0, vh0, VRD(vl0, vh0, 12), S1, 0,  C1, 32.f); GB(o[2], pw1, vl1, vh1, VRD(vl1, vh1, 13), S1, 2,  C1, 32.f); \
        GB(o[2], pw2, vl2, vh2, VRD(vl2, vh2, 14), S1, 4,  C1, 32.f); GB(o[2], pw3, vl3, vh3, VRD(vl3, vh3, 15), S1, 6,  C1, 32.f); \
        GB(o[3], pw0, vl0, vh0, KRN(kf0, 0),       S1, 8,  C1, 32.f); GB(o[3], pw1, vl1, vh1, KRN(kf1, 1),       S1, 10, C1, 32.f); \
        GB(o[3], pw2, vl2, vh2, KRN(kf2, 2),       S1, 12, C1, 32.f); GB(o[3], pw3, vl3, vh3, KRN(kf3, 3),       S1, 14, C1, 32.f); } while (0)
#define ROT3(s) ((s) == 2 ? 0 : (s) + 1)
#define ROT4(s) (((s) + 1) & 3)
#define STEP(S0, S1, P0, P1, it) do { \
        asm volatile("" : "+s"(sk), "+s"(sv)); \
        const int skm_ = (sk + 3) & 3, skp_ = ROT4(sk), svpp_ = sv == 0 ? 2 : sv - 1;   \
        const lds_cptr kp_ = kp0 + sk * KSLOT; const lds_cptr kn_ = kp0 + skp_ * KSLOT; const lds_cptr vp_ = vp0 + sv * KSLOT; \
        if (!(VAR & 8) && (it) + 3 < NT) DMA_K(TILE_OF((it) + 3), skm_); \
        SET_NEXT((it) + 1); SBAR(); \
        __builtin_amdgcn_s_setprio(1); PHASE_A(S0, S1, P0, P1); __builtin_amdgcn_s_setprio(0); \
        if (!(VAR & 8) && (it) + 1 < NT) DMA_V(TILE_OF((it) + 1), svpp_); \
        DECIDE(S0, S1); if (resc) SET_NEXT((it) + 1); SBAR(); \
        __builtin_amdgcn_s_setprio(1); PHASE_B(S0, S1, P0, P1); __builtin_amdgcn_s_setprio(0); \
        RESCALE_O(); sk = skp_; sv = ROT3(sv); } while (0)
    if (NT > 2) {
        { const lds_cptr kp_ = kp0 + 2 * KSLOT; const lds_cptr kn_ = kp0 + 3 * KSLOT;
          KRD(kf0, 0); KRD(kf1, 1); KRD(kf2, 2); KRD(kf3, 3);
          if (5 < NT) DMA_K(TILE_OF(5), 1); if (3 < NT) DMA_V(TILE_OF(3), 0);
          SET_NEXT(2); CINIT(xa0, xa1); SBAR();
          QK_ONLY(xa0, xa1);
          DECIDE(xa0, xa1); RESCALE_O();
#pragma unroll
          for (int r = 0; r < 16; ++r) { xa0[r] = EXP2(xa0[r]); xa1[r] = EXP2(xa1[r]); }
          SET_NEXT(3); CINIT(xb0, xb1);
          KRN(kf0, 0); KRN(kf1, 1); KRN(kf2, 2); KRN(kf3, 3); }
        int it = 3, sk = 3, sv = 2;
#pragma unroll 1
        for (; it + 1 < NT; it += 2) {
            if (!(VAR & 128)) { if (it + 2 < NT) { ATT_WAIT_BAR(4); } else { ATT_WAIT_BAR(2); } }
            STEP(xb0, xb1, xa0, xa1, it);
            if (!(VAR & 128)) { if (it + 3 < NT) { ATT_WAIT_BAR(4); } else { ATT_WAIT_BAR(2); } }
            STEP(xa0, xa1, xb0, xb1, it + 1);
        }
        if (it < NT) {
            ATT_WAIT_BAR(2);
            STEP(xb0, xb1, xa0, xa1, it);
            { float sacc = 0.f;
#pragma unroll
              for (int r = 0; r < 16; ++r) sacc += xb0[r] + xb1[r];
              l += sacc;
              pw0 = (u32x4){cvtpk(xb0[0], xb0[1]), cvtpk(xb0[2], xb0[3]), cvtpk(xb0[4], xb0[5]), cvtpk(xb0[6], xb0[7])}; pw1 = (u32x4){cvtpk(xb0[8], xb0[9]), cvtpk(xb0[10], xb0[11]), cvtpk(xb0[12], xb0[13]), cvtpk(xb0[14], xb0[15])};
              pw2 = (u32x4){cvtpk(xb1[0], xb1[1]), cvtpk(xb1[2], xb1[3]), cvtpk(xb1[4], xb1[5]), cvtpk(xb1[6], xb1[7])}; pw3 = (u32x4){cvtpk(xb1[8], xb1[9]), cvtpk(xb1[10], xb1[11]), cvtpk(xb1[12], xb1[13]), cvtpk(xb1[14], xb1[15])}; }
        } else {
            { float sacc = 0.f;
#pragma unroll
              for (int r = 0; r < 16; ++r) sacc += xa0[r] + xa1[r];
              l += sacc;
              pw0 = (u32x4){cvtpk(xa0[0], xa0[1]), cvtpk(xa0[2], xa0[3]), cvtpk(xa0[4], xa0[5]), cvtpk(xa0[6], xa0[7])}; pw1 = (u32x4){cvtpk(xa0[8], xa0[9]), cvtpk(xa0[10], xa0[11]), cvtpk(xa0[12], xa0[13]), cvtpk(xa0[14], xa0[15])};
              pw2 = (u32x4){cvtpk(xa1[0], xa1[1]), cvtpk(xa1[2], xa1[3]), cvtpk(xa1[4], xa1[5]), cvtpk(xa1[6], xa1[7])}; pw3 = (u32x4){cvtpk(xa1[8], xa1[9]), cvtpk(xa1[10], xa1[11]), cvtpk(xa1[12], xa1[13]), cvtpk(xa1[14], xa1[15])}; }
        }
        ATT_WAIT_BAR(0);
        { const int sl_ = (NT - 1) % 3; const lds_cptr vp_ = vp0 + sl_ * KSLOT;
#pragma unroll
          for (int d0 = 0; d0 < DV32; ++d0) {
              VRD(vl0, vh0, d0 * 4); VRD(vl1, vh1, d0 * 4 + 1); VRD(vl2, vh2, d0 * 4 + 2); VRD(vl3, vh3, d0 * 4 + 3);
              o[d0] = MF(__builtin_bit_cast(bf16x8, pw0), VFR(vl0, vh0), o[d0]); o[d0] = MF(__builtin_bit_cast(bf16x8, pw1), VFR(vl1, vh1), o[d0]);
              o[d0] = MF(__builtin_bit_cast(bf16x8, pw2), VFR(vl2, vh2), o[d0]); o[d0] = MF(__builtin_bit_cast(bf16x8, pw3), VFR(vl3, vh3), o[d0]); } }
    }
#undef TILE_OF
#undef DMA_K
#undef DMA_V
#undef KRD
#undef VRD
#undef VFR
#undef SET_NEXT
#undef CINIT
#undef GA
#undef PHASE_A
#undef QK_ONLY
#undef DECIDE
#undef RESCALE_O
#undef EXP2
#undef GB
#undef PHASE_B
#undef STEP
#undef ROT3
#undef ROT4
#undef KRN
    l = swap_sum(l);
    const float rl = 1.f / l;
    LAS float* cb = (LAS float*)shm + qs * 4096;
    ATT_WAIT_BAR(0);
    if (VAR & 1024) { if (lane == 0 && rl == 12345.f) O[0] = 0; return; }
    if (cmap == 1) {
#pragma unroll
        for (int r = 0; r < 16; ++r) { const int row = CRI(r) + 4 * hi; const float rr = __shfl(rl, row) * dc.lam_full;
#pragma unroll
            for (int d0 = 0; d0 < DV32; ++d0) cb[row * 128 + d0 * 32 + r32] = o[d0][r] * rr; }
    }
    ATT_WAIT_BAR(0);
    if (cmap == 0) {
        bf16_t* Ow = O + (size_t)(b * SEQ + iw) * D + hh * 128 + r32;
        float gsub[DV32];
#pragma unroll
        for (int d0 = 0; d0 < DV32; ++d0) gsub[d0] = dc.subln[d0 * 32 + r32] * (1.f - LAMBDA_INIT);
#pragma unroll
        for (int r = 0; r < 16; ++r) { const int row = CRI(r) + 4 * hi; const float rr = __shfl(rl, row);
            float v[DV32]; float ss = 0.f;
#pragma unroll
            for (int d0 = 0; d0 < DV32; ++d0) { v[d0] = o[d0][r] * rr - cb[row * 128 + d0 * 32 + r32]; ss += v[d0] * v[d0]; }
            ss += __shfl_xor(ss, 1); ss += __shfl_xor(ss, 2); ss += __shfl_xor(ss, 4); ss += __shfl_xor(ss, 8); ss += __shfl_xor(ss, 16);
            const float sc = __builtin_amdgcn_rsqf(ss * (1.f / 128.f) + 1e-5f);
#pragma unroll
            for (int d0 = 0; d0 < DV32; ++d0) Ow[(size_t)row * D + d0 * 32] = (bf16_t)f2bf(v[d0] * sc * gsub[d0]); }
    }
    asm volatile("s_waitcnt lgkmcnt(0)\n\ts_barrier" ::: "memory");
}
#undef SBAR
#undef PIN
#undef MF
#undef ATT_WAIT_BAR
}

typedef GAS unsigned gu32;
#define RLX_AGENT __ATOMIC_RELAXED, __HIP_MEMORY_SCOPE_AGENT
#define LDS_WAIT() asm volatile("s_waitcnt lgkmcnt(0)" ::: "memory")
#define VM_WAIT() asm volatile("s_waitcnt vmcnt(0)" ::: "memory")
#define XB_TMO      128
#define XB_XCNT(j)  (256  + 64 * (j))
#define XB_XSUB(j)  (1280 + 64 * (j))
#define XB_XGEN(j)  (2304 + 64 * (j))
#define XB_TOP      3328
#define XB_TOPGEN   3392
#define XCD_BAR_WORDS 3456
#define XB_SPIN_CAP (1u << 18)
__device__ __forceinline__ unsigned xb_ld(unsigned* p)              { return __hip_atomic_load(p, __ATOMIC_RELAXED, __HIP_MEMORY_SCOPE_AGENT); }
__device__ __forceinline__ unsigned xb_add(unsigned* p, unsigned v) { return __hip_atomic_fetch_add(p, v, __ATOMIC_RELAXED, __HIP_MEMORY_SCOPE_AGENT); }
__device__ __forceinline__ unsigned xb_xcc_id() { return (unsigned)__builtin_amdgcn_s_getreg((3 << 11) | 20) & 0xFu; }
#define XB_SPIN(cond, bar) do { unsigned _sp = 0; while (cond) { __builtin_amdgcn_s_sleep(1); \
    if ((++_sp & 255u) == 0u) { if (xb_ld(&(bar)[XB_TMO])) break; if (_sp > XB_SPIN_CAP) { atomicAdd(&(bar)[XB_TMO], 1u); break; } } } } while (0)
struct XcdBarrier { unsigned* bar; unsigned x; volatile LAS unsigned* st; };
__device__ __forceinline__ XcdBarrier xcd_barrier_post(unsigned* bar, volatile LAS unsigned* st, const bool leader) {
    XcdBarrier b; b.bar = bar; b.x = xb_xcc_id(); b.st = st;
    if (leader) (void)xb_add(&bar[XB_XCNT(b.x)], 1u);
    return b;
}
__device__ __forceinline__ void xcd_barrier_complete(unsigned* bar, unsigned x, unsigned& nloc, unsigned& nx) {
    const unsigned G = gridDim.x * gridDim.y * gridDim.z;
    unsigned sum, cnt, mine, sp = 0u;
    for (;;) {
        sum = 0u; cnt = 0u; mine = 0u;
#pragma unroll
        for (unsigned j = 0; j < 16; ++j) { const unsigned c = xb_ld(&bar[XB_XCNT(j)]); sum += c; cnt += (c > 0u) ? 1u : 0u; mine = (j == x) ? c : mine; }
        if (sum == G) break;
        __builtin_amdgcn_s_sleep(1);
        if ((++sp & 255u) == 0u) { if (xb_ld(&bar[XB_TMO])) break; if (sp > XB_SPIN_CAP) { atomicAdd(&bar[XB_TMO], 1u); break; } }
    }
    nloc = mine > 0u ? mine : 1u; nx = cnt > 0u ? cnt : 1u;
}
__device__ __forceinline__ void xcd_barrier(const XcdBarrier& b, const bool leader) {
    asm volatile("s_waitcnt vmcnt(0)" ::: "memory");
    __syncthreads();
    if (leader) {
        unsigned* bar = b.bar;
        __builtin_amdgcn_s_waitcnt(0);
        unsigned nloc = b.st[0], nx = b.st[1];
        if (nloc == 0u) { xcd_barrier_complete(bar, b.x, nloc, nx); b.st[0] = nloc; b.st[1] = nx; }
        const unsigned old = xb_add(&bar[XB_XSUB(b.x)], 1u);
        const unsigned gen = old / nloc;
        if (old + 1u == (gen + 1u) * nloc) {
            __builtin_amdgcn_fence(__ATOMIC_RELEASE, "agent");
            asm volatile("s_waitcnt vmcnt(0)" ::: "memory");
            const unsigned og = xb_add(&bar[XB_TOP], 1u);
            const unsigned tg = og / nx;
            if (og + 1u == (tg + 1u) * nx) xb_add(&bar[XB_TOPGEN], 1u);
            else XB_SPIN(xb_ld(&bar[XB_TOPGEN]) == tg, bar);
            __builtin_amdgcn_fence(__ATOMIC_ACQUIRE, "agent");
            xb_add(&bar[XB_XGEN(b.x)], 1u);
            asm volatile("s_waitcnt vmcnt(0)" ::: "memory");
        } else {
            XB_SPIN(xb_ld(&bar[XB_XGEN(b.x)]) == gen, bar);
            __builtin_amdgcn_fence(__ATOMIC_ACQUIRE, "agent");
            asm volatile("s_waitcnt vmcnt(0)" ::: "memory");
        }
    }
    __syncthreads();
}

struct Args { const float* in[18]; float* out; unsigned char* ws; int ph_lo, ph_hi, use_cg, pad; };
enum { I_X = 0, I_NMIX, I_NFFN, I_SWA_QKV, I_SWA_WO, I_SWA_SINK, I_DIFF_QKV, I_DIFF_WO, I_DIFF_LAM, I_DIFF_SUBLN, I_WG, I_BG, I_WR, I_BR, I_GATE, I_UP, I_DOWN, I_FNORM };
typedef const __attribute__((address_space(4))) Args* CArgs;
__device__ __forceinline__ CArgs kargs() { CArgs p = (CArgs)__builtin_amdgcn_kernarg_segment_ptr(); asm volatile("" : "+s"(p)); return p; }
__device__ __forceinline__ int vcu_of(int G) { const int bx = blockIdx.x; return (G % 8 == 0) ? (bx % 8) * (G / 8) + bx / 8 : bx; }

__device__ __forceinline__ void tr_item(const float* W, int N, int k0, int n0, bf16_t* dst, int ldd, LAS float* scr, int lane) {
    f32x4 v[8];
#pragma unroll
    for (int i = 0; i < 8; ++i) v[i] = *(const f32x4*)(W + (size_t)(k0 + 8 * i + (lane >> 3)) * N + n0 + (lane & 7) * 4);
#pragma unroll
    for (int i = 0; i < 8; ++i) { LAS float* p = scr + (8 * i + (lane >> 3)) * 33 + (lane & 7) * 4; p[0] = v[i].x; p[1] = v[i].y; p[2] = v[i].z; p[3] = v[i].w; }
    LDS_WAIT(); asm volatile("" ::: "memory");
    const int c = lane & 7;
#pragma unroll
    for (int j = 0; j < 4; ++j) { const int n = (lane >> 3) + 8 * j; const LAS float* s = scr + (8 * c) * 33 + n;
        u32x4 o; o.x = pk2(s[0 * 33], s[1 * 33]); o.y = pk2(s[2 * 33], s[3 * 33]); o.z = pk2(s[4 * 33], s[5 * 33]); o.w = pk2(s[6 * 33], s[7 * 33]);
        *(GAS u32x4*)(dst + (size_t)n * ldd + k0 + 8 * c) = o; }
    LDS_WAIT(); asm volatile("" ::: "memory");
}
__device__ __forceinline__ void rms_row_to_bf16(const float* xrow, const float* g, bf16_t* orow, int lane) {
    const GAS f32x4* xr = (const GAS f32x4*)xrow + lane; const GAS f32x4* gr = (const GAS f32x4*)g + lane;
    f32x4 v[4]; float s = 0.f;
#pragma unroll
    for (int j = 0; j < 4; ++j) { v[j] = xr[64 * j]; s += (v[j].x * v[j].x + v[j].y * v[j].y) + (v[j].z * v[j].z + v[j].w * v[j].w); }
    const float rstd = 1.f / sqrtf(wave_sum(s) * (1.f / D) + 1e-6f);
    GAS u32x2* o8 = (GAS u32x2*)orow + lane;
#pragma unroll
    for (int j = 0; j < 4; ++j) { const f32x4 gg = gr[64 * j]; u32x2 w; w.x = pk2(v[j].x * rstd * gg.x, v[j].y * rstd * gg.y); w.y = pk2(v[j].z * rstd * gg.z, v[j].w * rstd * gg.w); o8[64 * j] = w; }
}

__device__ __forceinline__ void phase_prologue(LAS unsigned char* lds_in, const int wave_in) {
    int lane = lane_id(); asm volatile("" : "+v"(lane)); int wave = wave_in; asm volatile("" : "+s"(wave)); LAS unsigned char* lds = lds_in; asm volatile("" : "+s"(lds));
    const CArgs a = kargs(); unsigned char* ws = a->ws;
    const int G = gridDim.x, vcu = vcu_of(G);
    LAS float* scr = (LAS float*)(lds + wave * 16384);
    const int gw = vcu * NWAVES + wave, NGW = G * NWAVES;
    bf16_t* swa_qkv_t = (bf16_t*)(ws + WS_SWA_QKV_T); bf16_t* swa_wo_t = (bf16_t*)(ws + WS_SWA_WO_T);
    bf16_t* diff_qkv_t = (bf16_t*)(ws + WS_DIFF_QKV_T); bf16_t* diff_wo_t = (bf16_t*)(ws + WS_DIFF_WO_T);
    constexpr int I0 = 16 * 48, I1 = 16 * 32, I2 = 16 * 96, I3 = 16 * 32, IM = 64 * 768, NITEMS = I0 + I1 + I2 + I3 + IM;
    struct TrItem { const float* src; int N; unsigned char* dstb; int ldb; int f8; };
    auto decode = [&](int it) -> TrItem {
        int r = it; const float* W; int N, k0, n0, ldd; bf16_t* dst; bf16_t* mbase = nullptr; int f8 = 0;
        if (r < I0) { const int kb = r / 48, nb = r % 48; W = a->in[I_SWA_QKV]; N = SWA_N; k0 = 64 * kb; n0 = 32 * nb; dst = swa_qkv_t + (size_t)n0 * D; ldd = D; }
        else if ((r -= I0) < I1) { const int kb = r / 32, nb = r % 32; W = a->in[I_SWA_WO]; N = D; k0 = 64 * kb; n0 = 32 * nb; dst = swa_wo_t + (size_t)n0 * D; ldd = D; }
        else if ((r -= I1) < I2) { const int kb = r / 96, nb = r % 96; W = a->in[I_DIFF_QKV]; N = DIFF_N; k0 = 64 * kb; n0 = 32 * nb; dst = diff_qkv_t + (size_t)n0 * D; ldd = D; }
        else if ((r -= I2) < I3) { const int kb = r / 32, nb = r % 32; W = a->in[I_DIFF_WO]; N = D; k0 = 64 * kb; n0 = 32 * nb; dst = diff_wo_t + (size_t)n0 * D; ldd = D; }
        else { r -= I3; const int le = r / 768, q = r % 768;
            bf16_t* gu = (bf16_t*)(ws + WS_WMOE + (size_t)le * 3 * MiB); bf16_t* dn = gu + (size_t)D * D;
            const bool l1 = le >= 32;
            if (q < 256) { const int kb = q / 16, c0 = 32 * (q % 16); W = a->in[I_GATE] + (size_t)le * D * DEXP; N = DEXP; k0 = 64 * kb; n0 = c0; dst = gu + (size_t)((c0 >> 7) * 256 + (c0 & 127)) * D; ldd = D; mbase = gu; f8 = ((F8_STAGE & 2) && l1); }
            else if (q < 512) { const int qq = q - 256; const int kb = qq / 16, c0 = 32 * (qq % 16); W = a->in[I_UP] + (size_t)le * D * DEXP; N = DEXP; k0 = 64 * kb; n0 = c0; dst = gu + (size_t)((c0 >> 7) * 256 + 128 + (c0 & 127)) * D; ldd = D; mbase = gu; f8 = ((F8_STAGE & 2) && l1); }
            else { const int qq = q - 512; const int kb = qq / 32, nb = qq % 32; W = a->in[I_DOWN] + (size_t)le * DEXP * D; N = D; k0 = 64 * kb; n0 = 32 * nb; dst = dn + (size_t)n0 * DEXP; ldd = DEXP; mbase = dn; f8 = ((F8_STAGE & 1) && l1); } }
        TrItem t; t.src = W + (size_t)(k0 + (lane >> 3)) * N + n0 + (lane & 7) * 4; t.N = N; t.f8 = f8;
        t.dstb = f8 ? (unsigned char*)mbase + (size_t)(dst - mbase) + k0 + 8 * (lane & 7) : (unsigned char*)(dst + k0 + 8 * (lane & 7)); t.ldb = f8 ? ldd : 2 * ldd; return t;
    };
    {
        f32x4 va[8], vb[8]; TrItem ca, cb;
#define TR_LOAD(v, t) do { _Pragma("unroll") for (int i = 0; i < 8; ++i) v[i] = *(const f32x4*)((t).src + (size_t)(8 * i) * (t).N); } while (0)
#define TR_FINISH(v, t) do { \
            _Pragma("unroll") for (int i = 0; i < 8; ++i) { LAS float* p = scr + (8 * i + (lane >> 3)) * 33 + (lane & 7) * 4; p[0] = v[i].x; p[1] = v[i].y; p[2] = v[i].z; p[3] = v[i].w; } \
            LDS_WAIT(); asm volatile("" ::: "memory"); \
            _Pragma("unroll") for (int j = 0; j < 4; ++j) { const int n = (lane >> 3) + 8 * j; const LAS float* s = scr + (8 * (lane & 7)) * 33 + n; \
                if ((t).f8) { u32x2 o8; o8.x = pk4_fp8(64.f * s[0 * 33], 64.f * s[1 * 33], 64.f * s[2 * 33], 64.f * s[3 * 33]); o8.y = pk4_fp8(64.f * s[4 * 33], 64.f * s[5 * 33], 64.f * s[6 * 33], 64.f * s[7 * 33]); \
                    *(GAS u32x2*)((t).dstb + (size_t)n * (t).ldb) = o8; } \
                else { u32x4 o; o.x = pk2(s[0 * 33], s[1 * 33]); o.y = pk2(s[2 * 33], s[3 * 33]); o.z = pk2(s[4 * 33], s[5 * 33]); o.w = pk2(s[6 * 33], s[7 * 33]); \
                    *(GAS u32x4*)((t).dstb + (size_t)n * (t).ldb) = o; } } \
            LDS_WAIT(); asm volatile("" ::: "memory"); } while (0)
        int it = gw;
        if (it < NITEMS) { ca = decode(it); TR_LOAD(va, ca); }
#pragma unroll 1
        for (; it < NITEMS; it += 2 * NGW) {
            const bool hb = it + NGW < NITEMS;
            if (hb) { cb = decode(it + NGW); TR_LOAD(vb, cb); }
            TR_FINISH(va, ca);
            const bool ha = it + 2 * NGW < NITEMS;
            if (ha) { ca = decode(it + 2 * NGW); TR_LOAD(va, ca); }
            if (hb) { TR_FINISH(vb, cb); }
        }
#undef TR_LOAD
#undef TR_FINISH
    }
    { bf16_t* wr_t = (bf16_t*)(ws + WS_WR); const int gt = gw * 64 + lane, NGT = NGW * 64;
      for (int i = gt; i < 2 * 36 * D; i += NGT) { const int l = i / (36 * D), rem = i % (36 * D), c = rem / D, k = rem % D;
          const float w = c < 4 ? a->in[I_WG][(size_t)l * D * 4 + k * 4 + c] : a->in[I_WR][(size_t)l * D * 32 + k * 32 + (c - 4)];
          const unsigned h = f2bf(w); const float r = w - __uint_as_float(h << 16);
          wr_t[(size_t)l * 2 * 36 * D + rem] = (bf16_t)h; wr_t[(size_t)l * 2 * 36 * D + 36 * D + rem] = (bf16_t)f2bf(r); } }
    bf16_t* XN = (bf16_t*)(ws + WS_XN);
#pragma unroll 1
    for (int mb = gw * 4; mb < M; mb += NGW * 4) {
        const float* xb = a->in[I_X] + (size_t)mb * D; const GAS f32x4* gr = (const GAS f32x4*)a->in[I_NMIX] + lane;
        f32x4 v[4][4];
#pragma unroll
        for (int r = 0; r < 4; ++r)
#pragma unroll
            for (int j = 0; j < 4; ++j) v[r][j] = ((const GAS f32x4*)(xb + (size_t)r * D) + lane)[64 * j];
        f32x4 gg[4];
#pragma unroll
        for (int j = 0; j < 4; ++j) gg[j] = gr[64 * j];
#pragma unroll
        for (int r = 0; r < 4; ++r) { float s = 0.f;
#pragma unroll
            for (int j = 0; j < 4; ++j) s += (v[r][j].x * v[r][j].x + v[r][j].y * v[r][j].y) + (v[r][j].z * v[r][j].z + v[r][j].w * v[r][j].w);
            const float rstd = 1.f / sqrtf(wave_sum(s) * (1.f / D) + 1e-6f);
            GAS u32x2* o8 = (GAS u32x2*)(XN + (size_t)(mb + r) * D) + lane;
#pragma unroll
            for (int j = 0; j < 4; ++j) { const f32x4 n = v[r][j] * rstd * gg[j]; u32x2 w; w.x = pk2(n.x, n.y); w.y = pk2(n.z, n.w); o8[64 * j] = w; } }
    }
}

template <int RV, bool F8OUT>
__device__ __forceinline__ void phase_router(LAS unsigned char* lds_in, int layer, const int wave_in, const bool dry) {
    int lane = lane_id(); asm volatile("" : "+v"(lane)); int wave = wave_in; asm volatile("" : "+s"(wave)); LAS unsigned char* lds = lds_in; asm volatile("" : "+s"(lds));
    const CArgs a = kargs(); unsigned char* ws = a->ws;
    const int G = gridDim.x, vcu = vcu_of(G);
    const int gw = vcu * NWAVES + wave, NGW = G * NWAVES;
    const float* g = a->in[I_NFFN] + layer * D;
    const bf16_t* wth = (const bf16_t*)(ws + WS_WR) + (size_t)layer * 2 * 36 * D; const bf16_t* wtl = wth + 36 * D;
    const float* bg = a->in[I_BG] + layer * 4; const float* br = a->in[I_BR] + layer * 32;
    bf16_t* XN = (bf16_t*)(ws + (dry ? WS_SCR : WS_XN)); const float* xin = a->out; float* rstd_tok = (float*)(ws + (dry ? WS_SCR + 80 * MiB : WS_RSTD));
    unsigned* cnt = (unsigned*)(ws + WS_CTL) + CW_CNT + (dry ? 2 : layer) * 1024;
    int* ltok = (int*)(ws + (dry ? WS_SCR + 64 * MiB : WS_LTOK)); float* lw = (float*)(ws + (dry ? WS_SCR + 68 * MiB : WS_LW)); i32x4* tinfo = (i32x4*)(ws + (dry ? WS_SCR + 72 * MiB : WS_TINFO));
    LAS float* lgs = (LAS float*)(lds + 98304 + wave * 4096);
    LAS float* rsl = lgs + 768;
    const int row = lane & 15, kg = lane >> 4;
    const bool c2ok = row < 4;
    LAS unsigned* lcnt = (LAS unsigned*)(lds + TP_OFF); LAS unsigned* lbase = lcnt + 32;
    const int tid = wave * 64 + lane;
#pragma unroll 1
    for (int bt0 = 0; bt0 < M / 16; bt0 += NGW) {
        const int bt = bt0 + gw; const bool live = bt < M / 16;
        const int t0 = (live ? bt : 0) * 16;
        if (tid < 32) lcnt[tid] = 0u;
        const char* xrow = (const char*)(xin + (size_t)(t0 + row) * D) + kg * 32;
        const char* grow = (const char*)g + kg * 32;
        char* orow = (char*)(XN + (size_t)(t0 + row) * D) + kg * 16;
        const char* w0 = (const char*)(wth + (size_t)row * D) + kg * 16;
        f32x4 acc0 = {0.f, 0.f, 0.f, 0.f}, acc1 = acc0, acc2 = acc0; float ss = 0.f;
        const unsigned m2 = c2ok ? 0xffffffffu : 0u;
        {
            f32x4 xa[3] = {}, xb[3] = {}, ga[3] = {}, gb[3] = {};
            const char* xbase = (const char*)(xin + (size_t)t0 * D); const unsigned xoff = (unsigned)(row * D * 4 + kg * 32);
            const char* gbase = (const char*)g; const unsigned goff = (unsigned)(kg * 32);
            const char* wb0h = (const char*)wth; const char* wb0l = wb0h + 36 * D * 2; const char* wb1h = wb0h + 16 * D * 2; const char* wb1l = wb0h + 52 * D * 2;
            char* obase = live ? (char*)XN + (size_t)t0 * D * (F8OUT ? 1 : 2) : (char*)(ws + WS_SCR + 100 * MiB); const unsigned ooff = F8OUT ? (unsigned)(row * D + kg * 8) : (unsigned)(row * D * 2 + kg * 16);
            const unsigned woff = (unsigned)((row * D + kg * 8) * 2) + (unsigned)wave * 64u, woff2 = (unsigned)(((32 + (row & 3)) * D + kg * 8) * 2) + (unsigned)wave * 64u;
            LAS unsigned char* bfill = lds + wave * 6144 + lane * 16;
            const LAS unsigned char* bread = lds + lane * 16;
            u32x4 fr0, fr1, fr2, fr3, fr4, fr5;
#define RT_BLOAD(c) do { fr0 = *(const u32x4*)(wb0h + woff + (c) * 512); fr1 = *(const u32x4*)(wb0l + woff + (c) * 512); fr2 = *(const u32x4*)(wb1h + woff + (c) * 512); \
            fr3 = *(const u32x4*)(wb1l + woff + (c) * 512); fr4 = *(const u32x4*)(wb0h + woff2 + (c) * 512); fr5 = *(const u32x4*)(wb0l + woff2 + (c) * 512); } while (0)
#define RT_BWRITE(buf) do { fr4.x &= m2; fr4.y &= m2; fr4.z &= m2; fr4.w &= m2; fr5.x &= m2; fr5.y &= m2; fr5.z &= m2; fr5.w &= m2; \
            *(LAS u32x4*)(bfill + (buf) * 49152) = fr0; *(LAS u32x4*)(bfill + (buf) * 49152 + 1024) = fr1; *(LAS u32x4*)(bfill + (buf) * 49152 + 2048) = fr2; \
            *(LAS u32x4*)(bfill + (buf) * 49152 + 3072) = fr3; *(LAS u32x4*)(bfill + (buf) * 49152 + 4096) = fr4; *(LAS u32x4*)(bfill + (buf) * 49152 + 5120) = fr5; } while (0)
#define RT_BAR() asm volatile("s_waitcnt lgkmcnt(0)\n\ts_barrier" ::: "memory")
#define RT_LOAD(st, s) do { if (!(RV & 2)) { xa[st] = *(const f32x4*)(xbase + xoff + (s) * 128); xb[st] = *(const f32x4*)(xbase + xoff + (s) * 128 + 16); } \
            ga[st] = *(const f32x4*)(gbase + goff + (s) * 128); gb[st] = *(const f32x4*)(gbase + goff + (s) * 128 + 16); } while (0)
            RT_BLOAD(0); RT_LOAD(0, 0); RT_LOAD(1, 1);
            RT_BWRITE(0); RT_BLOAD(1);
            RT_BAR();
#pragma unroll
            for (int s = 0; s < 32; ++s) {
                const int st = s % 3, c = s >> 3, sl = s & 7;
                if (sl == 0 && c + 1 < 4) { RT_BWRITE((c + 1) & 1); if (c + 2 < 4) { RT_BLOAD(c + 2); } }
                if (s + 2 < 32) { RT_LOAD((s + 2) % 3, s + 2); }
                __builtin_amdgcn_sched_barrier(0);
                const LAS unsigned char* bp = bread + (c & 1) * 49152 + sl * 6144;
                const bf16x8 b0h = *(const LAS bf16x8*)(bp), b0l = *(const LAS bf16x8*)(bp + 1024), b1h = *(const LAS bf16x8*)(bp + 2048), b1l = *(const LAS bf16x8*)(bp + 3072),
                             b2h = *(const LAS bf16x8*)(bp + 4096), b2l = *(const LAS bf16x8*)(bp + 5120);
                const f32x4 xa_ = xa[st], xb_ = xb[st];
                ss += (xa_.x * xa_.x + xa_.y * xa_.y) + (xa_.z * xa_.z + xa_.w * xa_.w) + (xb_.x * xb_.x + xb_.y * xb_.y) + (xb_.z * xb_.z + xb_.w * xb_.w);
                const f32x4 ya = xa_ * ga[st], yb = xb_ * gb[st];
                u32x4 hi; hi.x = cvtpk(ya.x, ya.y); hi.y = cvtpk(ya.z, ya.w); hi.z = cvtpk(yb.x, yb.y); hi.w = cvtpk(yb.z, yb.w);
                u32x4 lo; lo.x = cvtpk(ya.x - __uint_as_float(hi.x << 16), ya.y - __uint_as_float(hi.x & 0xffff0000u)); lo.y = cvtpk(ya.z - __uint_as_float(hi.y << 16), ya.w - __uint_as_float(hi.y & 0xffff0000u));
                lo.z = cvtpk(yb.x - __uint_as_float(hi.z << 16), yb.y - __uint_as_float(hi.z & 0xffff0000u)); lo.w = cvtpk(yb.z - __uint_as_float(hi.w << 16), yb.w - __uint_as_float(hi.w & 0xffff0000u));
                if constexpr (F8OUT) { u32x2 q8; q8.x = pk4_fp8(4.f * ya.x, 4.f * ya.y, 4.f * ya.z, 4.f * ya.w); q8.y = pk4_fp8(4.f * yb.x, 4.f * yb.y, 4.f * yb.z, 4.f * yb.w); *(u32x2*)(obase + ooff + s * 32) = q8; }
                else if (!(RV & 1)) *(u32x4*)(obase + ooff + s * 64) = hi;
                const bf16x8 ah = __builtin_bit_cast(bf16x8, hi), al = __builtin_bit_cast(bf16x8, lo);
                acc0 = __builtin_amdgcn_mfma_f32_16x16x32_bf16(ah, b0h, acc0, 0, 0, 0); acc0 = __builtin_amdgcn_mfma_f32_16x16x32_bf16(ah, b0l, acc0, 0, 0, 0); acc0 = __builtin_amdgcn_mfma_f32_16x16x32_bf16(al, b0h, acc0, 0, 0, 0);
                acc1 = __builtin_amdgcn_mfma_f32_16x16x32_bf16(ah, b1h, acc1, 0, 0, 0); acc1 = __builtin_amdgcn_mfma_f32_16x16x32_bf16(ah, b1l, acc1, 0, 0, 0); acc1 = __builtin_amdgcn_mfma_f32_16x16x32_bf16(al, b1h, acc1, 0, 0, 0);
                acc2 = __builtin_amdgcn_mfma_f32_16x16x32_bf16(ah, b2h, acc2, 0, 0, 0); acc2 = __builtin_amdgcn_mfma_f32_16x16x32_bf16(ah, b2l, acc2, 0, 0, 0); acc2 = __builtin_amdgcn_mfma_f32_16x16x32_bf16(al, b2h, acc2, 0, 0, 0);
                __builtin_amdgcn_sched_barrier(0);
                if (sl == 7 && c + 1 < 4) { RT_BAR(); }
            }
            RT_BAR();
#undef RT_LOAD
#undef RT_BLOAD
#undef RT_BWRITE
#undef RT_BAR
        }
        ss += __shfl_xor(ss, 16); ss += __shfl_xor(ss, 32);
        const float rstd = 1.f / sqrtf(ss * (1.f / D) + 1e-6f);
        if (kg == 0) { rsl[row] = rstd; if (live) rstd_tok[t0 + row] = rstd; }
#pragma unroll
        for (int j = 0; j < 4; ++j) { lgs[(4 * kg + j) * 48 + row] = acc0[j]; lgs[(4 * kg + j) * 48 + 16 + row] = acc1[j]; lgs[(4 * kg + j) * 48 + 32 + row] = acc2[j]; }
        LDS_WAIT(); asm volatile("" ::: "memory");
        int e1 = 0, e2 = 0, lp1 = 0, lp2 = 0; float w1 = 0.f, w2 = 0.f;
        const bool act = live && lane < 16 && !(RV & 4);
        __syncthreads();
        if (act) {
            const float rs = rsl[lane];
            float acc[36];
#pragma unroll
            for (int q = 0; q < 9; ++q) { const f32x4 x = *(const LAS f32x4*)(lgs + lane * 48 + 4 * q); acc[4 * q] = x.x * rs; acc[4 * q + 1] = x.y * rs; acc[4 * q + 2] = x.z * rs; acc[4 * q + 3] = x.w * rs; }
            float lgv[4]; int gs = 0;
#pragma unroll
            for (int c = 0; c < 4; ++c) lgv[c] = acc[c] + bg[c];
            float mx = lgv[0];
#pragma unroll
            for (int c = 1; c < 4; ++c) if (lgv[c] > mx) { mx = lgv[c]; gs = c; }
            float den = 0.f;
#pragma unroll
            for (int c = 0; c < 4; ++c) den += __expf(lgv[c] - mx);
            const float pg = 1.f / den;
            float le[8];
#pragma unroll
            for (int k = 0; k < 8; ++k) { const float a0 = acc[4 + k] + br[k], a1 = acc[12 + k] + br[8 + k], a2 = acc[20 + k] + br[16 + k], a3 = acc[28 + k] + br[24 + k];
                le[k] = gs == 0 ? a0 : (gs == 1 ? a1 : (gs == 2 ? a2 : a3)); }
            int i1 = 0; float m1 = le[0];
#pragma unroll
            for (int k = 1; k < 8; ++k) if (le[k] > m1) { m1 = le[k]; i1 = k; }
            int i2 = -1; float m2 = -INFINITY;
#pragma unroll
            for (int k = 0; k < 8; ++k) if (k != i1 && (i2 < 0 || le[k] > m2)) { m2 = le[k]; i2 = k; }
            const float ex = __expf(m2 - m1); const float tp1 = 1.f / (1.f + ex), tp2 = ex * tp1;
            w1 = pg * tp1; w2 = pg * tp2; e1 = gs * 8 + i1; e2 = gs * 8 + i2;
            lp1 = (int)__hip_atomic_fetch_add(lcnt + e1, 1u, __ATOMIC_RELAXED, __HIP_MEMORY_SCOPE_WORKGROUP);
            lp2 = (int)__hip_atomic_fetch_add(lcnt + e2, 1u, __ATOMIC_RELAXED, __HIP_MEMORY_SCOPE_WORKGROUP);
        }
        __syncthreads();
        if (tid < 32) { const unsigned c = lcnt[tid]; lbase[tid] = c ? __hip_atomic_fetch_add(cnt + 32 * tid, c, __ATOMIC_RELAXED, __HIP_MEMORY_SCOPE_AGENT) : 0u; }
        __syncthreads();
        if (act) {
            const int t = t0 + lane; const int p1 = (int)lbase[e1] + lp1, p2 = (int)lbase[e2] + lp2;
            ltok[(size_t)e1 * M + p1] = t; lw[(size_t)e1 * M + p1] = w1; ltok[(size_t)e2 * M + p2] = t; lw[(size_t)e2 * M + p2] = w2;
            tinfo[t] = (i32x4){e1, p1, e2, p2};
        }
        LDS_WAIT(); asm volatile("" ::: "memory");
        __syncthreads();
    }
}

__device__ __forceinline__ void moe_tables(LAS unsigned char* lds, unsigned char* ws, int layer, const int wave, const int lane) {
    LAS int* TP = (LAS int*)(lds + TP_OFF); LAS int* CNT = TP + 40;
    unsigned* cnt = (unsigned*)(ws + WS_CTL) + CW_CNT + layer * 1024;
    const int tid = wave * 64 + lane;
    __syncthreads();
    if (tid < 32) CNT[tid] = (int)__hip_atomic_load(cnt + 32 * tid, RLX_AGENT);
    __syncthreads();
    if (tid == 0) { int s = 0; for (int e = 0; e < 32; ++e) { TP[e] = s; s += (CNT[e] + 255) >> 8; } TP[32] = s; }
    __syncthreads();
}

__device__ __forceinline__ void phase_combine(LAS unsigned char* lds_in, int layer, const int wave_in, const bool dry) {
    int lane = lane_id(); asm volatile("" : "+v"(lane)); int wave = wave_in; asm volatile("" : "+s"(wave)); LAS unsigned char* lds = lds_in; asm volatile("" : "+s"(lds));
    const CArgs a = kargs(); unsigned char* ws = a->ws;
    moe_tables(lds, ws, layer, wave, lane);
    const bool final_ = layer == 1; const float* gnext = layer == 0 ? a->in[I_NMIX] + D : a->in[I_FNORM]; float* xio = a->out;
    const int G = gridDim.x, vcu = vcu_of(G);
    const int gw = vcu * NWAVES + wave, NGW = G * NWAVES;
    const LAS int* TP = (const LAS int*)(lds + TP_OFF);
    const bf16_t* Y = (const bf16_t*)(ws + WS_Y); const i32x4* tinfo = (const i32x4*)(ws + WS_TINFO); bf16_t* XN = (bf16_t*)(ws + WS_XN);
#pragma unroll 1
    for (int tb = gw * 4; tb < M; tb += NGW * 4) {
        size_t s1[4], s2[4];
#pragma unroll
        for (int r = 0; r < 4; ++r) { const i32x4 ti = tinfo[tb + r]; s1[r] = (size_t)TP[ti.x] * 256 + ti.y; s2[r] = (size_t)TP[ti.z] * 256 + ti.w; }
        f32x4 v[4][4]; u32x2 p[4][4], q[4][4];
#pragma unroll
        for (int r = 0; r < 4; ++r) {
            const GAS f32x4* xr = (const GAS f32x4*)(xio + (size_t)(tb + r) * D) + lane;
            const GAS u32x2* y1 = (const GAS u32x2*)(Y + s1[r] * D) + lane; const GAS u32x2* y2 = (const GAS u32x2*)(Y + s2[r] * D) + lane;
#pragma unroll
            for (int j = 0; j < 4; ++j) { v[r][j] = xr[64 * j]; p[r][j] = y1[64 * j]; q[r][j] = y2[64 * j]; }
        }
        f32x4 gg[4];
#pragma unroll
        for (int j = 0; j < 4; ++j) gg[j] = ((const GAS f32x4*)gnext + lane)[64 * j];
#pragma unroll
        for (int r = 0; r < 4; ++r) {
            float s = 0.f;
#pragma unroll
            for (int j = 0; j < 4; ++j) { const u32x2 pp = p[r][j], qq = q[r][j];
                f32x4 ya, yb; ya.x = __uint_as_float(pp.x << 16); ya.y = __uint_as_float(pp.x & 0xffff0000u); ya.z = __uint_as_float(pp.y << 16); ya.w = __uint_as_float(pp.y & 0xffff0000u);
                yb.x = __uint_as_float(qq.x << 16); yb.y = __uint_as_float(qq.x & 0xffff0000u); yb.z = __uint_as_float(qq.y << 16); yb.w = __uint_as_float(qq.y & 0xffff0000u);
                v[r][j] = v[r][j] + (ya + yb); s += (v[r][j].x * v[r][j].x + v[r][j].y * v[r][j].y) + (v[r][j].z * v[r][j].z + v[r][j].w * v[r][j].w); }
            const float rstd = 1.f / sqrtf(wave_sum(s) * (1.f / D) + 1e-6f);
            GAS f32x4* xw = (GAS f32x4*)(xio + (size_t)(tb + r) * D) + lane;
            if (final_) {
#pragma unroll
                for (int j = 0; j < 4; ++j) if (!dry) xw[64 * j] = v[r][j] * rstd * gg[j];
            } else {
                GAS u32x2* o8 = (GAS u32x2*)(XN + (size_t)(tb + r) * D) + lane;
#pragma unroll
                for (int j = 0; j < 4; ++j) { if (!dry) xw[64 * j] = v[r][j]; const f32x4 n = v[r][j] * rstd * gg[j]; u32x2 w; w.x = pk2(n.x, n.y); w.y = pk2(n.z, n.w); o8[64 * j] = w; }
            }
        }
    }
}

__device__ __forceinline__ float diff_lambda_full(const float* lam, int lane) {
    const float a = wave_sum(lam[lane] * lam[64 + lane]), b = wave_sum(lam[128 + lane] * lam[192 + lane]);
    return __expf(a) - __expf(b) + LAMBDA_INIT;
}

__device__ __forceinline__ void phase_qkv(LAS unsigned char* lds_in, int layer, const int wave_in) {
    int lane = lane_id(); asm volatile("" : "+v"(lane)); int wave = wave_in; asm volatile("" : "+s"(wave)); LAS unsigned char* lds = lds_in; asm volatile("" : "+s"(lds));
    const CArgs a = kargs(); unsigned char* ws = a->ws;
    const int N = layer == 0 ? SWA_N : DIFF_N;
    pg8::Gemm g{(const bf16_t*)(ws + WS_XN), (const bf16_t*)(ws + (layer == 0 ? WS_SWA_QKV_T : WS_DIFF_QKV_T)), D};
    pg8::DenseOrder S; S.init(M, N, (int)gridDim.x, (int)blockIdx.x);
    pg8::EpiQKV E{(bf16_t*)(ws + WS_QKV), N, 1024, QSCALE, layer == 1 ? (unsigned*)(ws + WS_CTL) + CW_KMAX : nullptr};
    pg8::gemm_phase<pg8::EpiQKV, pg8::DenseOrder, false, true>(lds, g, S, E, wave, lane);
}
__device__ __forceinline__ void phase_oproj(LAS unsigned char* lds_in, int layer, const int wave_in) {
    int lane = lane_id(); asm volatile("" : "+v"(lane)); int wave = wave_in; asm volatile("" : "+s"(wave)); LAS unsigned char* lds = lds_in; asm volatile("" : "+s"(lds));
    const CArgs a = kargs(); unsigned char* ws = a->ws;
    pg8::Gemm g{(const bf16_t*)(ws + WS_O), (const bf16_t*)(ws + (layer == 0 ? WS_SWA_WO_T : WS_DIFF_WO_T)), D};
    pg8::DenseOrder S; S.init(M, D, (int)gridDim.x, (int)blockIdx.x);
    pg8::EpiResid E{layer == 0 ? a->in[I_X] : (const float*)a->out, a->out};
    pg8::gemm_phase<pg8::EpiResid, pg8::DenseOrder, false, true>(lds, g, S, E, wave, lane);
}
__device__ __forceinline__ void phase_moe1(LAS unsigned char* lds_in, int layer, const int wave_in) {
    int lane = lane_id(); asm volatile("" : "+v"(lane)); int wave = wave_in; asm volatile("" : "+s"(wave)); LAS unsigned char* lds = lds_in; asm volatile("" : "+s"(lds));
    const CArgs a = kargs(); unsigned char* ws = a->ws;
    moe_tables(lds, ws, layer, wave, lane);
    const LAS int* TP = (const LAS int*)(lds + TP_OFF); const LAS int* CNT = TP + 40;
    if ((F8_STAGE & 2) && layer == 1) {
        pg8::Gemm g{(const bf16_t*)(ws + WS_XN), (const bf16_t*)(ws + WS_WMOE + (size_t)layer * 96 * MiB), D / 2, 0x79797979u, 0x7d7d7d7du};
        pg8::MoeOrder S{TP, CNT, (const int*)(ws + WS_LTOK), (int)gridDim.x, (int)blockIdx.x, 12, 0};
        if (F8_STAGE & 1) { pg8::EpiSwiGLU<true> E{(bf16_t*)(ws + WS_H), (const int*)(ws + WS_LTOK), (const float*)(ws + WS_RSTD), CNT};
            pg8::gemm_phase<pg8::EpiSwiGLU<true>, pg8::MoeOrder, true, true, true>(lds, g, S, E, wave, relaunder(lane)); }
        else { pg8::EpiSwiGLU<false> E{(bf16_t*)(ws + WS_H), (const int*)(ws + WS_LTOK), (const float*)(ws + WS_RSTD), CNT};
            pg8::gemm_phase<pg8::EpiSwiGLU<false>, pg8::MoeOrder, true, true, true>(lds, g, S, E, wave, relaunder(lane)); }
    } else if ((F8_STAGE & 1) && layer == 1) {
        pg8::Gemm g{(const bf16_t*)(ws + WS_XN), (const bf16_t*)(ws + WS_WMOE + (size_t)layer * 96 * MiB), D};
        pg8::MoeOrder S{TP, CNT, (const int*)(ws + WS_LTOK), (int)gridDim.x, (int)blockIdx.x, 6, 0};
        pg8::EpiSwiGLU<true> E{(bf16_t*)(ws + WS_H), (const int*)(ws + WS_LTOK), (const float*)(ws + WS_RSTD), CNT};
        pg8::gemm_phase<pg8::EpiSwiGLU<true>, pg8::MoeOrder, true, true>(lds, g, S, E, wave, relaunder(lane));
    } else {
        pg8::Gemm g{(const bf16_t*)(ws + WS_XN), (const bf16_t*)(ws + WS_WMOE + (size_t)layer * 96 * MiB), D};
        pg8::MoeOrder S{TP, CNT, (const int*)(ws + WS_LTOK), (int)gridDim.x, (int)blockIdx.x, 6, 0};
        pg8::EpiSwiGLU<false> E{(bf16_t*)(ws + WS_H), (const int*)(ws + WS_LTOK), (const float*)(ws + WS_RSTD), CNT};
        pg8::gemm_phase<pg8::EpiSwiGLU<false>, pg8::MoeOrder, true, true>(lds, g, S, E, wave, relaunder(lane));
    }
}
__device__ __forceinline__ void phase_moe2(LAS unsigned char* lds_in, int layer, const int wave_in) {
    int lane = lane_id(); asm volatile("" : "+v"(lane)); int wave = wave_in; asm volatile("" : "+s"(wave)); LAS unsigned char* lds = lds_in; asm volatile("" : "+s"(lds));
    const CArgs a = kargs(); unsigned char* ws = a->ws;
    moe_tables(lds, ws, layer, wave, lane);
    const LAS int* TP = (const LAS int*)(lds + TP_OFF); const LAS int* CNT = TP + 40;
    pg8::EpiDown E{(bf16_t*)(ws + WS_Y), (const float*)(ws + WS_LW)};
    if ((F8_STAGE & 1) && layer == 1) {
        pg8::Gemm g{(const bf16_t*)(ws + WS_H), (const bf16_t*)(ws + WS_WMOE + (size_t)layer * 96 * MiB), DEXP / 2, 0x79797979u, 0x7c7c7c7cu};
        pg8::MoeOrder S{TP, CNT, (const int*)(ws + WS_LTOK), (int)gridDim.x, (int)blockIdx.x, 24, 16};
        pg8::gemm_phase<pg8::EpiDown, pg8::MoeOrder, false, true, true>(lds, g, S, E, wave, relaunder(lane));
    } else {
        pg8::Gemm g{(const bf16_t*)(ws + WS_H), (const bf16_t*)(ws + WS_WMOE + (size_t)layer * 96 * MiB), DEXP};
        pg8::MoeOrder S{TP, CNT, (const int*)(ws + WS_LTOK), (int)gridDim.x, (int)blockIdx.x, 12, 8};
        pg8::gemm_phase<pg8::EpiDown, pg8::MoeOrder, false, true>(lds, g, S, E, wave, relaunder(lane));
    }
}
__device__ __forceinline__ void phase_attn(LAS unsigned char* lds_in, int layer, const int wave_in, const bool dry) {
    int lane = lane_id(); asm volatile("" : "+v"(lane)); int wave = wave_in; asm volatile("" : "+s"(wave)); LAS unsigned char* lds = lds_in; asm volatile("" : "+s"(lds));
    const CArgs a = kargs(); unsigned char* ws = a->ws;
    const int G = gridDim.x, vcu = vcu_of(G);
    const bf16_t* QKV = (const bf16_t*)(ws + WS_QKV); bf16_t* OB = (bf16_t*)(ws + WS_O);
    if (layer == 0) {
        att::DiffConsts dc{0.f, nullptr}; const float* sink = a->in[I_SWA_SINK];
#pragma unroll 1
        for (int i = 0; i < 2048; ++i) { const int id = vcu + G * i; if (id >= 2048) break; const int bk = id >> 7, qb = id & 127;
            att::attn_unit<0>(bk >> 2, bk & 3, qb, QKV, OB, sink, dc, lds, wave, lane); }
    } else {
        att::DiffConsts dc{diff_lambda_full(a->in[I_DIFF_LAM], lane), a->in[I_DIFF_SUBLN]};
        const unsigned* kmaxsq = (const unsigned*)(ws + WS_CTL) + CW_KMAX;
#pragma unroll 1
        for (int i = 0; i < 2048; ++i) { const int id = vcu + G * i; if (id >= 2048) break; const int h = id >> 8, bq = id & 255, b = bq >> 6;
            const int qb = ((0xD8 >> h) & 1) ? ((bq + 32) & 63) : (bq & 63);
            const int cm = wave >> 2, gi = b * 32 + 2 * (2 * h + cm);
            const float kmax = sqrtf(__uint_as_float(__hip_atomic_load(kmaxsq + gi, RLX_AGENT)) + __uint_as_float(__hip_atomic_load(kmaxsq + gi + 1, RLX_AGENT))) * 1.01f;
            if (ATT_PROBE_VARIANT != 0 && dry) att::diff_unit<ATT_PROBE_VARIANT>(b, h, qb, QKV, (bf16_t*)(ws + WS_XN), kmax, dc, lds, wave, lane);
            else att::diff_unit<0>(b, h, qb, QKV, OB, kmax, dc, lds, wave, lane); }
    }
}

__global__ void __launch_bounds__(NWAVES * 64, 2) mega_fwd(Args args_by_value) {
    extern __shared__ __attribute__((aligned(16))) unsigned char lds_raw[];
    LAS unsigned char* lds = (LAS unsigned char*)lds_raw;
    const int wave = __builtin_amdgcn_readfirstlane((int)(threadIdx.x >> 6));
    int lo, hi;
    { const CArgs a = kargs(); lo = a->ph_lo; hi = a->ph_hi;
      if (a->use_cg) cg::this_grid().sync(); }
    { const int tid = wave * 64 + lane_id();
      for (int u = tid; u < (LDS_BYTES - LDSCTL_OFF) / 4; u += NWAVES * 64) ((LAS unsigned*)(lds + LDSCTL_OFF))[u] = 0u; }
    __syncthreads();
    if (N_LAUNCHES == 1) { const CArgs a = kargs(); (void)xcd_barrier_post((unsigned*)(a->ws + WS_CTL) + CW_BAR, (volatile LAS unsigned*)(lds + MISC_OFF) + 8, wave == 0 && lane_id() == 0); }
    int rep_left = REP_COUNT;
    unsigned long long tp_prev = 0, tp_acc = 0;
    if (TPROBE_MASK != 0) tp_prev = __builtin_amdgcn_s_memrealtime();
#pragma unroll 1
    for (int ph = lo; ph < hi; ++ph) {
        const int layer = ph >= 8 ? 1 : 0, kind = ph == 0 ? 0 : ph - 7 * layer;
        const bool dry = REP_COUNT > 0 && ph == REP_PHASE && rep_left > 0;
        switch (kind) {
            case 0: phase_prologue(lds, wave); break;
            case 1: phase_qkv(lds, layer, wave); break;
            case 2: phase_attn(lds, layer, wave, dry); break;
            case 3: phase_oproj(lds, layer, wave); break;
            case 4: if (ROUTER_PROBE != 0 && dry) phase_router<ROUTER_PROBE, false>(lds, layer, wave, dry); else if ((F8_STAGE & 2) && layer == 1) phase_router<0, true>(lds, layer, wave, dry); else phase_router<0, false>(lds, layer, wave, dry); break;
            case 5: phase_moe1(lds, layer, wave); break;
            case 6: phase_moe2(lds, layer, wave); break;
            default: phase_combine(lds, layer, wave, dry); break;
        }
        if (ph + 1 < hi) { const CArgs a = kargs(); XcdBarrier bar; bar.bar = (unsigned*)(a->ws + WS_CTL) + CW_BAR; bar.x = xb_xcc_id(); bar.st = (volatile LAS unsigned*)(lds + MISC_OFF) + 8;
            xcd_barrier(bar, wave == 0 && lane_id() == 0);
        }
        if (TPROBE_MASK != 0) { const unsigned long long tn = __builtin_amdgcn_s_memrealtime(); if ((TPROBE_MASK >> ph) & 1) tp_acc += tn - tp_prev; tp_prev = tn; }
        if (REP_COUNT > 0 && ph == REP_PHASE && rep_left > 0) { --rep_left; --ph; }
        if (EXTRA_BARRIERS > 0 && ph == 3) { for (int xb = 0; xb < EXTRA_BARRIERS; ++xb) { const CArgs a = kargs(); XcdBarrier bar; bar.bar = (unsigned*)(a->ws + WS_CTL) + CW_BAR; bar.x = xb_xcc_id(); bar.st = (volatile LAS unsigned*)(lds + MISC_OFF) + 8; xcd_barrier(bar, wave == 0 && lane_id() == 0); } }
    }
    if (TPROBE_MASK != 0 && blockIdx.x == 0 && wave == 0) { const unsigned long long t0 = __builtin_amdgcn_s_memrealtime(); while (__builtin_amdgcn_s_memrealtime() - t0 < TPROBE_K * tp_acc) __builtin_amdgcn_s_sleep(8); }
}

extern "C" void kernel_launch(void* const* d_in, const int* in_sizes, int n_in, void* d_out, int out_size, void* d_ws, size_t ws_size, hipStream_t stream) {
    static int grid = 0;
    if (grid == 0) {
        if (n_in != 18 || in_sizes[0] != M * D || out_size != M * D || ws_size < WS_END) {
            fprintf(stderr, "kernel_launch: unexpected shapes: n_in %d in0 %d out %d ws %zu (need %zu)\n", n_in, n_in > 0 ? in_sizes[0] : -1, out_size, ws_size, (size_t)WS_END); grid = -1; return; }
        int dev = 0, cus = 0, per_cu = 0;
        if (hipGetDevice(&dev) != hipSuccess || hipDeviceGetAttribute(&cus, hipDeviceAttributeMultiprocessorCount, dev) != hipSuccess) { fprintf(stderr, "kernel_launch: device query failed\n"); grid = -1; return; }
        if (hipFuncSetAttribute((const void*)mega_fwd, hipFuncAttributeMaxDynamicSharedMemorySize, LDS_BYTES) != hipSuccess) { fprintf(stderr, "kernel_launch: hipFuncSetAttribute failed\n"); grid = -1; return; }
        if (hipOccupancyMaxActiveBlocksPerMultiprocessor(&per_cu, (const void*)mega_fwd, NWAVES * 64, LDS_BYTES) != hipSuccess || per_cu < 1) { fprintf(stderr, "kernel_launch: occupancy query says %d\n", per_cu); per_cu = 1; }
        (void)hipGetLastError();
        grid = cus;
    }
    if (grid < 0) return;
    (void)hipMemsetAsync((char*)d_ws + WS_CTL, 0, CTL_ZERO_BYTES, stream);
    Args a{};
    for (int i = 0; i < 18; ++i) a.in[i] = (const float*)d_in[i];
    a.out = (float*)d_out; a.ws = (unsigned char*)d_ws; a.use_cg = 0; a.pad = 0;
    if (N_LAUNCHES == 1) {
        a.ph_lo = 0; a.ph_hi = N_PHASES;
        void* kargs_[] = {&a};
        hipError_t e = hipLaunchCooperativeKernel((const void*)mega_fwd, dim3(grid), dim3(NWAVES * 64), kargs_, LDS_BYTES, stream);
        if (e != hipSuccess) fprintf(stderr, "kernel_launch: cooperative launch failed: %s (grid %d)\n", hipGetErrorString(e), grid);
    } else {
        for (int p = 0; p < N_PHASES; ++p) { a.ph_lo = p; a.ph_hi = p + 1; hipLaunchKernelGGL(mega_fwd, dim3(grid), dim3(NWAVES * 64), LDS_BYTES, stream, a); }
    }
}
```

```cpp
#include <hip/hip_runtime.h>
#include <hip/hip_cooperative_groups.h>
#include <cstdio>
#include <cstdint>
namespace cg = cooperative_groups;

#ifndef MK_N_LAUNCHES
#define MK_N_LAUNCHES 1
#endif
constexpr int N_PHASES = 15;
#define F8_STAGE 2
#define F8_L0 1
#define REP_PHASE -1
#define REP_COUNT 0
#define ATT_PROBE_VARIANT 0
#define EXTRA_BARRIERS 0
#define ROUTER_PROBE 0
#define TPROBE_MASK 0
#define TPROBE_K 4
constexpr int N_LAUNCHES = MK_N_LAUNCHES;

#define LAS __attribute__((address_space(3)))
#define GAS __attribute__((address_space(1)))
typedef unsigned short bf16_t;
typedef short bf16x8 __attribute__((ext_vector_type(8)));
typedef short s16x4 __attribute__((ext_vector_type(4)));
typedef float f32x2 __attribute__((ext_vector_type(2)));
typedef float f32x4 __attribute__((ext_vector_type(4)));
typedef float f32x16 __attribute__((ext_vector_type(16)));
typedef unsigned u32x2 __attribute__((ext_vector_type(2)));
typedef unsigned u32x4 __attribute__((ext_vector_type(4)));
typedef int i32x4 __attribute__((ext_vector_type(4)));
typedef int i32x8 __attribute__((ext_vector_type(8)));
typedef __bf16 bf16x2_t __attribute__((ext_vector_type(2)));

constexpr int D = 1024, BATCH = 4, SEQ = 8192, M = BATCH * SEQ;
constexpr int SWA_N = 1536, DIFF_N = 3072;
constexpr int NEXP = 32, DEXP = 512;
constexpr float LOG2E = 1.4426950408889634f;
constexpr float QSCALE = 0.125f * LOG2E;
constexpr float LAMBDA_INIT = 0.35550906759f;
constexpr int NWAVES = 8;

constexpr size_t MiB = 1u << 20;
constexpr size_t WS_CTL = 0, CTL_ZERO_BYTES = 1 * MiB;
constexpr size_t WS_SWA_QKV_T = 1 * MiB, WS_SWA_WO_T = 4 * MiB, WS_DIFF_QKV_T = 6 * MiB, WS_DIFF_WO_T = 12 * MiB;
constexpr size_t WS_WR = 14 * MiB;
constexpr size_t WS_RSTD = 14 * MiB + 512 * 1024;
constexpr size_t WS_LTOK = 15 * MiB, WS_LW = 19 * MiB, WS_TINFO = 23 * MiB;
constexpr size_t WS_WMOE = 24 * MiB;
constexpr size_t WS_XN = 216 * MiB;
constexpr size_t WS_SCR = 280 * MiB;
constexpr size_t WS_QKV = WS_SCR, WS_O = WS_SCR + 192 * MiB, WS_Y = WS_SCR, WS_H = WS_SCR + 144 * MiB;
constexpr size_t WS_END = 536 * MiB;
constexpr int CW_BAR = 4096;
constexpr int CW_CNT = 16384;
constexpr int CW_KMAX = 24576;

constexpr int RING_BYTES = 131072;
constexpr int LDSCTL_OFF = RING_BYTES;
constexpr int MISC_OFF = LDSCTL_OFF + 320;
constexpr int TP_OFF = LDSCTL_OFF + 1024;
constexpr int STASH_OFF = LDSCTL_OFF + 2048;
constexpr int LDS_BYTES = 147456;

__device__ __forceinline__ unsigned f2bf(float f) { unsigned u = __builtin_bit_cast(unsigned, f); return (u + 0x7fffu + ((u >> 16) & 1u)) >> 16; }
__device__ __forceinline__ unsigned pk2(float lo, float hi) { return f2bf(lo) | (f2bf(hi) << 16); }
__device__ __forceinline__ unsigned cvtpk(float lo, float hi) { f32x2 v = {lo, hi}; bf16x2_t b = __builtin_convertvector(v, bf16x2_t); return __builtin_bit_cast(unsigned, b); }
__device__ __forceinline__ unsigned pk4_fp8(float a, float b, float c, float d) {
    a = __builtin_fminf(__builtin_fmaxf(a, -448.f), 448.f); b = __builtin_fminf(__builtin_fmaxf(b, -448.f), 448.f); c = __builtin_fminf(__builtin_fmaxf(c, -448.f), 448.f); d = __builtin_fminf(__builtin_fmaxf(d, -448.f), 448.f);
    int r = 0; r = __builtin_amdgcn_cvt_pk_fp8_f32(a, b, r, false); r = __builtin_amdgcn_cvt_pk_fp8_f32(c, d, r, true); return (unsigned)r; }
__device__ __forceinline__ float bf2f(unsigned short h) { return __builtin_bit_cast(float, (unsigned)h << 16); }
__device__ __forceinline__ int relaunder(int x) { asm volatile("" : "+v"(x)); return x; }
__device__ __forceinline__ int lane_id() { return (int)__builtin_amdgcn_mbcnt_hi(~0u, __builtin_amdgcn_mbcnt_lo(~0u, 0u)); }
__device__ __forceinline__ float wave_sum(float v) {
#pragma unroll
    for (int o = 1; o < 64; o <<= 1) v += __shfl_xor(v, o);
    return v;
}

namespace pg8 {
constexpr int BM = 256, BK = 64, HALF = 128, HTB = HALF * BK * 2, STAGE_BYTES = 8 * HTB, NXCD = 8, WGM = 8;
__host__ __device__ __forceinline__ int lds_byte(int r, int c) { const int st = (r >> 4) * 2 + (c >> 5), rr = r & 15, cc = c & 31, ob = rr * 64 + cc * 2; return st * 1024 + (ob ^ (((ob >> 9) & 1) << 5)); }
__host__ __device__ __forceinline__ void stage_rc(int b, int& R, int& C) { const int st = b / 1024, sb = b % 1024, swz = sb ^ (((sb >> 9) & 1) << 5); R = (st >> 1) * 16 + swz / 64; C = (st & 1) * 32 + (swz % 64) / 2; }
__host__ __device__ __forceinline__ int perm32(int rho) { const int n = rho >> 4, i = rho & 15; return 8 * (i >> 2) + 4 * n + (i & 3); }

struct Unit { int pm, pn, e, t, pnl; };
struct Gemm { const bf16_t* A; const bf16_t* Bt; int K; unsigned sw = 0x7f7f7f7fu, sx = 0x7f7f7f7fu; };

struct DenseOrder {
    int nM, nN, nwg, G, c;
    __device__ void init(int Mr, int N, int G_, int c_) { nM = Mr / BM; nN = N / BM; nwg = nM * nN; G = G_; c = c_; }
    __device__ bool next(int i, Unit& u) const {
        const long L = (long)i * G + c; if (L >= nwg) return false;
        int wgid = (int)L; { const int q = nwg / NXCD, r = nwg % NXCD, xcd = wgid % NXCD, off = wgid / NXCD; wgid = (xcd < r ? xcd * (q + 1) : r * (q + 1) + (xcd - r) * q) + off; }
        const int nig = WGM * nN, gid = wgid / nig, fm = gid * WGM, gsz = (nM - fm) < WGM ? (nM - fm) : WGM;
        u.pm = fm + ((wgid % nig) % gsz); u.pn = (wgid % nig) / gsz; u.e = 0; u.t = 0; u.pnl = u.pn; return true;
    }
    __device__ __forceinline__ int token(const Unit&, int) const { return 0; }
};
struct MoeOrder {
    const LAS int* TP; const LAS int* CNT; const int* ltok; int G, c, pn_mul, pn_add;
    __device__ bool next(int i, Unit& u) const {
        const int ntile = __builtin_amdgcn_readfirstlane(TP[32]); const int nwg = ntile * 4;
        const long L = (long)i * G + c; if (L >= nwg) return false;
        int wgid = (int)L; { const int q = nwg / NXCD, r = nwg % NXCD, xcd = wgid % NXCD, off = wgid / NXCD; wgid = (xcd < r ? xcd * (q + 1) : r * (q + 1) + (xcd - r) * q) + off; }
        const int tau = wgid >> 2; int e = 0;
#pragma unroll
        for (int st = 16; st >= 1; st >>= 1) if (__builtin_amdgcn_readfirstlane(TP[e + st]) <= tau) e += st;
        u.pm = tau; u.e = e; u.t = tau - __builtin_amdgcn_readfirstlane(TP[e]); u.pnl = wgid & 3; u.pn = e * pn_mul + pn_add + u.pnl; return true;
    }
    __device__ __forceinline__ int token(const Unit& u, int r) const { const int idx = u.t * 256 + r; return ltok[(size_t)u.e * M + (idx < CNT[u.e] ? idx : 0)]; }
};

struct EpiQKV {
    static constexpr bool PERM = true;
    bf16_t* O; int ldc; int qcols; float qscale; unsigned* kmaxsq;
    __device__ __forceinline__ void operator()(const f32x4 (&acc)[2][2][4][2], const Unit& u, int wr, int wc, int fr, int fq) const {
        asm volatile("" : "+v"(fr), "+v"(fq));
        const int row0 = u.pm * BM + wr * 64 + fr, colt = u.pn * BM; const float sc = colt < qcols ? qscale : 1.f;
        const int col0 = colt + wc * 32 + 8 * fq;
#pragma unroll
        for (int ai = 0; ai < 2; ++ai)
#pragma unroll
            for (int m = 0; m < 4; ++m) { bf16_t* rowp = O + (size_t)(row0 + ai * HALF + m * 16) * ldc + col0;
#pragma unroll
                for (int bj = 0; bj < 2; ++bj) { const f32x4 v0 = acc[ai][bj][m][0] * sc, v1 = acc[ai][bj][m][1] * sc;
                    u32x4 w; w.x = cvtpk(v0[0], v0[1]); w.y = cvtpk(v0[2], v0[3]); w.z = cvtpk(v1[0], v1[1]); w.w = cvtpk(v1[2], v1[3]);
                    *(u32x4*)(rowp + bj * HALF) = w; } }
        if (kmaxsq != nullptr && colt >= 1024 && colt < 2048) {
#pragma unroll
            for (int bj = 0; bj < 2; ++bj) { float mx = 0.f;
#pragma unroll
                for (int ai = 0; ai < 2; ++ai)
#pragma unroll
                    for (int m = 0; m < 4; ++m) { const f32x4 v0 = acc[ai][bj][m][0], v1 = acc[ai][bj][m][1];
                        float ss = (v0[0] * v0[0] + v0[1] * v0[1]) + (v0[2] * v0[2] + v0[3] * v0[3]) + (v1[0] * v1[0] + v1[1] * v1[1]) + (v1[2] * v1[2] + v1[3] * v1[3]);
                        ss += __shfl_xor(ss, 16); ss += __shfl_xor(ss, 32); mx = __builtin_fmaxf(mx, ss); }
                mx = __builtin_fmaxf(mx, __shfl_xor(mx, 1)); mx = __builtin_fmaxf(mx, __shfl_xor(mx, 2)); mx = __builtin_fmaxf(mx, __shfl_xor(mx, 4)); mx = __builtin_fmaxf(mx, __shfl_xor(mx, 8));
                if (fr == 0 && fq == 0) atomicMax(kmaxsq + (u.pm >> 5) * 32 + ((colt - 1024 + bj * HALF + wc * 32) >> 5), __float_as_uint(mx)); }
        }
    }
};
struct EpiResid {
    static constexpr bool PERM = false;
    const float* base; float* out;
    __device__ __forceinline__ void operator()(const f32x4 (&acc)[2][2][4][2], const Unit& u, int wr, int wc, int fr, int fq) const {
        asm volatile("" : "+v"(fr), "+v"(fq));
        const int col0 = u.pn * BM + wc * 32 + 4 * fq;
#pragma unroll
        for (int ai = 0; ai < 2; ++ai) {
            f32x4 b[4][2][2];
#pragma unroll
            for (int m = 0; m < 4; ++m) { const size_t off = (size_t)(u.pm * BM + ai * HALF + wr * 64 + m * 16 + fr) * D + col0;
#pragma unroll
                for (int bj = 0; bj < 2; ++bj)
#pragma unroll
                    for (int n = 0; n < 2; ++n) b[m][bj][n] = *(const f32x4*)(base + off + bj * HALF + n * 16); }
            asm volatile("" ::: "memory");
#pragma unroll
            for (int m = 0; m < 4; ++m) { const size_t off = (size_t)(u.pm * BM + ai * HALF + wr * 64 + m * 16 + fr) * D + col0;
#pragma unroll
                for (int bj = 0; bj < 2; ++bj)
#pragma unroll
                    for (int n = 0; n < 2; ++n) *(f32x4*)(out + off + bj * HALF + n * 16) = b[m][bj][n] + acc[ai][bj][m][n]; }
            asm volatile("" ::: "memory");
        }
    }
};
__device__ __forceinline__ float silu_mul(float g, float u) { return g * u * __builtin_amdgcn_rcpf(1.f + __builtin_amdgcn_exp2f(-g * LOG2E)); }
template <bool F8>
struct EpiSwiGLU {
    static constexpr bool PERM = true;
    bf16_t* H; const int* ltok; const float* rstd_tok; const LAS int* CNT;
    __device__ __forceinline__ void operator()(const f32x4 (&acc)[2][2][4][2], const Unit& u, int wr, int wc, int fr, int fq) const {
        asm volatile("" : "+v"(fr), "+v"(fq));
        const int colh = u.pnl * 128 + wc * 32 + 8 * fq; const int cnt = CNT[u.e];
        int toks[2][4]; float rss[2][4];
#pragma unroll
        for (int ai = 0; ai < 2; ++ai)
#pragma unroll
            for (int m = 0; m < 4; ++m) { const int idx = u.t * 256 + ai * HALF + wr * 64 + m * 16 + fr; toks[ai][m] = ltok[(size_t)u.e * M + (idx < cnt ? idx : 0)]; }
#pragma unroll
        for (int ai = 0; ai < 2; ++ai)
#pragma unroll
            for (int m = 0; m < 4; ++m) rss[ai][m] = rstd_tok[toks[ai][m]];
        asm volatile("" ::: "memory");
#pragma unroll
        for (int ai = 0; ai < 2; ++ai)
#pragma unroll
            for (int m = 0; m < 4; ++m) { const int rl = ai * HALF + wr * 64 + m * 16 + fr; const size_t row = (size_t)u.pm * BM + rl;
                const float rs = rss[ai][m];
                const f32x4 g0 = acc[ai][0][m][0] * rs, g1 = acc[ai][0][m][1] * rs, u0 = acc[ai][1][m][0] * rs, u1 = acc[ai][1][m][1] * rs;
                if constexpr (F8) {
                    u32x2 w; w.x = pk4_fp8(8.f * silu_mul(g0[0], u0[0]), 8.f * silu_mul(g0[1], u0[1]), 8.f * silu_mul(g0[2], u0[2]), 8.f * silu_mul(g0[3], u0[3]));
                    w.y = pk4_fp8(8.f * silu_mul(g1[0], u1[0]), 8.f * silu_mul(g1[1], u1[1]), 8.f * silu_mul(g1[2], u1[2]), 8.f * silu_mul(g1[3], u1[3]));
                    *(u32x2*)((unsigned char*)H + row * DEXP + colh) = w;
                } else {
                    u32x4 w; w.x = cvtpk(silu_mul(g0[0], u0[0]), silu_mul(g0[1], u0[1])); w.y = cvtpk(silu_mul(g0[2], u0[2]), silu_mul(g0[3], u0[3]));
                    w.z = cvtpk(silu_mul(g1[0], u1[0]), silu_mul(g1[1], u1[1])); w.w = cvtpk(silu_mul(g1[2], u1[2]), silu_mul(g1[3], u1[3]));
                    *(u32x4*)(H + row * DEXP + colh) = w; }
            }
    }
};
struct EpiDown {
    static constexpr bool PERM = true;
    bf16_t* Y; const float* lw;
    __device__ __forceinline__ void operator()(const f32x4 (&acc)[2][2][4][2], const Unit& u, int wr, int wc, int fr, int fq) const {
        asm volatile("" : "+v"(fr), "+v"(fq));
        const int col0 = u.pnl * BM + wc * 32 + 8 * fq;
        float scs[2][4];
#pragma unroll
        for (int ai = 0; ai < 2; ++ai)
#pragma unroll
            for (int m = 0; m < 4; ++m) scs[ai][m] = lw[(size_t)u.e * M + u.t * 256 + ai * HALF + wr * 64 + m * 16 + fr];
        asm volatile("" ::: "memory");
#pragma unroll
        for (int ai = 0; ai < 2; ++ai)
#pragma unroll
            for (int m = 0; m < 4; ++m) { const int rl = ai * HALF + wr * 64 + m * 16 + fr; const size_t row = (size_t)u.pm * BM + rl;
                const float sc = scs[ai][m];
#pragma unroll
                for (int bj = 0; bj < 2; ++bj) { const f32x4 v0 = acc[ai][bj][m][0] * sc, v1 = acc[ai][bj][m][1] * sc;
                    u32x4 w; w.x = cvtpk(v0[0], v0[1]); w.y = cvtpk(v0[2], v0[3]); w.z = cvtpk(v1[0], v1[1]); w.w = cvtpk(v1[2], v1[3]);
                    *(u32x4*)(Y + row * D + col0 + bj * HALF) = w; } }
    }
};

template <class Epi, class Sched, bool GATHER, bool ALIGN_EPI, bool FP8 = false>
__device__ __forceinline__ void gemm_phase(LAS unsigned char* lds, const Gemm g, const Sched& S, const Epi& E, const int wid, const int lane) {
    const int tid = wid * 64 + lane, wr = wid >> 2, wc = wid & 3, fr = lane & 15, fq = lane >> 4;
    const int K = g.K, nt = K / BK;
    int Rr[2], Cc[2]; unsigned voffB[2];
#pragma unroll
    for (int i = 0; i < 2; ++i) { int R, C; stage_rc(tid * 16 + i * 8192, R, C); Rr[i] = R; Cc[i] = C; const int Rb = Epi::PERM ? ((R & ~31) + perm32(R & 31)) : R; voffB[i] = (unsigned)(Rb * K + C) * 2u; }
    const size_t kstep = (size_t)(BK * 2);
    const size_t hstep = (size_t)HALF * K * 2;
    const size_t tstep = 2 * hstep;
    const unsigned ldsw = (unsigned)wid * 1024u;
    const size_t R64 = (size_t)64 * K * 2;
    const size_t H1 = GATHER ? 0 : hstep;
    const int aoff = FP8 ? lds_byte(wr * 64 + fr, (fq >> 1) * 32 + (fq & 1) * 16) : lds_byte(wr * 64 + fr, fq * 8), boff = FP8 ? lds_byte(wc * 32 + fr, (fq >> 1) * 32 + (fq & 1) * 16) : lds_byte(wc * 32 + fr, fq * 8);

#define PG8_SA(b, h) (((b) * 2 + (h)) * HTB)
#define PG8_SB(b, h) ((4 + (b) * 2 + (h)) * HTB)
#define PG8_STAGE2(bufoff, gbase, o0, o1) do { \
        __builtin_amdgcn_global_load_lds((const unsigned*)((const char*)(gbase) + (o0)), (LAS unsigned*)(lds + (bufoff) + ldsw), 16, 0, 0); \
        __builtin_amdgcn_global_load_lds((const unsigned*)((const char*)(gbase) + (o1)), (LAS unsigned*)(lds + (bufoff) + ldsw + 8192), 16, 0, 0); } while (0)
#define PG8_STAGEB(bufoff, gbase) do {   \
        __builtin_amdgcn_global_load_lds((const unsigned*)((const char*)(gbase) + voffB[0]), (LAS unsigned*)(lds + (bufoff) + ldsw), 16, 0, 0); \
        __builtin_amdgcn_global_load_lds((const unsigned*)((const char*)(gbase) + R64 + voffB[0]), (LAS unsigned*)(lds + (bufoff) + ldsw + 8192), 16, 0, 0); } while (0)
#define PG8_LDA(dst, b, h) do { if constexpr (FP8) { _Pragma("unroll") for (int m = 0; m < 4; ++m) dst##8[m] = *(const LAS i32x8*)(lds + PG8_SA(b, h) + aoff + m * 2048); } \
        else { _Pragma("unroll") for (int m = 0; m < 4; ++m) _Pragma("unroll") for (int k = 0; k < 2; ++k) dst[m][k] = *(const LAS bf16x8*)(lds + PG8_SA(b, h) + aoff + m * 2048 + k * 1024); } } while (0)
#define PG8_LDB(dst, b, h) do { if constexpr (FP8) { _Pragma("unroll") for (int n = 0; n < 2; ++n) dst##8[n] = *(const LAS i32x8*)(lds + PG8_SB(b, h) + boff + n * 2048); } \
        else { _Pragma("unroll") for (int n = 0; n < 2; ++n) _Pragma("unroll") for (int k = 0; k < 2; ++k) dst[n][k] = *(const LAS bf16x8*)(lds + PG8_SB(b, h) + boff + n * 2048 + k * 1024); } } while (0)
#define PG8_CAT8(x) __builtin_shufflevector(__builtin_bit_cast(i32x4, (x)[0]), __builtin_bit_cast(i32x4, (x)[1]), 0, 1, 2, 3, 4, 5, 6, 7)
#define PG8_MMA(ai, bj, At, Bt) do { if constexpr (FP8) __builtin_amdgcn_sched_barrier(0); __builtin_amdgcn_s_setprio(1); _Pragma("unroll") for (int m = 0; m < 4; ++m) _Pragma("unroll") for (int n = 0; n < 2; ++n) { \
        if constexpr (FP8) acc[ai][bj][m][n] = __builtin_amdgcn_mfma_scale_f32_16x16x128_f8f6f4(Bt##8[n], At##8[m], acc[ai][bj][m][n], 0, 0, 0, (int)g.sw, 0, (int)g.sx); \
        else { _Pragma("unroll") for (int k = 0; k < 2; ++k) acc[ai][bj][m][n] = __builtin_amdgcn_mfma_f32_16x16x32_bf16(Bt[n][k], At[m][k], acc[ai][bj][m][n], 0, 0, 0); } } \
        if constexpr (FP8) { _Pragma("unroll") for (int m = 0; m < 4; ++m) _Pragma("unroll") for (int n = 0; n < 2; ++n) asm volatile("" : "+v"(acc[ai][bj][m][n])); }   \
        __builtin_amdgcn_s_setprio(0); if constexpr (FP8) __builtin_amdgcn_sched_barrier(0); } while (0)
#define PG8_WAIT_V(n) asm volatile("s_waitcnt vmcnt(" #n ")" ::: "memory")
#define PG8_WAIT_L(n) asm volatile("s_waitcnt lgkmcnt(" #n ")" ::: "memory")
#define PG8_BAR __builtin_amdgcn_s_barrier()
#define PG8_SCHED __builtin_amdgcn_sched_barrier(0)
    Unit cur, nxt; int ui = 0;
    if (!S.next(0, cur)) return;
    unsigned oc00, oc01, oc10, oc11;
    LAS u32x4* stash = (LAS u32x4*)(lds + (STASH_OFF - 0) ) + tid;
    if constexpr (GATHER) {
        oc00 = (unsigned)(S.token(cur, Rr[0]) * K + Cc[0]) * 2u; oc01 = (unsigned)(S.token(cur, Rr[1]) * K + Cc[1]) * 2u;
        oc10 = (unsigned)(S.token(cur, 128 + Rr[0]) * K + Cc[0]) * 2u; oc11 = (unsigned)(S.token(cur, 128 + Rr[1]) * K + Cc[1]) * 2u;
    } else {
        oc00 = (unsigned)(Rr[0] * K + Cc[0]) * 2u; oc01 = (unsigned)(Rr[1] * K + Cc[1]) * 2u; oc10 = oc00; oc11 = oc01;
    }
    f32x4 acc[2][2][4][2];
#pragma unroll
    for (int a = 0; a < 2; ++a)
#pragma unroll
        for (int b = 0; b < 2; ++b)
#pragma unroll
            for (int m = 0; m < 4; ++m)
#pragma unroll
                for (int n = 0; n < 2; ++n) acc[a][b][m][n] = (f32x4){0.f, 0.f, 0.f, 0.f};
    bf16x8 At[4][2], B0[2][2], B1[2][2];
    i32x8 At8[4], B08[2], B18[2];
    const char* cA = GATHER ? (const char*)g.A : (const char*)g.A + (size_t)cur.pm * tstep; const char* cB = (const char*)g.Bt + (size_t)cur.pn * tstep;
    PG8_STAGEB(PG8_SB(0, 0), cB); PG8_STAGEB(PG8_SB(0, 1), cB + hstep); PG8_STAGE2(PG8_SA(0, 0), cA, oc00, oc01); PG8_STAGE2(PG8_SA(0, 1), cA + H1, oc10, oc11);
    if (wr == 1) PG8_BAR;
    PG8_WAIT_V(2); PG8_BAR;
    PG8_STAGEB(PG8_SB(1, 0), cB + kstep); PG8_STAGE2(PG8_SA(1, 0), cA + kstep, oc00, oc01); PG8_STAGEB(PG8_SB(1, 1), cB + hstep + kstep);
    PG8_WAIT_V(6); PG8_BAR;
    for (;;) {
        const bool has_next = S.next(ui + 1, nxt);
        const char* nA = has_next ? (GATHER ? (const char*)g.A : (const char*)g.A + (size_t)nxt.pm * tstep) : cA; const char* nB = has_next ? (const char*)g.Bt + (size_t)nxt.pn * tstep : cB;
        if constexpr (GATHER) {
            u32x4 nx = {oc00, oc01, oc10, oc11};
            if (has_next) { int R0, C0, R1, C1; stage_rc(tid * 16, R0, C0); stage_rc(tid * 16 + 8192, R1, C1);
                nx.x = (unsigned)(S.token(nxt, R0) * K + C0) * 2u; nx.y = (unsigned)(S.token(nxt, R1) * K + C1) * 2u;
                nx.z = (unsigned)(S.token(nxt, 128 + R0) * K + C0) * 2u; nx.w = (unsigned)(S.token(nxt, 128 + R1) * K + C1) * 2u; }
            *stash = nx;
        }
        for (int t = 0; t < nt; t += 2) {
            const bool last = (t == nt - 2);
            const char* a1 = cA + (size_t)(t + 1) * kstep;
            const char* a2 = last ? nA : cA + (size_t)(t + 2) * kstep; const char* b2 = last ? nB : cB + (size_t)(t + 2) * kstep;
            const char* a3 = a2 + kstep; const char* b3 = b2 + kstep;
            unsigned x00 = oc00, x01 = oc01, x10 = oc10, x11 = oc11;
            if constexpr (GATHER) { if (last) { const u32x4 nx = *stash; x00 = nx.x; x01 = nx.y; x10 = nx.z; x11 = nx.w; } }
            PG8_LDB(B0, 0, 0); PG8_LDB(B1, 0, 1); PG8_SCHED; PG8_LDA(At, 0, 0); PG8_STAGE2(PG8_SA(1, 1), a1 + H1, oc10, oc11);
            PG8_WAIT_V(8); PG8_WAIT_L(0); PG8_BAR; PG8_MMA(0, 0, At, B0); PG8_MMA(0, 1, At, B1); PG8_BAR; PG8_SCHED;
            PG8_LDA(At, 0, 1); PG8_STAGEB(PG8_SB(0, 0), b2); PG8_STAGEB(PG8_SB(0, 1), b2 + hstep); PG8_STAGE2(PG8_SA(0, 0), a2, x00, x01);
            PG8_WAIT_V(8); PG8_WAIT_L(0); PG8_BAR; PG8_MMA(1, 0, At, B0); PG8_MMA(1, 1, At, B1); PG8_BAR; PG8_SCHED;
            PG8_LDB(B0, 1, 0); PG8_LDB(B1, 1, 1); PG8_SCHED; PG8_LDA(At, 1, 0); PG8_STAGE2(PG8_SA(0, 1), a2 + H1, x10, x11);
            PG8_WAIT_V(8); PG8_WAIT_L(0); PG8_BAR; PG8_MMA(0, 0, At, B0); PG8_MMA(0, 1, At, B1); PG8_BAR; PG8_SCHED;
            PG8_LDA(At, 1, 1); PG8_STAGEB(PG8_SB(1, 0), b3); PG8_STAGEB(PG8_SB(1, 1), b3 + hstep); PG8_STAGE2(PG8_SA(1, 0), a3, x00, x01);
            PG8_WAIT_V(8); PG8_WAIT_L(0); PG8_BAR; PG8_MMA(1, 0, At, B0); PG8_MMA(1, 1, At, B1); PG8_BAR; PG8_SCHED;
        }
        if constexpr (ALIGN_EPI) { if (wr == 0) PG8_BAR; }
        E(acc, cur, wr, wc, fr, fq);
        if (!has_next) break;
#pragma unroll
        for (int a = 0; a < 2; ++a)
#pragma unroll
            for (int b = 0; b < 2; ++b)
#pragma unroll
                for (int m = 0; m < 4; ++m)
#pragma unroll
                    for (int n = 0; n < 2; ++n) acc[a][b][m][n] = (f32x4){0.f, 0.f, 0.f, 0.f};
        cur = nxt; cA = nA; cB = nB; ++ui;
        if constexpr (GATHER) { const u32x4 nx = *stash; oc00 = nx.x; oc01 = nx.y; oc10 = nx.z; oc11 = nx.w; }
        if constexpr (ALIGN_EPI) { if (wr == 1) PG8_BAR; }
    }
    PG8_WAIT_V(0);
    if constexpr (!ALIGN_EPI) { if (wr == 0) PG8_BAR; }
    PG8_BAR;
#undef PG8_SA
#undef PG8_SB
#undef PG8_STAGE2
#undef PG8_STAGEB
#undef PG8_LDA
#undef PG8_LDB
#undef PG8_MMA
#undef PG8_CAT8
#undef PG8_WAIT_V
#undef PG8_WAIT_L
#undef PG8_BAR
#undef PG8_SCHED
}
}

namespace att {
constexpr int NSLOT = 3;
constexpr float THR = 8.0f;
__device__ __forceinline__ void glds16(const void* gsrc, unsigned lds_dst) { unsigned keep;
    asm volatile("s_mov_b32 %0, m0\n\ts_mov_b32 m0, %2\n\ts_nop 0\n\tglobal_load_lds_dwordx4 %1, off\n\ts_mov_b32 m0, %0" : "=&s"(keep) : "v"(gsrc), "s"(lds_dst) : "memory"); }
#define ATT_WAIT_BAR(N) asm volatile("s_waitcnt vmcnt(" #N ") lgkmcnt(0)\n\ts_barrier" ::: "memory")
typedef LAS const char* lds_cptr;
typedef short v4i16_t __attribute__((ext_vector_type(4)));
__device__ __forceinline__ s16x4 vtr(lds_cptr p) { return __builtin_bit_cast(s16x4, __builtin_amdgcn_ds_read_tr16_b64_v4i16((LAS v4i16_t*)p)); }
__device__ __forceinline__ float swap_max(float m) { auto rr = __builtin_amdgcn_permlane32_swap(__float_as_uint(m), __float_as_uint(m), false, false); return __builtin_fmaxf(__uint_as_float(rr[0]), __uint_as_float(rr[1])); }
__device__ __forceinline__ float swap_sum(float m) { auto rr = __builtin_amdgcn_permlane32_swap(__float_as_uint(m), __float_as_uint(m), false, false); return __uint_as_float(rr[0]) + __uint_as_float(rr[1]); }
__device__ __forceinline__ float max3f(float a, float b, float c) { float r; asm("v_max3_f32 %0, %1, %2, %3" : "=v"(r) : "v"(a), "v"(b), "v"(c)); return r; }
template <unsigned KB> __device__ __forceinline__ float fmamk(float a, float c) { float r; asm("v_fmamk_f32 %0, %1, %2, %3" : "=v"(r) : "v"(a), "i"(KB), "v"(c)); return r; }
#define CRF(r) ((float)(((r) & 3) + 8 * ((r) >> 2)))
#define CRI(r) (((r) & 3) + 8 * ((r) >> 2))

template <int MODE> struct Cfg;
template <> struct Cfg<0> { static constexpr int DV32 = 2, NK = 1, SLOTB = 16384, VOFF = 8192, PITCH = SWA_N, NVP = 1; };
template <> struct Cfg<1> { static constexpr int DV32 = 4, NK = 2, SLOTB = 32768, VOFF = 16384, PITCH = DIFF_N, NVP = 2; };

template <int MODE>
__device__ __forceinline__ void tile_step(lds_cptr kp, lds_cptr vp, const bf16x8 (&qr)[4], f32x16 (&o)[Cfg<MODE>::DV32], float& mhat, float& l, bool& first,
                                          const float slope2, const int dq_i, const int kind, const int hi) {
    constexpr int DV32 = Cfg<MODE>::DV32;
    f32x16 p0, p1;
    const float dq = (float)dq_i, nm = -mhat;
    {
        const float sl = kind == 2 ? 0.f : (kind == 0 ? slope2 : -slope2); const float base0 = __builtin_fmaf(-sl, dq, nm);
#pragma unroll
        for (int r = 0; r < 16; ++r) { p0[r] = __builtin_fmaf(sl, CRF(r), base0); p1[r] = __builtin_fmaf(sl, CRF(r) + 32.f, base0); }
    }
#pragma unroll
    for (int d0 = 0; d0 < 4; ++d0) {
        const bf16x8 b0 = *(const LAS bf16x8*)(kp + d0 * 2048);
        const bf16x8 b1 = *(const LAS bf16x8*)(kp + d0 * 2048 + 512);
        p0 = __builtin_amdgcn_mfma_f32_32x32x16_bf16(b0, qr[d0], p0, 0, 0, 0);
        p1 = __builtin_amdgcn_mfma_f32_32x32x16_bf16(b1, qr[d0], p1, 0, 0, 0);
    }
    if (kind == 2) {
#pragma unroll
        for (int r = 0; r < 16; ++r) {
            const float e0 = __builtin_fabsf(dq - CRF(r)), e1 = __builtin_fabsf(dq - CRF(r) - 32.f);
            if (MODE == 0) { p0[r] = e0 <= 128.f ? __builtin_fmaf(-slope2, e0, p0[r]) : -INFINITY; p1[r] = e1 <= 128.f ? __builtin_fmaf(-slope2, e1, p1[r]) : -INFINITY; }
            else { p0[r] = __builtin_fmaf(-slope2, e0, p0[r]); p1[r] = __builtin_fmaf(-slope2, e1, p1[r]); }
        }
    }
    float rm = __builtin_fmaxf(p0[0], p1[0]);
#pragma unroll
    for (int r = 1; r < 16; ++r) rm = __builtin_fmaxf(rm, __builtin_fmaxf(p0[r], p1[r]));
    rm = swap_max(rm);
    if (first || __any(rm > THR)) {
        const float dl = first ? rm : __builtin_fmaxf(rm, 0.f);
        mhat += dl;
#pragma unroll
        for (int r = 0; r < 16; ++r) { p0[r] -= dl; p1[r] -= dl; }
        if (!first) {
            const float f = __builtin_amdgcn_exp2f(-dl); l *= f;
#pragma unroll
            for (int r = 0; r < 16; ++r) { int h4_ = 4 * hi; asm volatile("" : "+v"(h4_)); const float fr_ = __shfl(f, CRI(r) + h4_);
#pragma unroll
                for (int d0 = 0; d0 < DV32; ++d0) o[d0][r] *= fr_; }
        }
        first = false;
    }
    float sacc = 0.f;
    u32x4 pw[4];
#pragma unroll
    for (int s = 0; s < 2; ++s) {
        float e[8];
#pragma unroll
        for (int j = 0; j < 8; ++j) { e[j] = __builtin_amdgcn_exp2f(p0[8 * s + j]); sacc += e[j]; }
        pw[s] = (u32x4){cvtpk(e[0], e[1]), cvtpk(e[2], e[3]), cvtpk(e[4], e[5]), cvtpk(e[6], e[7])};
    }
#pragma unroll
    for (int s = 0; s < 2; ++s) {
        float e[8];
#pragma unroll
        for (int j = 0; j < 8; ++j) { e[j] = __builtin_amdgcn_exp2f(p1[8 * s + j]); sacc += e[j]; }
        pw[2 + s] = (u32x4){cvtpk(e[0], e[1]), cvtpk(e[2], e[3]), cvtpk(e[4], e[5]), cvtpk(e[6], e[7])};
    }
    l += sacc;
#pragma unroll
    for (int d0 = 0; d0 < DV32; ++d0) {
#pragma unroll
        for (int ks = 0; ks < 4; ++ks) {
            const s16x4 lo = vtr(vp + d0 * 4096 + ks * 1024), hh = vtr(vp + d0 * 4096 + ks * 1024 + 512);
            const bf16x8 vf = (bf16x8){lo[0], lo[1], lo[2], lo[3], hh[0], hh[1], hh[2], hh[3]};
            o[d0] = __builtin_amdgcn_mfma_f32_32x32x16_bf16(__builtin_bit_cast(bf16x8, pw[ks]), vf, o[d0], 0, 0, 0);
        }
    }
}

struct DiffConsts { float lam_full; const float* subln; };

template <int MODE>
__device__ __forceinline__ void attn_unit(const int b, const int hh, const int qb, const bf16_t* __restrict__ QKV, bf16_t* __restrict__ O, const float* __restrict__ sink,
                                          const DiffConsts dc, LAS unsigned char* shm, const int wid, const int lane_in) {
    typedef Cfg<MODE> C;
    constexpr int DV32 = C::DV32, PITCH = C::PITCH;
    int lane = lane_in; asm volatile("" : "+v"(lane));
    const int r32 = lane & 31, hi = lane >> 5;
    int iw, qcol, kcol, vcol, t_lo, NT, hq = 0, cmap = 0, qs;
    float slope2;
    if (MODE == 0) { const int g = wid >> 1; qs = wid & 1; hq = hh * 4 + g; iw = qb * 64 + qs * 32; qcol = hq * 64; kcol = 1024 + hh * 64; vcol = 1280 + hh * 64;
        t_lo = qb - 2 < 0 ? 0 : qb - 2; const int t_hi = qb + 2 > 127 ? 127 : qb + 2; NT = t_hi - t_lo + 1; slope2 = __builtin_amdgcn_exp2f(-0.5f * (float)(hq + 1)) * LOG2E; }
    else { qs = wid & 3; cmap = wid >> 2; iw = qb * 128 + qs * 32; qcol = (hh * 2 + cmap) * 64; kcol = 1024 + hh * 128; vcol = 2048 + hh * 128; t_lo = 0; NT = SEQ / 64;
        slope2 = __builtin_amdgcn_exp2f(-(float)(hh + 1)) * LOG2E; }
    const bf16_t* base = QKV + (size_t)b * SEQ * PITCH;
    const unsigned lds0 = (unsigned)(uintptr_t)shm;
    const unsigned koff = (unsigned)(lane * PITCH + kcol + wid * 8) * 2u;
    const unsigned voff = (unsigned)((16 * (wid & 3) + (lane >> 2)) * PITCH + vcol + (wid >> 2) * 32 + (lane & 3) * 8) * 2u;
    const unsigned kdst = lds0 + wid * 1024, vdst = lds0 + C::VOFF + wid * 1024;
#define ATT_DMA(t, slot) do { const char* tb_ = (const char*)base + (size_t)(t) * 64 * PITCH * 2; const unsigned so_ = (unsigned)(slot) * C::SLOTB; \
        glds16(tb_ + koff, (unsigned)__builtin_amdgcn_readfirstlane(kdst + so_)); \
        if (MODE == 1) glds16(tb_ + koff + 128, (unsigned)__builtin_amdgcn_readfirstlane(kdst + so_ + 8192)); \
        glds16(tb_ + voff, (unsigned)__builtin_amdgcn_readfirstlane(vdst + so_)); \
        if (MODE == 1) glds16(tb_ + voff + 128, (unsigned)__builtin_amdgcn_readfirstlane(vdst + so_ + 8192)); } while (0)
    ATT_DMA(t_lo, 0);
    if (NT > 1) ATT_DMA(t_lo + 1, 1);
    bf16x8 qr[4];
    { const bf16_t* Qw = base + (size_t)(iw + r32) * PITCH + qcol;
#pragma unroll
      for (int d0 = 0; d0 < 4; ++d0) qr[d0] = *(const bf16x8*)(Qw + d0 * 16 + hi * 8); }
    f32x16 o[DV32];
#pragma unroll
    for (int d0 = 0; d0 < DV32; ++d0)
#pragma unroll
        for (int r = 0; r < 16; ++r) o[d0][r] = 0.f;
    float mhat = 0.f, l = 0.f; bool first = true;
    if (MODE == 0) { mhat = sink[hq] * LOG2E; l = (hi == 0) ? 1.f : 0.f; first = false; }
    const lds_cptr shm3 = (lds_cptr)shm;
    const lds_cptr kp0 = shm3 + (MODE == 1 ? cmap * 8192 : 0) + hi * 1024 + r32 * 16;
    const lds_cptr vp0 = shm3 + C::VOFF + ((lane >> 4) & 1) * 32 + (lane & 3) * 8 + (4 * hi + ((lane & 15) >> 2)) * 64;
    int slot = 0;
    for (int it = 0; it < NT; ++it) {
        if (it + 1 < NT) { if (MODE == 1) { ATT_WAIT_BAR(4); } else { ATT_WAIT_BAR(2); } } else { ATT_WAIT_BAR(0); }
        if (it + 2 < NT) { const int s2 = slot == 0 ? 2 : slot - 1; ATT_DMA(t_lo + it + 2, s2); }
        const int k0 = (t_lo + it) * 64;
        const int kind = (MODE == 0) ? ((t_lo + it == qb - 1) ? 0 : ((t_lo + it == qb + 1) ? 1 : 2)) : ((k0 + 63 < iw) ? 0 : ((k0 > iw + 31) ? 1 : 2));
        tile_step<MODE>(kp0 + slot * C::SLOTB, vp0 + slot * C::SLOTB, qr, o, mhat, l, first, slope2, iw + r32 - k0 - 4 * hi, kind, hi);
        slot = slot == 2 ? 0 : slot + 1;
    }
#undef ATT_DMA
    l = swap_sum(l);
    const float rl = 1.f / l;
    if (MODE == 0) {
        bf16_t* Ow = O + (size_t)(b * SEQ + iw) * D + hq * 64 + r32;
#pragma unroll
        for (int r = 0; r < 16; ++r) { const int row = CRI(r) + 4 * hi; const float rr = __shfl(rl, row);
#pragma unroll
            for (int d0 = 0; d0 < DV32; ++d0) Ow[(size_t)row * D + d0 * 32] = (bf16_t)f2bf(o[d0][r] * rr); }
        ATT_WAIT_BAR(0);
    } else {
        LAS float* cb = (LAS float*)shm + qs * 4096;
        ATT_WAIT_BAR(0);
        if (cmap == 1) {
#pragma unroll
            for (int r = 0; r < 16; ++r) { const int row = CRI(r) + 4 * hi; const float rr = __shfl(rl, row) * dc.lam_full;
#pragma unroll
                for (int d0 = 0; d0 < DV32; ++d0) cb[row * 128 + d0 * 32 + r32] = o[d0][r] * rr; }
        }
        ATT_WAIT_BAR(0);
        if (cmap == 0) {
            bf16_t* Ow = O + (size_t)(b * SEQ + iw) * D + hh * 128 + r32;
            float gsub[DV32];
#pragma unroll
            for (int d0 = 0; d0 < DV32; ++d0) gsub[d0] = dc.subln[d0 * 32 + r32] * (1.f - LAMBDA_INIT);
#pragma unroll
            for (int r = 0; r < 16; ++r) { const int row = CRI(r) + 4 * hi; const float rr = __shfl(rl, row);
                float v[DV32]; float ss = 0.f;
#pragma unroll
                for (int d0 = 0; d0 < DV32; ++d0) { v[d0] = o[d0][r] * rr - cb[row * 128 + d0 * 32 + r32]; ss += v[d0] * v[d0]; }
                ss += __shfl_xor(ss, 1); ss += __shfl_xor(ss, 2); ss += __shfl_xor(ss, 4); ss += __shfl_xor(ss, 8); ss += __shfl_xor(ss, 16);
                const float sc = __builtin_amdgcn_rsqf(ss * (1.f / 128.f) + 1e-5f);
#pragma unroll
                for (int d0 = 0; d0 < DV32; ++d0) Ow[(size_t)row * D + d0 * 32] = (bf16_t)f2bf(v[d0] * sc * gsub[d0]); }
        }
        ATT_WAIT_BAR(0);
    }
}

#define SBAR() __builtin_amdgcn_sched_barrier(0)
#define PIN(x) asm volatile("" : "+v"(x))
#define MF(a, b, c) __builtin_amdgcn_mfma_f32_32x32x16_bf16(a, b, c, 0, 0, 0)
template <int VAR>
__device__ __forceinline__ void diff_unit(const int b, const int hh, const int qb, const bf16_t* __restrict__ QKV, bf16_t* __restrict__ O, const float kmax,
                                          const DiffConsts dc, LAS unsigned char* shm, const int wid, const int lane_in) {
    constexpr int DV32 = 4, PITCH = DIFF_N, KSLOT = 16384, VRING = 4 * 16384;
    int lane = lane_in; asm volatile("" : "+v"(lane));
    const int r32 = lane & 31, hi = lane >> 5;
    const int qs = wid & 3, cmap = wid >> 2, i0 = qb * 128, iw = i0 + qs * 32, qcol = (hh * 2 + cmap) * 64, kcol = 1024 + hh * 128, vcol = 2048 + hh * 128;
    const float slope2 = __builtin_amdgcn_exp2f(-(float)(hh + 1)) * LOG2E;
    const bf16_t* base = QKV + (size_t)b * SEQ * PITCH;
    const unsigned lds0 = (unsigned)(uintptr_t)shm;
    const unsigned koff = (unsigned)(lane * PITCH + kcol + wid * 8) * 2u;
    const unsigned voff = (unsigned)((16 * (wid & 3) + (lane >> 2)) * PITCH + vcol + (wid >> 2) * 32 + (lane & 3) * 8) * 2u;
    const unsigned kdst = lds0 + wid * 1024, vdst = lds0 + VRING + wid * 1024;
#define DMA_K(t, slot) do { const char* tb_ = (const char*)base + (size_t)(t) * 64 * PITCH * 2; const unsigned so_ = (unsigned)(slot) * KSLOT; \
        glds16(tb_ + koff, (unsigned)__builtin_amdgcn_readfirstlane(kdst + so_)); glds16(tb_ + koff + 128, (unsigned)__builtin_amdgcn_readfirstlane(kdst + so_ + 8192)); } while (0)
#define DMA_V(t, slot) do { const char* tb_ = (const char*)base + (size_t)(t) * 64 * PITCH * 2; const unsigned so_ = (unsigned)(slot) * KSLOT; \
        glds16(tb_ + voff, (unsigned)__builtin_amdgcn_readfirstlane(vdst + so_)); glds16(tb_ + voff + 128, (unsigned)__builtin_amdgcn_readfirstlane(vdst + so_ + 8192)); } while (0)
    const int td0 = 2 * qb;
    int nL = td0;
#define TILE_OF(idx) ((idx) < 2 ? td0 + (idx) : ((idx) - 2 < nL ? td0 - 1 - ((idx) - 2) : td0 + 2 + ((idx) - 2 - nL)))
    DMA_K(td0, 0); DMA_V(td0, 0); DMA_K(td0 + 1, 1); DMA_V(td0 + 1, 1); DMA_K(TILE_OF(2), 2);
    bf16x8 qr[4]; float nq2 = 0.f;
    { const bf16_t* Qw = base + (size_t)(iw + r32) * PITCH + qcol;
#pragma unroll
      for (int d0 = 0; d0 < 4; ++d0) { qr[d0] = *(const bf16x8*)(Qw + d0 * 16 + hi * 8);
#pragma unroll
          for (int j = 0; j < 8; ++j) { const float f = bf2f((unsigned short)qr[d0][j]); nq2 += f * f; } } }
    nq2 = swap_sum(nq2);
    f32x16 o[DV32];
#pragma unroll
    for (int d0 = 0; d0 < DV32; ++d0)
#pragma unroll
        for (int r = 0; r < 16; ++r) o[d0][r] = 0.f;
    float mhat = 0.f, l = 0.f; bool first = true;
    const lds_cptr shm3 = (lds_cptr)shm;
    const lds_cptr kp0 = shm3 + cmap * 8192 + hi * 1024 + r32 * 16;
    const lds_cptr vp0 = shm3 + VRING + ((lane >> 4) & 1) * 32 + (lane & 3) * 8 + (4 * hi + ((lane & 15) >> 2)) * 64;
    LAS float* wsf = (LAS float*)(shm + 7 * KSLOT);
    ATT_WAIT_BAR(6);
    DMA_K(TILE_OF(3), 3);
    { const int k0 = td0 * 64; const int kind = (k0 + 63 < iw) ? 0 : ((k0 > iw + 31) ? 1 : 2);
      tile_step<1>(kp0, vp0, qr, o, mhat, l, first, slope2, iw + r32 - k0 - 4 * hi, kind, hi); }
    ATT_WAIT_BAR(4);
    DMA_K(TILE_OF(4), 0); DMA_V(TILE_OF(2), 2);
    { const int k0 = (td0 + 1) * 64; const int kind = (k0 + 63 < iw) ? 0 : ((k0 > iw + 31) ? 1 : 2);
      tile_step<1>(kp0 + KSLOT, vp0 + KSLOT, qr, o, mhat, l, first, slope2, iw + r32 - k0 - 4 * hi, kind, hi); }
    { float a = sqrtf(nq2) * kmax - mhat;
#pragma unroll
      for (int o_ = 1; o_ < 32; o_ <<= 1) a = __builtin_fmaxf(a, __shfl_xor(a, o_));
      if (lane == 0) wsf[wid] = a; }
    ATT_WAIT_BAR(4);
    int NT;
    { float amax = wsf[0];
#pragma unroll
      for (int w = 1; w < 8; ++w) amax = __builtin_fmaxf(amax, wsf[w]);
      const float dist = (64.f + __builtin_fmaxf(amax, 0.f)) / slope2;
      const float lo_f = ((float)(i0 - 63) - dist) * (1.f / 64.f), hi_f = ((float)(i0 + 127) + dist) * (1.f / 64.f);
      int t_lo = lo_f <= 0.f ? 0 : (int)lo_f, t_hi = hi_f >= 127.f ? 127 : (int)hi_f;
      if (t_lo > td0 - 2) t_lo = td0 - 2 < 0 ? 0 : td0 - 2; if (t_hi < td0 + 3) t_hi = td0 + 3 > 127 ? 127 : td0 + 3;
      t_lo = __builtin_amdgcn_readfirstlane(t_lo); t_hi = __builtin_amdgcn_readfirstlane(t_hi);
      nL = td0 - t_lo; NT = 2 + nL + (t_hi - (td0 + 1)); if (VAR & 256) NT = 2; }
    f32x16 xa0, xa1, xb0, xb1; u32x4 pw0, pw1, pw2, pw3; bf16x8 kf0, kf1, kf2, kf3; s16x4 vl0, vh0, vl1, vh1, vl2, vh2, vl3, vh3;
    float sl_n, base_n, rf = 1.f; bool resc = false;
#define KRD(dst, f) do { if ((VAR & 4) && (f) >= 4) break; dst = *(const LAS bf16x8*)(kp_ + ((f) >> 1) * 2048 + ((f) & 1) * 512); } while (0)
#define VRD(lo, hh_, i) do { if ((VAR & 2) && (i) >= 4) break; lo = vtr(vp_ + ((i) >> 2) * 4096 + ((i) & 3) * 1024); hh_ = vtr(vp_ + ((i) >> 2) * 4096 + ((i) & 3) * 1024 + 512); } while (0)
#define KRN(dst, f) dst = *(const LAS bf16x8*)(kn_ + ((f) >> 1) * 2048 + ((f) & 1) * 512)
#define VFR(lo, hh_) (bf16x8){lo[0], lo[1], lo[2], lo[3], hh_[0], hh_[1], hh_[2], hh_[3]}
#define SET_NEXT(idx) do { const int tn_ = TILE_OF(idx); const bool left_ = (idx) - 2 < nL; sl_n = left_ ? slope2 : -slope2; \
        base_n = __builtin_fmaf(-sl_n, (float)(iw + r32 - tn_ * 64 - 4 * hi), -mhat); } while (0)
#define CINIT(X0, X1) do { _Pragma("unroll") for (int r = 0; r < 16; ++r) { X0[r] = __builtin_fmaf(sl_n, CRF(r), base_n); X1[r] = __builtin_fmaf(sl_n, CRF(r) + 32.f, base_n); } } while (0)
#define GA(Sx, KF, qf, RD, P, e, PW, w0, w1) do { Sx = MF(KF, qf, Sx); RD; if (!(VAR & 32)) { sacc += P[e]; sacc += P[e + 1]; sacc += P[e + 2]; sacc += P[e + 3]; PIN(sacc); \
        PW[w0] = cvtpk(P[e], P[e + 1]); PW[w1] = cvtpk(P[e + 2], P[e + 3]); } PIN(PW); SBAR(); } while (0)
#define PHASE_A(S0, S1, P0, P1) do { float sacc = 0.f; \
        GA(S0, kf0, qr[0], KRD(kf0, 4), P0, 0,  pw0, 0, 1); GA(S1, kf1, qr[0], KRD(kf1, 5), P0, 4,  pw0, 2, 3); \
        GA(S0, kf2, qr[1], KRD(kf2, 6), P0, 8,  pw1, 0, 1); GA(S1, kf3, qr[1], KRD(kf3, 7), P0, 12, pw1, 2, 3); \
        GA(S0, kf0, qr[2], VRD(vl0, vh0, 0), P1, 0,  pw2, 0, 1); GA(S1, kf1, qr[2], VRD(vl1, vh1, 1), P1, 4,  pw2, 2, 3); \
        GA(S0, kf2, qr[3], VRD(vl2, vh2, 2), P1, 8,  pw3, 0, 1); GA(S1, kf3, qr[3], VRD(vl3, vh3, 3), P1, 12, pw3, 2, 3); \
        l += sacc; } while (0)
#define QK_ONLY(S0, S1) do { \
        S0 = MF(kf0, qr[0], S0); KRD(kf0, 4); S1 = MF(kf1, qr[0], S1); KRD(kf1, 5); S0 = MF(kf2, qr[1], S0); KRD(kf2, 6); S1 = MF(kf3, qr[1], S1); KRD(kf3, 7); SBAR(); \
        S0 = MF(kf0, qr[2], S0); S1 = MF(kf1, qr[2], S1); S0 = MF(kf2, qr[3], S0); S1 = MF(kf3, qr[3], S1); SBAR(); } while (0)
#define DECIDE(S0, S1) do { if (VAR & 64) break; asm volatile("s_nop 15\n\ts_nop 7" : "+v"(S0), "+v"(S1));   \
        float ma_ = max3f(S0[0], S0[1], S1[0]), mb_ = max3f(S0[2], S0[3], S1[1]); ma_ = max3f(ma_, S1[2], S1[3]); \
        _Pragma("unroll") for (int r = 4; r < 16; r += 4) { ma_ = max3f(ma_, S0[r], S0[r + 1]); mb_ = max3f(mb_, S0[r + 2], S0[r + 3]); ma_ = max3f(ma_, S1[r], S1[r + 1]); mb_ = max3f(mb_, S1[r + 2], S1[r + 3]); } \
        float rm_ = max3f(ma_, mb_, mb_); rm_ = swap_max(rm_); resc = false; \
        if (__builtin_expect(__any(rm_ > THR), 0)) { const float dl_ = __builtin_fmaxf(rm_, 0.f); mhat += dl_; \
            _Pragma("unroll") for (int r = 0; r < 16; ++r) { S0[r] -= dl_; S1[r] -= dl_; } \
            rf = __builtin_amdgcn_exp2f(-dl_); l *= rf; resc = true; } } while (0)
#define RESCALE_O() do { if (resc) { int h4_ = 4 * hi; asm volatile("" : "+v"(h4_)); _Pragma("unroll") for (int r = 0; r < 16; ++r) { const float fr_ = __shfl(rf, CRI(r) + h4_); \
            _Pragma("unroll") for (int d0 = 0; d0 < DV32; ++d0) o[d0][r] *= fr_; } resc = false; } } while (0)
#define EXP2(x) ((VAR & 1) ? (x) * 0.001f : __builtin_amdgcn_exp2f(x))
#define GB(Ox, PW, VL, VH, RD, S, e, C, crf) do { Ox = MF(__builtin_bit_cast(bf16x8, PW), VFR(VL, VH), Ox); RD; S[e] = EXP2(S[e]); S[e + 1] = EXP2(S[e + 1]); PIN(S); \
        if (!(VAR & 16)) { C[e] = fmamk<__builtin_bit_cast(unsigned, CRF(e) + (crf))>(sl_n, base_n); C[e + 1] = fmamk<__builtin_bit_cast(unsigned, CRF(e + 1) + (crf))>(sl_n, base_n); } PIN(C); SBAR(); } while (0)
#define PHASE_B(S0, S1, C0, C1) do { \
        GB(o[0], pw0, vl0, vh0, VRD(vl0, vh0, 4),  S0, 0,  C0, 0.f);  GB(o[0], pw1, vl1, vh1, VRD(vl1, vh1, 5),  S0, 2,  C0, 0.f); \
        GB(o[0], pw2, vl2, vh2, VRD(vl2, vh2, 6),  S0, 4,  C0, 0.f);  GB(o[0], pw3, vl3, vh3, VRD(vl3, vh3, 7),  S0, 6,  C0, 0.f); \
        GB(o[1], pw0, vl0, vh0, VRD(vl0, vh0, 8),  S0, 8,  C0, 0.f);  GB(o[1], pw1, vl1, vh1, VRD(vl1, vh1, 9),  S0, 10, C0, 0.f); \
        GB(o[1], pw2, vl2, vh2, VRD(vl2, vh2, 10), S0, 12, C0, 0.f);  GB(o[1], pw3, vl3, vh3, VRD(vl3, vh3, 11), S0, 14, C0, 0.f); \
        GB(o[2], pw0, vl0, vh0, VRD(vl0, vh0, 12), S1, 0,  C1, 32.f); GB(o[2], pw1, vl1, vh1, VRD(vl1, vh1, 13), S1, 2,  C1, 32.f); \
        GB(o[2], pw2, vl2, vh2, VRD(vl2, vh2, 14), S1, 4,  C1, 32.f); GB(o[2], pw3, vl3, vh3, VRD(vl3, vh3, 15), S1, 6,  C1, 32.f); \
        GB(o[3], pw0, vl0, vh0, KRN(kf0, 0),       S1, 8,  C1, 32.f); GB(o[3], pw1, vl1, vh1, KRN(kf1, 1),       S1, 10, C1, 32.f); \
        GB(o[3], pw2, vl2, vh2, KRN(kf2, 2),       S1, 12, C1, 32.f); GB(o[3], pw3, vl3, vh3, KRN(kf3, 3),       S1, 14, C1, 32.f); } while (0)
#define ROT3(s) ((s) == 2 ? 0 : (s) + 1)
#define ROT4(s) (((s) + 1) & 3)
#define STEP(S0, S1, P0, P1, it) do { \
        asm volatile("" : "+s"(sk), "+s"(sv)); \
        const int skm_ = (sk + 3) & 3, skp_ = ROT4(sk), svpp_ = sv == 0 ? 2 : sv - 1;   \
        const lds_cptr kp_ = kp0 + sk * KSLOT; const lds_cptr kn_ = kp0 + skp_ * KSLOT; const lds_cptr vp_ = vp0 + sv * KSLOT; \
        if (!(VAR & 8) && (it) + 3 < NT) DMA_K(TILE_OF((it) + 3), skm_); \
        SET_NEXT((it) + 1); SBAR(); \
        __builtin_amdgcn_s_setprio(1); PHASE_A(S0, S1, P0, P1); __builtin_amdgcn_s_setprio(0); \
        if (!(VAR & 8) && (it) + 1 < NT) DMA_V(TILE_OF((it) + 1), svpp_); \
        DECIDE(S0, S1); if (resc) SET_NEXT((it) + 1); SBAR(); \
        __builtin_amdgcn_s_setprio(1); PHASE_B(S0, S1, P0, P1); __builtin_amdgcn_s_setprio(0); \
        RESCALE_O(); sk = skp_; sv = ROT3(sv); } while (0)
    if (NT > 2) {
        { const lds_cptr kp_ = kp0 + 2 * KSLOT; const lds_cptr kn_ = kp0 + 3 * KSLOT;
          KRD(kf0, 0); KRD(kf1, 1); KRD(kf2, 2); KRD(kf3, 3);
          if (5 < NT) DMA_K(TILE_OF(5), 1); if (3 < NT) DMA_V(TILE_OF(3), 0);
          SET_NEXT(2); CINIT(xa0, xa1); SBAR();
          QK_ONLY(xa0, xa1);
          DECIDE(xa0, xa1); RESCALE_O();
#pragma unroll
          for (int r = 0; r < 16; ++r) { xa0[r] = EXP2(xa0[r]); xa1[r] = EXP2(xa1[r]); }
          SET_NEXT(3); CINIT(xb0, xb1);
          KRN(kf0, 0); KRN(kf1, 1); KRN(kf2, 2); KRN(kf3, 3); }
        int it = 3, sk = 3, sv = 2;
#pragma unroll 1
        for (; it + 1 < NT; it += 2) {
            if (!(VAR & 128)) { if (it + 2 < NT) { ATT_WAIT_BAR(4); } else { ATT_WAIT_BAR(2); } }
            STEP(xb0, xb1, xa0, xa1, it);
            if (!(VAR & 128)) { if (it + 3 < NT) { ATT_WAIT_BAR(4); } else { ATT_WAIT_BAR(2); } }
            STEP(xa0, xa1, xb0, xb1, it + 1);
        }
        if (it < NT) {
            ATT_WAIT_BAR(2);
            STEP(xb0, xb1, xa0, xa1, it);
            { float sacc = 0.f;
#pragma unroll
              for (int r = 0; r < 16; ++r) sacc += xb0[r] + xb1[r];
              l += sacc;
              pw0 = (u32x4){cvtpk(xb0[0], xb0[1]), cvtpk(xb0[2], xb0[3]), cvtpk(xb0[4], xb0[5]), cvtpk(xb0[6], xb0[7])}; pw1 = (u32x4){cvtpk(xb0[8], xb0[9]), cvtpk(xb0[10], xb0[11]), cvtpk(xb0[12], xb0[13]), cvtpk(xb0[14], xb0[15])};
              pw2 = (u32x4){cvtpk(xb1[0], xb1[1]), cvtpk(xb1[2], xb1[3]), cvtpk(xb1[4], xb1[5]), cvtpk(xb1[6], xb1[7])}; pw3 = (u32x4){cvtpk(xb1[8], xb1[9]), cvtpk(xb1[10], xb1[11]), cvtpk(xb1[12], xb1[13]), cvtpk(xb1[14], xb1[15])}; }
        } else {
            { float sacc = 0.f;
#pragma unroll
              for (int r = 0; r < 16; ++r) sacc += xa0[r] + xa1[r];
              l += sacc;
              pw0 = (u32x4){cvtpk(xa0[0], xa0[1]), cvtpk(xa0[2], xa0[3]), cvtpk(xa0[4], xa0[5]), cvtpk(xa0[6], xa0[7])}; pw1 = (u32x4){cvtpk(xa0[8], xa0[9]), cvtpk(xa0[10], xa0[11]), cvtpk(xa0[12], xa0[13]), cvtpk(xa0[14], xa0[15])};
              pw2 = (u32x4){cvtpk(xa1[0], xa1[1]), cvtpk(xa1[2], xa1[3]), cvtpk(xa1[4], xa1[5]), cvtpk(xa1[6], xa1[7])}; pw3 = (u32x4){cvtpk(xa1[8], xa1[9]), cvtpk(xa1[10], xa1[11]), cvtpk(xa1[12], xa1[13]), cvtpk(xa1[14], xa1[15])}; }
        }
        ATT_WAIT_BAR(0);
        { const int sl_ = (NT - 1) % 3; const lds_cptr vp_ = vp0 + sl_ * KSLOT;
#pragma unroll
          for (int d0 = 0; d0 < DV32; ++d0) {
              VRD(vl0, vh0, d0 * 4); VRD(vl1, vh1, d0 * 4 + 1); VRD(vl2, vh2, d0 * 4 + 2); VRD(vl3, vh3, d0 * 4 + 3);
              o[d0] = MF(__builtin_bit_cast(bf16x8, pw0), VFR(vl0, vh0), o[d0]); o[d0] = MF(__builtin_bit_cast(bf16x8, pw1), VFR(vl1, vh1), o[d0]);
              o[d0] = MF(__builtin_bit_cast(bf16x8, pw2), VFR(vl2, vh2), o[d0]); o[d0] = MF(__builtin_bit_cast(bf16x8, pw3), VFR(vl3, vh3), o[d0]); } }
    }
#undef TILE_OF
#undef DMA_K
#undef DMA_V
#undef KRD
#undef VRD
#undef VFR
#undef SET_NEXT
#undef CINIT
#undef GA
#undef PHASE_A
#undef QK_ONLY
#undef DECIDE
#undef RESCALE_O
#undef EXP2
#undef GB
#undef PHASE_B
#undef STEP
#undef ROT3
#undef ROT4
#undef KRN
    l = swap_sum(l);
    const float rl = 1.f / l;
    LAS float* cb = (LAS float*)shm + qs * 4096;
    ATT_WAIT_BAR(0);
    if (VAR & 1024) { if (lane == 0 && rl == 12345.f) O[0] = 0; return; }
    if (cmap == 1) {
#pragma unroll
        for (int r = 0; r < 16; ++r) { const int row = CRI(r) + 4 * hi; const float rr = __shfl(rl, row) * dc.lam_full;
#pragma unroll
            for (int d0 = 0; d0 < DV32; ++d0) cb[row * 128 + d0 * 32 + r32] = o[d0][r] * rr; }
    }
    ATT_WAIT_BAR(0);
    if (cmap == 0) {
        bf16_t* Ow = O + (size_t)(b * SEQ + iw) * D + hh * 128 + r32;
        float gsub[DV32];
#pragma unroll
        for (int d0 = 0; d0 < DV32; ++d0) gsub[d0] = dc.subln[d0 * 32 + r32] * (1.f - LAMBDA_INIT);
#pragma unroll
        for (int r = 0; r < 16; ++r) { const int row = CRI(r) + 4 * hi; const float rr = __shfl(rl, row);
            float v[DV32]; float ss = 0.f;
#pragma unroll
            for (int d0 = 0; d0 < DV32; ++d0) { v[d0] = o[d0][r] * rr - cb[row * 128 + d0 * 32 + r32]; ss += v[d0] * v[d0]; }
            ss += __shfl_xor(ss, 1); ss += __shfl_xor(ss, 2); ss += __shfl_xor(ss, 4); ss += __shfl_xor(ss, 8); ss += __shfl_xor(ss, 16);
            const float sc = __builtin_amdgcn_rsqf(ss * (1.f / 128.f) + 1e-5f);
#pragma unroll
            for (int d0 = 0; d0 < DV32; ++d0) Ow[(size_t)row * D + d0 * 32] = (bf16_t)f2bf(v[d0] * sc * gsub[d0]); }
    }
    asm volatile("s_waitcnt lgkmcnt(0)\n\ts_barrier" ::: "memory");
}
#undef SBAR
#undef PIN
#undef MF
#undef ATT_WAIT_BAR
}

typedef GAS unsigned gu32;
#define RLX_AGENT __ATOMIC_RELAXED, __HIP_MEMORY_SCOPE_AGENT
#define LDS_WAIT() asm volatile("s_waitcnt lgkmcnt(0)" ::: "memory")
#define VM_WAIT() asm volatile("s_waitcnt vmcnt(0)" ::: "memory")
#define XB_TMO      128
#define XB_XCNT(j)  (256  + 64 * (j))
#define XB_XSUB(j)  (1280 + 64 * (j))
#define XB_XGEN(j)  (2304 + 64 * (j))
#define XB_TOP      3328
#define XB_TOPGEN   3392
#define XCD_BAR_WORDS 3456
#define XB_SPIN_CAP (1u << 18)
__device__ __forceinline__ unsigned xb_ld(unsigned* p)              { return __hip_atomic_load(p, __ATOMIC_RELAXED, __HIP_MEMORY_SCOPE_AGENT); }
__device__ __forceinline__ unsigned xb_add(unsigned* p, unsigned v) { return __hip_atomic_fetch_add(p, v, __ATOMIC_RELAXED, __HIP_MEMORY_SCOPE_AGENT); }
__device__ __forceinline__ unsigned xb_xcc_id() { return (unsigned)__builtin_amdgcn_s_getreg((3 << 11) | 20) & 0xFu; }
#define XB_SPIN(cond, bar) do { unsigned _sp = 0; while (cond) { __builtin_amdgcn_s_sleep(1); \
    if ((++_sp & 255u) == 0u) { if (xb_ld(&(bar)[XB_TMO])) break; if (_sp > XB_SPIN_CAP) { atomicAdd(&(bar)[XB_TMO], 1u); break; } } } } while (0)
struct XcdBarrier { unsigned* bar; unsigned x; volatile LAS unsigned* st; };
__device__ __forceinline__ XcdBarrier xcd_barrier_post(unsigned* bar, volatile LAS unsigned* st, const bool leader) {
    XcdBarrier b; b.bar = bar; b.x = xb_xcc_id(); b.st = st;
    if (leader) (void)xb_add(&bar[XB_XCNT(b.x)], 1u);
    return b;
}
__device__ __forceinline__ void xcd_barrier_complete(unsigned* bar, unsigned x, unsigned& nloc, unsigned& nx) {
    const unsigned G = gridDim.x * gridDim.y * gridDim.z;
    unsigned sum, cnt, mine, sp = 0u;
    for (;;) {
        sum = 0u; cnt = 0u; mine = 0u;
#pragma unroll
        for (unsigned j = 0; j < 16; ++j) { const unsigned c = xb_ld(&bar[XB_XCNT(j)]); sum += c; cnt += (c > 0u) ? 1u : 0u; mine = (j == x) ? c : mine; }
        if (sum == G) break;
        __builtin_amdgcn_s_sleep(1);
        if ((++sp & 255u) == 0u) { if (xb_ld(&bar[XB_TMO])) break; if (sp > XB_SPIN_CAP) { atomicAdd(&bar[XB_TMO], 1u); break; } }
    }
    nloc = mine > 0u ? mine : 1u; nx = cnt > 0u ? cnt : 1u;
}
__device__ __forceinline__ void xcd_barrier(const XcdBarrier& b, const bool leader) {
    asm volatile("s_waitcnt vmcnt(0)" ::: "memory");
    __syncthreads();
    if (leader) {
        unsigned* bar = b.bar;
        __builtin_amdgcn_s_waitcnt(0);
        unsigned nloc = b.st[0], nx = b.st[1];
        if (nloc == 0u) { xcd_barrier_complete(bar, b.x, nloc, nx); b.st[0] = nloc; b.st[1] = nx; }
        const unsigned old = xb_add(&bar[XB_XSUB(b.x)], 1u);
        const unsigned gen = old / nloc;
        if (old + 1u == (gen + 1u) * nloc) {
            __builtin_amdgcn_fence(__ATOMIC_RELEASE, "agent");
            asm volatile("s_waitcnt vmcnt(0)" ::: "memory");
            const unsigned og = xb_add(&bar[XB_TOP], 1u);
            const unsigned tg = og / nx;
            if (og + 1u == (tg + 1u) * nx) xb_add(&bar[XB_TOPGEN], 1u);
            else XB_SPIN(xb_ld(&bar[XB_TOPGEN]) == tg, bar);
            __builtin_amdgcn_fence(__ATOMIC_ACQUIRE, "agent");
            xb_add(&bar[XB_XGEN(b.x)], 1u);
            asm volatile("s_waitcnt vmcnt(0)" ::: "memory");
        } else {
            XB_SPIN(xb_ld(&bar[XB_XGEN(b.x)]) == gen, bar);
            __builtin_amdgcn_fence(__ATOMIC_ACQUIRE, "agent");
            asm volatile("s_waitcnt vmcnt(0)" ::: "memory");
        }
    }
    __syncthreads();
}

struct Args { const float* in[18]; float* out; unsigned char* ws; int ph_lo, ph_hi, use_cg, pad; };
enum { I_X = 0, I_NMIX, I_NFFN, I_SWA_QKV, I_SWA_WO, I_SWA_SINK, I_DIFF_QKV, I_DIFF_WO, I_DIFF_LAM, I_DIFF_SUBLN, I_WG, I_BG, I_WR, I_BR, I_GATE, I_UP, I_DOWN, I_FNORM };
typedef const __attribute__((address_space(4))) Args* CArgs;
__device__ __forceinline__ CArgs kargs() { CArgs p = (CArgs)__builtin_amdgcn_kernarg_segment_ptr(); asm volatile("" : "+s"(p)); return p; }
__device__ __forceinline__ int vcu_of(int G) { const int bx = blockIdx.x; return (G % 8 == 0) ? (bx % 8) * (G / 8) + bx / 8 : bx; }

__device__ __forceinline__ void tr_item(const float* W, int N, int k0, int n0, bf16_t* dst, int ldd, LAS float* scr, int lane) {
    f32x4 v[8];
#pragma unroll
    for (int i = 0; i < 8; ++i) v[i] = *(const f32x4*)(W + (size_t)(k0 + 8 * i + (lane >> 3)) * N + n0 + (lane & 7) * 4);
#pragma unroll
    for (int i = 0; i < 8; ++i) { LAS float* p = scr + (8 * i + (lane >> 3)) * 33 + (lane & 7) * 4; p[0] = v[i].x; p[1] = v[i].y; p[2] = v[i].z; p[3] = v[i].w; }
    LDS_WAIT(); asm volatile("" ::: "memory");
    const int c = lane & 7;
#pragma unroll
    for (int j = 0; j < 4; ++j) { const int n = (lane >> 3) + 8 * j; const LAS float* s = scr + (8 * c) * 33 + n;
        u32x4 o; o.x = pk2(s[0 * 33], s[1 * 33]); o.y = pk2(s[2 * 33], s[3 * 33]); o.z = pk2(s[4 * 33], s[5 * 33]); o.w = pk2(s[6 * 33], s[7 * 33]);
        *(GAS u32x4*)(dst + (size_t)n * ldd + k0 + 8 * c) = o; }
    LDS_WAIT(); asm volatile("" ::: "memory");
}
__device__ __forceinline__ void rms_row_to_bf16(const float* xrow, const float* g, bf16_t* orow, int lane) {
    const GAS f32x4* xr = (const GAS f32x4*)xrow + lane; const GAS f32x4* gr = (const GAS f32x4*)g + lane;
    f32x4 v[4]; float s = 0.f;
#pragma unroll
    for (int j = 0; j < 4; ++j) { v[j] = xr[64 * j]; s += (v[j].x * v[j].x + v[j].y * v[j].y) + (v[j].z * v[j].z + v[j].w * v[j].w); }
    const float rstd = 1.f / sqrtf(wave_sum(s) * (1.f / D) + 1e-6f);
    GAS u32x2* o8 = (GAS u32x2*)orow + lane;
#pragma unroll
    for (int j = 0; j < 4; ++j) { const f32x4 gg = gr[64 * j]; u32x2 w; w.x = pk2(v[j].x * rstd * gg.x, v[j].y * rstd * gg.y); w.y = pk2(v[j].z * rstd * gg.z, v[j].w * rstd * gg.w); o8[64 * j] = w; }
}

__device__ __forceinline__ void phase_prologue(LAS unsigned char* lds_in, const int wave_in) {
    int lane = lane_id(); asm volatile("" : "+v"(lane)); int wave = wave_in; asm volatile("" : "+s"(wave)); LAS unsigned char* lds = lds_in; asm volatile("" : "+s"(lds));
    const CArgs a = kargs(); unsigned char* ws = a->ws;
    const int G = gridDim.x, vcu = vcu_of(G);
    LAS float* scr = (LAS float*)(lds + wave * 16384);
    const int gw = vcu * NWAVES + wave, NGW = G * NWAVES;
    bf16_t* swa_qkv_t = (bf16_t*)(ws + WS_SWA_QKV_T); bf16_t* swa_wo_t = (bf16_t*)(ws + WS_SWA_WO_T);
    bf16_t* diff_qkv_t = (bf16_t*)(ws + WS_DIFF_QKV_T); bf16_t* diff_wo_t = (bf16_t*)(ws + WS_DIFF_WO_T);
    constexpr int I0 = 16 * 48, I1 = 16 * 32, I2 = 16 * 96, I3 = 16 * 32, IM = 64 * 768, NITEMS = I0 + I1 + I2 + I3 + IM;
    struct TrItem { const float* src; int N; unsigned char* dstb; int ldb; int f8; };
    auto decode = [&](int it) -> TrItem {
        int r = it; const float* W; int N, k0, n0, ldd; bf16_t* dst; bf16_t* mbase = nullptr; int f8 = 0;
        if (r < I0) { const int kb = r / 48, nb = r % 48; W = a->in[I_SWA_QKV]; N = SWA_N; k0 = 64 * kb; n0 = 32 * nb; dst = swa_qkv_t + (size_t)n0 * D; ldd = D; }
        else if ((r -= I0) < I1) { const int kb = r / 32, nb = r % 32; W = a->in[I_SWA_WO]; N = D; k0 = 64 * kb; n0 = 32 * nb; dst = swa_wo_t + (size_t)n0 * D; ldd = D; }
        else if ((r -= I1) < I2) { const int kb = r / 96, nb = r % 96; W = a->in[I_DIFF_QKV]; N = DIFF_N; k0 = 64 * kb; n0 = 32 * nb; dst = diff_qkv_t + (size_t)n0 * D; ldd = D; }
        else if ((r -= I2) < I3) { const int kb = r / 32, nb = r % 32; W = a->in[I_DIFF_WO]; N = D; k0 = 64 * kb; n0 = 32 * nb; dst = diff_wo_t + (size_t)n0 * D; ldd = D; }
        else { r -= I3; const int le = r / 768, q = r % 768;
            bf16_t* gu = (bf16_t*)(ws + WS_WMOE + (size_t)le * 3 * MiB); bf16_t* dn = gu + (size_t)D * D;
            const bool l1 = le >= 32 || F8_L0;
            if (q < 256) { const int kb = q / 16, c0 = 32 * (q % 16); W = a->in[I_GATE] + (size_t)le * D * DEXP; N = DEXP; k0 = 64 * kb; n0 = c0; dst = gu + (size_t)((c0 >> 7) * 256 + (c0 & 127)) * D; ldd = D; mbase = gu; f8 = ((F8_STAGE & 2) && l1); }
            else if (q < 512) { const int qq = q - 256; const int kb = qq / 16, c0 = 32 * (qq % 16); W = a->in[I_UP] + (size_t)le * D * DEXP; N = DEXP; k0 = 64 * kb; n0 = c0; dst = gu + (size_t)((c0 >> 7) * 256 + 128 + (c0 & 127)) * D; ldd = D; mbase = gu; f8 = ((F8_STAGE & 2) && l1); }
            else { const int qq = q - 512; const int kb = qq / 32, nb = qq % 32; W = a->in[I_DOWN] + (size_t)le * DEXP * D; N = D; k0 = 64 * kb; n0 = 32 * nb; dst = dn + (size_t)n0 * DEXP; ldd = DEXP; mbase = dn; f8 = ((F8_STAGE & 1) && l1); } }
        TrItem t; t.src = W + (size_t)(k0 + (lane >> 3)) * N + n0 + (lane & 7) * 4; t.N = N; t.f8 = f8;
        t.dstb = f8 ? (unsigned char*)mbase + (size_t)(dst - mbase) + k0 + 8 * (lane & 7) : (unsigned char*)(dst + k0 + 8 * (lane & 7)); t.ldb = f8 ? ldd : 2 * ldd; return t;
    };
    {
        f32x4 va[8], vb[8]; TrItem ca, cb;
#define TR_LOAD(v, t) do { _Pragma("unroll") for (int i = 0; i < 8; ++i) v[i] = *(const f32x4*)((t).src + (size_t)(8 * i) * (t).N); } while (0)
#define TR_FINISH(v, t) do { \
            _Pragma("unroll") for (int i = 0; i < 8; ++i) { LAS float* p = scr + (8 * i + (lane >> 3)) * 33 + (lane & 7) * 4; p[0] = v[i].x; p[1] = v[i].y; p[2] = v[i].z; p[3] = v[i].w; } \
            LDS_WAIT(); asm volatile("" ::: "memory"); \
            if ((t).f8) { _Pragma("unroll") for (int j = 0; j < 4; ++j) { const int n = (lane >> 3) + 8 * j; const LAS float* s = scr + (8 * (lane & 7)) * 33 + n; \
                u32x2 o8; o8.x = pk4_fp8(64.f * s[0 * 33], 64.f * s[1 * 33], 64.f * s[2 * 33], 64.f * s[3 * 33]); o8.y = pk4_fp8(64.f * s[4 * 33], 64.f * s[5 * 33], 64.f * s[6 * 33], 64.f * s[7 * 33]); \
                *(GAS u32x2*)((t).dstb + (size_t)n * (t).ldb) = o8; } } \
            else { _Pragma("unroll") for (int j = 0; j < 4; ++j) { const int n = (lane >> 3) + 8 * j; const LAS float* s = scr + (8 * (lane & 7)) * 33 + n; \
                u32x4 o; o.x = pk2(s[0 * 33], s[1 * 33]); o.y = pk2(s[2 * 33], s[3 * 33]); o.z = pk2(s[4 * 33], s[5 * 33]); o.w = pk2(s[6 * 33], s[7 * 33]); \
                *(GAS u32x4*)((t).dstb + (size_t)n * (t).ldb) = o; } } \
            LDS_WAIT(); asm volatile("" ::: "memory"); } while (0)
        const int n_my = gw < NITEMS ? (NITEMS - gw + NGW - 1) / NGW : 0;
        if (n_my > 0) { ca = decode(gw); TR_LOAD(va, ca); }
#pragma unroll 1
        for (int j = 0; j < n_my; j += 2) {
            const int j1 = j + 1 < n_my ? j + 1 : n_my - 1, j2 = j + 2 < n_my ? j + 2 : n_my - 1;
            cb = decode(gw + j1 * NGW); TR_LOAD(vb, cb);
            TR_FINISH(va, ca);
            ca = decode(gw + j2 * NGW); TR_LOAD(va, ca);
            if (j + 1 < n_my) { TR_FINISH(vb, cb); }
        }
#undef TR_LOAD
#undef TR_FINISH
    }
    { bf16_t* wr_t = (bf16_t*)(ws + WS_WR); const int gt = gw * 64 + lane, NGT = NGW * 64;
      for (int i = gt; i < 2 * 36 * D; i += NGT) { const int l = i / (36 * D), rem = i % (36 * D), c = rem / D, k = rem % D;
          const float w = c < 4 ? a->in[I_WG][(size_t)l * D * 4 + k * 4 + c] : a->in[I_WR][(size_t)l * D * 32 + k * 32 + (c - 4)];
          const unsigned h = f2bf(w); const float r = w - __uint_as_float(h << 16);
          wr_t[(size_t)l * 2 * 36 * D + rem] = (bf16_t)h; wr_t[(size_t)l * 2 * 36 * D + 36 * D + rem] = (bf16_t)f2bf(r); } }
    bf16_t* XN = (bf16_t*)(ws + WS_XN);
#pragma unroll 1
    for (int mb = gw * 4; mb < M; mb += NGW * 4) {
        const float* xb = a->in[I_X] + (size_t)mb * D; const GAS f32x4* gr = (const GAS f32x4*)a->in[I_NMIX] + lane;
        f32x4 v[4][4];
#pragma unroll
        for (int r = 0; r < 4; ++r)
#pragma unroll
            for (int j = 0; j < 4; ++j) v[r][j] = ((const GAS f32x4*)(xb + (size_t)r * D) + lane)[64 * j];
        f32x4 gg[4];
#pragma unroll
        for (int j = 0; j < 4; ++j) gg[j] = gr[64 * j];
#pragma unroll
        for (int r = 0; r < 4; ++r) { float s = 0.f;
#pragma unroll
            for (int j = 0; j < 4; ++j) s += (v[r][j].x * v[r][j].x + v[r][j].y * v[r][j].y) + (v[r][j].z * v[r][j].z + v[r][j].w * v[r][j].w);
            const float rstd = 1.f / sqrtf(wave_sum(s) * (1.f / D) + 1e-6f);
            GAS u32x2* o8 = (GAS u32x2*)(XN + (size_t)(mb + r) * D) + lane;
#pragma unroll
            for (int j = 0; j < 4; ++j) { const f32x4 n = v[r][j] * rstd * gg[j]; u32x2 w; w.x = pk2(n.x, n.y); w.y = pk2(n.z, n.w); o8[64 * j] = w; } }
    }
}

template <int RV, bool F8OUT>
__device__ __forceinline__ void phase_router(LAS unsigned char* lds_in, int layer, const int wave_in, const bool dry) {
    int lane = lane_id(); asm volatile("" : "+v"(lane)); int wave = wave_in; asm volatile("" : "+s"(wave)); LAS unsigned char* lds = lds_in; asm volatile("" : "+s"(lds));
    const CArgs a = kargs(); unsigned char* ws = a->ws;
    const int G = gridDim.x, vcu = vcu_of(G);
    const int gw = vcu * NWAVES + wave, NGW = G * NWAVES;
    const float* g = a->in[I_NFFN] + layer * D;
    const bf16_t* wth = (const bf16_t*)(ws + WS_WR) + (size_t)layer * 2 * 36 * D; const bf16_t* wtl = wth + 36 * D;
    const float* bg = a->in[I_BG] + layer * 4; const float* br = a->in[I_BR] + layer * 32;
    bf16_t* XN = (bf16_t*)(ws + (dry ? WS_SCR : WS_XN)); const float* xin = a->out; float* rstd_tok = (float*)(ws + (dry ? WS_SCR + 80 * MiB : WS_RSTD));
    unsigned* cnt = (unsigned*)(ws + WS_CTL) + CW_CNT + (dry ? 2 : layer) * 1024;
    int* ltok = (int*)(ws + (dry ? WS_SCR + 64 * MiB : WS_LTOK)); float* lw = (float*)(ws + (dry ? WS_SCR + 68 * MiB : WS_LW)); i32x4* tinfo = (i32x4*)(ws + (dry ? WS_SCR + 72 * MiB : WS_TINFO));
    LAS float* lgs = (LAS float*)(lds + 98304 + wave * 4096);
    LAS float* rsl = lgs + 768;
    const int row = lane & 15, kg = lane >> 4;
    const bool c2ok = row < 4;
    LAS unsigned* lcnt = (LAS unsigned*)(lds + TP_OFF); LAS unsigned* lbase = lcnt + 32;
    const int tid = wave * 64 + lane;
#pragma unroll 1
    for (int bt0 = 0; bt0 < M / 16; bt0 += NGW) {
        const int bt = bt0 + gw; const bool live = bt < M / 16;
        const int t0 = (live ? bt : 0) * 16;
        if (tid < 32) lcnt[tid] = 0u;
        const char* xrow = (const char*)(xin + (size_t)(t0 + row) * D) + kg * 32;
        const char* grow = (const char*)g + kg * 32;
        char* orow = (char*)(XN + (size_t)(t0 + row) * D) + kg * 16;
        const char* w0 = (const char*)(wth + (size_t)row * D) + kg * 16;
        f32x4 acc0 = {0.f, 0.f, 0.f, 0.f}, acc1 = acc0, acc2 = acc0; float ss = 0.f;
        const unsigned m2 = c2ok ? 0xffffffffu : 0u;
        {
            f32x4 xa[3] = {}, xb[3] = {}, ga[3] = {}, gb[3] = {};
            const char* xbase = (const char*)(xin + (size_t)t0 * D); const unsigned xoff = (unsigned)(row * D * 4 + kg * 32);
            const char* gbase = (const char*)g; const unsigned goff = (unsigned)(kg * 32);
            const char* wb0h = (const char*)wth; const char* wb0l = wb0h + 36 * D * 2; const char* wb1h = wb0h + 16 * D * 2; const char* wb1l = wb0h + 52 * D * 2;
            char* obase = live ? (char*)XN + (size_t)t0 * D * (F8OUT ? 1 : 2) : (char*)(ws + WS_SCR + 100 * MiB); const unsigned ooff = F8OUT ? (unsigned)(row * D + kg * 8) : (unsigned)(row * D * 2 + kg * 16);
            const unsigned woff = (unsigned)((row * D + kg * 8) * 2) + (unsigned)wave * 64u, woff2 = (unsigned)(((32 + (row & 3)) * D + kg * 8) * 2) + (unsigned)wave * 64u;
            LAS unsigned char* bfill = lds + wave * 6144 + lane * 16;
            const LAS unsigned char* bread = lds + lane * 16;
            u32x4 fr0, fr1, fr2, fr3, fr4, fr5;
#define RT_BLOAD(c) do { fr0 = *(const u32x4*)(wb0h + woff + (c) * 512); fr1 = *(const u32x4*)(wb0l + woff + (c) * 512); fr2 = *(const u32x4*)(wb1h + woff + (c) * 512); \
            fr3 = *(const u32x4*)(wb1l + woff + (c) * 512); fr4 = *(const u32x4*)(wb0h + woff2 + (c) * 512); fr5 = *(const u32x4*)(wb0l + woff2 + (c) * 512); } while (0)
#define RT_BWRITE(buf) do { fr4.x &= m2; fr4.y &= m2; fr4.z &= m2; fr4.w &= m2; fr5.x &= m2; fr5.y &= m2; fr5.z &= m2; fr5.w &= m2; \
            *(LAS u32x4*)(bfill + (buf) * 49152) = fr0; *(LAS u32x4*)(bfill + (buf) * 49152 + 1024) = fr1; *(LAS u32x4*)(bfill + (buf) * 49152 + 2048) = fr2; \
            *(LAS u32x4*)(bfill + (buf) * 49152 + 3072) = fr3; *(LAS u32x4*)(bfill + (buf) * 49152 + 4096) = fr4; *(LAS u32x4*)(bfill + (buf) * 49152 + 5120) = fr5; } while (0)
#define RT_BAR() asm volatile("s_waitcnt lgkmcnt(0)\n\ts_barrier" ::: "memory")
#define RT_LOAD(st, s) do { if (!(RV & 2)) { xa[st] = *(const f32x4*)(xbase + xoff + (s) * 128); xb[st] = *(const f32x4*)(xbase + xoff + (s) * 128 + 16); } \
            ga[st] = *(const f32x4*)(gbase + goff + (s) * 128); gb[st] = *(const f32x4*)(gbase + goff + (s) * 128 + 16); } while (0)
            RT_BLOAD(0); RT_LOAD(0, 0); RT_LOAD(1, 1);
            RT_BWRITE(0); RT_BLOAD(1);
            RT_BAR();
#pragma unroll
            for (int s = 0; s < 32; ++s) {
                const int st = s % 3, c = s >> 3, sl = s & 7;
                if (sl == 0 && c + 1 < 4) { RT_BWRITE((c + 1) & 1); if (c + 2 < 4) { RT_BLOAD(c + 2); } }
                if (s + 2 < 32) { RT_LOAD((s + 2) % 3, s + 2); }
                __builtin_amdgcn_sched_barrier(0);
                const LAS unsigned char* bp = bread + (c & 1) * 49152 + sl * 6144;
                const bf16x8 b0h = *(const LAS bf16x8*)(bp), b0l = *(const LAS bf16x8*)(bp + 1024), b1h = *(const LAS bf16x8*)(bp + 2048), b1l = *(const LAS bf16x8*)(bp + 3072),
                             b2h = *(const LAS bf16x8*)(bp + 4096), b2l = *(const LAS bf16x8*)(bp + 5120);
                const f32x4 xa_ = xa[st], xb_ = xb[st];
                ss += (xa_.x * xa_.x + xa_.y * xa_.y) + (xa_.z * xa_.z + xa_.w * xa_.w) + (xb_.x * xb_.x + xb_.y * xb_.y) + (xb_.z * xb_.z + xb_.w * xb_.w);
                const f32x4 ya = xa_ * ga[st], yb = xb_ * gb[st];
                u32x4 hi; hi.x = cvtpk(ya.x, ya.y); hi.y = cvtpk(ya.z, ya.w); hi.z = cvtpk(yb.x, yb.y); hi.w = cvtpk(yb.z, yb.w);
                u32x4 lo; lo.x = cvtpk(ya.x - __uint_as_float(hi.x << 16), ya.y - __uint_as_float(hi.x & 0xffff0000u)); lo.y = cvtpk(ya.z - __uint_as_float(hi.y << 16), ya.w - __uint_as_float(hi.y & 0xffff0000u));
                lo.z = cvtpk(yb.x - __uint_as_float(hi.z << 16), yb.y - __uint_as_float(hi.z & 0xffff0000u)); lo.w = cvtpk(yb.z - __uint_as_float(hi.w << 16), yb.w - __uint_as_float(hi.w & 0xffff0000u));
                if constexpr (F8OUT) { u32x2 q8; q8.x = pk4_fp8(4.f * ya.x, 4.f * ya.y, 4.f * ya.z, 4.f * ya.w); q8.y = pk4_fp8(4.f * yb.x, 4.f * yb.y, 4.f * yb.z, 4.f * yb.w); *(u32x2*)(obase + ooff + s * 32) = q8; }
                else if (!(RV & 1)) *(u32x4*)(obase + ooff + s * 64) = hi;
                const bf16x8 ah = __builtin_bit_cast(bf16x8, hi), al = __builtin_bit_cast(bf16x8, lo);
                acc0 = __builtin_amdgcn_mfma_f32_16x16x32_bf16(ah, b0h, acc0, 0, 0, 0); acc0 = __builtin_amdgcn_mfma_f32_16x16x32_bf16(ah, b0l, acc0, 0, 0, 0); acc0 = __builtin_amdgcn_mfma_f32_16x16x32_bf16(al, b0h, acc0, 0, 0, 0);
                acc1 = __builtin_amdgcn_mfma_f32_16x16x32_bf16(ah, b1h, acc1, 0, 0, 0); acc1 = __builtin_amdgcn_mfma_f32_16x16x32_bf16(ah, b1l, acc1, 0, 0, 0); acc1 = __builtin_amdgcn_mfma_f32_16x16x32_bf16(al, b1h, acc1, 0, 0, 0);
                acc2 = __builtin_amdgcn_mfma_f32_16x16x32_bf16(ah, b2h, acc2, 0, 0, 0); acc2 = __builtin_amdgcn_mfma_f32_16x16x32_bf16(ah, b2l, acc2, 0, 0, 0); acc2 = __builtin_amdgcn_mfma_f32_16x16x32_bf16(al, b2h, acc2, 0, 0, 0);
                __builtin_amdgcn_sched_barrier(0);
                if (sl == 7 && c + 1 < 4) { RT_BAR(); }
            }
            RT_BAR();
#undef RT_LOAD
#undef RT_BLOAD
#undef RT_BWRITE
#undef RT_BAR
        }
        ss += __shfl_xor(ss, 16); ss += __shfl_xor(ss, 32);
        const float rstd = 1.f / sqrtf(ss * (1.f / D) + 1e-6f);
        if (kg == 0) { rsl[row] = rstd; if (live) rstd_tok[t0 + row] = rstd; }
#pragma unroll
        for (int j = 0; j < 4; ++j) { lgs[(4 * kg + j) * 48 + row] = acc0[j]; lgs[(4 * kg + j) * 48 + 16 + row] = acc1[j]; lgs[(4 * kg + j) * 48 + 32 + row] = acc2[j]; }
        LDS_WAIT(); asm volatile("" ::: "memory");
        int e1 = 0, e2 = 0, lp1 = 0, lp2 = 0; float w1 = 0.f, w2 = 0.f;
        const bool act = live && lane < 16 && !(RV & 4);
        __syncthreads();
        if (act) {
            const float rs = rsl[lane];
            float acc[36];
#pragma unroll
            for (int q = 0; q < 9; ++q) { const f32x4 x = *(const LAS f32x4*)(lgs + lane * 48 + 4 * q); acc[4 * q] = x.x * rs; acc[4 * q + 1] = x.y * rs; acc[4 * q + 2] = x.z * rs; acc[4 * q + 3] = x.w * rs; }
            float lgv[4]; int gs = 0;
#pragma unroll
            for (int c = 0; c < 4; ++c) lgv[c] = acc[c] + bg[c];
            float mx = lgv[0];
#pragma unroll
            for (int c = 1; c < 4; ++c) if (lgv[c] > mx) { mx = lgv[c]; gs = c; }
            float den = 0.f;
#pragma unroll
            for (int c = 0; c < 4; ++c) den += __expf(lgv[c] - mx);
            const float pg = 1.f / den;
            float le[8];
#pragma unroll
            for (int k = 0; k < 8; ++k) { const float a0 = acc[4 + k] + br[k], a1 = acc[12 + k] + br[8 + k], a2 = acc[20 + k] + br[16 + k], a3 = acc[28 + k] + br[24 + k];
                le[k] = gs == 0 ? a0 : (gs == 1 ? a1 : (gs == 2 ? a2 : a3)); }
            int i1 = 0; float m1 = le[0];
#pragma unroll
            for (int k = 1; k < 8; ++k) if (le[k] > m1) { m1 = le[k]; i1 = k; }
            int i2 = -1; float m2 = -INFINITY;
#pragma unroll
            for (int k = 0; k < 8; ++k) if (k != i1 && (i2 < 0 || le[k] > m2)) { m2 = le[k]; i2 = k; }
            const float ex = __expf(m2 - m1); const float tp1 = 1.f / (1.f + ex), tp2 = ex * tp1;
            w1 = pg * tp1; w2 = pg * tp2; e1 = gs * 8 + i1; e2 = gs * 8 + i2;
            lp1 = (int)__hip_atomic_fetch_add(lcnt + e1, 1u, __ATOMIC_RELAXED, __HIP_MEMORY_SCOPE_WORKGROUP);
            lp2 = (int)__hip_atomic_fetch_add(lcnt + e2, 1u, __ATOMIC_RELAXED, __HIP_MEMORY_SCOPE_WORKGROUP);
        }
        __syncthreads();
        if (tid < 32) { const unsigned c = lcnt[tid]; lbase[tid] = c ? __hip_atomic_fetch_add(cnt + 32 * tid, c, __ATOMIC_RELAXED, __HIP_MEMORY_SCOPE_AGENT) : 0u; }
        __syncthreads();
        if (act) {
            const int t = t0 + lane; const int p1 = (int)lbase[e1] + lp1, p2 = (int)lbase[e2] + lp2;
            ltok[(size_t)e1 * M + p1] = t; lw[(size_t)e1 * M + p1] = w1; ltok[(size_t)e2 * M + p2] = t; lw[(size_t)e2 * M + p2] = w2;
            tinfo[t] = (i32x4){e1, p1, e2, p2};
        }
        LDS_WAIT(); asm volatile("" ::: "memory");
        __syncthreads();
    }
}

__device__ __forceinline__ void moe_tables(LAS unsigned char* lds, unsigned char* ws, int layer, const int wave, const int lane) {
    LAS int* TP = (LAS int*)(lds + TP_OFF); LAS int* CNT = TP + 40;
    unsigned* cnt = (unsigned*)(ws + WS_CTL) + CW_CNT + layer * 1024;
    const int tid = wave * 64 + lane;
    __syncthreads();
    if (tid < 32) CNT[tid] = (int)__hip_atomic_load(cnt + 32 * tid, RLX_AGENT);
    __syncthreads();
    if (tid == 0) { int s = 0; for (int e = 0; e < 32; ++e) { TP[e] = s; s += (CNT[e] + 255) >> 8; } TP[32] = s; }
    __syncthreads();
}

__device__ __forceinline__ void phase_combine(LAS unsigned char* lds_in, int layer, const int wave_in, const bool dry) {
    int lane = lane_id(); asm volatile("" : "+v"(lane)); int wave = wave_in; asm volatile("" : "+s"(wave)); LAS unsigned char* lds = lds_in; asm volatile("" : "+s"(lds));
    const CArgs a = kargs(); unsigned char* ws = a->ws;
    moe_tables(lds, ws, layer, wave, lane);
    const bool final_ = layer == 1; const float* gnext = layer == 0 ? a->in[I_NMIX] + D : a->in[I_FNORM]; float* xio = a->out;
    const int G = gridDim.x, vcu = vcu_of(G);
    const int gw = vcu * NWAVES + wave, NGW = G * NWAVES;
    const LAS int* TP = (const LAS int*)(lds + TP_OFF);
    const bf16_t* Y = (const bf16_t*)(ws + WS_Y); const i32x4* tinfo = (const i32x4*)(ws + WS_TINFO); bf16_t* XN = (bf16_t*)(ws + WS_XN);
#pragma unroll 1
    for (int tb = gw * 4; tb < M; tb += NGW * 4) {
        size_t s1[4], s2[4];
#pragma unroll
        for (int r = 0; r < 4; ++r) { const i32x4 ti = tinfo[tb + r]; s1[r] = (size_t)TP[ti.x] * 256 + ti.y; s2[r] = (size_t)TP[ti.z] * 256 + ti.w; }
        f32x4 v[4][4]; u32x2 p[4][4], q[4][4];
#pragma unroll
        for (int r = 0; r < 4; ++r) {
            const GAS f32x4* xr = (const GAS f32x4*)(xio + (size_t)(tb + r) * D) + lane;
            const GAS u32x2* y1 = (const GAS u32x2*)(Y + s1[r] * D) + lane; const GAS u32x2* y2 = (const GAS u32x2*)(Y + s2[r] * D) + lane;
#pragma unroll
            for (int j = 0; j < 4; ++j) { v[r][j] = xr[64 * j]; p[r][j] = y1[64 * j]; q[r][j] = y2[64 * j]; }
        }
        f32x4 gg[4];
#pragma unroll
        for (int j = 0; j < 4; ++j) gg[j] = ((const GAS f32x4*)gnext + lane)[64 * j];
#pragma unroll
        for (int r = 0; r < 4; ++r) {
            float s = 0.f;
#pragma unroll
            for (int j = 0; j < 4; ++j) { const u32x2 pp = p[r][j], qq = q[r][j];
                f32x4 ya, yb; ya.x = __uint_as_float(pp.x << 16); ya.y = __uint_as_float(pp.x & 0xffff0000u); ya.z = __uint_as_float(pp.y << 16); ya.w = __uint_as_float(pp.y & 0xffff0000u);
                yb.x = __uint_as_float(qq.x << 16); yb.y = __uint_as_float(qq.x & 0xffff0000u); yb.z = __uint_as_float(qq.y << 16); yb.w = __uint_as_float(qq.y & 0xffff0000u);
                v[r][j] = v[r][j] + (ya + yb); s += (v[r][j].x * v[r][j].x + v[r][j].y * v[r][j].y) + (v[r][j].z * v[r][j].z + v[r][j].w * v[r][j].w); }
            const float rstd = 1.f / sqrtf(wave_sum(s) * (1.f / D) + 1e-6f);
            GAS f32x4* xw = (GAS f32x4*)(xio + (size_t)(tb + r) * D) + lane;
            if (final_) {
#pragma unroll
                for (int j = 0; j < 4; ++j) if (!dry) xw[64 * j] = v[r][j] * rstd * gg[j];
            } else {
                GAS u32x2* o8 = (GAS u32x2*)(XN + (size_t)(tb + r) * D) + lane;
#pragma unroll
                for (int j = 0; j < 4; ++j) { if (!dry) xw[64 * j] = v[r][j]; const f32x4 n = v[r][j] * rstd * gg[j]; u32x2 w; w.x = pk2(n.x, n.y); w.y = pk2(n.z, n.w); o8[64 * j] = w; }
            }
        }
    }
}

__device__ __forceinline__ float diff_lambda_full(const float* lam, int lane) {
    const float a = wave_sum(lam[lane] * lam[64 + lane]), b = wave_sum(lam[128 + lane] * lam[192 + lane]);
    return __expf(a) - __expf(b) + LAMBDA_INIT;
}

__device__ __forceinline__ void phase_qkv(LAS unsigned char* lds_in, int layer, const int wave_in) {
    int lane = lane_id(); asm volatile("" : "+v"(lane)); int wave = wave_in; asm volatile("" : "+s"(wave)); LAS unsigned char* lds = lds_in; asm volatile("" : "+s"(lds));
    const CArgs a = kargs(); unsigned char* ws = a->ws;
    const int N = layer == 0 ? SWA_N : DIFF_N;
    pg8::Gemm g{(const bf16_t*)(ws + WS_XN), (const bf16_t*)(ws + (layer == 0 ? WS_SWA_QKV_T : WS_DIFF_QKV_T)), D};
    pg8::DenseOrder S; S.init(M, N, (int)gridDim.x, (int)blockIdx.x);
    pg8::EpiQKV E{(bf16_t*)(ws + WS_QKV), N, 1024, QSCALE, layer == 1 ? (unsigned*)(ws + WS_CTL) + CW_KMAX : nullptr};
    pg8::gemm_phase<pg8::EpiQKV, pg8::DenseOrder, false, true>(lds, g, S, E, wave, lane);
}
__device__ __forceinline__ void phase_oproj(LAS unsigned char* lds_in, int layer, const int wave_in) {
    int lane = lane_id(); asm volatile("" : "+v"(lane)); int wave = wave_in; asm volatile("" : "+s"(wave)); LAS unsigned char* lds = lds_in; asm volatile("" : "+s"(lds));
    const CArgs a = kargs(); unsigned char* ws = a->ws;
    pg8::Gemm g{(const bf16_t*)(ws + WS_O), (const bf16_t*)(ws + (layer == 0 ? WS_SWA_WO_T : WS_DIFF_WO_T)), D};
    pg8::DenseOrder S; S.init(M, D, (int)gridDim.x, (int)blockIdx.x);
    pg8::EpiResid E{layer == 0 ? a->in[I_X] : (const float*)a->out, a->out};
    pg8::gemm_phase<pg8::EpiResid, pg8::DenseOrder, false, true>(lds, g, S, E, wave, lane);
}
__device__ __forceinline__ void phase_moe1(LAS unsigned char* lds_in, int layer, const int wave_in) {
    int lane = lane_id(); asm volatile("" : "+v"(lane)); int wave = wave_in; asm volatile("" : "+s"(wave)); LAS unsigned char* lds = lds_in; asm volatile("" : "+s"(lds));
    const CArgs a = kargs(); unsigned char* ws = a->ws;
    moe_tables(lds, ws, layer, wave, lane);
    const LAS int* TP = (const LAS int*)(lds + TP_OFF); const LAS int* CNT = TP + 40;
    if ((F8_STAGE & 2) && (layer == 1 || F8_L0)) {
        pg8::Gemm g{(const bf16_t*)(ws + WS_XN), (const bf16_t*)(ws + WS_WMOE + (size_t)layer * 96 * MiB), D / 2, 0x79797979u, 0x7d7d7d7du};
        pg8::MoeOrder S{TP, CNT, (const int*)(ws + WS_LTOK), (int)gridDim.x, (int)blockIdx.x, 12, 0};
        if (F8_STAGE & 1) { pg8::EpiSwiGLU<true> E{(bf16_t*)(ws + WS_H), (const int*)(ws + WS_LTOK), (const float*)(ws + WS_RSTD), CNT};
            pg8::gemm_phase<pg8::EpiSwiGLU<true>, pg8::MoeOrder, true, true, true>(lds, g, S, E, wave, relaunder(lane)); }
        else { pg8::EpiSwiGLU<false> E{(bf16_t*)(ws + WS_H), (const int*)(ws + WS_LTOK), (const float*)(ws + WS_RSTD), CNT};
            pg8::gemm_phase<pg8::EpiSwiGLU<false>, pg8::MoeOrder, true, true, true>(lds, g, S, E, wave, relaunder(lane)); }
    } else if ((F8_STAGE & 1) && layer == 1) {
        pg8::Gemm g{(const bf16_t*)(ws + WS_XN), (const bf16_t*)(ws + WS_WMOE + (size_t)layer * 96 * MiB), D};
        pg8::MoeOrder S{TP, CNT, (const int*)(ws + WS_LTOK), (int)gridDim.x, (int)blockIdx.x, 6, 0};
        pg8::EpiSwiGLU<true> E{(bf16_t*)(ws + WS_H), (const int*)(ws + WS_LTOK), (const float*)(ws + WS_RSTD), CNT};
        pg8::gemm_phase<pg8::EpiSwiGLU<true>, pg8::MoeOrder, true, true>(lds, g, S, E, wave, relaunder(lane));
    } else {
        pg8::Gemm g{(const bf16_t*)(ws + WS_XN), (const bf16_t*)(ws + WS_WMOE + (size_t)layer * 96 * MiB), D};
        pg8::MoeOrder S{TP, CNT, (const int*)(ws + WS_LTOK), (int)gridDim.x, (int)blockIdx.x, 6, 0};
        pg8::EpiSwiGLU<false> E{(bf16_t*)(ws + WS_H), (const int*)(ws + WS_LTOK), (const float*)(ws + WS_RSTD), CNT};
        pg8::gemm_phase<pg8::EpiSwiGLU<false>, pg8::MoeOrder, true, true>(lds, g, S, E, wave, relaunder(lane));
    }
}
__device__ __forceinline__ void phase_moe2(LAS unsigned char* lds_in, int layer, const int wave_in) {
    int lane = lane_id(); asm volatile("" : "+v"(lane)); int wave = wave_in; asm volatile("" : "+s"(wave)); LAS unsigned char* lds = lds_in; asm volatile("" : "+s"(lds));
    const CArgs a = kargs(); unsigned char* ws = a->ws;
    moe_tables(lds, ws, layer, wave, lane);
    const LAS int* TP = (const LAS int*)(lds + TP_OFF); const LAS int* CNT = TP + 40;
    pg8::EpiDown E{(bf16_t*)(ws + WS_Y), (const float*)(ws + WS_LW)};
    if ((F8_STAGE & 1) && layer == 1) {
        pg8::Gemm g{(const bf16_t*)(ws + WS_H), (const bf16_t*)(ws + WS_WMOE + (size_t)layer * 96 * MiB), DEXP / 2, 0x79797979u, 0x7c7c7c7cu};
        pg8::MoeOrder S{TP, CNT, (const int*)(ws + WS_LTOK), (int)gridDim.x, (int)blockIdx.x, 24, 16};
        pg8::gemm_phase<pg8::EpiDown, pg8::MoeOrder, false, true, true>(lds, g, S, E, wave, relaunder(lane));
    } else {
        pg8::Gemm g{(const bf16_t*)(ws + WS_H), (const bf16_t*)(ws + WS_WMOE + (size_t)layer * 96 * MiB), DEXP};
        pg8::MoeOrder S{TP, CNT, (const int*)(ws + WS_LTOK), (int)gridDim.x, (int)blockIdx.x, 12, 8};
        pg8::gemm_phase<pg8::EpiDown, pg8::MoeOrder, false, true>(lds, g, S, E, wave, relaunder(lane));
    }
}
__device__ __forceinline__ void phase_attn(LAS unsigned char* lds_in, int layer, const int wave_in, const bool dry) {
    int lane = lane_id(); asm volatile("" : "+v"(lane)); int wave = wave_in; asm volatile("" : "+s"(wave)); LAS unsigned char* lds = lds_in; asm volatile("" : "+s"(lds));
    const CArgs a = kargs(); unsigned char* ws = a->ws;
    const int G = gridDim.x, vcu = vcu_of(G);
    const bf16_t* QKV = (const bf16_t*)(ws + WS_QKV); bf16_t* OB = (bf16_t*)(ws + WS_O);
    if (layer == 0) {
        att::DiffConsts dc{0.f, nullptr}; const float* sink = a->in[I_SWA_SINK];
#pragma unroll 1
        for (int i = 0; i < 2048; ++i) { const int id = vcu + G * i; if (id >= 2048) break; const int bk = id >> 7, qb = id & 127;
            att::attn_unit<0>(bk >> 2, bk & 3, qb, QKV, OB, sink, dc, lds, wave, lane); }
    } else {
        att::DiffConsts dc{diff_lambda_full(a->in[I_DIFF_LAM], lane), a->in[I_DIFF_SUBLN]};
        const unsigned* kmaxsq = (const unsigned*)(ws + WS_CTL) + CW_KMAX;
#pragma unroll 1
        for (int i = 0; i < 2048; ++i) { const int id = vcu + G * i; if (id >= 2048) break; const int h = id >> 8, bq = id & 255, b = bq >> 6;
            const int qb = ((0xD8 >> h) & 1) ? ((bq + 32) & 63) : (bq & 63);
            const int cm = wave >> 2, gi = b * 32 + 2 * (2 * h + cm);
            const float kmax = sqrtf(__uint_as_float(__hip_atomic_load(kmaxsq + gi, RLX_AGENT)) + __uint_as_float(__hip_atomic_load(kmaxsq + gi + 1, RLX_AGENT))) * 1.01f;
            if (ATT_PROBE_VARIANT != 0 && dry) att::diff_unit<ATT_PROBE_VARIANT>(b, h, qb, QKV, (bf16_t*)(ws + WS_XN), kmax, dc, lds, wave, lane);
            else att::diff_unit<0>(b, h, qb, QKV, OB, kmax, dc, lds, wave, lane); }
    }
}

__global__ void __launch_bounds__(NWAVES * 64, 2) mega_fwd(Args args_by_value) {
    extern __shared__ __attribute__((aligned(16))) unsigned char lds_raw[];
    LAS unsigned char* lds = (LAS unsigned char*)lds_raw;
    const int wave = __builtin_amdgcn_readfirstlane((int)(threadIdx.x >> 6));
    int lo, hi;
    { const CArgs a = kargs(); lo = a->ph_lo; hi = a->ph_hi;
      if (a->use_cg) cg::this_grid().sync(); }
    { const int tid = wave * 64 + lane_id();
      for (int u = tid; u < (LDS_BYTES - LDSCTL_OFF) / 4; u += NWAVES * 64) ((LAS unsigned*)(lds + LDSCTL_OFF))[u] = 0u; }
    __syncthreads();
    if (N_LAUNCHES == 1) { const CArgs a = kargs(); (void)xcd_barrier_post((unsigned*)(a->ws + WS_CTL) + CW_BAR, (volatile LAS unsigned*)(lds + MISC_OFF) + 8, wave == 0 && lane_id() == 0); }
    int rep_left = REP_COUNT;
    unsigned long long tp_prev = 0, tp_acc = 0;
    if (TPROBE_MASK != 0) tp_prev = __builtin_amdgcn_s_memrealtime();
#pragma unroll 1
    for (int ph = lo; ph < hi; ++ph) {
        const int layer = ph >= 8 ? 1 : 0, kind = ph == 0 ? 0 : ph - 7 * layer;
        const bool dry = REP_COUNT > 0 && ph == REP_PHASE && rep_left > 0;
        switch (kind) {
            case 0: phase_prologue(lds, wave); break;
            case 1: phase_qkv(lds, layer, wave); break;
            case 2: phase_attn(lds, layer, wave, dry); break;
            case 3: phase_oproj(lds, layer, wave); break;
            case 4: if (ROUTER_PROBE != 0 && dry) phase_router<ROUTER_PROBE, false>(lds, layer, wave, dry); else if ((F8_STAGE & 2) && (layer == 1 || F8_L0)) phase_router<0, true>(lds, layer, wave, dry); else phase_router<0, false>(lds, layer, wave, dry); break;
            case 5: phase_moe1(lds, layer, wave); break;
            case 6: phase_moe2(lds, layer, wave); break;
            default: phase_combine(lds, layer, wave, dry); break;
        }
        if (ph + 1 < hi) { const CArgs a = kargs(); XcdBarrier bar; bar.bar = (unsigned*)(a->ws + WS_CTL) + CW_BAR; bar.x = xb_xcc_id(); bar.st = (volatile LAS unsigned*)(lds + MISC_OFF) + 8;
            xcd_barrier(bar, wave == 0 && lane_id() == 0);
        }
        if (TPROBE_MASK != 0) { const unsigned long long tn = __builtin_amdgcn_s_memrealtime(); if ((TPROBE_MASK >> ph) & 1) tp_acc += tn - tp_prev; tp_prev = tn; }
        if (REP_COUNT > 0 && ph == REP_PHASE && rep_left > 0) { --rep_left; --ph; }
        if (EXTRA_BARRIERS > 0 && ph == 3) { for (int xb = 0; xb < EXTRA_BARRIERS; ++xb) { const CArgs a = kargs(); XcdBarrier bar; bar.bar = (unsigned*)(a->ws + WS_CTL) + CW_BAR; bar.x = xb_xcc_id(); bar.st = (volatile LAS unsigned*)(lds + MISC_OFF) + 8; xcd_barrier(bar, wave == 0 && lane_id() == 0); } }
    }
    if (TPROBE_MASK != 0 && blockIdx.x == 0 && wave == 0) { const unsigned long long t0 = __builtin_amdgcn_s_memrealtime(); while (__builtin_amdgcn_s_memrealtime() - t0 < TPROBE_K * tp_acc) __builtin_amdgcn_s_sleep(8); }
}

extern "C" void kernel_launch(void* const* d_in, const int* in_sizes, int n_in, void* d_out, int out_size, void* d_ws, size_t ws_size, hipStream_t stream) {
    static int grid = 0;
    if (grid == 0) {
        if (n_in != 18 || in_sizes[0] != M * D || out_size != M * D || ws_size < WS_END) {
            fprintf(stderr, "kernel_launch: unexpected shapes: n_in %d in0 %d out %d ws %zu (need %zu)\n", n_in, n_in > 0 ? in_sizes[0] : -1, out_size, ws_size, (size_t)WS_END); grid = -1; return; }
        int dev = 0, cus = 0, per_cu = 0;
        if (hipGetDevice(&dev) != hipSuccess || hipDeviceGetAttribute(&cus, hipDeviceAttributeMultiprocessorCount, dev) != hipSuccess) { fprintf(stderr, "kernel_launch: device query failed\n"); grid = -1; return; }
        if (hipFuncSetAttribute((const void*)mega_fwd, hipFuncAttributeMaxDynamicSharedMemorySize, LDS_BYTES) != hipSuccess) { fprintf(stderr, "kernel_launch: hipFuncSetAttribute failed\n"); grid = -1; return; }
        if (hipOccupancyMaxActiveBlocksPerMultiprocessor(&per_cu, (const void*)mega_fwd, NWAVES * 64, LDS_BYTES) != hipSuccess || per_cu < 1) { fprintf(stderr, "kernel_launch: occupancy query says %d\n", per_cu); per_cu = 1; }
        (void)hipGetLastError();
        grid = cus;
    }
    if (grid < 0) return;
    (void)hipMemsetAsync((char*)d_ws + WS_CTL, 0, CTL_ZERO_BYTES, stream);
    Args a{};
    for (int i = 0; i < 18; ++i) a.in[i] = (const float*)d_in[i];
    a.out = (float*)d_out; a.ws = (unsigned char*)d_ws; a.use_cg = 0; a.pad = 0;
    if (N_LAUNCHES == 1) {
        a.ph_lo = 0; a.ph_hi = N_PHASES;
        void* kargs_[] = {&a};
        hipError_t e = hipLaunchCooperativeKernel((const void*)mega_fwd, dim3(grid), dim3(NWAVES * 64), kargs_, LDS_BYTES, stream);
        if (e != hipSuccess) fprintf(stderr, "kernel_launch: cooperative launch failed: %s (grid %d)\n", hipGetErrorString(e), grid);
    } else {
        for (int p = 0; p < N_PHASES; ++p) { a.ph_lo = p; a.ph_hi = p + 1; hipLaunchKernelGGL(mega_fwd, dim3(grid), dim3(NWAVES * 64), LDS_BYTES, stream, a); }
    }
}
```

```cpp
#include <hip/hip_runtime.h>
#include <hip/hip_cooperative_groups.h>
#include <cstdio>
#include <cstdint>
namespace cg = cooperative_groups;

#ifndef MK_N_LAUNCHES
#define MK_N_LAUNCHES 1
#endif
constexpr int N_PHASES = 15;
#define F8_STAGE 2
#define F8_L0 1
#define REP_PHASE -1
#define REP_COUNT 0
#define ATT_PROBE_VARIANT 0
#define EXTRA_BARRIERS 0
#define ROUTER_PROBE 0
#define TPROBE_MASK 0
#define TPROBE_K 4
constexpr int N_LAUNCHES = MK_N_LAUNCHES;

#define LAS __attribute__((address_space(3)))
#define GAS __attribute__((address_space(1)))
typedef unsigned short bf16_t;
typedef short bf16x8 __attribute__((ext_vector_type(8)));
typedef short s16x4 __attribute__((ext_vector_type(4)));
typedef float f32x2 __attribute__((ext_vector_type(2)));
typedef float f32x4 __attribute__((ext_vector_type(4)));
typedef float f32x16 __attribute__((ext_vector_type(16)));
typedef unsigned u32x2 __attribute__((ext_vector_type(2)));
typedef unsigned u32x4 __attribute__((ext_vector_type(4)));
typedef int i32x4 __attribute__((ext_vector_type(4)));
typedef int i32x8 __attribute__((ext_vector_type(8)));
typedef __bf16 bf16x2_t __attribute__((ext_vector_type(2)));

constexpr int D = 1024, BATCH = 4, SEQ = 8192, M = BATCH * SEQ;
constexpr int SWA_N = 1536, DIFF_N = 3072;
constexpr int NEXP = 32, DEXP = 512;
constexpr float LOG2E = 1.4426950408889634f;
constexpr float QSCALE = 0.125f * LOG2E;
constexpr float LAMBDA_INIT = 0.35550906759f;
constexpr int NWAVES = 8;

constexpr size_t MiB = 1u << 20;
constexpr size_t WS_CTL = 0, CTL_ZERO_BYTES = 1 * MiB;
constexpr size_t WS_SWA_QKV_T = 1 * MiB, WS_SWA_WO_T = 4 * MiB, WS_DIFF_QKV_T = 6 * MiB, WS_DIFF_WO_T = 12 * MiB;
constexpr size_t WS_WR = 14 * MiB;
constexpr size_t WS_RSTD = 14 * MiB + 512 * 1024;
constexpr size_t WS_LTOK = 15 * MiB, WS_LW = 19 * MiB, WS_TINFO = 23 * MiB;
constexpr size_t WS_WMOE = 24 * MiB;
constexpr size_t WS_XN = 216 * MiB;
constexpr size_t WS_SCR = 280 * MiB;
constexpr size_t WS_QKV = WS_SCR, WS_O = WS_SCR + 192 * MiB, WS_Y = WS_SCR, WS_H = WS_SCR + 144 * MiB;
constexpr size_t WS_END = 536 * MiB;
constexpr int CW_BAR = 4096;
constexpr int CW_CNT = 16384;
constexpr int CW_KMAX = 24576;

constexpr int RING_BYTES = 131072;
constexpr int LDSCTL_OFF = RING_BYTES;
constexpr int MISC_OFF = LDSCTL_OFF + 320;
constexpr int TP_OFF = LDSCTL_OFF + 1024;
constexpr int STASH_OFF = LDSCTL_OFF + 2048;
constexpr int LDS_BYTES = 147456;

__device__ __forceinline__ unsigned f2bf(float f) { unsigned u = __builtin_bit_cast(unsigned, f); return (u + 0x7fffu + ((u >> 16) & 1u)) >> 16; }
__device__ __forceinline__ unsigned pk2(float lo, float hi) { return f2bf(lo) | (f2bf(hi) << 16); }
__device__ __forceinline__ unsigned cvtpk(float lo, float hi) { f32x2 v = {lo, hi}; bf16x2_t b = __builtin_convertvector(v, bf16x2_t); return __builtin_bit_cast(unsigned, b); }
__device__ __forceinline__ unsigned pk4_fp8(float a, float b, float c, float d) {
    a = __builtin_fminf(__builtin_fmaxf(a, -448.f), 448.f); b = __builtin_fminf(__builtin_fmaxf(b, -448.f), 448.f); c = __builtin_fminf(__builtin_fmaxf(c, -448.f), 448.f); d = __builtin_fminf(__builtin_fmaxf(d, -448.f), 448.f);
    int r = 0; r = __builtin_amdgcn_cvt_pk_fp8_f32(a, b, r, false); r = __builtin_amdgcn_cvt_pk_fp8_f32(c, d, r, true); return (unsigned)r; }
__device__ __forceinline__ float bf2f(unsigned short h) { return __builtin_bit_cast(float, (unsigned)h << 16); }
__device__ __forceinline__ int relaunder(int x) { asm volatile("" : "+v"(x)); return x; }
__device__ __forceinline__ int lane_id() { return (int)__builtin_amdgcn_mbcnt_hi(~0u, __builtin_amdgcn_mbcnt_lo(~0u, 0u)); }
__device__ __forceinline__ float wave_sum(float v) {
#pragma unroll
    for (int o = 1; o < 64; o <<= 1) v += __shfl_xor(v, o);
    return v;
}

namespace pg8 {
constexpr int BM = 256, BK = 64, HALF = 128, HTB = HALF * BK * 2, STAGE_BYTES = 8 * HTB, NXCD = 8, WGM = 8;
__host__ __device__ __forceinline__ int lds_byte(int r, int c) { const int st = (r >> 4) * 2 + (c >> 5), rr = r & 15, cc = c & 31, ob = rr * 64 + cc * 2; return st * 1024 + (ob ^ (((ob >> 9) & 1) << 5)); }
__host__ __device__ __forceinline__ void stage_rc(int b, int& R, int& C) { const int st = b / 1024, sb = b % 1024, swz = sb ^ (((sb >> 9) & 1) << 5); R = (st >> 1) * 16 + swz / 64; C = (st & 1) * 32 + (swz % 64) / 2; }
__host__ __device__ __forceinline__ int perm32(int rho) { const int n = rho >> 4, i = rho & 15; return 8 * (i >> 2) + 4 * n + (i & 3); }

struct Unit { int pm, pn, e, t, pnl; };
struct Gemm { const bf16_t* A; const bf16_t* Bt; int K; unsigned sw = 0x7f7f7f7fu, sx = 0x7f7f7f7fu; };

struct DenseOrder {
    int nM, nN, nwg, G, c;
    __device__ void init(int Mr, int N, int G_, int c_) { nM = Mr / BM; nN = N / BM; nwg = nM * nN; G = G_; c = c_; }
    __device__ bool next(int i, Unit& u) const {
        const long L = (long)i * G + c; if (L >= nwg) return false;
        int wgid = (int)L; { const int q = nwg / NXCD, r = nwg % NXCD, xcd = wgid % NXCD, off = wgid / NXCD; wgid = (xcd < r ? xcd * (q + 1) : r * (q + 1) + (xcd - r) * q) + off; }
        const int nig = WGM * nN, gid = wgid / nig, fm = gid * WGM, gsz = (nM - fm) < WGM ? (nM - fm) : WGM;
        u.pm = fm + ((wgid % nig) % gsz); u.pn = (wgid % nig) / gsz; u.e = 0; u.t = 0; u.pnl = u.pn; return true;
    }
    __device__ __forceinline__ int token(const Unit&, int) const { return 0; }
};
struct MoeOrder {
    const LAS int* TP; const LAS int* CNT; const int* ltok; int G, c, pn_mul, pn_add;
    __device__ bool next(int i, Unit& u) const {
        const int ntile = __builtin_amdgcn_readfirstlane(TP[32]); const int nwg = ntile * 4;
        const long L = (long)i * G + c; if (L >= nwg) return false;
        int wgid = (int)L; { const int q = nwg / NXCD, r = nwg % NXCD, xcd = wgid % NXCD, off = wgid / NXCD; wgid = (xcd < r ? xcd * (q + 1) : r * (q + 1) + (xcd - r) * q) + off; }
        const int tau = wgid >> 2; int e = 0;
#pragma unroll
        for (int st = 16; st >= 1; st >>= 1) if (__builtin_amdgcn_readfirstlane(TP[e + st]) <= tau) e += st;
        u.pm = tau; u.e = e; u.t = tau - __builtin_amdgcn_readfirstlane(TP[e]); u.pnl = wgid & 3; u.pn = e * pn_mul + pn_add + u.pnl; return true;
    }
    __device__ __forceinline__ int token(const Unit& u, int r) const { const int idx = u.t * 256 + r; return ltok[(size_t)u.e * M + (idx < CNT[u.e] ? idx : 0)]; }
};

struct EpiQKV {
    static constexpr bool PERM = true;
    bf16_t* O; int ldc; int qcols; float qscale; unsigned* kmaxsq;
    __device__ __forceinline__ void operator()(const f32x4 (&acc)[2][2][4][2], const Unit& u, int wr, int wc, int fr, int fq) const {
        asm volatile("" : "+v"(fr), "+v"(fq));
        const int row0 = u.pm * BM + wr * 64 + fr, colt = u.pn * BM; const float sc = colt < qcols ? qscale : 1.f;
        const int col0 = colt + wc * 32 + 8 * fq;
#pragma unroll
        for (int ai = 0; ai < 2; ++ai)
#pragma unroll
            for (int m = 0; m < 4; ++m) { bf16_t* rowp = O + (size_t)(row0 + ai * HALF + m * 16) * ldc + col0;
#pragma unroll
                for (int bj = 0; bj < 2; ++bj) { const f32x4 v0 = acc[ai][bj][m][0] * sc, v1 = acc[ai][bj][m][1] * sc;
                    u32x4 w; w.x = cvtpk(v0[0], v0[1]); w.y = cvtpk(v0[2], v0[3]); w.z = cvtpk(v1[0], v1[1]); w.w = cvtpk(v1[2], v1[3]);
                    *(u32x4*)(rowp + bj * HALF) = w; } }
        if (kmaxsq != nullptr && colt >= 1024 && colt < 2048) {
#pragma unroll
            for (int bj = 0; bj < 2; ++bj) { float mx = 0.f;
#pragma unroll
                for (int ai = 0; ai < 2; ++ai)
#pragma unroll
                    for (int m = 0; m < 4; ++m) { const f32x4 v0 = acc[ai][bj][m][0], v1 = acc[ai][bj][m][1];
                        float ss = (v0[0] * v0[0] + v0[1] * v0[1]) + (v0[2] * v0[2] + v0[3] * v0[3]) + (v1[0] * v1[0] + v1[1] * v1[1]) + (v1[2] * v1[2] + v1[3] * v1[3]);
                        ss += __shfl_xor(ss, 16); ss += __shfl_xor(ss, 32); mx = __builtin_fmaxf(mx, ss); }
                mx = __builtin_fmaxf(mx, __shfl_xor(mx, 1)); mx = __builtin_fmaxf(mx, __shfl_xor(mx, 2)); mx = __builtin_fmaxf(mx, __shfl_xor(mx, 4)); mx = __builtin_fmaxf(mx, __shfl_xor(mx, 8));
                if (fr == 0 && fq == 0) atomicMax(kmaxsq + (u.pm >> 5) * 32 + ((colt - 1024 + bj * HALF + wc * 32) >> 5), __float_as_uint(mx)); }
        }
    }
};
struct EpiResid {
    static constexpr bool PERM = false;
    const float* base; float* out;
    __device__ __forceinline__ void operator()(const f32x4 (&acc)[2][2][4][2], const Unit& u, int wr, int wc, int fr, int fq) const {
        asm volatile("" : "+v"(fr), "+v"(fq));
        const int col0 = u.pn * BM + wc * 32 + 4 * fq;
#pragma unroll
        for (int ai = 0; ai < 2; ++ai) {
            f32x4 b[4][2][2];
#pragma unroll
            for (int m = 0; m < 4; ++m) { const size_t off = (size_t)(u.pm * BM + ai * HALF + wr * 64 + m * 16 + fr) * D + col0;
#pragma unroll
                for (int bj = 0; bj < 2; ++bj)
#pragma unroll
                    for (int n = 0; n < 2; ++n) b[m][bj][n] = *(const f32x4*)(base + off + bj * HALF + n * 16); }
            asm volatile("" ::: "memory");
#pragma unroll
            for (int m = 0; m < 4; ++m) { const size_t off = (size_t)(u.pm * BM + ai * HALF + wr * 64 + m * 16 + fr) * D + col0;
#pragma unroll
                for (int bj = 0; bj < 2; ++bj)
#pragma unroll
                    for (int n = 0; n < 2; ++n) *(f32x4*)(out + off + bj * HALF + n * 16) = b[m][bj][n] + acc[ai][bj][m][n]; }
            asm volatile("" ::: "memory");
        }
    }
};
__device__ __forceinline__ float silu_mul(float g, float u) { return g * u * __builtin_amdgcn_rcpf(1.f + __builtin_amdgcn_exp2f(-g * LOG2E)); }
template <bool F8>
struct EpiSwiGLU {
    static constexpr bool PERM = true;
    bf16_t* H; const int* ltok; const float* rstd_tok; const LAS int* CNT;
    __device__ __forceinline__ void operator()(const f32x4 (&acc)[2][2][4][2], const Unit& u, int wr, int wc, int fr, int fq) const {
        asm volatile("" : "+v"(fr), "+v"(fq));
        const int colh = u.pnl * 128 + wc * 32 + 8 * fq; const int cnt = CNT[u.e];
        int toks[2][4]; float rss[2][4];
#pragma unroll
        for (int ai = 0; ai < 2; ++ai)
#pragma unroll
            for (int m = 0; m < 4; ++m) { const int idx = u.t * 256 + ai * HALF + wr * 64 + m * 16 + fr; toks[ai][m] = ltok[(size_t)u.e * M + (idx < cnt ? idx : 0)]; }
#pragma unroll
        for (int ai = 0; ai < 2; ++ai)
#pragma unroll
            for (int m = 0; m < 4; ++m) rss[ai][m] = rstd_tok[toks[ai][m]];
        asm volatile("" ::: "memory");
#pragma unroll
        for (int ai = 0; ai < 2; ++ai)
#pragma unroll
            for (int m = 0; m < 4; ++m) { const int rl = ai * HALF + wr * 64 + m * 16 + fr; const size_t row = (size_t)u.pm * BM + rl;
                const float rs = rss[ai][m];
                const f32x4 g0 = acc[ai][0][m][0] * rs, g1 = acc[ai][0][m][1] * rs, u0 = acc[ai][1][m][0] * rs, u1 = acc[ai][1][m][1] * rs;
                if constexpr (F8) {
                    u32x2 w; w.x = pk4_fp8(8.f * silu_mul(g0[0], u0[0]), 8.f * silu_mul(g0[1], u0[1]), 8.f * silu_mul(g0[2], u0[2]), 8.f * silu_mul(g0[3], u0[3]));
                    w.y = pk4_fp8(8.f * silu_mul(g1[0], u1[0]), 8.f * silu_mul(g1[1], u1[1]), 8.f * silu_mul(g1[2], u1[2]), 8.f * silu_mul(g1[3], u1[3]));
                    *(u32x2*)((unsigned char*)H + row * DEXP + colh) = w;
                } else {
                    u32x4 w; w.x = cvtpk(silu_mul(g0[0], u0[0]), silu_mul(g0[1], u0[1])); w.y = cvtpk(silu_mul(g0[2], u0[2]), silu_mul(g0[3], u0[3]));
                    w.z = cvtpk(silu_mul(g1[0], u1[0]), silu_mul(g1[1], u1[1])); w.w = cvtpk(silu_mul(g1[2], u1[2]), silu_mul(g1[3], u1[3]));
                    *(u32x4*)(H + row * DEXP + colh) = w; }
            }
    }
};
struct EpiDown {
    static constexpr bool PERM = true;
    bf16_t* Y; const float* lw;
    __device__ __forceinline__ void operator()(const f32x4 (&acc)[2][2][4][2], const Unit& u, int wr, int wc, int fr, int fq) const {
        asm volatile("" : "+v"(fr), "+v"(fq));
        const int col0 = u.pnl * BM + wc * 32 + 8 * fq;
        float scs[2][4];
#pragma unroll
        for (int ai = 0; ai < 2; ++ai)
#pragma unroll
            for (int m = 0; m < 4; ++m) scs[ai][m] = lw[(size_t)u.e * M + u.t * 256 + ai * HALF + wr * 64 + m * 16 + fr];
        asm volatile("" ::: "memory");
#pragma unroll
        for (int ai = 0; ai < 2; ++ai)
#pragma unroll
            for (int m = 0; m < 4; ++m) { const int rl = ai * HALF + wr * 64 + m * 16 + fr; const size_t row = (size_t)u.pm * BM + rl;
                const float sc = scs[ai][m];
#pragma unroll
                for (int bj = 0; bj < 2; ++bj) { const f32x4 v0 = acc[ai][bj][m][0] * sc, v1 = acc[ai][bj][m][1] * sc;
                    u32x4 w; w.x = cvtpk(v0[0], v0[1]); w.y = cvtpk(v0[2], v0[3]); w.z = cvtpk(v1[0], v1[1]); w.w = cvtpk(v1[2], v1[3]);
                    *(u32x4*)(Y + row * D + col0 + bj * HALF) = w; } }
    }
};

template <class Epi, class Sched, bool GATHER, bool ALIGN_EPI, bool FP8 = false>
__device__ __forceinline__ void gemm_phase(LAS unsigned char* lds, const Gemm g, const Sched& S, const Epi& E, const int wid, const int lane) {
    const int tid = wid * 64 + lane, wr = wid >> 2, wc = wid & 3, fr = lane & 15, fq = lane >> 4;
    const int K = g.K, nt = K / BK;
    int Rr[2], Cc[2]; unsigned voffB[2];
#pragma unroll
    for (int i = 0; i < 2; ++i) { int R, C; stage_rc(tid * 16 + i * 8192, R, C); Rr[i] = R; Cc[i] = C; const int Rb = Epi::PERM ? ((R & ~31) + perm32(R & 31)) : R; voffB[i] = (unsigned)(Rb * K + C) * 2u; }
    const size_t kstep = (size_t)(BK * 2);
    const size_t hstep = (size_t)HALF * K * 2;
    const size_t tstep = 2 * hstep;
    const unsigned ldsw = (unsigned)wid * 1024u;
    const size_t R64 = (size_t)64 * K * 2;
    const size_t H1 = GATHER ? 0 : hstep;
    const int aoff = FP8 ? lds_byte(wr * 64 + fr, (fq >> 1) * 32 + (fq & 1) * 16) : lds_byte(wr * 64 + fr, fq * 8), boff = FP8 ? lds_byte(wc * 32 + fr, (fq >> 1) * 32 + (fq & 1) * 16) : lds_byte(wc * 32 + fr, fq * 8);

#define PG8_SA(b, h) (((b) * 2 + (h)) * HTB)
#define PG8_SB(b, h) ((4 + (b) * 2 + (h)) * HTB)
#define PG8_STAGE2(bufoff, gbase, o0, o1) do { \
        __builtin_amdgcn_global_load_lds((const unsigned*)((const char*)(gbase) + (o0)), (LAS unsigned*)(lds + (bufoff) + ldsw), 16, 0, 0); \
        __builtin_amdgcn_global_load_lds((const unsigned*)((const char*)(gbase) + (o1)), (LAS unsigned*)(lds + (bufoff) + ldsw + 8192), 16, 0, 0); } while (0)
#define PG8_STAGEB(bufoff, gbase) do {   \
        __builtin_amdgcn_global_load_lds((const unsigned*)((const char*)(gbase) + voffB[0]), (LAS unsigned*)(lds + (bufoff) + ldsw), 16, 0, 0); \
        __builtin_amdgcn_global_load_lds((const unsigned*)((const char*)(gbase) + R64 + voffB[0]), (LAS unsigned*)(lds + (bufoff) + ldsw + 8192), 16, 0, 0); } while (0)
#define PG8_LDA(dst, b, h) do { if constexpr (FP8) { _Pragma("unroll") for (int m = 0; m < 4; ++m) dst##8[m] = *(const LAS i32x8*)(lds + PG8_SA(b, h) + aoff + m * 2048); } \
        else { _Pragma("unroll") for (int m = 0; m < 4; ++m) _Pragma("unroll") for (int k = 0; k < 2; ++k) dst[m][k] = *(const LAS bf16x8*)(lds + PG8_SA(b, h) + aoff + m * 2048 + k * 1024); } } while (0)
#define PG8_LDB(dst, b, h) do { if constexpr (FP8) { _Pragma("unroll") for (int n = 0; n < 2; ++n) dst##8[n] = *(const LAS i32x8*)(lds + PG8_SB(b, h) + boff + n * 2048); } \
        else { _Pragma("unroll") for (int n = 0; n < 2; ++n) _Pragma("unroll") for (int k = 0; k < 2; ++k) dst[n][k] = *(const LAS bf16x8*)(lds + PG8_SB(b, h) + boff + n * 2048 + k * 1024); } } while (0)
#define PG8_CAT8(x) __builtin_shufflevector(__builtin_bit_cast(i32x4, (x)[0]), __builtin_bit_cast(i32x4, (x)[1]), 0, 1, 2, 3, 4, 5, 6, 7)
#define PG8_MMA(ai, bj, At, Bt) do { if constexpr (FP8) __builtin_amdgcn_sched_barrier(0); __builtin_amdgcn_s_setprio(1); _Pragma("unroll") for (int m = 0; m < 4; ++m) _Pragma("unroll") for (int n = 0; n < 2; ++n) { \
        if constexpr (FP8) acc[ai][bj][m][n] = __builtin_amdgcn_mfma_scale_f32_16x16x128_f8f6f4(Bt##8[n], At##8[m], acc[ai][bj][m][n], 0, 0, 0, (int)g.sw, 0, (int)g.sx); \
        else { _Pragma("unroll") for (int k = 0; k < 2; ++k) acc[ai][bj][m][n] = __builtin_amdgcn_mfma_f32_16x16x32_bf16(Bt[n][k], At[m][k], acc[ai][bj][m][n], 0, 0, 0); } } \
        if constexpr (FP8) { _Pragma("unroll") for (int m = 0; m < 4; ++m) _Pragma("unroll") for (int n = 0; n < 2; ++n) asm volatile("" : "+v"(acc[ai][bj][m][n])); }   \
        __builtin_amdgcn_s_setprio(0); if constexpr (FP8) __builtin_amdgcn_sched_barrier(0); } while (0)
#define PG8_WAIT_V(n) asm volatile("s_waitcnt vmcnt(" #n ")" ::: "memory")
#define PG8_WAIT_L(n) asm volatile("s_waitcnt lgkmcnt(" #n ")" ::: "memory")
#define PG8_BAR __builtin_amdgcn_s_barrier()
#define PG8_SCHED __builtin_amdgcn_sched_barrier(0)
    Unit cur, nxt; int ui = 0;
    if (!S.next(0, cur)) return;
    unsigned oc00, oc01, oc10, oc11;
    LAS u32x4* stash = (LAS u32x4*)(lds + (STASH_OFF - 0) ) + tid;
    if constexpr (GATHER) {
        oc00 = (unsigned)(S.token(cur, Rr[0]) * K + Cc[0]) * 2u; oc01 = (unsigned)(S.token(cur, Rr[1]) * K + Cc[1]) * 2u;
        oc10 = (unsigned)(S.token(cur, 128 + Rr[0]) * K + Cc[0]) * 2u; oc11 = (unsigned)(S.token(cur, 128 + Rr[1]) * K + Cc[1]) * 2u;
    } else {
        oc00 = (unsigned)(Rr[0] * K + Cc[0]) * 2u; oc01 = (unsigned)(Rr[1] * K + Cc[1]) * 2u; oc10 = oc00; oc11 = oc01;
    }
    f32x4 acc[2][2][4][2];
#pragma unroll
    for (int a = 0; a < 2; ++a)
#pragma unroll
        for (int b = 0; b < 2; ++b)
#pragma unroll
            for (int m = 0; m < 4; ++m)
#pragma unroll
                for (int n = 0; n < 2; ++n) acc[a][b][m][n] = (f32x4){0.f, 0.f, 0.f, 0.f};
    bf16x8 At[4][2], B0[2][2], B1[2][2];
    i32x8 At8[4], B08[2], B18[2];
    const char* cA = GATHER ? (const char*)g.A : (const char*)g.A + (size_t)cur.pm * tstep; const char* cB = (const char*)g.Bt + (size_t)cur.pn * tstep;
    PG8_STAGEB(PG8_SB(0, 0), cB); PG8_STAGEB(PG8_SB(0, 1), cB + hstep); PG8_STAGE2(PG8_SA(0, 0), cA, oc00, oc01); PG8_STAGE2(PG8_SA(0, 1), cA + H1, oc10, oc11);
    if (wr == 1) PG8_BAR;
    PG8_WAIT_V(2); PG8_BAR;
    PG8_STAGEB(PG8_SB(1, 0), cB + kstep); PG8_STAGE2(PG8_SA(1, 0), cA + kstep, oc00, oc01); PG8_STAGEB(PG8_SB(1, 1), cB + hstep + kstep);
    PG8_WAIT_V(6); PG8_BAR;
    for (;;) {
        const bool has_next = S.next(ui + 1, nxt);
        const char* nA = has_next ? (GATHER ? (const char*)g.A : (const char*)g.A + (size_t)nxt.pm * tstep) : cA; const char* nB = has_next ? (const char*)g.Bt + (size_t)nxt.pn * tstep : cB;
        if constexpr (GATHER) {
            u32x4 nx = {oc00, oc01, oc10, oc11};
            if (has_next) { int R0, C0, R1, C1; stage_rc(tid * 16, R0, C0); stage_rc(tid * 16 + 8192, R1, C1);
                nx.x = (unsigned)(S.token(nxt, R0) * K + C0) * 2u; nx.y = (unsigned)(S.token(nxt, R1) * K + C1) * 2u;
                nx.z = (unsigned)(S.token(nxt, 128 + R0) * K + C0) * 2u; nx.w = (unsigned)(S.token(nxt, 128 + R1) * K + C1) * 2u; }
            *stash = nx;
        }
        for (int t = 0; t < nt; t += 2) {
            const bool last = (t == nt - 2);
            const char* a1 = cA + (size_t)(t + 1) * kstep;
            const char* a2 = last ? nA : cA + (size_t)(t + 2) * kstep; const char* b2 = last ? nB : cB + (size_t)(t + 2) * kstep;
            const char* a3 = a2 + kstep; const char* b3 = b2 + kstep;
            unsigned x00 = oc00, x01 = oc01, x10 = oc10, x11 = oc11;
            if constexpr (GATHER) { if (last) { const u32x4 nx = *stash; x00 = nx.x; x01 = nx.y; x10 = nx.z; x11 = nx.w; } }
            PG8_LDB(B0, 0, 0); PG8_LDB(B1, 0, 1); PG8_SCHED; PG8_LDA(At, 0, 0); PG8_STAGE2(PG8_SA(1, 1), a1 + H1, oc10, oc11);
            PG8_WAIT_V(8); PG8_WAIT_L(0); PG8_BAR; PG8_MMA(0, 0, At, B0); PG8_MMA(0, 1, At, B1); PG8_BAR; PG8_SCHED;
            PG8_LDA(At, 0, 1); PG8_STAGEB(PG8_SB(0, 0), b2); PG8_STAGEB(PG8_SB(0, 1), b2 + hstep); PG8_STAGE2(PG8_SA(0, 0), a2, x00, x01);
            PG8_WAIT_V(8); PG8_WAIT_L(0); PG8_BAR; PG8_MMA(1, 0, At, B0); PG8_MMA(1, 1, At, B1); PG8_BAR; PG8_SCHED;
            PG8_LDB(B0, 1, 0); PG8_LDB(B1, 1, 1); PG8_SCHED; PG8_LDA(At, 1, 0); PG8_STAGE2(PG8_SA(0, 1), a2 + H1, x10, x11);
            PG8_WAIT_V(8); PG8_WAIT_L(0); PG8_BAR; PG8_MMA(0, 0, At, B0); PG8_MMA(0, 1, At, B1); PG8_BAR; PG8_SCHED;
            PG8_LDA(At, 1, 1); PG8_STAGEB(PG8_SB(1, 0), b3); PG8_STAGEB(PG8_SB(1, 1), b3 + hstep); PG8_STAGE2(PG8_SA(1, 0), a3, x00, x01);
            PG8_WAIT_V(8); PG8_WAIT_L(0); PG8_BAR; PG8_MMA(1, 0, At, B0); PG8_MMA(1, 1, At, B1); PG8_BAR; PG8_SCHED;
        }
        if constexpr (ALIGN_EPI) { if (wr == 0) PG8_BAR; }
        E(acc, cur, wr, wc, fr, fq);
        if (!has_next) break;
#pragma unroll
        for (int a = 0; a < 2; ++a)
#pragma unroll
            for (int b = 0; b < 2; ++b)
#pragma unroll
                for (int m = 0; m < 4; ++m)
#pragma unroll
                    for (int n = 0; n < 2; ++n) acc[a][b][m][n] = (f32x4){0.f, 0.f, 0.f, 0.f};
        cur = nxt; cA = nA; cB = nB; ++ui;
        if constexpr (GATHER) { const u32x4 nx = *stash; oc00 = nx.x; oc01 = nx.y; oc10 = nx.z; oc11 = nx.w; }
        if constexpr (ALIGN_EPI) { if (wr == 1) PG8_BAR; }
    }
    PG8_WAIT_V(0);
    if constexpr (!ALIGN_EPI) { if (wr == 0) PG8_BAR; }
    PG8_BAR;
#undef PG8_SA
#undef PG8_SB
#undef PG8_STAGE2
#undef PG8_STAGEB
#undef PG8_LDA
#undef PG8_LDB
#undef PG8_MMA
#undef PG8_CAT8
#undef PG8_WAIT_V
#undef PG8_WAIT_L
#undef PG8_BAR
#undef PG8_SCHED
}
}

namespace att {
constexpr int NSLOT = 3;
constexpr float THR = 8.0f;
__device__ __forceinline__ void glds16(const void* gsrc, unsigned lds_dst) { unsigned keep;
    asm volatile("s_mov_b32 %0, m0\n\ts_mov_b32 m0, %2\n\ts_nop 0\n\tglobal_load_lds_dwordx4 %1, off\n\ts_mov_b32 m0, %0" : "=&s"(keep) : "v"(gsrc), "s"(lds_dst) : "memory"); }
#define ATT_WAIT_BAR(N) asm volatile("s_waitcnt vmcnt(" #N ") lgkmcnt(0)\n\ts_barrier" ::: "memory")
typedef LAS const char* lds_cptr;
typedef short v4i16_t __attribute__((ext_vector_type(4)));
__device__ __forceinline__ s16x4 vtr(lds_cptr p) { return __builtin_bit_cast(s16x4, __builtin_amdgcn_ds_read_tr16_b64_v4i16((LAS v4i16_t*)p)); }
__device__ __forceinline__ float swap_max(float m) { auto rr = __builtin_amdgcn_permlane32_swap(__float_as_uint(m), __float_as_uint(m), false, false); return __builtin_fmaxf(__uint_as_float(rr[0]), __uint_as_float(rr[1])); }
__device__ __forceinline__ float swap_sum(float m) { auto rr = __builtin_amdgcn_permlane32_swap(__float_as_uint(m), __float_as_uint(m), false, false); return __uint_as_float(rr[0]) + __uint_as_float(rr[1]); }
__device__ __forceinline__ float max3f(float a, float b, float c) { float r; asm("v_max3_f32 %0, %1, %2, %3" : "=v"(r) : "v"(a), "v"(b), "v"(c)); return r; }
template <unsigned KB> __device__ __forceinline__ float fmamk(float a, float c) { float r; asm("v_fmamk_f32 %0, %1, %2, %3" : "=v"(r) : "v"(a), "i"(KB), "v"(c)); return r; }
#define CRF(r) ((float)(((r) & 3) + 8 * ((r) >> 2)))
#define CRI(r) (((r) & 3) + 8 * ((r) >> 2))

template <int MODE> struct Cfg;
template <> struct Cfg<0> { static constexpr int DV32 = 2, NK = 1, SLOTB = 16384, VOFF = 8192, PITCH = SWA_N, NVP = 1; };
template <> struct Cfg<1> { static constexpr int DV32 = 4, NK = 2, SLOTB = 32768, VOFF = 16384, PITCH = DIFF_N, NVP = 2; };

template <int MODE>
__device__ __forceinline__ void tile_step(lds_cptr kp, lds_cptr vp, const bf16x8 (&qr)[4], f32x16 (&o)[Cfg<MODE>::DV32], float& mhat, float& l, bool& first,
                                          const float slope2, const int dq_i, const int kind, const int hi) {
    constexpr int DV32 = Cfg<MODE>::DV32;
    f32x16 p0, p1;
    const float dq = (float)dq_i, nm = -mhat;
    {
        const float sl = kind == 2 ? 0.f : (kind == 0 ? slope2 : -slope2); const float base0 = __builtin_fmaf(-sl, dq, nm);
#pragma unroll
        for (int r = 0; r < 16; ++r) { p0[r] = __builtin_fmaf(sl, CRF(r), base0); p1[r] = __builtin_fmaf(sl, CRF(r) + 32.f, base0); }
    }
#pragma unroll
    for (int d0 = 0; d0 < 4; ++d0) {
        const bf16x8 b0 = *(const LAS bf16x8*)(kp + d0 * 2048);
        const bf16x8 b1 = *(const LAS bf16x8*)(kp + d0 * 2048 + 512);
        p0 = __builtin_amdgcn_mfma_f32_32x32x16_bf16(b0, qr[d0], p0, 0, 0, 0);
        p1 = __builtin_amdgcn_mfma_f32_32x32x16_bf16(b1, qr[d0], p1, 0, 0, 0);
    }
    if (kind == 2) {
#pragma unroll
        for (int r = 0; r < 16; ++r) {
            const float e0 = __builtin_fabsf(dq - CRF(r)), e1 = __builtin_fabsf(dq - CRF(r) - 32.f);
            if (MODE == 0) { p0[r] = e0 <= 128.f ? __builtin_fmaf(-slope2, e0, p0[r]) : -INFINITY; p1[r] = e1 <= 128.f ? __builtin_fmaf(-slope2, e1, p1[r]) : -INFINITY; }
            else { p0[r] = __builtin_fmaf(-slope2, e0, p0[r]); p1[r] = __builtin_fmaf(-slope2, e1, p1[r]); }
        }
    }
    float rm = __builtin_fmaxf(p0[0], p1[0]);
#pragma unroll
    for (int r = 1; r < 16; ++r) rm = __builtin_fmaxf(rm, __builtin_fmaxf(p0[r], p1[r]));
    rm = swap_max(rm);
    if (first || __any(rm > THR)) {
        const float dl = first ? rm : __builtin_fmaxf(rm, 0.f);
        mhat += dl;
#pragma unroll
        for (int r = 0; r < 16; ++r) { p0[r] -= dl; p1[r] -= dl; }
        if (!first) {
            const float f = __builtin_amdgcn_exp2f(-dl); l *= f;
#pragma unroll
            for (int r = 0; r < 16; ++r) { int h4_ = 4 * hi; asm volatile("" : "+v"(h4_)); const float fr_ = __shfl(f, CRI(r) + h4_);
#pragma unroll
                for (int d0 = 0; d0 < DV32; ++d0) o[d0][r] *= fr_; }
        }
        first = false;
    }
    float sacc = 0.f;
    u32x4 pw[4];
#pragma unroll
    for (int s = 0; s < 2; ++s) {
        float e[8];
#pragma unroll
        for (int j = 0; j < 8; ++j) { e[j] = __builtin_amdgcn_exp2f(p0[8 * s + j]); sacc += e[j]; }
        pw[s] = (u32x4){cvtpk(e[0], e[1]), cvtpk(e[2], e[3]), cvtpk(e[4], e[5]), cvtpk(e[6], e[7])};
    }
#pragma unroll
    for (int s = 0; s < 2; ++s) {
        float e[8];
#pragma unroll
        for (int j = 0; j < 8; ++j) { e[j] = __builtin_amdgcn_exp2f(p1[8 * s + j]); sacc += e[j]; }
        pw[2 + s] = (u32x4){cvtpk(e[0], e[1]), cvtpk(e[2], e[3]), cvtpk(e[4], e[5]), cvtpk(e[6], e[7])};
    }
    l += sacc;
#pragma unroll
    for (int d0 = 0; d0 < DV32; ++d0) {
#pragma unroll
        for (int ks = 0; ks < 4; ++ks) {
            const s16x4 lo = vtr(vp + d0 * 4096 + ks * 1024), hh = vtr(vp + d0 * 4096 + ks * 1024 + 512);
            const bf16x8 vf = (bf16x8){lo[0], lo[1], lo[2], lo[3], hh[0], hh[1], hh[2], hh[3]};
            o[d0] = __builtin_amdgcn_mfma_f32_32x32x16_bf16(__builtin_bit_cast(bf16x8, pw[ks]), vf, o[d0], 0, 0, 0);
        }
    }
}

struct DiffConsts { float lam_full; const float* subln; float gs0, gs1, gs2, gs3; };

template <int MODE>
__device__ __forceinline__ void attn_unit(const int b, const int hh, const int qb, const bf16_t* __restrict__ QKV, bf16_t* __restrict__ O, const float* __restrict__ sink,
                                          const DiffConsts dc, LAS unsigned char* shm, const int wid, const int lane_in) {
    typedef Cfg<MODE> C;
    constexpr int DV32 = C::DV32, PITCH = C::PITCH;
    int lane = lane_in; asm volatile("" : "+v"(lane));
    const int r32 = lane & 31, hi = lane >> 5;
    int iw, qcol, kcol, vcol, t_lo, NT, hq = 0, cmap = 0, qs;
    float slope2;
    if (MODE == 0) { const int g = wid >> 1; qs = wid & 1; hq = hh * 4 + g; iw = qb * 64 + qs * 32; qcol = hq * 64; kcol = 1024 + hh * 64; vcol = 1280 + hh * 64;
        t_lo = qb - 2 < 0 ? 0 : qb - 2; const int t_hi = qb + 2 > 127 ? 127 : qb + 2; NT = t_hi - t_lo + 1; slope2 = __builtin_amdgcn_exp2f(-0.5f * (float)(hq + 1)) * LOG2E; }
    else { qs = wid & 3; cmap = wid >> 2; iw = qb * 128 + qs * 32; qcol = (hh * 2 + cmap) * 64; kcol = 1024 + hh * 128; vcol = 2048 + hh * 128; t_lo = 0; NT = SEQ / 64;
        slope2 = __builtin_amdgcn_exp2f(-(float)(hh + 1)) * LOG2E; }
    const bf16_t* base = QKV + (size_t)b * SEQ * PITCH;
    const unsigned lds0 = (unsigned)(uintptr_t)shm;
    const unsigned koff = (unsigned)(lane * PITCH + kcol + wid * 8) * 2u;
    const unsigned voff = (unsigned)((16 * (wid & 3) + (lane >> 2)) * PITCH + vcol + (wid >> 2) * 32 + (lane & 3) * 8) * 2u;
    const unsigned kdst = lds0 + wid * 1024, vdst = lds0 + C::VOFF + wid * 1024;
#define ATT_DMA(t, slot) do { const char* tb_ = (const char*)base + (size_t)(t) * 64 * PITCH * 2; const unsigned so_ = (unsigned)(slot) * C::SLOTB; \
        glds16(tb_ + koff, (unsigned)__builtin_amdgcn_readfirstlane(kdst + so_)); \
        if (MODE == 1) glds16(tb_ + koff + 128, (unsigned)__builtin_amdgcn_readfirstlane(kdst + so_ + 8192)); \
        glds16(tb_ + voff, (unsigned)__builtin_amdgcn_readfirstlane(vdst + so_)); \
        if (MODE == 1) glds16(tb_ + voff + 128, (unsigned)__builtin_amdgcn_readfirstlane(vdst + so_ + 8192)); } while (0)
    ATT_DMA(t_lo, 0);
    if (NT > 1) ATT_DMA(t_lo + 1, 1);
    bf16x8 qr[4];
    { const bf16_t* Qw = base + (size_t)(iw + r32) * PITCH + qcol;
#pragma unroll
      for (int d0 = 0; d0 < 4; ++d0) qr[d0] = *(const bf16x8*)(Qw + d0 * 16 + hi * 8); }
    f32x16 o[DV32];
#pragma unroll
    for (int d0 = 0; d0 < DV32; ++d0)
#pragma unroll
        for (int r = 0; r < 16; ++r) o[d0][r] = 0.f;
    float mhat = 0.f, l = 0.f; bool first = true;
    if (MODE == 0) { mhat = sink[hq] * LOG2E; l = (hi == 0) ? 1.f : 0.f; first = false; }
    const lds_cptr shm3 = (lds_cptr)shm;
    const lds_cptr kp0 = shm3 + (MODE == 1 ? cmap * 8192 : 0) + hi * 1024 + r32 * 16;
    const lds_cptr vp0 = shm3 + C::VOFF + ((lane >> 4) & 1) * 32 + (lane & 3) * 8 + (4 * hi + ((lane & 15) >> 2)) * 64;
    int slot = 0;
    for (int it = 0; it < NT; ++it) {
        if (it + 1 < NT) { if (MODE == 1) { ATT_WAIT_BAR(4); } else { ATT_WAIT_BAR(2); } } else { ATT_WAIT_BAR(0); }
        if (it + 2 < NT) { const int s2 = slot == 0 ? 2 : slot - 1; ATT_DMA(t_lo + it + 2, s2); }
        const int k0 = (t_lo + it) * 64;
        const int kind = (MODE == 0) ? ((t_lo + it == qb - 1) ? 0 : ((t_lo + it == qb + 1) ? 1 : 2)) : ((k0 + 63 < iw) ? 0 : ((k0 > iw + 31) ? 1 : 2));
        tile_step<MODE>(kp0 + slot * C::SLOTB, vp0 + slot * C::SLOTB, qr, o, mhat, l, first, slope2, iw + r32 - k0 - 4 * hi, kind, hi);
        slot = slot == 2 ? 0 : slot + 1;
    }
#undef ATT_DMA
    l = swap_sum(l);
    const float rl = 1.f / l;
    if (MODE == 0) {
        bf16_t* Ow = O + (size_t)(b * SEQ + iw) * D + hq * 64 + r32;
#pragma unroll
        for (int r = 0; r < 16; ++r) { const int row = CRI(r) + 4 * hi; const float rr = __shfl(rl, row);
#pragma unroll
            for (int d0 = 0; d0 < DV32; ++d0) Ow[(size_t)row * D + d0 * 32] = (bf16_t)f2bf(o[d0][r] * rr); }
        ATT_WAIT_BAR(0);
    } else {
        LAS float* cb = (LAS float*)shm + qs * 4096;
        ATT_WAIT_BAR(0);
        if (cmap == 1) {
#pragma unroll
            for (int r = 0; r < 16; ++r) { const int row = CRI(r) + 4 * hi; const float rr = __shfl(rl, row) * dc.lam_full;
#pragma unroll
                for (int d0 = 0; d0 < DV32; ++d0) cb[row * 128 + d0 * 32 + r32] = o[d0][r] * rr; }
        }
        ATT_WAIT_BAR(0);
        if (cmap == 0) {
            bf16_t* Ow = O + (size_t)(b * SEQ + iw) * D + hh * 128 + r32;
            float gsub[DV32];
#pragma unroll
            for (int d0 = 0; d0 < DV32; ++d0) gsub[d0] = dc.subln[d0 * 32 + r32] * (1.f - LAMBDA_INIT);
#pragma unroll
            for (int r = 0; r < 16; ++r) { const int row = CRI(r) + 4 * hi; const float rr = __shfl(rl, row);
                float v[DV32]; float ss = 0.f;
#pragma unroll
                for (int d0 = 0; d0 < DV32; ++d0) { v[d0] = o[d0][r] * rr - cb[row * 128 + d0 * 32 + r32]; ss += v[d0] * v[d0]; }
                ss += __shfl_xor(ss, 1); ss += __shfl_xor(ss, 2); ss += __shfl_xor(ss, 4); ss += __shfl_xor(ss, 8); ss += __shfl_xor(ss, 16);
                const float sc = __builtin_amdgcn_rsqf(ss * (1.f / 128.f) + 1e-5f);
#pragma unroll
                for (int d0 = 0; d0 < DV32; ++d0) Ow[(size_t)row * D + d0 * 32] = (bf16_t)f2bf(v[d0] * sc * gsub[d0]); }
        }
        ATT_WAIT_BAR(0);
    }
}

#define SBAR() __builtin_amdgcn_sched_barrier(0)
#define PIN(x) asm volatile("" : "+v"(x))
#define MF(a, b, c) __builtin_amdgcn_mfma_f32_32x32x16_bf16(a, b, c, 0, 0, 0)
template <int VAR>
__device__ __forceinline__ void diff_unit(const int b, const int hh, const int qb, const bf16_t* __restrict__ QKV, bf16_t* __restrict__ O, const float kmax,
                                          const DiffConsts dc, LAS unsigned char* shm, const int wid, const int lane_in) {
    constexpr int DV32 = 4, PITCH = DIFF_N, KSLOT = 16384, VRING = 4 * 16384;
    int lane = lane_in; asm volatile("" : "+v"(lane));
    const int r32 = lane & 31, hi = lane >> 5;
    const int qs = wid & 3, cmap = wid >> 2, i0 = qb * 128, iw = i0 + qs * 32, qcol = (hh * 2 + cmap) * 64, kcol = 1024 + hh * 128, vcol = 2048 + hh * 128;
    const float slope2 = __builtin_amdgcn_exp2f(-(float)(hh + 1)) * LOG2E;
    const bf16_t* base = QKV + (size_t)b * SEQ * PITCH;
    const unsigned lds0 = (unsigned)(uintptr_t)shm;
    const unsigned koff = (unsigned)(lane * PITCH + kcol + wid * 8) * 2u;
    const unsigned voff = (unsigned)((16 * (wid & 3) + (lane >> 2)) * PITCH + vcol + (wid >> 2) * 32 + (lane & 3) * 8) * 2u;
    const unsigned kdst = lds0 + wid * 1024, vdst = lds0 + VRING + wid * 1024;
#define DMA_K(t, slot) do { const char* tb_ = (const char*)base + (size_t)(t) * 64 * PITCH * 2; const unsigned so_ = (unsigned)(slot) * KSLOT; \
        glds16(tb_ + koff, (unsigned)__builtin_amdgcn_readfirstlane(kdst + so_)); glds16(tb_ + koff + 128, (unsigned)__builtin_amdgcn_readfirstlane(kdst + so_ + 8192)); } while (0)
#define DMA_V(t, slot) do { const char* tb_ = (const char*)base + (size_t)(t) * 64 * PITCH * 2; const unsigned so_ = (unsigned)(slot) * KSLOT; \
        glds16(tb_ + voff, (unsigned)__builtin_amdgcn_readfirstlane(vdst + so_)); glds16(tb_ + voff + 128, (unsigned)__builtin_amdgcn_readfirstlane(vdst + so_ + 8192)); } while (0)
    const int td0 = 2 * qb;
    int nL = td0;
#define TILE_OF(idx) ((idx) < 2 ? td0 + (idx) : ((idx) - 2 < nL ? td0 - 1 - ((idx) - 2) : td0 + 2 + ((idx) - 2 - nL)))
    DMA_K(td0, 0); DMA_V(td0, 0); DMA_K(td0 + 1, 1); DMA_V(td0 + 1, 1); DMA_K(TILE_OF(2), 2);
    bf16x8 qr[4]; float nq2 = 0.f;
    { const bf16_t* Qw = base + (size_t)(iw + r32) * PITCH + qcol;
#pragma unroll
      for (int d0 = 0; d0 < 4; ++d0) { qr[d0] = *(const bf16x8*)(Qw + d0 * 16 + hi * 8);
#pragma unroll
          for (int j = 0; j < 8; ++j) { const float f = bf2f((unsigned short)qr[d0][j]); nq2 += f * f; } } }
    nq2 = swap_sum(nq2);
    f32x16 o[DV32];
#pragma unroll
    for (int d0 = 0; d0 < DV32; ++d0)
#pragma unroll
        for (int r = 0; r < 16; ++r) o[d0][r] = 0.f;
    float mhat = 0.f, l = 0.f; bool first = true;
    const lds_cptr shm3 = (lds_cptr)shm;
    const lds_cptr kp0 = shm3 + cmap * 8192 + hi * 1024 + r32 * 16;
    const lds_cptr vp0 = shm3 + VRING + ((lane >> 4) & 1) * 32 + (lane & 3) * 8 + (4 * hi + ((lane & 15) >> 2)) * 64;
    LAS float* wsf = (LAS float*)(shm + 7 * KSLOT);
    ATT_WAIT_BAR(6);
    DMA_K(TILE_OF(3), 3);
    { const int k0 = td0 * 64; const int kind = (k0 + 63 < iw) ? 0 : ((k0 > iw + 31) ? 1 : 2);
      tile_step<1>(kp0, vp0, qr, o, mhat, l, first, slope2, iw + r32 - k0 - 4 * hi, kind, hi); }
    ATT_WAIT_BAR(4);
    DMA_K(TILE_OF(4), 0); DMA_V(TILE_OF(2), 2);
    { const int k0 = (td0 + 1) * 64; const int kind = (k0 + 63 < iw) ? 0 : ((k0 > iw + 31) ? 1 : 2);
      tile_step<1>(kp0 + KSLOT, vp0 + KSLOT, qr, o, mhat, l, first, slope2, iw + r32 - k0 - 4 * hi, kind, hi); }
    { float a = sqrtf(nq2) * kmax - mhat;
#pragma unroll
      for (int o_ = 1; o_ < 32; o_ <<= 1) a = __builtin_fmaxf(a, __shfl_xor(a, o_));
      if (lane == 0) wsf[wid] = a; }
    ATT_WAIT_BAR(4);
    int NT; bool nochk;
    { float amax = wsf[0];
#pragma unroll
      for (int w = 1; w < 8; ++w) amax = __builtin_fmaxf(amax, wsf[w]);
      const float dist = (64.f + __builtin_fmaxf(amax, 0.f)) / slope2;
      const float lo_f = ((float)(i0 - 63) - dist) * (1.f / 64.f), hi_f = ((float)(i0 + 127) + dist) * (1.f / 64.f);
      int t_lo = lo_f <= 0.f ? 0 : (int)lo_f, t_hi = hi_f >= 127.f ? 127 : (int)hi_f;
      if (t_lo > td0 - 2) t_lo = td0 - 2 < 0 ? 0 : td0 - 2; if (t_hi < td0 + 3) t_hi = td0 + 3 > 127 ? 127 : td0 + 3;
      t_lo = __builtin_amdgcn_readfirstlane(t_lo); t_hi = __builtin_amdgcn_readfirstlane(t_hi);
      nL = td0 - t_lo; NT = 2 + nL + (t_hi - (td0 + 1)); if (VAR & 256) NT = 2;
      nochk = __builtin_amdgcn_readfirstlane(amax <= 64.f ? 1 : 0) != 0; }
    f32x16 xa0, xa1, xb0, xb1; u32x4 pw0, pw1, pw2, pw3; bf16x8 kf0, kf1, kf2, kf3; s16x4 vl0, vh0, vl1, vh1, vl2, vh2, vl3, vh3;
    float sl_n, base_n, rf = 1.f; bool resc = false;
#define KRD(dst, f) do { if ((VAR & 4) && (f) >= 4) break; dst = *(const LAS bf16x8*)(kp_ + ((f) >> 1) * 2048 + ((f) & 1) * 512); } while (0)
#define VRD(lo, hh_, i) do { if ((VAR & 2) && (i) >= 4) break; lo = vtr(vp_ + ((i) >> 2) * 4096 + ((i) & 3) * 1024); hh_ = vtr(vp_ + ((i) >> 2) * 4096 + ((i) & 3) * 1024 + 512); } while (0)
#define KRN(dst, f) dst = *(const LAS bf16x8*)(kn_ + ((f) >> 1) * 2048 + ((f) & 1) * 512)
#define VFR(lo, hh_) (bf16x8){lo[0], lo[1], lo[2], lo[3], hh_[0], hh_[1], hh_[2], hh_[3]}
#define SET_NEXT(idx) do { const int tn_ = TILE_OF(idx); const bool left_ = (idx) - 2 < nL; sl_n = left_ ? slope2 : -slope2; \
        base_n = __builtin_fmaf(-sl_n, (float)(iw + r32 - tn_ * 64 - 4 * hi), -mhat); } while (0)
#define CINIT(X0, X1) do { _Pragma("unroll") for (int r = 0; r < 16; ++r) { X0[r] = __builtin_fmaf(sl_n, CRF(r), base_n); X1[r] = __builtin_fmaf(sl_n, CRF(r) + 32.f, base_n); } } while (0)
#define GA(Sx, KF, qf, RD, P, e, PW, w0, w1) do { Sx = MF(KF, qf, Sx); RD; if (!(VAR & 32)) { sacc += P[e]; sacc += P[e + 1]; sacc += P[e + 2]; sacc += P[e + 3]; PIN(sacc); \
        PW[w0] = cvtpk(P[e], P[e + 1]); PW[w1] = cvtpk(P[e + 2], P[e + 3]); } PIN(PW); SBAR(); } while (0)
#define PHASE_A(S0, S1, P0, P1) do { float sacc = 0.f; \
        GA(S0, kf0, qr[0], KRD(kf0, 4), P0, 0,  pw0, 0, 1); GA(S1, kf1, qr[0], KRD(kf1, 5), P0, 4,  pw0, 2, 3); \
        GA(S0, kf2, qr[1], KRD(kf2, 6), P0, 8,  pw1, 0, 1); GA(S1, kf3, qr[1], KRD(kf3, 7), P0, 12, pw1, 2, 3); \
        GA(S0, kf0, qr[2], VRD(vl0, vh0, 0), P1, 0,  pw2, 0, 1); GA(S1, kf1, qr[2], VRD(vl1, vh1, 1), P1, 4,  pw2, 2, 3); \
        GA(S0, kf2, qr[3], VRD(vl2, vh2, 2), P1, 8,  pw3, 0, 1); GA(S1, kf3, qr[3], VRD(vl3, vh3, 3), P1, 12, pw3, 2, 3); \
        l += sacc; } while (0)
#define QK_ONLY(S0, S1) do { \
        S0 = MF(kf0, qr[0], S0); KRD(kf0, 4); S1 = MF(kf1, qr[0], S1); KRD(kf1, 5); S0 = MF(kf2, qr[1], S0); KRD(kf2, 6); S1 = MF(kf3, qr[1], S1); KRD(kf3, 7); SBAR(); \
        S0 = MF(kf0, qr[2], S0); S1 = MF(kf1, qr[2], S1); S0 = MF(kf2, qr[3], S0); S1 = MF(kf3, qr[3], S1); SBAR(); } while (0)
#define DECIDE(S0, S1) do { if (VAR & 64) break; asm volatile("s_nop 15\n\ts_nop 7" : "+v"(S0), "+v"(S1));   \
        float ma_ = max3f(S0[0], S0[1], S1[0]), mb_ = max3f(S0[2], S0[3], S1[1]); ma_ = max3f(ma_, S1[2], S1[3]); \
        _Pragma("unroll") for (int r = 4; r < 16; r += 4) { ma_ = max3f(ma_, S0[r], S0[r + 1]); mb_ = max3f(mb_, S0[r + 2], S0[r + 3]); ma_ = max3f(ma_, S1[r], S1[r + 1]); mb_ = max3f(mb_, S1[r + 2], S1[r + 3]); } \
        float rm_ = max3f(ma_, mb_, mb_); rm_ = swap_max(rm_); resc = false; \
        if (__builtin_expect(__any(rm_ > THR), 0)) { const float dl_ = __builtin_fmaxf(rm_, 0.f); mhat += dl_; \
            _Pragma("unroll") for (int r = 0; r < 16; ++r) { S0[r] -= dl_; S1[r] -= dl_; } \
            rf = __builtin_amdgcn_exp2f(-dl_); l *= rf; resc = true; } } while (0)
#define RESCALE_O() do { if (resc) { int h4_ = 4 * hi; asm volatile("" : "+v"(h4_)); _Pragma("unroll") for (int r = 0; r < 16; ++r) { const float fr_ = __shfl(rf, CRI(r) + h4_); \
            _Pragma("unroll") for (int d0 = 0; d0 < DV32; ++d0) o[d0][r] *= fr_; } resc = false; } } while (0)
#define EXP2(x) ((VAR & 1) ? (x) * 0.001f : __builtin_amdgcn_exp2f(x))
#define GB(Ox, PW, VL, VH, RD, S, e, C, crf) do { if (!(VAR & 512)) Ox = MF(__builtin_bit_cast(bf16x8, PW), VFR(VL, VH), Ox); RD; S[e] = EXP2(S[e]); S[e + 1] = EXP2(S[e + 1]); PIN(S); \
        if (!(VAR & 16)) { C[e] = fmamk<__builtin_bit_cast(unsigned, CRF(e) + (crf))>(sl_n, base_n); C[e + 1] = fmamk<__builtin_bit_cast(unsigned, CRF(e + 1) + (crf))>(sl_n, base_n); } PIN(C); SBAR(); } while (0)
#define PHASE_B(S0, S1, C0, C1) do { \
        GB(o[0], pw0, vl0, vh0, VRD(vl0, vh0, 4),  S0, 0,  C0, 0.f);  GB(o[0], pw1, vl1, vh1, VRD(vl1, vh1, 5),  S0, 2,  C0, 0.f); \
        GB(o[0], pw2, vl2, vh2, VRD(vl2, vh2, 6),  S0, 4,  C0, 0.f);  GB(o[0], pw3, vl3, vh3, VRD(vl3, vh3, 7),  S0, 6,  C0, 0.f); \
        GB(o[1], pw0, vl0, vh0, VRD(vl0, vh0, 8),  S0, 8,  C0, 0.f);  GB(o[1], pw1, vl1, vh1, VRD(vl1, vh1, 9),  S0, 10, C0, 0.f); \
        GB(o[1], pw2, vl2, vh2, VRD(vl2, vh2, 10), S0, 12, C0, 0.f);  GB(o[1], pw3, vl3, vh3, VRD(vl3, vh3, 11), S0, 14, C0, 0.f); \
        GB(o[2], pw0, vl0, vh0, VRD(vl0, vh0, 12), S1, 0,  C1, 32.f); GB(o[2], pw1, vl1, vh1, VRD(vl1, vh1, 13), S1, 2,  C1, 32.f); \
        GB(o[2], pw2, vl2, vh2, VRD(vl2, vh2, 14), S1, 4,  C1, 32.f); GB(o[2], pw3, vl3, vh3, VRD(vl3, vh3, 15), S1, 6,  C1, 32.f); \
        GB(o[3], pw0, vl0, vh0, KRN(kf0, 0),       S1, 8,  C1, 32.f); GB(o[3], pw1, vl1, vh1, KRN(kf1, 1),       S1, 10, C1, 32.f); \
        GB(o[3], pw2, vl2, vh2, KRN(kf2, 2),       S1, 12, C1, 32.f); GB(o[3], pw3, vl3, vh3, KRN(kf3, 3),       S1, 14, C1, 32.f); } while (0)
#define ROT3(s) ((s) == 2 ? 0 : (s) + 1)
#define ROT4(s) (((s) + 1) & 3)
#define STEP(S0, S1, P0, P1, it, CHK) do { \
        asm volatile("" : "+s"(sk), "+s"(sv)); \
        const int skm_ = (sk + 3) & 3, skp_ = ROT4(sk), svpp_ = sv == 0 ? 2 : sv - 1;   \
        const lds_cptr kp_ = kp0 + sk * KSLOT; const lds_cptr kn_ = kp0 + skp_ * KSLOT; const lds_cptr vp_ = vp0 + sv * KSLOT; \
        if (!(VAR & 8) && (it) + 3 < NT) DMA_K(TILE_OF((it) + 3), skm_); \
        SET_NEXT((it) + 1); SBAR(); \
        __builtin_amdgcn_s_setprio(1); PHASE_A(S0, S1, P0, P1); __builtin_amdgcn_s_setprio(0); \
        if (!(VAR & 8) && (it) + 1 < NT) DMA_V(TILE_OF((it) + 1), svpp_); \
        if (CHK) { DECIDE(S0, S1); if (resc) SET_NEXT((it) + 1); } SBAR(); \
        __builtin_amdgcn_s_setprio(1); PHASE_B(S0, S1, P0, P1); __builtin_amdgcn_s_setprio(0); \
        if (CHK) RESCALE_O(); sk = skp_; sv = ROT3(sv); } while (0)
    if (NT > 2) {
        { const lds_cptr kp_ = kp0 + 2 * KSLOT; const lds_cptr kn_ = kp0 + 3 * KSLOT;
          KRD(kf0, 0); KRD(kf1, 1); KRD(kf2, 2); KRD(kf3, 3);
          if (5 < NT) DMA_K(TILE_OF(5), 1); if (3 < NT) DMA_V(TILE_OF(3), 0);
          SET_NEXT(2); CINIT(xa0, xa1); SBAR();
          QK_ONLY(xa0, xa1);
          if (!nochk) { DECIDE(xa0, xa1); RESCALE_O(); }
#pragma unroll
          for (int r = 0; r < 16; ++r) { xa0[r] = EXP2(xa0[r]); xa1[r] = EXP2(xa1[r]); }
          SET_NEXT(3); CINIT(xb0, xb1);
          KRN(kf0, 0); KRN(kf1, 1); KRN(kf2, 2); KRN(kf3, 3); }
#define PIPE_LOOP(CHK_) do { \
        int it = 3, sk = 3, sv = 2; \
        _Pragma("unroll 1") \
        for (; it + 1 < NT; it += 2) { \
            if (!(VAR & 128)) { if (it + 2 < NT) { ATT_WAIT_BAR(4); } else { ATT_WAIT_BAR(2); } } \
            STEP(xb0, xb1, xa0, xa1, it, CHK_); \
            if (!(VAR & 128)) { if (it + 3 < NT) { ATT_WAIT_BAR(4); } else { ATT_WAIT_BAR(2); } } \
            STEP(xa0, xa1, xb0, xb1, it + 1, CHK_); \
        } \
        if (it < NT) { \
            ATT_WAIT_BAR(2); \
            STEP(xb0, xb1, xa0, xa1, it, CHK_); \
 \
            { float sacc = 0.f; \
        _Pragma("unroll") \
              for (int r = 0; r < 16; ++r) sacc += xb0[r] + xb1[r]; \
              l += sacc; \
              pw0 = (u32x4){cvtpk(xb0[0], xb0[1]), cvtpk(xb0[2], xb0[3]), cvtpk(xb0[4], xb0[5]), cvtpk(xb0[6], xb0[7])}; pw1 = (u32x4){cvtpk(xb0[8], xb0[9]), cvtpk(xb0[10], xb0[11]), cvtpk(xb0[12], xb0[13]), cvtpk(xb0[14], xb0[15])}; \
              pw2 = (u32x4){cvtpk(xb1[0], xb1[1]), cvtpk(xb1[2], xb1[3]), cvtpk(xb1[4], xb1[5]), cvtpk(xb1[6], xb1[7])}; pw3 = (u32x4){cvtpk(xb1[8], xb1[9]), cvtpk(xb1[10], xb1[11]), cvtpk(xb1[12], xb1[13]), cvtpk(xb1[14], xb1[15])}; } \
        } else { \
            { float sacc = 0.f; \
        _Pragma("unroll") \
              for (int r = 0; r < 16; ++r) sacc += xa0[r] + xa1[r]; \
              l += sacc; \
              pw0 = (u32x4){cvtpk(xa0[0], xa0[1]), cvtpk(xa0[2], xa0[3]), cvtpk(xa0[4], xa0[5]), cvtpk(xa0[6], xa0[7])}; pw1 = (u32x4){cvtpk(xa0[8], xa0[9]), cvtpk(xa0[10], xa0[11]), cvtpk(xa0[12], xa0[13]), cvtpk(xa0[14], xa0[15])}; \
              pw2 = (u32x4){cvtpk(xa1[0], xa1[1]), cvtpk(xa1[2], xa1[3]), cvtpk(xa1[4], xa1[5]), cvtpk(xa1[6], xa1[7])}; pw3 = (u32x4){cvtpk(xa1[8], xa1[9]), cvtpk(xa1[10], xa1[11]), cvtpk(xa1[12], xa1[13]), cvtpk(xa1[14], xa1[15])}; } \
        } \
    } while (0)
        PIPE_LOOP(!nochk);
#undef PIPE_LOOP
        ATT_WAIT_BAR(0);
        { const int sl_ = (NT - 1) % 3; const lds_cptr vp_ = vp0 + sl_ * KSLOT;
#pragma unroll
          for (int d0 = 0; d0 < DV32; ++d0) {
              VRD(vl0, vh0, d0 * 4); VRD(vl1, vh1, d0 * 4 + 1); VRD(vl2, vh2, d0 * 4 + 2); VRD(vl3, vh3, d0 * 4 + 3);
              o[d0] = MF(__builtin_bit_cast(bf16x8, pw0), VFR(vl0, vh0), o[d0]); o[d0] = MF(__builtin_bit_cast(bf16x8, pw1), VFR(vl1, vh1), o[d0]);
              o[d0] = MF(__builtin_bit_cast(bf16x8, pw2), VFR(vl2, vh2), o[d0]); o[d0] = MF(__builtin_bit_cast(bf16x8, pw3), VFR(vl3, vh3), o[d0]); } }
    }
#undef TILE_OF
#undef DMA_K
#undef DMA_V
#undef KRD
#undef VRD
#undef VFR
#undef SET_NEXT
#undef CINIT
#undef GA
#undef PHASE_A
#undef QK_ONLY
#undef DECIDE
#undef RESCALE_O
#undef EXP2
#undef GB
#undef PHASE_B
#undef STEP
#undef ROT3
#undef ROT4
#undef KRN
    l = swap_sum(l);
    const float rl = 1.f / l;
    LAS float* cb = (LAS float*)shm + qs * 4096;
    ATT_WAIT_BAR(0);
    if (VAR & 1024) { if (lane == 0 && rl == 12345.f) O[0] = 0; return; }
    if (cmap == 1) {
#pragma unroll
        for (int r = 0; r < 16; ++r) { const int row = CRI(r) + 4 * hi; const float rr = __shfl(rl, row) * dc.lam_full;
#pragma unroll
            for (int d0 = 0; d0 < DV32; ++d0) cb[row * 128 + d0 * 32 + r32] = o[d0][r] * rr; }
    }
    ATT_WAIT_BAR(0);
    if (cmap == 0) {
        bf16_t* Ow = O + (size_t)(b * SEQ + iw) * D + hh * 128 + r32;
        const float gsub[DV32] = {dc.gs0, dc.gs1, dc.gs2, dc.gs3};
#pragma unroll
        for (int r = 0; r < 16; ++r) { const int row = CRI(r) + 4 * hi; const float rr = __shfl(rl, row);
            float v[DV32]; float ss = 0.f;
#pragma unroll
            for (int d0 = 0; d0 < DV32; ++d0) { v[d0] = o[d0][r] * rr - cb[row * 128 + d0 * 32 + r32]; ss += v[d0] * v[d0]; }
            ss += __shfl_xor(ss, 1); ss += __shfl_xor(ss, 2); ss += __shfl_xor(ss, 4); ss += __shfl_xor(ss, 8); ss += __shfl_xor(ss, 16);
            const float sc = __builtin_amdgcn_rsqf(ss * (1.f / 128.f) + 1e-5f);
#pragma unroll
            for (int d0 = 0; d0 < DV32; ++d0) Ow[(size_t)row * D + d0 * 32] = (bf16_t)f2bf(v[d0] * sc * gsub[d0]); }
    }
    asm volatile("s_waitcnt lgkmcnt(0)\n\ts_barrier" ::: "memory");
}
#undef SBAR
#undef PIN
#undef MF
#undef ATT_WAIT_BAR
}

typedef GAS unsigned gu32;
#define RLX_AGENT __ATOMIC_RELAXED, __HIP_MEMORY_SCOPE_AGENT
#define LDS_WAIT() asm volatile("s_waitcnt lgkmcnt(0)" ::: "memory")
#define VM_WAIT() asm volatile("s_waitcnt vmcnt(0)" ::: "memory")
#define XB_TMO      128
#define XB_XCNT(j)  (256  + 64 * (j))
#define XB_XSUB(j)  (1280 + 64 * (j))
#define XB_XGEN(j)  (2304 + 64 * (j))
#define XB_TOP      3328
#define XB_TOPGEN   3392
#define XCD_BAR_WORDS 3456
#define XB_SPIN_CAP (1u << 18)
__device__ __forceinline__ unsigned xb_ld(unsigned* p)              { return __hip_atomic_load(p, __ATOMIC_RELAXED, __HIP_MEMORY_SCOPE_AGENT); }
__device__ __forceinline__ unsigned xb_add(unsigned* p, unsigned v) { return __hip_atomic_fetch_add(p, v, __ATOMIC_RELAXED, __HIP_MEMORY_SCOPE_AGENT); }
__device__ __forceinline__ unsigned xb_xcc_id() { return (unsigned)__builtin_amdgcn_s_getreg((3 << 11) | 20) & 0xFu; }
#define XB_SPIN(cond, bar) do { unsigned _sp = 0; while (cond) { __builtin_amdgcn_s_sleep(1); \
    if ((++_sp & 255u) == 0u) { if (xb_ld(&(bar)[XB_TMO])) break; if (_sp > XB_SPIN_CAP) { atomicAdd(&(bar)[XB_TMO], 1u); break; } } } } while (0)
struct XcdBarrier { unsigned* bar; unsigned x; volatile LAS unsigned* st; };
__device__ __forceinline__ XcdBarrier xcd_barrier_post(unsigned* bar, volatile LAS unsigned* st, const bool leader) {
    XcdBarrier b; b.bar = bar; b.x = xb_xcc_id(); b.st = st;
    if (leader) (void)xb_add(&bar[XB_XCNT(b.x)], 1u);
    return b;
}
__device__ __forceinline__ void xcd_barrier_complete(unsigned* bar, unsigned x, unsigned& nloc, unsigned& nx) {
    const unsigned G = gridDim.x * gridDim.y * gridDim.z;
    unsigned sum, cnt, mine, sp = 0u;
    for (;;) {
        sum = 0u; cnt = 0u; mine = 0u;
#pragma unroll
        for (unsigned j = 0; j < 16; ++j) { const unsigned c = xb_ld(&bar[XB_XCNT(j)]); sum += c; cnt += (c > 0u) ? 1u : 0u; mine = (j == x) ? c : mine; }
        if (sum == G) break;
        __builtin_amdgcn_s_sleep(1);
        if ((++sp & 255u) == 0u) { if (xb_ld(&bar[XB_TMO])) break; if (sp > XB_SPIN_CAP) { atomicAdd(&bar[XB_TMO], 1u); break; } }
    }
    nloc = mine > 0u ? mine : 1u; nx = cnt > 0u ? cnt : 1u;
}
__device__ __forceinline__ void xcd_barrier(const XcdBarrier& b, const bool leader) {
    asm volatile("s_waitcnt vmcnt(0)" ::: "memory");
    __syncthreads();
    if (leader) {
        unsigned* bar = b.bar;
        __builtin_amdgcn_s_waitcnt(0);
        unsigned nloc = b.st[0], nx = b.st[1];
        if (nloc == 0u) { xcd_barrier_complete(bar, b.x, nloc, nx); b.st[0] = nloc; b.st[1] = nx; }
        const unsigned old = xb_add(&bar[XB_XSUB(b.x)], 1u);
        const unsigned gen = old / nloc;
        if (old + 1u == (gen + 1u) * nloc) {
            __builtin_amdgcn_fence(__ATOMIC_RELEASE, "agent");
            asm volatile("s_waitcnt vmcnt(0)" ::: "memory");
            const unsigned og = xb_add(&bar[XB_TOP], 1u);
            const unsigned tg = og / nx;
            if (og + 1u == (tg + 1u) * nx) xb_add(&bar[XB_TOPGEN], 1u);
            else XB_SPIN(xb_ld(&bar[XB_TOPGEN]) == tg, bar);
            __builtin_amdgcn_fence(__ATOMIC_ACQUIRE, "agent");
            xb_add(&bar[XB_XGEN(b.x)], 1u);
            asm volatile("s_waitcnt vmcnt(0)" ::: "memory");
        } else {
            XB_SPIN(xb_ld(&bar[XB_XGEN(b.x)]) == gen, bar);
            __builtin_amdgcn_fence(__ATOMIC_ACQUIRE, "agent");
            asm volatile("s_waitcnt vmcnt(0)" ::: "memory");
        }
    }
    __syncthreads();
}

struct Args { const float* in[18]; float* out; unsigned char* ws; int ph_lo, ph_hi, use_cg, pad; };
enum { I_X = 0, I_NMIX, I_NFFN, I_SWA_QKV, I_SWA_WO, I_SWA_SINK, I_DIFF_QKV, I_DIFF_WO, I_DIFF_LAM, I_DIFF_SUBLN, I_WG, I_BG, I_WR, I_BR, I_GATE, I_UP, I_DOWN, I_FNORM };
typedef const __attribute__((address_space(4))) Args* CArgs;
__device__ __forceinline__ CArgs kargs() { CArgs p = (CArgs)__builtin_amdgcn_kernarg_segment_ptr(); asm volatile("" : "+s"(p)); return p; }
__device__ __forceinline__ int vcu_of(int G) { const int bx = blockIdx.x; return (G % 8 == 0) ? (bx % 8) * (G / 8) + bx / 8 : bx; }

__device__ __forceinline__ void tr_item(const float* W, int N, int k0, int n0, bf16_t* dst, int ldd, LAS float* scr, int lane) {
    f32x4 v[8];
#pragma unroll
    for (int i = 0; i < 8; ++i) v[i] = *(const f32x4*)(W + (size_t)(k0 + 8 * i + (lane >> 3)) * N + n0 + (lane & 7) * 4);
#pragma unroll
    for (int i = 0; i < 8; ++i) { LAS float* p = scr + (8 * i + (lane >> 3)) * 33 + (lane & 7) * 4; p[0] = v[i].x; p[1] = v[i].y; p[2] = v[i].z; p[3] = v[i].w; }
    LDS_WAIT(); asm volatile("" ::: "memory");
    const int c = lane & 7;
#pragma unroll
    for (int j = 0; j < 4; ++j) { const int n = (lane >> 3) + 8 * j; const LAS float* s = scr + (8 * c) * 33 + n;
        u32x4 o; o.x = pk2(s[0 * 33], s[1 * 33]); o.y = pk2(s[2 * 33], s[3 * 33]); o.z = pk2(s[4 * 33], s[5 * 33]); o.w = pk2(s[6 * 33], s[7 * 33]);
        *(GAS u32x4*)(dst + (size_t)n * ldd + k0 + 8 * c) = o; }
    LDS_WAIT(); asm volatile("" ::: "memory");
}
__device__ __forceinline__ void rms_row_to_bf16(const float* xrow, const float* g, bf16_t* orow, int lane) {
    const GAS f32x4* xr = (const GAS f32x4*)xrow + lane; const GAS f32x4* gr = (const GAS f32x4*)g + lane;
    f32x4 v[4]; float s = 0.f;
#pragma unroll
    for (int j = 0; j < 4; ++j) { v[j] = xr[64 * j]; s += (v[j].x * v[j].x + v[j].y * v[j].y) + (v[j].z * v[j].z + v[j].w * v[j].w); }
    const float rstd = 1.f / sqrtf(wave_sum(s) * (1.f / D) + 1e-6f);
    GAS u32x2* o8 = (GAS u32x2*)orow + lane;
#pragma unroll
    for (int j = 0; j < 4; ++j) { const f32x4 gg = gr[64 * j]; u32x2 w; w.x = pk2(v[j].x * rstd * gg.x, v[j].y * rstd * gg.y); w.y = pk2(v[j].z * rstd * gg.z, v[j].w * rstd * gg.w); o8[64 * j] = w; }
}

__device__ __forceinline__ void phase_prologue(LAS unsigned char* lds_in, const int wave_in) {
    int lane = lane_id(); asm volatile("" : "+v"(lane)); int wave = wave_in; asm volatile("" : "+s"(wave)); LAS unsigned char* lds = lds_in; asm volatile("" : "+s"(lds));
    const CArgs a = kargs(); unsigned char* ws = a->ws;
    const int G = gridDim.x, vcu = vcu_of(G);
    LAS float* scr = (LAS float*)(lds + wave * 16384);
    const int gw = vcu * NWAVES + wave, NGW = G * NWAVES;
    bf16_t* swa_qkv_t = (bf16_t*)(ws + WS_SWA_QKV_T); bf16_t* swa_wo_t = (bf16_t*)(ws + WS_SWA_WO_T);
    bf16_t* diff_qkv_t = (bf16_t*)(ws + WS_DIFF_QKV_T); bf16_t* diff_wo_t = (bf16_t*)(ws + WS_DIFF_WO_T);
    constexpr int I0 = 16 * 48, I1 = 16 * 32, I2 = 16 * 96, I3 = 16 * 32, IM = 64 * 768, NITEMS = I0 + I1 + I2 + I3 + IM;
    struct TrItem { const float* src; int N; unsigned char* dstb; int ldb; int f8; };
    auto decode = [&](int it) -> TrItem {
        int r = it; const float* W; int N, k0, n0, ldd; bf16_t* dst; bf16_t* mbase = nullptr; int f8 = 0;
        if (r < I0) { const int kb = r / 48, nb = r % 48; W = a->in[I_SWA_QKV]; N = SWA_N; k0 = 64 * kb; n0 = 32 * nb; dst = swa_qkv_t + (size_t)n0 * D; ldd = D; }
        else if ((r -= I0) < I1) { const int kb = r / 32, nb = r % 32; W = a->in[I_SWA_WO]; N = D; k0 = 64 * kb; n0 = 32 * nb; dst = swa_wo_t + (size_t)n0 * D; ldd = D; }
        else if ((r -= I1) < I2) { const int kb = r / 96, nb = r % 96; W = a->in[I_DIFF_QKV]; N = DIFF_N; k0 = 64 * kb; n0 = 32 * nb; dst = diff_qkv_t + (size_t)n0 * D; ldd = D; }
        else if ((r -= I2) < I3) { const int kb = r / 32, nb = r % 32; W = a->in[I_DIFF_WO]; N = D; k0 = 64 * kb; n0 = 32 * nb; dst = diff_wo_t + (size_t)n0 * D; ldd = D; }
        else { r -= I3; const int le = r / 768, q = r % 768;
            bf16_t* gu = (bf16_t*)(ws + WS_WMOE + (size_t)le * 3 * MiB); bf16_t* dn = gu + (size_t)D * D;
            const bool l1 = le >= 32 || F8_L0;
            if (q < 256) { const int kb = q / 16, c0 = 32 * (q % 16); W = a->in[I_GATE] + (size_t)le * D * DEXP; N = DEXP; k0 = 64 * kb; n0 = c0; dst = gu + (size_t)((c0 >> 7) * 256 + (c0 & 127)) * D; ldd = D; mbase = gu; f8 = ((F8_STAGE & 2) && l1); }
            else if (q < 512) { const int qq = q - 256; const int kb = qq / 16, c0 = 32 * (qq % 16); W = a->in[I_UP] + (size_t)le * D * DEXP; N = DEXP; k0 = 64 * kb; n0 = c0; dst = gu + (size_t)((c0 >> 7) * 256 + 128 + (c0 & 127)) * D; ldd = D; mbase = gu; f8 = ((F8_STAGE & 2) && l1); }
            else { const int qq = q - 512; const int kb = qq / 32, nb = qq % 32; W = a->in[I_DOWN] + (size_t)le * DEXP * D; N = D; k0 = 64 * kb; n0 = 32 * nb; dst = dn + (size_t)n0 * DEXP; ldd = DEXP; mbase = dn; f8 = ((F8_STAGE & 1) && l1); } }
        TrItem t; t.src = W + (size_t)(k0 + (lane >> 3)) * N + n0 + (lane & 7) * 4; t.N = N; t.f8 = f8;
        t.dstb = f8 ? (unsigned char*)mbase + (size_t)(dst - mbase) + k0 + 8 * (lane & 7) : (unsigned char*)(dst + k0 + 8 * (lane & 7)); t.ldb = f8 ? ldd : 2 * ldd; return t;
    };
    {
        f32x4 va[8], vb[8]; TrItem ca, cb;
#define TR_LOAD(v, t) do { _Pragma("unroll") for (int i = 0; i < 8; ++i) v[i] = *(const f32x4*)((t).src + (size_t)(8 * i) * (t).N); } while (0)
#define TR_FINISH(v, t) do { \
            _Pragma("unroll") for (int i = 0; i < 8; ++i) { LAS float* p = scr + (8 * i + (lane >> 3)) * 33 + (lane & 7) * 4; p[0] = v[i].x; p[1] = v[i].y; p[2] = v[i].z; p[3] = v[i].w; } \
            LDS_WAIT(); asm volatile("" ::: "memory"); \
            if ((t).f8) { _Pragma("unroll") for (int j = 0; j < 4; ++j) { const int n = (lane >> 3) + 8 * j; const LAS float* s = scr + (8 * (lane & 7)) * 33 + n; \
                u32x2 o8; o8.x = pk4_fp8(64.f * s[0 * 33], 64.f * s[1 * 33], 64.f * s[2 * 33], 64.f * s[3 * 33]); o8.y = pk4_fp8(64.f * s[4 * 33], 64.f * s[5 * 33], 64.f * s[6 * 33], 64.f * s[7 * 33]); \
                *(GAS u32x2*)((t).dstb + (size_t)n * (t).ldb) = o8; } } \
            else { _Pragma("unroll") for (int j = 0; j < 4; ++j) { const int n = (lane >> 3) + 8 * j; const LAS float* s = scr + (8 * (lane & 7)) * 33 + n; \
                u32x4 o; o.x = pk2(s[0 * 33], s[1 * 33]); o.y = pk2(s[2 * 33], s[3 * 33]); o.z = pk2(s[4 * 33], s[5 * 33]); o.w = pk2(s[6 * 33], s[7 * 33]); \
                *(GAS u32x4*)((t).dstb + (size_t)n * (t).ldb) = o; } } \
            LDS_WAIT(); asm volatile("" ::: "memory"); } while (0)
        const int n_my = gw < NITEMS ? (NITEMS - gw + NGW - 1) / NGW : 0;
        if (n_my > 0) { ca = decode(gw); TR_LOAD(va, ca); }
#pragma unroll 1
        for (int j = 0; j < n_my; j += 2) {
            const int j1 = j + 1 < n_my ? j + 1 : n_my - 1, j2 = j + 2 < n_my ? j + 2 : n_my - 1;
            cb = decode(gw + j1 * NGW); TR_LOAD(vb, cb);
            TR_FINISH(va, ca);
            ca = decode(gw + j2 * NGW); TR_LOAD(va, ca);
            if (j + 1 < n_my) { TR_FINISH(vb, cb); }
        }
#undef TR_LOAD
#undef TR_FINISH
    }
    { bf16_t* wr_t = (bf16_t*)(ws + WS_WR); const int gt = gw * 64 + lane, NGT = NGW * 64;
      for (int i = gt; i < 2 * 36 * D; i += NGT) { const int l = i / (36 * D), rem = i % (36 * D), c = rem / D, k = rem % D;
          const float w = c < 4 ? a->in[I_WG][(size_t)l * D * 4 + k * 4 + c] : a->in[I_WR][(size_t)l * D * 32 + k * 32 + (c - 4)];
          const unsigned h = f2bf(w); const float r = w - __uint_as_float(h << 16);
          wr_t[(size_t)l * 2 * 36 * D + rem] = (bf16_t)h; wr_t[(size_t)l * 2 * 36 * D + 36 * D + rem] = (bf16_t)f2bf(r); } }
    bf16_t* XN = (bf16_t*)(ws + WS_XN);
#pragma unroll 1
    for (int mb = gw * 4; mb < M; mb += NGW * 4) {
        const float* xb = a->in[I_X] + (size_t)mb * D; const GAS f32x4* gr = (const GAS f32x4*)a->in[I_NMIX] + lane;
        f32x4 v[4][4];
#pragma unroll
        for (int r = 0; r < 4; ++r)
#pragma unroll
            for (int j = 0; j < 4; ++j) v[r][j] = ((const GAS f32x4*)(xb + (size_t)r * D) + lane)[64 * j];
        f32x4 gg[4];
#pragma unroll
        for (int j = 0; j < 4; ++j) gg[j] = gr[64 * j];
#pragma unroll
        for (int r = 0; r < 4; ++r) { float s = 0.f;
#pragma unroll
            for (int j = 0; j < 4; ++j) s += (v[r][j].x * v[r][j].x + v[r][j].y * v[r][j].y) + (v[r][j].z * v[r][j].z + v[r][j].w * v[r][j].w);
            const float rstd = 1.f / sqrtf(wave_sum(s) * (1.f / D) + 1e-6f);
            GAS u32x2* o8 = (GAS u32x2*)(XN + (size_t)(mb + r) * D) + lane;
#pragma unroll
            for (int j = 0; j < 4; ++j) { const f32x4 n = v[r][j] * rstd * gg[j]; u32x2 w; w.x = pk2(n.x, n.y); w.y = pk2(n.z, n.w); o8[64 * j] = w; } }
    }
}

template <int RV, bool F8OUT>
__device__ __forceinline__ void phase_router(LAS unsigned char* lds_in, int layer, const int wave_in, const bool dry) {
    int lane = lane_id(); asm volatile("" : "+v"(lane)); int wave = wave_in; asm volatile("" : "+s"(wave)); LAS unsigned char* lds = lds_in; asm volatile("" : "+s"(lds));
    const CArgs a = kargs(); unsigned char* ws = a->ws;
    const int G = gridDim.x, vcu = vcu_of(G);
    const int gw = vcu * NWAVES + wave, NGW = G * NWAVES;
    const float* g = a->in[I_NFFN] + layer * D;
    const bf16_t* wth = (const bf16_t*)(ws + WS_WR) + (size_t)layer * 2 * 36 * D; const bf16_t* wtl = wth + 36 * D;
    const float* bg = a->in[I_BG] + layer * 4; const float* br = a->in[I_BR] + layer * 32;
    bf16_t* XN = (bf16_t*)(ws + (dry ? WS_SCR : WS_XN)); const float* xin = a->out; float* rstd_tok = (float*)(ws + (dry ? WS_SCR + 80 * MiB : WS_RSTD));
    unsigned* cnt = (unsigned*)(ws + WS_CTL) + CW_CNT + (dry ? 2 : layer) * 1024;
    int* ltok = (int*)(ws + (dry ? WS_SCR + 64 * MiB : WS_LTOK)); float* lw = (float*)(ws + (dry ? WS_SCR + 68 * MiB : WS_LW)); i32x4* tinfo = (i32x4*)(ws + (dry ? WS_SCR + 72 * MiB : WS_TINFO));
    LAS float* lgs = (LAS float*)(lds + 98304 + wave * 4096);
    LAS float* rsl = lgs + 768;
    const int row = lane & 15, kg = lane >> 4;
    const bool c2ok = row < 4;
    LAS unsigned* lcnt = (LAS unsigned*)(lds + TP_OFF); LAS unsigned* lbase = lcnt + 32;
    const int tid = wave * 64 + lane;
#pragma unroll 1
    for (int bt0 = 0; bt0 < M / 16; bt0 += NGW) {
        const int bt = bt0 + gw; const bool live = bt < M / 16;
        const int t0 = (live ? bt : 0) * 16;
        if (tid < 32) lcnt[tid] = 0u;
        const char* xrow = (const char*)(xin + (size_t)(t0 + row) * D) + kg * 32;
        const char* grow = (const char*)g + kg * 32;
        char* orow = (char*)(XN + (size_t)(t0 + row) * D) + kg * 16;
        const char* w0 = (const char*)(wth + (size_t)row * D) + kg * 16;
        f32x4 acc0 = {0.f, 0.f, 0.f, 0.f}, acc1 = acc0, acc2 = acc0; float ss = 0.f;
        const unsigned m2 = c2ok ? 0xffffffffu : 0u;
        {
            f32x4 xa[3] = {}, xb[3] = {}, ga[3] = {}, gb[3] = {};
            const char* xbase = (const char*)(xin + (size_t)t0 * D); const unsigned xoff = (unsigned)(row * D * 4 + kg * 32);
            const char* gbase = (const char*)g; const unsigned goff = (unsigned)(kg * 32);
            const char* wb0h = (const char*)wth; const char* wb0l = wb0h + 36 * D * 2; const char* wb1h = wb0h + 16 * D * 2; const char* wb1l = wb0h + 52 * D * 2;
            char* obase = live ? (char*)XN + (size_t)t0 * D * (F8OUT ? 1 : 2) : (char*)(ws + WS_SCR + 100 * MiB); const unsigned ooff = F8OUT ? (unsigned)(row * D + kg * 8) : (unsigned)(row * D * 2 + kg * 16);
            const unsigned woff = (unsigned)((row * D + kg * 8) * 2) + (unsigned)wave * 64u, woff2 = (unsigned)(((32 + (row & 3)) * D + kg * 8) * 2) + (unsigned)wave * 64u;
            LAS unsigned char* bfill = lds + wave * 6144 + lane * 16;
            const LAS unsigned char* bread = lds + lane * 16;
            u32x4 fr0, fr1, fr2, fr3, fr4, fr5;
#define RT_BLOAD(c) do { fr0 = *(const u32x4*)(wb0h + woff + (c) * 512); fr1 = *(const u32x4*)(wb0l + woff + (c) * 512); fr2 = *(const u32x4*)(wb1h + woff + (c) * 512); \
            fr3 = *(const u32x4*)(wb1l + woff + (c) * 512); fr4 = *(const u32x4*)(wb0h + woff2 + (c) * 512); fr5 = *(const u32x4*)(wb0l + woff2 + (c) * 512); } while (0)
#define RT_BWRITE(buf) do { fr4.x &= m2; fr4.y &= m2; fr4.z &= m2; fr4.w &= m2; fr5.x &= m2; fr5.y &= m2; fr5.z &= m2; fr5.w &= m2; \
            *(LAS u32x4*)(bfill + (buf) * 49152) = fr0; *(LAS u32x4*)(bfill + (buf) * 49152 + 1024) = fr1; *(LAS u32x4*)(bfill + (buf) * 49152 + 2048) = fr2; \
            *(LAS u32x4*)(bfill + (buf) * 49152 + 3072) = fr3; *(LAS u32x4*)(bfill + (buf) * 49152 + 4096) = fr4; *(LAS u32x4*)(bfill + (buf) * 49152 + 5120) = fr5; } while (0)
#define RT_BAR() asm volatile("s_waitcnt lgkmcnt(0)\n\ts_barrier" ::: "memory")
#define RT_LOAD(st, s) do { if (!(RV & 2)) { xa[st] = *(const f32x4*)(xbase + xoff + (s) * 128); xb[st] = *(const f32x4*)(xbase + xoff + (s) * 128 + 16); } \
            ga[st] = *(const f32x4*)(gbase + goff + (s) * 128); gb[st] = *(const f32x4*)(gbase + goff + (s) * 128 + 16); } while (0)
            RT_BLOAD(0); RT_LOAD(0, 0); RT_LOAD(1, 1);
            RT_BWRITE(0); RT_BLOAD(1);
            RT_BAR();
#pragma unroll
            for (int s = 0; s < 32; ++s) {
                const int st = s % 3, c = s >> 3, sl = s & 7;
                if (sl == 0 && c + 1 < 4) { RT_BWRITE((c + 1) & 1); if (c + 2 < 4) { RT_BLOAD(c + 2); } }
                if (s + 2 < 32) { RT_LOAD((s + 2) % 3, s + 2); }
                __builtin_amdgcn_sched_barrier(0);
                const LAS unsigned char* bp = bread + (c & 1) * 49152 + sl * 6144;
                const bf16x8 b0h = *(const LAS bf16x8*)(bp), b0l = *(const LAS bf16x8*)(bp + 1024), b1h = *(const LAS bf16x8*)(bp + 2048), b1l = *(const LAS bf16x8*)(bp + 3072),
                             b2h = *(const LAS bf16x8*)(bp + 4096), b2l = *(const LAS bf16x8*)(bp + 5120);
                const f32x4 xa_ = xa[st], xb_ = xb[st];
                ss += (xa_.x * xa_.x + xa_.y * xa_.y) + (xa_.z * xa_.z + xa_.w * xa_.w) + (xb_.x * xb_.x + xb_.y * xb_.y) + (xb_.z * xb_.z + xb_.w * xb_.w);
                const f32x4 ya = xa_ * ga[st], yb = xb_ * gb[st];
                u32x4 hi; hi.x = cvtpk(ya.x, ya.y); hi.y = cvtpk(ya.z, ya.w); hi.z = cvtpk(yb.x, yb.y); hi.w = cvtpk(yb.z, yb.w);
                u32x4 lo; lo.x = cvtpk(ya.x - __uint_as_float(hi.x << 16), ya.y - __uint_as_float(hi.x & 0xffff0000u)); lo.y = cvtpk(ya.z - __uint_as_float(hi.y << 16), ya.w - __uint_as_float(hi.y & 0xffff0000u));
                lo.z = cvtpk(yb.x - __uint_as_float(hi.z << 16), yb.y - __uint_as_float(hi.z & 0xffff0000u)); lo.w = cvtpk(yb.z - __uint_as_float(hi.w << 16), yb.w - __uint_as_float(hi.w & 0xffff0000u));
                if constexpr (F8OUT) { u32x2 q8; q8.x = pk4_fp8(4.f * ya.x, 4.f * ya.y, 4.f * ya.z, 4.f * ya.w); q8.y = pk4_fp8(4.f * yb.x, 4.f * yb.y, 4.f * yb.z, 4.f * yb.w); *(u32x2*)(obase + ooff + s * 32) = q8; }
                else if (!(RV & 1)) *(u32x4*)(obase + ooff + s * 64) = hi;
                const bf16x8 ah = __builtin_bit_cast(bf16x8, hi), al = __builtin_bit_cast(bf16x8, lo);
                acc0 = __builtin_amdgcn_mfma_f32_16x16x32_bf16(ah, b0h, acc0, 0, 0, 0); acc0 = __builtin_amdgcn_mfma_f32_16x16x32_bf16(ah, b0l, acc0, 0, 0, 0); acc0 = __builtin_amdgcn_mfma_f32_16x16x32_bf16(al, b0h, acc0, 0, 0, 0);
                acc1 = __builtin_amdgcn_mfma_f32_16x16x32_bf16(ah, b1h, acc1, 0, 0, 0); acc1 = __builtin_amdgcn_mfma_f32_16x16x32_bf16(ah, b1l, acc1, 0, 0, 0); acc1 = __builtin_amdgcn_mfma_f32_16x16x32_bf16(al, b1h, acc1, 0, 0, 0);
                acc2 = __builtin_amdgcn_mfma_f32_16x16x32_bf16(ah, b2h, acc2, 0, 0, 0); acc2 = __builtin_amdgcn_mfma_f32_16x16x32_bf16(ah, b2l, acc2, 0, 0, 0); acc2 = __builtin_amdgcn_mfma_f32_16x16x32_bf16(al, b2h, acc2, 0, 0, 0);
                __builtin_amdgcn_sched_barrier(0);
                if (sl == 7 && c + 1 < 4) { RT_BAR(); }
            }
            RT_BAR();
#undef RT_LOAD
#undef RT_BLOAD
#undef RT_BWRITE
#undef RT_BAR
        }
        ss += __shfl_xor(ss, 16); ss += __shfl_xor(ss, 32);
        const float rstd = 1.f / sqrtf(ss * (1.f / D) + 1e-6f);
        if (kg == 0) { rsl[row] = rstd; if (live) rstd_tok[t0 + row] = rstd; }
#pragma unroll
        for (int j = 0; j < 4; ++j) { lgs[(4 * kg + j) * 48 + row] = acc0[j]; lgs[(4 * kg + j) * 48 + 16 + row] = acc1[j]; lgs[(4 * kg + j) * 48 + 32 + row] = acc2[j]; }
        LDS_WAIT(); asm volatile("" ::: "memory");
        int e1 = 0, e2 = 0, lp1 = 0, lp2 = 0; float w1 = 0.f, w2 = 0.f;
        const bool act = live && lane < 16 && !(RV & 4);
        __syncthreads();
        if (act) {
            const float rs = rsl[lane];
            float acc[36];
#pragma unroll
            for (int q = 0; q < 9; ++q) { const f32x4 x = *(const LAS f32x4*)(lgs + lane * 48 + 4 * q); acc[4 * q] = x.x * rs; acc[4 * q + 1] = x.y * rs; acc[4 * q + 2] = x.z * rs; acc[4 * q + 3] = x.w * rs; }
            float lgv[4]; int gs = 0;
#pragma unroll
            for (int c = 0; c < 4; ++c) lgv[c] = acc[c] + bg[c];
            float mx = lgv[0];
#pragma unroll
            for (int c = 1; c < 4; ++c) if (lgv[c] > mx) { mx = lgv[c]; gs = c; }
            float den = 0.f;
#pragma unroll
            for (int c = 0; c < 4; ++c) den += __expf(lgv[c] - mx);
            const float pg = 1.f / den;
            float le[8];
#pragma unroll
            for (int k = 0; k < 8; ++k) { const float a0 = acc[4 + k] + br[k], a1 = acc[12 + k] + br[8 + k], a2 = acc[20 + k] + br[16 + k], a3 = acc[28 + k] + br[24 + k];
                le[k] = gs == 0 ? a0 : (gs == 1 ? a1 : (gs == 2 ? a2 : a3)); }
            int i1 = 0; float m1 = le[0];
#pragma unroll
            for (int k = 1; k < 8; ++k) if (le[k] > m1) { m1 = le[k]; i1 = k; }
            int i2 = -1; float m2 = -INFINITY;
#pragma unroll
            for (int k = 0; k < 8; ++k) if (k != i1 && (i2 < 0 || le[k] > m2)) { m2 = le[k]; i2 = k; }
            const float ex = __expf(m2 - m1); const float tp1 = 1.f / (1.f + ex), tp2 = ex * tp1;
            w1 = pg * tp1; w2 = pg * tp2; e1 = gs * 8 + i1; e2 = gs * 8 + i2;
            lp1 = (int)__hip_atomic_fetch_add(lcnt + e1, 1u, __ATOMIC_RELAXED, __HIP_MEMORY_SCOPE_WORKGROUP);
            lp2 = (int)__hip_atomic_fetch_add(lcnt + e2, 1u, __ATOMIC_RELAXED, __HIP_MEMORY_SCOPE_WORKGROUP);
        }
        __syncthreads();
        if (tid < 32) { const unsigned c = lcnt[tid]; lbase[tid] = c ? __hip_atomic_fetch_add(cnt + 32 * tid, c, __ATOMIC_RELAXED, __HIP_MEMORY_SCOPE_AGENT) : 0u; }
        __syncthreads();
        if (act) {
            const int t = t0 + lane; const int p1 = (int)lbase[e1] + lp1, p2 = (int)lbase[e2] + lp2;
            ltok[(size_t)e1 * M + p1] = t; lw[(size_t)e1 * M + p1] = w1; ltok[(size_t)e2 * M + p2] = t; lw[(size_t)e2 * M + p2] = w2;
            tinfo[t] = (i32x4){e1, p1, e2, p2};
        }
        LDS_WAIT(); asm volatile("" ::: "memory");
        __syncthreads();
    }
}

__device__ __forceinline__ void moe_tables(LAS unsigned char* lds, unsigned char* ws, int layer, const int wave, const int lane) {
    LAS int* TP = (LAS int*)(lds + TP_OFF); LAS int* CNT = TP + 40;
    unsigned* cnt = (unsigned*)(ws + WS_CTL) + CW_CNT + layer * 1024;
    const int tid = wave * 64 + lane;
    __syncthreads();
    if (tid < 32) CNT[tid] = (int)__hip_atomic_load(cnt + 32 * tid, RLX_AGENT);
    __syncthreads();
    if (tid == 0) { int s = 0; for (int e = 0; e < 32; ++e) { TP[e] = s; s += (CNT[e] + 255) >> 8; } TP[32] = s; }
    __syncthreads();
}

__device__ __forceinline__ void phase_combine(LAS unsigned char* lds_in, int layer, const int wave_in, const bool dry) {
    int lane = lane_id(); asm volatile("" : "+v"(lane)); int wave = wave_in; asm volatile("" : "+s"(wave)); LAS unsigned char* lds = lds_in; asm volatile("" : "+s"(lds));
    const CArgs a = kargs(); unsigned char* ws = a->ws;
    moe_tables(lds, ws, layer, wave, lane);
    const bool final_ = layer == 1; const float* gnext = layer == 0 ? a->in[I_NMIX] + D : a->in[I_FNORM]; float* xio = a->out;
    const int G = gridDim.x, vcu = vcu_of(G);
    const int gw = vcu * NWAVES + wave, NGW = G * NWAVES;
    const LAS int* TP = (const LAS int*)(lds + TP_OFF);
    const bf16_t* Y = (const bf16_t*)(ws + WS_Y); const i32x4* tinfo = (const i32x4*)(ws + WS_TINFO); bf16_t* XN = (bf16_t*)(ws + WS_XN);
#pragma unroll 1
    for (int tb = gw * 4; tb < M; tb += NGW * 4) {
        size_t s1[4], s2[4];
#pragma unroll
        for (int r = 0; r < 4; ++r) { const i32x4 ti = tinfo[tb + r]; s1[r] = (size_t)TP[ti.x] * 256 + ti.y; s2[r] = (size_t)TP[ti.z] * 256 + ti.w; }
        f32x4 v[4][4]; u32x2 p[4][4], q[4][4];
#pragma unroll
        for (int r = 0; r < 4; ++r) {
            const GAS f32x4* xr = (const GAS f32x4*)(xio + (size_t)(tb + r) * D) + lane;
            const GAS u32x2* y1 = (const GAS u32x2*)(Y + s1[r] * D) + lane; const GAS u32x2* y2 = (const GAS u32x2*)(Y + s2[r] * D) + lane;
#pragma unroll
            for (int j = 0; j < 4; ++j) { v[r][j] = xr[64 * j]; p[r][j] = y1[64 * j]; q[r][j] = y2[64 * j]; }
        }
        f32x4 gg[4];
#pragma unroll
        for (int j = 0; j < 4; ++j) gg[j] = ((const GAS f32x4*)gnext + lane)[64 * j];
#pragma unroll
        for (int r = 0; r < 4; ++r) {
            float s = 0.f;
#pragma unroll
            for (int j = 0; j < 4; ++j) { const u32x2 pp = p[r][j], qq = q[r][j];
                f32x4 ya, yb; ya.x = __uint_as_float(pp.x << 16); ya.y = __uint_as_float(pp.x & 0xffff0000u); ya.z = __uint_as_float(pp.y << 16); ya.w = __uint_as_float(pp.y & 0xffff0000u);
                yb.x = __uint_as_float(qq.x << 16); yb.y = __uint_as_float(qq.x & 0xffff0000u); yb.z = __uint_as_float(qq.y << 16); yb.w = __uint_as_float(qq.y & 0xffff0000u);
                v[r][j] = v[r][j] + (ya + yb); s += (v[r][j].x * v[r][j].x + v[r][j].y * v[r][j].y) + (v[r][j].z * v[r][j].z + v[r][j].w * v[r][j].w); }
            const float rstd = 1.f / sqrtf(wave_sum(s) * (1.f / D) + 1e-6f);
            GAS f32x4* xw = (GAS f32x4*)(xio + (size_t)(tb + r) * D) + lane;
            if (final_) {
#pragma unroll
                for (int j = 0; j < 4; ++j) if (!dry) xw[64 * j] = v[r][j] * rstd * gg[j];
            } else {
                GAS u32x2* o8 = (GAS u32x2*)(XN + (size_t)(tb + r) * D) + lane;
#pragma unroll
                for (int j = 0; j < 4; ++j) { if (!dry) xw[64 * j] = v[r][j]; const f32x4 n = v[r][j] * rstd * gg[j]; u32x2 w; w.x = pk2(n.x, n.y); w.y = pk2(n.z, n.w); o8[64 * j] = w; }
            }
        }
    }
}

__device__ __forceinline__ float diff_lambda_full(const float* lam, int lane) {
    const float a = wave_sum(lam[lane] * lam[64 + lane]), b = wave_sum(lam[128 + lane] * lam[192 + lane]);
    return __expf(a) - __expf(b) + LAMBDA_INIT;
}

__device__ __forceinline__ void phase_qkv(LAS unsigned char* lds_in, int layer, const int wave_in) {
    int lane = lane_id(); asm volatile("" : "+v"(lane)); int wave = wave_in; asm volatile("" : "+s"(wave)); LAS unsigned char* lds = lds_in; asm volatile("" : "+s"(lds));
    const CArgs a = kargs(); unsigned char* ws = a->ws;
    const int N = layer == 0 ? SWA_N : DIFF_N;
    pg8::Gemm g{(const bf16_t*)(ws + WS_XN), (const bf16_t*)(ws + (layer == 0 ? WS_SWA_QKV_T : WS_DIFF_QKV_T)), D};
    pg8::DenseOrder S; S.init(M, N, (int)gridDim.x, (int)blockIdx.x);
    pg8::EpiQKV E{(bf16_t*)(ws + WS_QKV), N, 1024, QSCALE, layer == 1 ? (unsigned*)(ws + WS_CTL) + CW_KMAX : nullptr};
    pg8::gemm_phase<pg8::EpiQKV, pg8::DenseOrder, false, true>(lds, g, S, E, wave, lane);
}
__device__ __forceinline__ void phase_oproj(LAS unsigned char* lds_in, int layer, const int wave_in) {
    int lane = lane_id(); asm volatile("" : "+v"(lane)); int wave = wave_in; asm volatile("" : "+s"(wave)); LAS unsigned char* lds = lds_in; asm volatile("" : "+s"(lds));
    const CArgs a = kargs(); unsigned char* ws = a->ws;
    pg8::Gemm g{(const bf16_t*)(ws + WS_O), (const bf16_t*)(ws + (layer == 0 ? WS_SWA_WO_T : WS_DIFF_WO_T)), D};
    pg8::DenseOrder S; S.init(M, D, (int)gridDim.x, (int)blockIdx.x);
    pg8::EpiResid E{layer == 0 ? a->in[I_X] : (const float*)a->out, a->out};
    pg8::gemm_phase<pg8::EpiResid, pg8::DenseOrder, false, true>(lds, g, S, E, wave, lane);
}
__device__ __forceinline__ void phase_moe1(LAS unsigned char* lds_in, int layer, const int wave_in) {
    int lane = lane_id(); asm volatile("" : "+v"(lane)); int wave = wave_in; asm volatile("" : "+s"(wave)); LAS unsigned char* lds = lds_in; asm volatile("" : "+s"(lds));
    const CArgs a = kargs(); unsigned char* ws = a->ws;
    moe_tables(lds, ws, layer, wave, lane);
    const LAS int* TP = (const LAS int*)(lds + TP_OFF); const LAS int* CNT = TP + 40;
    if ((F8_STAGE & 2) && (layer == 1 || F8_L0)) {
        pg8::Gemm g{(const bf16_t*)(ws + WS_XN), (const bf16_t*)(ws + WS_WMOE + (size_t)layer * 96 * MiB), D / 2, 0x79797979u, 0x7d7d7d7du};
        pg8::MoeOrder S{TP, CNT, (const int*)(ws + WS_LTOK), (int)gridDim.x, (int)blockIdx.x, 12, 0};
        if (F8_STAGE & 1) { pg8::EpiSwiGLU<true> E{(bf16_t*)(ws + WS_H), (const int*)(ws + WS_LTOK), (const float*)(ws + WS_RSTD), CNT};
            pg8::gemm_phase<pg8::EpiSwiGLU<true>, pg8::MoeOrder, true, true, true>(lds, g, S, E, wave, relaunder(lane)); }
        else { pg8::EpiSwiGLU<false> E{(bf16_t*)(ws + WS_H), (const int*)(ws + WS_LTOK), (const float*)(ws + WS_RSTD), CNT};
            pg8::gemm_phase<pg8::EpiSwiGLU<false>, pg8::MoeOrder, true, true, true>(lds, g, S, E, wave, relaunder(lane)); }
    } else if ((F8_STAGE & 1) && layer == 1) {
        pg8::Gemm g{(const bf16_t*)(ws + WS_XN), (const bf16_t*)(ws + WS_WMOE + (size_t)layer * 96 * MiB), D};
        pg8::MoeOrder S{TP, CNT, (const int*)(ws + WS_LTOK), (int)gridDim.x, (int)blockIdx.x, 6, 0};
        pg8::EpiSwiGLU<true> E{(bf16_t*)(ws + WS_H), (const int*)(ws + WS_LTOK), (const float*)(ws + WS_RSTD), CNT};
        pg8::gemm_phase<pg8::EpiSwiGLU<true>, pg8::MoeOrder, true, true>(lds, g, S, E, wave, relaunder(lane));
    } else {
        pg8::Gemm g{(const bf16_t*)(ws + WS_XN), (const bf16_t*)(ws + WS_WMOE + (size_t)layer * 96 * MiB), D};
        pg8::MoeOrder S{TP, CNT, (const int*)(ws + WS_LTOK), (int)gridDim.x, (int)blockIdx.x, 6, 0};
        pg8::EpiSwiGLU<false> E{(bf16_t*)(ws + WS_H), (const int*)(ws + WS_LTOK), (const float*)(ws + WS_RSTD), CNT};
        pg8::gemm_phase<pg8::EpiSwiGLU<false>, pg8::MoeOrder, true, true>(lds, g, S, E, wave, relaunder(lane));
    }
}
__device__ __forceinline__ void phase_moe2(LAS unsigned char* lds_in, int layer, const int wave_in) {
    int lane = lane_id(); asm volatile("" : "+v"(lane)); int wave = wave_in; asm volatile("" : "+s"(wave)); LAS unsigned char* lds = lds_in; asm volatile("" : "+s"(lds));
    const CArgs a = kargs(); unsigned char* ws = a->ws;
    moe_tables(lds, ws, layer, wave, lane);
    const LAS int* TP = (const LAS int*)(lds + TP_OFF); const LAS int* CNT = TP + 40;
    pg8::EpiDown E{(bf16_t*)(ws + WS_Y), (const float*)(ws + WS_LW)};
    if ((F8_STAGE & 1) && layer == 1) {
        pg8::Gemm g{(const bf16_t*)(ws + WS_H), (const bf16_t*)(ws + WS_WMOE + (size_t)layer * 96 * MiB), DEXP / 2, 0x79797979u, 0x7c7c7c7cu};
        pg8::MoeOrder S{TP, CNT, (const int*)(ws + WS_LTOK), (int)gridDim.x, (int)blockIdx.x, 24, 16};
        pg8::gemm_phase<pg8::EpiDown, pg8::MoeOrder, false, true, true>(lds, g, S, E, wave, relaunder(lane));
    } else {
        pg8::Gemm g{(const bf16_t*)(ws + WS_H), (const bf16_t*)(ws + WS_WMOE + (size_t)layer * 96 * MiB), DEXP};
        pg8::MoeOrder S{TP, CNT, (const int*)(ws + WS_LTOK), (int)gridDim.x, (int)blockIdx.x, 12, 8};
        pg8::gemm_phase<pg8::EpiDown, pg8::MoeOrder, false, true>(lds, g, S, E, wave, relaunder(lane));
    }
}
__device__ __forceinline__ void phase_attn(LAS unsigned char* lds_in, int layer, const int wave_in, const bool dry) {
    int lane = lane_id(); asm volatile("" : "+v"(lane)); int wave = wave_in; asm volatile("" : "+s"(wave)); LAS unsigned char* lds = lds_in; asm volatile("" : "+s"(lds));
    const CArgs a = kargs(); unsigned char* ws = a->ws;
    const int G = gridDim.x, vcu = vcu_of(G);
    const bf16_t* QKV = (const bf16_t*)(ws + WS_QKV); bf16_t* OB = (bf16_t*)(ws + WS_O);
    if (layer == 0) {
        att::DiffConsts dc{0.f, nullptr, 0.f, 0.f, 0.f, 0.f}; const float* sink = a->in[I_SWA_SINK];
#pragma unroll 1
        for (int i = 0; i < 2048; ++i) { const int id = vcu + G * i; if (id >= 2048) break; const int bk = id >> 7, qb = id & 127;
            att::attn_unit<0>(bk >> 2, bk & 3, qb, QKV, OB, sink, dc, lds, wave, lane); }
    } else {
        const float* sg = a->in[I_DIFF_SUBLN] + (lane & 31); const float sgs = 1.f - LAMBDA_INIT;
        att::DiffConsts dc{diff_lambda_full(a->in[I_DIFF_LAM], lane), a->in[I_DIFF_SUBLN], sg[0] * sgs, sg[32] * sgs, sg[64] * sgs, sg[96] * sgs};
        const unsigned* kmaxsq = (const unsigned*)(ws + WS_CTL) + CW_KMAX;
#pragma unroll 1
        for (int i = 0; i < 2048; ++i) { const int id = vcu + G * i; if (id >= 2048) break; const int h = id >> 8, bq = id & 255, b = bq >> 6;
            const int qb = ((0xD8 >> h) & 1) ? ((bq + 32) & 63) : (bq & 63);
            const int cm = wave >> 2, gi = b * 32 + 2 * (2 * h + cm);
            const float kmax = sqrtf(__uint_as_float(__hip_atomic_load(kmaxsq + gi, RLX_AGENT)) + __uint_as_float(__hip_atomic_load(kmaxsq + gi + 1, RLX_AGENT))) * 1.01f;
            if (ATT_PROBE_VARIANT != 0 && dry) att::diff_unit<ATT_PROBE_VARIANT>(b, h, qb, QKV, (bf16_t*)(ws + WS_XN), kmax, dc, lds, wave, lane);
            else att::diff_unit<0>(b, h, qb, QKV, OB, kmax, dc, lds, wave, lane); }
    }
}

__global__ void __launch_bounds__(NWAVES * 64, 2) mega_fwd(Args args_by_value) {
    extern __shared__ __attribute__((aligned(16))) unsigned char lds_raw[];
    LAS unsigned char* lds = (LAS unsigned char*)lds_raw;
    const int wave = __builtin_amdgcn_readfirstlane((int)(threadIdx.x >> 6));
    int lo, hi;
    { const CArgs a = kargs(); lo = a->ph_lo; hi = a->ph_hi;
      if (a->use_cg) cg::this_grid().sync(); }
    { const int tid = wave * 64 + lane_id();
      for (int u = tid; u < (LDS_BYTES - LDSCTL_OFF) / 4; u += NWAVES * 64) ((LAS unsigned*)(lds + LDSCTL_OFF))[u] = 0u; }
    __syncthreads();
    if (N_LAUNCHES == 1) { const CArgs a = kargs(); (void)xcd_barrier_post((unsigned*)(a->ws + WS_CTL) + CW_BAR, (volatile LAS unsigned*)(lds + MISC_OFF) + 8, wave == 0 && lane_id() == 0); }
    int rep_left = REP_COUNT;
    unsigned long long tp_prev = 0, tp_acc = 0;
    if (TPROBE_MASK != 0) tp_prev = __builtin_amdgcn_s_memrealtime();
#pragma unroll 1
    for (int ph = lo; ph < hi; ++ph) {
        const int layer = ph >= 8 ? 1 : 0, kind = ph == 0 ? 0 : ph - 7 * layer;
        const bool dry = REP_COUNT > 0 && ph == REP_PHASE && rep_left > 0;
        switch (kind) {
            case 0: phase_prologue(lds, wave); break;
            case 1: phase_qkv(lds, layer, wave); break;
            case 2: phase_attn(lds, layer, wave, dry); break;
            case 3: phase_oproj(lds, layer, wave); break;
            case 4: if (ROUTER_PROBE != 0 && dry) phase_router<ROUTER_PROBE, false>(lds, layer, wave, dry); else if ((F8_STAGE & 2) && (layer == 1 || F8_L0)) phase_router<0, true>(lds, layer, wave, dry); else phase_router<0, false>(lds, layer, wave, dry); break;
            case 5: phase_moe1(lds, layer, wave); break;
            case 6: phase_moe2(lds, layer, wave); break;
            default: phase_combine(lds, layer, wave, dry); break;
        }
        if (ph + 1 < hi) { const CArgs a = kargs(); XcdBarrier bar; bar.bar = (unsigned*)(a->ws + WS_CTL) + CW_BAR; bar.x = xb_xcc_id(); bar.st = (volatile LAS unsigned*)(lds + MISC_OFF) + 8;
            xcd_barrier(bar, wave == 0 && lane_id() == 0);
        }
        if (TPROBE_MASK != 0) { const unsigned long long tn = __builtin_amdgcn_s_memrealtime(); if ((TPROBE_MASK >> ph) & 1) tp_acc += tn - tp_prev; tp_prev = tn; }
        if (REP_COUNT > 0 && ph == REP_PHASE && rep_left > 0) { --rep_left; --ph; }
        if (EXTRA_BARRIERS > 0 && ph == 3) { for (int xb = 0; xb < EXTRA_BARRIERS; ++xb) { const CArgs a = kargs(); XcdBarrier bar; bar.bar = (unsigned*)(a->ws + WS_CTL) + CW_BAR; bar.x = xb_xcc_id(); bar.st = (volatile LAS unsigned*)(lds + MISC_OFF) + 8; xcd_barrier(bar, wave == 0 && lane_id() == 0); } }
    }
    if (TPROBE_MASK != 0 && blockIdx.x == 0 && wave == 0) { const unsigned long long t0 = __builtin_amdgcn_s_memrealtime(); while (__builtin_amdgcn_s_memrealtime() - t0 < TPROBE_K * tp_acc) __builtin_amdgcn_s_sleep(8); }
}

extern "C" void kernel_launch(void* const* d_in, const int* in_sizes, int n_in, void* d_out, int out_size, void* d_ws, size_t ws_size, hipStream_t stream) {
    static int grid = 0;
    if (grid == 0) {
        if (n_in != 18 || in_sizes[0] != M * D || out_size != M * D || ws_size < WS_END) {
            fprintf(stderr, "kernel_launch: unexpected shapes: n_in %d in0 %d out %d ws %zu (need %zu)\n", n_in, n_in > 0 ? in_sizes[0] : -1, out_size, ws_size, (size_t)WS_END); grid = -1; return; }
        int dev = 0, cus = 0, per_cu = 0;
        if (hipGetDevice(&dev) != hipSuccess || hipDeviceGetAttribute(&cus, hipDeviceAttributeMultiprocessorCount, dev) != hipSuccess) { fprintf(stderr, "kernel_launch: device query failed\n"); grid = -1; return; }
        if (hipFuncSetAttribute((const void*)mega_fwd, hipFuncAttributeMaxDynamicSharedMemorySize, LDS_BYTES) != hipSuccess) { fprintf(stderr, "kernel_launch: hipFuncSetAttribute failed\n"); grid = -1; return; }
        if (hipOccupancyMaxActiveBlocksPerMultiprocessor(&per_cu, (const void*)mega_fwd, NWAVES * 64, LDS_BYTES) != hipSuccess || per_cu < 1) { fprintf(stderr, "kernel_launch: occupancy query says %d\n", per_cu); per_cu = 1; }
        (void)hipGetLastError();
        grid = cus;
    }
    if (grid < 0) return;
    (void)hipMemsetAsync((char*)d_ws + WS_CTL, 0, CTL_ZERO_BYTES, stream);
    Args a{};
    for (int i = 0; i < 18; ++i) a.in[i] = (const float*)d_in[i];
    a.out = (float*)d_out; a.ws = (unsigned char*)d_ws; a.use_cg = 0; a.pad = 0;
    if (N_LAUNCHES == 1) {
        a.ph_lo = 0; a.ph_hi = N_PHASES;
        void* kargs_[] = {&a};
        hipError_t e = hipLaunchCooperativeKernel((const void*)mega_fwd, dim3(grid), dim3(NWAVES * 64), kargs_, LDS_BYTES, stream);
        if (e != hipSuccess) fprintf(stderr, "kernel_launch: cooperative launch failed: %s (grid %d)\n", hipGetErrorString(e), grid);
    } else {
        for (int p = 0; p < N_PHASES; ++p) { a.ph_lo = p; a.ph_hi = p + 1; hipLaunchKernelGGL(mega_fwd, dim3(grid), dim3(NWAVES * 64), LDS_BYTES, stream, a); }
    }
}
```

```cpp
#include <hip/hip_runtime.h>
#include <hip/hip_cooperative_groups.h>
#include <cstdio>
#include <cstdint>
namespace cg = cooperative_groups;

#ifndef MK_N_LAUNCHES
#define MK_N_LAUNCHES 1
#endif
constexpr int N_PHASES = 15;
#define F8_STAGE 2
#define F8_L0 1
#define F8_QKV 2
#define REP_PHASE -1
#define REP_COUNT 0
#define ATT_PROBE_VARIANT 0
#define EXTRA_BARRIERS 0
#define ROUTER_PROBE 0
#define TPROBE_MASK 0
#define TPROBE_K 4
constexpr int N_LAUNCHES = MK_N_LAUNCHES;

#define LAS __attribute__((address_space(3)))
#define GAS __attribute__((address_space(1)))
typedef unsigned short bf16_t;
typedef short bf16x8 __attribute__((ext_vector_type(8)));
typedef short s16x4 __attribute__((ext_vector_type(4)));
typedef float f32x2 __attribute__((ext_vector_type(2)));
typedef float f32x4 __attribute__((ext_vector_type(4)));
typedef float f32x16 __attribute__((ext_vector_type(16)));
typedef unsigned u32x2 __attribute__((ext_vector_type(2)));
typedef unsigned u32x4 __attribute__((ext_vector_type(4)));
typedef int i32x4 __attribute__((ext_vector_type(4)));
typedef int i32x8 __attribute__((ext_vector_type(8)));
typedef __bf16 bf16x2_t __attribute__((ext_vector_type(2)));

constexpr int D = 1024, BATCH = 4, SEQ = 8192, M = BATCH * SEQ;
constexpr int SWA_N = 1536, DIFF_N = 3072;
constexpr int NEXP = 32, DEXP = 512;
constexpr float LOG2E = 1.4426950408889634f;
constexpr float QSCALE = 0.125f * LOG2E;
constexpr float LAMBDA_INIT = 0.35550906759f;
constexpr int NWAVES = 8;

constexpr size_t MiB = 1u << 20;
constexpr size_t WS_CTL = 0, CTL_ZERO_BYTES = 1 * MiB;
constexpr size_t WS_SWA_QKV_T = 1 * MiB, WS_SWA_WO_T = 4 * MiB, WS_DIFF_QKV_T = 6 * MiB, WS_DIFF_WO_T = 12 * MiB;
constexpr size_t WS_WR = 14 * MiB;
constexpr size_t WS_RSTD = 14 * MiB + 512 * 1024;
constexpr size_t WS_LTOK = 15 * MiB, WS_LW = 19 * MiB, WS_TINFO = 23 * MiB;
constexpr size_t WS_WMOE = 24 * MiB;
constexpr size_t WS_XN = 216 * MiB;
constexpr size_t WS_SCR = 280 * MiB;
constexpr size_t WS_QKV = WS_SCR, WS_O = WS_SCR + 192 * MiB, WS_Y = WS_SCR, WS_H = WS_SCR + 144 * MiB;
constexpr size_t WS_END = 536 * MiB;
constexpr int CW_BAR = 4096;
constexpr int CW_CNT = 16384;
constexpr int CW_KMAX = 24576;

constexpr int RING_BYTES = 131072;
constexpr int LDSCTL_OFF = RING_BYTES;
constexpr int MISC_OFF = LDSCTL_OFF + 320;
constexpr int TP_OFF = LDSCTL_OFF + 1024;
constexpr int STASH_OFF = LDSCTL_OFF + 2048;
constexpr int LDS_BYTES = 147456;

__device__ __forceinline__ unsigned f2bf(float f) { unsigned u = __builtin_bit_cast(unsigned, f); return (u + 0x7fffu + ((u >> 16) & 1u)) >> 16; }
__device__ __forceinline__ unsigned pk2(float lo, float hi) { return f2bf(lo) | (f2bf(hi) << 16); }
__device__ __forceinline__ unsigned cvtpk(float lo, float hi) { f32x2 v = {lo, hi}; bf16x2_t b = __builtin_convertvector(v, bf16x2_t); return __builtin_bit_cast(unsigned, b); }
__device__ __forceinline__ unsigned pk4_fp8(float a, float b, float c, float d) {
    a = __builtin_fminf(__builtin_fmaxf(a, -448.f), 448.f); b = __builtin_fminf(__builtin_fmaxf(b, -448.f), 448.f); c = __builtin_fminf(__builtin_fmaxf(c, -448.f), 448.f); d = __builtin_fminf(__builtin_fmaxf(d, -448.f), 448.f);
    int r = 0; r = __builtin_amdgcn_cvt_pk_fp8_f32(a, b, r, false); r = __builtin_amdgcn_cvt_pk_fp8_f32(c, d, r, true); return (unsigned)r; }
__device__ __forceinline__ float bf2f(unsigned short h) { return __builtin_bit_cast(float, (unsigned)h << 16); }
__device__ __forceinline__ int relaunder(int x) { asm volatile("" : "+v"(x)); return x; }
__device__ __forceinline__ int lane_id() { return (int)__builtin_amdgcn_mbcnt_hi(~0u, __builtin_amdgcn_mbcnt_lo(~0u, 0u)); }
__device__ __forceinline__ float wave_sum(float v) {
#pragma unroll
    for (int o = 1; o < 64; o <<= 1) v += __shfl_xor(v, o);
    return v;
}

namespace pg8 {
constexpr int BM = 256, BK = 64, HALF = 128, HTB = HALF * BK * 2, STAGE_BYTES = 8 * HTB, NXCD = 8, WGM = 8;
__host__ __device__ __forceinline__ int lds_byte(int r, int c) { const int st = (r >> 4) * 2 + (c >> 5), rr = r & 15, cc = c & 31, ob = rr * 64 + cc * 2; return st * 1024 + (ob ^ (((ob >> 9) & 1) << 5)); }
__host__ __device__ __forceinline__ void stage_rc(int b, int& R, int& C) { const int st = b / 1024, sb = b % 1024, swz = sb ^ (((sb >> 9) & 1) << 5); R = (st >> 1) * 16 + swz / 64; C = (st & 1) * 32 + (swz % 64) / 2; }
__host__ __device__ __forceinline__ int perm32(int rho) { const int n = rho >> 4, i = rho & 15; return 8 * (i >> 2) + 4 * n + (i & 3); }

struct Unit { int pm, pn, e, t, pnl; };
struct Gemm { const bf16_t* A; const bf16_t* Bt; int K; unsigned sw = 0x7f7f7f7fu, sx = 0x7f7f7f7fu; };

struct DenseOrder {
    int nM, nN, nwg, G, c;
    __device__ void init(int Mr, int N, int G_, int c_) { nM = Mr / BM; nN = N / BM; nwg = nM * nN; G = G_; c = c_; }
    __device__ bool next(int i, Unit& u) const {
        const long L = (long)i * G + c; if (L >= nwg) return false;
        int wgid = (int)L; { const int q = nwg / NXCD, r = nwg % NXCD, xcd = wgid % NXCD, off = wgid / NXCD; wgid = (xcd < r ? xcd * (q + 1) : r * (q + 1) + (xcd - r) * q) + off; }
        const int nig = WGM * nN, gid = wgid / nig, fm = gid * WGM, gsz = (nM - fm) < WGM ? (nM - fm) : WGM;
        u.pm = fm + ((wgid % nig) % gsz); u.pn = (wgid % nig) / gsz; u.e = 0; u.t = 0; u.pnl = u.pn; return true;
    }
    __device__ __forceinline__ int token(const Unit&, int) const { return 0; }
};
struct MoeOrder {
    const LAS int* TP; const LAS int* CNT; const int* ltok; int G, c, pn_mul, pn_add;
    __device__ bool next(int i, Unit& u) const {
        const int ntile = __builtin_amdgcn_readfirstlane(TP[32]); const int nwg = ntile * 4;
        const long L = (long)i * G + c; if (L >= nwg) return false;
        int wgid = (int)L; { const int q = nwg / NXCD, r = nwg % NXCD, xcd = wgid % NXCD, off = wgid / NXCD; wgid = (xcd < r ? xcd * (q + 1) : r * (q + 1) + (xcd - r) * q) + off; }
        const int tau = wgid >> 2; int e = 0;
#pragma unroll
        for (int st = 16; st >= 1; st >>= 1) if (__builtin_amdgcn_readfirstlane(TP[e + st]) <= tau) e += st;
        u.pm = tau; u.e = e; u.t = tau - __builtin_amdgcn_readfirstlane(TP[e]); u.pnl = wgid & 3; u.pn = e * pn_mul + pn_add + u.pnl; return true;
    }
    __device__ __forceinline__ int token(const Unit& u, int r) const { const int idx = u.t * 256 + r; return ltok[(size_t)u.e * M + (idx < CNT[u.e] ? idx : 0)]; }
};

struct EpiQKV {
    static constexpr bool PERM = true;
    bf16_t* O; int ldc; int qcols; float qscale; unsigned* kmaxsq;
    __device__ __forceinline__ void operator()(const f32x4 (&acc)[2][2][4][2], const Unit& u, int wr, int wc, int fr, int fq) const {
        asm volatile("" : "+v"(fr), "+v"(fq));
        const int row0 = u.pm * BM + wr * 64 + fr, colt = u.pn * BM; const float sc = colt < qcols ? qscale : 1.f;
        const int col0 = colt + wc * 32 + 8 * fq;
#pragma unroll
        for (int ai = 0; ai < 2; ++ai)
#pragma unroll
            for (int m = 0; m < 4; ++m) { bf16_t* rowp = O + (size_t)(row0 + ai * HALF + m * 16) * ldc + col0;
#pragma unroll
                for (int bj = 0; bj < 2; ++bj) { const f32x4 v0 = acc[ai][bj][m][0] * sc, v1 = acc[ai][bj][m][1] * sc;
                    u32x4 w; w.x = cvtpk(v0[0], v0[1]); w.y = cvtpk(v0[2], v0[3]); w.z = cvtpk(v1[0], v1[1]); w.w = cvtpk(v1[2], v1[3]);
                    *(u32x4*)(rowp + bj * HALF) = w; } }
        if (kmaxsq != nullptr && colt >= 1024 && colt < 2048) {
#pragma unroll
            for (int bj = 0; bj < 2; ++bj) { float mx = 0.f;
#pragma unroll
                for (int ai = 0; ai < 2; ++ai)
#pragma unroll
                    for (int m = 0; m < 4; ++m) { const f32x4 v0 = acc[ai][bj][m][0], v1 = acc[ai][bj][m][1];
                        float ss = (v0[0] * v0[0] + v0[1] * v0[1]) + (v0[2] * v0[2] + v0[3] * v0[3]) + (v1[0] * v1[0] + v1[1] * v1[1]) + (v1[2] * v1[2] + v1[3] * v1[3]);
                        ss += __shfl_xor(ss, 16); ss += __shfl_xor(ss, 32); mx = __builtin_fmaxf(mx, ss); }
                mx = __builtin_fmaxf(mx, __shfl_xor(mx, 1)); mx = __builtin_fmaxf(mx, __shfl_xor(mx, 2)); mx = __builtin_fmaxf(mx, __shfl_xor(mx, 4)); mx = __builtin_fmaxf(mx, __shfl_xor(mx, 8));
                if (fr == 0 && fq == 0) atomicMax(kmaxsq + (u.pm >> 5) * 32 + ((colt - 1024 + bj * HALF + wc * 32) >> 5), __float_as_uint(mx)); }
        }
    }
};
struct EpiResid {
    static constexpr bool PERM = false;
    const float* base; float* out;
    __device__ __forceinline__ void operator()(const f32x4 (&acc)[2][2][4][2], const Unit& u, int wr, int wc, int fr, int fq) const {
        asm volatile("" : "+v"(fr), "+v"(fq));
        const int col0 = u.pn * BM + wc * 32 + 4 * fq;
#pragma unroll
        for (int ai = 0; ai < 2; ++ai) {
            f32x4 b[4][2][2];
#pragma unroll
            for (int m = 0; m < 4; ++m) { const size_t off = (size_t)(u.pm * BM + ai * HALF + wr * 64 + m * 16 + fr) * D + col0;
#pragma unroll
                for (int bj = 0; bj < 2; ++bj)
#pragma unroll
                    for (int n = 0; n < 2; ++n) b[m][bj][n] = *(const f32x4*)(base + off + bj * HALF + n * 16); }
            asm volatile("" ::: "memory");
#pragma unroll
            for (int m = 0; m < 4; ++m) { const size_t off = (size_t)(u.pm * BM + ai * HALF + wr * 64 + m * 16 + fr) * D + col0;
#pragma unroll
                for (int bj = 0; bj < 2; ++bj)
#pragma unroll
                    for (int n = 0; n < 2; ++n) *(f32x4*)(out + off + bj * HALF + n * 16) = b[m][bj][n] + acc[ai][bj][m][n]; }
            asm volatile("" ::: "memory");
        }
    }
};
__device__ __forceinline__ float silu_mul(float g, float u) { return g * u * __builtin_amdgcn_rcpf(1.f + __builtin_amdgcn_exp2f(-g * LOG2E)); }
template <bool F8>
struct EpiSwiGLU {
    static constexpr bool PERM = true;
    bf16_t* H; const int* ltok; const float* rstd_tok; const LAS int* CNT;
    __device__ __forceinline__ void operator()(const f32x4 (&acc)[2][2][4][2], const Unit& u, int wr, int wc, int fr, int fq) const {
        asm volatile("" : "+v"(fr), "+v"(fq));
        const int colh = u.pnl * 128 + wc * 32 + 8 * fq; const int cnt = CNT[u.e];
        int toks[2][4]; float rss[2][4];
#pragma unroll
        for (int ai = 0; ai < 2; ++ai)
#pragma unroll
            for (int m = 0; m < 4; ++m) { const int idx = u.t * 256 + ai * HALF + wr * 64 + m * 16 + fr; toks[ai][m] = ltok[(size_t)u.e * M + (idx < cnt ? idx : 0)]; }
#pragma unroll
        for (int ai = 0; ai < 2; ++ai)
#pragma unroll
            for (int m = 0; m < 4; ++m) rss[ai][m] = rstd_tok[toks[ai][m]];
        asm volatile("" ::: "memory");
#pragma unroll
        for (int ai = 0; ai < 2; ++ai)
#pragma unroll
            for (int m = 0; m < 4; ++m) { const int rl = ai * HALF + wr * 64 + m * 16 + fr; const size_t row = (size_t)u.pm * BM + rl;
                const float rs = rss[ai][m];
                const f32x4 g0 = acc[ai][0][m][0] * rs, g1 = acc[ai][0][m][1] * rs, u0 = acc[ai][1][m][0] * rs, u1 = acc[ai][1][m][1] * rs;
                if constexpr (F8) {
                    u32x2 w; w.x = pk4_fp8(8.f * silu_mul(g0[0], u0[0]), 8.f * silu_mul(g0[1], u0[1]), 8.f * silu_mul(g0[2], u0[2]), 8.f * silu_mul(g0[3], u0[3]));
                    w.y = pk4_fp8(8.f * silu_mul(g1[0], u1[0]), 8.f * silu_mul(g1[1], u1[1]), 8.f * silu_mul(g1[2], u1[2]), 8.f * silu_mul(g1[3], u1[3]));
                    *(u32x2*)((unsigned char*)H + row * DEXP + colh) = w;
                } else {
                    u32x4 w; w.x = cvtpk(silu_mul(g0[0], u0[0]), silu_mul(g0[1], u0[1])); w.y = cvtpk(silu_mul(g0[2], u0[2]), silu_mul(g0[3], u0[3]));
                    w.z = cvtpk(silu_mul(g1[0], u1[0]), silu_mul(g1[1], u1[1])); w.w = cvtpk(silu_mul(g1[2], u1[2]), silu_mul(g1[3], u1[3]));
                    *(u32x4*)(H + row * DEXP + colh) = w; }
            }
    }
};
struct EpiDown {
    static constexpr bool PERM = true;
    bf16_t* Y; const float* lw;
    __device__ __forceinline__ void operator()(const f32x4 (&acc)[2][2][4][2], const Unit& u, int wr, int wc, int fr, int fq) const {
        asm volatile("" : "+v"(fr), "+v"(fq));
        const int col0 = u.pnl * BM + wc * 32 + 8 * fq;
        float scs[2][4];
#pragma unroll
        for (int ai = 0; ai < 2; ++ai)
#pragma unroll
            for (int m = 0; m < 4; ++m) scs[ai][m] = lw[(size_t)u.e * M + u.t * 256 + ai * HALF + wr * 64 + m * 16 + fr];
        asm volatile("" ::: "memory");
#pragma unroll
        for (int ai = 0; ai < 2; ++ai)
#pragma unroll
            for (int m = 0; m < 4; ++m) { const int rl = ai * HALF + wr * 64 + m * 16 + fr; const size_t row = (size_t)u.pm * BM + rl;
                const float sc = scs[ai][m];
#pragma unroll
                for (int bj = 0; bj < 2; ++bj) { const f32x4 v0 = acc[ai][bj][m][0] * sc, v1 = acc[ai][bj][m][1] * sc;
                    u32x4 w; w.x = cvtpk(v0[0], v0[1]); w.y = cvtpk(v0[2], v0[3]); w.z = cvtpk(v1[0], v1[1]); w.w = cvtpk(v1[2], v1[3]);
                    *(u32x4*)(Y + row * D + col0 + bj * HALF) = w; } }
    }
};

template <class Epi, class Sched, bool GATHER, bool ALIGN_EPI, bool FP8 = false>
__device__ __forceinline__ void gemm_phase(LAS unsigned char* lds, const Gemm g, const Sched& S, const Epi& E, const int wid, const int lane) {
    const int tid = wid * 64 + lane, wr = wid >> 2, wc = wid & 3, fr = lane & 15, fq = lane >> 4;
    const int K = g.K, nt = K / BK;
    int Rr[2], Cc[2]; unsigned voffB[2];
#pragma unroll
    for (int i = 0; i < 2; ++i) { int R, C; stage_rc(tid * 16 + i * 8192, R, C); Rr[i] = R; Cc[i] = C; const int Rb = Epi::PERM ? ((R & ~31) + perm32(R & 31)) : R; voffB[i] = (unsigned)(Rb * K + C) * 2u; }
    const size_t kstep = (size_t)(BK * 2);
    const size_t hstep = (size_t)HALF * K * 2;
    const size_t tstep = 2 * hstep;
    const unsigned ldsw = (unsigned)wid * 1024u;
    const size_t R64 = (size_t)64 * K * 2;
    const size_t H1 = GATHER ? 0 : hstep;
    const int aoff = FP8 ? lds_byte(wr * 64 + fr, (fq >> 1) * 32 + (fq & 1) * 16) : lds_byte(wr * 64 + fr, fq * 8), boff = FP8 ? lds_byte(wc * 32 + fr, (fq >> 1) * 32 + (fq & 1) * 16) : lds_byte(wc * 32 + fr, fq * 8);

#define PG8_SA(b, h) (((b) * 2 + (h)) * HTB)
#define PG8_SB(b, h) ((4 + (b) * 2 + (h)) * HTB)
#define PG8_STAGE2(bufoff, gbase, o0, o1) do { \
        __builtin_amdgcn_global_load_lds((const unsigned*)((const char*)(gbase) + (o0)), (LAS unsigned*)(lds + (bufoff) + ldsw), 16, 0, 0); \
        __builtin_amdgcn_global_load_lds((const unsigned*)((const char*)(gbase) + (o1)), (LAS unsigned*)(lds + (bufoff) + ldsw + 8192), 16, 0, 0); } while (0)
#define PG8_STAGEB(bufoff, gbase) do {   \
        __builtin_amdgcn_global_load_lds((const unsigned*)((const char*)(gbase) + voffB[0]), (LAS unsigned*)(lds + (bufoff) + ldsw), 16, 0, 0); \
        __builtin_amdgcn_global_load_lds((const unsigned*)((const char*)(gbase) + R64 + voffB[0]), (LAS unsigned*)(lds + (bufoff) + ldsw + 8192), 16, 0, 0); } while (0)
#define PG8_LDA(dst, b, h) do { if constexpr (FP8) { _Pragma("unroll") for (int m = 0; m < 4; ++m) dst##8[m] = *(const LAS i32x8*)(lds + PG8_SA(b, h) + aoff + m * 2048); } \
        else { _Pragma("unroll") for (int m = 0; m < 4; ++m) _Pragma("unroll") for (int k = 0; k < 2; ++k) dst[m][k] = *(const LAS bf16x8*)(lds + PG8_SA(b, h) + aoff + m * 2048 + k * 1024); } } while (0)
#define PG8_LDB(dst, b, h) do { if constexpr (FP8) { _Pragma("unroll") for (int n = 0; n < 2; ++n) dst##8[n] = *(const LAS i32x8*)(lds + PG8_SB(b, h) + boff + n * 2048); } \
        else { _Pragma("unroll") for (int n = 0; n < 2; ++n) _Pragma("unroll") for (int k = 0; k < 2; ++k) dst[n][k] = *(const LAS bf16x8*)(lds + PG8_SB(b, h) + boff + n * 2048 + k * 1024); } } while (0)
#define PG8_CAT8(x) __builtin_shufflevector(__builtin_bit_cast(i32x4, (x)[0]), __builtin_bit_cast(i32x4, (x)[1]), 0, 1, 2, 3, 4, 5, 6, 7)
#define PG8_MMA(ai, bj, At, Bt) do { if constexpr (FP8) __builtin_amdgcn_sched_barrier(0); __builtin_amdgcn_s_setprio(1); _Pragma("unroll") for (int m = 0; m < 4; ++m) _Pragma("unroll") for (int n = 0; n < 2; ++n) { \
        if constexpr (FP8) acc[ai][bj][m][n] = __builtin_amdgcn_mfma_scale_f32_16x16x128_f8f6f4(Bt##8[n], At##8[m], acc[ai][bj][m][n], 0, 0, 0, (int)g.sw, 0, (int)g.sx); \
        else { _Pragma("unroll") for (int k = 0; k < 2; ++k) acc[ai][bj][m][n] = __builtin_amdgcn_mfma_f32_16x16x32_bf16(Bt[n][k], At[m][k], acc[ai][bj][m][n], 0, 0, 0); } } \
        if constexpr (FP8) { _Pragma("unroll") for (int m = 0; m < 4; ++m) _Pragma("unroll") for (int n = 0; n < 2; ++n) asm volatile("" : "+v"(acc[ai][bj][m][n])); }   \
        __builtin_amdgcn_s_setprio(0); if constexpr (FP8) __builtin_amdgcn_sched_barrier(0); } while (0)
#define PG8_WAIT_V(n) asm volatile("s_waitcnt vmcnt(" #n ")" ::: "memory")
#define PG8_WAIT_L(n) asm volatile("s_waitcnt lgkmcnt(" #n ")" ::: "memory")
#define PG8_BAR __builtin_amdgcn_s_barrier()
#define PG8_SCHED __builtin_amdgcn_sched_barrier(0)
    Unit cur, nxt; int ui = 0;
    if (!S.next(0, cur)) return;
    unsigned oc00, oc01, oc10, oc11;
    LAS u32x4* stash = (LAS u32x4*)(lds + (STASH_OFF - 0) ) + tid;
    if constexpr (GATHER) {
        oc00 = (unsigned)(S.token(cur, Rr[0]) * K + Cc[0]) * 2u; oc01 = (unsigned)(S.token(cur, Rr[1]) * K + Cc[1]) * 2u;
        oc10 = (unsigned)(S.token(cur, 128 + Rr[0]) * K + Cc[0]) * 2u; oc11 = (unsigned)(S.token(cur, 128 + Rr[1]) * K + Cc[1]) * 2u;
    } else {
        oc00 = (unsigned)(Rr[0] * K + Cc[0]) * 2u; oc01 = (unsigned)(Rr[1] * K + Cc[1]) * 2u; oc10 = oc00; oc11 = oc01;
    }
    f32x4 acc[2][2][4][2];
#pragma unroll
    for (int a = 0; a < 2; ++a)
#pragma unroll
        for (int b = 0; b < 2; ++b)
#pragma unroll
            for (int m = 0; m < 4; ++m)
#pragma unroll
                for (int n = 0; n < 2; ++n) acc[a][b][m][n] = (f32x4){0.f, 0.f, 0.f, 0.f};
    bf16x8 At[4][2], B0[2][2], B1[2][2];
    i32x8 At8[4], B08[2], B18[2];
    const char* cA = GATHER ? (const char*)g.A : (const char*)g.A + (size_t)cur.pm * tstep; const char* cB = (const char*)g.Bt + (size_t)cur.pn * tstep;
    PG8_STAGEB(PG8_SB(0, 0), cB); PG8_STAGEB(PG8_SB(0, 1), cB + hstep); PG8_STAGE2(PG8_SA(0, 0), cA, oc00, oc01); PG8_STAGE2(PG8_SA(0, 1), cA + H1, oc10, oc11);
    if (wr == 1) PG8_BAR;
    PG8_WAIT_V(2); PG8_BAR;
    PG8_STAGEB(PG8_SB(1, 0), cB + kstep); PG8_STAGE2(PG8_SA(1, 0), cA + kstep, oc00, oc01); PG8_STAGEB(PG8_SB(1, 1), cB + hstep + kstep);
    PG8_WAIT_V(6); PG8_BAR;
    for (;;) {
        const bool has_next = S.next(ui + 1, nxt);
        const char* nA = has_next ? (GATHER ? (const char*)g.A : (const char*)g.A + (size_t)nxt.pm * tstep) : cA; const char* nB = has_next ? (const char*)g.Bt + (size_t)nxt.pn * tstep : cB;
        if constexpr (GATHER) {
            u32x4 nx = {oc00, oc01, oc10, oc11};
            if (has_next) { int R0, C0, R1, C1; stage_rc(tid * 16, R0, C0); stage_rc(tid * 16 + 8192, R1, C1);
                nx.x = (unsigned)(S.token(nxt, R0) * K + C0) * 2u; nx.y = (unsigned)(S.token(nxt, R1) * K + C1) * 2u;
                nx.z = (unsigned)(S.token(nxt, 128 + R0) * K + C0) * 2u; nx.w = (unsigned)(S.token(nxt, 128 + R1) * K + C1) * 2u; }
            *stash = nx;
        }
        for (int t = 0; t < nt; t += 2) {
            const bool last = (t == nt - 2);
            const char* a1 = cA + (size_t)(t + 1) * kstep;
            const char* a2 = last ? nA : cA + (size_t)(t + 2) * kstep; const char* b2 = last ? nB : cB + (size_t)(t + 2) * kstep;
            const char* a3 = a2 + kstep; const char* b3 = b2 + kstep;
            unsigned x00 = oc00, x01 = oc01, x10 = oc10, x11 = oc11;
            if constexpr (GATHER) { if (last) { const u32x4 nx = *stash; x00 = nx.x; x01 = nx.y; x10 = nx.z; x11 = nx.w; } }
            PG8_LDB(B0, 0, 0); PG8_LDB(B1, 0, 1); PG8_SCHED; PG8_LDA(At, 0, 0); PG8_STAGE2(PG8_SA(1, 1), a1 + H1, oc10, oc11);
            PG8_WAIT_V(8); PG8_WAIT_L(0); PG8_BAR; PG8_MMA(0, 0, At, B0); PG8_MMA(0, 1, At, B1); PG8_BAR; PG8_SCHED;
            PG8_LDA(At, 0, 1); PG8_STAGEB(PG8_SB(0, 0), b2); PG8_STAGEB(PG8_SB(0, 1), b2 + hstep); PG8_STAGE2(PG8_SA(0, 0), a2, x00, x01);
            PG8_WAIT_V(8); PG8_WAIT_L(0); PG8_BAR; PG8_MMA(1, 0, At, B0); PG8_MMA(1, 1, At, B1); PG8_BAR; PG8_SCHED;
            PG8_LDB(B0, 1, 0); PG8_LDB(B1, 1, 1); PG8_SCHED; PG8_LDA(At, 1, 0); PG8_STAGE2(PG8_SA(0, 1), a2 + H1, x10, x11);
            PG8_WAIT_V(8); PG8_WAIT_L(0); PG8_BAR; PG8_MMA(0, 0, At, B0); PG8_MMA(0, 1, At, B1); PG8_BAR; PG8_SCHED;
            PG8_LDA(At, 1, 1); PG8_STAGEB(PG8_SB(1, 0), b3); PG8_STAGEB(PG8_SB(1, 1), b3 + hstep); PG8_STAGE2(PG8_SA(1, 0), a3, x00, x01);
            PG8_WAIT_V(8); PG8_WAIT_L(0); PG8_BAR; PG8_MMA(1, 0, At, B0); PG8_MMA(1, 1, At, B1); PG8_BAR; PG8_SCHED;
        }
        if constexpr (ALIGN_EPI) { if (wr == 0) PG8_BAR; }
        E(acc, cur, wr, wc, fr, fq);
        if (!has_next) break;
#pragma unroll
        for (int a = 0; a < 2; ++a)
#pragma unroll
            for (int b = 0; b < 2; ++b)
#pragma unroll
                for (int m = 0; m < 4; ++m)
#pragma unroll
                    for (int n = 0; n < 2; ++n) acc[a][b][m][n] = (f32x4){0.f, 0.f, 0.f, 0.f};
        cur = nxt; cA = nA; cB = nB; ++ui;
        if constexpr (GATHER) { const u32x4 nx = *stash; oc00 = nx.x; oc01 = nx.y; oc10 = nx.z; oc11 = nx.w; }
        if constexpr (ALIGN_EPI) { if (wr == 1) PG8_BAR; }
    }
    PG8_WAIT_V(0);
    if constexpr (!ALIGN_EPI) { if (wr == 0) PG8_BAR; }
    PG8_BAR;
#undef PG8_SA
#undef PG8_SB
#undef PG8_STAGE2
#undef PG8_STAGEB
#undef PG8_LDA
#undef PG8_LDB
#undef PG8_MMA
#undef PG8_CAT8
#undef PG8_WAIT_V
#undef PG8_WAIT_L
#undef PG8_BAR
#undef PG8_SCHED
}
}

namespace att {
constexpr int NSLOT = 3;
constexpr float THR = 8.0f;
__device__ __forceinline__ void glds16(const void* gsrc, unsigned lds_dst) { unsigned keep;
    asm volatile("s_mov_b32 %0, m0\n\ts_mov_b32 m0, %2\n\ts_nop 0\n\tglobal_load_lds_dwordx4 %1, off\n\ts_mov_b32 m0, %0" : "=&s"(keep) : "v"(gsrc), "s"(lds_dst) : "memory"); }
#define ATT_WAIT_BAR(N) asm volatile("s_waitcnt vmcnt(" #N ") lgkmcnt(0)\n\ts_barrier" ::: "memory")
typedef LAS const char* lds_cptr;
typedef short v4i16_t __attribute__((ext_vector_type(4)));
__device__ __forceinline__ s16x4 vtr(lds_cptr p) { return __builtin_bit_cast(s16x4, __builtin_amdgcn_ds_read_tr16_b64_v4i16((LAS v4i16_t*)p)); }
__device__ __forceinline__ float swap_max(float m) { auto rr = __builtin_amdgcn_permlane32_swap(__float_as_uint(m), __float_as_uint(m), false, false); return __builtin_fmaxf(__uint_as_float(rr[0]), __uint_as_float(rr[1])); }
__device__ __forceinline__ float swap_sum(float m) { auto rr = __builtin_amdgcn_permlane32_swap(__float_as_uint(m), __float_as_uint(m), false, false); return __uint_as_float(rr[0]) + __uint_as_float(rr[1]); }
__device__ __forceinline__ float max3f(float a, float b, float c) { float r; asm("v_max3_f32 %0, %1, %2, %3" : "=v"(r) : "v"(a), "v"(b), "v"(c)); return r; }
template <unsigned KB> __device__ __forceinline__ float fmamk(float a, float c) { float r; asm("v_fmamk_f32 %0, %1, %2, %3" : "=v"(r) : "v"(a), "i"(KB), "v"(c)); return r; }
#define CRF(r) ((float)(((r) & 3) + 8 * ((r) >> 2)))
#define CRI(r) (((r) & 3) + 8 * ((r) >> 2))

template <int MODE> struct Cfg;
template <> struct Cfg<0> { static constexpr int DV32 = 2, NK = 1, SLOTB = 16384, VOFF = 8192, PITCH = SWA_N, NVP = 1; };
template <> struct Cfg<1> { static constexpr int DV32 = 4, NK = 2, SLOTB = 32768, VOFF = 16384, PITCH = DIFF_N, NVP = 2; };

template <int MODE>
__device__ __forceinline__ void tile_step(lds_cptr kp, lds_cptr vp, const bf16x8 (&qr)[4], f32x16 (&o)[Cfg<MODE>::DV32], float& mhat, float& l, bool& first,
                                          const float slope2, const int dq_i, const int kind, const int hi) {
    constexpr int DV32 = Cfg<MODE>::DV32;
    f32x16 p0, p1;
    const float dq = (float)dq_i, nm = -mhat;
    {
        const float sl = kind == 2 ? 0.f : (kind == 0 ? slope2 : -slope2); const float base0 = __builtin_fmaf(-sl, dq, nm);
#pragma unroll
        for (int r = 0; r < 16; ++r) { p0[r] = __builtin_fmaf(sl, CRF(r), base0); p1[r] = __builtin_fmaf(sl, CRF(r) + 32.f, base0); }
    }
#pragma unroll
    for (int d0 = 0; d0 < 4; ++d0) {
        const bf16x8 b0 = *(const LAS bf16x8*)(kp + d0 * 2048);
        const bf16x8 b1 = *(const LAS bf16x8*)(kp + d0 * 2048 + 512);
        p0 = __builtin_amdgcn_mfma_f32_32x32x16_bf16(b0, qr[d0], p0, 0, 0, 0);
        p1 = __builtin_amdgcn_mfma_f32_32x32x16_bf16(b1, qr[d0], p1, 0, 0, 0);
    }
    if (kind == 2) {
#pragma unroll
        for (int r = 0; r < 16; ++r) {
            const float e0 = __builtin_fabsf(dq - CRF(r)), e1 = __builtin_fabsf(dq - CRF(r) - 32.f);
            if (MODE == 0) { p0[r] = e0 <= 128.f ? __builtin_fmaf(-slope2, e0, p0[r]) : -INFINITY; p1[r] = e1 <= 128.f ? __builtin_fmaf(-slope2, e1, p1[r]) : -INFINITY; }
            else { p0[r] = __builtin_fmaf(-slope2, e0, p0[r]); p1[r] = __builtin_fmaf(-slope2, e1, p1[r]); }
        }
    }
    float rm = __builtin_fmaxf(p0[0], p1[0]);
#pragma unroll
    for (int r = 1; r < 16; ++r) rm = __builtin_fmaxf(rm, __builtin_fmaxf(p0[r], p1[r]));
    rm = swap_max(rm);
    if (first || __any(rm > THR)) {
        const float dl = first ? rm : __builtin_fmaxf(rm, 0.f);
        mhat += dl;
#pragma unroll
        for (int r = 0; r < 16; ++r) { p0[r] -= dl; p1[r] -= dl; }
        if (!first) {
            const float f = __builtin_amdgcn_exp2f(-dl); l *= f;
#pragma unroll
            for (int r = 0; r < 16; ++r) { int h4_ = 4 * hi; asm volatile("" : "+v"(h4_)); const float fr_ = __shfl(f, CRI(r) + h4_);
#pragma unroll
                for (int d0 = 0; d0 < DV32; ++d0) o[d0][r] *= fr_; }
        }
        first = false;
    }
    float sacc = 0.f;
    u32x4 pw[4];
#pragma unroll
    for (int s = 0; s < 2; ++s) {
        float e[8];
#pragma unroll
        for (int j = 0; j < 8; ++j) { e[j] = __builtin_amdgcn_exp2f(p0[8 * s + j]); sacc += e[j]; }
        pw[s] = (u32x4){cvtpk(e[0], e[1]), cvtpk(e[2], e[3]), cvtpk(e[4], e[5]), cvtpk(e[6], e[7])};
    }
#pragma unroll
    for (int s = 0; s < 2; ++s) {
        float e[8];
#pragma unroll
        for (int j = 0; j < 8; ++j) { e[j] = __builtin_amdgcn_exp2f(p1[8 * s + j]); sacc += e[j]; }
        pw[2 + s] = (u32x4){cvtpk(e[0], e[1]), cvtpk(e[2], e[3]), cvtpk(e[4], e[5]), cvtpk(e[6], e[7])};
    }
    l += sacc;
#pragma unroll
    for (int d0 = 0; d0 < DV32; ++d0) {
#pragma unroll
        for (int ks = 0; ks < 4; ++ks) {
            const s16x4 lo = vtr(vp + d0 * 4096 + ks * 1024), hh = vtr(vp + d0 * 4096 + ks * 1024 + 512);
            const bf16x8 vf = (bf16x8){lo[0], lo[1], lo[2], lo[3], hh[0], hh[1], hh[2], hh[3]};
            o[d0] = __builtin_amdgcn_mfma_f32_32x32x16_bf16(__builtin_bit_cast(bf16x8, pw[ks]), vf, o[d0], 0, 0, 0);
        }
    }
}

struct DiffConsts { float lam_full; const float* subln; float gs0, gs1, gs2, gs3; };

template <int MODE>
__device__ __forceinline__ void attn_unit(const int b, const int hh, const int qb, const bf16_t* __restrict__ QKV, bf16_t* __restrict__ O, const float* __restrict__ sink,
                                          const DiffConsts dc, LAS unsigned char* shm, const int wid, const int lane_in) {
    typedef Cfg<MODE> C;
    constexpr int DV32 = C::DV32, PITCH = C::PITCH;
    int lane = lane_in; asm volatile("" : "+v"(lane));
    const int r32 = lane & 31, hi = lane >> 5;
    int iw, qcol, kcol, vcol, t_lo, NT, hq = 0, cmap = 0, qs;
    float slope2;
    if (MODE == 0) { const int g = wid >> 1; qs = wid & 1; hq = hh * 4 + g; iw = qb * 64 + qs * 32; qcol = hq * 64; kcol = 1024 + hh * 64; vcol = 1280 + hh * 64;
        t_lo = qb - 2 < 0 ? 0 : qb - 2; const int t_hi = qb + 2 > 127 ? 127 : qb + 2; NT = t_hi - t_lo + 1; slope2 = __builtin_amdgcn_exp2f(-0.5f * (float)(hq + 1)) * LOG2E; }
    else { qs = wid & 3; cmap = wid >> 2; iw = qb * 128 + qs * 32; qcol = (hh * 2 + cmap) * 64; kcol = 1024 + hh * 128; vcol = 2048 + hh * 128; t_lo = 0; NT = SEQ / 64;
        slope2 = __builtin_amdgcn_exp2f(-(float)(hh + 1)) * LOG2E; }
    const bf16_t* base = QKV + (size_t)b * SEQ * PITCH;
    const unsigned lds0 = (unsigned)(uintptr_t)shm;
    const unsigned koff = (unsigned)(lane * PITCH + kcol + wid * 8) * 2u;
    const unsigned voff = (unsigned)((16 * (wid & 3) + (lane >> 2)) * PITCH + vcol + (wid >> 2) * 32 + (lane & 3) * 8) * 2u;
    const unsigned kdst = lds0 + wid * 1024, vdst = lds0 + C::VOFF + wid * 1024;
#define ATT_DMA(t, slot) do { const char* tb_ = (const char*)base + (size_t)(t) * 64 * PITCH * 2; const unsigned so_ = (unsigned)(slot) * C::SLOTB; \
        glds16(tb_ + koff, (unsigned)__builtin_amdgcn_readfirstlane(kdst + so_)); \
        if (MODE == 1) glds16(tb_ + koff + 128, (unsigned)__builtin_amdgcn_readfirstlane(kdst + so_ + 8192)); \
        glds16(tb_ + voff, (unsigned)__builtin_amdgcn_readfirstlane(vdst + so_)); \
        if (MODE == 1) glds16(tb_ + voff + 128, (unsigned)__builtin_amdgcn_readfirstlane(vdst + so_ + 8192)); } while (0)
    ATT_DMA(t_lo, 0);
    if (NT > 1) ATT_DMA(t_lo + 1, 1);
    bf16x8 qr[4];
    { const bf16_t* Qw = base + (size_t)(iw + r32) * PITCH + qcol;
#pragma unroll
      for (int d0 = 0; d0 < 4; ++d0) qr[d0] = *(const bf16x8*)(Qw + d0 * 16 + hi * 8); }
    f32x16 o[DV32];
#pragma unroll
    for (int d0 = 0; d0 < DV32; ++d0)
#pragma unroll
        for (int r = 0; r < 16; ++r) o[d0][r] = 0.f;
    float mhat = 0.f, l = 0.f; bool first = true;
    if (MODE == 0) { mhat = sink[hq] * LOG2E; l = (hi == 0) ? 1.f : 0.f; first = false; }
    const lds_cptr shm3 = (lds_cptr)shm;
    const lds_cptr kp0 = shm3 + (MODE == 1 ? cmap * 8192 : 0) + hi * 1024 + r32 * 16;
    const lds_cptr vp0 = shm3 + C::VOFF + ((lane >> 4) & 1) * 32 + (lane & 3) * 8 + (4 * hi + ((lane & 15) >> 2)) * 64;
    int slot = 0;
    for (int it = 0; it < NT; ++it) {
        if (it + 1 < NT) { if (MODE == 1) { ATT_WAIT_BAR(4); } else { ATT_WAIT_BAR(2); } } else { ATT_WAIT_BAR(0); }
        if (it + 2 < NT) { const int s2 = slot == 0 ? 2 : slot - 1; ATT_DMA(t_lo + it + 2, s2); }
        const int k0 = (t_lo + it) * 64;
        const int kind = (MODE == 0) ? ((t_lo + it == qb - 1) ? 0 : ((t_lo + it == qb + 1) ? 1 : 2)) : ((k0 + 63 < iw) ? 0 : ((k0 > iw + 31) ? 1 : 2));
        tile_step<MODE>(kp0 + slot * C::SLOTB, vp0 + slot * C::SLOTB, qr, o, mhat, l, first, slope2, iw + r32 - k0 - 4 * hi, kind, hi);
        slot = slot == 2 ? 0 : slot + 1;
    }
#undef ATT_DMA
    l = swap_sum(l);
    const float rl = 1.f / l;
    if (MODE == 0) {
        bf16_t* Ow = O + (size_t)(b * SEQ + iw) * D + hq * 64 + r32;
#pragma unroll
        for (int r = 0; r < 16; ++r) { const int row = CRI(r) + 4 * hi; const float rr = __shfl(rl, row);
#pragma unroll
            for (int d0 = 0; d0 < DV32; ++d0) Ow[(size_t)row * D + d0 * 32] = (bf16_t)f2bf(o[d0][r] * rr); }
        ATT_WAIT_BAR(0);
    } else {
        LAS float* cb = (LAS float*)shm + qs * 4096;
        ATT_WAIT_BAR(0);
        if (cmap == 1) {
#pragma unroll
            for (int r = 0; r < 16; ++r) { const int row = CRI(r) + 4 * hi; const float rr = __shfl(rl, row) * dc.lam_full;
#pragma unroll
                for (int d0 = 0; d0 < DV32; ++d0) cb[row * 128 + d0 * 32 + r32] = o[d0][r] * rr; }
        }
        ATT_WAIT_BAR(0);
        if (cmap == 0) {
            bf16_t* Ow = O + (size_t)(b * SEQ + iw) * D + hh * 128 + r32;
            float gsub[DV32];
#pragma unroll
            for (int d0 = 0; d0 < DV32; ++d0) gsub[d0] = dc.subln[d0 * 32 + r32] * (1.f - LAMBDA_INIT);
#pragma unroll
            for (int r = 0; r < 16; ++r) { const int row = CRI(r) + 4 * hi; const float rr = __shfl(rl, row);
                float v[DV32]; float ss = 0.f;
#pragma unroll
                for (int d0 = 0; d0 < DV32; ++d0) { v[d0] = o[d0][r] * rr - cb[row * 128 + d0 * 32 + r32]; ss += v[d0] * v[d0]; }
                ss += __shfl_xor(ss, 1); ss += __shfl_xor(ss, 2); ss += __shfl_xor(ss, 4); ss += __shfl_xor(ss, 8); ss += __shfl_xor(ss, 16);
                const float sc = __builtin_amdgcn_rsqf(ss * (1.f / 128.f) + 1e-5f);
#pragma unroll
                for (int d0 = 0; d0 < DV32; ++d0) Ow[(size_t)row * D + d0 * 32] = (bf16_t)f2bf(v[d0] * sc * gsub[d0]); }
        }
        ATT_WAIT_BAR(0);
    }
}

#define SBAR() __builtin_amdgcn_sched_barrier(0)
#define PIN(x) asm volatile("" : "+v"(x))
#define MF(a, b, c) __builtin_amdgcn_mfma_f32_32x32x16_bf16(a, b, c, 0, 0, 0)
template <int VAR>
__device__ __forceinline__ void diff_unit(const int b, const int hh, const int qb, const bf16_t* __restrict__ QKV, bf16_t* __restrict__ O, const float kmax,
                                          const DiffConsts dc, LAS unsigned char* shm, const int wid, const int lane_in) {
    constexpr int DV32 = 4, PITCH = DIFF_N, KSLOT = 16384, VRING = 4 * 16384;
    int lane = lane_in; asm volatile("" : "+v"(lane));
    const int r32 = lane & 31, hi = lane >> 5;
    const int qs = wid & 3, cmap = wid >> 2, i0 = qb * 128, iw = i0 + qs * 32, qcol = (hh * 2 + cmap) * 64, kcol = 1024 + hh * 128, vcol = 2048 + hh * 128;
    const float slope2 = __builtin_amdgcn_exp2f(-(float)(hh + 1)) * LOG2E;
    const bf16_t* base = QKV + (size_t)b * SEQ * PITCH;
    const unsigned lds0 = (unsigned)(uintptr_t)shm;
    const unsigned koff = (unsigned)(lane * PITCH + kcol + wid * 8) * 2u;
    const unsigned voff = (unsigned)((16 * (wid & 3) + (lane >> 2)) * PITCH + vcol + (wid >> 2) * 32 + (lane & 3) * 8) * 2u;
    const unsigned kdst = lds0 + wid * 1024, vdst = lds0 + VRING + wid * 1024;
#define DMA_K(t, slot) do { const char* tb_ = (const char*)base + (size_t)(t) * 64 * PITCH * 2; const unsigned so_ = (unsigned)(slot) * KSLOT; \
        glds16(tb_ + koff, (unsigned)__builtin_amdgcn_readfirstlane(kdst + so_)); glds16(tb_ + koff + 128, (unsigned)__builtin_amdgcn_readfirstlane(kdst + so_ + 8192)); } while (0)
#define DMA_V(t, slot) do { const char* tb_ = (const char*)base + (size_t)(t) * 64 * PITCH * 2; const unsigned so_ = (unsigned)(slot) * KSLOT; \
        glds16(tb_ + voff, (unsigned)__builtin_amdgcn_readfirstlane(vdst + so_)); glds16(tb_ + voff + 128, (unsigned)__builtin_amdgcn_readfirstlane(vdst + so_ + 8192)); } while (0)
    const int td0 = 2 * qb;
    int nL = td0;
#define TILE_OF(idx) ((idx) < 2 ? td0 + (idx) : ((idx) - 2 < nL ? td0 - 1 - ((idx) - 2) : td0 + 2 + ((idx) - 2 - nL)))
    DMA_K(td0, 0); DMA_V(td0, 0); DMA_K(td0 + 1, 1); DMA_V(td0 + 1, 1); DMA_K(TILE_OF(2), 2);
    bf16x8 qr[4]; float nq2 = 0.f;
    { const bf16_t* Qw = base + (size_t)(iw + r32) * PITCH + qcol;
#pragma unroll
      for (int d0 = 0; d0 < 4; ++d0) { qr[d0] = *(const bf16x8*)(Qw + d0 * 16 + hi * 8);
#pragma unroll
          for (int j = 0; j < 8; ++j) { const float f = bf2f((unsigned short)qr[d0][j]); nq2 += f * f; } } }
    nq2 = swap_sum(nq2);
    f32x16 o[DV32];
#pragma unroll
    for (int d0 = 0; d0 < DV32; ++d0)
#pragma unroll
        for (int r = 0; r < 16; ++r) o[d0][r] = 0.f;
    float mhat = 0.f, l = 0.f; bool first = true;
    const lds_cptr shm3 = (lds_cptr)shm;
    const lds_cptr kp0 = shm3 + cmap * 8192 + hi * 1024 + r32 * 16;
    const lds_cptr vp0 = shm3 + VRING + ((lane >> 4) & 1) * 32 + (lane & 3) * 8 + (4 * hi + ((lane & 15) >> 2)) * 64;
    LAS float* wsf = (LAS float*)(shm + 7 * KSLOT);
    ATT_WAIT_BAR(6);
    DMA_K(TILE_OF(3), 3);
    { const int k0 = td0 * 64; const int kind = (k0 + 63 < iw) ? 0 : ((k0 > iw + 31) ? 1 : 2);
      tile_step<1>(kp0, vp0, qr, o, mhat, l, first, slope2, iw + r32 - k0 - 4 * hi, kind, hi); }
    ATT_WAIT_BAR(4);
    DMA_K(TILE_OF(4), 0); DMA_V(TILE_OF(2), 2);
    { const int k0 = (td0 + 1) * 64; const int kind = (k0 + 63 < iw) ? 0 : ((k0 > iw + 31) ? 1 : 2);
      tile_step<1>(kp0 + KSLOT, vp0 + KSLOT, qr, o, mhat, l, first, slope2, iw + r32 - k0 - 4 * hi, kind, hi); }
    { float a = sqrtf(nq2) * kmax - mhat;
#pragma unroll
      for (int o_ = 1; o_ < 32; o_ <<= 1) a = __builtin_fmaxf(a, __shfl_xor(a, o_));
      if (lane == 0) wsf[wid] = a; }
    ATT_WAIT_BAR(4);
    int NT; bool nochk;
    { float amax = wsf[0];
#pragma unroll
      for (int w = 1; w < 8; ++w) amax = __builtin_fmaxf(amax, wsf[w]);
      const float dist = (64.f + __builtin_fmaxf(amax, 0.f)) / slope2;
      const float lo_f = ((float)(i0 - 63) - dist) * (1.f / 64.f), hi_f = ((float)(i0 + 127) + dist) * (1.f / 64.f);
      int t_lo = lo_f <= 0.f ? 0 : (int)lo_f, t_hi = hi_f >= 127.f ? 127 : (int)hi_f;
      if (t_lo > td0 - 2) t_lo = td0 - 2 < 0 ? 0 : td0 - 2; if (t_hi < td0 + 3) t_hi = td0 + 3 > 127 ? 127 : td0 + 3;
      t_lo = __builtin_amdgcn_readfirstlane(t_lo); t_hi = __builtin_amdgcn_readfirstlane(t_hi);
      nL = td0 - t_lo; NT = 2 + nL + (t_hi - (td0 + 1)); if (VAR & 256) NT = 2;
      nochk = __builtin_amdgcn_readfirstlane(amax <= 64.f ? 1 : 0) != 0; }
    f32x16 xa0, xa1, xb0, xb1; u32x4 pw0, pw1, pw2, pw3; bf16x8 kf0, kf1, kf2, kf3; s16x4 vl0, vh0, vl1, vh1, vl2, vh2, vl3, vh3;
    float sl_n, base_n, rf = 1.f; bool resc = false;
#define KRD(dst, f) do { if ((VAR & 4) && (f) >= 4) break; dst = *(const LAS bf16x8*)(kp_ + ((f) >> 1) * 2048 + ((f) & 1) * 512); } while (0)
#define VRD(lo, hh_, i) do { if ((VAR & 2) && (i) >= 4) break; lo = vtr(vp_ + ((i) >> 2) * 4096 + ((i) & 3) * 1024); hh_ = vtr(vp_ + ((i) >> 2) * 4096 + ((i) & 3) * 1024 + 512); } while (0)
#define KRN(dst, f) dst = *(const LAS bf16x8*)(kn_ + ((f) >> 1) * 2048 + ((f) & 1) * 512)
#define VFR(lo, hh_) (bf16x8){lo[0], lo[1], lo[2], lo[3], hh_[0], hh_[1], hh_[2], hh_[3]}
#define SET_NEXT(idx) do { const int tn_ = TILE_OF(idx); const bool left_ = (idx) - 2 < nL; sl_n = left_ ? slope2 : -slope2; \
        base_n = __builtin_fmaf(-sl_n, (float)(iw + r32 - tn_ * 64 - 4 * hi), -mhat); } while (0)
#define CINIT(X0, X1) do { _Pragma("unroll") for (int r = 0; r < 16; ++r) { X0[r] = __builtin_fmaf(sl_n, CRF(r), base_n); X1[r] = __builtin_fmaf(sl_n, CRF(r) + 32.f, base_n); } } while (0)
#define GA(Sx, KF, qf, RD, P, e, PW, w0, w1) do { Sx = MF(KF, qf, Sx); RD; if (!(VAR & 32)) { sacc += P[e]; sacc += P[e + 1]; sacc += P[e + 2]; sacc += P[e + 3]; PIN(sacc); \
        PW[w0] = cvtpk(P[e], P[e + 1]); PW[w1] = cvtpk(P[e + 2], P[e + 3]); } PIN(PW); SBAR(); } while (0)
#define PHASE_A(S0, S1, P0, P1) do { float sacc = 0.f; \
        GA(S0, kf0, qr[0], KRD(kf0, 4), P0, 0,  pw0, 0, 1); GA(S1, kf1, qr[0], KRD(kf1, 5), P0, 4,  pw0, 2, 3); \
        GA(S0, kf2, qr[1], KRD(kf2, 6), P0, 8,  pw1, 0, 1); GA(S1, kf3, qr[1], KRD(kf3, 7), P0, 12, pw1, 2, 3); \
        GA(S0, kf0, qr[2], VRD(vl0, vh0, 0), P1, 0,  pw2, 0, 1); GA(S1, kf1, qr[2], VRD(vl1, vh1, 1), P1, 4,  pw2, 2, 3); \
        GA(S0, kf2, qr[3], VRD(vl2, vh2, 2), P1, 8,  pw3, 0, 1); GA(S1, kf3, qr[3], VRD(vl3, vh3, 3), P1, 12, pw3, 2, 3); \
        l += sacc; } while (0)
#define QK_ONLY(S0, S1) do { \
        S0 = MF(kf0, qr[0], S0); KRD(kf0, 4); S1 = MF(kf1, qr[0], S1); KRD(kf1, 5); S0 = MF(kf2, qr[1], S0); KRD(kf2, 6); S1 = MF(kf3, qr[1], S1); KRD(kf3, 7); SBAR(); \
        S0 = MF(kf0, qr[2], S0); S1 = MF(kf1, qr[2], S1); S0 = MF(kf2, qr[3], S0); S1 = MF(kf3, qr[3], S1); SBAR(); } while (0)
#define DECIDE(S0, S1) do { if (VAR & 64) break; asm volatile("s_nop 15\n\ts_nop 7" : "+v"(S0), "+v"(S1));   \
        float ma_ = max3f(S0[0], S0[1], S1[0]), mb_ = max3f(S0[2], S0[3], S1[1]); ma_ = max3f(ma_, S1[2], S1[3]); \
        _Pragma("unroll") for (int r = 4; r < 16; r += 4) { ma_ = max3f(ma_, S0[r], S0[r + 1]); mb_ = max3f(mb_, S0[r + 2], S0[r + 3]); ma_ = max3f(ma_, S1[r], S1[r + 1]); mb_ = max3f(mb_, S1[r + 2], S1[r + 3]); } \
        float rm_ = max3f(ma_, mb_, mb_); rm_ = swap_max(rm_); resc = false; \
        if (__builtin_expect(__any(rm_ > THR), 0)) { const float dl_ = __builtin_fmaxf(rm_, 0.f); mhat += dl_; \
            _Pragma("unroll") for (int r = 0; r < 16; ++r) { S0[r] -= dl_; S1[r] -= dl_; } \
            rf = __builtin_amdgcn_exp2f(-dl_); l *= rf; resc = true; } } while (0)
#define RESCALE_O() do { if (resc) { int h4_ = 4 * hi; asm volatile("" : "+v"(h4_)); _Pragma("unroll") for (int r = 0; r < 16; ++r) { const float fr_ = __shfl(rf, CRI(r) + h4_); \
            _Pragma("unroll") for (int d0 = 0; d0 < DV32; ++d0) o[d0][r] *= fr_; } resc = false; } } while (0)
#define EXP2(x) ((VAR & 1) ? (x) * 0.001f : __builtin_amdgcn_exp2f(x))
#define GB(Ox, PW, VL, VH, RD, S, e, C, crf) do { if (!(VAR & 512)) Ox = MF(__builtin_bit_cast(bf16x8, PW), VFR(VL, VH), Ox); RD; S[e] = EXP2(S[e]); S[e + 1] = EXP2(S[e + 1]); PIN(S); \
        if (!(VAR & 16)) { C[e] = fmamk<__builtin_bit_cast(unsigned, CRF(e) + (crf))>(sl_n, base_n); C[e + 1] = fmamk<__builtin_bit_cast(unsigned, CRF(e + 1) + (crf))>(sl_n, base_n); } PIN(C); SBAR(); } while (0)
#define PHASE_B(S0, S1, C0, C1) do { \
        GB(o[0], pw0, vl0, vh0, VRD(vl0, vh0, 4),  S0, 0,  C0, 0.f);  GB(o[0], pw1, vl1, vh1, VRD(vl1, vh1, 5),  S0, 2,  C0, 0.f); \
        GB(o[0], pw2, vl2, vh2, VRD(vl2, vh2, 6),  S0, 4,  C0, 0.f);  GB(o[0], pw3, vl3, vh3, VRD(vl3, vh3, 7),  S0, 6,  C0, 0.f); \
        GB(o[1], pw0, vl0, vh0, VRD(vl0, vh0, 8),  S0, 8,  C0, 0.f);  GB(o[1], pw1, vl1, vh1, VRD(vl1, vh1, 9),  S0, 10, C0, 0.f); \
        GB(o[1], pw2, vl2, vh2, VRD(vl2, vh2, 10), S0, 12, C0, 0.f);  GB(o[1], pw3, vl3, vh3, VRD(vl3, vh3, 11), S0, 14, C0, 0.f); \
        GB(o[2], pw0, vl0, vh0, VRD(vl0, vh0, 12), S1, 0,  C1, 32.f); GB(o[2], pw1, vl1, vh1, VRD(vl1, vh1, 13), S1, 2,  C1, 32.f); \
        GB(o[2], pw2, vl2, vh2, VRD(vl2, vh2, 14), S1, 4,  C1, 32.f); GB(o[2], pw3, vl3, vh3, VRD(vl3, vh3, 15), S1, 6,  C1, 32.f); \
        GB(o[3], pw0, vl0, vh0, KRN(kf0, 0),       S1, 8,  C1, 32.f); GB(o[3], pw1, vl1, vh1, KRN(kf1, 1),       S1, 10, C1, 32.f); \
        GB(o[3], pw2, vl2, vh2, KRN(kf2, 2),       S1, 12, C1, 32.f); GB(o[3], pw3, vl3, vh3, KRN(kf3, 3),       S1, 14, C1, 32.f); } while (0)
#define ROT3(s) ((s) == 2 ? 0 : (s) + 1)
#define ROT4(s) (((s) + 1) & 3)
#define STEP(S0, S1, P0, P1, it, CHK) do { \
        asm volatile("" : "+s"(sk), "+s"(sv)); \
        const int skm_ = (sk + 3) & 3, skp_ = ROT4(sk), svpp_ = sv == 0 ? 2 : sv - 1;   \
        const lds_cptr kp_ = kp0 + sk * KSLOT; const lds_cptr kn_ = kp0 + skp_ * KSLOT; const lds_cptr vp_ = vp0 + sv * KSLOT; \
        if (!(VAR & 8) && (it) + 3 < NT) DMA_K(TILE_OF((it) + 3), skm_); \
        SET_NEXT((it) + 1); SBAR(); \
        __builtin_amdgcn_s_setprio(1); PHASE_A(S0, S1, P0, P1); __builtin_amdgcn_s_setprio(0); \
        if (!(VAR & 8) && (it) + 1 < NT) DMA_V(TILE_OF((it) + 1), svpp_); \
        if (CHK) { DECIDE(S0, S1); if (resc) SET_NEXT((it) + 1); } SBAR(); \
        __builtin_amdgcn_s_setprio(1); PHASE_B(S0, S1, P0, P1); __builtin_amdgcn_s_setprio(0); \
        if (CHK) RESCALE_O(); sk = skp_; sv = ROT3(sv); } while (0)
    if (NT > 2) {
        { const lds_cptr kp_ = kp0 + 2 * KSLOT; const lds_cptr kn_ = kp0 + 3 * KSLOT;
          KRD(kf0, 0); KRD(kf1, 1); KRD(kf2, 2); KRD(kf3, 3);
          if (5 < NT) DMA_K(TILE_OF(5), 1); if (3 < NT) DMA_V(TILE_OF(3), 0);
          SET_NEXT(2); CINIT(xa0, xa1); SBAR();
          QK_ONLY(xa0, xa1);
          if (!nochk) { DECIDE(xa0, xa1); RESCALE_O(); }
#pragma unroll
          for (int r = 0; r < 16; ++r) { xa0[r] = EXP2(xa0[r]); xa1[r] = EXP2(xa1[r]); }
          SET_NEXT(3); CINIT(xb0, xb1);
          KRN(kf0, 0); KRN(kf1, 1); KRN(kf2, 2); KRN(kf3, 3); }
#define PIPE_LOOP(CHK_) do { \
        int it = 3, sk = 3, sv = 2; \
        _Pragma("unroll 1") \
        for (; it + 1 < NT; it += 2) { \
            if (!(VAR & 128)) { if (it + 2 < NT) { ATT_WAIT_BAR(4); } else { ATT_WAIT_BAR(2); } } \
            STEP(xb0, xb1, xa0, xa1, it, CHK_); \
            if (!(VAR & 128)) { if (it + 3 < NT) { ATT_WAIT_BAR(4); } else { ATT_WAIT_BAR(2); } } \
            STEP(xa0, xa1, xb0, xb1, it + 1, CHK_); \
        } \
        if (it < NT) { \
            ATT_WAIT_BAR(2); \
            STEP(xb0, xb1, xa0, xa1, it, CHK_); \
 \
            { float sacc = 0.f; \
        _Pragma("unroll") \
              for (int r = 0; r < 16; ++r) sacc += xb0[r] + xb1[r]; \
              l += sacc; \
              pw0 = (u32x4){cvtpk(xb0[0], xb0[1]), cvtpk(xb0[2], xb0[3]), cvtpk(xb0[4], xb0[5]), cvtpk(xb0[6], xb0[7])}; pw1 = (u32x4){cvtpk(xb0[8], xb0[9]), cvtpk(xb0[10], xb0[11]), cvtpk(xb0[12], xb0[13]), cvtpk(xb0[14], xb0[15])}; \
              pw2 = (u32x4){cvtpk(xb1[0], xb1[1]), cvtpk(xb1[2], xb1[3]), cvtpk(xb1[4], xb1[5]), cvtpk(xb1[6], xb1[7])}; pw3 = (u32x4){cvtpk(xb1[8], xb1[9]), cvtpk(xb1[10], xb1[11]), cvtpk(xb1[12], xb1[13]), cvtpk(xb1[14], xb1[15])}; } \
        } else { \
            { float sacc = 0.f; \
        _Pragma("unroll") \
              for (int r = 0; r < 16; ++r) sacc += xa0[r] + xa1[r]; \
              l += sacc; \
              pw0 = (u32x4){cvtpk(xa0[0], xa0[1]), cvtpk(xa0[2], xa0[3]), cvtpk(xa0[4], xa0[5]), cvtpk(xa0[6], xa0[7])}; pw1 = (u32x4){cvtpk(xa0[8], xa0[9]), cvtpk(xa0[10], xa0[11]), cvtpk(xa0[12], xa0[13]), cvtpk(xa0[14], xa0[15])}; \
              pw2 = (u32x4){cvtpk(xa1[0], xa1[1]), cvtpk(xa1[2], xa1[3]), cvtpk(xa1[4], xa1[5]), cvtpk(xa1[6], xa1[7])}; pw3 = (u32x4){cvtpk(xa1[8], xa1[9]), cvtpk(xa1[10], xa1[11]), cvtpk(xa1[12], xa1[13]), cvtpk(xa1[14], xa1[15])}; } \
        } \
    } while (0)
        PIPE_LOOP(!nochk);
#undef PIPE_LOOP
        ATT_WAIT_BAR(0);
        { const int sl_ = (NT - 1) % 3; const lds_cptr vp_ = vp0 + sl_ * KSLOT;
#pragma unroll
          for (int d0 = 0; d0 < DV32; ++d0) {
              VRD(vl0, vh0, d0 * 4); VRD(vl1, vh1, d0 * 4 + 1); VRD(vl2, vh2, d0 * 4 + 2); VRD(vl3, vh3, d0 * 4 + 3);
              o[d0] = MF(__builtin_bit_cast(bf16x8, pw0), VFR(vl0, vh0), o[d0]); o[d0] = MF(__builtin_bit_cast(bf16x8, pw1), VFR(vl1, vh1), o[d0]);
              o[d0] = MF(__builtin_bit_cast(bf16x8, pw2), VFR(vl2, vh2), o[d0]); o[d0] = MF(__builtin_bit_cast(bf16x8, pw3), VFR(vl3, vh3), o[d0]); } }
    }
#undef TILE_OF
#undef DMA_K
#undef DMA_V
#undef KRD
#undef VRD
#undef VFR
#undef SET_NEXT
#undef CINIT
#undef GA
#undef PHASE_A
#undef QK_ONLY
#undef DECIDE
#undef RESCALE_O
#undef EXP2
#undef GB
#undef PHASE_B
#undef STEP
#undef ROT3
#undef ROT4
#undef KRN
    l = swap_sum(l);
    const float rl = 1.f / l;
    LAS float* cb = (LAS float*)shm + qs * 4096;
    ATT_WAIT_BAR(0);
    if (VAR & 1024) { if (lane == 0 && rl == 12345.f) O[0] = 0; return; }
    if (cmap == 1) {
#pragma unroll
        for (int r = 0; r < 16; ++r) { const int row = CRI(r) + 4 * hi; const float rr = __shfl(rl, row) * dc.lam_full;
#pragma unroll
            for (int d0 = 0; d0 < DV32; ++d0) cb[row * 128 + d0 * 32 + r32] = o[d0][r] * rr; }
    }
    ATT_WAIT_BAR(0);
    if (cmap == 0) {
        bf16_t* Ow = O + (size_t)(b * SEQ + iw) * D + hh * 128 + r32;
        const float gsub[DV32] = {dc.gs0, dc.gs1, dc.gs2, dc.gs3};
#pragma unroll
        for (int r = 0; r < 16; ++r) { const int row = CRI(r) + 4 * hi; const float rr = __shfl(rl, row);
            float v[DV32]; float ss = 0.f;
#pragma unroll
            for (int d0 = 0; d0 < DV32; ++d0) { v[d0] = o[d0][r] * rr - cb[row * 128 + d0 * 32 + r32]; ss += v[d0] * v[d0]; }
            ss += __shfl_xor(ss, 1); ss += __shfl_xor(ss, 2); ss += __shfl_xor(ss, 4); ss += __shfl_xor(ss, 8); ss += __shfl_xor(ss, 16);
            const float sc = __builtin_amdgcn_rsqf(ss * (1.f / 128.f) + 1e-5f);
#pragma unroll
            for (int d0 = 0; d0 < DV32; ++d0) Ow[(size_t)row * D + d0 * 32] = (bf16_t)f2bf(v[d0] * sc * gsub[d0]); }
    }
    asm volatile("s_waitcnt lgkmcnt(0)\n\ts_barrier" ::: "memory");
}
#undef SBAR
#undef PIN
#undef MF
#undef ATT_WAIT_BAR
}

typedef GAS unsigned gu32;
#define RLX_AGENT __ATOMIC_RELAXED, __HIP_MEMORY_SCOPE_AGENT
#define LDS_WAIT() asm volatile("s_waitcnt lgkmcnt(0)" ::: "memory")
#define VM_WAIT() asm volatile("s_waitcnt vmcnt(0)" ::: "memory")
#define XB_TMO      128
#define XB_XCNT(j)  (256  + 64 * (j))
#define XB_XSUB(j)  (1280 + 64 * (j))
#define XB_XGEN(j)  (2304 + 64 * (j))
#define XB_TOP      3328
#define XB_TOPGEN   3392
#define XCD_BAR_WORDS 3456
#define XB_SPIN_CAP (1u << 18)
__device__ __forceinline__ unsigned xb_ld(unsigned* p)              { return __hip_atomic_load(p, __ATOMIC_RELAXED, __HIP_MEMORY_SCOPE_AGENT); }
__device__ __forceinline__ unsigned xb_add(unsigned* p, unsigned v) { return __hip_atomic_fetch_add(p, v, __ATOMIC_RELAXED, __HIP_MEMORY_SCOPE_AGENT); }
__device__ __forceinline__ unsigned xb_xcc_id() { return (unsigned)__builtin_amdgcn_s_getreg((3 << 11) | 20) & 0xFu; }
#define XB_SPIN(cond, bar) do { unsigned _sp = 0; while (cond) { __builtin_amdgcn_s_sleep(1); \
    if ((++_sp & 255u) == 0u) { if (xb_ld(&(bar)[XB_TMO])) break; if (_sp > XB_SPIN_CAP) { atomicAdd(&(bar)[XB_TMO], 1u); break; } } } } while (0)
struct XcdBarrier { unsigned* bar; unsigned x; volatile LAS unsigned* st; };
__device__ __forceinline__ XcdBarrier xcd_barrier_post(unsigned* bar, volatile LAS unsigned* st, const bool leader) {
    XcdBarrier b; b.bar = bar; b.x = xb_xcc_id(); b.st = st;
    if (leader) (void)xb_add(&bar[XB_XCNT(b.x)], 1u);
    return b;
}
__device__ __forceinline__ void xcd_barrier_complete(unsigned* bar, unsigned x, unsigned& nloc, unsigned& nx) {
    const unsigned G = gridDim.x * gridDim.y * gridDim.z;
    unsigned sum, cnt, mine, sp = 0u;
    for (;;) {
        sum = 0u; cnt = 0u; mine = 0u;
#pragma unroll
        for (unsigned j = 0; j < 16; ++j) { const unsigned c = xb_ld(&bar[XB_XCNT(j)]); sum += c; cnt += (c > 0u) ? 1u : 0u; mine = (j == x) ? c : mine; }
        if (sum == G) break;
        __builtin_amdgcn_s_sleep(1);
        if ((++sp & 255u) == 0u) { if (xb_ld(&bar[XB_TMO])) break; if (sp > XB_SPIN_CAP) { atomicAdd(&bar[XB_TMO], 1u); break; } }
    }
    nloc = mine > 0u ? mine : 1u; nx = cnt > 0u ? cnt : 1u;
}
__device__ __forceinline__ void xcd_barrier(const XcdBarrier& b, const bool leader) {
    asm volatile("s_waitcnt vmcnt(0)" ::: "memory");
    __syncthreads();
    if (leader) {
        unsigned* bar = b.bar;
        __builtin_amdgcn_s_waitcnt(0);
        unsigned nloc = b.st[0], nx = b.st[1];
        if (nloc == 0u) { xcd_barrier_complete(bar, b.x, nloc, nx); b.st[0] = nloc; b.st[1] = nx; }
        const unsigned old = xb_add(&bar[XB_XSUB(b.x)], 1u);
        const unsigned gen = old / nloc;
        if (old + 1u == (gen + 1u) * nloc) {
            __builtin_amdgcn_fence(__ATOMIC_RELEASE, "agent");
            asm volatile("s_waitcnt vmcnt(0)" ::: "memory");
            const unsigned og = xb_add(&bar[XB_TOP], 1u);
            const unsigned tg = og / nx;
            if (og + 1u == (tg + 1u) * nx) xb_add(&bar[XB_TOPGEN], 1u);
            else XB_SPIN(xb_ld(&bar[XB_TOPGEN]) == tg, bar);
            __builtin_amdgcn_fence(__ATOMIC_ACQUIRE, "agent");
            xb_add(&bar[XB_XGEN(b.x)], 1u);
            asm volatile("s_waitcnt vmcnt(0)" ::: "memory");
        } else {
            XB_SPIN(xb_ld(&bar[XB_XGEN(b.x)]) == gen, bar);
            __builtin_amdgcn_fence(__ATOMIC_ACQUIRE, "agent");
            asm volatile("s_waitcnt vmcnt(0)" ::: "memory");
        }
    }
    __syncthreads();
}

struct Args { const float* in[18]; float* out; unsigned char* ws; int ph_lo, ph_hi, use_cg, pad; };
enum { I_X = 0, I_NMIX, I_NFFN, I_SWA_QKV, I_SWA_WO, I_SWA_SINK, I_DIFF_QKV, I_DIFF_WO, I_DIFF_LAM, I_DIFF_SUBLN, I_WG, I_BG, I_WR, I_BR, I_GATE, I_UP, I_DOWN, I_FNORM };
typedef const __attribute__((address_space(4))) Args* CArgs;
__device__ __forceinline__ CArgs kargs() { CArgs p = (CArgs)__builtin_amdgcn_kernarg_segment_ptr(); asm volatile("" : "+s"(p)); return p; }
__device__ __forceinline__ int vcu_of(int G) { const int bx = blockIdx.x; return (G % 8 == 0) ? (bx % 8) * (G / 8) + bx / 8 : bx; }

__device__ __forceinline__ void tr_item(const float* W, int N, int k0, int n0, bf16_t* dst, int ldd, LAS float* scr, int lane) {
    f32x4 v[8];
#pragma unroll
    for (int i = 0; i < 8; ++i) v[i] = *(const f32x4*)(W + (size_t)(k0 + 8 * i + (lane >> 3)) * N + n0 + (lane & 7) * 4);
#pragma unroll
    for (int i = 0; i < 8; ++i) { LAS float* p = scr + (8 * i + (lane >> 3)) * 33 + (lane & 7) * 4; p[0] = v[i].x; p[1] = v[i].y; p[2] = v[i].z; p[3] = v[i].w; }
    LDS_WAIT(); asm volatile("" ::: "memory");
    const int c = lane & 7;
#pragma unroll
    for (int j = 0; j < 4; ++j) { const int n = (lane >> 3) + 8 * j; const LAS float* s = scr + (8 * c) * 33 + n;
        u32x4 o; o.x = pk2(s[0 * 33], s[1 * 33]); o.y = pk2(s[2 * 33], s[3 * 33]); o.z = pk2(s[4 * 33], s[5 * 33]); o.w = pk2(s[6 * 33], s[7 * 33]);
        *(GAS u32x4*)(dst + (size_t)n * ldd + k0 + 8 * c) = o; }
    LDS_WAIT(); asm volatile("" ::: "memory");
}
__device__ __forceinline__ void rms_row_to_bf16(const float* xrow, const float* g, bf16_t* orow, int lane) {
    const GAS f32x4* xr = (const GAS f32x4*)xrow + lane; const GAS f32x4* gr = (const GAS f32x4*)g + lane;
    f32x4 v[4]; float s = 0.f;
#pragma unroll
    for (int j = 0; j < 4; ++j) { v[j] = xr[64 * j]; s += (v[j].x * v[j].x + v[j].y * v[j].y) + (v[j].z * v[j].z + v[j].w * v[j].w); }
    const float rstd = 1.f / sqrtf(wave_sum(s) * (1.f / D) + 1e-6f);
    GAS u32x2* o8 = (GAS u32x2*)orow + lane;
#pragma unroll
    for (int j = 0; j < 4; ++j) { const f32x4 gg = gr[64 * j]; u32x2 w; w.x = pk2(v[j].x * rstd * gg.x, v[j].y * rstd * gg.y); w.y = pk2(v[j].z * rstd * gg.z, v[j].w * rstd * gg.w); o8[64 * j] = w; }
}

__device__ __forceinline__ void phase_prologue(LAS unsigned char* lds_in, const int wave_in) {
    int lane = lane_id(); asm volatile("" : "+v"(lane)); int wave = wave_in; asm volatile("" : "+s"(wave)); LAS unsigned char* lds = lds_in; asm volatile("" : "+s"(lds));
    const CArgs a = kargs(); unsigned char* ws = a->ws;
    const int G = gridDim.x, vcu = vcu_of(G);
    LAS float* scr = (LAS float*)(lds + wave * 16384);
    const int gw = vcu * NWAVES + wave, NGW = G * NWAVES;
    bf16_t* swa_qkv_t = (bf16_t*)(ws + WS_SWA_QKV_T); bf16_t* swa_wo_t = (bf16_t*)(ws + WS_SWA_WO_T);
    bf16_t* diff_qkv_t = (bf16_t*)(ws + WS_DIFF_QKV_T); bf16_t* diff_wo_t = (bf16_t*)(ws + WS_DIFF_WO_T);
    constexpr int I0 = 16 * 48, I1 = 16 * 32, I2 = 16 * 96, I3 = 16 * 32, IM = 64 * 768, NITEMS = I0 + I1 + I2 + I3 + IM;
    struct TrItem { const float* src; int N; unsigned char* dstb; int ldb; int f8; };
    auto decode = [&](int it) -> TrItem {
        int r = it; const float* W; int N, k0, n0, ldd; bf16_t* dst; bf16_t* mbase = nullptr; int f8 = 0;
        if (r < I0) { const int kb = r / 48, nb = r % 48; W = a->in[I_SWA_QKV]; N = SWA_N; k0 = 64 * kb; n0 = 32 * nb; dst = swa_qkv_t + (size_t)n0 * D; ldd = D; mbase = swa_qkv_t; f8 = F8_QKV & 1; }
        else if ((r -= I0) < I1) { const int kb = r / 32, nb = r % 32; W = a->in[I_SWA_WO]; N = D; k0 = 64 * kb; n0 = 32 * nb; dst = swa_wo_t + (size_t)n0 * D; ldd = D; }
        else if ((r -= I1) < I2) { const int kb = r / 96, nb = r % 96; W = a->in[I_DIFF_QKV]; N = DIFF_N; k0 = 64 * kb; n0 = 32 * nb; dst = diff_qkv_t + (size_t)n0 * D; ldd = D; mbase = diff_qkv_t; f8 = (F8_QKV >> 1) & 1; }
        else if ((r -= I2) < I3) { const int kb = r / 32, nb = r % 32; W = a->in[I_DIFF_WO]; N = D; k0 = 64 * kb; n0 = 32 * nb; dst = diff_wo_t + (size_t)n0 * D; ldd = D; }
        else { r -= I3; const int le = r / 768, q = r % 768;
            bf16_t* gu = (bf16_t*)(ws + WS_WMOE + (size_t)le * 3 * MiB); bf16_t* dn = gu + (size_t)D * D;
            const bool l1 = le >= 32 || F8_L0;
            if (q < 256) { const int kb = q / 16, c0 = 32 * (q % 16); W = a->in[I_GATE] + (size_t)le * D * DEXP; N = DEXP; k0 = 64 * kb; n0 = c0; dst = gu + (size_t)((c0 >> 7) * 256 + (c0 & 127)) * D; ldd = D; mbase = gu; f8 = ((F8_STAGE & 2) && l1); }
            else if (q < 512) { const int qq = q - 256; const int kb = qq / 16, c0 = 32 * (qq % 16); W = a->in[I_UP] + (size_t)le * D * DEXP; N = DEXP; k0 = 64 * kb; n0 = c0; dst = gu + (size_t)((c0 >> 7) * 256 + 128 + (c0 & 127)) * D; ldd = D; mbase = gu; f8 = ((F8_STAGE & 2) && l1); }
            else { const int qq = q - 512; const int kb = qq / 32, nb = qq % 32; W = a->in[I_DOWN] + (size_t)le * DEXP * D; N = D; k0 = 64 * kb; n0 = 32 * nb; dst = dn + (size_t)n0 * DEXP; ldd = DEXP; mbase = dn; f8 = ((F8_STAGE & 1) && l1); } }
        TrItem t; t.src = W + (size_t)(k0 + (lane >> 3)) * N + n0 + (lane & 7) * 4; t.N = N; t.f8 = f8;
        t.dstb = f8 ? (unsigned char*)mbase + (size_t)(dst - mbase) + k0 + 8 * (lane & 7) : (unsigned char*)(dst + k0 + 8 * (lane & 7)); t.ldb = f8 ? ldd : 2 * ldd; return t;
    };
    {
        f32x4 va[8], vb[8]; TrItem ca, cb;
#define TR_LOAD(v, t) do { _Pragma("unroll") for (int i = 0; i < 8; ++i) v[i] = *(const f32x4*)((t).src + (size_t)(8 * i) * (t).N); } while (0)
#define TR_FINISH(v, t) do { \
            _Pragma("unroll") for (int i = 0; i < 8; ++i) { LAS float* p = scr + (8 * i + (lane >> 3)) * 33 + (lane & 7) * 4; p[0] = v[i].x; p[1] = v[i].y; p[2] = v[i].z; p[3] = v[i].w; } \
            LDS_WAIT(); asm volatile("" ::: "memory"); \
            if ((t).f8) { _Pragma("unroll") for (int j = 0; j < 4; ++j) { const int n = (lane >> 3) + 8 * j; const LAS float* s = scr + (8 * (lane & 7)) * 33 + n; \
                u32x2 o8; o8.x = pk4_fp8(64.f * s[0 * 33], 64.f * s[1 * 33], 64.f * s[2 * 33], 64.f * s[3 * 33]); o8.y = pk4_fp8(64.f * s[4 * 33], 64.f * s[5 * 33], 64.f * s[6 * 33], 64.f * s[7 * 33]); \
                *(GAS u32x2*)((t).dstb + (size_t)n * (t).ldb) = o8; } } \
            else { _Pragma("unroll") for (int j = 0; j < 4; ++j) { const int n = (lane >> 3) + 8 * j; const LAS float* s = scr + (8 * (lane & 7)) * 33 + n; \
                u32x4 o; o.x = pk2(s[0 * 33], s[1 * 33]); o.y = pk2(s[2 * 33], s[3 * 33]); o.z = pk2(s[4 * 33], s[5 * 33]); o.w = pk2(s[6 * 33], s[7 * 33]); \
                *(GAS u32x4*)((t).dstb + (size_t)n * (t).ldb) = o; } } \
            LDS_WAIT(); asm volatile("" ::: "memory"); } while (0)
        const int n_my = gw < NITEMS ? (NITEMS - gw + NGW - 1) / NGW : 0;
        if (n_my > 0) { ca = decode(gw); TR_LOAD(va, ca); }
#pragma unroll 1
        for (int j = 0; j < n_my; j += 2) {
            const int j1 = j + 1 < n_my ? j + 1 : n_my - 1, j2 = j + 2 < n_my ? j + 2 : n_my - 1;
            cb = decode(gw + j1 * NGW); TR_LOAD(vb, cb);
            TR_FINISH(va, ca);
            ca = decode(gw + j2 * NGW); TR_LOAD(va, ca);
            if (j + 1 < n_my) { TR_FINISH(vb, cb); }
        }
#undef TR_LOAD
#undef TR_FINISH
    }
    { bf16_t* wr_t = (bf16_t*)(ws + WS_WR); const int gt = gw * 64 + lane, NGT = NGW * 64;
      for (int i = gt; i < 2 * 36 * D; i += NGT) { const int l = i / (36 * D), rem = i % (36 * D), c = rem / D, k = rem % D;
          const float w = c < 4 ? a->in[I_WG][(size_t)l * D * 4 + k * 4 + c] : a->in[I_WR][(size_t)l * D * 32 + k * 32 + (c - 4)];
          const unsigned h = f2bf(w); const float r = w - __uint_as_float(h << 16);
          wr_t[(size_t)l * 2 * 36 * D + rem] = (bf16_t)h; wr_t[(size_t)l * 2 * 36 * D + 36 * D + rem] = (bf16_t)f2bf(r); } }
    bf16_t* XN = (bf16_t*)(ws + WS_XN);
#pragma unroll 1
    for (int mb = gw * 4; mb < M; mb += NGW * 4) {
        const float* xb = a->in[I_X] + (size_t)mb * D; const GAS f32x4* gr = (const GAS f32x4*)a->in[I_NMIX] + lane;
        f32x4 v[4][4];
#pragma unroll
        for (int r = 0; r < 4; ++r)
#pragma unroll
            for (int j = 0; j < 4; ++j) v[r][j] = ((const GAS f32x4*)(xb + (size_t)r * D) + lane)[64 * j];
        f32x4 gg[4];
#pragma unroll
        for (int j = 0; j < 4; ++j) gg[j] = gr[64 * j];
#pragma unroll
        for (int r = 0; r < 4; ++r) { float s = 0.f;
#pragma unroll
            for (int j = 0; j < 4; ++j) s += (v[r][j].x * v[r][j].x + v[r][j].y * v[r][j].y) + (v[r][j].z * v[r][j].z + v[r][j].w * v[r][j].w);
            const float rstd = 1.f / sqrtf(wave_sum(s) * (1.f / D) + 1e-6f);
            if (F8_QKV & 1) { GAS unsigned* o4 = (GAS unsigned*)((unsigned char*)XN + (size_t)(mb + r) * D) + lane;
#pragma unroll
                for (int j = 0; j < 4; ++j) { const f32x4 n = v[r][j] * (4.f * rstd) * gg[j]; o4[64 * j] = pk4_fp8(n.x, n.y, n.z, n.w); } }
            else { GAS u32x2* o8 = (GAS u32x2*)(XN + (size_t)(mb + r) * D) + lane;
#pragma unroll
                for (int j = 0; j < 4; ++j) { const f32x4 n = v[r][j] * rstd * gg[j]; u32x2 w; w.x = pk2(n.x, n.y); w.y = pk2(n.z, n.w); o8[64 * j] = w; } } }
    }
}

template <int RV, bool F8OUT>
__device__ __forceinline__ void phase_router(LAS unsigned char* lds_in, int layer, const int wave_in, const bool dry) {
    int lane = lane_id(); asm volatile("" : "+v"(lane)); int wave = wave_in; asm volatile("" : "+s"(wave)); LAS unsigned char* lds = lds_in; asm volatile("" : "+s"(lds));
    const CArgs a = kargs(); unsigned char* ws = a->ws;
    const int G = gridDim.x, vcu = vcu_of(G);
    const int gw = vcu * NWAVES + wave, NGW = G * NWAVES;
    const float* g = a->in[I_NFFN] + layer * D;
    const bf16_t* wth = (const bf16_t*)(ws + WS_WR) + (size_t)layer * 2 * 36 * D; const bf16_t* wtl = wth + 36 * D;
    const float* bg = a->in[I_BG] + layer * 4; const float* br = a->in[I_BR] + layer * 32;
    bf16_t* XN = (bf16_t*)(ws + (dry ? WS_SCR : WS_XN)); const float* xin = a->out; float* rstd_tok = (float*)(ws + (dry ? WS_SCR + 80 * MiB : WS_RSTD));
    unsigned* cnt = (unsigned*)(ws + WS_CTL) + CW_CNT + (dry ? 2 : layer) * 1024;
    int* ltok = (int*)(ws + (dry ? WS_SCR + 64 * MiB : WS_LTOK)); float* lw = (float*)(ws + (dry ? WS_SCR + 68 * MiB : WS_LW)); i32x4* tinfo = (i32x4*)(ws + (dry ? WS_SCR + 72 * MiB : WS_TINFO));
    LAS float* lgs = (LAS float*)(lds + 98304 + wave * 4096);
    LAS float* rsl = lgs + 768;
    const int row = lane & 15, kg = lane >> 4;
    const bool c2ok = row < 4;
    LAS unsigned* lcnt = (LAS unsigned*)(lds + TP_OFF); LAS unsigned* lbase = lcnt + 32;
    const int tid = wave * 64 + lane;
#pragma unroll 1
    for (int bt0 = 0; bt0 < M / 16; bt0 += NGW) {
        const int bt = bt0 + gw; const bool live = bt < M / 16;
        const int t0 = (live ? bt : 0) * 16;
        if (tid < 32) lcnt[tid] = 0u;
        const char* xrow = (const char*)(xin + (size_t)(t0 + row) * D) + kg * 32;
        const char* grow = (const char*)g + kg * 32;
        char* orow = (char*)(XN + (size_t)(t0 + row) * D) + kg * 16;
        const char* w0 = (const char*)(wth + (size_t)row * D) + kg * 16;
        f32x4 acc0 = {0.f, 0.f, 0.f, 0.f}, acc1 = acc0, acc2 = acc0; float ss = 0.f;
        const unsigned m2 = c2ok ? 0xffffffffu : 0u;
        {
            f32x4 xa[3] = {}, xb[3] = {}, ga[3] = {}, gb[3] = {};
            const char* xbase = (const char*)(xin + (size_t)t0 * D); const unsigned xoff = (unsigned)(row * D * 4 + kg * 32);
            const char* gbase = (const char*)g; const unsigned goff = (unsigned)(kg * 32);
            const char* wb0h = (const char*)wth; const char* wb0l = wb0h + 36 * D * 2; const char* wb1h = wb0h + 16 * D * 2; const char* wb1l = wb0h + 52 * D * 2;
            char* obase = live ? (char*)XN + (size_t)t0 * D * (F8OUT ? 1 : 2) : (char*)(ws + WS_SCR + 100 * MiB); const unsigned ooff = F8OUT ? (unsigned)(row * D + kg * 8) : (unsigned)(row * D * 2 + kg * 16);
            const unsigned woff = (unsigned)((row * D + kg * 8) * 2) + (unsigned)wave * 64u, woff2 = (unsigned)(((32 + (row & 3)) * D + kg * 8) * 2) + (unsigned)wave * 64u;
            LAS unsigned char* bfill = lds + wave * 6144 + lane * 16;
            const LAS unsigned char* bread = lds + lane * 16;
            u32x4 fr0, fr1, fr2, fr3, fr4, fr5;
#define RT_BLOAD(c) do { fr0 = *(const u32x4*)(wb0h + woff + (c) * 512); fr1 = *(const u32x4*)(wb0l + woff + (c) * 512); fr2 = *(const u32x4*)(wb1h + woff + (c) * 512); \
            fr3 = *(const u32x4*)(wb1l + woff + (c) * 512); fr4 = *(const u32x4*)(wb0h + woff2 + (c) * 512); fr5 = *(const u32x4*)(wb0l + woff2 + (c) * 512); } while (0)
#define RT_BWRITE(buf) do { fr4.x &= m2; fr4.y &= m2; fr4.z &= m2; fr4.w &= m2; fr5.x &= m2; fr5.y &= m2; fr5.z &= m2; fr5.w &= m2; \
            *(LAS u32x4*)(bfill + (buf) * 49152) = fr0; *(LAS u32x4*)(bfill + (buf) * 49152 + 1024) = fr1; *(LAS u32x4*)(bfill + (buf) * 49152 + 2048) = fr2; \
            *(LAS u32x4*)(bfill + (buf) * 49152 + 3072) = fr3; *(LAS u32x4*)(bfill + (buf) * 49152 + 4096) = fr4; *(LAS u32x4*)(bfill + (buf) * 49152 + 5120) = fr5; } while (0)
#define RT_BAR() asm volatile("s_waitcnt lgkmcnt(0)\n\ts_barrier" ::: "memory")
#define RT_LOAD(st, s) do { if (!(RV & 2)) { xa[st] = *(const f32x4*)(xbase + xoff + (s) * 128); xb[st] = *(const f32x4*)(xbase + xoff + (s) * 128 + 16); } \
            ga[st] = *(const f32x4*)(gbase + goff + (s) * 128); gb[st] = *(const f32x4*)(gbase + goff + (s) * 128 + 16); } while (0)
            RT_BLOAD(0); RT_LOAD(0, 0); RT_LOAD(1, 1);
            RT_BWRITE(0); RT_BLOAD(1);
            RT_BAR();
#pragma unroll
            for (int s = 0; s < 32; ++s) {
                const int st = s % 3, c = s >> 3, sl = s & 7;
                if (sl == 0 && c + 1 < 4) { RT_BWRITE((c + 1) & 1); if (c + 2 < 4) { RT_BLOAD(c + 2); } }
                if (s + 2 < 32) { RT_LOAD((s + 2) % 3, s + 2); }
                __builtin_amdgcn_sched_barrier(0);
                const LAS unsigned char* bp = bread + (c & 1) * 49152 + sl * 6144;
                const bf16x8 b0h = *(const LAS bf16x8*)(bp), b0l = *(const LAS bf16x8*)(bp + 1024), b1h = *(const LAS bf16x8*)(bp + 2048), b1l = *(const LAS bf16x8*)(bp + 3072),
                             b2h = *(const LAS bf16x8*)(bp + 4096), b2l = *(const LAS bf16x8*)(bp + 5120);
                const f32x4 xa_ = xa[st], xb_ = xb[st];
                ss += (xa_.x * xa_.x + xa_.y * xa_.y) + (xa_.z * xa_.z + xa_.w * xa_.w) + (xb_.x * xb_.x + xb_.y * xb_.y) + (xb_.z * xb_.z + xb_.w * xb_.w);
                const f32x4 ya = xa_ * ga[st], yb = xb_ * gb[st];
                u32x4 hi; hi.x = cvtpk(ya.x, ya.y); hi.y = cvtpk(ya.z, ya.w); hi.z = cvtpk(yb.x, yb.y); hi.w = cvtpk(yb.z, yb.w);
                u32x4 lo; lo.x = cvtpk(ya.x - __uint_as_float(hi.x << 16), ya.y - __uint_as_float(hi.x & 0xffff0000u)); lo.y = cvtpk(ya.z - __uint_as_float(hi.y << 16), ya.w - __uint_as_float(hi.y & 0xffff0000u));
                lo.z = cvtpk(yb.x - __uint_as_float(hi.z << 16), yb.y - __uint_as_float(hi.z & 0xffff0000u)); lo.w = cvtpk(yb.z - __uint_as_float(hi.w << 16), yb.w - __uint_as_float(hi.w & 0xffff0000u));
                if constexpr (F8OUT) { u32x2 q8; q8.x = pk4_fp8(4.f * ya.x, 4.f * ya.y, 4.f * ya.z, 4.f * ya.w); q8.y = pk4_fp8(4.f * yb.x, 4.f * yb.y, 4.f * yb.z, 4.f * yb.w); *(u32x2*)(obase + ooff + s * 32) = q8; }
                else if (!(RV & 1)) *(u32x4*)(obase + ooff + s * 64) = hi;
                const bf16x8 ah = __builtin_bit_cast(bf16x8, hi), al = __builtin_bit_cast(bf16x8, lo);
                acc0 = __builtin_amdgcn_mfma_f32_16x16x32_bf16(ah, b0h, acc0, 0, 0, 0); acc0 = __builtin_amdgcn_mfma_f32_16x16x32_bf16(ah, b0l, acc0, 0, 0, 0); acc0 = __builtin_amdgcn_mfma_f32_16x16x32_bf16(al, b0h, acc0, 0, 0, 0);
                acc1 = __builtin_amdgcn_mfma_f32_16x16x32_bf16(ah, b1h, acc1, 0, 0, 0); acc1 = __builtin_amdgcn_mfma_f32_16x16x32_bf16(ah, b1l, acc1, 0, 0, 0); acc1 = __builtin_amdgcn_mfma_f32_16x16x32_bf16(al, b1h, acc1, 0, 0, 0);
                acc2 = __builtin_amdgcn_mfma_f32_16x16x32_bf16(ah, b2h, acc2, 0, 0, 0); acc2 = __builtin_amdgcn_mfma_f32_16x16x32_bf16(ah, b2l, acc2, 0, 0, 0); acc2 = __builtin_amdgcn_mfma_f32_16x16x32_bf16(al, b2h, acc2, 0, 0, 0);
                __builtin_amdgcn_sched_barrier(0);
                if (sl == 7 && c + 1 < 4) { RT_BAR(); }
            }
            RT_BAR();
#undef RT_LOAD
#undef RT_BLOAD
#undef RT_BWRITE
#undef RT_BAR
        }
        ss += __shfl_xor(ss, 16); ss += __shfl_xor(ss, 32);
        const float rstd = 1.f / sqrtf(ss * (1.f / D) + 1e-6f);
        if (kg == 0) { rsl[row] = rstd; if (live) rstd_tok[t0 + row] = rstd; }
#pragma unroll
        for (int j = 0; j < 4; ++j) { lgs[(4 * kg + j) * 48 + row] = acc0[j]; lgs[(4 * kg + j) * 48 + 16 + row] = acc1[j]; lgs[(4 * kg + j) * 48 + 32 + row] = acc2[j]; }
        LDS_WAIT(); asm volatile("" ::: "memory");
        int e1 = 0, e2 = 0, lp1 = 0, lp2 = 0; float w1 = 0.f, w2 = 0.f;
        const bool act = live && lane < 16 && !(RV & 4);
        __syncthreads();
        if (act) {
            const float rs = rsl[lane];
            float acc[36];
#pragma unroll
            for (int q = 0; q < 9; ++q) { const f32x4 x = *(const LAS f32x4*)(lgs + lane * 48 + 4 * q); acc[4 * q] = x.x * rs; acc[4 * q + 1] = x.y * rs; acc[4 * q + 2] = x.z * rs; acc[4 * q + 3] = x.w * rs; }
            float lgv[4]; int gs = 0;
#pragma unroll
            for (int c = 0; c < 4; ++c) lgv[c] = acc[c] + bg[c];
            float mx = lgv[0];
#pragma unroll
            for (int c = 1; c < 4; ++c) if (lgv[c] > mx) { mx = lgv[c]; gs = c; }
            float den = 0.f;
#pragma unroll
            for (int c = 0; c < 4; ++c) den += __expf(lgv[c] - mx);
            const float pg = 1.f / den;
            float le[8];
#pragma unroll
            for (int k = 0; k < 8; ++k) { const float a0 = acc[4 + k] + br[k], a1 = acc[12 + k] + br[8 + k], a2 = acc[20 + k] + br[16 + k], a3 = acc[28 + k] + br[24 + k];
                le[k] = gs == 0 ? a0 : (gs == 1 ? a1 : (gs == 2 ? a2 : a3)); }
            int i1 = 0; float m1 = le[0];
#pragma unroll
            for (int k = 1; k < 8; ++k) if (le[k] > m1) { m1 = le[k]; i1 = k; }
            int i2 = -1; float m2 = -INFINITY;
#pragma unroll
            for (int k = 0; k < 8; ++k) if (k != i1 && (i2 < 0 || le[k] > m2)) { m2 = le[k]; i2 = k; }
            const float ex = __expf(m2 - m1); const float tp1 = 1.f / (1.f + ex), tp2 = ex * tp1;
            w1 = pg * tp1; w2 = pg * tp2; e1 = gs * 8 + i1; e2 = gs * 8 + i2;
            lp1 = (int)__hip_atomic_fetch_add(lcnt + e1, 1u, __ATOMIC_RELAXED, __HIP_MEMORY_SCOPE_WORKGROUP);
            lp2 = (int)__hip_atomic_fetch_add(lcnt + e2, 1u, __ATOMIC_RELAXED, __HIP_MEMORY_SCOPE_WORKGROUP);
        }
        __syncthreads();
        if (tid < 32) { const unsigned c = lcnt[tid]; lbase[tid] = c ? __hip_atomic_fetch_add(cnt + 32 * tid, c, __ATOMIC_RELAXED, __HIP_MEMORY_SCOPE_AGENT) : 0u; }
        __syncthreads();
        if (act) {
            const int t = t0 + lane; const int p1 = (int)lbase[e1] + lp1, p2 = (int)lbase[e2] + lp2;
            ltok[(size_t)e1 * M + p1] = t; lw[(size_t)e1 * M + p1] = w1; ltok[(size_t)e2 * M + p2] = t; lw[(size_t)e2 * M + p2] = w2;
            tinfo[t] = (i32x4){e1, p1, e2, p2};
        }
        LDS_WAIT(); asm volatile("" ::: "memory");
        __syncthreads();
    }
}

__device__ __forceinline__ void moe_tables(LAS unsigned char* lds, unsigned char* ws, int layer, const int wave, const int lane) {
    LAS int* TP = (LAS int*)(lds + TP_OFF); LAS int* CNT = TP + 40;
    unsigned* cnt = (unsigned*)(ws + WS_CTL) + CW_CNT + layer * 1024;
    const int tid = wave * 64 + lane;
    __syncthreads();
    if (tid < 32) CNT[tid] = (int)__hip_atomic_load(cnt + 32 * tid, RLX_AGENT);
    __syncthreads();
    if (tid == 0) { int s = 0; for (int e = 0; e < 32; ++e) { TP[e] = s; s += (CNT[e] + 255) >> 8; } TP[32] = s; }
    __syncthreads();
}

__device__ __forceinline__ void phase_combine(LAS unsigned char* lds_in, int layer, const int wave_in, const bool dry) {
    int lane = lane_id(); asm volatile("" : "+v"(lane)); int wave = wave_in; asm volatile("" : "+s"(wave)); LAS unsigned char* lds = lds_in; asm volatile("" : "+s"(lds));
    const CArgs a = kargs(); unsigned char* ws = a->ws;
    moe_tables(lds, ws, layer, wave, lane);
    const bool final_ = layer == 1; const float* gnext = layer == 0 ? a->in[I_NMIX] + D : a->in[I_FNORM]; float* xio = a->out;
    const int G = gridDim.x, vcu = vcu_of(G);
    const int gw = vcu * NWAVES + wave, NGW = G * NWAVES;
    const LAS int* TP = (const LAS int*)(lds + TP_OFF);
    const bf16_t* Y = (const bf16_t*)(ws + WS_Y); const i32x4* tinfo = (const i32x4*)(ws + WS_TINFO); bf16_t* XN = (bf16_t*)(ws + WS_XN);
#pragma unroll 1
    for (int tb = gw * 4; tb < M; tb += NGW * 4) {
        size_t s1[4], s2[4];
#pragma unroll
        for (int r = 0; r < 4; ++r) { const i32x4 ti = tinfo[tb + r]; s1[r] = (size_t)TP[ti.x] * 256 + ti.y; s2[r] = (size_t)TP[ti.z] * 256 + ti.w; }
        f32x4 v[4][4]; u32x2 p[4][4], q[4][4];
#pragma unroll
        for (int r = 0; r < 4; ++r) {
            const GAS f32x4* xr = (const GAS f32x4*)(xio + (size_t)(tb + r) * D) + lane;
            const GAS u32x2* y1 = (const GAS u32x2*)(Y + s1[r] * D) + lane; const GAS u32x2* y2 = (const GAS u32x2*)(Y + s2[r] * D) + lane;
#pragma unroll
            for (int j = 0; j < 4; ++j) { v[r][j] = xr[64 * j]; p[r][j] = y1[64 * j]; q[r][j] = y2[64 * j]; }
        }
        f32x4 gg[4];
#pragma unroll
        for (int j = 0; j < 4; ++j) gg[j] = ((const GAS f32x4*)gnext + lane)[64 * j];
#pragma unroll
        for (int r = 0; r < 4; ++r) {
            float s = 0.f;
#pragma unroll
            for (int j = 0; j < 4; ++j) { const u32x2 pp = p[r][j], qq = q[r][j];
                f32x4 ya, yb; ya.x = __uint_as_float(pp.x << 16); ya.y = __uint_as_float(pp.x & 0xffff0000u); ya.z = __uint_as_float(pp.y << 16); ya.w = __uint_as_float(pp.y & 0xffff0000u);
                yb.x = __uint_as_float(qq.x << 16); yb.y = __uint_as_float(qq.x & 0xffff0000u); yb.z = __uint_as_float(qq.y << 16); yb.w = __uint_as_float(qq.y & 0xffff0000u);
                v[r][j] = v[r][j] + (ya + yb); s += (v[r][j].x * v[r][j].x + v[r][j].y * v[r][j].y) + (v[r][j].z * v[r][j].z + v[r][j].w * v[r][j].w); }
            const float rstd = 1.f / sqrtf(wave_sum(s) * (1.f / D) + 1e-6f);
            GAS f32x4* xw = (GAS f32x4*)(xio + (size_t)(tb + r) * D) + lane;
            if (final_) {
#pragma unroll
                for (int j = 0; j < 4; ++j) if (!dry) xw[64 * j] = v[r][j] * rstd * gg[j];
            } else {
                if (F8_QKV & 2) { GAS unsigned* o4 = (GAS unsigned*)((unsigned char*)XN + (size_t)(tb + r) * D) + lane;
#pragma unroll
                    for (int j = 0; j < 4; ++j) { if (!dry) xw[64 * j] = v[r][j]; const f32x4 n = v[r][j] * (4.f * rstd) * gg[j]; o4[64 * j] = pk4_fp8(n.x, n.y, n.z, n.w); } }
                else { GAS u32x2* o8 = (GAS u32x2*)(XN + (size_t)(tb + r) * D) + lane;
#pragma unroll
                    for (int j = 0; j < 4; ++j) { if (!dry) xw[64 * j] = v[r][j]; const f32x4 n = v[r][j] * rstd * gg[j]; u32x2 w; w.x = pk2(n.x, n.y); w.y = pk2(n.z, n.w); o8[64 * j] = w; } }
            }
        }
    }
}

__device__ __forceinline__ float diff_lambda_full(const float* lam, int lane) {
    const float a = wave_sum(lam[lane] * lam[64 + lane]), b = wave_sum(lam[128 + lane] * lam[192 + lane]);
    return __expf(a) - __expf(b) + LAMBDA_INIT;
}

__device__ __forceinline__ void phase_qkv(LAS unsigned char* lds_in, int layer, const int wave_in) {
    int lane = lane_id(); asm volatile("" : "+v"(lane)); int wave = wave_in; asm volatile("" : "+s"(wave)); LAS unsigned char* lds = lds_in; asm volatile("" : "+s"(lds));
    const CArgs a = kargs(); unsigned char* ws = a->ws;
    const int N = layer == 0 ? SWA_N : DIFF_N;
    pg8::DenseOrder S; S.init(M, N, (int)gridDim.x, (int)blockIdx.x);
    pg8::EpiQKV E{(bf16_t*)(ws + WS_QKV), N, 1024, QSCALE, layer == 1 ? (unsigned*)(ws + WS_CTL) + CW_KMAX : nullptr};
    if ((F8_QKV >> layer) & 1) { pg8::Gemm g{(const bf16_t*)(ws + WS_XN), (const bf16_t*)(ws + (layer == 0 ? WS_SWA_QKV_T : WS_DIFF_QKV_T)), D / 2, 0x79797979u, 0x7d7d7d7du};
        pg8::gemm_phase<pg8::EpiQKV, pg8::DenseOrder, false, true, true>(lds, g, S, E, wave, lane); }
    else { pg8::Gemm g{(const bf16_t*)(ws + WS_XN), (const bf16_t*)(ws + (layer == 0 ? WS_SWA_QKV_T : WS_DIFF_QKV_T)), D};
        pg8::gemm_phase<pg8::EpiQKV, pg8::DenseOrder, false, true>(lds, g, S, E, wave, lane); }
}
__device__ __forceinline__ void phase_oproj(LAS unsigned char* lds_in, int layer, const int wave_in) {
    int lane = lane_id(); asm volatile("" : "+v"(lane)); int wave = wave_in; asm volatile("" : "+s"(wave)); LAS unsigned char* lds = lds_in; asm volatile("" : "+s"(lds));
    const CArgs a = kargs(); unsigned char* ws = a->ws;
    pg8::Gemm g{(const bf16_t*)(ws + WS_O), (const bf16_t*)(ws + (layer == 0 ? WS_SWA_WO_T : WS_DIFF_WO_T)), D};
    pg8::DenseOrder S; S.init(M, D, (int)gridDim.x, (int)blockIdx.x);
    pg8::EpiResid E{layer == 0 ? a->in[I_X] : (const float*)a->out, a->out};
    pg8::gemm_phase<pg8::EpiResid, pg8::DenseOrder, false, true>(lds, g, S, E, wave, lane);
}
__device__ __forceinline__ void phase_moe1(LAS unsigned char* lds_in, int layer, const int wave_in) {
    int lane = lane_id(); asm volatile("" : "+v"(lane)); int wave = wave_in; asm volatile("" : "+s"(wave)); LAS unsigned char* lds = lds_in; asm volatile("" : "+s"(lds));
    const CArgs a = kargs(); unsigned char* ws = a->ws;
    moe_tables(lds, ws, layer, wave, lane);
    const LAS int* TP = (const LAS int*)(lds + TP_OFF); const LAS int* CNT = TP + 40;
    if ((F8_STAGE & 2) && (layer == 1 || F8_L0)) {
        pg8::Gemm g{(const bf16_t*)(ws + WS_XN), (const bf16_t*)(ws + WS_WMOE + (size_t)layer * 96 * MiB), D / 2, 0x79797979u, 0x7d7d7d7du};
        pg8::MoeOrder S{TP, CNT, (const int*)(ws + WS_LTOK), (int)gridDim.x, (int)blockIdx.x, 12, 0};
        if (F8_STAGE & 1) { pg8::EpiSwiGLU<true> E{(bf16_t*)(ws + WS_H), (const int*)(ws + WS_LTOK), (const float*)(ws + WS_RSTD), CNT};
            pg8::gemm_phase<pg8::EpiSwiGLU<true>, pg8::MoeOrder, true, true, true>(lds, g, S, E, wave, relaunder(lane)); }
        else { pg8::EpiSwiGLU<false> E{(bf16_t*)(ws + WS_H), (const int*)(ws + WS_LTOK), (const float*)(ws + WS_RSTD), CNT};
            pg8::gemm_phase<pg8::EpiSwiGLU<false>, pg8::MoeOrder, true, true, true>(lds, g, S, E, wave, relaunder(lane)); }
    } else if ((F8_STAGE & 1) && layer == 1) {
        pg8::Gemm g{(const bf16_t*)(ws + WS_XN), (const bf16_t*)(ws + WS_WMOE + (size_t)layer * 96 * MiB), D};
        pg8::MoeOrder S{TP, CNT, (const int*)(ws + WS_LTOK), (int)gridDim.x, (int)blockIdx.x, 6, 0};
        pg8::EpiSwiGLU<true> E{(bf16_t*)(ws + WS_H), (const int*)(ws + WS_LTOK), (const float*)(ws + WS_RSTD), CNT};
        pg8::gemm_phase<pg8::EpiSwiGLU<true>, pg8::MoeOrder, true, true>(lds, g, S, E, wave, relaunder(lane));
    } else {
        pg8::Gemm g{(const bf16_t*)(ws + WS_XN), (const bf16_t*)(ws + WS_WMOE + (size_t)layer * 96 * MiB), D};
        pg8::MoeOrder S{TP, CNT, (const int*)(ws + WS_LTOK), (int)gridDim.x, (int)blockIdx.x, 6, 0};
        pg8::EpiSwiGLU<false> E{(bf16_t*)(ws + WS_H), (const int*)(ws + WS_LTOK), (const float*)(ws + WS_RSTD), CNT};
        pg8::gemm_phase<pg8::EpiSwiGLU<false>, pg8::MoeOrder, true, true>(lds, g, S, E, wave, relaunder(lane));
    }
}
__device__ __forceinline__ void phase_moe2(LAS unsigned char* lds_in, int layer, const int wave_in) {
    int lane = lane_id(); asm volatile("" : "+v"(lane)); int wave = wave_in; asm volatile("" : "+s"(wave)); LAS unsigned char* lds = lds_in; asm volatile("" : "+s"(lds));
    const CArgs a = kargs(); unsigned char* ws = a->ws;
    moe_tables(lds, ws, layer, wave, lane);
    const LAS int* TP = (const LAS int*)(lds + TP_OFF); const LAS int* CNT = TP + 40;
    pg8::EpiDown E{(bf16_t*)(ws + WS_Y), (const float*)(ws + WS_LW)};
    if ((F8_STAGE & 1) && layer == 1) {
        pg8::Gemm g{(const bf16_t*)(ws + WS_H), (const bf16_t*)(ws + WS_WMOE + (size_t)layer * 96 * MiB), DEXP / 2, 0x79797979u, 0x7c7c7c7cu};
        pg8::MoeOrder S{TP, CNT, (const int*)(ws + WS_LTOK), (int)gridDim.x, (int)blockIdx.x, 24, 16};
        pg8::gemm_phase<pg8::EpiDown, pg8::MoeOrder, false, true, true>(lds, g, S, E, wave, relaunder(lane));
    } else {
        pg8::Gemm g{(const bf16_t*)(ws + WS_H), (const bf16_t*)(ws + WS_WMOE + (size_t)layer * 96 * MiB), DEXP};
        pg8::MoeOrder S{TP, CNT, (const int*)(ws + WS_LTOK), (int)gridDim.x, (int)blockIdx.x, 12, 8};
        pg8::gemm_phase<pg8::EpiDown, pg8::MoeOrder, false, true>(lds, g, S, E, wave, relaunder(lane));
    }
}
__device__ __forceinline__ void phase_attn(LAS unsigned char* lds_in, int layer, const int wave_in, const bool dry) {
    int lane = lane_id(); asm volatile("" : "+v"(lane)); int wave = wave_in; asm volatile("" : "+s"(wave)); LAS unsigned char* lds = lds_in; asm volatile("" : "+s"(lds));
    const CArgs a = kargs(); unsigned char* ws = a->ws;
    const int G = gridDim.x, vcu = vcu_of(G);
    const bf16_t* QKV = (const bf16_t*)(ws + WS_QKV); bf16_t* OB = (bf16_t*)(ws + WS_O);
    if (layer == 0) {
        att::DiffConsts dc{0.f, nullptr, 0.f, 0.f, 0.f, 0.f}; const float* sink = a->in[I_SWA_SINK];
#pragma unroll 1
        for (int i = 0; i < 2048; ++i) { const int id = vcu + G * i; if (id >= 2048) break; const int bk = id >> 7, qb = id & 127;
            att::attn_unit<0>(bk >> 2, bk & 3, qb, QKV, OB, sink, dc, lds, wave, lane); }
    } else {
        const float* sg = a->in[I_DIFF_SUBLN] + (lane & 31); const float sgs = 1.f - LAMBDA_INIT;
        att::DiffConsts dc{diff_lambda_full(a->in[I_DIFF_LAM], lane), a->in[I_DIFF_SUBLN], sg[0] * sgs, sg[32] * sgs, sg[64] * sgs, sg[96] * sgs};
        const unsigned* kmaxsq = (const unsigned*)(ws + WS_CTL) + CW_KMAX;
#pragma unroll 1
        for (int i = 0; i < 2048; ++i) { const int id = vcu + G * i; if (id >= 2048) break; const int h = id >> 8, bq = id & 255, b = bq >> 6;
            const int qb = ((0xD8 >> h) & 1) ? ((bq + 32) & 63) : (bq & 63);
            const int cm = wave >> 2, gi = b * 32 + 2 * (2 * h + cm);
            const float kmax = sqrtf(__uint_as_float(__hip_atomic_load(kmaxsq + gi, RLX_AGENT)) + __uint_as_float(__hip_atomic_load(kmaxsq + gi + 1, RLX_AGENT))) * 1.01f;
            if (ATT_PROBE_VARIANT != 0 && dry) att::diff_unit<ATT_PROBE_VARIANT>(b, h, qb, QKV, (bf16_t*)(ws + WS_XN), kmax, dc, lds, wave, lane);
            else att::diff_unit<0>(b, h, qb, QKV, OB, kmax, dc, lds, wave, lane); }
    }
}

__global__ void __launch_bounds__(NWAVES * 64, 2) mega_fwd(Args args_by_value) {
    extern __shared__ __attribute__((aligned(16))) unsigned char lds_raw[];
    LAS unsigned char* lds = (LAS unsigned char*)lds_raw;
    const int wave = __builtin_amdgcn_readfirstlane((int)(threadIdx.x >> 6));
    int lo, hi;
    { const CArgs a = kargs(); lo = a->ph_lo; hi = a->ph_hi;
      if (a->use_cg) cg::this_grid().sync(); }
    { const int tid = wave * 64 + lane_id();
      for (int u = tid; u < (LDS_BYTES - LDSCTL_OFF) / 4; u += NWAVES * 64) ((LAS unsigned*)(lds + LDSCTL_OFF))[u] = 0u; }
    __syncthreads();
    if (N_LAUNCHES == 1) { const CArgs a = kargs(); (void)xcd_barrier_post((unsigned*)(a->ws + WS_CTL) + CW_BAR, (volatile LAS unsigned*)(lds + MISC_OFF) + 8, wave == 0 && lane_id() == 0); }
    int rep_left = REP_COUNT;
    unsigned long long tp_prev = 0, tp_acc = 0;
    if (TPROBE_MASK != 0) tp_prev = __builtin_amdgcn_s_memrealtime();
#pragma unroll 1
    for (int ph = lo; ph < hi; ++ph) {
        const int layer = ph >= 8 ? 1 : 0, kind = ph == 0 ? 0 : ph - 7 * layer;
        const bool dry = REP_COUNT > 0 && ph == REP_PHASE && rep_left > 0;
        switch (kind) {
            case 0: phase_prologue(lds, wave); break;
            case 1: phase_qkv(lds, layer, wave); break;
            case 2: phase_attn(lds, layer, wave, dry); break;
            case 3: phase_oproj(lds, layer, wave); break;
            case 4: if (ROUTER_PROBE != 0 && dry) phase_router<ROUTER_PROBE, false>(lds, layer, wave, dry); else if ((F8_STAGE & 2) && (layer == 1 || F8_L0)) phase_router<0, true>(lds, layer, wave, dry); else phase_router<0, false>(lds, layer, wave, dry); break;
            case 5: phase_moe1(lds, layer, wave); break;
            case 6: phase_moe2(lds, layer, wave); break;
            default: phase_combine(lds, layer, wave, dry); break;
        }
        if (ph + 1 < hi) { const CArgs a = kargs(); XcdBarrier bar; bar.bar = (unsigned*)(a->ws + WS_CTL) + CW_BAR; bar.x = xb_xcc_id(); bar.st = (volatile LAS unsigned*)(lds + MISC_OFF) + 8;
            xcd_barrier(bar, wave == 0 && lane_id() == 0);
        }
        if (TPROBE_MASK != 0) { const unsigned long long tn = __builtin_amdgcn_s_memrealtime(); if ((TPROBE_MASK >> ph) & 1) tp_acc += tn - tp_prev; tp_prev = tn; }
        if (REP_COUNT > 0 && ph == REP_PHASE && rep_left > 0) { --rep_left; --ph; }
        if (EXTRA_BARRIERS > 0 && ph == 3) { for (int xb = 0; xb < EXTRA_BARRIERS; ++xb) { const CArgs a = kargs(); XcdBarrier bar; bar.bar = (unsigned*)(a->ws + WS_CTL) + CW_BAR; bar.x = xb_xcc_id(); bar.st = (volatile LAS unsigned*)(lds + MISC_OFF) + 8; xcd_barrier(bar, wave == 0 && lane_id() == 0); } }
    }
    if (TPROBE_MASK != 0 && blockIdx.x == 0 && wave == 0) { const unsigned long long t0 = __builtin_amdgcn_s_memrealtime(); while (__builtin_amdgcn_s_memrealtime() - t0 < TPROBE_K * tp_acc) __builtin_amdgcn_s_sleep(8); }
}

extern "C" void kernel_launch(void* const* d_in, const int* in_sizes, int n_in, void* d_out, int out_size, void* d_ws, size_t ws_size, hipStream_t stream) {
    static int grid = 0;
    if (grid == 0) {
        if (n_in != 18 || in_sizes[0] != M * D || out_size != M * D || ws_size < WS_END) {
            fprintf(stderr, "kernel_launch: unexpected shapes: n_in %d in0 %d out %d ws %zu (need %zu)\n", n_in, n_in > 0 ? in_sizes[0] : -1, out_size, ws_size, (size_t)WS_END); grid = -1; return; }
        int dev = 0, cus = 0, per_cu = 0;
        if (hipGetDevice(&dev) != hipSuccess || hipDeviceGetAttribute(&cus, hipDeviceAttributeMultiprocessorCount, dev) != hipSuccess) { fprintf(stderr, "kernel_launch: device query failed\n"); grid = -1; return; }
        if (hipFuncSetAttribute((const void*)mega_fwd, hipFuncAttributeMaxDynamicSharedMemorySize, LDS_BYTES) != hipSuccess) { fprintf(stderr, "kernel_launch: hipFuncSetAttribute failed\n"); grid = -1; return; }
        if (hipOccupancyMaxActiveBlocksPerMultiprocessor(&per_cu, (const void*)mega_fwd, NWAVES * 64, LDS_BYTES) != hipSuccess || per_cu < 1) { fprintf(stderr, "kernel_launch: occupancy query says %d\n", per_cu); per_cu = 1; }
        (void)hipGetLastError();
        grid = cus;
    }
    if (grid < 0) return;
    (void)hipMemsetAsync((char*)d_ws + WS_CTL, 0, CTL_ZERO_BYTES, stream);
    Args a{};
    for (int i = 0; i < 18; ++i) a.in[i] = (const float*)d_in[i];
    a.out = (float*)d_out; a.ws = (unsigned char*)d_ws; a.use_cg = 0; a.pad = 0;
    if (N_LAUNCHES == 1) {
        a.ph_lo = 0; a.ph_hi = N_PHASES;
        void* kargs_[] = {&a};
        hipError_t e = hipLaunchCooperativeKernel((const void*)mega_fwd, dim3(grid), dim3(NWAVES * 64), kargs_, LDS_BYTES, stream);
        if (e != hipSuccess) fprintf(stderr, "kernel_launch: cooperative launch failed: %s (grid %d)\n", hipGetErrorString(e), grid);
    } else {
        for (int p = 0; p < N_PHASES; ++p) { a.ph_lo = p; a.ph_hi = p + 1; hipLaunchKernelGGL(mega_fwd, dim3(grid), dim3(NWAVES * 64), LDS_BYTES, stream, a); }
    }
}
```

```cpp
#include <hip/hip_runtime.h>
#include <hip/hip_cooperative_groups.h>
#include <cstdio>
#include <cstdint>
namespace cg = cooperative_groups;

#ifndef MK_N_LAUNCHES
#define MK_N_LAUNCHES 1
#endif
constexpr int N_PHASES = 15;
#define F8_STAGE 2
#define F8_L0 1
#define F8_QKV 2
#define REP_PHASE -1
#define REP_COUNT 0
#define ATT_PROBE_VARIANT 0
#define EXTRA_BARRIERS 0
#define ROUTER_PROBE 0
#define TPROBE_MASK 0
#define TPROBE_K 4
constexpr int N_LAUNCHES = MK_N_LAUNCHES;

#define LAS __attribute__((address_space(3)))
#define GAS __attribute__((address_space(1)))
typedef unsigned short bf16_t;
typedef short bf16x8 __attribute__((ext_vector_type(8)));
typedef short s16x4 __attribute__((ext_vector_type(4)));
typedef float f32x2 __attribute__((ext_vector_type(2)));
typedef float f32x4 __attribute__((ext_vector_type(4)));
typedef float f32x16 __attribute__((ext_vector_type(16)));
typedef unsigned u32x2 __attribute__((ext_vector_type(2)));
typedef unsigned u32x4 __attribute__((ext_vector_type(4)));
typedef int i32x4 __attribute__((ext_vector_type(4)));
typedef int i32x8 __attribute__((ext_vector_type(8)));
typedef __bf16 bf16x2_t __attribute__((ext_vector_type(2)));

constexpr int D = 1024, BATCH = 4, SEQ = 8192, M = BATCH * SEQ;
constexpr int SWA_N = 1536, DIFF_N = 3072;
constexpr int NEXP = 32, DEXP = 512;
constexpr float LOG2E = 1.4426950408889634f;
constexpr float QSCALE = 0.125f * LOG2E;
constexpr float LAMBDA_INIT = 0.35550906759f;
constexpr int NWAVES = 8;

constexpr size_t MiB = 1u << 20;
constexpr size_t WS_CTL = 0, CTL_ZERO_BYTES = 1 * MiB;
constexpr size_t WS_SWA_QKV_T = 1 * MiB, WS_SWA_WO_T = 4 * MiB, WS_DIFF_QKV_T = 6 * MiB, WS_DIFF_WO_T = 12 * MiB;
constexpr size_t WS_WR = 14 * MiB;
constexpr size_t WS_RSTD = 14 * MiB + 512 * 1024;
constexpr size_t WS_LTOK = 15 * MiB, WS_LW = 19 * MiB, WS_TINFO = 23 * MiB;
constexpr size_t WS_WMOE = 24 * MiB;
constexpr size_t WS_XR = 216 * MiB;
#define XNB(a) ((unsigned char*)(a)->out)
constexpr size_t WS_SCR = 280 * MiB;
constexpr size_t WS_QKV = WS_SCR, WS_O = WS_SCR + 192 * MiB, WS_Y = WS_SCR, WS_H = WS_SCR + 144 * MiB;
constexpr size_t WS_END = 536 * MiB;
constexpr int CW_BAR = 4096;
constexpr int CW_CNT = 16384;
constexpr int CW_KMAX = 24576;

constexpr int RING_BYTES = 131072;
constexpr int LDSCTL_OFF = RING_BYTES;
constexpr int MISC_OFF = LDSCTL_OFF + 320;
constexpr int TP_OFF = LDSCTL_OFF + 1024;
constexpr int STASH_OFF = LDSCTL_OFF + 2048;
constexpr int LDS_BYTES = 147456;

__device__ __forceinline__ unsigned f2bf(float f) { unsigned u = __builtin_bit_cast(unsigned, f); return (u + 0x7fffu + ((u >> 16) & 1u)) >> 16; }
__device__ __forceinline__ unsigned pk2(float lo, float hi) { return f2bf(lo) | (f2bf(hi) << 16); }
__device__ __forceinline__ unsigned cvtpk(float lo, float hi) { f32x2 v = {lo, hi}; bf16x2_t b = __builtin_convertvector(v, bf16x2_t); return __builtin_bit_cast(unsigned, b); }
__device__ __forceinline__ unsigned pk4_fp8(float a, float b, float c, float d) {
    a = __builtin_fminf(__builtin_fmaxf(a, -448.f), 448.f); b = __builtin_fminf(__builtin_fmaxf(b, -448.f), 448.f); c = __builtin_fminf(__builtin_fmaxf(c, -448.f), 448.f); d = __builtin_fminf(__builtin_fmaxf(d, -448.f), 448.f);
    int r = 0; r = __builtin_amdgcn_cvt_pk_fp8_f32(a, b, r, false); r = __builtin_amdgcn_cvt_pk_fp8_f32(c, d, r, true); return (unsigned)r; }
__device__ __forceinline__ float bf2f(unsigned short h) { return __builtin_bit_cast(float, (unsigned)h << 16); }
__device__ __forceinline__ int relaunder(int x) { asm volatile("" : "+v"(x)); return x; }
__device__ __forceinline__ int lane_id() { return (int)__builtin_amdgcn_mbcnt_hi(~0u, __builtin_amdgcn_mbcnt_lo(~0u, 0u)); }
__device__ __forceinline__ float wave_sum(float v) {
#pragma unroll
    for (int o = 1; o < 64; o <<= 1) v += __shfl_xor(v, o);
    return v;
}

namespace pg8 {
constexpr int BM = 256, BK = 64, HALF = 128, HTB = HALF * BK * 2, STAGE_BYTES = 8 * HTB, NXCD = 8, WGM = 8;
__host__ __device__ __forceinline__ int lds_byte(int r, int c) { const int st = (r >> 4) * 2 + (c >> 5), rr = r & 15, cc = c & 31, ob = rr * 64 + cc * 2; return st * 1024 + (ob ^ (((ob >> 9) & 1) << 5)); }
__host__ __device__ __forceinline__ void stage_rc(int b, int& R, int& C) { const int st = b / 1024, sb = b % 1024, swz = sb ^ (((sb >> 9) & 1) << 5); R = (st >> 1) * 16 + swz / 64; C = (st & 1) * 32 + (swz % 64) / 2; }
__host__ __device__ __forceinline__ int perm32(int rho) { const int n = rho >> 4, i = rho & 15; return 8 * (i >> 2) + 4 * n + (i & 3); }

struct Unit { int pm, pn, e, t, pnl; };
struct Gemm { const bf16_t* A; const bf16_t* Bt; int K; unsigned sw = 0x7f7f7f7fu, sx = 0x7f7f7f7fu; };

struct DenseOrder {
    int nM, nN, nwg, G, c;
    __device__ void init(int Mr, int N, int G_, int c_) { nM = Mr / BM; nN = N / BM; nwg = nM * nN; G = G_; c = c_; }
    __device__ bool next(int i, Unit& u) const {
        const long L = (long)i * G + c; if (L >= nwg) return false;
        int wgid = (int)L; { const int q = nwg / NXCD, r = nwg % NXCD, xcd = wgid % NXCD, off = wgid / NXCD; wgid = (xcd < r ? xcd * (q + 1) : r * (q + 1) + (xcd - r) * q) + off; }
        const int nig = WGM * nN, gid = wgid / nig, fm = gid * WGM, gsz = (nM - fm) < WGM ? (nM - fm) : WGM;
        u.pm = fm + ((wgid % nig) % gsz); u.pn = (wgid % nig) / gsz; u.e = 0; u.t = 0; u.pnl = u.pn; return true;
    }
    __device__ __forceinline__ int token(const Unit&, int) const { return 0; }
};
struct MoeOrder {
    const LAS int* TP; const LAS int* CNT; const int* ltok; int G, c, pn_mul, pn_add;
    __device__ bool next(int i, Unit& u) const {
        const int ntile = __builtin_amdgcn_readfirstlane(TP[32]); const int nwg = ntile * 4;
        const long L = (long)i * G + c; if (L >= nwg) return false;
        int wgid = (int)L; { const int q = nwg / NXCD, r = nwg % NXCD, xcd = wgid % NXCD, off = wgid / NXCD; wgid = (xcd < r ? xcd * (q + 1) : r * (q + 1) + (xcd - r) * q) + off; }
        const int tau = wgid >> 2; int e = 0;
#pragma unroll
        for (int st = 16; st >= 1; st >>= 1) if (__builtin_amdgcn_readfirstlane(TP[e + st]) <= tau) e += st;
        u.pm = tau; u.e = e; u.t = tau - __builtin_amdgcn_readfirstlane(TP[e]); u.pnl = wgid & 3; u.pn = e * pn_mul + pn_add + u.pnl; return true;
    }
    __device__ __forceinline__ int token(const Unit& u, int r) const { const int idx = u.t * 256 + r; return ltok[(size_t)u.e * M + (idx < CNT[u.e] ? idx : 0)]; }
};

struct EpiQKV {
    static constexpr bool PERM = true;
    bf16_t* O; int ldc; int qcols; float qscale; unsigned* kmaxsq;
    __device__ __forceinline__ void operator()(const f32x4 (&acc)[2][2][4][2], const Unit& u, int wr, int wc, int fr, int fq) const {
        asm volatile("" : "+v"(fr), "+v"(fq));
        const int row0 = u.pm * BM + wr * 64 + fr, colt = u.pn * BM; const float sc = colt < qcols ? qscale : 1.f;
        const int col0 = colt + wc * 32 + 8 * fq;
#pragma unroll
        for (int ai = 0; ai < 2; ++ai)
#pragma unroll
            for (int m = 0; m < 4; ++m) { bf16_t* rowp = O + (size_t)(row0 + ai * HALF + m * 16) * ldc + col0;
#pragma unroll
                for (int bj = 0; bj < 2; ++bj) { const f32x4 v0 = acc[ai][bj][m][0] * sc, v1 = acc[ai][bj][m][1] * sc;
                    u32x4 w; w.x = cvtpk(v0[0], v0[1]); w.y = cvtpk(v0[2], v0[3]); w.z = cvtpk(v1[0], v1[1]); w.w = cvtpk(v1[2], v1[3]);
                    *(u32x4*)(rowp + bj * HALF) = w; } }
        if (kmaxsq != nullptr && colt >= 1024 && colt < 2048) {
#pragma unroll
            for (int bj = 0; bj < 2; ++bj) { float mx = 0.f;
#pragma unroll
                for (int ai = 0; ai < 2; ++ai)
#pragma unroll
                    for (int m = 0; m < 4; ++m) { const f32x4 v0 = acc[ai][bj][m][0], v1 = acc[ai][bj][m][1];
                        float ss = (v0[0] * v0[0] + v0[1] * v0[1]) + (v0[2] * v0[2] + v0[3] * v0[3]) + (v1[0] * v1[0] + v1[1] * v1[1]) + (v1[2] * v1[2] + v1[3] * v1[3]);
                        ss += __shfl_xor(ss, 16); ss += __shfl_xor(ss, 32); mx = __builtin_fmaxf(mx, ss); }
                mx = __builtin_fmaxf(mx, __shfl_xor(mx, 1)); mx = __builtin_fmaxf(mx, __shfl_xor(mx, 2)); mx = __builtin_fmaxf(mx, __shfl_xor(mx, 4)); mx = __builtin_fmaxf(mx, __shfl_xor(mx, 8));
                if (fr == 0 && fq == 0) atomicMax(kmaxsq + (u.pm >> 5) * 32 + ((colt - 1024 + bj * HALF + wc * 32) >> 5), __float_as_uint(mx)); }
        }
    }
};
struct EpiResid {
    static constexpr bool PERM = false;
    const float* base32; const bf16_t* base16; bf16_t* out;
    __device__ __forceinline__ void operator()(const f32x4 (&acc)[2][2][4][2], const Unit& u, int wr, int wc, int fr, int fq) const {
        asm volatile("" : "+v"(fr), "+v"(fq));
        const int col0 = u.pn * BM + wc * 32 + 4 * fq;
#pragma unroll
        for (int ai = 0; ai < 2; ++ai) {
            f32x4 b[4][2][2];
            if (base32) {
#pragma unroll
                for (int m = 0; m < 4; ++m) { const size_t off = (size_t)(u.pm * BM + ai * HALF + wr * 64 + m * 16 + fr) * D + col0;
#pragma unroll
                    for (int bj = 0; bj < 2; ++bj)
#pragma unroll
                        for (int n = 0; n < 2; ++n) b[m][bj][n] = *(const f32x4*)(base32 + off + bj * HALF + n * 16); }
            } else {
                u32x2 q[4][2][2];
#pragma unroll
                for (int m = 0; m < 4; ++m) { const size_t off = (size_t)(u.pm * BM + ai * HALF + wr * 64 + m * 16 + fr) * D + col0;
#pragma unroll
                    for (int bj = 0; bj < 2; ++bj)
#pragma unroll
                        for (int n = 0; n < 2; ++n) q[m][bj][n] = *(const u32x2*)(base16 + off + bj * HALF + n * 16); }
#pragma unroll
                for (int m = 0; m < 4; ++m)
#pragma unroll
                    for (int bj = 0; bj < 2; ++bj)
#pragma unroll
                        for (int n = 0; n < 2; ++n) { const u32x2 w = q[m][bj][n];
                            b[m][bj][n] = (f32x4){__uint_as_float(w.x << 16), __uint_as_float(w.x & 0xffff0000u), __uint_as_float(w.y << 16), __uint_as_float(w.y & 0xffff0000u)}; }
            }
            asm volatile("" ::: "memory");
#pragma unroll
            for (int m = 0; m < 4; ++m) { const size_t off = (size_t)(u.pm * BM + ai * HALF + wr * 64 + m * 16 + fr) * D + col0;
#pragma unroll
                for (int bj = 0; bj < 2; ++bj)
#pragma unroll
                    for (int n = 0; n < 2; ++n) { const f32x4 s = b[m][bj][n] + acc[ai][bj][m][n]; u32x2 w; w.x = pk2(s.x, s.y); w.y = pk2(s.z, s.w); *(u32x2*)(out + off + bj * HALF + n * 16) = w; } }
            asm volatile("" ::: "memory");
        }
    }
};
__device__ __forceinline__ float silu_mul(float g, float u) { return g * u * __builtin_amdgcn_rcpf(1.f + __builtin_amdgcn_exp2f(-g * LOG2E)); }
template <bool F8>
struct EpiSwiGLU {
    static constexpr bool PERM = true;
    bf16_t* H; const int* ltok; const float* rstd_tok; const LAS int* CNT;
    __device__ __forceinline__ void operator()(const f32x4 (&acc)[2][2][4][2], const Unit& u, int wr, int wc, int fr, int fq) const {
        asm volatile("" : "+v"(fr), "+v"(fq));
        const int colh = u.pnl * 128 + wc * 32 + 8 * fq; const int cnt = CNT[u.e];
        int toks[2][4]; float rss[2][4];
#pragma unroll
        for (int ai = 0; ai < 2; ++ai)
#pragma unroll
            for (int m = 0; m < 4; ++m) { const int idx = u.t * 256 + ai * HALF + wr * 64 + m * 16 + fr; toks[ai][m] = ltok[(size_t)u.e * M + (idx < cnt ? idx : 0)]; }
#pragma unroll
        for (int ai = 0; ai < 2; ++ai)
#pragma unroll
            for (int m = 0; m < 4; ++m) rss[ai][m] = rstd_tok[toks[ai][m]];
        asm volatile("" ::: "memory");
#pragma unroll
        for (int ai = 0; ai < 2; ++ai)
#pragma unroll
            for (int m = 0; m < 4; ++m) { const int rl = ai * HALF + wr * 64 + m * 16 + fr; const size_t row = (size_t)u.pm * BM + rl;
                const float rs = rss[ai][m];
                const f32x4 g0 = acc[ai][0][m][0] * rs, g1 = acc[ai][0][m][1] * rs, u0 = acc[ai][1][m][0] * rs, u1 = acc[ai][1][m][1] * rs;
                if constexpr (F8) {
                    u32x2 w; w.x = pk4_fp8(8.f * silu_mul(g0[0], u0[0]), 8.f * silu_mul(g0[1], u0[1]), 8.f * silu_mul(g0[2], u0[2]), 8.f * silu_mul(g0[3], u0[3]));
                    w.y = pk4_fp8(8.f * silu_mul(g1[0], u1[0]), 8.f * silu_mul(g1[1], u1[1]), 8.f * silu_mul(g1[2], u1[2]), 8.f * silu_mul(g1[3], u1[3]));
                    *(u32x2*)((unsigned char*)H + row * DEXP + colh) = w;
                } else {
                    u32x4 w; w.x = cvtpk(silu_mul(g0[0], u0[0]), silu_mul(g0[1], u0[1])); w.y = cvtpk(silu_mul(g0[2], u0[2]), silu_mul(g0[3], u0[3]));
                    w.z = cvtpk(silu_mul(g1[0], u1[0]), silu_mul(g1[1], u1[1])); w.w = cvtpk(silu_mul(g1[2], u1[2]), silu_mul(g1[3], u1[3]));
                    *(u32x4*)(H + row * DEXP + colh) = w; }
            }
    }
};
struct EpiDown {
    static constexpr bool PERM = true;
    bf16_t* Y; const float* lw;
    __device__ __forceinline__ void operator()(const f32x4 (&acc)[2][2][4][2], const Unit& u, int wr, int wc, int fr, int fq) const {
        asm volatile("" : "+v"(fr), "+v"(fq));
        const int col0 = u.pnl * BM + wc * 32 + 8 * fq;
        float scs[2][4];
#pragma unroll
        for (int ai = 0; ai < 2; ++ai)
#pragma unroll
            for (int m = 0; m < 4; ++m) scs[ai][m] = lw[(size_t)u.e * M + u.t * 256 + ai * HALF + wr * 64 + m * 16 + fr];
        asm volatile("" ::: "memory");
#pragma unroll
        for (int ai = 0; ai < 2; ++ai)
#pragma unroll
            for (int m = 0; m < 4; ++m) { const int rl = ai * HALF + wr * 64 + m * 16 + fr; const size_t row = (size_t)u.pm * BM + rl;
                const float sc = scs[ai][m];
#pragma unroll
                for (int bj = 0; bj < 2; ++bj) { const f32x4 v0 = acc[ai][bj][m][0] * sc, v1 = acc[ai][bj][m][1] * sc;
                    u32x4 w; w.x = cvtpk(v0[0], v0[1]); w.y = cvtpk(v0[2], v0[3]); w.z = cvtpk(v1[0], v1[1]); w.w = cvtpk(v1[2], v1[3]);
                    *(u32x4*)(Y + row * D + col0 + bj * HALF) = w; } }
    }
};

template <class Epi, class Sched, bool GATHER, bool ALIGN_EPI, bool FP8 = false>
__device__ __forceinline__ void gemm_phase(LAS unsigned char* lds, const Gemm g, const Sched& S, const Epi& E, const int wid, const int lane) {
    const int tid = wid * 64 + lane, wr = wid >> 2, wc = wid & 3, fr = lane & 15, fq = lane >> 4;
    const int K = g.K, nt = K / BK;
    int Rr[2], Cc[2]; unsigned voffB[2];
#pragma unroll
    for (int i = 0; i < 2; ++i) { int R, C; stage_rc(tid * 16 + i * 8192, R, C); Rr[i] = R; Cc[i] = C; const int Rb = Epi::PERM ? ((R & ~31) + perm32(R & 31)) : R; voffB[i] = (unsigned)(Rb * K + C) * 2u; }
    const size_t kstep = (size_t)(BK * 2);
    const size_t hstep = (size_t)HALF * K * 2;
    const size_t tstep = 2 * hstep;
    const unsigned ldsw = (unsigned)wid * 1024u;
    const size_t R64 = (size_t)64 * K * 2;
    const size_t H1 = GATHER ? 0 : hstep;
    const int aoff = FP8 ? lds_byte(wr * 64 + fr, (fq >> 1) * 32 + (fq & 1) * 16) : lds_byte(wr * 64 + fr, fq * 8), boff = FP8 ? lds_byte(wc * 32 + fr, (fq >> 1) * 32 + (fq & 1) * 16) : lds_byte(wc * 32 + fr, fq * 8);

#define PG8_SA(b, h) (((b) * 2 + (h)) * HTB)
#define PG8_SB(b, h) ((4 + (b) * 2 + (h)) * HTB)
#define PG8_STAGE2(bufoff, gbase, o0, o1) do { \
        __builtin_amdgcn_global_load_lds((const unsigned*)((const char*)(gbase) + (o0)), (LAS unsigned*)(lds + (bufoff) + ldsw), 16, 0, 0); \
        __builtin_amdgcn_global_load_lds((const unsigned*)((const char*)(gbase) + (o1)), (LAS unsigned*)(lds + (bufoff) + ldsw + 8192), 16, 0, 0); } while (0)
#define PG8_STAGEB(bufoff, gbase) do {   \
        __builtin_amdgcn_global_load_lds((const unsigned*)((const char*)(gbase) + voffB[0]), (LAS unsigned*)(lds + (bufoff) + ldsw), 16, 0, 0); \
        __builtin_amdgcn_global_load_lds((const unsigned*)((const char*)(gbase) + R64 + voffB[0]), (LAS unsigned*)(lds + (bufoff) + ldsw + 8192), 16, 0, 0); } while (0)
#define PG8_LDA(dst, b, h) do { if constexpr (FP8) { _Pragma("unroll") for (int m = 0; m < 4; ++m) dst##8[m] = *(const LAS i32x8*)(lds + PG8_SA(b, h) + aoff + m * 2048); } \
        else { _Pragma("unroll") for (int m = 0; m < 4; ++m) _Pragma("unroll") for (int k = 0; k < 2; ++k) dst[m][k] = *(const LAS bf16x8*)(lds + PG8_SA(b, h) + aoff + m * 2048 + k * 1024); } } while (0)
#define PG8_LDB(dst, b, h) do { if constexpr (FP8) { _Pragma("unroll") for (int n = 0; n < 2; ++n) dst##8[n] = *(const LAS i32x8*)(lds + PG8_SB(b, h) + boff + n * 2048); } \
        else { _Pragma("unroll") for (int n = 0; n < 2; ++n) _Pragma("unroll") for (int k = 0; k < 2; ++k) dst[n][k] = *(const LAS bf16x8*)(lds + PG8_SB(b, h) + boff + n * 2048 + k * 1024); } } while (0)
#define PG8_CAT8(x) __builtin_shufflevector(__builtin_bit_cast(i32x4, (x)[0]), __builtin_bit_cast(i32x4, (x)[1]), 0, 1, 2, 3, 4, 5, 6, 7)
#define PG8_MMA(ai, bj, At, Bt) do { if constexpr (FP8) __builtin_amdgcn_sched_barrier(0); __builtin_amdgcn_s_setprio(1); _Pragma("unroll") for (int m = 0; m < 4; ++m) _Pragma("unroll") for (int n = 0; n < 2; ++n) { \
        if constexpr (FP8) acc[ai][bj][m][n] = __builtin_amdgcn_mfma_scale_f32_16x16x128_f8f6f4(Bt##8[n], At##8[m], acc[ai][bj][m][n], 0, 0, 0, (int)g.sw, 0, (int)g.sx); \
        else { _Pragma("unroll") for (int k = 0; k < 2; ++k) acc[ai][bj][m][n] = __builtin_amdgcn_mfma_f32_16x16x32_bf16(Bt[n][k], At[m][k], acc[ai][bj][m][n], 0, 0, 0); } } \
        if constexpr (FP8) { _Pragma("unroll") for (int m = 0; m < 4; ++m) _Pragma("unroll") for (int n = 0; n < 2; ++n) asm volatile("" : "+v"(acc[ai][bj][m][n])); }   \
        __builtin_amdgcn_s_setprio(0); if constexpr (FP8) __builtin_amdgcn_sched_barrier(0); } while (0)
#define PG8_WAIT_V(n) asm volatile("s_waitcnt vmcnt(" #n ")" ::: "memory")
#define PG8_WAIT_L(n) asm volatile("s_waitcnt lgkmcnt(" #n ")" ::: "memory")
#define PG8_BAR __builtin_amdgcn_s_barrier()
#define PG8_SCHED __builtin_amdgcn_sched_barrier(0)
    Unit cur, nxt; int ui = 0;
    if (!S.next(0, cur)) return;
    unsigned oc00, oc01, oc10, oc11;
    LAS u32x4* stash = (LAS u32x4*)(lds + (STASH_OFF - 0) ) + tid;
    if constexpr (GATHER) {
        oc00 = (unsigned)(S.token(cur, Rr[0]) * K + Cc[0]) * 2u; oc01 = (unsigned)(S.token(cur, Rr[1]) * K + Cc[1]) * 2u;
        oc10 = (unsigned)(S.token(cur, 128 + Rr[0]) * K + Cc[0]) * 2u; oc11 = (unsigned)(S.token(cur, 128 + Rr[1]) * K + Cc[1]) * 2u;
    } else {
        oc00 = (unsigned)(Rr[0] * K + Cc[0]) * 2u; oc01 = (unsigned)(Rr[1] * K + Cc[1]) * 2u; oc10 = oc00; oc11 = oc01;
    }
    f32x4 acc[2][2][4][2];
#pragma unroll
    for (int a = 0; a < 2; ++a)
#pragma unroll
        for (int b = 0; b < 2; ++b)
#pragma unroll
            for (int m = 0; m < 4; ++m)
#pragma unroll
                for (int n = 0; n < 2; ++n) acc[a][b][m][n] = (f32x4){0.f, 0.f, 0.f, 0.f};
    bf16x8 At[4][2], B0[2][2], B1[2][2];
    i32x8 At8[4], B08[2], B18[2];
    const char* cA = GATHER ? (const char*)g.A : (const char*)g.A + (size_t)cur.pm * tstep; const char* cB = (const char*)g.Bt + (size_t)cur.pn * tstep;
    PG8_STAGEB(PG8_SB(0, 0), cB); PG8_STAGEB(PG8_SB(0, 1), cB + hstep); PG8_STAGE2(PG8_SA(0, 0), cA, oc00, oc01); PG8_STAGE2(PG8_SA(0, 1), cA + H1, oc10, oc11);
    if (wr == 1) PG8_BAR;
    PG8_WAIT_V(2); PG8_BAR;
    PG8_STAGEB(PG8_SB(1, 0), cB + kstep); PG8_STAGE2(PG8_SA(1, 0), cA + kstep, oc00, oc01); PG8_STAGEB(PG8_SB(1, 1), cB + hstep + kstep);
    PG8_WAIT_V(6); PG8_BAR;
    for (;;) {
        const bool has_next = S.next(ui + 1, nxt);
        const char* nA = has_next ? (GATHER ? (const char*)g.A : (const char*)g.A + (size_t)nxt.pm * tstep) : cA; const char* nB = has_next ? (const char*)g.Bt + (size_t)nxt.pn * tstep : cB;
        if constexpr (GATHER) {
            u32x4 nx = {oc00, oc01, oc10, oc11};
            if (has_next) { int R0, C0, R1, C1; stage_rc(tid * 16, R0, C0); stage_rc(tid * 16 + 8192, R1, C1);
                nx.x = (unsigned)(S.token(nxt, R0) * K + C0) * 2u; nx.y = (unsigned)(S.token(nxt, R1) * K + C1) * 2u;
                nx.z = (unsigned)(S.token(nxt, 128 + R0) * K + C0) * 2u; nx.w = (unsigned)(S.token(nxt, 128 + R1) * K + C1) * 2u; }
            *stash = nx;
        }
        for (int t = 0; t < nt; t += 2) {
            const bool last = (t == nt - 2);
            const char* a1 = cA + (size_t)(t + 1) * kstep;
            const char* a2 = last ? nA : cA + (size_t)(t + 2) * kstep; const char* b2 = last ? nB : cB + (size_t)(t + 2) * kstep;
            const char* a3 = a2 + kstep; const char* b3 = b2 + kstep;
            unsigned x00 = oc00, x01 = oc01, x10 = oc10, x11 = oc11;
            if constexpr (GATHER) { if (last) { const u32x4 nx = *stash; x00 = nx.x; x01 = nx.y; x10 = nx.z; x11 = nx.w; } }
            PG8_LDB(B0, 0, 0); PG8_LDB(B1, 0, 1); PG8_SCHED; PG8_LDA(At, 0, 0); PG8_STAGE2(PG8_SA(1, 1), a1 + H1, oc10, oc11);
            PG8_WAIT_V(8); PG8_WAIT_L(0); PG8_BAR; PG8_MMA(0, 0, At, B0); PG8_MMA(0, 1, At, B1); PG8_BAR; PG8_SCHED;
            PG8_LDA(At, 0, 1); PG8_STAGEB(PG8_SB(0, 0), b2); PG8_STAGEB(PG8_SB(0, 1), b2 + hstep); PG8_STAGE2(PG8_SA(0, 0), a2, x00, x01);
            PG8_WAIT_V(8); PG8_WAIT_L(0); PG8_BAR; PG8_MMA(1, 0, At, B0); PG8_MMA(1, 1, At, B1); PG8_BAR; PG8_SCHED;
            PG8_LDB(B0, 1, 0); PG8_LDB(B1, 1, 1); PG8_SCHED; PG8_LDA(At, 1, 0); PG8_STAGE2(PG8_SA(0, 1), a2 + H1, x10, x11);
            PG8_WAIT_V(8); PG8_WAIT_L(0); PG8_BAR; PG8_MMA(0, 0, At, B0); PG8_MMA(0, 1, At, B1); PG8_BAR; PG8_SCHED;
            PG8_LDA(At, 1, 1); PG8_STAGEB(PG8_SB(1, 0), b3); PG8_STAGEB(PG8_SB(1, 1), b3 + hstep); PG8_STAGE2(PG8_SA(1, 0), a3, x00, x01);
            PG8_WAIT_V(8); PG8_WAIT_L(0); PG8_BAR; PG8_MMA(1, 0, At, B0); PG8_MMA(1, 1, At, B1); PG8_BAR; PG8_SCHED;
        }
        if constexpr (ALIGN_EPI) { if (wr == 0) PG8_BAR; }
        E(acc, cur, wr, wc, fr, fq);
        if (!has_next) break;
#pragma unroll
        for (int a = 0; a < 2; ++a)
#pragma unroll
            for (int b = 0; b < 2; ++b)
#pragma unroll
                for (int m = 0; m < 4; ++m)
#pragma unroll
                    for (int n = 0; n < 2; ++n) acc[a][b][m][n] = (f32x4){0.f, 0.f, 0.f, 0.f};
        cur = nxt; cA = nA; cB = nB; ++ui;
        if constexpr (GATHER) { const u32x4 nx = *stash; oc00 = nx.x; oc01 = nx.y; oc10 = nx.z; oc11 = nx.w; }
        if constexpr (ALIGN_EPI) { if (wr == 1) PG8_BAR; }
    }
    PG8_WAIT_V(0);
    if constexpr (!ALIGN_EPI) { if (wr == 0) PG8_BAR; }
    PG8_BAR;
#undef PG8_SA
#undef PG8_SB
#undef PG8_STAGE2
#undef PG8_STAGEB
#undef PG8_LDA
#undef PG8_LDB
#undef PG8_MMA
#undef PG8_CAT8
#undef PG8_WAIT_V
#undef PG8_WAIT_L
#undef PG8_BAR
#undef PG8_SCHED
}
}

namespace att {
constexpr int NSLOT = 3;
constexpr float THR = 8.0f;
__device__ __forceinline__ void glds16(const void* gsrc, unsigned lds_dst) { unsigned keep;
    asm volatile("s_mov_b32 %0, m0\n\ts_mov_b32 m0, %2\n\ts_nop 0\n\tglobal_load_lds_dwordx4 %1, off\n\ts_mov_b32 m0, %0" : "=&s"(keep) : "v"(gsrc), "s"(lds_dst) : "memory"); }
#define ATT_WAIT_BAR(N) asm volatile("s_waitcnt vmcnt(" #N ") lgkmcnt(0)\n\ts_barrier" ::: "memory")
typedef LAS const char* lds_cptr;
typedef short v4i16_t __attribute__((ext_vector_type(4)));
__device__ __forceinline__ s16x4 vtr(lds_cptr p) { return __builtin_bit_cast(s16x4, __builtin_amdgcn_ds_read_tr16_b64_v4i16((LAS v4i16_t*)p)); }
__device__ __forceinline__ float swap_max(float m) { auto rr = __builtin_amdgcn_permlane32_swap(__float_as_uint(m), __float_as_uint(m), false, false); return __builtin_fmaxf(__uint_as_float(rr[0]), __uint_as_float(rr[1])); }
__device__ __forceinline__ float swap_sum(float m) { auto rr = __builtin_amdgcn_permlane32_swap(__float_as_uint(m), __float_as_uint(m), false, false); return __uint_as_float(rr[0]) + __uint_as_float(rr[1]); }
__device__ __forceinline__ float max3f(float a, float b, float c) { float r; asm("v_max3_f32 %0, %1, %2, %3" : "=v"(r) : "v"(a), "v"(b), "v"(c)); return r; }
template <unsigned KB> __device__ __forceinline__ float fmamk(float a, float c) { float r; asm("v_fmamk_f32 %0, %1, %2, %3" : "=v"(r) : "v"(a), "i"(KB), "v"(c)); return r; }
#define CRF(r) ((float)(((r) & 3) + 8 * ((r) >> 2)))
#define CRI(r) (((r) & 3) + 8 * ((r) >> 2))

template <int MODE> struct Cfg;
template <> struct Cfg<0> { static constexpr int DV32 = 2, NK = 1, SLOTB = 16384, VOFF = 8192, PITCH = SWA_N, NVP = 1; };
template <> struct Cfg<1> { static constexpr int DV32 = 4, NK = 2, SLOTB = 32768, VOFF = 16384, PITCH = DIFF_N, NVP = 2; };

template <int MODE>
__device__ __forceinline__ void tile_step(lds_cptr kp, lds_cptr vp, const bf16x8 (&qr)[4], f32x16 (&o)[Cfg<MODE>::DV32], float& mhat, float& l, bool& first,
                                          const float slope2, const int dq_i, const int kind, const int hi) {
    constexpr int DV32 = Cfg<MODE>::DV32;
    f32x16 p0, p1;
    const float dq = (float)dq_i, nm = -mhat;
    {
        const float sl = kind == 2 ? 0.f : (kind == 0 ? slope2 : -slope2); const float base0 = __builtin_fmaf(-sl, dq, nm);
#pragma unroll
        for (int r = 0; r < 16; ++r) { p0[r] = __builtin_fmaf(sl, CRF(r), base0); p1[r] = __builtin_fmaf(sl, CRF(r) + 32.f, base0); }
    }
#pragma unroll
    for (int d0 = 0; d0 < 4; ++d0) {
        const bf16x8 b0 = *(const LAS bf16x8*)(kp + d0 * 2048);
        const bf16x8 b1 = *(const LAS bf16x8*)(kp + d0 * 2048 + 512);
        p0 = __builtin_amdgcn_mfma_f32_32x32x16_bf16(b0, qr[d0], p0, 0, 0, 0);
        p1 = __builtin_amdgcn_mfma_f32_32x32x16_bf16(b1, qr[d0], p1, 0, 0, 0);
    }
    if (kind == 2) {
#pragma unroll
        for (int r = 0; r < 16; ++r) {
            const float e0 = __builtin_fabsf(dq - CRF(r)), e1 = __builtin_fabsf(dq - CRF(r) - 32.f);
            if (MODE == 0) { p0[r] = e0 <= 128.f ? __builtin_fmaf(-slope2, e0, p0[r]) : -INFINITY; p1[r] = e1 <= 128.f ? __builtin_fmaf(-slope2, e1, p1[r]) : -INFINITY; }
            else { p0[r] = __builtin_fmaf(-slope2, e0, p0[r]); p1[r] = __builtin_fmaf(-slope2, e1, p1[r]); }
        }
    }
    float rm = __builtin_fmaxf(p0[0], p1[0]);
#pragma unroll
    for (int r = 1; r < 16; ++r) rm = __builtin_fmaxf(rm, __builtin_fmaxf(p0[r], p1[r]));
    rm = swap_max(rm);
    if (first || __any(rm > THR)) {
        const float dl = first ? rm : __builtin_fmaxf(rm, 0.f);
        mhat += dl;
#pragma unroll
        for (int r = 0; r < 16; ++r) { p0[r] -= dl; p1[r] -= dl; }
        if (!first) {
            const float f = __builtin_amdgcn_exp2f(-dl); l *= f;
#pragma unroll
            for (int r = 0; r < 16; ++r) { int h4_ = 4 * hi; asm volatile("" : "+v"(h4_)); const float fr_ = __shfl(f, CRI(r) + h4_);
#pragma unroll
                for (int d0 = 0; d0 < DV32; ++d0) o[d0][r] *= fr_; }
        }
        first = false;
    }
    float sacc = 0.f;
    u32x4 pw[4];
#pragma unroll
    for (int s = 0; s < 2; ++s) {
        float e[8];
#pragma unroll
        for (int j = 0; j < 8; ++j) { e[j] = __builtin_amdgcn_exp2f(p0[8 * s + j]); sacc += e[j]; }
        pw[s] = (u32x4){cvtpk(e[0], e[1]), cvtpk(e[2], e[3]), cvtpk(e[4], e[5]), cvtpk(e[6], e[7])};
    }
#pragma unroll
    for (int s = 0; s < 2; ++s) {
        float e[8];
#pragma unroll
        for (int j = 0; j < 8; ++j) { e[j] = __builtin_amdgcn_exp2f(p1[8 * s + j]); sacc += e[j]; }
        pw[2 + s] = (u32x4){cvtpk(e[0], e[1]), cvtpk(e[2], e[3]), cvtpk(e[4], e[5]), cvtpk(e[6], e[7])};
    }
    l += sacc;
#pragma unroll
    for (int d0 = 0; d0 < DV32; ++d0) {
#pragma unroll
        for (int ks = 0; ks < 4; ++ks) {
            const s16x4 lo = vtr(vp + d0 * 4096 + ks * 1024), hh = vtr(vp + d0 * 4096 + ks * 1024 + 512);
            const bf16x8 vf = (bf16x8){lo[0], lo[1], lo[2], lo[3], hh[0], hh[1], hh[2], hh[3]};
            o[d0] = __builtin_amdgcn_mfma_f32_32x32x16_bf16(__builtin_bit_cast(bf16x8, pw[ks]), vf, o[d0], 0, 0, 0);
        }
    }
}

struct DiffConsts { float lam_full; const float* subln; float gs0, gs1, gs2, gs3; };

template <int MODE>
__device__ __forceinline__ void attn_unit(const int b, const int hh, const int qb, const bf16_t* __restrict__ QKV, bf16_t* __restrict__ O, const float* __restrict__ sink,
                                          const DiffConsts dc, LAS unsigned char* shm, const int wid, const int lane_in) {
    typedef Cfg<MODE> C;
    constexpr int DV32 = C::DV32, PITCH = C::PITCH;
    int lane = lane_in; asm volatile("" : "+v"(lane));
    const int r32 = lane & 31, hi = lane >> 5;
    int iw, qcol, kcol, vcol, t_lo, NT, hq = 0, cmap = 0, qs;
    float slope2;
    if (MODE == 0) { const int g = wid >> 1; qs = wid & 1; hq = hh * 4 + g; iw = qb * 64 + qs * 32; qcol = hq * 64; kcol = 1024 + hh * 64; vcol = 1280 + hh * 64;
        t_lo = qb - 2 < 0 ? 0 : qb - 2; const int t_hi = qb + 2 > 127 ? 127 : qb + 2; NT = t_hi - t_lo + 1; slope2 = __builtin_amdgcn_exp2f(-0.5f * (float)(hq + 1)) * LOG2E; }
    else { qs = wid & 3; cmap = wid >> 2; iw = qb * 128 + qs * 32; qcol = (hh * 2 + cmap) * 64; kcol = 1024 + hh * 128; vcol = 2048 + hh * 128; t_lo = 0; NT = SEQ / 64;
        slope2 = __builtin_amdgcn_exp2f(-(float)(hh + 1)) * LOG2E; }
    const bf16_t* base = QKV + (size_t)b * SEQ * PITCH;
    const unsigned lds0 = (unsigned)(uintptr_t)shm;
    const unsigned koff = (unsigned)(lane * PITCH + kcol + wid * 8) * 2u;
    const unsigned voff = (unsigned)((16 * (wid & 3) + (lane >> 2)) * PITCH + vcol + (wid >> 2) * 32 + (lane & 3) * 8) * 2u;
    const unsigned kdst = lds0 + wid * 1024, vdst = lds0 + C::VOFF + wid * 1024;
#define ATT_DMA(t, slot) do { const char* tb_ = (const char*)base + (size_t)(t) * 64 * PITCH * 2; const unsigned so_ = (unsigned)(slot) * C::SLOTB; \
        glds16(tb_ + koff, (unsigned)__builtin_amdgcn_readfirstlane(kdst + so_)); \
        if (MODE == 1) glds16(tb_ + koff + 128, (unsigned)__builtin_amdgcn_readfirstlane(kdst + so_ + 8192)); \
        glds16(tb_ + voff, (unsigned)__builtin_amdgcn_readfirstlane(vdst + so_)); \
        if (MODE == 1) glds16(tb_ + voff + 128, (unsigned)__builtin_amdgcn_readfirstlane(vdst + so_ + 8192)); } while (0)
    ATT_DMA(t_lo, 0);
    if (NT > 1) ATT_DMA(t_lo + 1, 1);
    bf16x8 qr[4];
    { const bf16_t* Qw = base + (size_t)(iw + r32) * PITCH + qcol;
#pragma unroll
      for (int d0 = 0; d0 < 4; ++d0) qr[d0] = *(const bf16x8*)(Qw + d0 * 16 + hi * 8); }
    f32x16 o[DV32];
#pragma unroll
    for (int d0 = 0; d0 < DV32; ++d0)
#pragma unroll
        for (int r = 0; r < 16; ++r) o[d0][r] = 0.f;
    float mhat = 0.f, l = 0.f; bool first = true;
    if (MODE == 0) { mhat = sink[hq] * LOG2E; l = (hi == 0) ? 1.f : 0.f; first = false; }
    const lds_cptr shm3 = (lds_cptr)shm;
    const lds_cptr kp0 = shm3 + (MODE == 1 ? cmap * 8192 : 0) + hi * 1024 + r32 * 16;
    const lds_cptr vp0 = shm3 + C::VOFF + ((lane >> 4) & 1) * 32 + (lane & 3) * 8 + (4 * hi + ((lane & 15) >> 2)) * 64;
    int slot = 0;
    for (int it = 0; it < NT; ++it) {
        if (it + 1 < NT) { if (MODE == 1) { ATT_WAIT_BAR(4); } else { ATT_WAIT_BAR(2); } } else { ATT_WAIT_BAR(0); }
        if (it + 2 < NT) { const int s2 = slot == 0 ? 2 : slot - 1; ATT_DMA(t_lo + it + 2, s2); }
        const int k0 = (t_lo + it) * 64;
        const int kind = (MODE == 0) ? ((t_lo + it == qb - 1) ? 0 : ((t_lo + it == qb + 1) ? 1 : 2)) : ((k0 + 63 < iw) ? 0 : ((k0 > iw + 31) ? 1 : 2));
        tile_step<MODE>(kp0 + slot * C::SLOTB, vp0 + slot * C::SLOTB, qr, o, mhat, l, first, slope2, iw + r32 - k0 - 4 * hi, kind, hi);
        slot = slot == 2 ? 0 : slot + 1;
    }
#undef ATT_DMA
    l = swap_sum(l);
    const float rl = 1.f / l;
    if (MODE == 0) {
        bf16_t* Ow = O + (size_t)(b * SEQ + iw) * D + hq * 64 + r32;
#pragma unroll
        for (int r = 0; r < 16; ++r) { const int row = CRI(r) + 4 * hi; const float rr = __shfl(rl, row);
#pragma unroll
            for (int d0 = 0; d0 < DV32; ++d0) Ow[(size_t)row * D + d0 * 32] = (bf16_t)f2bf(o[d0][r] * rr); }
        ATT_WAIT_BAR(0);
    } else {
        LAS float* cb = (LAS float*)shm + qs * 4096;
        ATT_WAIT_BAR(0);
        if (cmap == 1) {
#pragma unroll
            for (int r = 0; r < 16; ++r) { const int row = CRI(r) + 4 * hi; const float rr = __shfl(rl, row) * dc.lam_full;
#pragma unroll
                for (int d0 = 0; d0 < DV32; ++d0) cb[row * 128 + d0 * 32 + r32] = o[d0][r] * rr; }
        }
        ATT_WAIT_BAR(0);
        if (cmap == 0) {
            bf16_t* Ow = O + (size_t)(b * SEQ + iw) * D + hh * 128 + r32;
            float gsub[DV32];
#pragma unroll
            for (int d0 = 0; d0 < DV32; ++d0) gsub[d0] = dc.subln[d0 * 32 + r32] * (1.f - LAMBDA_INIT);
#pragma unroll
            for (int r = 0; r < 16; ++r) { const int row = CRI(r) + 4 * hi; const float rr = __shfl(rl, row);
                float v[DV32]; float ss = 0.f;
#pragma unroll
                for (int d0 = 0; d0 < DV32; ++d0) { v[d0] = o[d0][r] * rr - cb[row * 128 + d0 * 32 + r32]; ss += v[d0] * v[d0]; }
                ss += __shfl_xor(ss, 1); ss += __shfl_xor(ss, 2); ss += __shfl_xor(ss, 4); ss += __shfl_xor(ss, 8); ss += __shfl_xor(ss, 16);
                const float sc = __builtin_amdgcn_rsqf(ss * (1.f / 128.f) + 1e-5f);
#pragma unroll
                for (int d0 = 0; d0 < DV32; ++d0) Ow[(size_t)row * D + d0 * 32] = (bf16_t)f2bf(v[d0] * sc * gsub[d0]); }
        }
        ATT_WAIT_BAR(0);
    }
}

#define SBAR() __builtin_amdgcn_sched_barrier(0)
#define PIN(x) asm volatile("" : "+v"(x))
#define MF(a, b, c) __builtin_amdgcn_mfma_f32_32x32x16_bf16(a, b, c, 0, 0, 0)
template <int VAR>
__device__ __forceinline__ void diff_unit(const int b, const int hh, const int qb, const bf16_t* __restrict__ QKV, bf16_t* __restrict__ O, const float kmax,
                                          const DiffConsts dc, LAS unsigned char* shm, const int wid, const int lane_in) {
    constexpr int DV32 = 4, PITCH = DIFF_N, KSLOT = 16384, VRING = 4 * 16384;
    int lane = lane_in; asm volatile("" : "+v"(lane));
    const int r32 = lane & 31, hi = lane >> 5;
    const int qs = wid & 3, cmap = wid >> 2, i0 = qb * 128, iw = i0 + qs * 32, qcol = (hh * 2 + cmap) * 64, kcol = 1024 + hh * 128, vcol = 2048 + hh * 128;
    const float slope2 = __builtin_amdgcn_exp2f(-(float)(hh + 1)) * LOG2E;
    const bf16_t* base = QKV + (size_t)b * SEQ * PITCH;
    const unsigned lds0 = (unsigned)(uintptr_t)shm;
    const unsigned koff = (unsigned)(lane * PITCH + kcol + wid * 8) * 2u;
    const unsigned voff = (unsigned)((16 * (wid & 3) + (lane >> 2)) * PITCH + vcol + (wid >> 2) * 32 + (lane & 3) * 8) * 2u;
    const unsigned kdst = lds0 + wid * 1024, vdst = lds0 + VRING + wid * 1024;
#define DMA_K(t, slot) do { const char* tb_ = (const char*)base + (size_t)(t) * 64 * PITCH * 2; const unsigned so_ = (unsigned)(slot) * KSLOT; \
        glds16(tb_ + koff, (unsigned)__builtin_amdgcn_readfirstlane(kdst + so_)); glds16(tb_ + koff + 128, (unsigned)__builtin_amdgcn_readfirstlane(kdst + so_ + 8192)); } while (0)
#define DMA_V(t, slot) do { const char* tb_ = (const char*)base + (size_t)(t) * 64 * PITCH * 2; const unsigned so_ = (unsigned)(slot) * KSLOT; \
        glds16(tb_ + voff, (unsigned)__builtin_amdgcn_readfirstlane(vdst + so_)); glds16(tb_ + voff + 128, (unsigned)__builtin_amdgcn_readfirstlane(vdst + so_ + 8192)); } while (0)
    const int td0 = 2 * qb;
    int nL = td0;
#define TILE_OF(idx) ((idx) < 2 ? td0 + (idx) : ((idx) - 2 < nL ? td0 - 1 - ((idx) - 2) : td0 + 2 + ((idx) - 2 - nL)))
    DMA_K(td0, 0); DMA_V(td0, 0); DMA_K(td0 + 1, 1); DMA_V(td0 + 1, 1); DMA_K(TILE_OF(2), 2);
    bf16x8 qr[4]; float nq2 = 0.f;
    { const bf16_t* Qw = base + (size_t)(iw + r32) * PITCH + qcol;
#pragma unroll
      for (int d0 = 0; d0 < 4; ++d0) { qr[d0] = *(const bf16x8*)(Qw + d0 * 16 + hi * 8);
#pragma unroll
          for (int j = 0; j < 8; ++j) { const float f = bf2f((unsigned short)qr[d0][j]); nq2 += f * f; } } }
    nq2 = swap_sum(nq2);
    f32x16 o[DV32];
#pragma unroll
    for (int d0 = 0; d0 < DV32; ++d0)
#pragma unroll
        for (int r = 0; r < 16; ++r) o[d0][r] = 0.f;
    float mhat = 0.f, l = 0.f; bool first = true;
    const lds_cptr shm3 = (lds_cptr)shm;
    const lds_cptr kp0 = shm3 + cmap * 8192 + hi * 1024 + r32 * 16;
    const lds_cptr vp0 = shm3 + VRING + ((lane >> 4) & 1) * 32 + (lane & 3) * 8 + (4 * hi + ((lane & 15) >> 2)) * 64;
    LAS float* wsf = (LAS float*)(shm + 7 * KSLOT);
    ATT_WAIT_BAR(6);
    DMA_K(TILE_OF(3), 3);
    { const int k0 = td0 * 64; const int kind = (k0 + 63 < iw) ? 0 : ((k0 > iw + 31) ? 1 : 2);
      tile_step<1>(kp0, vp0, qr, o, mhat, l, first, slope2, iw + r32 - k0 - 4 * hi, kind, hi); }
    ATT_WAIT_BAR(4);
    DMA_K(TILE_OF(4), 0); DMA_V(TILE_OF(2), 2);
    { const int k0 = (td0 + 1) * 64; const int kind = (k0 + 63 < iw) ? 0 : ((k0 > iw + 31) ? 1 : 2);
      tile_step<1>(kp0 + KSLOT, vp0 + KSLOT, qr, o, mhat, l, first, slope2, iw + r32 - k0 - 4 * hi, kind, hi); }
    { float a = sqrtf(nq2) * kmax - mhat;
#pragma unroll
      for (int o_ = 1; o_ < 32; o_ <<= 1) a = __builtin_fmaxf(a, __shfl_xor(a, o_));
      if (lane == 0) wsf[wid] = a; }
    ATT_WAIT_BAR(4);
    int NT; bool nochk;
    { float amax = wsf[0];
#pragma unroll
      for (int w = 1; w < 8; ++w) amax = __builtin_fmaxf(amax, wsf[w]);
      const float dist = (64.f + __builtin_fmaxf(amax, 0.f)) / slope2;
      const float lo_f = ((float)(i0 - 63) - dist) * (1.f / 64.f), hi_f = ((float)(i0 + 127) + dist) * (1.f / 64.f);
      int t_lo = lo_f <= 0.f ? 0 : (int)lo_f, t_hi = hi_f >= 127.f ? 127 : (int)hi_f;
      if (t_lo > td0 - 2) t_lo = td0 - 2 < 0 ? 0 : td0 - 2; if (t_hi < td0 + 3) t_hi = td0 + 3 > 127 ? 127 : td0 + 3;
      t_lo = __builtin_amdgcn_readfirstlane(t_lo); t_hi = __builtin_amdgcn_readfirstlane(t_hi);
      nL = td0 - t_lo; NT = 2 + nL + (t_hi - (td0 + 1)); if (VAR & 256) NT = 2;
      nochk = __builtin_amdgcn_readfirstlane(amax <= 64.f ? 1 : 0) != 0; }
    f32x16 xa0, xa1, xb0, xb1; u32x4 pw0, pw1, pw2, pw3; bf16x8 kf0, kf1, kf2, kf3; s16x4 vl0, vh0, vl1, vh1, vl2, vh2, vl3, vh3;
    float sl_n, base_n, rf = 1.f; bool resc = false;
#define KRD(dst, f) do { if ((VAR & 4) && (f) >= 4) break; dst = *(const LAS bf16x8*)(kp_ + ((f) >> 1) * 2048 + ((f) & 1) * 512); } while (0)
#define VRD(lo, hh_, i) do { if ((VAR & 2) && (i) >= 4) break; lo = vtr(vp_ + ((i) >> 2) * 4096 + ((i) & 3) * 1024); hh_ = vtr(vp_ + ((i) >> 2) * 4096 + ((i) & 3) * 1024 + 512); } while (0)
#define KRN(dst, f) dst = *(const LAS bf16x8*)(kn_ + ((f) >> 1) * 2048 + ((f) & 1) * 512)
#define VFR(lo, hh_) (bf16x8){lo[0], lo[1], lo[2], lo[3], hh_[0], hh_[1], hh_[2], hh_[3]}
#define SET_NEXT(idx) do { const int tn_ = TILE_OF(idx); const bool left_ = (idx) - 2 < nL; sl_n = left_ ? slope2 : -slope2; \
        base_n = __builtin_fmaf(-sl_n, (float)(iw + r32 - tn_ * 64 - 4 * hi), -mhat); } while (0)
#define CINIT(X0, X1) do { _Pragma("unroll") for (int r = 0; r < 16; ++r) { X0[r] = __builtin_fmaf(sl_n, CRF(r), base_n); X1[r] = __builtin_fmaf(sl_n, CRF(r) + 32.f, base_n); } } while (0)
#define GA(Sx, KF, qf, RD, P, e, PW, w0, w1) do { Sx = MF(KF, qf, Sx); RD; if (!(VAR & 32)) { sacc += P[e]; sacc += P[e + 1]; sacc += P[e + 2]; sacc += P[e + 3]; PIN(sacc); \
        PW[w0] = cvtpk(P[e], P[e + 1]); PW[w1] = cvtpk(P[e + 2], P[e + 3]); } PIN(PW); SBAR(); } while (0)
#define PHASE_A(S0, S1, P0, P1) do { float sacc = 0.f; \
        GA(S0, kf0, qr[0], KRD(kf0, 4), P0, 0,  pw0, 0, 1); GA(S1, kf1, qr[0], KRD(kf1, 5), P0, 4,  pw0, 2, 3); \
        GA(S0, kf2, qr[1], KRD(kf2, 6), P0, 8,  pw1, 0, 1); GA(S1, kf3, qr[1], KRD(kf3, 7), P0, 12, pw1, 2, 3); \
        GA(S0, kf0, qr[2], VRD(vl0, vh0, 0), P1, 0,  pw2, 0, 1); GA(S1, kf1, qr[2], VRD(vl1, vh1, 1), P1, 4,  pw2, 2, 3); \
        GA(S0, kf2, qr[3], VRD(vl2, vh2, 2), P1, 8,  pw3, 0, 1); GA(S1, kf3, qr[3], VRD(vl3, vh3, 3), P1, 12, pw3, 2, 3); \
        l += sacc; } while (0)
#define QK_ONLY(S0, S1) do { \
        S0 = MF(kf0, qr[0], S0); KRD(kf0, 4); S1 = MF(kf1, qr[0], S1); KRD(kf1, 5); S0 = MF(kf2, qr[1], S0); KRD(kf2, 6); S1 = MF(kf3, qr[1], S1); KRD(kf3, 7); SBAR(); \
        S0 = MF(kf0, qr[2], S0); S1 = MF(kf1, qr[2], S1); S0 = MF(kf2, qr[3], S0); S1 = MF(kf3, qr[3], S1); SBAR(); } while (0)
#define DECIDE(S0, S1) do { if (VAR & 64) break; asm volatile("s_nop 15\n\ts_nop 7" : "+v"(S0), "+v"(S1));   \
        float ma_ = max3f(S0[0], S0[1], S1[0]), mb_ = max3f(S0[2], S0[3], S1[1]); ma_ = max3f(ma_, S1[2], S1[3]); \
        _Pragma("unroll") for (int r = 4; r < 16; r += 4) { ma_ = max3f(ma_, S0[r], S0[r + 1]); mb_ = max3f(mb_, S0[r + 2], S0[r + 3]); ma_ = max3f(ma_, S1[r], S1[r + 1]); mb_ = max3f(mb_, S1[r + 2], S1[r + 3]); } \
        float rm_ = max3f(ma_, mb_, mb_); rm_ = swap_max(rm_); resc = false; \
        if (__builtin_expect(__any(rm_ > THR), 0)) { const float dl_ = __builtin_fmaxf(rm_, 0.f); mhat += dl_; \
            _Pragma("unroll") for (int r = 0; r < 16; ++r) { S0[r] -= dl_; S1[r] -= dl_; } \
            rf = __builtin_amdgcn_exp2f(-dl_); l *= rf; resc = true; } } while (0)
#define RESCALE_O() do { if (resc) { int h4_ = 4 * hi; asm volatile("" : "+v"(h4_)); _Pragma("unroll") for (int r = 0; r < 16; ++r) { const float fr_ = __shfl(rf, CRI(r) + h4_); \
            _Pragma("unroll") for (int d0 = 0; d0 < DV32; ++d0) o[d0][r] *= fr_; } resc = false; } } while (0)
#define EXP2(x) ((VAR & 1) ? (x) * 0.001f : __builtin_amdgcn_exp2f(x))
#define GB(Ox, PW, VL, VH, RD, S, e, C, crf) do { if (!(VAR & 512)) Ox = MF(__builtin_bit_cast(bf16x8, PW), VFR(VL, VH), Ox); RD; S[e] = EXP2(S[e]); S[e + 1] = EXP2(S[e + 1]); PIN(S); \
        if (!(VAR & 16)) { C[e] = fmamk<__builtin_bit_cast(unsigned, CRF(e) + (crf))>(sl_n, base_n); C[e + 1] = fmamk<__builtin_bit_cast(unsigned, CRF(e + 1) + (crf))>(sl_n, base_n); } PIN(C); SBAR(); } while (0)
#define PHASE_B(S0, S1, C0, C1) do { \
        GB(o[0], pw0, vl0, vh0, VRD(vl0, vh0, 4),  S0, 0,  C0, 0.f);  GB(o[0], pw1, vl1, vh1, VRD(vl1, vh1, 5),  S0, 2,  C0, 0.f); \
        GB(o[0], pw2, vl2, vh2, VRD(vl2, vh2, 6),  S0, 4,  C0, 0.f);  GB(o[0], pw3, vl3, vh3, VRD(vl3, vh3, 7),  S0, 6,  C0, 0.f); \
        GB(o[1], pw0, vl0, vh0, VRD(vl0, vh0, 8),  S0, 8,  C0, 0.f);  GB(o[1], pw1, vl1, vh1, VRD(vl1, vh1, 9),  S0, 10, C0, 0.f); \
        GB(o[1], pw2, vl2, vh2, VRD(vl2, vh2, 10), S0, 12, C0, 0.f);  GB(o[1], pw3, vl3, vh3, VRD(vl3, vh3, 11), S0, 14, C0, 0.f); \
        GB(o[2], pw0, vl0, vh0, VRD(vl0, vh0, 12), S1, 0,  C1, 32.f); GB(o[2], pw1, vl1, vh1, VRD(vl1, vh1, 13), S1, 2,  C1, 32.f); \
        GB(o[2], pw2, vl2, vh2, VRD(vl2, vh2, 14), S1, 4,  C1, 32.f); GB(o[2], pw3, vl3, vh3, VRD(vl3, vh3, 15), S1, 6,  C1, 32.f); \
        GB(o[3], pw0, vl0, vh0, KRN(kf0, 0),       S1, 8,  C1, 32.f); GB(o[3], pw1, vl1, vh1, KRN(kf1, 1),       S1, 10, C1, 32.f); \
        GB(o[3], pw2, vl2, vh2, KRN(kf2, 2),       S1, 12, C1, 32.f); GB(o[3], pw3, vl3, vh3, KRN(kf3, 3),       S1, 14, C1, 32.f); } while (0)
#define ROT3(s) ((s) == 2 ? 0 : (s) + 1)
#define ROT4(s) (((s) + 1) & 3)
#define STEP(S0, S1, P0, P1, it, CHK) do { \
        asm volatile("" : "+s"(sk), "+s"(sv)); \
        const int skm_ = (sk + 3) & 3, skp_ = ROT4(sk), svpp_ = sv == 0 ? 2 : sv - 1;   \
        const lds_cptr kp_ = kp0 + sk * KSLOT; const lds_cptr kn_ = kp0 + skp_ * KSLOT; const lds_cptr vp_ = vp0 + sv * KSLOT; \
        if (!(VAR & 8) && (it) + 3 < NT) DMA_K(TILE_OF((it) + 3), skm_); \
        SET_NEXT((it) + 1); SBAR(); \
        __builtin_amdgcn_s_setprio(1); PHASE_A(S0, S1, P0, P1); __builtin_amdgcn_s_setprio(0); \
        if (!(VAR & 8) && (it) + 1 < NT) DMA_V(TILE_OF((it) + 1), svpp_); \
        if (CHK) { DECIDE(S0, S1); if (resc) SET_NEXT((it) + 1); } SBAR(); \
        __builtin_amdgcn_s_setprio(1); PHASE_B(S0, S1, P0, P1); __builtin_amdgcn_s_setprio(0); \
        if (CHK) RESCALE_O(); sk = skp_; sv = ROT3(sv); } while (0)
    if (NT > 2) {
        { const lds_cptr kp_ = kp0 + 2 * KSLOT; const lds_cptr kn_ = kp0 + 3 * KSLOT;
          KRD(kf0, 0); KRD(kf1, 1); KRD(kf2, 2); KRD(kf3, 3);
          if (5 < NT) DMA_K(TILE_OF(5), 1); if (3 < NT) DMA_V(TILE_OF(3), 0);
          SET_NEXT(2); CINIT(xa0, xa1); SBAR();
          QK_ONLY(xa0, xa1);
          if (!nochk) { DECIDE(xa0, xa1); RESCALE_O(); }
#pragma unroll
          for (int r = 0; r < 16; ++r) { xa0[r] = EXP2(xa0[r]); xa1[r] = EXP2(xa1[r]); }
          SET_NEXT(3); CINIT(xb0, xb1);
          KRN(kf0, 0); KRN(kf1, 1); KRN(kf2, 2); KRN(kf3, 3); }
#define PIPE_LOOP(CHK_) do { \
        int it = 3, sk = 3, sv = 2; \
        _Pragma("unroll 1") \
        for (; it + 1 < NT; it += 2) { \
            if (!(VAR & 128)) { if (it + 2 < NT) { ATT_WAIT_BAR(4); } else { ATT_WAIT_BAR(2); } } \
            STEP(xb0, xb1, xa0, xa1, it, CHK_); \
            if (!(VAR & 128)) { if (it + 3 < NT) { ATT_WAIT_BAR(4); } else { ATT_WAIT_BAR(2); } } \
            STEP(xa0, xa1, xb0, xb1, it + 1, CHK_); \
        } \
        if (it < NT) { \
            ATT_WAIT_BAR(2); \
            STEP(xb0, xb1, xa0, xa1, it, CHK_); \
 \
            { float sacc = 0.f; \
        _Pragma("unroll") \
              for (int r = 0; r < 16; ++r) sacc += xb0[r] + xb1[r]; \
              l += sacc; \
              pw0 = (u32x4){cvtpk(xb0[0], xb0[1]), cvtpk(xb0[2], xb0[3]), cvtpk(xb0[4], xb0[5]), cvtpk(xb0[6], xb0[7])}; pw1 = (u32x4){cvtpk(xb0[8], xb0[9]), cvtpk(xb0[10], xb0[11]), cvtpk(xb0[12], xb0[13]), cvtpk(xb0[14], xb0[15])}; \
              pw2 = (u32x4){cvtpk(xb1[0], xb1[1]), cvtpk(xb1[2], xb1[3]), cvtpk(xb1[4], xb1[5]), cvtpk(xb1[6], xb1[7])}; pw3 = (u32x4){cvtpk(xb1[8], xb1[9]), cvtpk(xb1[10], xb1[11]), cvtpk(xb1[12], xb1[13]), cvtpk(xb1[14], xb1[15])}; } \
        } else { \
            { float sacc = 0.f; \
        _Pragma("unroll") \
              for (int r = 0; r < 16; ++r) sacc += xa0[r] + xa1[r]; \
              l += sacc; \
              pw0 = (u32x4){cvtpk(xa0[0], xa0[1]), cvtpk(xa0[2], xa0[3]), cvtpk(xa0[4], xa0[5]), cvtpk(xa0[6], xa0[7])}; pw1 = (u32x4){cvtpk(xa0[8], xa0[9]), cvtpk(xa0[10], xa0[11]), cvtpk(xa0[12], xa0[13]), cvtpk(xa0[14], xa0[15])}; \
              pw2 = (u32x4){cvtpk(xa1[0], xa1[1]), cvtpk(xa1[2], xa1[3]), cvtpk(xa1[4], xa1[5]), cvtpk(xa1[6], xa1[7])}; pw3 = (u32x4){cvtpk(xa1[8], xa1[9]), cvtpk(xa1[10], xa1[11]), cvtpk(xa1[12], xa1[13]), cvtpk(xa1[14], xa1[15])}; } \
        } \
    } while (0)
        PIPE_LOOP(!nochk);
#undef PIPE_LOOP
        ATT_WAIT_BAR(0);
        { const int sl_ = (NT - 1) % 3; const lds_cptr vp_ = vp0 + sl_ * KSLOT;
#pragma unroll
          for (int d0 = 0; d0 < DV32; ++d0) {
              VRD(vl0, vh0, d0 * 4); VRD(vl1, vh1, d0 * 4 + 1); VRD(vl2, vh2, d0 * 4 + 2); VRD(vl3, vh3, d0 * 4 + 3);
              o[d0] = MF(__builtin_bit_cast(bf16x8, pw0), VFR(vl0, vh0), o[d0]); o[d0] = MF(__builtin_bit_cast(bf16x8, pw1), VFR(vl1, vh1), o[d0]);
              o[d0] = MF(__builtin_bit_cast(bf16x8, pw2), VFR(vl2, vh2), o[d0]); o[d0] = MF(__builtin_bit_cast(bf16x8, pw3), VFR(vl3, vh3), o[d0]); } }
    }
#undef TILE_OF
#undef DMA_K
#undef DMA_V
#undef KRD
#undef VRD
#undef VFR
#undef SET_NEXT
#undef CINIT
#undef GA
#undef PHASE_A
#undef QK_ONLY
#undef DECIDE
#undef RESCALE_O
#undef EXP2
#undef GB
#undef PHASE_B
#undef STEP
#undef ROT3
#undef ROT4
#undef KRN
    l = swap_sum(l);
    const float rl = 1.f / l;
    LAS float* cb = (LAS float*)shm + qs * 4096;
    ATT_WAIT_BAR(0);
    if (VAR & 1024) { if (lane == 0 && rl == 12345.f) O[0] = 0; return; }
    if (cmap == 1) {
#pragma unroll
        for (int r = 0; r < 16; ++r) { const int row = CRI(r) + 4 * hi; const float rr = __shfl(rl, row) * dc.lam_full;
#pragma unroll
            for (int d0 = 0; d0 < DV32; ++d0) cb[row * 128 + d0 * 32 + r32] = o[d0][r] * rr; }
    }
    ATT_WAIT_BAR(0);
    if (cmap == 0) {
        bf16_t* Ow = O + (size_t)(b * SEQ + iw) * D + hh * 128 + r32;
        const float gsub[DV32] = {dc.gs0, dc.gs1, dc.gs2, dc.gs3};
#pragma unroll
        for (int r = 0; r < 16; ++r) { const int row = CRI(r) + 4 * hi; const float rr = __shfl(rl, row);
            float v[DV32]; float ss = 0.f;
#pragma unroll
            for (int d0 = 0; d0 < DV32; ++d0) { v[d0] = o[d0][r] * rr - cb[row * 128 + d0 * 32 + r32]; ss += v[d0] * v[d0]; }
            ss += __shfl_xor(ss, 1); ss += __shfl_xor(ss, 2); ss += __shfl_xor(ss, 4); ss += __shfl_xor(ss, 8); ss += __shfl_xor(ss, 16);
            const float sc = __builtin_amdgcn_rsqf(ss * (1.f / 128.f) + 1e-5f);
#pragma unroll
            for (int d0 = 0; d0 < DV32; ++d0) Ow[(size_t)row * D + d0 * 32] = (bf16_t)f2bf(v[d0] * sc * gsub[d0]); }
    }
    asm volatile("s_waitcnt lgkmcnt(0)\n\ts_barrier" ::: "memory");
}
#undef SBAR
#undef PIN
#undef MF
#undef ATT_WAIT_BAR
}

typedef GAS unsigned gu32;
#define RLX_AGENT __ATOMIC_RELAXED, __HIP_MEMORY_SCOPE_AGENT
#define LDS_WAIT() asm volatile("s_waitcnt lgkmcnt(0)" ::: "memory")
#define VM_WAIT() asm volatile("s_waitcnt vmcnt(0)" ::: "memory")
#define XB_TMO      128
#define XB_XCNT(j)  (256  + 64 * (j))
#define XB_XSUB(j)  (1280 + 64 * (j))
#define XB_XGEN(j)  (2304 + 64 * (j))
#define XB_TOP      3328
#define XB_TOPGEN   3392
#define XCD_BAR_WORDS 3456
#define XB_SPIN_CAP (1u << 18)
__device__ __forceinline__ unsigned xb_ld(unsigned* p)              { return __hip_atomic_load(p, __ATOMIC_RELAXED, __HIP_MEMORY_SCOPE_AGENT); }
__device__ __forceinline__ unsigned xb_add(unsigned* p, unsigned v) { return __hip_atomic_fetch_add(p, v, __ATOMIC_RELAXED, __HIP_MEMORY_SCOPE_AGENT); }
__device__ __forceinline__ unsigned xb_xcc_id() { return (unsigned)__builtin_amdgcn_s_getreg((3 << 11) | 20) & 0xFu; }
#define XB_SPIN(cond, bar) do { unsigned _sp = 0; while (cond) { __builtin_amdgcn_s_sleep(1); \
    if ((++_sp & 255u) == 0u) { if (xb_ld(&(bar)[XB_TMO])) break; if (_sp > XB_SPIN_CAP) { atomicAdd(&(bar)[XB_TMO], 1u); break; } } } } while (0)
struct XcdBarrier { unsigned* bar; unsigned x; volatile LAS unsigned* st; };
__device__ __forceinline__ XcdBarrier xcd_barrier_post(unsigned* bar, volatile LAS unsigned* st, const bool leader) {
    XcdBarrier b; b.bar = bar; b.x = xb_xcc_id(); b.st = st;
    if (leader) (void)xb_add(&bar[XB_XCNT(b.x)], 1u);
    return b;
}
__device__ __forceinline__ void xcd_barrier_complete(unsigned* bar, unsigned x, unsigned& nloc, unsigned& nx) {
    const unsigned G = gridDim.x * gridDim.y * gridDim.z;
    unsigned sum, cnt, mine, sp = 0u;
    for (;;) {
        sum = 0u; cnt = 0u; mine = 0u;
#pragma unroll
        for (unsigned j = 0; j < 16; ++j) { const unsigned c = xb_ld(&bar[XB_XCNT(j)]); sum += c; cnt += (c > 0u) ? 1u : 0u; mine = (j == x) ? c : mine; }
        if (sum == G) break;
        __builtin_amdgcn_s_sleep(1);
        if ((++sp & 255u) == 0u) { if (xb_ld(&bar[XB_TMO])) break; if (sp > XB_SPIN_CAP) { atomicAdd(&bar[XB_TMO], 1u); break; } }
    }
    nloc = mine > 0u ? mine : 1u; nx = cnt > 0u ? cnt : 1u;
}
__device__ __forceinline__ void xcd_barrier(const XcdBarrier& b, const bool leader) {
    asm volatile("s_waitcnt vmcnt(0)" ::: "memory");
    __syncthreads();
    if (leader) {
        unsigned* bar = b.bar;
        __builtin_amdgcn_s_waitcnt(0);
        unsigned nloc = b.st[0], nx = b.st[1];
        if (nloc == 0u) { xcd_barrier_complete(bar, b.x, nloc, nx); b.st[0] = nloc; b.st[1] = nx; }
        const unsigned old = xb_add(&bar[XB_XSUB(b.x)], 1u);
        const unsigned gen = old / nloc;
        if (old + 1u == (gen + 1u) * nloc) {
            __builtin_amdgcn_fence(__ATOMIC_RELEASE, "agent");
            asm volatile("s_waitcnt vmcnt(0)" ::: "memory");
            const unsigned og = xb_add(&bar[XB_TOP], 1u);
            const unsigned tg = og / nx;
            if (og + 1u == (tg + 1u) * nx) xb_add(&bar[XB_TOPGEN], 1u);
            else XB_SPIN(xb_ld(&bar[XB_TOPGEN]) == tg, bar);
            __builtin_amdgcn_fence(__ATOMIC_ACQUIRE, "agent");
            xb_add(&bar[XB_XGEN(b.x)], 1u);
            asm volatile("s_waitcnt vmcnt(0)" ::: "memory");
        } else {
            XB_SPIN(xb_ld(&bar[XB_XGEN(b.x)]) == gen, bar);
            __builtin_amdgcn_fence(__ATOMIC_ACQUIRE, "agent");
            asm volatile("s_waitcnt vmcnt(0)" ::: "memory");
        }
    }
    __syncthreads();
}

struct Args { const float* in[18]; float* out; unsigned char* ws; int ph_lo, ph_hi, use_cg, pad; };
enum { I_X = 0, I_NMIX, I_NFFN, I_SWA_QKV, I_SWA_WO, I_SWA_SINK, I_DIFF_QKV, I_DIFF_WO, I_DIFF_LAM, I_DIFF_SUBLN, I_WG, I_BG, I_WR, I_BR, I_GATE, I_UP, I_DOWN, I_FNORM };
typedef const __attribute__((address_space(4))) Args* CArgs;
__device__ __forceinline__ CArgs kargs() { CArgs p = (CArgs)__builtin_amdgcn_kernarg_segment_ptr(); asm volatile("" : "+s"(p)); return p; }
__device__ __forceinline__ int vcu_of(int G) { const int bx = blockIdx.x; return (G % 8 == 0) ? (bx % 8) * (G / 8) + bx / 8 : bx; }

__device__ __forceinline__ void tr_item(const float* W, int N, int k0, int n0, bf16_t* dst, int ldd, LAS float* scr, int lane) {
    f32x4 v[8];
#pragma unroll
    for (int i = 0; i < 8; ++i) v[i] = *(const f32x4*)(W + (size_t)(k0 + 8 * i + (lane >> 3)) * N + n0 + (lane & 7) * 4);
#pragma unroll
    for (int i = 0; i < 8; ++i) { LAS float* p = scr + (8 * i + (lane >> 3)) * 33 + (lane & 7) * 4; p[0] = v[i].x; p[1] = v[i].y; p[2] = v[i].z; p[3] = v[i].w; }
    LDS_WAIT(); asm volatile("" ::: "memory");
    const int c = lane & 7;
#pragma unroll
    for (int j = 0; j < 4; ++j) { const int n = (lane >> 3) + 8 * j; const LAS float* s = scr + (8 * c) * 33 + n;
        u32x4 o; o.x = pk2(s[0 * 33], s[1 * 33]); o.y = pk2(s[2 * 33], s[3 * 33]); o.z = pk2(s[4 * 33], s[5 * 33]); o.w = pk2(s[6 * 33], s[7 * 33]);
        *(GAS u32x4*)(dst + (size_t)n * ldd + k0 + 8 * c) = o; }
    LDS_WAIT(); asm volatile("" ::: "memory");
}
__device__ __forceinline__ void rms_row_to_bf16(const float* xrow, const float* g, bf16_t* orow, int lane) {
    const GAS f32x4* xr = (const GAS f32x4*)xrow + lane; const GAS f32x4* gr = (const GAS f32x4*)g + lane;
    f32x4 v[4]; float s = 0.f;
#pragma unroll
    for (int j = 0; j < 4; ++j) { v[j] = xr[64 * j]; s += (v[j].x * v[j].x + v[j].y * v[j].y) + (v[j].z * v[j].z + v[j].w * v[j].w); }
    const float rstd = 1.f / sqrtf(wave_sum(s) * (1.f / D) + 1e-6f);
    GAS u32x2* o8 = (GAS u32x2*)orow + lane;
#pragma unroll
    for (int j = 0; j < 4; ++j) { const f32x4 gg = gr[64 * j]; u32x2 w; w.x = pk2(v[j].x * rstd * gg.x, v[j].y * rstd * gg.y); w.y = pk2(v[j].z * rstd * gg.z, v[j].w * rstd * gg.w); o8[64 * j] = w; }
}

__device__ __forceinline__ void phase_prologue(LAS unsigned char* lds_in, const int wave_in) {
    int lane = lane_id(); asm volatile("" : "+v"(lane)); int wave = wave_in; asm volatile("" : "+s"(wave)); LAS unsigned char* lds = lds_in; asm volatile("" : "+s"(lds));
    const CArgs a = kargs(); unsigned char* ws = a->ws;
    const int G = gridDim.x, vcu = vcu_of(G);
    LAS float* scr = (LAS float*)(lds + wave * 16384);
    const int gw = vcu * NWAVES + wave, NGW = G * NWAVES;
    bf16_t* swa_qkv_t = (bf16_t*)(ws + WS_SWA_QKV_T); bf16_t* swa_wo_t = (bf16_t*)(ws + WS_SWA_WO_T);
    bf16_t* diff_qkv_t = (bf16_t*)(ws + WS_DIFF_QKV_T); bf16_t* diff_wo_t = (bf16_t*)(ws + WS_DIFF_WO_T);
    constexpr int I0 = 16 * 48, I1 = 16 * 32, I2 = 16 * 96, I3 = 16 * 32, IM = 64 * 768, NITEMS = I0 + I1 + I2 + I3 + IM;
    struct TrItem { const float* src; int N; unsigned char* dstb; int ldb; int f8; };
    auto decode = [&](int it) -> TrItem {
        int r = it; const float* W; int N, k0, n0, ldd; bf16_t* dst; bf16_t* mbase = nullptr; int f8 = 0;
        if (r < I0) { const int kb = r / 48, nb = r % 48; W = a->in[I_SWA_QKV]; N = SWA_N; k0 = 64 * kb; n0 = 32 * nb; dst = swa_qkv_t + (size_t)n0 * D; ldd = D; mbase = swa_qkv_t; f8 = F8_QKV & 1; }
        else if ((r -= I0) < I1) { const int kb = r / 32, nb = r % 32; W = a->in[I_SWA_WO]; N = D; k0 = 64 * kb; n0 = 32 * nb; dst = swa_wo_t + (size_t)n0 * D; ldd = D; }
        else if ((r -= I1) < I2) { const int kb = r / 96, nb = r % 96; W = a->in[I_DIFF_QKV]; N = DIFF_N; k0 = 64 * kb; n0 = 32 * nb; dst = diff_qkv_t + (size_t)n0 * D; ldd = D; mbase = diff_qkv_t; f8 = (F8_QKV >> 1) & 1; }
        else if ((r -= I2) < I3) { const int kb = r / 32, nb = r % 32; W = a->in[I_DIFF_WO]; N = D; k0 = 64 * kb; n0 = 32 * nb; dst = diff_wo_t + (size_t)n0 * D; ldd = D; }
        else { r -= I3; const int le = r / 768, q = r % 768;
            bf16_t* gu = (bf16_t*)(ws + WS_WMOE + (size_t)le * 3 * MiB); bf16_t* dn = gu + (size_t)D * D;
            const bool l1 = le >= 32 || F8_L0;
            if (q < 256) { const int kb = q / 16, c0 = 32 * (q % 16); W = a->in[I_GATE] + (size_t)le * D * DEXP; N = DEXP; k0 = 64 * kb; n0 = c0; dst = gu + (size_t)((c0 >> 7) * 256 + (c0 & 127)) * D; ldd = D; mbase = gu; f8 = ((F8_STAGE & 2) && l1); }
            else if (q < 512) { const int qq = q - 256; const int kb = qq / 16, c0 = 32 * (qq % 16); W = a->in[I_UP] + (size_t)le * D * DEXP; N = DEXP; k0 = 64 * kb; n0 = c0; dst = gu + (size_t)((c0 >> 7) * 256 + 128 + (c0 & 127)) * D; ldd = D; mbase = gu; f8 = ((F8_STAGE & 2) && l1); }
            else { const int qq = q - 512; const int kb = qq / 32, nb = qq % 32; W = a->in[I_DOWN] + (size_t)le * DEXP * D; N = D; k0 = 64 * kb; n0 = 32 * nb; dst = dn + (size_t)n0 * DEXP; ldd = DEXP; mbase = dn; f8 = ((F8_STAGE & 1) && l1); } }
        TrItem t; t.src = W + (size_t)(k0 + (lane >> 3)) * N + n0 + (lane & 7) * 4; t.N = N; t.f8 = f8;
        t.dstb = f8 ? (unsigned char*)mbase + (size_t)(dst - mbase) + k0 + 8 * (lane & 7) : (unsigned char*)(dst + k0 + 8 * (lane & 7)); t.ldb = f8 ? ldd : 2 * ldd; return t;
    };
    {
        f32x4 va[8], vb[8]; TrItem ca, cb;
#define TR_LOAD(v, t) do { _Pragma("unroll") for (int i = 0; i < 8; ++i) v[i] = *(const f32x4*)((t).src + (size_t)(8 * i) * (t).N); } while (0)
#define TR_FINISH(v, t) do { \
            _Pragma("unroll") for (int i = 0; i < 8; ++i) { LAS float* p = scr + (8 * i + (lane >> 3)) * 33 + (lane & 7) * 4; p[0] = v[i].x; p[1] = v[i].y; p[2] = v[i].z; p[3] = v[i].w; } \
            LDS_WAIT(); asm volatile("" ::: "memory"); \
            if ((t).f8) { _Pragma("unroll") for (int j = 0; j < 4; ++j) { const int n = (lane >> 3) + 8 * j; const LAS float* s = scr + (8 * (lane & 7)) * 33 + n; \
                u32x2 o8; o8.x = pk4_fp8(64.f * s[0 * 33], 64.f * s[1 * 33], 64.f * s[2 * 33], 64.f * s[3 * 33]); o8.y = pk4_fp8(64.f * s[4 * 33], 64.f * s[5 * 33], 64.f * s[6 * 33], 64.f * s[7 * 33]); \
                *(GAS u32x2*)((t).dstb + (size_t)n * (t).ldb) = o8; } } \
            else { _Pragma("unroll") for (int j = 0; j < 4; ++j) { const int n = (lane >> 3) + 8 * j; const LAS float* s = scr + (8 * (lane & 7)) * 33 + n; \
                u32x4 o; o.x = pk2(s[0 * 33], s[1 * 33]); o.y = pk2(s[2 * 33], s[3 * 33]); o.z = pk2(s[4 * 33], s[5 * 33]); o.w = pk2(s[6 * 33], s[7 * 33]); \
                *(GAS u32x4*)((t).dstb + (size_t)n * (t).ldb) = o; } } \
            LDS_WAIT(); asm volatile("" ::: "memory"); } while (0)
        const int n_my = gw < NITEMS ? (NITEMS - gw + NGW - 1) / NGW : 0;
        if (n_my > 0) { ca = decode(gw); TR_LOAD(va, ca); }
#pragma unroll 1
        for (int j = 0; j < n_my; j += 2) {
            const int j1 = j + 1 < n_my ? j + 1 : n_my - 1, j2 = j + 2 < n_my ? j + 2 : n_my - 1;
            cb = decode(gw + j1 * NGW); TR_LOAD(vb, cb);
            TR_FINISH(va, ca);
            ca = decode(gw + j2 * NGW); TR_LOAD(va, ca);
            if (j + 1 < n_my) { TR_FINISH(vb, cb); }
        }
#undef TR_LOAD
#undef TR_FINISH
    }
    { bf16_t* wr_t = (bf16_t*)(ws + WS_WR); const int gt = gw * 64 + lane, NGT = NGW * 64;
      for (int i = gt; i < 2 * 36 * D; i += NGT) { const int l = i / (36 * D), rem = i % (36 * D), c = rem / D, k = rem % D;
          const float w = c < 4 ? a->in[I_WG][(size_t)l * D * 4 + k * 4 + c] : a->in[I_WR][(size_t)l * D * 32 + k * 32 + (c - 4)];
          const unsigned h = f2bf(w); const float r = w - __uint_as_float(h << 16);
          wr_t[(size_t)l * 2 * 36 * D + rem] = (bf16_t)h; wr_t[(size_t)l * 2 * 36 * D + 36 * D + rem] = (bf16_t)f2bf(r); } }
    bf16_t* XN = (bf16_t*)XNB(a);
#pragma unroll 1
    for (int mb = gw * 4; mb < M; mb += NGW * 4) {
        const float* xb = a->in[I_X] + (size_t)mb * D; const GAS f32x4* gr = (const GAS f32x4*)a->in[I_NMIX] + lane;
        f32x4 v[4][4];
#pragma unroll
        for (int r = 0; r < 4; ++r)
#pragma unroll
            for (int j = 0; j < 4; ++j) v[r][j] = ((const GAS f32x4*)(xb + (size_t)r * D) + lane)[64 * j];
        f32x4 gg[4];
#pragma unroll
        for (int j = 0; j < 4; ++j) gg[j] = gr[64 * j];
#pragma unroll
        for (int r = 0; r < 4; ++r) { float s = 0.f;
#pragma unroll
            for (int j = 0; j < 4; ++j) s += (v[r][j].x * v[r][j].x + v[r][j].y * v[r][j].y) + (v[r][j].z * v[r][j].z + v[r][j].w * v[r][j].w);
            const float rstd = 1.f / sqrtf(wave_sum(s) * (1.f / D) + 1e-6f);
            if (F8_QKV & 1) { GAS unsigned* o4 = (GAS unsigned*)((unsigned char*)XN + (size_t)(mb + r) * D) + lane;
#pragma unroll
                for (int j = 0; j < 4; ++j) { const f32x4 n = v[r][j] * (4.f * rstd) * gg[j]; o4[64 * j] = pk4_fp8(n.x, n.y, n.z, n.w); } }
            else { GAS u32x2* o8 = (GAS u32x2*)(XN + (size_t)(mb + r) * D) + lane;
#pragma unroll
                for (int j = 0; j < 4; ++j) { const f32x4 n = v[r][j] * rstd * gg[j]; u32x2 w; w.x = pk2(n.x, n.y); w.y = pk2(n.z, n.w); o8[64 * j] = w; } } }
    }
}

template <int RV, bool F8OUT>
__device__ __forceinline__ void phase_router(LAS unsigned char* lds_in, int layer, const int wave_in, const bool dry) {
    int lane = lane_id(); asm volatile("" : "+v"(lane)); int wave = wave_in; asm volatile("" : "+s"(wave)); LAS unsigned char* lds = lds_in; asm volatile("" : "+s"(lds));
    const CArgs a = kargs(); unsigned char* ws = a->ws;
    const int G = gridDim.x, vcu = vcu_of(G);
    const int gw = vcu * NWAVES + wave, NGW = G * NWAVES;
    const float* g = a->in[I_NFFN] + layer * D;
    const bf16_t* wth = (const bf16_t*)(ws + WS_WR) + (size_t)layer * 2 * 36 * D; const bf16_t* wtl = wth + 36 * D;
    const float* bg = a->in[I_BG] + layer * 4; const float* br = a->in[I_BR] + layer * 32;
    bf16_t* XN = (bf16_t*)(dry ? ws + WS_SCR : XNB(a)); const bf16_t* xin = (const bf16_t*)(ws + WS_XR); float* rstd_tok = (float*)(ws + (dry ? WS_SCR + 80 * MiB : WS_RSTD));
    unsigned* cnt = (unsigned*)(ws + WS_CTL) + CW_CNT + (dry ? 2 : layer) * 1024;
    int* ltok = (int*)(ws + (dry ? WS_SCR + 64 * MiB : WS_LTOK)); float* lw = (float*)(ws + (dry ? WS_SCR + 68 * MiB : WS_LW)); i32x4* tinfo = (i32x4*)(ws + (dry ? WS_SCR + 72 * MiB : WS_TINFO));
    LAS float* lgs = (LAS float*)(lds + 98304 + wave * 4096);
    LAS float* rsl = lgs + 768;
    const int row = lane & 15, kg = lane >> 4;
    const bool c2ok = row < 4;
    LAS unsigned* lcnt = (LAS unsigned*)(lds + TP_OFF); LAS unsigned* lbase = lcnt + 32;
    const int tid = wave * 64 + lane;
#pragma unroll 1
    for (int bt0 = 0; bt0 < M / 16; bt0 += NGW) {
        const int bt = bt0 + gw; const bool live = bt < M / 16;
        const int t0 = (live ? bt : 0) * 16;
        if (tid < 32) lcnt[tid] = 0u;
        const char* grow = (const char*)g + kg * 32;
        char* orow = (char*)(XN + (size_t)(t0 + row) * D) + kg * 16;
        const char* w0 = (const char*)(wth + (size_t)row * D) + kg * 16;
        f32x4 acc0 = {0.f, 0.f, 0.f, 0.f}, acc1 = acc0, acc2 = acc0; float ss = 0.f;
        const unsigned m2 = c2ok ? 0xffffffffu : 0u;
        {
            u32x4 xq[3] = {}; f32x4 ga[3] = {}, gb[3] = {};
            const char* xbase = (const char*)(xin + (size_t)t0 * D); const unsigned xoff = (unsigned)(row * D * 2 + kg * 16);
            const char* gbase = (const char*)g; const unsigned goff = (unsigned)(kg * 32);
            const char* wb0h = (const char*)wth; const char* wb0l = wb0h + 36 * D * 2; const char* wb1h = wb0h + 16 * D * 2; const char* wb1l = wb0h + 52 * D * 2;
            char* obase = live ? (char*)XN + (size_t)t0 * D * (F8OUT ? 1 : 2) : (char*)(ws + WS_SCR + 100 * MiB); const unsigned ooff = F8OUT ? (unsigned)(row * D + kg * 8) : (unsigned)(row * D * 2 + kg * 16);
            const unsigned woff = (unsigned)((row * D + kg * 8) * 2) + (unsigned)wave * 64u, woff2 = (unsigned)(((32 + (row & 3)) * D + kg * 8) * 2) + (unsigned)wave * 64u;
            LAS unsigned char* bfill = lds + wave * 6144 + lane * 16;
            const LAS unsigned char* bread = lds + lane * 16;
            u32x4 fr0, fr1, fr2, fr3, fr4, fr5;
#define RT_BLOAD(c) do { fr0 = *(const u32x4*)(wb0h + woff + (c) * 512); fr1 = *(const u32x4*)(wb0l + woff + (c) * 512); fr2 = *(const u32x4*)(wb1h + woff + (c) * 512); \
            fr3 = *(const u32x4*)(wb1l + woff + (c) * 512); fr4 = *(const u32x4*)(wb0h + woff2 + (c) * 512); fr5 = *(const u32x4*)(wb0l + woff2 + (c) * 512); } while (0)
#define RT_BWRITE(buf) do { fr4.x &= m2; fr4.y &= m2; fr4.z &= m2; fr4.w &= m2; fr5.x &= m2; fr5.y &= m2; fr5.z &= m2; fr5.w &= m2; \
            *(LAS u32x4*)(bfill + (buf) * 49152) = fr0; *(LAS u32x4*)(bfill + (buf) * 49152 + 1024) = fr1; *(LAS u32x4*)(bfill + (buf) * 49152 + 2048) = fr2; \
            *(LAS u32x4*)(bfill + (buf) * 49152 + 3072) = fr3; *(LAS u32x4*)(bfill + (buf) * 49152 + 4096) = fr4; *(LAS u32x4*)(bfill + (buf) * 49152 + 5120) = fr5; } while (0)
#define RT_BAR() asm volatile("s_waitcnt lgkmcnt(0)\n\ts_barrier" ::: "memory")
#define RT_LOAD(st, s) do { if (!(RV & 2)) { xq[st] = *(const u32x4*)(xbase + xoff + (s) * 64); } \
            ga[st] = *(const f32x4*)(gbase + goff + (s) * 128); gb[st] = *(const f32x4*)(gbase + goff + (s) * 128 + 16); } while (0)
            RT_BLOAD(0); RT_LOAD(0, 0); RT_LOAD(1, 1);
            RT_BWRITE(0); RT_BLOAD(1);
            RT_BAR();
#pragma unroll
            for (int s = 0; s < 32; ++s) {
                const int st = s % 3, c = s >> 3, sl = s & 7;
                if (sl == 0 && c + 1 < 4) { RT_BWRITE((c + 1) & 1); if (c + 2 < 4) { RT_BLOAD(c + 2); } }
                if (s + 2 < 32) { RT_LOAD((s + 2) % 3, s + 2); }
                __builtin_amdgcn_sched_barrier(0);
                const LAS unsigned char* bp = bread + (c & 1) * 49152 + sl * 6144;
                const bf16x8 b0h = *(const LAS bf16x8*)(bp), b0l = *(const LAS bf16x8*)(bp + 1024), b1h = *(const LAS bf16x8*)(bp + 2048), b1l = *(const LAS bf16x8*)(bp + 3072),
                             b2h = *(const LAS bf16x8*)(bp + 4096), b2l = *(const LAS bf16x8*)(bp + 5120);
                const u32x4 xq_ = xq[st];
                const f32x4 xa_ = {__uint_as_float(xq_.x << 16), __uint_as_float(xq_.x & 0xffff0000u), __uint_as_float(xq_.y << 16), __uint_as_float(xq_.y & 0xffff0000u)};
                const f32x4 xb_ = {__uint_as_float(xq_.z << 16), __uint_as_float(xq_.z & 0xffff0000u), __uint_as_float(xq_.w << 16), __uint_as_float(xq_.w & 0xffff0000u)};
                ss += (xa_.x * xa_.x + xa_.y * xa_.y) + (xa_.z * xa_.z + xa_.w * xa_.w) + (xb_.x * xb_.x + xb_.y * xb_.y) + (xb_.z * xb_.z + xb_.w * xb_.w);
                const f32x4 ya = xa_ * ga[st], yb = xb_ * gb[st];
                u32x4 hi; hi.x = cvtpk(ya.x, ya.y); hi.y = cvtpk(ya.z, ya.w); hi.z = cvtpk(yb.x, yb.y); hi.w = cvtpk(yb.z, yb.w);
                u32x4 lo; lo.x = cvtpk(ya.x - __uint_as_float(hi.x << 16), ya.y - __uint_as_float(hi.x & 0xffff0000u)); lo.y = cvtpk(ya.z - __uint_as_float(hi.y << 16), ya.w - __uint_as_float(hi.y & 0xffff0000u));
                lo.z = cvtpk(yb.x - __uint_as_float(hi.z << 16), yb.y - __uint_as_float(hi.z & 0xffff0000u)); lo.w = cvtpk(yb.z - __uint_as_float(hi.w << 16), yb.w - __uint_as_float(hi.w & 0xffff0000u));
                if constexpr (F8OUT) { u32x2 q8; q8.x = pk4_fp8(4.f * ya.x, 4.f * ya.y, 4.f * ya.z, 4.f * ya.w); q8.y = pk4_fp8(4.f * yb.x, 4.f * yb.y, 4.f * yb.z, 4.f * yb.w); *(u32x2*)(obase + ooff + s * 32) = q8; }
                else if (!(RV & 1)) *(u32x4*)(obase + ooff + s * 64) = hi;
                const bf16x8 ah = __builtin_bit_cast(bf16x8, hi), al = __builtin_bit_cast(bf16x8, lo);
                acc0 = __builtin_amdgcn_mfma_f32_16x16x32_bf16(ah, b0h, acc0, 0, 0, 0); acc0 = __builtin_amdgcn_mfma_f32_16x16x32_bf16(ah, b0l, acc0, 0, 0, 0); acc0 = __builtin_amdgcn_mfma_f32_16x16x32_bf16(al, b0h, acc0, 0, 0, 0);
                acc1 = __builtin_amdgcn_mfma_f32_16x16x32_bf16(ah, b1h, acc1, 0, 0, 0); acc1 = __builtin_amdgcn_mfma_f32_16x16x32_bf16(ah, b1l, acc1, 0, 0, 0); acc1 = __builtin_amdgcn_mfma_f32_16x16x32_bf16(al, b1h, acc1, 0, 0, 0);
                acc2 = __builtin_amdgcn_mfma_f32_16x16x32_bf16(ah, b2h, acc2, 0, 0, 0); acc2 = __builtin_amdgcn_mfma_f32_16x16x32_bf16(ah, b2l, acc2, 0, 0, 0); acc2 = __builtin_amdgcn_mfma_f32_16x16x32_bf16(al, b2h, acc2, 0, 0, 0);
                __builtin_amdgcn_sched_barrier(0);
                if (sl == 7 && c + 1 < 4) { RT_BAR(); }
            }
            RT_BAR();
#undef RT_LOAD
#undef RT_BLOAD
#undef RT_BWRITE
#undef RT_BAR
        }
        ss += __shfl_xor(ss, 16); ss += __shfl_xor(ss, 32);
        const float rstd = 1.f / sqrtf(ss * (1.f / D) + 1e-6f);
        if (kg == 0) { rsl[row] = rstd; if (live) rstd_tok[t0 + row] = rstd; }
#pragma unroll
        for (int j = 0; j < 4; ++j) { lgs[(4 * kg + j) * 48 + row] = acc0[j]; lgs[(4 * kg + j) * 48 + 16 + row] = acc1[j]; lgs[(4 * kg + j) * 48 + 32 + row] = acc2[j]; }
        LDS_WAIT(); asm volatile("" ::: "memory");
        int e1 = 0, e2 = 0, lp1 = 0, lp2 = 0; float w1 = 0.f, w2 = 0.f;
        const bool act = live && lane < 16 && !(RV & 4);
        __syncthreads();
        if (act) {
            const float rs = rsl[lane];
            float acc[36];
#pragma unroll
            for (int q = 0; q < 9; ++q) { const f32x4 x = *(const LAS f32x4*)(lgs + lane * 48 + 4 * q); acc[4 * q] = x.x * rs; acc[4 * q + 1] = x.y * rs; acc[4 * q + 2] = x.z * rs; acc[4 * q + 3] = x.w * rs; }
            float lgv[4]; int gs = 0;
#pragma unroll
            for (int c = 0; c < 4; ++c) lgv[c] = acc[c] + bg[c];
            float mx = lgv[0];
#pragma unroll
            for (int c = 1; c < 4; ++c) if (lgv[c] > mx) { mx = lgv[c]; gs = c; }
            float den = 0.f;
#pragma unroll
            for (int c = 0; c < 4; ++c) den += __expf(lgv[c] - mx);
            const float pg = 1.f / den;
            float le[8];
#pragma unroll
            for (int k = 0; k < 8; ++k) { const float a0 = acc[4 + k] + br[k], a1 = acc[12 + k] + br[8 + k], a2 = acc[20 + k] + br[16 + k], a3 = acc[28 + k] + br[24 + k];
                le[k] = gs == 0 ? a0 : (gs == 1 ? a1 : (gs == 2 ? a2 : a3)); }
            int i1 = 0; float m1 = le[0];
#pragma unroll
            for (int k = 1; k < 8; ++k) if (le[k] > m1) { m1 = le[k]; i1 = k; }
            int i2 = -1; float m2 = -INFINITY;
#pragma unroll
            for (int k = 0; k < 8; ++k) if (k != i1 && (i2 < 0 || le[k] > m2)) { m2 = le[k]; i2 = k; }
            const float ex = __expf(m2 - m1); const float tp1 = 1.f / (1.f + ex), tp2 = ex * tp1;
            w1 = pg * tp1; w2 = pg * tp2; e1 = gs * 8 + i1; e2 = gs * 8 + i2;
            lp1 = (int)__hip_atomic_fetch_add(lcnt + e1, 1u, __ATOMIC_RELAXED, __HIP_MEMORY_SCOPE_WORKGROUP);
            lp2 = (int)__hip_atomic_fetch_add(lcnt + e2, 1u, __ATOMIC_RELAXED, __HIP_MEMORY_SCOPE_WORKGROUP);
        }
        __syncthreads();
        if (tid < 32) { const unsigned c = lcnt[tid]; lbase[tid] = c ? __hip_atomic_fetch_add(cnt + 32 * tid, c, __ATOMIC_RELAXED, __HIP_MEMORY_SCOPE_AGENT) : 0u; }
        __syncthreads();
        if (act) {
            const int t = t0 + lane; const int p1 = (int)lbase[e1] + lp1, p2 = (int)lbase[e2] + lp2;
            ltok[(size_t)e1 * M + p1] = t; lw[(size_t)e1 * M + p1] = w1; ltok[(size_t)e2 * M + p2] = t; lw[(size_t)e2 * M + p2] = w2;
            tinfo[t] = (i32x4){e1, p1, e2, p2};
        }
        LDS_WAIT(); asm volatile("" ::: "memory");
        __syncthreads();
    }
}

__device__ __forceinline__ void moe_tables(LAS unsigned char* lds, unsigned char* ws, int layer, const int wave, const int lane) {
    LAS int* TP = (LAS int*)(lds + TP_OFF); LAS int* CNT = TP + 40;
    unsigned* cnt = (unsigned*)(ws + WS_CTL) + CW_CNT + layer * 1024;
    const int tid = wave * 64 + lane;
    __syncthreads();
    if (tid < 32) CNT[tid] = (int)__hip_atomic_load(cnt + 32 * tid, RLX_AGENT);
    __syncthreads();
    if (tid == 0) { int s = 0; for (int e = 0; e < 32; ++e) { TP[e] = s; s += (CNT[e] + 255) >> 8; } TP[32] = s; }
    __syncthreads();
}

__device__ __forceinline__ void phase_combine(LAS unsigned char* lds_in, int layer, const int wave_in, const bool dry) {
    int lane = lane_id(); asm volatile("" : "+v"(lane)); int wave = wave_in; asm volatile("" : "+s"(wave)); LAS unsigned char* lds = lds_in; asm volatile("" : "+s"(lds));
    const CArgs a = kargs(); unsigned char* ws = a->ws;
    moe_tables(lds, ws, layer, wave, lane);
    const bool final_ = layer == 1; const float* gnext = layer == 0 ? a->in[I_NMIX] + D : a->in[I_FNORM]; float* xout = a->out; bf16_t* xr16 = (bf16_t*)(ws + WS_XR);
    const int G = gridDim.x, vcu = vcu_of(G);
    const int gw = vcu * NWAVES + wave, NGW = G * NWAVES;
    const LAS int* TP = (const LAS int*)(lds + TP_OFF);
    const bf16_t* Y = (const bf16_t*)(ws + WS_Y); const i32x4* tinfo = (const i32x4*)(ws + WS_TINFO); bf16_t* XN = (bf16_t*)XNB(a);
#pragma unroll 1
    for (int tb = gw * 4; tb < M; tb += NGW * 4) {
        size_t s1[4], s2[4];
#pragma unroll
        for (int r = 0; r < 4; ++r) { const i32x4 ti = tinfo[tb + r]; s1[r] = (size_t)TP[ti.x] * 256 + ti.y; s2[r] = (size_t)TP[ti.z] * 256 + ti.w; }
        f32x4 v[4][4]; u32x2 p[4][4], q[4][4], xv[4][4];
#pragma unroll
        for (int r = 0; r < 4; ++r) {
            const GAS u32x2* xr = (const GAS u32x2*)(xr16 + (size_t)(tb + r) * D) + lane;
            const GAS u32x2* y1 = (const GAS u32x2*)(Y + s1[r] * D) + lane; const GAS u32x2* y2 = (const GAS u32x2*)(Y + s2[r] * D) + lane;
#pragma unroll
            for (int j = 0; j < 4; ++j) { xv[r][j] = xr[64 * j]; p[r][j] = y1[64 * j]; q[r][j] = y2[64 * j]; }
        }
        f32x4 gg[4];
#pragma unroll
        for (int j = 0; j < 4; ++j) gg[j] = ((const GAS f32x4*)gnext + lane)[64 * j];
#pragma unroll
        for (int r = 0; r < 4; ++r) {
            float s = 0.f;
#pragma unroll
            for (int j = 0; j < 4; ++j) { const u32x2 pp = p[r][j], qq = q[r][j], xx = xv[r][j];
                v[r][j] = (f32x4){__uint_as_float(xx.x << 16), __uint_as_float(xx.x & 0xffff0000u), __uint_as_float(xx.y << 16), __uint_as_float(xx.y & 0xffff0000u)};
                f32x4 ya, yb; ya.x = __uint_as_float(pp.x << 16); ya.y = __uint_as_float(pp.x & 0xffff0000u); ya.z = __uint_as_float(pp.y << 16); ya.w = __uint_as_float(pp.y & 0xffff0000u);
                yb.x = __uint_as_float(qq.x << 16); yb.y = __uint_as_float(qq.x & 0xffff0000u); yb.z = __uint_as_float(qq.y << 16); yb.w = __uint_as_float(qq.y & 0xffff0000u);
                v[r][j] = v[r][j] + (ya + yb); s += (v[r][j].x * v[r][j].x + v[r][j].y * v[r][j].y) + (v[r][j].z * v[r][j].z + v[r][j].w * v[r][j].w); }
            const float rstd = 1.f / sqrtf(wave_sum(s) * (1.f / D) + 1e-6f);
            GAS f32x4* xw = (GAS f32x4*)(xout + (size_t)(tb + r) * D) + lane; GAS u32x2* xw16 = (GAS u32x2*)(xr16 + (size_t)(tb + r) * D) + lane;
            if (final_) {
#pragma unroll
                for (int j = 0; j < 4; ++j) if (!dry) xw[64 * j] = v[r][j] * rstd * gg[j];
            } else {
                if (F8_QKV & 2) { GAS unsigned* o4 = (GAS unsigned*)((unsigned char*)XN + (size_t)(tb + r) * D) + lane;
#pragma unroll
                    for (int j = 0; j < 4; ++j) { if (!dry) { u32x2 w; w.x = pk2(v[r][j].x, v[r][j].y); w.y = pk2(v[r][j].z, v[r][j].w); xw16[64 * j] = w; } const f32x4 n = v[r][j] * (4.f * rstd) * gg[j]; o4[64 * j] = pk4_fp8(n.x, n.y, n.z, n.w); } }
                else { GAS u32x2* o8 = (GAS u32x2*)(XN + (size_t)(tb + r) * D) + lane;
#pragma unroll
                    for (int j = 0; j < 4; ++j) { if (!dry) { u32x2 w; w.x = pk2(v[r][j].x, v[r][j].y); w.y = pk2(v[r][j].z, v[r][j].w); xw16[64 * j] = w; } const f32x4 n = v[r][j] * rstd * gg[j]; u32x2 w; w.x = pk2(n.x, n.y); w.y = pk2(n.z, n.w); o8[64 * j] = w; } }
            }
        }
    }
}

__device__ __forceinline__ float diff_lambda_full(const float* lam, int lane) {
    const float a = wave_sum(lam[lane] * lam[64 + lane]), b = wave_sum(lam[128 + lane] * lam[192 + lane]);
    return __expf(a) - __expf(b) + LAMBDA_INIT;
}

__device__ __forceinline__ void phase_qkv(LAS unsigned char* lds_in, int layer, const int wave_in) {
    int lane = lane_id(); asm volatile("" : "+v"(lane)); int wave = wave_in; asm volatile("" : "+s"(wave)); LAS unsigned char* lds = lds_in; asm volatile("" : "+s"(lds));
    const CArgs a = kargs(); unsigned char* ws = a->ws;
    const int N = layer == 0 ? SWA_N : DIFF_N;
    pg8::DenseOrder S; S.init(M, N, (int)gridDim.x, (int)blockIdx.x);
    pg8::EpiQKV E{(bf16_t*)(ws + WS_QKV), N, 1024, QSCALE, layer == 1 ? (unsigned*)(ws + WS_CTL) + CW_KMAX : nullptr};
    if ((F8_QKV >> layer) & 1) { pg8::Gemm g{(const bf16_t*)XNB(a), (const bf16_t*)(ws + (layer == 0 ? WS_SWA_QKV_T : WS_DIFF_QKV_T)), D / 2, 0x79797979u, 0x7d7d7d7du};
        pg8::gemm_phase<pg8::EpiQKV, pg8::DenseOrder, false, true, true>(lds, g, S, E, wave, lane); }
    else { pg8::Gemm g{(const bf16_t*)XNB(a), (const bf16_t*)(ws + (layer == 0 ? WS_SWA_QKV_T : WS_DIFF_QKV_T)), D};
        pg8::gemm_phase<pg8::EpiQKV, pg8::DenseOrder, false, true>(lds, g, S, E, wave, lane); }
}
__device__ __forceinline__ void phase_oproj(LAS unsigned char* lds_in, int layer, const int wave_in) {
    int lane = lane_id(); asm volatile("" : "+v"(lane)); int wave = wave_in; asm volatile("" : "+s"(wave)); LAS unsigned char* lds = lds_in; asm volatile("" : "+s"(lds));
    const CArgs a = kargs(); unsigned char* ws = a->ws;
    pg8::Gemm g{(const bf16_t*)(ws + WS_O), (const bf16_t*)(ws + (layer == 0 ? WS_SWA_WO_T : WS_DIFF_WO_T)), D};
    pg8::DenseOrder S; S.init(M, D, (int)gridDim.x, (int)blockIdx.x);
    pg8::EpiResid E{layer == 0 ? a->in[I_X] : nullptr, (const bf16_t*)(ws + WS_XR), (bf16_t*)(ws + WS_XR)};
    pg8::gemm_phase<pg8::EpiResid, pg8::DenseOrder, false, true>(lds, g, S, E, wave, lane);
}
__device__ __forceinline__ void phase_moe1(LAS unsigned char* lds_in, int layer, const int wave_in) {
    int lane = lane_id(); asm volatile("" : "+v"(lane)); int wave = wave_in; asm volatile("" : "+s"(wave)); LAS unsigned char* lds = lds_in; asm volatile("" : "+s"(lds));
    const CArgs a = kargs(); unsigned char* ws = a->ws;
    moe_tables(lds, ws, layer, wave, lane);
    const LAS int* TP = (const LAS int*)(lds + TP_OFF); const LAS int* CNT = TP + 40;
    if ((F8_STAGE & 2) && (layer == 1 || F8_L0)) {
        pg8::Gemm g{(const bf16_t*)XNB(a), (const bf16_t*)(ws + WS_WMOE + (size_t)layer * 96 * MiB), D / 2, 0x79797979u, 0x7d7d7d7du};
        pg8::MoeOrder S{TP, CNT, (const int*)(ws + WS_LTOK), (int)gridDim.x, (int)blockIdx.x, 12, 0};
        if (F8_STAGE & 1) { pg8::EpiSwiGLU<true> E{(bf16_t*)(ws + WS_H), (const int*)(ws + WS_LTOK), (const float*)(ws + WS_RSTD), CNT};
            pg8::gemm_phase<pg8::EpiSwiGLU<true>, pg8::MoeOrder, true, true, true>(lds, g, S, E, wave, relaunder(lane)); }
        else { pg8::EpiSwiGLU<false> E{(bf16_t*)(ws + WS_H), (const int*)(ws + WS_LTOK), (const float*)(ws + WS_RSTD), CNT};
            pg8::gemm_phase<pg8::EpiSwiGLU<false>, pg8::MoeOrder, true, true, true>(lds, g, S, E, wave, relaunder(lane)); }
    } else if ((F8_STAGE & 1) && layer == 1) {
        pg8::Gemm g{(const bf16_t*)XNB(a), (const bf16_t*)(ws + WS_WMOE + (size_t)layer * 96 * MiB), D};
        pg8::MoeOrder S{TP, CNT, (const int*)(ws + WS_LTOK), (int)gridDim.x, (int)blockIdx.x, 6, 0};
        pg8::EpiSwiGLU<true> E{(bf16_t*)(ws + WS_H), (const int*)(ws + WS_LTOK), (const float*)(ws + WS_RSTD), CNT};
        pg8::gemm_phase<pg8::EpiSwiGLU<true>, pg8::MoeOrder, true, true>(lds, g, S, E, wave, relaunder(lane));
    } else {
        pg8::Gemm g{(const bf16_t*)XNB(a), (const bf16_t*)(ws + WS_WMOE + (size_t)layer * 96 * MiB), D};
        pg8::MoeOrder S{TP, CNT, (const int*)(ws + WS_LTOK), (int)gridDim.x, (int)blockIdx.x, 6, 0};
        pg8::EpiSwiGLU<false> E{(bf16_t*)(ws + WS_H), (const int*)(ws + WS_LTOK), (const float*)(ws + WS_RSTD), CNT};
        pg8::gemm_phase<pg8::EpiSwiGLU<false>, pg8::MoeOrder, true, true>(lds, g, S, E, wave, relaunder(lane));
    }
}
__device__ __forceinline__ void phase_moe2(LAS unsigned char* lds_in, int layer, const int wave_in) {
    int lane = lane_id(); asm volatile("" : "+v"(lane)); int wave = wave_in; asm volatile("" : "+s"(wave)); LAS unsigned char* lds = lds_in; asm volatile("" : "+s"(lds));
    const CArgs a = kargs(); unsigned char* ws = a->ws;
    moe_tables(lds, ws, layer, wave, lane);
    const LAS int* TP = (const LAS int*)(lds + TP_OFF); const LAS int* CNT = TP + 40;
    pg8::EpiDown E{(bf16_t*)(ws + WS_Y), (const float*)(ws + WS_LW)};
    if ((F8_STAGE & 1) && layer == 1) {
        pg8::Gemm g{(const bf16_t*)(ws + WS_H), (const bf16_t*)(ws + WS_WMOE + (size_t)layer * 96 * MiB), DEXP / 2, 0x79797979u, 0x7c7c7c7cu};
        pg8::MoeOrder S{TP, CNT, (const int*)(ws + WS_LTOK), (int)gridDim.x, (int)blockIdx.x, 24, 16};
        pg8::gemm_phase<pg8::EpiDown, pg8::MoeOrder, false, true, true>(lds, g, S, E, wave, relaunder(lane));
    } else {
        pg8::Gemm g{(const bf16_t*)(ws + WS_H), (const bf16_t*)(ws + WS_WMOE + (size_t)layer * 96 * MiB), DEXP};
        pg8::MoeOrder S{TP, CNT, (const int*)(ws + WS_LTOK), (int)gridDim.x, (int)blockIdx.x, 12, 8};
        pg8::gemm_phase<pg8::EpiDown, pg8::MoeOrder, false, true>(lds, g, S, E, wave, relaunder(lane));
    }
}
__device__ __forceinline__ void phase_attn(LAS unsigned char* lds_in, int layer, const int wave_in, const bool dry) {
    int lane = lane_id(); asm volatile("" : "+v"(lane)); int wave = wave_in; asm volatile("" : "+s"(wave)); LAS unsigned char* lds = lds_in; asm volatile("" : "+s"(lds));
    const CArgs a = kargs(); unsigned char* ws = a->ws;
    const int G = gridDim.x, vcu = vcu_of(G);
    const bf16_t* QKV = (const bf16_t*)(ws + WS_QKV); bf16_t* OB = (bf16_t*)(ws + WS_O);
    if (layer == 0) {
        att::DiffConsts dc{0.f, nullptr, 0.f, 0.f, 0.f, 0.f}; const float* sink = a->in[I_SWA_SINK];
#pragma unroll 1
        for (int i = 0; i < 2048; ++i) { const int id = vcu + G * i; if (id >= 2048) break; const int bk = id >> 7, qb = id & 127;
            att::attn_unit<0>(bk >> 2, bk & 3, qb, QKV, OB, sink, dc, lds, wave, lane); }
    } else {
        const float* sg = a->in[I_DIFF_SUBLN] + (lane & 31); const float sgs = 1.f - LAMBDA_INIT;
        att::DiffConsts dc{diff_lambda_full(a->in[I_DIFF_LAM], lane), a->in[I_DIFF_SUBLN], sg[0] * sgs, sg[32] * sgs, sg[64] * sgs, sg[96] * sgs};
        const unsigned* kmaxsq = (const unsigned*)(ws + WS_CTL) + CW_KMAX;
#pragma unroll 1
        for (int i = 0; i < 2048; ++i) { const int id = vcu + G * i; if (id >= 2048) break; const int h = id >> 8, bq = id & 255, b = bq >> 6;
            const int qb = ((0xD8 >> h) & 1) ? ((bq + 32) & 63) : (bq & 63);
            const int cm = wave >> 2, gi = b * 32 + 2 * (2 * h + cm);
            const float kmax = sqrtf(__uint_as_float(__hip_atomic_load(kmaxsq + gi, RLX_AGENT)) + __uint_as_float(__hip_atomic_load(kmaxsq + gi + 1, RLX_AGENT))) * 1.01f;
            if (ATT_PROBE_VARIANT != 0 && dry) att::diff_unit<ATT_PROBE_VARIANT>(b, h, qb, QKV, (bf16_t*)XNB(a), kmax, dc, lds, wave, lane);
            else att::diff_unit<0>(b, h, qb, QKV, OB, kmax, dc, lds, wave, lane); }
    }
}

__global__ void __launch_bounds__(NWAVES * 64, 2) mega_fwd(Args args_by_value) {
    extern __shared__ __attribute__((aligned(16))) unsigned char lds_raw[];
    LAS unsigned char* lds = (LAS unsigned char*)lds_raw;
    const int wave = __builtin_amdgcn_readfirstlane((int)(threadIdx.x >> 6));
    int lo, hi;
    { const CArgs a = kargs(); lo = a->ph_lo; hi = a->ph_hi;
      if (a->use_cg) cg::this_grid().sync(); }
    { const int tid = wave * 64 + lane_id();
      for (int u = tid; u < (LDS_BYTES - LDSCTL_OFF) / 4; u += NWAVES * 64) ((LAS unsigned*)(lds + LDSCTL_OFF))[u] = 0u; }
    __syncthreads();
    if (N_LAUNCHES == 1) { const CArgs a = kargs(); (void)xcd_barrier_post((unsigned*)(a->ws + WS_CTL) + CW_BAR, (volatile LAS unsigned*)(lds + MISC_OFF) + 8, wave == 0 && lane_id() == 0); }
    int rep_left = REP_COUNT;
    unsigned long long tp_prev = 0, tp_acc = 0;
    if (TPROBE_MASK != 0) tp_prev = __builtin_amdgcn_s_memrealtime();
#pragma unroll 1
    for (int ph = lo; ph < hi; ++ph) {
        const int layer = ph >= 8 ? 1 : 0, kind = ph == 0 ? 0 : ph - 7 * layer;
        const bool dry = REP_COUNT > 0 && ph == REP_PHASE && rep_left > 0;
        switch (kind) {
            case 0: phase_prologue(lds, wave); break;
            case 1: phase_qkv(lds, layer, wave); break;
            case 2: phase_attn(lds, layer, wave, dry); break;
            case 3: phase_oproj(lds, layer, wave); break;
            case 4: if (ROUTER_PROBE != 0 && dry) phase_router<ROUTER_PROBE, false>(lds, layer, wave, dry); else if ((F8_STAGE & 2) && (layer == 1 || F8_L0)) phase_router<0, true>(lds, layer, wave, dry); else phase_router<0, false>(lds, layer, wave, dry); break;
            case 5: phase_moe1(lds, layer, wave); break;
            case 6: phase_moe2(lds, layer, wave); break;
            default: phase_combine(lds, layer, wave, dry); break;
        }
        if (ph + 1 < hi) { const CArgs a = kargs(); XcdBarrier bar; bar.bar = (unsigned*)(a->ws + WS_CTL) + CW_BAR; bar.x = xb_xcc_id(); bar.st = (volatile LAS unsigned*)(lds + MISC_OFF) + 8;
            xcd_barrier(bar, wave == 0 && lane_id() == 0);
        }
        if (TPROBE_MASK != 0) { const unsigned long long tn = __builtin_amdgcn_s_memrealtime(); if ((TPROBE_MASK >> ph) & 1) tp_acc += tn - tp_prev; tp_prev = tn; }
        if (REP_COUNT > 0 && ph == REP_PHASE && rep_left > 0) { --rep_left; --ph; }
        if (EXTRA_BARRIERS > 0 && ph == 3) { for (int xb = 0; xb < EXTRA_BARRIERS; ++xb) { const CArgs a = kargs(); XcdBarrier bar; bar.bar = (unsigned*)(a->ws + WS_CTL) + CW_BAR; bar.x = xb_xcc_id(); bar.st = (volatile LAS unsigned*)(lds + MISC_OFF) + 8; xcd_barrier(bar, wave == 0 && lane_id() == 0); } }
    }
    if (TPROBE_MASK != 0 && blockIdx.x == 0 && wave == 0) { const unsigned long long t0 = __builtin_amdgcn_s_memrealtime(); while (__builtin_amdgcn_s_memrealtime() - t0 < TPROBE_K * tp_acc) __builtin_amdgcn_s_sleep(8); }
}

extern "C" void kernel_launch(void* const* d_in, const int* in_sizes, int n_in, void* d_out, int out_size, void* d_ws, size_t ws_size, hipStream_t stream) {
    static int grid = 0;
    if (grid == 0) {
        if (n_in != 18 || in_sizes[0] != M * D || out_size != M * D || ws_size < WS_END) {
            fprintf(stderr, "kernel_launch: unexpected shapes: n_in %d in0 %d out %d ws %zu (need %zu)\n", n_in, n_in > 0 ? in_sizes[0] : -1, out_size, ws_size, (size_t)WS_END); grid = -1; return; }
        int dev = 0, cus = 0, per_cu = 0;
        if (hipGetDevice(&dev) != hipSuccess || hipDeviceGetAttribute(&cus, hipDeviceAttributeMultiprocessorCount, dev) != hipSuccess) { fprintf(stderr, "kernel_launch: device query failed\n"); grid = -1; return; }
        if (hipFuncSetAttribute((const void*)mega_fwd, hipFuncAttributeMaxDynamicSharedMemorySize, LDS_BYTES) != hipSuccess) { fprintf(stderr, "kernel_launch: hipFuncSetAttribute failed\n"); grid = -1; return; }
        if (hipOccupancyMaxActiveBlocksPerMultiprocessor(&per_cu, (const void*)mega_fwd, NWAVES * 64, LDS_BYTES) != hipSuccess || per_cu < 1) { fprintf(stderr, "kernel_launch: occupancy query says %d\n", per_cu); per_cu = 1; }
        (void)hipGetLastError();
        grid = cus;
    }
    if (grid < 0) return;
    (void)hipMemsetAsync((char*)d_ws + WS_CTL, 0, CTL_ZERO_BYTES, stream);
    Args a{};
    for (int i = 0; i < 18; ++i) a.in[i] = (const float*)d_in[i];
    a.out = (float*)d_out; a.ws = (unsigned char*)d_ws; a.use_cg = 0; a.pad = 0;
    if (N_LAUNCHES == 1) {
        a.ph_lo = 0; a.ph_hi = N_PHASES;
        void* kargs_[] = {&a};
        hipError_t e = hipLaunchCooperativeKernel((const void*)mega_fwd, dim3(grid), dim3(NWAVES * 64), kargs_, LDS_BYTES, stream);
        if (e != hipSuccess) fprintf(stderr, "kernel_launch: cooperative launch failed: %s (grid %d)\n", hipGetErrorString(e), grid);
    } else {
        for (int p = 0; p < N_PHASES; ++p) { a.ph_lo = p; a.ph_hi = p + 1; hipLaunchKernelGGL(mega_fwd, dim3(grid), dim3(NWAVES * 64), LDS_BYTES, stream, a); }
    }
}
```

```cpp
#include <hip/hip_runtime.h>
#include <hip/hip_cooperative_groups.h>
#include <cstdio>
#include <cstdint>
namespace cg = cooperative_groups;

#ifndef MK_N_LAUNCHES
#define MK_N_LAUNCHES 1
#endif
constexpr int N_PHASES = 15;
#define F8_STAGE 2
#define F8_L0 1
#define F8_QKV 2
#define REP_PHASE -1
#define REP_COUNT 0
#define ATT_PROBE_VARIANT 0
#define EXTRA_BARRIERS 0
#define ROUTER_PROBE 0
#define TPROBE_MASK 0
#define TPROBE_K 4
constexpr int N_LAUNCHES = MK_N_LAUNCHES;

#define LAS __attribute__((address_space(3)))
#define GAS __attribute__((address_space(1)))
typedef unsigned short bf16_t;
typedef short bf16x8 __attribute__((ext_vector_type(8)));
typedef short s16x4 __attribute__((ext_vector_type(4)));
typedef float f32x2 __attribute__((ext_vector_type(2)));
typedef float f32x4 __attribute__((ext_vector_type(4)));
typedef float f32x16 __attribute__((ext_vector_type(16)));
typedef unsigned u32x2 __attribute__((ext_vector_type(2)));
typedef unsigned u32x4 __attribute__((ext_vector_type(4)));
typedef int i32x4 __attribute__((ext_vector_type(4)));
typedef int i32x8 __attribute__((ext_vector_type(8)));
typedef __bf16 bf16x2_t __attribute__((ext_vector_type(2)));

constexpr int D = 1024, BATCH = 4, SEQ = 8192, M = BATCH * SEQ;
constexpr int SWA_N = 1536, DIFF_N = 3072;
constexpr int NEXP = 32, DEXP = 512;
constexpr float LOG2E = 1.4426950408889634f;
constexpr float QSCALE = 0.125f * LOG2E;
constexpr float LAMBDA_INIT = 0.35550906759f;
constexpr int NWAVES = 8;

constexpr size_t MiB = 1u << 20;
constexpr size_t WS_CTL = 0, CTL_ZERO_BYTES = 1 * MiB;
constexpr size_t WS_SWA_QKV_T = 1 * MiB, WS_SWA_WO_T = 4 * MiB, WS_DIFF_QKV_T = 6 * MiB, WS_DIFF_WO_T = 12 * MiB;
constexpr size_t WS_WR = 14 * MiB;
constexpr size_t WS_RSTD = 14 * MiB + 512 * 1024;
constexpr size_t WS_LTOK = 15 * MiB, WS_LW = 19 * MiB, WS_TINFO = 23 * MiB;
constexpr size_t WS_WMOE = 24 * MiB;
constexpr size_t WS_XR = 216 * MiB;
#define XNB(a) ((unsigned char*)(a)->out)
constexpr size_t WS_SCR = 280 * MiB;
constexpr size_t WS_QKV = WS_SCR, WS_O = WS_SCR + 192 * MiB, WS_Y = WS_SCR, WS_H = WS_SCR + 144 * MiB;
constexpr size_t WS_END = 536 * MiB;
constexpr int CW_BAR = 4096;
constexpr int CW_CNT = 16384;
constexpr int CW_KMAX = 24576;

constexpr int RING_BYTES = 131072;
constexpr int LDSCTL_OFF = RING_BYTES;
constexpr int MISC_OFF = LDSCTL_OFF + 320;
constexpr int TP_OFF = LDSCTL_OFF + 1024;
constexpr int STASH_OFF = LDSCTL_OFF + 2048;
constexpr int LDS_BYTES = 147456;

__device__ __forceinline__ unsigned f2bf(float f) { unsigned u = __builtin_bit_cast(unsigned, f); return (u + 0x7fffu + ((u >> 16) & 1u)) >> 16; }
__device__ __forceinline__ unsigned pk2(float lo, float hi) { return f2bf(lo) | (f2bf(hi) << 16); }
__device__ __forceinline__ unsigned cvtpk(float lo, float hi) { f32x2 v = {lo, hi}; bf16x2_t b = __builtin_convertvector(v, bf16x2_t); return __builtin_bit_cast(unsigned, b); }
__device__ __forceinline__ unsigned pk4_fp8(float a, float b, float c, float d) {
    a = __builtin_fminf(__builtin_fmaxf(a, -448.f), 448.f); b = __builtin_fminf(__builtin_fmaxf(b, -448.f), 448.f); c = __builtin_fminf(__builtin_fmaxf(c, -448.f), 448.f); d = __builtin_fminf(__builtin_fmaxf(d, -448.f), 448.f);
    int r = 0; r = __builtin_amdgcn_cvt_pk_fp8_f32(a, b, r, false); r = __builtin_amdgcn_cvt_pk_fp8_f32(c, d, r, true); return (unsigned)r; }
__device__ __forceinline__ float bf2f(unsigned short h) { return __builtin_bit_cast(float, (unsigned)h << 16); }
__device__ __forceinline__ int relaunder(int x) { asm volatile("" : "+v"(x)); return x; }
__device__ __forceinline__ int lane_id() { return (int)__builtin_amdgcn_mbcnt_hi(~0u, __builtin_amdgcn_mbcnt_lo(~0u, 0u)); }
__device__ __forceinline__ float wave_sum(float v) {
#pragma unroll
    for (int o = 1; o < 64; o <<= 1) v += __shfl_xor(v, o);
    return v;
}

namespace pg8 {
constexpr int BM = 256, BK = 64, HALF = 128, HTB = HALF * BK * 2, STAGE_BYTES = 8 * HTB, NXCD = 8, WGM = 8;
__host__ __device__ __forceinline__ int lds_byte(int r, int c) { const int st = (r >> 4) * 2 + (c >> 5), rr = r & 15, cc = c & 31, ob = rr * 64 + cc * 2; return st * 1024 + (ob ^ (((ob >> 9) & 1) << 5)); }
__host__ __device__ __forceinline__ void stage_rc(int b, int& R, int& C) { const int st = b / 1024, sb = b % 1024, swz = sb ^ (((sb >> 9) & 1) << 5); R = (st >> 1) * 16 + swz / 64; C = (st & 1) * 32 + (swz % 64) / 2; }
__host__ __device__ __forceinline__ int perm32(int rho) { const int n = rho >> 4, i = rho & 15; return 8 * (i >> 2) + 4 * n + (i & 3); }

struct Unit { int pm, pn, e, t, pnl; };
struct Gemm { const bf16_t* A; const bf16_t* Bt; int K; unsigned sw = 0x7f7f7f7fu, sx = 0x7f7f7f7fu; };

struct DenseOrder {
    int nM, nN, nwg, G, c;
    __device__ void init(int Mr, int N, int G_, int c_) { nM = Mr / BM; nN = N / BM; nwg = nM * nN; G = G_; c = c_; }
    __device__ bool next(int i, Unit& u) const {
        const long L = (long)i * G + c; if (L >= nwg) return false;
        int wgid = (int)L; { const int q = nwg / NXCD, r = nwg % NXCD, xcd = wgid % NXCD, off = wgid / NXCD; wgid = (xcd < r ? xcd * (q + 1) : r * (q + 1) + (xcd - r) * q) + off; }
        const int nig = WGM * nN, gid = wgid / nig, fm = gid * WGM, gsz = (nM - fm) < WGM ? (nM - fm) : WGM;
        u.pm = fm + ((wgid % nig) % gsz); u.pn = (wgid % nig) / gsz; u.e = 0; u.t = 0; u.pnl = u.pn; return true;
    }
    __device__ __forceinline__ int token(const Unit&, int) const { return 0; }
};
struct MoeOrder {
    const LAS int* TP; const LAS int* CNT; const int* ltok; int G, c, pn_mul, pn_add;
    __device__ bool next(int i, Unit& u) const {
        const int ntile = __builtin_amdgcn_readfirstlane(TP[32]); const int nwg = ntile * 4;
        const long L = (long)i * G + c; if (L >= nwg) return false;
        int wgid = (int)L; { const int q = nwg / NXCD, r = nwg % NXCD, xcd = wgid % NXCD, off = wgid / NXCD; wgid = (xcd < r ? xcd * (q + 1) : r * (q + 1) + (xcd - r) * q) + off; }
        const int tau = wgid >> 2; int e = 0;
#pragma unroll
        for (int st = 16; st >= 1; st >>= 1) if (__builtin_amdgcn_readfirstlane(TP[e + st]) <= tau) e += st;
        u.pm = tau; u.e = e; u.t = tau - __builtin_amdgcn_readfirstlane(TP[e]); u.pnl = wgid & 3; u.pn = e * pn_mul + pn_add + u.pnl; return true;
    }
    __device__ __forceinline__ int token(const Unit& u, int r) const { const int idx = u.t * 256 + r; return ltok[(size_t)u.e * M + (idx < CNT[u.e] ? idx : 0)]; }
};

struct EpiQKV {
    static constexpr bool PERM = true;
    bf16_t* O; int ldc; int qcols; float qscale; unsigned* kmaxsq;
    __device__ __forceinline__ void operator()(const f32x4 (&acc)[2][2][4][2], const Unit& u, int wr, int wc, int fr, int fq) const {
        asm volatile("" : "+v"(fr), "+v"(fq));
        const int row0 = u.pm * BM + wr * 64 + fr, colt = u.pn * BM; const float sc = colt < qcols ? qscale : 1.f;
        const int col0 = colt + wc * 32 + 8 * fq;
#pragma unroll
        for (int ai = 0; ai < 2; ++ai)
#pragma unroll
            for (int m = 0; m < 4; ++m) { bf16_t* rowp = O + (size_t)(row0 + ai * HALF + m * 16) * ldc + col0;
#pragma unroll
                for (int bj = 0; bj < 2; ++bj) { const f32x4 v0 = acc[ai][bj][m][0] * sc, v1 = acc[ai][bj][m][1] * sc;
                    u32x4 w; w.x = cvtpk(v0[0], v0[1]); w.y = cvtpk(v0[2], v0[3]); w.z = cvtpk(v1[0], v1[1]); w.w = cvtpk(v1[2], v1[3]);
                    *(u32x4*)(rowp + bj * HALF) = w; } }
        if (kmaxsq != nullptr && colt >= 1024 && colt < 2048) {
#pragma unroll
            for (int bj = 0; bj < 2; ++bj) { float mx = 0.f;
#pragma unroll
                for (int ai = 0; ai < 2; ++ai)
#pragma unroll
                    for (int m = 0; m < 4; ++m) { const f32x4 v0 = acc[ai][bj][m][0], v1 = acc[ai][bj][m][1];
                        float ss = (v0[0] * v0[0] + v0[1] * v0[1]) + (v0[2] * v0[2] + v0[3] * v0[3]) + (v1[0] * v1[0] + v1[1] * v1[1]) + (v1[2] * v1[2] + v1[3] * v1[3]);
                        ss += __shfl_xor(ss, 16); ss += __shfl_xor(ss, 32); mx = __builtin_fmaxf(mx, ss); }
                mx = __builtin_fmaxf(mx, __shfl_xor(mx, 1)); mx = __builtin_fmaxf(mx, __shfl_xor(mx, 2)); mx = __builtin_fmaxf(mx, __shfl_xor(mx, 4)); mx = __builtin_fmaxf(mx, __shfl_xor(mx, 8));
                if (fr == 0 && fq == 0) atomicMax(kmaxsq + (u.pm >> 5) * 32 + ((colt - 1024 + bj * HALF + wc * 32) >> 5), __float_as_uint(mx)); }
        }
    }
};
struct EpiResid {
    static constexpr bool PERM = false;
    const float* base32; const bf16_t* base16; bf16_t* out;
    __device__ __forceinline__ void operator()(const f32x4 (&acc)[2][2][4][2], const Unit& u, int wr, int wc, int fr, int fq) const {
        asm volatile("" : "+v"(fr), "+v"(fq));
        const int col0 = u.pn * BM + wc * 32 + 4 * fq;
#pragma unroll
        for (int ai = 0; ai < 2; ++ai) {
            f32x4 b[4][2][2];
            if (base32) {
#pragma unroll
                for (int m = 0; m < 4; ++m) { const size_t off = (size_t)(u.pm * BM + ai * HALF + wr * 64 + m * 16 + fr) * D + col0;
#pragma unroll
                    for (int bj = 0; bj < 2; ++bj)
#pragma unroll
                        for (int n = 0; n < 2; ++n) b[m][bj][n] = *(const f32x4*)(base32 + off + bj * HALF + n * 16); }
            } else {
                u32x2 q[4][2][2];
#pragma unroll
                for (int m = 0; m < 4; ++m) { const size_t off = (size_t)(u.pm * BM + ai * HALF + wr * 64 + m * 16 + fr) * D + col0;
#pragma unroll
                    for (int bj = 0; bj < 2; ++bj)
#pragma unroll
                        for (int n = 0; n < 2; ++n) q[m][bj][n] = *(const u32x2*)(base16 + off + bj * HALF + n * 16); }
#pragma unroll
                for (int m = 0; m < 4; ++m)
#pragma unroll
                    for (int bj = 0; bj < 2; ++bj)
#pragma unroll
                        for (int n = 0; n < 2; ++n) { const u32x2 w = q[m][bj][n];
                            b[m][bj][n] = (f32x4){__uint_as_float(w.x << 16), __uint_as_float(w.x & 0xffff0000u), __uint_as_float(w.y << 16), __uint_as_float(w.y & 0xffff0000u)}; }
            }
            asm volatile("" ::: "memory");
#pragma unroll
            for (int m = 0; m < 4; ++m) { const size_t off = (size_t)(u.pm * BM + ai * HALF + wr * 64 + m * 16 + fr) * D + col0;
#pragma unroll
                for (int bj = 0; bj < 2; ++bj)
#pragma unroll
                    for (int n = 0; n < 2; ++n) { const f32x4 s = b[m][bj][n] + acc[ai][bj][m][n]; u32x2 w; w.x = pk2(s.x, s.y); w.y = pk2(s.z, s.w); *(u32x2*)(out + off + bj * HALF + n * 16) = w; } }
            asm volatile("" ::: "memory");
        }
    }
};
__device__ __forceinline__ float silu_mul(float g, float u) { return g * u * __builtin_amdgcn_rcpf(1.f + __builtin_amdgcn_exp2f(-g * LOG2E)); }
template <bool F8>
struct EpiSwiGLU {
    static constexpr bool PERM = true;
    bf16_t* H; const int* ltok; const float* rstd_tok; const LAS int* CNT;
    __device__ __forceinline__ void operator()(const f32x4 (&acc)[2][2][4][2], const Unit& u, int wr, int wc, int fr, int fq) const {
        asm volatile("" : "+v"(fr), "+v"(fq));
        const int colh = u.pnl * 128 + wc * 32 + 8 * fq; const int cnt = CNT[u.e];
        int toks[2][4]; float rss[2][4];
#pragma unroll
        for (int ai = 0; ai < 2; ++ai)
#pragma unroll
            for (int m = 0; m < 4; ++m) { const int idx = u.t * 256 + ai * HALF + wr * 64 + m * 16 + fr; toks[ai][m] = ltok[(size_t)u.e * M + (idx < cnt ? idx : 0)]; }
#pragma unroll
        for (int ai = 0; ai < 2; ++ai)
#pragma unroll
            for (int m = 0; m < 4; ++m) rss[ai][m] = rstd_tok[toks[ai][m]];
        asm volatile("" ::: "memory");
#pragma unroll
        for (int ai = 0; ai < 2; ++ai)
#pragma unroll
            for (int m = 0; m < 4; ++m) { const int rl = ai * HALF + wr * 64 + m * 16 + fr; const size_t row = (size_t)u.pm * BM + rl;
                const float rs = rss[ai][m];
                const f32x4 g0 = acc[ai][0][m][0] * rs, g1 = acc[ai][0][m][1] * rs, u0 = acc[ai][1][m][0] * rs, u1 = acc[ai][1][m][1] * rs;
                if constexpr (F8) {
                    u32x2 w; w.x = pk4_fp8(8.f * silu_mul(g0[0], u0[0]), 8.f * silu_mul(g0[1], u0[1]), 8.f * silu_mul(g0[2], u0[2]), 8.f * silu_mul(g0[3], u0[3]));
                    w.y = pk4_fp8(8.f * silu_mul(g1[0], u1[0]), 8.f * silu_mul(g1[1], u1[1]), 8.f * silu_mul(g1[2], u1[2]), 8.f * silu_mul(g1[3], u1[3]));
                    *(u32x2*)((unsigned char*)H + row * DEXP + colh) = w;
                } else {
                    u32x4 w; w.x = cvtpk(silu_mul(g0[0], u0[0]), silu_mul(g0[1], u0[1])); w.y = cvtpk(silu_mul(g0[2], u0[2]), silu_mul(g0[3], u0[3]));
                    w.z = cvtpk(silu_mul(g1[0], u1[0]), silu_mul(g1[1], u1[1])); w.w = cvtpk(silu_mul(g1[2], u1[2]), silu_mul(g1[3], u1[3]));
                    *(u32x4*)(H + row * DEXP + colh) = w; }
            }
    }
};
struct EpiDown {
    static constexpr bool PERM = true;
    bf16_t* Y; const float* lw;
    __device__ __forceinline__ void operator()(const f32x4 (&acc)[2][2][4][2], const Unit& u, int wr, int wc, int fr, int fq) const {
        asm volatile("" : "+v"(fr), "+v"(fq));
        const int col0 = u.pnl * BM + wc * 32 + 8 * fq;
        float scs[2][4];
#pragma unroll
        for (int ai = 0; ai < 2; ++ai)
#pragma unroll
            for (int m = 0; m < 4; ++m) scs[ai][m] = lw[(size_t)u.e * M + u.t * 256 + ai * HALF + wr * 64 + m * 16 + fr];
        asm volatile("" ::: "memory");
#pragma unroll
        for (int ai = 0; ai < 2; ++ai)
#pragma unroll
            for (int m = 0; m < 4; ++m) { const int rl = ai * HALF + wr * 64 + m * 16 + fr; const size_t row = (size_t)u.pm * BM + rl;
                const float sc = scs[ai][m];
#pragma unroll
                for (int bj = 0; bj < 2; ++bj) { const f32x4 v0 = acc[ai][bj][m][0] * sc, v1 = acc[ai][bj][m][1] * sc;
                    u32x4 w; w.x = cvtpk(v0[0], v0[1]); w.y = cvtpk(v0[2], v0[3]); w.z = cvtpk(v1[0], v1[1]); w.w = cvtpk(v1[2], v1[3]);
                    *(u32x4*)(Y + row * D + col0 + bj * HALF) = w; } }
    }
};

template <class Epi, class Sched, bool GATHER, bool ALIGN_EPI, bool FP8 = false>
__device__ __forceinline__ void gemm_phase(LAS unsigned char* lds, const Gemm g, const Sched& S, const Epi& E, const int wid, const int lane) {
    const int tid = wid * 64 + lane, wr = wid >> 2, wc = wid & 3, fr = lane & 15, fq = lane >> 4;
    const int K = g.K, nt = K / BK;
    int Rr[2], Cc[2]; unsigned voffB[2];
#pragma unroll
    for (int i = 0; i < 2; ++i) { int R, C; stage_rc(tid * 16 + i * 8192, R, C); Rr[i] = R; Cc[i] = C; const int Rb = Epi::PERM ? ((R & ~31) + perm32(R & 31)) : R; voffB[i] = (unsigned)(Rb * K + C) * 2u; }
    const size_t kstep = (size_t)(BK * 2);
    const size_t hstep = (size_t)HALF * K * 2;
    const size_t tstep = 2 * hstep;
    const unsigned ldsw = (unsigned)wid * 1024u;
    const size_t R64 = (size_t)64 * K * 2;
    const size_t H1 = GATHER ? 0 : hstep;
    const int aoff = FP8 ? lds_byte(wr * 64 + fr, (fq >> 1) * 32 + (fq & 1) * 16) : lds_byte(wr * 64 + fr, fq * 8), boff = FP8 ? lds_byte(wc * 32 + fr, (fq >> 1) * 32 + (fq & 1) * 16) : lds_byte(wc * 32 + fr, fq * 8);

#define PG8_SA(b, h) (((b) * 2 + (h)) * HTB)
#define PG8_SB(b, h) ((4 + (b) * 2 + (h)) * HTB)
#define PG8_STAGE2(bufoff, gbase, o0, o1) do { \
        __builtin_amdgcn_global_load_lds((const unsigned*)((const char*)(gbase) + (o0)), (LAS unsigned*)(lds + (bufoff) + ldsw), 16, 0, 0); \
        __builtin_amdgcn_global_load_lds((const unsigned*)((const char*)(gbase) + (o1)), (LAS unsigned*)(lds + (bufoff) + ldsw + 8192), 16, 0, 0); } while (0)
#define PG8_STAGEB(bufoff, gbase) do {   \
        __builtin_amdgcn_global_load_lds((const unsigned*)((const char*)(gbase) + voffB[0]), (LAS unsigned*)(lds + (bufoff) + ldsw), 16, 0, 0); \
        __builtin_amdgcn_global_load_lds((const unsigned*)((const char*)(gbase) + R64 + voffB[0]), (LAS unsigned*)(lds + (bufoff) + ldsw + 8192), 16, 0, 0); } while (0)
#define PG8_LDA(dst, b, h) do { if constexpr (FP8) { _Pragma("unroll") for (int m = 0; m < 4; ++m) dst##8[m] = *(const LAS i32x8*)(lds + PG8_SA(b, h) + aoff + m * 2048); } \
        else { _Pragma("unroll") for (int m = 0; m < 4; ++m) _Pragma("unroll") for (int k = 0; k < 2; ++k) dst[m][k] = *(const LAS bf16x8*)(lds + PG8_SA(b, h) + aoff + m * 2048 + k * 1024); } } while (0)
#define PG8_LDB(dst, b, h) do { if constexpr (FP8) { _Pragma("unroll") for (int n = 0; n < 2; ++n) dst##8[n] = *(const LAS i32x8*)(lds + PG8_SB(b, h) + boff + n * 2048); } \
        else { _Pragma("unroll") for (int n = 0; n < 2; ++n) _Pragma("unroll") for (int k = 0; k < 2; ++k) dst[n][k] = *(const LAS bf16x8*)(lds + PG8_SB(b, h) + boff + n * 2048 + k * 1024); } } while (0)
#define PG8_CAT8(x) __builtin_shufflevector(__builtin_bit_cast(i32x4, (x)[0]), __builtin_bit_cast(i32x4, (x)[1]), 0, 1, 2, 3, 4, 5, 6, 7)
#define PG8_MMA(ai, bj, At, Bt) do { if constexpr (FP8) __builtin_amdgcn_sched_barrier(0); __builtin_amdgcn_s_setprio(1); _Pragma("unroll") for (int m = 0; m < 4; ++m) _Pragma("unroll") for (int n = 0; n < 2; ++n) { \
        if constexpr (FP8) acc[ai][bj][m][n] = __builtin_amdgcn_mfma_scale_f32_16x16x128_f8f6f4(Bt##8[n], At##8[m], acc[ai][bj][m][n], 0, 0, 0, (int)g.sw, 0, (int)g.sx); \
        else { _Pragma("unroll") for (int k = 0; k < 2; ++k) acc[ai][bj][m][n] = __builtin_amdgcn_mfma_f32_16x16x32_bf16(Bt[n][k], At[m][k], acc[ai][bj][m][n], 0, 0, 0); } } \
        if constexpr (FP8) { _Pragma("unroll") for (int m = 0; m < 4; ++m) _Pragma("unroll") for (int n = 0; n < 2; ++n) asm volatile("" : "+v"(acc[ai][bj][m][n])); }   \
        __builtin_amdgcn_s_setprio(0); if constexpr (FP8) __builtin_amdgcn_sched_barrier(0); } while (0)
#define PG8_WAIT_V(n) asm volatile("s_waitcnt vmcnt(" #n ")" ::: "memory")
#define PG8_WAIT_L(n) asm volatile("s_waitcnt lgkmcnt(" #n ")" ::: "memory")
#define PG8_BAR __builtin_amdgcn_s_barrier()
#define PG8_SCHED __builtin_amdgcn_sched_barrier(0)
    Unit cur, nxt; int ui = 0;
    if (!S.next(0, cur)) return;
    unsigned oc00, oc01, oc10, oc11;
    LAS u32x4* stash = (LAS u32x4*)(lds + (STASH_OFF - 0) ) + tid;
    if constexpr (GATHER) {
        oc00 = (unsigned)(S.token(cur, Rr[0]) * K + Cc[0]) * 2u; oc01 = (unsigned)(S.token(cur, Rr[1]) * K + Cc[1]) * 2u;
        oc10 = (unsigned)(S.token(cur, 128 + Rr[0]) * K + Cc[0]) * 2u; oc11 = (unsigned)(S.token(cur, 128 + Rr[1]) * K + Cc[1]) * 2u;
    } else {
        oc00 = (unsigned)(Rr[0] * K + Cc[0]) * 2u; oc01 = (unsigned)(Rr[1] * K + Cc[1]) * 2u; oc10 = oc00; oc11 = oc01;
    }
    f32x4 acc[2][2][4][2];
#pragma unroll
    for (int a = 0; a < 2; ++a)
#pragma unroll
        for (int b = 0; b < 2; ++b)
#pragma unroll
            for (int m = 0; m < 4; ++m)
#pragma unroll
                for (int n = 0; n < 2; ++n) acc[a][b][m][n] = (f32x4){0.f, 0.f, 0.f, 0.f};
    bf16x8 At[4][2], B0[2][2], B1[2][2];
    i32x8 At8[4], B08[2], B18[2];
    const char* cA = GATHER ? (const char*)g.A : (const char*)g.A + (size_t)cur.pm * tstep; const char* cB = (const char*)g.Bt + (size_t)cur.pn * tstep;
    PG8_STAGEB(PG8_SB(0, 0), cB); PG8_STAGEB(PG8_SB(0, 1), cB + hstep); PG8_STAGE2(PG8_SA(0, 0), cA, oc00, oc01); PG8_STAGE2(PG8_SA(0, 1), cA + H1, oc10, oc11);
    if (wr == 1) PG8_BAR;
    PG8_WAIT_V(2); PG8_BAR;
    PG8_STAGEB(PG8_SB(1, 0), cB + kstep); PG8_STAGE2(PG8_SA(1, 0), cA + kstep, oc00, oc01); PG8_STAGEB(PG8_SB(1, 1), cB + hstep + kstep);
    PG8_WAIT_V(6); PG8_BAR;
    for (;;) {
        const bool has_next = S.next(ui + 1, nxt);
        const char* nA = has_next ? (GATHER ? (const char*)g.A : (const char*)g.A + (size_t)nxt.pm * tstep) : cA; const char* nB = has_next ? (const char*)g.Bt + (size_t)nxt.pn * tstep : cB;
        if constexpr (GATHER) {
            u32x4 nx = {oc00, oc01, oc10, oc11};
            if (has_next) { int R0, C0, R1, C1; stage_rc(tid * 16, R0, C0); stage_rc(tid * 16 + 8192, R1, C1);
                nx.x = (unsigned)(S.token(nxt, R0) * K + C0) * 2u; nx.y = (unsigned)(S.token(nxt, R1) * K + C1) * 2u;
                nx.z = (unsigned)(S.token(nxt, 128 + R0) * K + C0) * 2u; nx.w = (unsigned)(S.token(nxt, 128 + R1) * K + C1) * 2u; }
            *stash = nx;
        }
        for (int t = 0; t < nt; t += 2) {
            const bool last = (t == nt - 2);
            const char* a1 = cA + (size_t)(t + 1) * kstep;
            const char* a2 = last ? nA : cA + (size_t)(t + 2) * kstep; const char* b2 = last ? nB : cB + (size_t)(t + 2) * kstep;
            const char* a3 = a2 + kstep; const char* b3 = b2 + kstep;
            unsigned x00 = oc00, x01 = oc01, x10 = oc10, x11 = oc11;
            if constexpr (GATHER) { if (last) { const u32x4 nx = *stash; x00 = nx.x; x01 = nx.y; x10 = nx.z; x11 = nx.w; } }
            PG8_LDB(B0, 0, 0); PG8_LDB(B1, 0, 1); PG8_SCHED; PG8_LDA(At, 0, 0); PG8_STAGE2(PG8_SA(1, 1), a1 + H1, oc10, oc11);
            PG8_WAIT_V(8); PG8_WAIT_L(0); PG8_BAR; PG8_MMA(0, 0, At, B0); PG8_MMA(0, 1, At, B1); PG8_BAR; PG8_SCHED;
            PG8_LDA(At, 0, 1); PG8_STAGEB(PG8_SB(0, 0), b2); PG8_STAGEB(PG8_SB(0, 1), b2 + hstep); PG8_STAGE2(PG8_SA(0, 0), a2, x00, x01);
            PG8_WAIT_V(8); PG8_WAIT_L(0); PG8_BAR; PG8_MMA(1, 0, At, B0); PG8_MMA(1, 1, At, B1); PG8_BAR; PG8_SCHED;
            PG8_LDB(B0, 1, 0); PG8_LDB(B1, 1, 1); PG8_SCHED; PG8_LDA(At, 1, 0); PG8_STAGE2(PG8_SA(0, 1), a2 + H1, x10, x11);
            PG8_WAIT_V(8); PG8_WAIT_L(0); PG8_BAR; PG8_MMA(0, 0, At, B0); PG8_MMA(0, 1, At, B1); PG8_BAR; PG8_SCHED;
            PG8_LDA(At, 1, 1); PG8_STAGEB(PG8_SB(1, 0), b3); PG8_STAGEB(PG8_SB(1, 1), b3 + hstep); PG8_STAGE2(PG8_SA(1, 0), a3, x00, x01);
            PG8_WAIT_V(8); PG8_WAIT_L(0); PG8_BAR; PG8_MMA(1, 0, At, B0); PG8_MMA(1, 1, At, B1); PG8_BAR; PG8_SCHED;
        }
        if constexpr (ALIGN_EPI) { if (wr == 0) PG8_BAR; }
        E(acc, cur, wr, wc, fr, fq);
        if (!has_next) break;
#pragma unroll
        for (int a = 0; a < 2; ++a)
#pragma unroll
            for (int b = 0; b < 2; ++b)
#pragma unroll
                for (int m = 0; m < 4; ++m)
#pragma unroll
                    for (int n = 0; n < 2; ++n) acc[a][b][m][n] = (f32x4){0.f, 0.f, 0.f, 0.f};
        cur = nxt; cA = nA; cB = nB; ++ui;
        if constexpr (GATHER) { const u32x4 nx = *stash; oc00 = nx.x; oc01 = nx.y; oc10 = nx.z; oc11 = nx.w; }
        if constexpr (ALIGN_EPI) { if (wr == 1) PG8_BAR; }
    }
    PG8_WAIT_V(0);
    if constexpr (!ALIGN_EPI) { if (wr == 0) PG8_BAR; }
    PG8_BAR;
#undef PG8_SA
#undef PG8_SB
#undef PG8_STAGE2
#undef PG8_STAGEB
#undef PG8_LDA
#undef PG8_LDB
#undef PG8_MMA
#undef PG8_CAT8
#undef PG8_WAIT_V
#undef PG8_WAIT_L
#undef PG8_BAR
#undef PG8_SCHED
}
}

namespace att {
constexpr int NSLOT = 3;
constexpr float THR = 8.0f;
__device__ __forceinline__ void glds16(const void* gsrc, unsigned lds_dst) { unsigned keep;
    asm volatile("s_mov_b32 %0, m0\n\ts_mov_b32 m0, %2\n\ts_nop 0\n\tglobal_load_lds_dwordx4 %1, off\n\ts_mov_b32 m0, %0" : "=&s"(keep) : "v"(gsrc), "s"(lds_dst) : "memory"); }
#define ATT_WAIT_BAR(N) asm volatile("s_waitcnt vmcnt(" #N ") lgkmcnt(0)\n\ts_barrier" ::: "memory")
typedef LAS const char* lds_cptr;
typedef short v4i16_t __attribute__((ext_vector_type(4)));
__device__ __forceinline__ s16x4 vtr(lds_cptr p) { return __builtin_bit_cast(s16x4, __builtin_amdgcn_ds_read_tr16_b64_v4i16((LAS v4i16_t*)p)); }
__device__ __forceinline__ float swap_max(float m) { auto rr = __builtin_amdgcn_permlane32_swap(__float_as_uint(m), __float_as_uint(m), false, false); return __builtin_fmaxf(__uint_as_float(rr[0]), __uint_as_float(rr[1])); }
__device__ __forceinline__ float swap_sum(float m) { auto rr = __builtin_amdgcn_permlane32_swap(__float_as_uint(m), __float_as_uint(m), false, false); return __uint_as_float(rr[0]) + __uint_as_float(rr[1]); }
__device__ __forceinline__ float max3f(float a, float b, float c) { float r; asm("v_max3_f32 %0, %1, %2, %3" : "=v"(r) : "v"(a), "v"(b), "v"(c)); return r; }
template <unsigned KB> __device__ __forceinline__ float fmamk(float a, float c) { float r; asm("v_fmamk_f32 %0, %1, %2, %3" : "=v"(r) : "v"(a), "i"(KB), "v"(c)); return r; }
#define CRF(r) ((float)(((r) & 3) + 8 * ((r) >> 2)))
#define CRI(r) (((r) & 3) + 8 * ((r) >> 2))

__device__ __forceinline__ u32x4 pair_rows(const u32x2 A, const u32x2 B) {
    auto x = __builtin_amdgcn_permlane32_swap(A.x, B.x, false, false); auto y = __builtin_amdgcn_permlane32_swap(A.y, B.y, false, false);
    return (u32x4){(unsigned)x[0], (unsigned)y[0], (unsigned)x[1], (unsigned)y[1]}; }
template <int MODE> struct Cfg;
template <> struct Cfg<0> { static constexpr int DV32 = 2, NK = 1, SLOTB = 16384, VOFF = 8192, PITCH = SWA_N, NVP = 1; };
template <> struct Cfg<1> { static constexpr int DV32 = 4, NK = 2, SLOTB = 32768, VOFF = 16384, PITCH = DIFF_N, NVP = 2; };

template <int MODE>
__device__ __forceinline__ void tile_step(lds_cptr kp, lds_cptr vp, const bf16x8 (&qr)[4], f32x16 (&o)[Cfg<MODE>::DV32], float& mhat, float& l, bool& first,
                                          const float slope2, const int dq_i, const int kind, const int hi) {
    constexpr int DV32 = Cfg<MODE>::DV32;
    f32x16 p0, p1;
    const float dq = (float)dq_i, nm = -mhat;
    {
        const float sl = kind == 2 ? 0.f : (kind == 0 ? slope2 : -slope2); const float base0 = __builtin_fmaf(-sl, dq, nm);
#pragma unroll
        for (int r = 0; r < 16; ++r) { p0[r] = __builtin_fmaf(sl, CRF(r), base0); p1[r] = __builtin_fmaf(sl, CRF(r) + 32.f, base0); }
    }
#pragma unroll
    for (int d0 = 0; d0 < 4; ++d0) {
        const bf16x8 b0 = *(const LAS bf16x8*)(kp + d0 * 2048);
        const bf16x8 b1 = *(const LAS bf16x8*)(kp + d0 * 2048 + 512);
        p0 = __builtin_amdgcn_mfma_f32_32x32x16_bf16(b0, qr[d0], p0, 0, 0, 0);
        p1 = __builtin_amdgcn_mfma_f32_32x32x16_bf16(b1, qr[d0], p1, 0, 0, 0);
    }
    if (kind == 2) {
#pragma unroll
        for (int r = 0; r < 16; ++r) {
            const float e0 = __builtin_fabsf(dq - CRF(r)), e1 = __builtin_fabsf(dq - CRF(r) - 32.f);
            if (MODE == 0) { p0[r] = e0 <= 128.f ? __builtin_fmaf(-slope2, e0, p0[r]) : -INFINITY; p1[r] = e1 <= 128.f ? __builtin_fmaf(-slope2, e1, p1[r]) : -INFINITY; }
            else { p0[r] = __builtin_fmaf(-slope2, e0, p0[r]); p1[r] = __builtin_fmaf(-slope2, e1, p1[r]); }
        }
    }
    float rm = __builtin_fmaxf(p0[0], p1[0]);
#pragma unroll
    for (int r = 1; r < 16; ++r) rm = __builtin_fmaxf(rm, __builtin_fmaxf(p0[r], p1[r]));
    rm = swap_max(rm);
    if (first || __any(rm > THR)) {
        const float dl = first ? rm : __builtin_fmaxf(rm, 0.f);
        mhat += dl;
#pragma unroll
        for (int r = 0; r < 16; ++r) { p0[r] -= dl; p1[r] -= dl; }
        if (!first) {
            const float f = __builtin_amdgcn_exp2f(-dl); l *= f;
#pragma unroll
            for (int r = 0; r < 16; ++r)
#pragma unroll
                for (int d0 = 0; d0 < DV32; ++d0) o[d0][r] *= f;
        }
        first = false;
    }
    float sacc = 0.f;
    u32x4 pw[4];
#pragma unroll
    for (int s = 0; s < 2; ++s) {
        float e[8];
#pragma unroll
        for (int j = 0; j < 8; ++j) { e[j] = __builtin_amdgcn_exp2f(p0[8 * s + j]); sacc += e[j]; }
        pw[s] = (u32x4){cvtpk(e[0], e[1]), cvtpk(e[2], e[3]), cvtpk(e[4], e[5]), cvtpk(e[6], e[7])};
    }
#pragma unroll
    for (int s = 0; s < 2; ++s) {
        float e[8];
#pragma unroll
        for (int j = 0; j < 8; ++j) { e[j] = __builtin_amdgcn_exp2f(p1[8 * s + j]); sacc += e[j]; }
        pw[2 + s] = (u32x4){cvtpk(e[0], e[1]), cvtpk(e[2], e[3]), cvtpk(e[4], e[5]), cvtpk(e[6], e[7])};
    }
    l += sacc;
#pragma unroll
    for (int d0 = 0; d0 < DV32; ++d0) {
#pragma unroll
        for (int ks = 0; ks < 4; ++ks) {
            const s16x4 lo = vtr(vp + d0 * 4096 + ks * 1024), hh = vtr(vp + d0 * 4096 + ks * 1024 + 512);
            const bf16x8 vf = (bf16x8){lo[0], lo[1], lo[2], lo[3], hh[0], hh[1], hh[2], hh[3]};
            o[d0] = __builtin_amdgcn_mfma_f32_32x32x16_bf16(vf, __builtin_bit_cast(bf16x8, pw[ks]), o[d0], 0, 0, 0);
        }
    }
}

struct DiffConsts { float lam_full; const float* subln; };

template <int MODE>
__device__ __forceinline__ void attn_unit(const int b, const int hh, const int qb, const bf16_t* __restrict__ QKV, bf16_t* __restrict__ O, const float* __restrict__ sink,
                                          const DiffConsts dc, LAS unsigned char* shm, const int wid, const int lane_in) {
    typedef Cfg<MODE> C;
    constexpr int DV32 = C::DV32, PITCH = C::PITCH;
    int lane = lane_in; asm volatile("" : "+v"(lane));
    const int r32 = lane & 31, hi = lane >> 5;
    int iw, qcol, kcol, vcol, t_lo, NT, hq = 0, cmap = 0, qs;
    float slope2;
    if (MODE == 0) { const int g = wid >> 1; qs = wid & 1; hq = hh * 4 + g; iw = qb * 64 + qs * 32; qcol = hq * 64; kcol = 1024 + hh * 64; vcol = 1280 + hh * 64;
        t_lo = qb - 2 < 0 ? 0 : qb - 2; const int t_hi = qb + 2 > 127 ? 127 : qb + 2; NT = t_hi - t_lo + 1; slope2 = __builtin_amdgcn_exp2f(-0.5f * (float)(hq + 1)) * LOG2E; }
    else { qs = wid & 3; cmap = wid >> 2; iw = qb * 128 + qs * 32; qcol = (hh * 2 + cmap) * 64; kcol = 1024 + hh * 128; vcol = 2048 + hh * 128; t_lo = 0; NT = SEQ / 64;
        slope2 = __builtin_amdgcn_exp2f(-(float)(hh + 1)) * LOG2E; }
    const bf16_t* base = QKV + (size_t)b * SEQ * PITCH;
    const unsigned lds0 = (unsigned)(uintptr_t)shm;
    const unsigned koff = (unsigned)(lane * PITCH + kcol + wid * 8) * 2u;
    const unsigned voff = (unsigned)((16 * (wid & 3) + (lane >> 2)) * PITCH + vcol + (wid >> 2) * 32 + (lane & 3) * 8) * 2u;
    const unsigned kdst = lds0 + wid * 1024, vdst = lds0 + C::VOFF + wid * 1024;
#define ATT_DMA(t, slot) do { const char* tb_ = (const char*)base + (size_t)(t) * 64 * PITCH * 2; const unsigned so_ = (unsigned)(slot) * C::SLOTB; \
        glds16(tb_ + koff, (unsigned)__builtin_amdgcn_readfirstlane(kdst + so_)); \
        if (MODE == 1) glds16(tb_ + koff + 128, (unsigned)__builtin_amdgcn_readfirstlane(kdst + so_ + 8192)); \
        glds16(tb_ + voff, (unsigned)__builtin_amdgcn_readfirstlane(vdst + so_)); \
        if (MODE == 1) glds16(tb_ + voff + 128, (unsigned)__builtin_amdgcn_readfirstlane(vdst + so_ + 8192)); } while (0)
    ATT_DMA(t_lo, 0);
    if (NT > 1) ATT_DMA(t_lo + 1, 1);
    bf16x8 qr[4];
    { const bf16_t* Qw = base + (size_t)(iw + r32) * PITCH + qcol;
#pragma unroll
      for (int d0 = 0; d0 < 4; ++d0) qr[d0] = *(const bf16x8*)(Qw + d0 * 16 + hi * 8); }
    f32x16 o[DV32];
#pragma unroll
    for (int d0 = 0; d0 < DV32; ++d0)
#pragma unroll
        for (int r = 0; r < 16; ++r) o[d0][r] = 0.f;
    float mhat = 0.f, l = 0.f; bool first = true;
    if (MODE == 0) { mhat = sink[hq] * LOG2E; l = (hi == 0) ? 1.f : 0.f; first = false; }
    const lds_cptr shm3 = (lds_cptr)shm;
    const lds_cptr kp0 = shm3 + (MODE == 1 ? cmap * 8192 : 0) + hi * 1024 + r32 * 16;
    const lds_cptr vp0 = shm3 + C::VOFF + ((lane >> 4) & 1) * 32 + (lane & 3) * 8 + (4 * hi + ((lane & 15) >> 2)) * 64;
    int slot = 0;
    for (int it = 0; it < NT; ++it) {
        if (it + 1 < NT) { if (MODE == 1) { ATT_WAIT_BAR(4); } else { ATT_WAIT_BAR(2); } } else { ATT_WAIT_BAR(0); }
        if (it + 2 < NT) { const int s2 = slot == 0 ? 2 : slot - 1; ATT_DMA(t_lo + it + 2, s2); }
        const int k0 = (t_lo + it) * 64;
        const int kind = (MODE == 0) ? ((t_lo + it == qb - 1) ? 0 : ((t_lo + it == qb + 1) ? 1 : 2)) : ((k0 + 63 < iw) ? 0 : ((k0 > iw + 31) ? 1 : 2));
        tile_step<MODE>(kp0 + slot * C::SLOTB, vp0 + slot * C::SLOTB, qr, o, mhat, l, first, slope2, iw + r32 - k0 - 4 * hi, kind, hi);
        slot = slot == 2 ? 0 : slot + 1;
    }
#undef ATT_DMA
    l = swap_sum(l);
    const float rl = 1.f / l;
    if (MODE == 0) {
        bf16_t* Ow = O + (size_t)(b * SEQ + iw + r32) * D + hq * 64 + 8 * hi;
#pragma unroll
        for (int d0 = 0; d0 < DV32; ++d0)
#pragma unroll
            for (int ge = 0; ge < 4; ge += 2) { u32x2 A, B;
                A.x = cvtpk(o[d0][4 * ge] * rl, o[d0][4 * ge + 1] * rl); A.y = cvtpk(o[d0][4 * ge + 2] * rl, o[d0][4 * ge + 3] * rl);
                B.x = cvtpk(o[d0][4 * ge + 4] * rl, o[d0][4 * ge + 5] * rl); B.y = cvtpk(o[d0][4 * ge + 6] * rl, o[d0][4 * ge + 7] * rl);
                *(u32x4*)(Ow + d0 * 32 + 8 * ge) = pair_rows(A, B); }
        ATT_WAIT_BAR(0);
    } else {
        LAS float* cb = (LAS float*)shm + qs * 4096;
        ATT_WAIT_BAR(0);
        if (cmap == 1) {
#pragma unroll
            for (int r = 0; r < 16; ++r) { const int row = CRI(r) + 4 * hi; const float rr = __shfl(rl, row) * dc.lam_full;
#pragma unroll
                for (int d0 = 0; d0 < DV32; ++d0) cb[row * 128 + d0 * 32 + r32] = o[d0][r] * rr; }
        }
        ATT_WAIT_BAR(0);
        if (cmap == 0) {
            bf16_t* Ow = O + (size_t)(b * SEQ + iw) * D + hh * 128 + r32;
            float gsub[DV32];
#pragma unroll
            for (int d0 = 0; d0 < DV32; ++d0) gsub[d0] = dc.subln[d0 * 32 + r32] * (1.f - LAMBDA_INIT);
#pragma unroll
            for (int r = 0; r < 16; ++r) { const int row = CRI(r) + 4 * hi; const float rr = __shfl(rl, row);
                float v[DV32]; float ss = 0.f;
#pragma unroll
                for (int d0 = 0; d0 < DV32; ++d0) { v[d0] = o[d0][r] * rr - cb[row * 128 + d0 * 32 + r32]; ss += v[d0] * v[d0]; }
                ss += __shfl_xor(ss, 1); ss += __shfl_xor(ss, 2); ss += __shfl_xor(ss, 4); ss += __shfl_xor(ss, 8); ss += __shfl_xor(ss, 16);
                const float sc = __builtin_amdgcn_rsqf(ss * (1.f / 128.f) + 1e-5f);
#pragma unroll
                for (int d0 = 0; d0 < DV32; ++d0) Ow[(size_t)row * D + d0 * 32] = (bf16_t)f2bf(v[d0] * sc * gsub[d0]); }
        }
        ATT_WAIT_BAR(0);
    }
}

#define SBAR() __builtin_amdgcn_sched_barrier(0)
#define PIN(x) asm volatile("" : "+v"(x))
#define MF(a, b, c) __builtin_amdgcn_mfma_f32_32x32x16_bf16(a, b, c, 0, 0, 0)
template <int VAR>
__device__ __forceinline__ void diff_unit(const int b, const int hh, const int qb, const bf16_t* __restrict__ QKV, bf16_t* __restrict__ O, const float kmax,
                                          const DiffConsts dc, LAS unsigned char* shm, const int wid, const int lane_in) {
    constexpr int DV32 = 4, PITCH = DIFF_N, KSLOT = 16384, VRING = 4 * 16384;
    int lane = lane_in; asm volatile("" : "+v"(lane));
    const int r32 = lane & 31, hi = lane >> 5;
    const int qs = wid & 3, cmap = wid >> 2, i0 = qb * 128, iw = i0 + qs * 32, qcol = (hh * 2 + cmap) * 64, kcol = 1024 + hh * 128, vcol = 2048 + hh * 128;
    const float slope2 = __builtin_amdgcn_exp2f(-(float)(hh + 1)) * LOG2E;
    const bf16_t* base = QKV + (size_t)b * SEQ * PITCH;
    const unsigned lds0 = (unsigned)(uintptr_t)shm;
    const unsigned koff = (unsigned)(lane * PITCH + kcol + wid * 8) * 2u;
    const unsigned voff = (unsigned)((16 * (wid & 3) + (lane >> 2)) * PITCH + vcol + (wid >> 2) * 32 + (lane & 3) * 8) * 2u;
    const unsigned kdst = lds0 + wid * 1024, vdst = lds0 + VRING + wid * 1024;
#define DMA_K(t, slot) do { const char* tb_ = (const char*)base + (size_t)(t) * 64 * PITCH * 2; const unsigned so_ = (unsigned)(slot) * KSLOT; \
        glds16(tb_ + koff, (unsigned)__builtin_amdgcn_readfirstlane(kdst + so_)); glds16(tb_ + koff + 128, (unsigned)__builtin_amdgcn_readfirstlane(kdst + so_ + 8192)); } while (0)
#define DMA_V(t, slot) do { const char* tb_ = (const char*)base + (size_t)(t) * 64 * PITCH * 2; const unsigned so_ = (unsigned)(slot) * KSLOT; \
        glds16(tb_ + voff, (unsigned)__builtin_amdgcn_readfirstlane(vdst + so_)); glds16(tb_ + voff + 128, (unsigned)__builtin_amdgcn_readfirstlane(vdst + so_ + 8192)); } while (0)
    const int td0 = 2 * qb;
    int nL = td0;
#define TILE_OF(idx) ((idx) < 2 ? td0 + (idx) : ((idx) - 2 < nL ? td0 - 1 - ((idx) - 2) : td0 + 2 + ((idx) - 2 - nL)))
    DMA_K(td0, 0); DMA_V(td0, 0); DMA_K(td0 + 1, 1); DMA_V(td0 + 1, 1); DMA_K(TILE_OF(2), 2);
    bf16x8 qr[4]; float nq2 = 0.f;
    { const bf16_t* Qw = base + (size_t)(iw + r32) * PITCH + qcol;
#pragma unroll
      for (int d0 = 0; d0 < 4; ++d0) { qr[d0] = *(const bf16x8*)(Qw + d0 * 16 + hi * 8);
#pragma unroll
          for (int j = 0; j < 8; ++j) { const float f = bf2f((unsigned short)qr[d0][j]); nq2 += f * f; } } }
    nq2 = swap_sum(nq2);
    f32x16 o[DV32];
#pragma unroll
    for (int d0 = 0; d0 < DV32; ++d0)
#pragma unroll
        for (int r = 0; r < 16; ++r) o[d0][r] = 0.f;
    float mhat = 0.f, l = 0.f; bool first = true;
    const lds_cptr shm3 = (lds_cptr)shm;
    const lds_cptr kp0 = shm3 + cmap * 8192 + hi * 1024 + r32 * 16;
    const lds_cptr vp0 = shm3 + VRING + ((lane >> 4) & 1) * 32 + (lane & 3) * 8 + (4 * hi + ((lane & 15) >> 2)) * 64;
    LAS float* wsf = (LAS float*)(shm + 7 * KSLOT);
    ATT_WAIT_BAR(6);
    DMA_K(TILE_OF(3), 3);
    { const int k0 = td0 * 64; const int kind = (k0 + 63 < iw) ? 0 : ((k0 > iw + 31) ? 1 : 2);
      tile_step<1>(kp0, vp0, qr, o, mhat, l, first, slope2, iw + r32 - k0 - 4 * hi, kind, hi); }
    ATT_WAIT_BAR(4);
    DMA_K(TILE_OF(4), 0); DMA_V(TILE_OF(2), 2);
    { const int k0 = (td0 + 1) * 64; const int kind = (k0 + 63 < iw) ? 0 : ((k0 > iw + 31) ? 1 : 2);
      tile_step<1>(kp0 + KSLOT, vp0 + KSLOT, qr, o, mhat, l, first, slope2, iw + r32 - k0 - 4 * hi, kind, hi); }
    { float a = sqrtf(nq2) * kmax - mhat;
#pragma unroll
      for (int o_ = 1; o_ < 32; o_ <<= 1) a = __builtin_fmaxf(a, __shfl_xor(a, o_));
      if (lane == 0) wsf[wid] = a; }
    ATT_WAIT_BAR(4);
    int NT; bool nochk;
    { float amax = wsf[0];
#pragma unroll
      for (int w = 1; w < 8; ++w) amax = __builtin_fmaxf(amax, wsf[w]);
      const float dist = (64.f + __builtin_fmaxf(amax, 0.f)) / slope2;
      const float lo_f = ((float)(i0 - 63) - dist) * (1.f / 64.f), hi_f = ((float)(i0 + 127) + dist) * (1.f / 64.f);
      int t_lo = lo_f <= 0.f ? 0 : (int)lo_f, t_hi = hi_f >= 127.f ? 127 : (int)hi_f;
      if (t_lo > td0 - 2) t_lo = td0 - 2 < 0 ? 0 : td0 - 2; if (t_hi < td0 + 3) t_hi = td0 + 3 > 127 ? 127 : td0 + 3;
      t_lo = __builtin_amdgcn_readfirstlane(t_lo); t_hi = __builtin_amdgcn_readfirstlane(t_hi);
      nL = td0 - t_lo; NT = 2 + nL + (t_hi - (td0 + 1)); if (VAR & 256) NT = 2;
      nochk = __builtin_amdgcn_readfirstlane(amax <= 64.f ? 1 : 0) != 0; }
    f32x16 xa0, xa1, xb0, xb1; u32x4 pw0, pw1, pw2, pw3; bf16x8 kf0, kf1, kf2, kf3; s16x4 vl0, vh0, vl1, vh1, vl2, vh2, vl3, vh3;
    float sl_n, base_n, rf = 1.f; bool resc = false;
#define KRD(dst, f) do { if ((VAR & 4) && (f) >= 4) break; dst = *(const LAS bf16x8*)(kp_ + ((f) >> 1) * 2048 + ((f) & 1) * 512); } while (0)
#define VRD(lo, hh_, i) do { if ((VAR & 2) && (i) >= 4) break; lo = vtr(vp_ + ((i) >> 2) * 4096 + ((i) & 3) * 1024); hh_ = vtr(vp_ + ((i) >> 2) * 4096 + ((i) & 3) * 1024 + 512); } while (0)
#define KRN(dst, f) dst = *(const LAS bf16x8*)(kn_ + ((f) >> 1) * 2048 + ((f) & 1) * 512)
#define VFR(lo, hh_) (bf16x8){lo[0], lo[1], lo[2], lo[3], hh_[0], hh_[1], hh_[2], hh_[3]}
#define SET_NEXT(idx) do { const int tn_ = TILE_OF(idx); const bool left_ = (idx) - 2 < nL; sl_n = left_ ? slope2 : -slope2; \
        base_n = __builtin_fmaf(-sl_n, (float)(iw + r32 - tn_ * 64 - 4 * hi), -mhat); } while (0)
#define CINIT(X0, X1) do { _Pragma("unroll") for (int r = 0; r < 16; ++r) { X0[r] = __builtin_fmaf(sl_n, CRF(r), base_n); X1[r] = __builtin_fmaf(sl_n, CRF(r) + 32.f, base_n); } } while (0)
#define GA(Sx, KF, qf, RD, P, e, PW, w0, w1) do { Sx = MF(KF, qf, Sx); RD; if (!(VAR & 32)) { sacc += P[e]; sacc += P[e + 1]; sacc += P[e + 2]; sacc += P[e + 3]; PIN(sacc); \
        PW[w0] = cvtpk(P[e], P[e + 1]); PW[w1] = cvtpk(P[e + 2], P[e + 3]); } PIN(PW); SBAR(); } while (0)
#define PHASE_A(S0, S1, P0, P1) do { float sacc = 0.f; \
        GA(S0, kf0, qr[0], KRD(kf0, 4), P0, 0,  pw0, 0, 1); GA(S1, kf1, qr[0], KRD(kf1, 5), P0, 4,  pw0, 2, 3); \
        GA(S0, kf2, qr[1], KRD(kf2, 6), P0, 8,  pw1, 0, 1); GA(S1, kf3, qr[1], KRD(kf3, 7), P0, 12, pw1, 2, 3); \
        GA(S0, kf0, qr[2], VRD(vl0, vh0, 0), P1, 0,  pw2, 0, 1); GA(S1, kf1, qr[2], VRD(vl1, vh1, 1), P1, 4,  pw2, 2, 3); \
        GA(S0, kf2, qr[3], VRD(vl2, vh2, 2), P1, 8,  pw3, 0, 1); GA(S1, kf3, qr[3], VRD(vl3, vh3, 3), P1, 12, pw3, 2, 3); \
        l += sacc; } while (0)
#define QK_ONLY(S0, S1) do { \
        S0 = MF(kf0, qr[0], S0); KRD(kf0, 4); S1 = MF(kf1, qr[0], S1); KRD(kf1, 5); S0 = MF(kf2, qr[1], S0); KRD(kf2, 6); S1 = MF(kf3, qr[1], S1); KRD(kf3, 7); SBAR(); \
        S0 = MF(kf0, qr[2], S0); S1 = MF(kf1, qr[2], S1); S0 = MF(kf2, qr[3], S0); S1 = MF(kf3, qr[3], S1); SBAR(); } while (0)
#define DECIDE(S0, S1) do { if (VAR & 64) break; asm volatile("s_nop 15\n\ts_nop 7" : "+v"(S0), "+v"(S1));   \
        float ma_ = max3f(S0[0], S0[1], S1[0]), mb_ = max3f(S0[2], S0[3], S1[1]); ma_ = max3f(ma_, S1[2], S1[3]); \
        _Pragma("unroll") for (int r = 4; r < 16; r += 4) { ma_ = max3f(ma_, S0[r], S0[r + 1]); mb_ = max3f(mb_, S0[r + 2], S0[r + 3]); ma_ = max3f(ma_, S1[r], S1[r + 1]); mb_ = max3f(mb_, S1[r + 2], S1[r + 3]); } \
        float rm_ = max3f(ma_, mb_, mb_); rm_ = swap_max(rm_); resc = false; \
        if (__builtin_expect(__any(rm_ > THR), 0)) { const float dl_ = __builtin_fmaxf(rm_, 0.f); mhat += dl_; \
            _Pragma("unroll") for (int r = 0; r < 16; ++r) { S0[r] -= dl_; S1[r] -= dl_; } \
            rf = __builtin_amdgcn_exp2f(-dl_); l *= rf; resc = true; } } while (0)
#define RESCALE_O() do { if (resc) { _Pragma("unroll") for (int r = 0; r < 16; ++r) { \
            _Pragma("unroll") for (int d0 = 0; d0 < DV32; ++d0) o[d0][r] *= rf; } resc = false; } } while (0)
#define EXP2(x) ((VAR & 1) ? (x) * 0.001f : __builtin_amdgcn_exp2f(x))
#define GB(Ox, PW, VL, VH, RD, S, e, C, crf) do { if (!(VAR & 512)) Ox = MF(VFR(VL, VH), __builtin_bit_cast(bf16x8, PW), Ox); RD; S[e] = EXP2(S[e]); S[e + 1] = EXP2(S[e + 1]); PIN(S); \
        if (!(VAR & 16)) { C[e] = fmamk<__builtin_bit_cast(unsigned, CRF(e) + (crf))>(sl_n, base_n); C[e + 1] = fmamk<__builtin_bit_cast(unsigned, CRF(e + 1) + (crf))>(sl_n, base_n); } PIN(C); SBAR(); } while (0)
#define PHASE_B(S0, S1, C0, C1) do { \
        GB(o[0], pw0, vl0, vh0, VRD(vl0, vh0, 4),  S0, 0,  C0, 0.f);  GB(o[0], pw1, vl1, vh1, VRD(vl1, vh1, 5),  S0, 2,  C0, 0.f); \
        GB(o[0], pw2, vl2, vh2, VRD(vl2, vh2, 6),  S0, 4,  C0, 0.f);  GB(o[0], pw3, vl3, vh3, VRD(vl3, vh3, 7),  S0, 6,  C0, 0.f); \
        GB(o[1], pw0, vl0, vh0, VRD(vl0, vh0, 8),  S0, 8,  C0, 0.f);  GB(o[1], pw1, vl1, vh1, VRD(vl1, vh1, 9),  S0, 10, C0, 0.f); \
        GB(o[1], pw2, vl2, vh2, VRD(vl2, vh2, 10), S0, 12, C0, 0.f);  GB(o[1], pw3, vl3, vh3, VRD(vl3, vh3, 11), S0, 14, C0, 0.f); \
        GB(o[2], pw0, vl0, vh0, VRD(vl0, vh0, 12), S1, 0,  C1, 32.f); GB(o[2], pw1, vl1, vh1, VRD(vl1, vh1, 13), S1, 2,  C1, 32.f); \
        GB(o[2], pw2, vl2, vh2, VRD(vl2, vh2, 14), S1, 4,  C1, 32.f); GB(o[2], pw3, vl3, vh3, VRD(vl3, vh3, 15), S1, 6,  C1, 32.f); \
        GB(o[3], pw0, vl0, vh0, KRN(kf0, 0),       S1, 8,  C1, 32.f); GB(o[3], pw1, vl1, vh1, KRN(kf1, 1),       S1, 10, C1, 32.f); \
        GB(o[3], pw2, vl2, vh2, KRN(kf2, 2),       S1, 12, C1, 32.f); GB(o[3], pw3, vl3, vh3, KRN(kf3, 3),       S1, 14, C1, 32.f); } while (0)
#define ROT3(s) ((s) == 2 ? 0 : (s) + 1)
#define ROT4(s) (((s) + 1) & 3)
#define STEP(S0, S1, P0, P1, it, CHK) do { \
        asm volatile("" : "+s"(sk), "+s"(sv)); \
        const int skm_ = (sk + 3) & 3, skp_ = ROT4(sk), svpp_ = sv == 0 ? 2 : sv - 1;   \
        const lds_cptr kp_ = kp0 + sk * KSLOT; const lds_cptr kn_ = kp0 + skp_ * KSLOT; const lds_cptr vp_ = vp0 + sv * KSLOT; \
        if (!(VAR & 8) && (it) + 3 < NT) DMA_K(TILE_OF((it) + 3), skm_); \
        SET_NEXT((it) + 1); SBAR(); \
        __builtin_amdgcn_s_setprio(1); PHASE_A(S0, S1, P0, P1); __builtin_amdgcn_s_setprio(0); \
        if (!(VAR & 8) && (it) + 1 < NT) DMA_V(TILE_OF((it) + 1), svpp_); \
        if (CHK) { DECIDE(S0, S1); if (resc) SET_NEXT((it) + 1); } SBAR(); \
        __builtin_amdgcn_s_setprio(1); PHASE_B(S0, S1, P0, P1); __builtin_amdgcn_s_setprio(0); \
        if (CHK) RESCALE_O(); sk = skp_; sv = ROT3(sv); } while (0)
    if (NT > 2) {
        { const lds_cptr kp_ = kp0 + 2 * KSLOT; const lds_cptr kn_ = kp0 + 3 * KSLOT;
          KRD(kf0, 0); KRD(kf1, 1); KRD(kf2, 2); KRD(kf3, 3);
          if (5 < NT) DMA_K(TILE_OF(5), 1); if (3 < NT) DMA_V(TILE_OF(3), 0);
          SET_NEXT(2); CINIT(xa0, xa1); SBAR();
          QK_ONLY(xa0, xa1);
          if (!nochk) { DECIDE(xa0, xa1); RESCALE_O(); }
#pragma unroll
          for (int r = 0; r < 16; ++r) { xa0[r] = EXP2(xa0[r]); xa1[r] = EXP2(xa1[r]); }
          SET_NEXT(3); CINIT(xb0, xb1);
          KRN(kf0, 0); KRN(kf1, 1); KRN(kf2, 2); KRN(kf3, 3); }
#define PIPE_LOOP(CHK_) do { \
        int it = 3, sk = 3, sv = 2; \
        _Pragma("unroll 1") \
        for (; it + 1 < NT; it += 2) { \
            if (!(VAR & 128)) { if (it + 2 < NT) { ATT_WAIT_BAR(4); } else { ATT_WAIT_BAR(2); } } \
            STEP(xb0, xb1, xa0, xa1, it, CHK_); \
            if (!(VAR & 128)) { if (it + 3 < NT) { ATT_WAIT_BAR(4); } else { ATT_WAIT_BAR(2); } } \
            STEP(xa0, xa1, xb0, xb1, it + 1, CHK_); \
        } \
        if (it < NT) { \
            ATT_WAIT_BAR(2); \
            STEP(xb0, xb1, xa0, xa1, it, CHK_); \
 \
            { float sacc = 0.f; \
        _Pragma("unroll") \
              for (int r = 0; r < 16; ++r) sacc += xb0[r] + xb1[r]; \
              l += sacc; \
              pw0 = (u32x4){cvtpk(xb0[0], xb0[1]), cvtpk(xb0[2], xb0[3]), cvtpk(xb0[4], xb0[5]), cvtpk(xb0[6], xb0[7])}; pw1 = (u32x4){cvtpk(xb0[8], xb0[9]), cvtpk(xb0[10], xb0[11]), cvtpk(xb0[12], xb0[13]), cvtpk(xb0[14], xb0[15])}; \
              pw2 = (u32x4){cvtpk(xb1[0], xb1[1]), cvtpk(xb1[2], xb1[3]), cvtpk(xb1[4], xb1[5]), cvtpk(xb1[6], xb1[7])}; pw3 = (u32x4){cvtpk(xb1[8], xb1[9]), cvtpk(xb1[10], xb1[11]), cvtpk(xb1[12], xb1[13]), cvtpk(xb1[14], xb1[15])}; } \
        } else { \
            { float sacc = 0.f; \
        _Pragma("unroll") \
              for (int r = 0; r < 16; ++r) sacc += xa0[r] + xa1[r]; \
              l += sacc; \
              pw0 = (u32x4){cvtpk(xa0[0], xa0[1]), cvtpk(xa0[2], xa0[3]), cvtpk(xa0[4], xa0[5]), cvtpk(xa0[6], xa0[7])}; pw1 = (u32x4){cvtpk(xa0[8], xa0[9]), cvtpk(xa0[10], xa0[11]), cvtpk(xa0[12], xa0[13]), cvtpk(xa0[14], xa0[15])}; \
              pw2 = (u32x4){cvtpk(xa1[0], xa1[1]), cvtpk(xa1[2], xa1[3]), cvtpk(xa1[4], xa1[5]), cvtpk(xa1[6], xa1[7])}; pw3 = (u32x4){cvtpk(xa1[8], xa1[9]), cvtpk(xa1[10], xa1[11]), cvtpk(xa1[12], xa1[13]), cvtpk(xa1[14], xa1[15])}; } \
        } \
    } while (0)
        PIPE_LOOP(!nochk);
#undef PIPE_LOOP
        ATT_WAIT_BAR(0);
        { const int sl_ = (NT - 1) % 3; const lds_cptr vp_ = vp0 + sl_ * KSLOT;
#pragma unroll
          for (int d0 = 0; d0 < DV32; ++d0) {
              VRD(vl0, vh0, d0 * 4); VRD(vl1, vh1, d0 * 4 + 1); VRD(vl2, vh2, d0 * 4 + 2); VRD(vl3, vh3, d0 * 4 + 3);
              o[d0] = MF(VFR(vl0, vh0), __builtin_bit_cast(bf16x8, pw0), o[d0]); o[d0] = MF(VFR(vl1, vh1), __builtin_bit_cast(bf16x8, pw1), o[d0]);
              o[d0] = MF(VFR(vl2, vh2), __builtin_bit_cast(bf16x8, pw2), o[d0]); o[d0] = MF(VFR(vl3, vh3), __builtin_bit_cast(bf16x8, pw3), o[d0]); } }
    }
#undef TILE_OF
#undef DMA_K
#undef DMA_V
#undef KRD
#undef VRD
#undef VFR
#undef SET_NEXT
#undef CINIT
#undef GA
#undef PHASE_A
#undef QK_ONLY
#undef DECIDE
#undef RESCALE_O
#undef EXP2
#undef GB
#undef PHASE_B
#undef STEP
#undef ROT3
#undef ROT4
#undef KRN
    l = swap_sum(l);
    const float rl = 1.f / l;
    LAS f32x4* cb4 = (LAS f32x4*)shm + qs * 1024 + lane;
    ATT_WAIT_BAR(0);
    if (VAR & 1024) { if (lane == 0 && rl == 12345.f) O[0] = 0; return; }
    if (cmap == 1) { const float rr = rl * dc.lam_full;
#pragma unroll
        for (int d0 = 0; d0 < DV32; ++d0)
#pragma unroll
            for (int g = 0; g < 4; ++g) cb4[(d0 * 4 + g) * 64] = (f32x4){o[d0][4 * g] * rr, o[d0][4 * g + 1] * rr, o[d0][4 * g + 2] * rr, o[d0][4 * g + 3] * rr};
    }
    ATT_WAIT_BAR(0);
    if (cmap == 0) {
        float ss = 0.f;
#pragma unroll
        for (int d0 = 0; d0 < DV32; ++d0)
#pragma unroll
            for (int g = 0; g < 4; ++g) { const f32x4 x = cb4[(d0 * 4 + g) * 64];
#pragma unroll
                for (int j = 0; j < 4; ++j) { const float v = o[d0][4 * g + j] * rl - x[j]; o[d0][4 * g + j] = v; ss += v * v; } }
        ss = swap_sum(ss);
        const float sc = __builtin_amdgcn_rsqf(ss * (1.f / 128.f) + 1e-5f);
        const LAS f32x4* gt4 = (const LAS f32x4*)(shm + 7 * KSLOT + 256) + hi;
        bf16_t* Ow = O + (size_t)(b * SEQ + iw + r32) * D + hh * 128 + 8 * hi;
#pragma unroll
        for (int d0 = 0; d0 < DV32; ++d0)
#pragma unroll
            for (int ge = 0; ge < 4; ge += 2) { const f32x4 ga = gt4[d0 * 8 + 2 * ge] * sc, gb = gt4[d0 * 8 + 2 * ge + 2] * sc; u32x2 A, B;
                A.x = cvtpk(o[d0][4 * ge] * ga.x, o[d0][4 * ge + 1] * ga.y); A.y = cvtpk(o[d0][4 * ge + 2] * ga.z, o[d0][4 * ge + 3] * ga.w);
                B.x = cvtpk(o[d0][4 * ge + 4] * gb.x, o[d0][4 * ge + 5] * gb.y); B.y = cvtpk(o[d0][4 * ge + 6] * gb.z, o[d0][4 * ge + 7] * gb.w);
                *(u32x4*)(Ow + d0 * 32 + 8 * ge) = pair_rows(A, B); }
    }
    asm volatile("s_waitcnt lgkmcnt(0)\n\ts_barrier" ::: "memory");
}
#undef SBAR
#undef PIN
#undef MF
#undef ATT_WAIT_BAR
}

typedef GAS unsigned gu32;
#define RLX_AGENT __ATOMIC_RELAXED, __HIP_MEMORY_SCOPE_AGENT
#define LDS_WAIT() asm volatile("s_waitcnt lgkmcnt(0)" ::: "memory")
#define VM_WAIT() asm volatile("s_waitcnt vmcnt(0)" ::: "memory")
#define XB_TMO      128
#define XB_XCNT(j)  (256  + 64 * (j))
#define XB_XSUB(j)  (1280 + 64 * (j))
#define XB_XGEN(j)  (2304 + 64 * (j))
#define XB_TOP      3328
#define XB_TOPGEN   3392
#define XCD_BAR_WORDS 3456
#define XB_SPIN_CAP (1u << 18)
__device__ __forceinline__ unsigned xb_ld(unsigned* p)              { return __hip_atomic_load(p, __ATOMIC_RELAXED, __HIP_MEMORY_SCOPE_AGENT); }
__device__ __forceinline__ unsigned xb_add(unsigned* p, unsigned v) { return __hip_atomic_fetch_add(p, v, __ATOMIC_RELAXED, __HIP_MEMORY_SCOPE_AGENT); }
__device__ __forceinline__ unsigned xb_xcc_id() { return (unsigned)__builtin_amdgcn_s_getreg((3 << 11) | 20) & 0xFu; }
#define XB_SPIN(cond, bar) do { unsigned _sp = 0; while (cond) { __builtin_amdgcn_s_sleep(1); \
    if ((++_sp & 255u) == 0u) { if (xb_ld(&(bar)[XB_TMO])) break; if (_sp > XB_SPIN_CAP) { atomicAdd(&(bar)[XB_TMO], 1u); break; } } } } while (0)
struct XcdBarrier { unsigned* bar; unsigned x; volatile LAS unsigned* st; };
__device__ __forceinline__ XcdBarrier xcd_barrier_post(unsigned* bar, volatile LAS unsigned* st, const bool leader) {
    XcdBarrier b; b.bar = bar; b.x = xb_xcc_id(); b.st = st;
    if (leader) (void)xb_add(&bar[XB_XCNT(b.x)], 1u);
    return b;
}
__device__ __forceinline__ void xcd_barrier_complete(unsigned* bar, unsigned x, unsigned& nloc, unsigned& nx) {
    const unsigned G = gridDim.x * gridDim.y * gridDim.z;
    unsigned sum, cnt, mine, sp = 0u;
    for (;;) {
        sum = 0u; cnt = 0u; mine = 0u;
#pragma unroll
        for (unsigned j = 0; j < 16; ++j) { const unsigned c = xb_ld(&bar[XB_XCNT(j)]); sum += c; cnt += (c > 0u) ? 1u : 0u; mine = (j == x) ? c : mine; }
        if (sum == G) break;
        __builtin_amdgcn_s_sleep(1);
        if ((++sp & 255u) == 0u) { if (xb_ld(&bar[XB_TMO])) break; if (sp > XB_SPIN_CAP) { atomicAdd(&bar[XB_TMO], 1u); break; } }
    }
    nloc = mine > 0u ? mine : 1u; nx = cnt > 0u ? cnt : 1u;
}
__device__ __forceinline__ void xcd_barrier(const XcdBarrier& b, const bool leader) {
    asm volatile("s_waitcnt vmcnt(0)" ::: "memory");
    __syncthreads();
    if (leader) {
        unsigned* bar = b.bar;
        __builtin_amdgcn_s_waitcnt(0);
        unsigned nloc = b.st[0], nx = b.st[1];
        if (nloc == 0u) { xcd_barrier_complete(bar, b.x, nloc, nx); b.st[0] = nloc; b.st[1] = nx; }
        const unsigned old = xb_add(&bar[XB_XSUB(b.x)], 1u);
        const unsigned gen = old / nloc;
        if (old + 1u == (gen + 1u) * nloc) {
            __builtin_amdgcn_fence(__ATOMIC_RELEASE, "agent");
            asm volatile("s_waitcnt vmcnt(0)" ::: "memory");
            const unsigned og = xb_add(&bar[XB_TOP], 1u);
            const unsigned tg = og / nx;
            if (og + 1u == (tg + 1u) * nx) xb_add(&bar[XB_TOPGEN], 1u);
            else XB_SPIN(xb_ld(&bar[XB_TOPGEN]) == tg, bar);
            __builtin_amdgcn_fence(__ATOMIC_ACQUIRE, "agent");
            xb_add(&bar[XB_XGEN(b.x)], 1u);
            asm volatile("s_waitcnt vmcnt(0)" ::: "memory");
        } else {
            XB_SPIN(xb_ld(&bar[XB_XGEN(b.x)]) == gen, bar);
            __builtin_amdgcn_fence(__ATOMIC_ACQUIRE, "agent");
            asm volatile("s_waitcnt vmcnt(0)" ::: "memory");
        }
    }
    __syncthreads();
}

struct Args { const float* in[18]; float* out; unsigned char* ws; int ph_lo, ph_hi, use_cg, pad; };
enum { I_X = 0, I_NMIX, I_NFFN, I_SWA_QKV, I_SWA_WO, I_SWA_SINK, I_DIFF_QKV, I_DIFF_WO, I_DIFF_LAM, I_DIFF_SUBLN, I_WG, I_BG, I_WR, I_BR, I_GATE, I_UP, I_DOWN, I_FNORM };
typedef const __attribute__((address_space(4))) Args* CArgs;
__device__ __forceinline__ CArgs kargs() { CArgs p = (CArgs)__builtin_amdgcn_kernarg_segment_ptr(); asm volatile("" : "+s"(p)); return p; }
__device__ __forceinline__ int vcu_of(int G) { const int bx = blockIdx.x; return (G % 8 == 0) ? (bx % 8) * (G / 8) + bx / 8 : bx; }

__device__ __forceinline__ void tr_item(const float* W, int N, int k0, int n0, bf16_t* dst, int ldd, LAS float* scr, int lane) {
    f32x4 v[8];
#pragma unroll
    for (int i = 0; i < 8; ++i) v[i] = *(const f32x4*)(W + (size_t)(k0 + 8 * i + (lane >> 3)) * N + n0 + (lane & 7) * 4);
#pragma unroll
    for (int i = 0; i < 8; ++i) { LAS float* p = scr + (8 * i + (lane >> 3)) * 33 + (lane & 7) * 4; p[0] = v[i].x; p[1] = v[i].y; p[2] = v[i].z; p[3] = v[i].w; }
    LDS_WAIT(); asm volatile("" ::: "memory");
    const int c = lane & 7;
#pragma unroll
    for (int j = 0; j < 4; ++j) { const int n = (lane >> 3) + 8 * j; const LAS float* s = scr + (8 * c) * 33 + n;
        u32x4 o; o.x = pk2(s[0 * 33], s[1 * 33]); o.y = pk2(s[2 * 33], s[3 * 33]); o.z = pk2(s[4 * 33], s[5 * 33]); o.w = pk2(s[6 * 33], s[7 * 33]);
        *(GAS u32x4*)(dst + (size_t)n * ldd + k0 + 8 * c) = o; }
    LDS_WAIT(); asm volatile("" ::: "memory");
}
__device__ __forceinline__ void rms_row_to_bf16(const float* xrow, const float* g, bf16_t* orow, int lane) {
    const GAS f32x4* xr = (const GAS f32x4*)xrow + lane; const GAS f32x4* gr = (const GAS f32x4*)g + lane;
    f32x4 v[4]; float s = 0.f;
#pragma unroll
    for (int j = 0; j < 4; ++j) { v[j] = xr[64 * j]; s += (v[j].x * v[j].x + v[j].y * v[j].y) + (v[j].z * v[j].z + v[j].w * v[j].w); }
    const float rstd = 1.f / sqrtf(wave_sum(s) * (1.f / D) + 1e-6f);
    GAS u32x2* o8 = (GAS u32x2*)orow + lane;
#pragma unroll
    for (int j = 0; j < 4; ++j) { const f32x4 gg = gr[64 * j]; u32x2 w; w.x = pk2(v[j].x * rstd * gg.x, v[j].y * rstd * gg.y); w.y = pk2(v[j].z * rstd * gg.z, v[j].w * rstd * gg.w); o8[64 * j] = w; }
}

__device__ __forceinline__ void phase_prologue(LAS unsigned char* lds_in, const int wave_in) {
    int lane = lane_id(); asm volatile("" : "+v"(lane)); int wave = wave_in; asm volatile("" : "+s"(wave)); LAS unsigned char* lds = lds_in; asm volatile("" : "+s"(lds));
    const CArgs a = kargs(); unsigned char* ws = a->ws;
    const int G = gridDim.x, vcu = vcu_of(G);
    LAS float* scr = (LAS float*)(lds + wave * 16384);
    const int gw = vcu * NWAVES + wave, NGW = G * NWAVES;
    bf16_t* swa_qkv_t = (bf16_t*)(ws + WS_SWA_QKV_T); bf16_t* swa_wo_t = (bf16_t*)(ws + WS_SWA_WO_T);
    bf16_t* diff_qkv_t = (bf16_t*)(ws + WS_DIFF_QKV_T); bf16_t* diff_wo_t = (bf16_t*)(ws + WS_DIFF_WO_T);
    constexpr int I0 = 16 * 48, I1 = 16 * 32, I2 = 16 * 96, I3 = 16 * 32, IM = 64 * 768, NITEMS = I0 + I1 + I2 + I3 + IM;
    struct TrItem { const float* src; int N; unsigned char* dstb; int ldb; int f8; };
    auto decode = [&](int it) -> TrItem {
        int r = it; const float* W; int N, k0, n0, ldd; bf16_t* dst; bf16_t* mbase = nullptr; int f8 = 0;
        if (r < I0) { const int kb = r / 48, nb = r % 48; W = a->in[I_SWA_QKV]; N = SWA_N; k0 = 64 * kb; n0 = 32 * nb; dst = swa_qkv_t + (size_t)n0 * D; ldd = D; mbase = swa_qkv_t; f8 = F8_QKV & 1; }
        else if ((r -= I0) < I1) { const int kb = r / 32, nb = r % 32; W = a->in[I_SWA_WO]; N = D; k0 = 64 * kb; n0 = 32 * nb; dst = swa_wo_t + (size_t)n0 * D; ldd = D; }
        else if ((r -= I1) < I2) { const int kb = r / 96, nb = r % 96; W = a->in[I_DIFF_QKV]; N = DIFF_N; k0 = 64 * kb; n0 = 32 * nb; dst = diff_qkv_t + (size_t)n0 * D; ldd = D; mbase = diff_qkv_t; f8 = (F8_QKV >> 1) & 1; }
        else if ((r -= I2) < I3) { const int kb = r / 32, nb = r % 32; W = a->in[I_DIFF_WO]; N = D; k0 = 64 * kb; n0 = 32 * nb; dst = diff_wo_t + (size_t)n0 * D; ldd = D; }
        else { r -= I3; const int le = r / 768, q = r % 768;
            bf16_t* gu = (bf16_t*)(ws + WS_WMOE + (size_t)le * 3 * MiB); bf16_t* dn = gu + (size_t)D * D;
            const bool l1 = le >= 32 || F8_L0;
            if (q < 256) { const int kb = q / 16, c0 = 32 * (q % 16); W = a->in[I_GATE] + (size_t)le * D * DEXP; N = DEXP; k0 = 64 * kb; n0 = c0; dst = gu + (size_t)((c0 >> 7) * 256 + (c0 & 127)) * D; ldd = D; mbase = gu; f8 = ((F8_STAGE & 2) && l1); }
            else if (q < 512) { const int qq = q - 256; const int kb = qq / 16, c0 = 32 * (qq % 16); W = a->in[I_UP] + (size_t)le * D * DEXP; N = DEXP; k0 = 64 * kb; n0 = c0; dst = gu + (size_t)((c0 >> 7) * 256 + 128 + (c0 & 127)) * D; ldd = D; mbase = gu; f8 = ((F8_STAGE & 2) && l1); }
            else { const int qq = q - 512; const int kb = qq / 32, nb = qq % 32; W = a->in[I_DOWN] + (size_t)le * DEXP * D; N = D; k0 = 64 * kb; n0 = 32 * nb; dst = dn + (size_t)n0 * DEXP; ldd = DEXP; mbase = dn; f8 = ((F8_STAGE & 1) && l1); } }
        TrItem t; t.src = W + (size_t)(k0 + (lane >> 3)) * N + n0 + (lane & 7) * 4; t.N = N; t.f8 = f8;
        t.dstb = f8 ? (unsigned char*)mbase + (size_t)(dst - mbase) + k0 + 8 * (lane & 7) : (unsigned char*)(dst + k0 + 8 * (lane & 7)); t.ldb = f8 ? ldd : 2 * ldd; return t;
    };
    {
        f32x4 va[8], vb[8]; TrItem ca, cb;
#define TR_LOAD(v, t) do { _Pragma("unroll") for (int i = 0; i < 8; ++i) v[i] = *(const f32x4*)((t).src + (size_t)(8 * i) * (t).N); } while (0)
#define TR_FINISH(v, t) do { \
            _Pragma("unroll") for (int i = 0; i < 8; ++i) { LAS float* p = scr + (8 * i + (lane >> 3)) * 33 + (lane & 7) * 4; p[0] = v[i].x; p[1] = v[i].y; p[2] = v[i].z; p[3] = v[i].w; } \
            LDS_WAIT(); asm volatile("" ::: "memory"); \
            if ((t).f8) { _Pragma("unroll") for (int j = 0; j < 4; ++j) { const int n = (lane >> 3) + 8 * j; const LAS float* s = scr + (8 * (lane & 7)) * 33 + n; \
                u32x2 o8; o8.x = pk4_fp8(64.f * s[0 * 33], 64.f * s[1 * 33], 64.f * s[2 * 33], 64.f * s[3 * 33]); o8.y = pk4_fp8(64.f * s[4 * 33], 64.f * s[5 * 33], 64.f * s[6 * 33], 64.f * s[7 * 33]); \
                *(GAS u32x2*)((t).dstb + (size_t)n * (t).ldb) = o8; } } \
            else { _Pragma("unroll") for (int j = 0; j < 4; ++j) { const int n = (lane >> 3) + 8 * j; const LAS float* s = scr + (8 * (lane & 7)) * 33 + n; \
                u32x4 o; o.x = pk2(s[0 * 33], s[1 * 33]); o.y = pk2(s[2 * 33], s[3 * 33]); o.z = pk2(s[4 * 33], s[5 * 33]); o.w = pk2(s[6 * 33], s[7 * 33]); \
                *(GAS u32x4*)((t).dstb + (size_t)n * (t).ldb) = o; } } \
            LDS_WAIT(); asm volatile("" ::: "memory"); } while (0)
        const int n_my = gw < NITEMS ? (NITEMS - gw + NGW - 1) / NGW : 0;
        if (n_my > 0) { ca = decode(gw); TR_LOAD(va, ca); }
#pragma unroll 1
        for (int j = 0; j < n_my; j += 2) {
            const int j1 = j + 1 < n_my ? j + 1 : n_my - 1, j2 = j + 2 < n_my ? j + 2 : n_my - 1;
            cb = decode(gw + j1 * NGW); TR_LOAD(vb, cb);
            TR_FINISH(va, ca);
            ca = decode(gw + j2 * NGW); TR_LOAD(va, ca);
            if (j + 1 < n_my) { TR_FINISH(vb, cb); }
        }
#undef TR_LOAD
#undef TR_FINISH
    }
    { bf16_t* wr_t = (bf16_t*)(ws + WS_WR); const int gt = gw * 64 + lane, NGT = NGW * 64;
      for (int i = gt; i < 2 * 36 * D; i += NGT) { const int l = i / (36 * D), rem = i % (36 * D), c = rem / D, k = rem % D;
          const float w = c < 4 ? a->in[I_WG][(size_t)l * D * 4 + k * 4 + c] : a->in[I_WR][(size_t)l * D * 32 + k * 32 + (c - 4)];
          const unsigned h = f2bf(w); const float r = w - __uint_as_float(h << 16);
          wr_t[(size_t)l * 2 * 36 * D + rem] = (bf16_t)h; wr_t[(size_t)l * 2 * 36 * D + 36 * D + rem] = (bf16_t)f2bf(r); } }
    bf16_t* XN = (bf16_t*)XNB(a);
#pragma unroll 1
    for (int mb = gw * 4; mb < M; mb += NGW * 4) {
        const float* xb = a->in[I_X] + (size_t)mb * D; const GAS f32x4* gr = (const GAS f32x4*)a->in[I_NMIX] + lane;
        f32x4 v[4][4];
#pragma unroll
        for (int r = 0; r < 4; ++r)
#pragma unroll
            for (int j = 0; j < 4; ++j) v[r][j] = ((const GAS f32x4*)(xb + (size_t)r * D) + lane)[64 * j];
        f32x4 gg[4];
#pragma unroll
        for (int j = 0; j < 4; ++j) gg[j] = gr[64 * j];
#pragma unroll
        for (int r = 0; r < 4; ++r) { float s = 0.f;
#pragma unroll
            for (int j = 0; j < 4; ++j) s += (v[r][j].x * v[r][j].x + v[r][j].y * v[r][j].y) + (v[r][j].z * v[r][j].z + v[r][j].w * v[r][j].w);
            const float rstd = 1.f / sqrtf(wave_sum(s) * (1.f / D) + 1e-6f);
            if (F8_QKV & 1) { GAS unsigned* o4 = (GAS unsigned*)((unsigned char*)XN + (size_t)(mb + r) * D) + lane;
#pragma unroll
                for (int j = 0; j < 4; ++j) { const f32x4 n = v[r][j] * (4.f * rstd) * gg[j]; o4[64 * j] = pk4_fp8(n.x, n.y, n.z, n.w); } }
            else { GAS u32x2* o8 = (GAS u32x2*)(XN + (size_t)(mb + r) * D) + lane;
#pragma unroll
                for (int j = 0; j < 4; ++j) { const f32x4 n = v[r][j] * rstd * gg[j]; u32x2 w; w.x = pk2(n.x, n.y); w.y = pk2(n.z, n.w); o8[64 * j] = w; } } }
    }
}

template <int RV, bool F8OUT>
__device__ __forceinline__ void phase_router(LAS unsigned char* lds_in, int layer, const int wave_in, const bool dry) {
    int lane = lane_id(); asm volatile("" : "+v"(lane)); int wave = wave_in; asm volatile("" : "+s"(wave)); LAS unsigned char* lds = lds_in; asm volatile("" : "+s"(lds));
    const CArgs a = kargs(); unsigned char* ws = a->ws;
    const int G = gridDim.x, vcu = vcu_of(G);
    const int gw = vcu * NWAVES + wave, NGW = G * NWAVES;
    const float* g = a->in[I_NFFN] + layer * D;
    const bf16_t* wth = (const bf16_t*)(ws + WS_WR) + (size_t)layer * 2 * 36 * D; const bf16_t* wtl = wth + 36 * D;
    const float* bg = a->in[I_BG] + layer * 4; const float* br = a->in[I_BR] + layer * 32;
    bf16_t* XN = (bf16_t*)(dry ? ws + WS_SCR : XNB(a)); const bf16_t* xin = (const bf16_t*)(ws + WS_XR); float* rstd_tok = (float*)(ws + (dry ? WS_SCR + 80 * MiB : WS_RSTD));
    unsigned* cnt = (unsigned*)(ws + WS_CTL) + CW_CNT + (dry ? 2 : layer) * 1024;
    int* ltok = (int*)(ws + (dry ? WS_SCR + 64 * MiB : WS_LTOK)); float* lw = (float*)(ws + (dry ? WS_SCR + 68 * MiB : WS_LW)); i32x4* tinfo = (i32x4*)(ws + (dry ? WS_SCR + 72 * MiB : WS_TINFO));
    LAS float* lgs = (LAS float*)(lds + 98304 + wave * 4096);
    LAS float* rsl = lgs + 768;
    const int row = lane & 15, kg = lane >> 4;
    const bool c2ok = row < 4;
    LAS unsigned* lcnt = (LAS unsigned*)(lds + TP_OFF); LAS unsigned* lbase = lcnt + 32;
    const int tid = wave * 64 + lane;
#pragma unroll 1
    for (int bt0 = 0; bt0 < M / 16; bt0 += NGW) {
        const int bt = bt0 + gw; const bool live = bt < M / 16;
        const int t0 = (live ? bt : 0) * 16;
        if (tid < 32) lcnt[tid] = 0u;
        const char* grow = (const char*)g + kg * 32;
        char* orow = (char*)(XN + (size_t)(t0 + row) * D) + kg * 16;
        const char* w0 = (const char*)(wth + (size_t)row * D) + kg * 16;
        f32x4 acc0 = {0.f, 0.f, 0.f, 0.f}, acc1 = acc0, acc2 = acc0; float ss = 0.f;
        const unsigned m2 = c2ok ? 0xffffffffu : 0u;
        {
            u32x4 xq[3] = {}; f32x4 ga[3] = {}, gb[3] = {};
            const char* xbase = (const char*)(xin + (size_t)t0 * D); const unsigned xoff = (unsigned)(row * D * 2 + kg * 16);
            const char* gbase = (const char*)g; const unsigned goff = (unsigned)(kg * 32);
            const char* wb0h = (const char*)wth; const char* wb0l = wb0h + 36 * D * 2; const char* wb1h = wb0h + 16 * D * 2; const char* wb1l = wb0h + 52 * D * 2;
            char* obase = live ? (char*)XN + (size_t)t0 * D * (F8OUT ? 1 : 2) : (char*)(ws + WS_SCR + 100 * MiB); const unsigned ooff = F8OUT ? (unsigned)(row * D + kg * 8) : (unsigned)(row * D * 2 + kg * 16);
            const unsigned woff = (unsigned)((row * D + kg * 8) * 2) + (unsigned)wave * 64u, woff2 = (unsigned)(((32 + (row & 3)) * D + kg * 8) * 2) + (unsigned)wave * 64u;
            LAS unsigned char* bfill = lds + wave * 6144 + lane * 16;
            const LAS unsigned char* bread = lds + lane * 16;
            u32x4 fr0, fr1, fr2, fr3, fr4, fr5;
#define RT_BLOAD(c) do { fr0 = *(const u32x4*)(wb0h + woff + (c) * 512); fr1 = *(const u32x4*)(wb0l + woff + (c) * 512); fr2 = *(const u32x4*)(wb1h + woff + (c) * 512); \
            fr3 = *(const u32x4*)(wb1l + woff + (c) * 512); fr4 = *(const u32x4*)(wb0h + woff2 + (c) * 512); fr5 = *(const u32x4*)(wb0l + woff2 + (c) * 512); } while (0)
#define RT_BWRITE(buf) do { fr4.x &= m2; fr4.y &= m2; fr4.z &= m2; fr4.w &= m2; fr5.x &= m2; fr5.y &= m2; fr5.z &= m2; fr5.w &= m2; \
            *(LAS u32x4*)(bfill + (buf) * 49152) = fr0; *(LAS u32x4*)(bfill + (buf) * 49152 + 1024) = fr1; *(LAS u32x4*)(bfill + (buf) * 49152 + 2048) = fr2; \
            *(LAS u32x4*)(bfill + (buf) * 49152 + 3072) = fr3; *(LAS u32x4*)(bfill + (buf) * 49152 + 4096) = fr4; *(LAS u32x4*)(bfill + (buf) * 49152 + 5120) = fr5; } while (0)
#define RT_BAR() asm volatile("s_waitcnt lgkmcnt(0)\n\ts_barrier" ::: "memory")
#define RT_LOAD(st, s) do { if (!(RV & 2)) { xq[st] = *(const u32x4*)(xbase + xoff + (s) * 64); } \
            ga[st] = *(const f32x4*)(gbase + goff + (s) * 128); gb[st] = *(const f32x4*)(gbase + goff + (s) * 128 + 16); } while (0)
            RT_BLOAD(0); RT_LOAD(0, 0); RT_LOAD(1, 1);
            RT_BWRITE(0); RT_BLOAD(1);
            RT_BAR();
#pragma unroll
            for (int s = 0; s < 32; ++s) {
                const int st = s % 3, c = s >> 3, sl = s & 7;
                if (sl == 0 && c + 1 < 4) { RT_BWRITE((c + 1) & 1); if (c + 2 < 4) { RT_BLOAD(c + 2); } }
                if (s + 2 < 32) { RT_LOAD((s + 2) % 3, s + 2); }
                __builtin_amdgcn_sched_barrier(0);
                const LAS unsigned char* bp = bread + (c & 1) * 49152 + sl * 6144;
                const bf16x8 b0h = *(const LAS bf16x8*)(bp), b0l = *(const LAS bf16x8*)(bp + 1024), b1h = *(const LAS bf16x8*)(bp + 2048), b1l = *(const LAS bf16x8*)(bp + 3072),
                             b2h = *(const LAS bf16x8*)(bp + 4096), b2l = *(const LAS bf16x8*)(bp + 5120);
                const u32x4 xq_ = xq[st];
                const f32x4 xa_ = {__uint_as_float(xq_.x << 16), __uint_as_float(xq_.x & 0xffff0000u), __uint_as_float(xq_.y << 16), __uint_as_float(xq_.y & 0xffff0000u)};
                const f32x4 xb_ = {__uint_as_float(xq_.z << 16), __uint_as_float(xq_.z & 0xffff0000u), __uint_as_float(xq_.w << 16), __uint_as_float(xq_.w & 0xffff0000u)};
                ss += (xa_.x * xa_.x + xa_.y * xa_.y) + (xa_.z * xa_.z + xa_.w * xa_.w) + (xb_.x * xb_.x + xb_.y * xb_.y) + (xb_.z * xb_.z + xb_.w * xb_.w);
                const f32x4 ya = xa_ * ga[st], yb = xb_ * gb[st];
                u32x4 hi; hi.x = cvtpk(ya.x, ya.y); hi.y = cvtpk(ya.z, ya.w); hi.z = cvtpk(yb.x, yb.y); hi.w = cvtpk(yb.z, yb.w);
                u32x4 lo; lo.x = cvtpk(ya.x - __uint_as_float(hi.x << 16), ya.y - __uint_as_float(hi.x & 0xffff0000u)); lo.y = cvtpk(ya.z - __uint_as_float(hi.y << 16), ya.w - __uint_as_float(hi.y & 0xffff0000u));
                lo.z = cvtpk(yb.x - __uint_as_float(hi.z << 16), yb.y - __uint_as_float(hi.z & 0xffff0000u)); lo.w = cvtpk(yb.z - __uint_as_float(hi.w << 16), yb.w - __uint_as_float(hi.w & 0xffff0000u));
                if constexpr (F8OUT) { u32x2 q8; q8.x = pk4_fp8(4.f * ya.x, 4.f * ya.y, 4.f * ya.z, 4.f * ya.w); q8.y = pk4_fp8(4.f * yb.x, 4.f * yb.y, 4.f * yb.z, 4.f * yb.w); *(u32x2*)(obase + ooff + s * 32) = q8; }
                else if (!(RV & 1)) *(u32x4*)(obase + ooff + s * 64) = hi;
                const bf16x8 ah = __builtin_bit_cast(bf16x8, hi), al = __builtin_bit_cast(bf16x8, lo);
                acc0 = __builtin_amdgcn_mfma_f32_16x16x32_bf16(ah, b0h, acc0, 0, 0, 0); acc0 = __builtin_amdgcn_mfma_f32_16x16x32_bf16(ah, b0l, acc0, 0, 0, 0); acc0 = __builtin_amdgcn_mfma_f32_16x16x32_bf16(al, b0h, acc0, 0, 0, 0);
                acc1 = __builtin_amdgcn_mfma_f32_16x16x32_bf16(ah, b1h, acc1, 0, 0, 0); acc1 = __builtin_amdgcn_mfma_f32_16x16x32_bf16(ah, b1l, acc1, 0, 0, 0); acc1 = __builtin_amdgcn_mfma_f32_16x16x32_bf16(al, b1h, acc1, 0, 0, 0);
                acc2 = __builtin_amdgcn_mfma_f32_16x16x32_bf16(ah, b2h, acc2, 0, 0, 0); acc2 = __builtin_amdgcn_mfma_f32_16x16x32_bf16(ah, b2l, acc2, 0, 0, 0); acc2 = __builtin_amdgcn_mfma_f32_16x16x32_bf16(al, b2h, acc2, 0, 0, 0);
                __builtin_amdgcn_sched_barrier(0);
                if (sl == 7 && c + 1 < 4) { RT_BAR(); }
            }
            RT_BAR();
#undef RT_LOAD
#undef RT_BLOAD
#undef RT_BWRITE
#undef RT_BAR
        }
        ss += __shfl_xor(ss, 16); ss += __shfl_xor(ss, 32);
        const float rstd = 1.f / sqrtf(ss * (1.f / D) + 1e-6f);
        if (kg == 0) { rsl[row] = rstd; if (live) rstd_tok[t0 + row] = rstd; }
#pragma unroll
        for (int j = 0; j < 4; ++j) { lgs[(4 * kg + j) * 48 + row] = acc0[j]; lgs[(4 * kg + j) * 48 + 16 + row] = acc1[j]; lgs[(4 * kg + j) * 48 + 32 + row] = acc2[j]; }
        LDS_WAIT(); asm volatile("" ::: "memory");
        int e1 = 0, e2 = 0, lp1 = 0, lp2 = 0; float w1 = 0.f, w2 = 0.f;
        const bool act = live && lane < 16 && !(RV & 4);
        __syncthreads();
        if (act) {
            const float rs = rsl[lane];
            float acc[36];
#pragma unroll
            for (int q = 0; q < 9; ++q) { const f32x4 x = *(const LAS f32x4*)(lgs + lane * 48 + 4 * q); acc[4 * q] = x.x * rs; acc[4 * q + 1] = x.y * rs; acc[4 * q + 2] = x.z * rs; acc[4 * q + 3] = x.w * rs; }
            float lgv[4]; int gs = 0;
#pragma unroll
            for (int c = 0; c < 4; ++c) lgv[c] = acc[c] + bg[c];
            float mx = lgv[0];
#pragma unroll
            for (int c = 1; c < 4; ++c) if (lgv[c] > mx) { mx = lgv[c]; gs = c; }
            float den = 0.f;
#pragma unroll
            for (int c = 0; c < 4; ++c) den += __expf(lgv[c] - mx);
            const float pg = 1.f / den;
            float le[8];
#pragma unroll
            for (int k = 0; k < 8; ++k) { const float a0 = acc[4 + k] + br[k], a1 = acc[12 + k] + br[8 + k], a2 = acc[20 + k] + br[16 + k], a3 = acc[28 + k] + br[24 + k];
                le[k] = gs == 0 ? a0 : (gs == 1 ? a1 : (gs == 2 ? a2 : a3)); }
            int i1 = 0; float m1 = le[0];
#pragma unroll
            for (int k = 1; k < 8; ++k) if (le[k] > m1) { m1 = le[k]; i1 = k; }
            int i2 = -1; float m2 = -INFINITY;
#pragma unroll
            for (int k = 0; k < 8; ++k) if (k != i1 && (i2 < 0 || le[k] > m2)) { m2 = le[k]; i2 = k; }
            const float ex = __expf(m2 - m1); const float tp1 = 1.f / (1.f + ex), tp2 = ex * tp1;
            w1 = pg * tp1; w2 = pg * tp2; e1 = gs * 8 + i1; e2 = gs * 8 + i2;
            lp1 = (int)__hip_atomic_fetch_add(lcnt + e1, 1u, __ATOMIC_RELAXED, __HIP_MEMORY_SCOPE_WORKGROUP);
            lp2 = (int)__hip_atomic_fetch_add(lcnt + e2, 1u, __ATOMIC_RELAXED, __HIP_MEMORY_SCOPE_WORKGROUP);
        }
        __syncthreads();
        if (tid < 32) { const unsigned c = lcnt[tid]; lbase[tid] = c ? __hip_atomic_fetch_add(cnt + 32 * tid, c, __ATOMIC_RELAXED, __HIP_MEMORY_SCOPE_AGENT) : 0u; }
        __syncthreads();
        if (act) {
            const int t = t0 + lane; const int p1 = (int)lbase[e1] + lp1, p2 = (int)lbase[e2] + lp2;
            ltok[(size_t)e1 * M + p1] = t; lw[(size_t)e1 * M + p1] = w1; ltok[(size_t)e2 * M + p2] = t; lw[(size_t)e2 * M + p2] = w2;
            tinfo[t] = (i32x4){e1, p1, e2, p2};
        }
        LDS_WAIT(); asm volatile("" ::: "memory");
        __syncthreads();
    }
}

__device__ __forceinline__ void moe_tables(LAS unsigned char* lds, unsigned char* ws, int layer, const int wave, const int lane) {
    LAS int* TP = (LAS int*)(lds + TP_OFF); LAS int* CNT = TP + 40;
    unsigned* cnt = (unsigned*)(ws + WS_CTL) + CW_CNT + layer * 1024;
    const int tid = wave * 64 + lane;
    __syncthreads();
    if (tid < 32) CNT[tid] = (int)__hip_atomic_load(cnt + 32 * tid, RLX_AGENT);
    __syncthreads();
    if (tid == 0) { int s = 0; for (int e = 0; e < 32; ++e) { TP[e] = s; s += (CNT[e] + 255) >> 8; } TP[32] = s; }
    __syncthreads();
}

__device__ __forceinline__ void phase_combine(LAS unsigned char* lds_in, int layer, const int wave_in, const bool dry) {
    int lane = lane_id(); asm volatile("" : "+v"(lane)); int wave = wave_in; asm volatile("" : "+s"(wave)); LAS unsigned char* lds = lds_in; asm volatile("" : "+s"(lds));
    const CArgs a = kargs(); unsigned char* ws = a->ws;
    moe_tables(lds, ws, layer, wave, lane);
    const bool final_ = layer == 1; const float* gnext = layer == 0 ? a->in[I_NMIX] + D : a->in[I_FNORM]; float* xout = a->out; bf16_t* xr16 = (bf16_t*)(ws + WS_XR);
    const int G = gridDim.x, vcu = vcu_of(G);
    const int gw = vcu * NWAVES + wave, NGW = G * NWAVES;
    const LAS int* TP = (const LAS int*)(lds + TP_OFF);
    const bf16_t* Y = (const bf16_t*)(ws + WS_Y); const i32x4* tinfo = (const i32x4*)(ws + WS_TINFO); bf16_t* XN = (bf16_t*)XNB(a);
#pragma unroll 1
    for (int tb = gw * 4; tb < M; tb += NGW * 4) {
        size_t s1[4], s2[4];
#pragma unroll
        for (int r = 0; r < 4; ++r) { const i32x4 ti = tinfo[tb + r]; s1[r] = (size_t)TP[ti.x] * 256 + ti.y; s2[r] = (size_t)TP[ti.z] * 256 + ti.w; }
        f32x4 v[4][4]; u32x2 p[4][4], q[4][4], xv[4][4];
#pragma unroll
        for (int r = 0; r < 4; ++r) {
            const GAS u32x2* xr = (const GAS u32x2*)(xr16 + (size_t)(tb + r) * D) + lane;
            const GAS u32x2* y1 = (const GAS u32x2*)(Y + s1[r] * D) + lane; const GAS u32x2* y2 = (const GAS u32x2*)(Y + s2[r] * D) + lane;
#pragma unroll
            for (int j = 0; j < 4; ++j) { xv[r][j] = xr[64 * j]; p[r][j] = y1[64 * j]; q[r][j] = y2[64 * j]; }
        }
        f32x4 gg[4];
#pragma unroll
        for (int j = 0; j < 4; ++j) gg[j] = ((const GAS f32x4*)gnext + lane)[64 * j];
#pragma unroll
        for (int r = 0; r < 4; ++r) {
            float s = 0.f;
#pragma unroll
            for (int j = 0; j < 4; ++j) { const u32x2 pp = p[r][j], qq = q[r][j], xx = xv[r][j];
                v[r][j] = (f32x4){__uint_as_float(xx.x << 16), __uint_as_float(xx.x & 0xffff0000u), __uint_as_float(xx.y << 16), __uint_as_float(xx.y & 0xffff0000u)};
                f32x4 ya, yb; ya.x = __uint_as_float(pp.x << 16); ya.y = __uint_as_float(pp.x & 0xffff0000u); ya.z = __uint_as_float(pp.y << 16); ya.w = __uint_as_float(pp.y & 0xffff0000u);
                yb.x = __uint_as_float(qq.x << 16); yb.y = __uint_as_float(qq.x & 0xffff0000u); yb.z = __uint_as_float(qq.y << 16); yb.w = __uint_as_float(qq.y & 0xffff0000u);
                v[r][j] = v[r][j] + (ya + yb); s += (v[r][j].x * v[r][j].x + v[r][j].y * v[r][j].y) + (v[r][j].z * v[r][j].z + v[r][j].w * v[r][j].w); }
            const float rstd = 1.f / sqrtf(wave_sum(s) * (1.f / D) + 1e-6f);
            GAS f32x4* xw = (GAS f32x4*)(xout + (size_t)(tb + r) * D) + lane; GAS u32x2* xw16 = (GAS u32x2*)(xr16 + (size_t)(tb + r) * D) + lane;
            if (final_) {
#pragma unroll
                for (int j = 0; j < 4; ++j) if (!dry) xw[64 * j] = v[r][j] * rstd * gg[j];
            } else {
                if (F8_QKV & 2) { GAS unsigned* o4 = (GAS unsigned*)((unsigned char*)XN + (size_t)(tb + r) * D) + lane;
#pragma unroll
                    for (int j = 0; j < 4; ++j) { if (!dry) { u32x2 w; w.x = pk2(v[r][j].x, v[r][j].y); w.y = pk2(v[r][j].z, v[r][j].w); xw16[64 * j] = w; } const f32x4 n = v[r][j] * (4.f * rstd) * gg[j]; o4[64 * j] = pk4_fp8(n.x, n.y, n.z, n.w); } }
                else { GAS u32x2* o8 = (GAS u32x2*)(XN + (size_t)(tb + r) * D) + lane;
#pragma unroll
                    for (int j = 0; j < 4; ++j) { if (!dry) { u32x2 w; w.x = pk2(v[r][j].x, v[r][j].y); w.y = pk2(v[r][j].z, v[r][j].w); xw16[64 * j] = w; } const f32x4 n = v[r][j] * rstd * gg[j]; u32x2 w; w.x = pk2(n.x, n.y); w.y = pk2(n.z, n.w); o8[64 * j] = w; } }
            }
        }
    }
}

__device__ __forceinline__ float diff_lambda_full(const float* lam, int lane) {
    const float a = wave_sum(lam[lane] * lam[64 + lane]), b = wave_sum(lam[128 + lane] * lam[192 + lane]);
    return __expf(a) - __expf(b) + LAMBDA_INIT;
}

__device__ __forceinline__ void phase_qkv(LAS unsigned char* lds_in, int layer, const int wave_in) {
    int lane = lane_id(); asm volatile("" : "+v"(lane)); int wave = wave_in; asm volatile("" : "+s"(wave)); LAS unsigned char* lds = lds_in; asm volatile("" : "+s"(lds));
    const CArgs a = kargs(); unsigned char* ws = a->ws;
    const int N = layer == 0 ? SWA_N : DIFF_N;
    pg8::DenseOrder S; S.init(M, N, (int)gridDim.x, (int)blockIdx.x);
    pg8::EpiQKV E{(bf16_t*)(ws + WS_QKV), N, 1024, QSCALE, layer == 1 ? (unsigned*)(ws + WS_CTL) + CW_KMAX : nullptr};
    if ((F8_QKV >> layer) & 1) { pg8::Gemm g{(const bf16_t*)XNB(a), (const bf16_t*)(ws + (layer == 0 ? WS_SWA_QKV_T : WS_DIFF_QKV_T)), D / 2, 0x79797979u, 0x7d7d7d7du};
        pg8::gemm_phase<pg8::EpiQKV, pg8::DenseOrder, false, true, true>(lds, g, S, E, wave, lane); }
    else { pg8::Gemm g{(const bf16_t*)XNB(a), (const bf16_t*)(ws + (layer == 0 ? WS_SWA_QKV_T : WS_DIFF_QKV_T)), D};
        pg8::gemm_phase<pg8::EpiQKV, pg8::DenseOrder, false, true>(lds, g, S, E, wave, lane); }
}
__device__ __forceinline__ void phase_oproj(LAS unsigned char* lds_in, int layer, const int wave_in) {
    int lane = lane_id(); asm volatile("" : "+v"(lane)); int wave = wave_in; asm volatile("" : "+s"(wave)); LAS unsigned char* lds = lds_in; asm volatile("" : "+s"(lds));
    const CArgs a = kargs(); unsigned char* ws = a->ws;
    pg8::Gemm g{(const bf16_t*)(ws + WS_O), (const bf16_t*)(ws + (layer == 0 ? WS_SWA_WO_T : WS_DIFF_WO_T)), D};
    pg8::DenseOrder S; S.init(M, D, (int)gridDim.x, (int)blockIdx.x);
    pg8::EpiResid E{layer == 0 ? a->in[I_X] : nullptr, (const bf16_t*)(ws + WS_XR), (bf16_t*)(ws + WS_XR)};
    pg8::gemm_phase<pg8::EpiResid, pg8::DenseOrder, false, true>(lds, g, S, E, wave, lane);
}
__device__ __forceinline__ void phase_moe1(LAS unsigned char* lds_in, int layer, const int wave_in) {
    int lane = lane_id(); asm volatile("" : "+v"(lane)); int wave = wave_in; asm volatile("" : "+s"(wave)); LAS unsigned char* lds = lds_in; asm volatile("" : "+s"(lds));
    const CArgs a = kargs(); unsigned char* ws = a->ws;
    moe_tables(lds, ws, layer, wave, lane);
    const LAS int* TP = (const LAS int*)(lds + TP_OFF); const LAS int* CNT = TP + 40;
    if ((F8_STAGE & 2) && (layer == 1 || F8_L0)) {
        pg8::Gemm g{(const bf16_t*)XNB(a), (const bf16_t*)(ws + WS_WMOE + (size_t)layer * 96 * MiB), D / 2, 0x79797979u, 0x7d7d7d7du};
        pg8::MoeOrder S{TP, CNT, (const int*)(ws + WS_LTOK), (int)gridDim.x, (int)blockIdx.x, 12, 0};
        if (F8_STAGE & 1) { pg8::EpiSwiGLU<true> E{(bf16_t*)(ws + WS_H), (const int*)(ws + WS_LTOK), (const float*)(ws + WS_RSTD), CNT};
            pg8::gemm_phase<pg8::EpiSwiGLU<true>, pg8::MoeOrder, true, true, true>(lds, g, S, E, wave, relaunder(lane)); }
        else { pg8::EpiSwiGLU<false> E{(bf16_t*)(ws + WS_H), (const int*)(ws + WS_LTOK), (const float*)(ws + WS_RSTD), CNT};
            pg8::gemm_phase<pg8::EpiSwiGLU<false>, pg8::MoeOrder, true, true, true>(lds, g, S, E, wave, relaunder(lane)); }
    } else if ((F8_STAGE & 1) && layer == 1) {
        pg8::Gemm g{(const bf16_t*)XNB(a), (const bf16_t*)(ws + WS_WMOE + (size_t)layer * 96 * MiB), D};
        pg8::MoeOrder S{TP, CNT, (const int*)(ws + WS_LTOK), (int)gridDim.x, (int)blockIdx.x, 6, 0};
        pg8::EpiSwiGLU<true> E{(bf16_t*)(ws + WS_H), (const int*)(ws + WS_LTOK), (const float*)(ws + WS_RSTD), CNT};
        pg8::gemm_phase<pg8::EpiSwiGLU<true>, pg8::MoeOrder, true, true>(lds, g, S, E, wave, relaunder(lane));
    } else {
        pg8::Gemm g{(const bf16_t*)XNB(a), (const bf16_t*)(ws + WS_WMOE + (size_t)layer * 96 * MiB), D};
        pg8::MoeOrder S{TP, CNT, (const int*)(ws + WS_LTOK), (int)gridDim.x, (int)blockIdx.x, 6, 0};
        pg8::EpiSwiGLU<false> E{(bf16_t*)(ws + WS_H), (const int*)(ws + WS_LTOK), (const float*)(ws + WS_RSTD), CNT};
        pg8::gemm_phase<pg8::EpiSwiGLU<false>, pg8::MoeOrder, true, true>(lds, g, S, E, wave, relaunder(lane));
    }
}
__device__ __forceinline__ void phase_moe2(LAS unsigned char* lds_in, int layer, const int wave_in) {
    int lane = lane_id(); asm volatile("" : "+v"(lane)); int wave = wave_in; asm volatile("" : "+s"(wave)); LAS unsigned char* lds = lds_in; asm volatile("" : "+s"(lds));
    const CArgs a = kargs(); unsigned char* ws = a->ws;
    moe_tables(lds, ws, layer, wave, lane);
    const LAS int* TP = (const LAS int*)(lds + TP_OFF); const LAS int* CNT = TP + 40;
    pg8::EpiDown E{(bf16_t*)(ws + WS_Y), (const float*)(ws + WS_LW)};
    if ((F8_STAGE & 1) && layer == 1) {
        pg8::Gemm g{(const bf16_t*)(ws + WS_H), (const bf16_t*)(ws + WS_WMOE + (size_t)layer * 96 * MiB), DEXP / 2, 0x79797979u, 0x7c7c7c7cu};
        pg8::MoeOrder S{TP, CNT, (const int*)(ws + WS_LTOK), (int)gridDim.x, (int)blockIdx.x, 24, 16};
        pg8::gemm_phase<pg8::EpiDown, pg8::MoeOrder, false, true, true>(lds, g, S, E, wave, relaunder(lane));
    } else {
        pg8::Gemm g{(const bf16_t*)(ws + WS_H), (const bf16_t*)(ws + WS_WMOE + (size_t)layer * 96 * MiB), DEXP};
        pg8::MoeOrder S{TP, CNT, (const int*)(ws + WS_LTOK), (int)gridDim.x, (int)blockIdx.x, 12, 8};
        pg8::gemm_phase<pg8::EpiDown, pg8::MoeOrder, false, true>(lds, g, S, E, wave, relaunder(lane));
    }
}
__device__ __forceinline__ void phase_attn(LAS unsigned char* lds_in, int layer, const int wave_in, const bool dry) {
    int lane = lane_id(); asm volatile("" : "+v"(lane)); int wave = wave_in; asm volatile("" : "+s"(wave)); LAS unsigned char* lds = lds_in; asm volatile("" : "+s"(lds));
    const CArgs a = kargs(); unsigned char* ws = a->ws;
    const int G = gridDim.x, vcu = vcu_of(G);
    const bf16_t* QKV = (const bf16_t*)(ws + WS_QKV); bf16_t* OB = (bf16_t*)(ws + WS_O);
    if (layer == 0) {
        att::DiffConsts dc{0.f, nullptr}; const float* sink = a->in[I_SWA_SINK];
#pragma unroll 1
        for (int i = 0; i < 2048; ++i) { const int id = vcu + G * i; if (id >= 2048) break; const int bk = id >> 7, qb = id & 127;
            att::attn_unit<0>(bk >> 2, bk & 3, qb, QKV, OB, sink, dc, lds, wave, lane); }
    } else {
        att::DiffConsts dc{diff_lambda_full(a->in[I_DIFF_LAM], lane), a->in[I_DIFF_SUBLN]};
        if (wave == 0) { LAS float* gt = (LAS float*)(lds + 7 * 16384 + 256); const float sgs = 1.f - LAMBDA_INIT;
            gt[lane] = a->in[I_DIFF_SUBLN][lane] * sgs; gt[64 + lane] = a->in[I_DIFF_SUBLN][64 + lane] * sgs; }
        const unsigned* kmaxsq = (const unsigned*)(ws + WS_CTL) + CW_KMAX;
#pragma unroll 1
        for (int i = 0; i < 2048; ++i) { const int id = vcu + G * i; if (id >= 2048) break; const int h = id >> 8, bq = id & 255, b = bq >> 6;
            const int qb = ((0xD8 >> h) & 1) ? ((bq + 32) & 63) : (bq & 63);
            const int cm = wave >> 2, gi = b * 32 + 2 * (2 * h + cm);
            const float kmax = sqrtf(__uint_as_float(__hip_atomic_load(kmaxsq + gi, RLX_AGENT)) + __uint_as_float(__hip_atomic_load(kmaxsq + gi + 1, RLX_AGENT))) * 1.01f;
            if (ATT_PROBE_VARIANT != 0 && dry) att::diff_unit<ATT_PROBE_VARIANT>(b, h, qb, QKV, (bf16_t*)XNB(a), kmax, dc, lds, wave, lane);
            else att::diff_unit<0>(b, h, qb, QKV, OB, kmax, dc, lds, wave, lane); }
    }
}

__global__ void __launch_bounds__(NWAVES * 64, 2) mega_fwd(Args args_by_value) {
    extern __shared__ __attribute__((aligned(16))) unsigned char lds_raw[];
    LAS unsigned char* lds = (LAS unsigned char*)lds_raw;
    const int wave = __builtin_amdgcn_readfirstlane((int)(threadIdx.x >> 6));
    int lo, hi;
    { const CArgs a = kargs(); lo = a->ph_lo; hi = a->ph_hi;
      if (a->use_cg) cg::this_grid().sync(); }
    { const int tid = wave * 64 + lane_id();
      for (int u = tid; u < (LDS_BYTES - LDSCTL_OFF) / 4; u += NWAVES * 64) ((LAS unsigned*)(lds + LDSCTL_OFF))[u] = 0u; }
    __syncthreads();
    if (N_LAUNCHES == 1) { const CArgs a = kargs(); (void)xcd_barrier_post((unsigned*)(a->ws + WS_CTL) + CW_BAR, (volatile LAS unsigned*)(lds + MISC_OFF) + 8, wave == 0 && lane_id() == 0); }
    int rep_left = REP_COUNT;
    unsigned long long tp_prev = 0, tp_acc = 0;
    if (TPROBE_MASK != 0) tp_prev = __builtin_amdgcn_s_memrealtime();
#pragma unroll 1
    for (int ph = lo; ph < hi; ++ph) {
        const int layer = ph >= 8 ? 1 : 0, kind = ph == 0 ? 0 : ph - 7 * layer;
        const bool dry = REP_COUNT > 0 && ph == REP_PHASE && rep_left > 0;
        switch (kind) {
            case 0: phase_prologue(lds, wave); break;
            case 1: phase_qkv(lds, layer, wave); break;
            case 2: phase_attn(lds, layer, wave, dry); break;
            case 3: phase_oproj(lds, layer, wave); break;
            case 4: if (ROUTER_PROBE != 0 && dry) phase_router<ROUTER_PROBE, false>(lds, layer, wave, dry); else if ((F8_STAGE & 2) && (layer == 1 || F8_L0)) phase_router<0, true>(lds, layer, wave, dry); else phase_router<0, false>(lds, layer, wave, dry); break;
            case 5: phase_moe1(lds, layer, wave); break;
            case 6: phase_moe2(lds, layer, wave); break;
            default: phase_combine(lds, layer, wave, dry); break;
        }
        if (ph + 1 < hi) { const CArgs a = kargs(); XcdBarrier bar; bar.bar = (unsigned*)(a->ws + WS_CTL) + CW_BAR; bar.x = xb_xcc_id(); bar.st = (volatile LAS unsigned*)(lds + MISC_OFF) + 8;
            xcd_barrier(bar, wave == 0 && lane_id() == 0);
        }
        if (TPROBE_MASK != 0) { const unsigned long long tn = __builtin_amdgcn_s_memrealtime(); if ((TPROBE_MASK >> ph) & 1) tp_acc += tn - tp_prev; tp_prev = tn; }
        if (REP_COUNT > 0 && ph == REP_PHASE && rep_left > 0) { --rep_left; --ph; }
        if (EXTRA_BARRIERS > 0 && ph == 3) { for (int xb = 0; xb < EXTRA_BARRIERS; ++xb) { const CArgs a = kargs(); XcdBarrier bar; bar.bar = (unsigned*)(a->ws + WS_CTL) + CW_BAR; bar.x = xb_xcc_id(); bar.st = (volatile LAS unsigned*)(lds + MISC_OFF) + 8; xcd_barrier(bar, wave == 0 && lane_id() == 0); } }
    }
    if (TPROBE_MASK != 0 && blockIdx.x == 0 && wave == 0) { const unsigned long long t0 = __builtin_amdgcn_s_memrealtime(); while (__builtin_amdgcn_s_memrealtime() - t0 < TPROBE_K * tp_acc) __builtin_amdgcn_s_sleep(8); }
}

extern "C" void kernel_launch(void* const* d_in, const int* in_sizes, int n_in, void* d_out, int out_size, void* d_ws, size_t ws_size, hipStream_t stream) {
    static int grid = 0;
    if (grid == 0) {
        if (n_in != 18 || in_sizes[0] != M * D || out_size != M * D || ws_size < WS_END) {
            fprintf(stderr, "kernel_launch: unexpected shapes: n_in %d in0 %d out %d ws %zu (need %zu)\n", n_in, n_in > 0 ? in_sizes[0] : -1, out_size, ws_size, (size_t)WS_END); grid = -1; return; }
        int dev = 0, cus = 0, per_cu = 0;
        if (hipGetDevice(&dev) != hipSuccess || hipDeviceGetAttribute(&cus, hipDeviceAttributeMultiprocessorCount, dev) != hipSuccess) { fprintf(stderr, "kernel_launch: device query failed\n"); grid = -1; return; }
        if (hipFuncSetAttribute((const void*)mega_fwd, hipFuncAttributeMaxDynamicSharedMemorySize, LDS_BYTES) != hipSuccess) { fprintf(stderr, "kernel_launch: hipFuncSetAttribute failed\n"); grid = -1; return; }
        if (hipOccupancyMaxActiveBlocksPerMultiprocessor(&per_cu, (const void*)mega_fwd, NWAVES * 64, LDS_BYTES) != hipSuccess || per_cu < 1) { fprintf(stderr, "kernel_launch: occupancy query says %d\n", per_cu); per_cu = 1; }
        (void)hipGetLastError();
        grid = cus;
    }
    if (grid < 0) return;
    (void)hipMemsetAsync((char*)d_ws + WS_CTL, 0, CTL_ZERO_BYTES, stream);
    Args a{};
    for (int i = 0; i < 18; ++i) a.in[i] = (const float*)d_in[i];
    a.out = (float*)d_out; a.ws = (unsigned char*)d_ws; a.use_cg = 0; a.pad = 0;
    if (N_LAUNCHES == 1) {
        a.ph_lo = 0; a.ph_hi = N_PHASES;
        void* kargs_[] = {&a};
        hipError_t e = hipLaunchCooperativeKernel((const void*)mega_fwd, dim3(grid), dim3(NWAVES * 64), kargs_, LDS_BYTES, stream);
        if (e != hipSuccess) fprintf(stderr, "kernel_launch: cooperative launch failed: %s (grid %d)\n", hipGetErrorString(e), grid);
    } else {
        for (int p = 0; p < N_PHASES; ++p) { a.ph_lo = p; a.ph_hi = p + 1; hipLaunchKernelGGL(mega_fwd, dim3(grid), dim3(NWAVES * 64), LDS_BYTES, stream, a); }
    }
}
```

```cpp
#include <hip/hip_runtime.h>
#include <hip/hip_cooperative_groups.h>
#include <cstdio>
#include <cstdint>
namespace cg = cooperative_groups;

#ifndef MK_N_LAUNCHES
#define MK_N_LAUNCHES 1
#endif
constexpr int N_PHASES = 15;
#define F8_STAGE 2
#define F8_L0 1
#define OPROJ_PAIR 1
#define F8_QKV 2
#define REP_PHASE -1
#define REP_COUNT 0
#define ATT_PROBE_VARIANT 0
#define EXTRA_BARRIERS 0
#define ROUTER_PROBE 0
#define TPROBE_MASK 0
#define TPROBE_K 4
constexpr int N_LAUNCHES = MK_N_LAUNCHES;

#define LAS __attribute__((address_space(3)))
#define GAS __attribute__((address_space(1)))
typedef unsigned short bf16_t;
typedef short bf16x8 __attribute__((ext_vector_type(8)));
typedef short s16x4 __attribute__((ext_vector_type(4)));
typedef float f32x2 __attribute__((ext_vector_type(2)));
typedef float f32x4 __attribute__((ext_vector_type(4)));
typedef float f32x16 __attribute__((ext_vector_type(16)));
typedef unsigned u32x2 __attribute__((ext_vector_type(2)));
typedef unsigned u32x4 __attribute__((ext_vector_type(4)));
typedef int i32x4 __attribute__((ext_vector_type(4)));
typedef int i32x8 __attribute__((ext_vector_type(8)));
typedef __bf16 bf16x2_t __attribute__((ext_vector_type(2)));

constexpr int D = 1024, BATCH = 4, SEQ = 8192, M = BATCH * SEQ;
constexpr int SWA_N = 1536, DIFF_N = 3072;
constexpr int NEXP = 32, DEXP = 512;
constexpr float LOG2E = 1.4426950408889634f;
constexpr float QSCALE = 0.125f * LOG2E;
constexpr float LAMBDA_INIT = 0.35550906759f;
constexpr int NWAVES = 8;

constexpr size_t MiB = 1u << 20;
constexpr size_t WS_CTL = 0, CTL_ZERO_BYTES = 1 * MiB;
constexpr size_t WS_SWA_QKV_T = 1 * MiB, WS_SWA_WO_T = 4 * MiB, WS_DIFF_QKV_T = 6 * MiB, WS_DIFF_WO_T = 12 * MiB;
constexpr size_t WS_WR = 14 * MiB;
constexpr size_t WS_RSTD = 14 * MiB + 512 * 1024;
constexpr size_t WS_LTOK = 15 * MiB, WS_LW = 19 * MiB, WS_TINFO = 23 * MiB;
constexpr size_t WS_WMOE = 24 * MiB;
constexpr size_t WS_XR = 216 * MiB;
#define XNB(a) ((unsigned char*)(a)->out)
constexpr size_t WS_SCR = 280 * MiB;
constexpr size_t WS_QKV = WS_SCR, WS_O = WS_SCR + 192 * MiB, WS_Y = WS_SCR, WS_H = WS_SCR + 144 * MiB;
constexpr size_t WS_END = 536 * MiB;
constexpr int CW_BAR = 4096;
constexpr int CW_CNT = 16384;
constexpr int CW_PAIR = 47104;
constexpr int CW_PQ = 45056;
constexpr int CW_Q = 32768;
constexpr int CW_KMAX = 24576;

constexpr int RING_BYTES = 131072;
constexpr int LDSCTL_OFF = RING_BYTES;
constexpr int MISC_OFF = LDSCTL_OFF + 320;
constexpr int TP_OFF = LDSCTL_OFF + 1024;
constexpr int STASH_OFF = LDSCTL_OFF + 2048;
constexpr int LDS_BYTES = 147456;

__device__ __forceinline__ unsigned f2bf(float f) { unsigned u = __builtin_bit_cast(unsigned, f); return (u + 0x7fffu + ((u >> 16) & 1u)) >> 16; }
__device__ __forceinline__ unsigned pk2(float lo, float hi) { return f2bf(lo) | (f2bf(hi) << 16); }
__device__ __forceinline__ unsigned cvtpk(float lo, float hi) { f32x2 v = {lo, hi}; bf16x2_t b = __builtin_convertvector(v, bf16x2_t); return __builtin_bit_cast(unsigned, b); }
__device__ __forceinline__ unsigned pk4_fp8(float a, float b, float c, float d) {
    a = __builtin_fminf(__builtin_fmaxf(a, -448.f), 448.f); b = __builtin_fminf(__builtin_fmaxf(b, -448.f), 448.f); c = __builtin_fminf(__builtin_fmaxf(c, -448.f), 448.f); d = __builtin_fminf(__builtin_fmaxf(d, -448.f), 448.f);
    int r = 0; r = __builtin_amdgcn_cvt_pk_fp8_f32(a, b, r, false); r = __builtin_amdgcn_cvt_pk_fp8_f32(c, d, r, true); return (unsigned)r; }
__device__ __forceinline__ float bf2f(unsigned short h) { return __builtin_bit_cast(float, (unsigned)h << 16); }
__device__ __forceinline__ void store16_wt(void* p, const u32x4 v) { asm volatile("global_store_dwordx4 %0, %1, off sc1\n\ts_nop 1" :: "v"(p), "v"(v) : "memory"); }
__device__ __forceinline__ int relaunder(int x) { asm volatile("" : "+v"(x)); return x; }
__device__ __forceinline__ int lane_id() { return (int)__builtin_amdgcn_mbcnt_hi(~0u, __builtin_amdgcn_mbcnt_lo(~0u, 0u)); }
__device__ __forceinline__ float wave_sum(float v) {
#pragma unroll
    for (int o = 1; o < 64; o <<= 1) v += __shfl_xor(v, o);
    return v;
}

namespace pg8 {
constexpr int BM = 256, BK = 64, HALF = 128, HTB = HALF * BK * 2, STAGE_BYTES = 8 * HTB, NXCD = 8, WGM = 8;
__host__ __device__ __forceinline__ int lds_byte(int r, int c) { const int st = (r >> 4) * 2 + (c >> 5), rr = r & 15, cc = c & 31, ob = rr * 64 + cc * 2; return st * 1024 + (ob ^ (((ob >> 9) & 1) << 5)); }
__host__ __device__ __forceinline__ void stage_rc(int b, int& R, int& C) { const int st = b / 1024, sb = b % 1024, swz = sb ^ (((sb >> 9) & 1) << 5); R = (st >> 1) * 16 + swz / 64; C = (st & 1) * 32 + (swz % 64) / 2; }
__host__ __device__ __forceinline__ int perm32(int rho) { const int n = rho >> 4, i = rho & 15; return 8 * (i >> 2) + 4 * n + (i & 3); }

struct Unit { int pm, pn, e, t, pnl; };
struct Gemm { const bf16_t* A; const bf16_t* Bt; int K; unsigned sw = 0x7f7f7f7fu, sx = 0x7f7f7f7fu; };

struct DenseOrder {
    int nM, nN, nwg, G, c; int pair = -1;
    __device__ void init(int Mr, int N, int G_, int c_) { nM = Mr / BM; nN = N / BM; nwg = nM * nN; G = G_; c = c_; }
    __device__ bool next(int i, Unit& u) const {
        if (pair >= 0) { if (i >= 2) return false; u.pm = pair >> 1; u.pn = 2 * (pair & 1) + i; u.e = 0; u.t = 0; u.pnl = u.pn; return true; }
        const long L = (long)i * G + c; if (L >= nwg) return false;
        int wgid = (int)L; { const int q = nwg / NXCD, r = nwg % NXCD, xcd = wgid % NXCD, off = wgid / NXCD; wgid = (xcd < r ? xcd * (q + 1) : r * (q + 1) + (xcd - r) * q) + off; }
        const int nig = WGM * nN, gid = wgid / nig, fm = gid * WGM, gsz = (nM - fm) < WGM ? (nM - fm) : WGM;
        u.pm = fm + ((wgid % nig) % gsz); u.pn = (wgid % nig) / gsz; u.e = 0; u.t = 0; u.pnl = u.pn; return true;
    }
    __device__ __forceinline__ int token(const Unit&, int) const { return 0; }
};
struct MoeOrder {
    const LAS int* TP; const LAS int* CNT; const int* ltok; int G, c, pn_mul, pn_add;
    __device__ bool next(int i, Unit& u) const {
        const int ntile = __builtin_amdgcn_readfirstlane(TP[32]); const int nwg = ntile * 4;
        const long L = (long)i * G + c; if (L >= nwg) return false;
        int wgid = (int)L; { const int q = nwg / NXCD, r = nwg % NXCD, xcd = wgid % NXCD, off = wgid / NXCD; wgid = (xcd < r ? xcd * (q + 1) : r * (q + 1) + (xcd - r) * q) + off; }
        const int tau = wgid >> 2; int e = 0;
#pragma unroll
        for (int st = 16; st >= 1; st >>= 1) if (__builtin_amdgcn_readfirstlane(TP[e + st]) <= tau) e += st;
        u.pm = tau; u.e = e; u.t = tau - __builtin_amdgcn_readfirstlane(TP[e]); u.pnl = wgid & 3; u.pn = e * pn_mul + pn_add + u.pnl; return true;
    }
    __device__ __forceinline__ int token(const Unit& u, int r) const { const int idx = u.t * 256 + r; return ltok[(size_t)u.e * M + (idx < CNT[u.e] ? idx : 0)]; }
};

struct EpiQKV {
    static constexpr bool PERM = true;
    bf16_t* O; int ldc; int qcols; float qscale; unsigned* kmaxsq;
    __device__ __forceinline__ void operator()(const f32x4 (&acc)[2][2][4][2], const Unit& u, int wr, int wc, int fr, int fq) const {
        asm volatile("" : "+v"(fr), "+v"(fq));
        const int row0 = u.pm * BM + wr * 64 + fr, colt = u.pn * BM; const float sc = colt < qcols ? qscale : 1.f;
        const int col0 = colt + wc * 32 + 8 * fq;
#pragma unroll
        for (int ai = 0; ai < 2; ++ai)
#pragma unroll
            for (int m = 0; m < 4; ++m) { bf16_t* rowp = O + (size_t)(row0 + ai * HALF + m * 16) * ldc + col0;
#pragma unroll
                for (int bj = 0; bj < 2; ++bj) { const f32x4 v0 = acc[ai][bj][m][0] * sc, v1 = acc[ai][bj][m][1] * sc;
                    u32x4 w; w.x = cvtpk(v0[0], v0[1]); w.y = cvtpk(v0[2], v0[3]); w.z = cvtpk(v1[0], v1[1]); w.w = cvtpk(v1[2], v1[3]);
                    store16_wt(rowp + bj * HALF, w); } }
        if (kmaxsq != nullptr && colt >= 1024 && colt < 2048) {
#pragma unroll
            for (int bj = 0; bj < 2; ++bj) { float mx = 0.f;
#pragma unroll
                for (int ai = 0; ai < 2; ++ai)
#pragma unroll
                    for (int m = 0; m < 4; ++m) { const f32x4 v0 = acc[ai][bj][m][0], v1 = acc[ai][bj][m][1];
                        float ss = (v0[0] * v0[0] + v0[1] * v0[1]) + (v0[2] * v0[2] + v0[3] * v0[3]) + (v1[0] * v1[0] + v1[1] * v1[1]) + (v1[2] * v1[2] + v1[3] * v1[3]);
                        ss += __shfl_xor(ss, 16); ss += __shfl_xor(ss, 32); mx = __builtin_fmaxf(mx, ss); }
                mx = __builtin_fmaxf(mx, __shfl_xor(mx, 1)); mx = __builtin_fmaxf(mx, __shfl_xor(mx, 2)); mx = __builtin_fmaxf(mx, __shfl_xor(mx, 4)); mx = __builtin_fmaxf(mx, __shfl_xor(mx, 8));
                if (fr == 0 && fq == 0) atomicMax(kmaxsq + (u.pm >> 5) * 32 + ((colt - 1024 + bj * HALF + wc * 32) >> 5), __float_as_uint(mx)); }
        }
    }
};
struct EpiResid {
    static constexpr bool PERM = true;
    const float* base32; const bf16_t* base16; bf16_t* out;
    __device__ __forceinline__ void operator()(const f32x4 (&acc)[2][2][4][2], const Unit& u, int wr, int wc, int fr, int fq) const {
        asm volatile("" : "+v"(fr), "+v"(fq));
        const int col0 = u.pn * BM + wc * 32 + 8 * fq;
#pragma unroll
        for (int ai = 0; ai < 2; ++ai) {
            f32x4 b[4][2][2];
            if (base32) {
#pragma unroll
                for (int m = 0; m < 4; ++m) { const size_t off = (size_t)(u.pm * BM + ai * HALF + wr * 64 + m * 16 + fr) * D + col0;
#pragma unroll
                    for (int bj = 0; bj < 2; ++bj)
#pragma unroll
                        for (int n = 0; n < 2; ++n) b[m][bj][n] = *(const f32x4*)(base32 + off + bj * HALF + n * 4); }
            } else {
                u32x4 q[4][2];
#pragma unroll
                for (int m = 0; m < 4; ++m) { const size_t off = (size_t)(u.pm * BM + ai * HALF + wr * 64 + m * 16 + fr) * D + col0;
#pragma unroll
                    for (int bj = 0; bj < 2; ++bj) q[m][bj] = *(const u32x4*)(base16 + off + bj * HALF); }
#pragma unroll
                for (int m = 0; m < 4; ++m)
#pragma unroll
                    for (int bj = 0; bj < 2; ++bj) { const u32x4 w = q[m][bj];
                        b[m][bj][0] = (f32x4){__uint_as_float(w.x << 16), __uint_as_float(w.x & 0xffff0000u), __uint_as_float(w.y << 16), __uint_as_float(w.y & 0xffff0000u)};
                        b[m][bj][1] = (f32x4){__uint_as_float(w.z << 16), __uint_as_float(w.z & 0xffff0000u), __uint_as_float(w.w << 16), __uint_as_float(w.w & 0xffff0000u)}; }
            }
            asm volatile("" ::: "memory");
#pragma unroll
            for (int m = 0; m < 4; ++m) { const size_t off = (size_t)(u.pm * BM + ai * HALF + wr * 64 + m * 16 + fr) * D + col0;
#pragma unroll
                for (int bj = 0; bj < 2; ++bj) { const f32x4 s0 = b[m][bj][0] + acc[ai][bj][m][0], s1 = b[m][bj][1] + acc[ai][bj][m][1];
                    u32x4 w; w.x = pk2(s0.x, s0.y); w.y = pk2(s0.z, s0.w); w.z = pk2(s1.x, s1.y); w.w = pk2(s1.z, s1.w); store16_wt(out + off + bj * HALF, w); } }
            asm volatile("" ::: "memory");
        }
    }
};
__device__ __forceinline__ float silu_mul(float g, float u) { return g * u * __builtin_amdgcn_rcpf(1.f + __builtin_amdgcn_exp2f(-g * LOG2E)); }
template <bool F8>
struct EpiSwiGLU {
    static constexpr bool PERM = true;
    bf16_t* H; const int* ltok; const float* rstd_tok; const LAS int* CNT;
    __device__ __forceinline__ void operator()(const f32x4 (&acc)[2][2][4][2], const Unit& u, int wr, int wc, int fr, int fq) const {
        asm volatile("" : "+v"(fr), "+v"(fq));
        const int colh = u.pnl * 128 + wc * 32 + 8 * fq; const int cnt = CNT[u.e];
        int toks[2][4]; float rss[2][4];
#pragma unroll
        for (int ai = 0; ai < 2; ++ai)
#pragma unroll
            for (int m = 0; m < 4; ++m) { const int idx = u.t * 256 + ai * HALF + wr * 64 + m * 16 + fr; toks[ai][m] = ltok[(size_t)u.e * M + (idx < cnt ? idx : 0)]; }
#pragma unroll
        for (int ai = 0; ai < 2; ++ai)
#pragma unroll
            for (int m = 0; m < 4; ++m) rss[ai][m] = rstd_tok[toks[ai][m]];
        asm volatile("" ::: "memory");
#pragma unroll
        for (int ai = 0; ai < 2; ++ai)
#pragma unroll
            for (int m = 0; m < 4; ++m) { const int rl = ai * HALF + wr * 64 + m * 16 + fr; const size_t row = (size_t)u.pm * BM + rl;
                const float rs = rss[ai][m];
                const f32x4 g0 = acc[ai][0][m][0] * rs, g1 = acc[ai][0][m][1] * rs, u0 = acc[ai][1][m][0] * rs, u1 = acc[ai][1][m][1] * rs;
                if constexpr (F8) {
                    u32x2 w; w.x = pk4_fp8(8.f * silu_mul(g0[0], u0[0]), 8.f * silu_mul(g0[1], u0[1]), 8.f * silu_mul(g0[2], u0[2]), 8.f * silu_mul(g0[3], u0[3]));
                    w.y = pk4_fp8(8.f * silu_mul(g1[0], u1[0]), 8.f * silu_mul(g1[1], u1[1]), 8.f * silu_mul(g1[2], u1[2]), 8.f * silu_mul(g1[3], u1[3]));
                    *(u32x2*)((unsigned char*)H + row * DEXP + colh) = w;
                } else {
                    u32x4 w; w.x = cvtpk(silu_mul(g0[0], u0[0]), silu_mul(g0[1], u0[1])); w.y = cvtpk(silu_mul(g0[2], u0[2]), silu_mul(g0[3], u0[3]));
                    w.z = cvtpk(silu_mul(g1[0], u1[0]), silu_mul(g1[1], u1[1])); w.w = cvtpk(silu_mul(g1[2], u1[2]), silu_mul(g1[3], u1[3]));
                    *(u32x4*)(H + row * DEXP + colh) = w; }
            }
    }
};
struct EpiDown {
    static constexpr bool PERM = true;
    bf16_t* Y; const float* lw;
    __device__ __forceinline__ void operator()(const f32x4 (&acc)[2][2][4][2], const Unit& u, int wr, int wc, int fr, int fq) const {
        asm volatile("" : "+v"(fr), "+v"(fq));
        const int col0 = u.pnl * BM + wc * 32 + 8 * fq;
        float scs[2][4];
#pragma unroll
        for (int ai = 0; ai < 2; ++ai)
#pragma unroll
            for (int m = 0; m < 4; ++m) scs[ai][m] = lw[(size_t)u.e * M + u.t * 256 + ai * HALF + wr * 64 + m * 16 + fr];
        asm volatile("" ::: "memory");
#pragma unroll
        for (int ai = 0; ai < 2; ++ai)
#pragma unroll
            for (int m = 0; m < 4; ++m) { const int rl = ai * HALF + wr * 64 + m * 16 + fr; const size_t row = (size_t)u.pm * BM + rl;
                const float sc = scs[ai][m];
#pragma unroll
                for (int bj = 0; bj < 2; ++bj) { const f32x4 v0 = acc[ai][bj][m][0] * sc, v1 = acc[ai][bj][m][1] * sc;
                    u32x4 w; w.x = cvtpk(v0[0], v0[1]); w.y = cvtpk(v0[2], v0[3]); w.z = cvtpk(v1[0], v1[1]); w.w = cvtpk(v1[2], v1[3]);
                    *(u32x4*)(Y + row * D + col0 + bj * HALF) = w; } }
    }
};

template <class Epi, class Sched, bool GATHER, bool ALIGN_EPI, bool FP8 = false>
__device__ __forceinline__ void gemm_phase(LAS unsigned char* lds, const Gemm g, const Sched& S, const Epi& E, const int wid, const int lane) {
    const int tid = wid * 64 + lane, wr = wid >> 2, wc = wid & 3, fr = lane & 15, fq = lane >> 4;
    const int K = g.K, nt = K / BK;
    int Rr[2], Cc[2]; unsigned voffB[2];
#pragma unroll
    for (int i = 0; i < 2; ++i) { int R, C; stage_rc(tid * 16 + i * 8192, R, C); Rr[i] = R; Cc[i] = C; const int Rb = Epi::PERM ? ((R & ~31) + perm32(R & 31)) : R; voffB[i] = (unsigned)(Rb * K + C) * 2u; }
    const size_t kstep = (size_t)(BK * 2);
    const size_t hstep = (size_t)HALF * K * 2;
    const size_t tstep = 2 * hstep;
    const unsigned ldsw = (unsigned)wid * 1024u;
    const size_t R64 = (size_t)64 * K * 2;
    const size_t H1 = GATHER ? 0 : hstep;
    const int aoff = FP8 ? lds_byte(wr * 64 + fr, (fq >> 1) * 32 + (fq & 1) * 16) : lds_byte(wr * 64 + fr, fq * 8), boff = FP8 ? lds_byte(wc * 32 + fr, (fq >> 1) * 32 + (fq & 1) * 16) : lds_byte(wc * 32 + fr, fq * 8);

#define PG8_SA(b, h) (((b) * 2 + (h)) * HTB)
#define PG8_SB(b, h) ((4 + (b) * 2 + (h)) * HTB)
#define PG8_STAGE2(bufoff, gbase, o0, o1) do { \
        __builtin_amdgcn_global_load_lds((const unsigned*)((const char*)(gbase) + (o0)), (LAS unsigned*)(lds + (bufoff) + ldsw), 16, 0, 0); \
        __builtin_amdgcn_global_load_lds((const unsigned*)((const char*)(gbase) + (o1)), (LAS unsigned*)(lds + (bufoff) + ldsw + 8192), 16, 0, 0); } while (0)
#define PG8_STAGEB(bufoff, gbase) do {   \
        __builtin_amdgcn_global_load_lds((const unsigned*)((const char*)(gbase) + voffB[0]), (LAS unsigned*)(lds + (bufoff) + ldsw), 16, 0, 0); \
        __builtin_amdgcn_global_load_lds((const unsigned*)((const char*)(gbase) + R64 + voffB[0]), (LAS unsigned*)(lds + (bufoff) + ldsw + 8192), 16, 0, 0); } while (0)
#define PG8_LDA(dst, b, h) do { if constexpr (FP8) { _Pragma("unroll") for (int m = 0; m < 4; ++m) dst##8[m] = *(const LAS i32x8*)(lds + PG8_SA(b, h) + aoff + m * 2048); } \
        else { _Pragma("unroll") for (int m = 0; m < 4; ++m) _Pragma("unroll") for (int k = 0; k < 2; ++k) dst[m][k] = *(const LAS bf16x8*)(lds + PG8_SA(b, h) + aoff + m * 2048 + k * 1024); } } while (0)
#define PG8_LDB(dst, b, h) do { if constexpr (FP8) { _Pragma("unroll") for (int n = 0; n < 2; ++n) dst##8[n] = *(const LAS i32x8*)(lds + PG8_SB(b, h) + boff + n * 2048); } \
        else { _Pragma("unroll") for (int n = 0; n < 2; ++n) _Pragma("unroll") for (int k = 0; k < 2; ++k) dst[n][k] = *(const LAS bf16x8*)(lds + PG8_SB(b, h) + boff + n * 2048 + k * 1024); } } while (0)
#define PG8_CAT8(x) __builtin_shufflevector(__builtin_bit_cast(i32x4, (x)[0]), __builtin_bit_cast(i32x4, (x)[1]), 0, 1, 2, 3, 4, 5, 6, 7)
#define PG8_MMA(ai, bj, At, Bt) do { if constexpr (FP8) __builtin_amdgcn_sched_barrier(0); __builtin_amdgcn_s_setprio(1); _Pragma("unroll") for (int m = 0; m < 4; ++m) _Pragma("unroll") for (int n = 0; n < 2; ++n) { \
        if constexpr (FP8) acc[ai][bj][m][n] = __builtin_amdgcn_mfma_scale_f32_16x16x128_f8f6f4(Bt##8[n], At##8[m], acc[ai][bj][m][n], 0, 0, 0, (int)g.sw, 0, (int)g.sx); \
        else { _Pragma("unroll") for (int k = 0; k < 2; ++k) acc[ai][bj][m][n] = __builtin_amdgcn_mfma_f32_16x16x32_bf16(Bt[n][k], At[m][k], acc[ai][bj][m][n], 0, 0, 0); } } \
        if constexpr (FP8) { _Pragma("unroll") for (int m = 0; m < 4; ++m) _Pragma("unroll") for (int n = 0; n < 2; ++n) asm volatile("" : "+v"(acc[ai][bj][m][n])); }   \
        __builtin_amdgcn_s_setprio(0); if constexpr (FP8) __builtin_amdgcn_sched_barrier(0); } while (0)
#define PG8_WAIT_V(n) asm volatile("s_waitcnt vmcnt(" #n ")" ::: "memory")
#define PG8_WAIT_L(n) asm volatile("s_waitcnt lgkmcnt(" #n ")" ::: "memory")
#define PG8_BAR __builtin_amdgcn_s_barrier()
#define PG8_SCHED __builtin_amdgcn_sched_barrier(0)
    Unit cur, nxt; int ui = 0;
    if (!S.next(0, cur)) return;
    unsigned oc00, oc01, oc10, oc11;
    LAS u32x4* stash = (LAS u32x4*)(lds + (STASH_OFF - 0) ) + tid;
    if constexpr (GATHER) {
        oc00 = (unsigned)(S.token(cur, Rr[0]) * K + Cc[0]) * 2u; oc01 = (unsigned)(S.token(cur, Rr[1]) * K + Cc[1]) * 2u;
        oc10 = (unsigned)(S.token(cur, 128 + Rr[0]) * K + Cc[0]) * 2u; oc11 = (unsigned)(S.token(cur, 128 + Rr[1]) * K + Cc[1]) * 2u;
    } else {
        oc00 = (unsigned)(Rr[0] * K + Cc[0]) * 2u; oc01 = (unsigned)(Rr[1] * K + Cc[1]) * 2u; oc10 = oc00; oc11 = oc01;
    }
    f32x4 acc[2][2][4][2];
#pragma unroll
    for (int a = 0; a < 2; ++a)
#pragma unroll
        for (int b = 0; b < 2; ++b)
#pragma unroll
            for (int m = 0; m < 4; ++m)
#pragma unroll
                for (int n = 0; n < 2; ++n) acc[a][b][m][n] = (f32x4){0.f, 0.f, 0.f, 0.f};
    bf16x8 At[4][2], B0[2][2], B1[2][2];
    i32x8 At8[4], B08[2], B18[2];
    const char* cA = GATHER ? (const char*)g.A : (const char*)g.A + (size_t)cur.pm * tstep; const char* cB = (const char*)g.Bt + (size_t)cur.pn * tstep;
    PG8_STAGEB(PG8_SB(0, 0), cB); PG8_STAGEB(PG8_SB(0, 1), cB + hstep); PG8_STAGE2(PG8_SA(0, 0), cA, oc00, oc01); PG8_STAGE2(PG8_SA(0, 1), cA + H1, oc10, oc11);
    if (wr == 1) PG8_BAR;
    PG8_WAIT_V(2); PG8_BAR;
    PG8_STAGEB(PG8_SB(1, 0), cB + kstep); PG8_STAGE2(PG8_SA(1, 0), cA + kstep, oc00, oc01); PG8_STAGEB(PG8_SB(1, 1), cB + hstep + kstep);
    PG8_WAIT_V(6); PG8_BAR;
    for (;;) {
        const bool has_next = S.next(ui + 1, nxt);
        const char* nA = has_next ? (GATHER ? (const char*)g.A : (const char*)g.A + (size_t)nxt.pm * tstep) : cA; const char* nB = has_next ? (const char*)g.Bt + (size_t)nxt.pn * tstep : cB;
        if constexpr (GATHER) {
            u32x4 nx = {oc00, oc01, oc10, oc11};
            if (has_next) { int R0, C0, R1, C1; stage_rc(tid * 16, R0, C0); stage_rc(tid * 16 + 8192, R1, C1);
                nx.x = (unsigned)(S.token(nxt, R0) * K + C0) * 2u; nx.y = (unsigned)(S.token(nxt, R1) * K + C1) * 2u;
                nx.z = (unsigned)(S.token(nxt, 128 + R0) * K + C0) * 2u; nx.w = (unsigned)(S.token(nxt, 128 + R1) * K + C1) * 2u; }
            *stash = nx;
        }
        for (int t = 0; t < nt; t += 2) {
            const bool last = (t == nt - 2);
            const char* a1 = cA + (size_t)(t + 1) * kstep;
            const char* a2 = last ? nA : cA + (size_t)(t + 2) * kstep; const char* b2 = last ? nB : cB + (size_t)(t + 2) * kstep;
            const char* a3 = a2 + kstep; const char* b3 = b2 + kstep;
            unsigned x00 = oc00, x01 = oc01, x10 = oc10, x11 = oc11;
            if constexpr (GATHER) { if (last) { const u32x4 nx = *stash; x00 = nx.x; x01 = nx.y; x10 = nx.z; x11 = nx.w; } }
            PG8_LDB(B0, 0, 0); PG8_LDB(B1, 0, 1); PG8_SCHED; PG8_LDA(At, 0, 0); PG8_STAGE2(PG8_SA(1, 1), a1 + H1, oc10, oc11);
            PG8_WAIT_V(8); PG8_WAIT_L(0); PG8_BAR; PG8_MMA(0, 0, At, B0); PG8_MMA(0, 1, At, B1); PG8_BAR; PG8_SCHED;
            PG8_LDA(At, 0, 1); PG8_STAGEB(PG8_SB(0, 0), b2); PG8_STAGEB(PG8_SB(0, 1), b2 + hstep); PG8_STAGE2(PG8_SA(0, 0), a2, x00, x01);
            PG8_WAIT_V(8); PG8_WAIT_L(0); PG8_BAR; PG8_MMA(1, 0, At, B0); PG8_MMA(1, 1, At, B1); PG8_BAR; PG8_SCHED;
            PG8_LDB(B0, 1, 0); PG8_LDB(B1, 1, 1); PG8_SCHED; PG8_LDA(At, 1, 0); PG8_STAGE2(PG8_SA(0, 1), a2 + H1, x10, x11);
            PG8_WAIT_V(8); PG8_WAIT_L(0); PG8_BAR; PG8_MMA(0, 0, At, B0); PG8_MMA(0, 1, At, B1); PG8_BAR; PG8_SCHED;
            PG8_LDA(At, 1, 1); PG8_STAGEB(PG8_SB(1, 0), b3); PG8_STAGEB(PG8_SB(1, 1), b3 + hstep); PG8_STAGE2(PG8_SA(1, 0), a3, x00, x01);
            PG8_WAIT_V(8); PG8_WAIT_L(0); PG8_BAR; PG8_MMA(1, 0, At, B0); PG8_MMA(1, 1, At, B1); PG8_BAR; PG8_SCHED;
        }
        if constexpr (ALIGN_EPI) { if (wr == 0) PG8_BAR; }
        E(acc, cur, wr, wc, fr, fq);
        if (!has_next) break;
#pragma unroll
        for (int a = 0; a < 2; ++a)
#pragma unroll
            for (int b = 0; b < 2; ++b)
#pragma unroll
                for (int m = 0; m < 4; ++m)
#pragma unroll
                    for (int n = 0; n < 2; ++n) acc[a][b][m][n] = (f32x4){0.f, 0.f, 0.f, 0.f};
        cur = nxt; cA = nA; cB = nB; ++ui;
        if constexpr (GATHER) { const u32x4 nx = *stash; oc00 = nx.x; oc01 = nx.y; oc10 = nx.z; oc11 = nx.w; }
        if constexpr (ALIGN_EPI) { if (wr == 1) PG8_BAR; }
    }
    PG8_WAIT_V(0);
    if constexpr (!ALIGN_EPI) { if (wr == 0) PG8_BAR; }
    PG8_BAR;
#undef PG8_SA
#undef PG8_SB
#undef PG8_STAGE2
#undef PG8_STAGEB
#undef PG8_LDA
#undef PG8_LDB
#undef PG8_MMA
#undef PG8_CAT8
#undef PG8_WAIT_V
#undef PG8_WAIT_L
#undef PG8_BAR
#undef PG8_SCHED
}
}

namespace att {
constexpr int NSLOT = 3;
constexpr float THR = 8.0f;
constexpr float SKIP_T = 32.0f;
__device__ __forceinline__ void glds16(const void* gsrc, unsigned lds_dst) { unsigned keep;
    asm volatile("s_mov_b32 %0, m0\n\ts_mov_b32 m0, %2\n\ts_nop 0\n\tglobal_load_lds_dwordx4 %1, off\n\ts_mov_b32 m0, %0" : "=&s"(keep) : "v"(gsrc), "s"(lds_dst) : "memory"); }
#define ATT_WAIT_BAR(N) asm volatile("s_waitcnt vmcnt(" #N ") lgkmcnt(0)\n\ts_barrier" ::: "memory")
typedef LAS const char* lds_cptr;
typedef short v4i16_t __attribute__((ext_vector_type(4)));
__device__ __forceinline__ s16x4 vtr(lds_cptr p) { return __builtin_bit_cast(s16x4, __builtin_amdgcn_ds_read_tr16_b64_v4i16((LAS v4i16_t*)p)); }
__device__ __forceinline__ float swap_max(float m) { auto rr = __builtin_amdgcn_permlane32_swap(__float_as_uint(m), __float_as_uint(m), false, false); return __builtin_fmaxf(__uint_as_float(rr[0]), __uint_as_float(rr[1])); }
__device__ __forceinline__ float swap_sum(float m) { auto rr = __builtin_amdgcn_permlane32_swap(__float_as_uint(m), __float_as_uint(m), false, false); return __uint_as_float(rr[0]) + __uint_as_float(rr[1]); }
__device__ __forceinline__ float max3f(float a, float b, float c) { float r; asm("v_max3_f32 %0, %1, %2, %3" : "=v"(r) : "v"(a), "v"(b), "v"(c)); return r; }
__device__ __forceinline__ float fmax3(float a, float b, float c) { return __builtin_fmaxf(__builtin_fmaxf(a, b), c); }
template <unsigned KB> __device__ __forceinline__ float fmamk(float a, float c) { float r; asm("v_fmamk_f32 %0, %1, %2, %3" : "=v"(r) : "v"(a), "i"(KB), "v"(c)); return r; }
#define CRF(r) ((float)(((r) & 3) + 8 * ((r) >> 2)))
#define CRI(r) (((r) & 3) + 8 * ((r) >> 2))

__device__ __forceinline__ u32x4 pair_rows(const u32x2 A, const u32x2 B) {
    auto x = __builtin_amdgcn_permlane32_swap(A.x, B.x, false, false); auto y = __builtin_amdgcn_permlane32_swap(A.y, B.y, false, false);
    return (u32x4){(unsigned)x[0], (unsigned)y[0], (unsigned)x[1], (unsigned)y[1]}; }
template <int MODE> struct Cfg;
template <> struct Cfg<0> { static constexpr int DV32 = 2, NK = 1, SLOTB = 16384, VOFF = 8192, PITCH = SWA_N, NVP = 1; };
template <> struct Cfg<1> { static constexpr int DV32 = 4, NK = 2, SLOTB = 32768, VOFF = 16384, PITCH = DIFF_N, NVP = 2; };

template <int MODE>
__device__ __forceinline__ void tile_step(lds_cptr kp, lds_cptr vp, const bf16x8 (&qr)[4], f32x16 (&o)[Cfg<MODE>::DV32], float& mhat, float& l, bool& first,
                                          const float slope2, const int dq_i, const int kind, const int hi) {
    constexpr int DV32 = Cfg<MODE>::DV32;
    f32x16 p0, p1;
    const float dq = (float)dq_i, nm = -mhat;
    {
        const float sl = kind == 2 ? 0.f : (kind == 0 ? slope2 : -slope2); const float base0 = __builtin_fmaf(-sl, dq, nm);
#pragma unroll
        for (int r = 0; r < 16; ++r) { p0[r] = __builtin_fmaf(sl, CRF(r), base0); p1[r] = __builtin_fmaf(sl, CRF(r) + 32.f, base0); }
    }
#pragma unroll
    for (int d0 = 0; d0 < 4; ++d0) {
        const bf16x8 b0 = *(const LAS bf16x8*)(kp + d0 * 2048);
        const bf16x8 b1 = *(const LAS bf16x8*)(kp + d0 * 2048 + 512);
        p0 = __builtin_amdgcn_mfma_f32_32x32x16_bf16(b0, qr[d0], p0, 0, 0, 0);
        p1 = __builtin_amdgcn_mfma_f32_32x32x16_bf16(b1, qr[d0], p1, 0, 0, 0);
    }
    if (kind == 2) {
#pragma unroll
        for (int r = 0; r < 16; ++r) {
            const float e0 = __builtin_fabsf(dq - CRF(r)), e1 = __builtin_fabsf(dq - CRF(r) - 32.f);
            if (MODE == 0) { p0[r] = e0 <= 128.f ? __builtin_fmaf(-slope2, e0, p0[r]) : -INFINITY; p1[r] = e1 <= 128.f ? __builtin_fmaf(-slope2, e1, p1[r]) : -INFINITY; }
            else { p0[r] = __builtin_fmaf(-slope2, e0, p0[r]); p1[r] = __builtin_fmaf(-slope2, e1, p1[r]); }
        }
    }
    float rm = __builtin_fmaxf(p0[0], p1[0]);
#pragma unroll
    for (int r = 1; r < 16; ++r) rm = __builtin_fmaxf(rm, __builtin_fmaxf(p0[r], p1[r]));
    rm = swap_max(rm);
    if (first || __any(rm > THR)) {
        const float dl = first ? rm : __builtin_fmaxf(rm, 0.f);
        mhat += dl;
#pragma unroll
        for (int r = 0; r < 16; ++r) { p0[r] -= dl; p1[r] -= dl; }
        if (!first) {
            const float f = __builtin_amdgcn_exp2f(-dl); l *= f;
#pragma unroll
            for (int r = 0; r < 16; ++r)
#pragma unroll
                for (int d0 = 0; d0 < DV32; ++d0) o[d0][r] *= f;
        }
        first = false;
    }
    float sacc = 0.f;
    u32x4 pw[4];
#pragma unroll
    for (int s = 0; s < 2; ++s) {
        float e[8];
#pragma unroll
        for (int j = 0; j < 8; ++j) { e[j] = __builtin_amdgcn_exp2f(p0[8 * s + j]); sacc += e[j]; }
        pw[s] = (u32x4){cvtpk(e[0], e[1]), cvtpk(e[2], e[3]), cvtpk(e[4], e[5]), cvtpk(e[6], e[7])};
    }
#pragma unroll
    for (int s = 0; s < 2; ++s) {
        float e[8];
#pragma unroll
        for (int j = 0; j < 8; ++j) { e[j] = __builtin_amdgcn_exp2f(p1[8 * s + j]); sacc += e[j]; }
        pw[2 + s] = (u32x4){cvtpk(e[0], e[1]), cvtpk(e[2], e[3]), cvtpk(e[4], e[5]), cvtpk(e[6], e[7])};
    }
    l += sacc;
#pragma unroll
    for (int d0 = 0; d0 < DV32; ++d0) {
#pragma unroll
        for (int ks = 0; ks < 4; ++ks) {
            const s16x4 lo = vtr(vp + d0 * 4096 + ks * 1024), hh = vtr(vp + d0 * 4096 + ks * 1024 + 512);
            const bf16x8 vf = (bf16x8){lo[0], lo[1], lo[2], lo[3], hh[0], hh[1], hh[2], hh[3]};
            o[d0] = __builtin_amdgcn_mfma_f32_32x32x16_bf16(vf, __builtin_bit_cast(bf16x8, pw[ks]), o[d0], 0, 0, 0);
        }
    }
}


#define SWA_INIT(p0, p1, dq, kind) do { \
        if ((kind) == 2) { _Pragma("unroll") for (int r = 0; r < 16; ++r) { p0[r] = __builtin_fmaf(-slope2, __builtin_fabsf((dq) - CRF(r)), -mhat); p1[r] = __builtin_fmaf(-slope2, __builtin_fabsf((dq) - CRF(r) - 32.f), -mhat); } } \
        else { const bool left_ = (kind) == 0 || (kind) == 3; const float sl_ = left_ ? slope2 : -slope2; const float base0_ = __builtin_fmaf(-sl_, (dq), -mhat); \
            _Pragma("unroll") for (int r = 0; r < 16; ++r) { p0[r] = __builtin_fmaf(sl_, CRF(r), base0_); p1[r] = __builtin_fmaf(sl_, CRF(r) + 32.f, base0_); } \
            if ((kind) == 3) { const float t_ = (dq) - 128.f; _Pragma("unroll") for (int r = 0; r < 16; ++r) { p0[r] = CRF(r) >= t_ ? p0[r] : -INFINITY; p1[r] = CRF(r) + 32.f >= t_ ? p1[r] : -INFINITY; } } \
            if ((kind) == 4) { const float t_ = (dq) + 128.f; _Pragma("unroll") for (int r = 0; r < 16; ++r) { p0[r] = CRF(r) <= t_ ? p0[r] : -INFINITY; p1[r] = CRF(r) + 32.f <= t_ ? p1[r] : -INFINITY; } } } } while (0)
#define SWA_EXPPK(dst, src, s) do { float e_[8]; _Pragma("unroll") for (int j = 0; j < 8; ++j) { e_[j] = __builtin_amdgcn_exp2f(src[8 * (s) + j]); sacc += e_[j]; } \
        dst = (u32x4){cvtpk(e_[0], e_[1]), cvtpk(e_[2], e_[3]), cvtpk(e_[4], e_[5]), cvtpk(e_[6], e_[7])}; } while (0)
#define SWA_PV(vp, pw) do { _Pragma("unroll") for (int d0 = 0; d0 < 2; ++d0) { _Pragma("unroll") for (int ks = 0; ks < 4; ++ks) { \
        const s16x4 lo = vtr((vp) + d0 * 4096 + ks * 1024), hh = vtr((vp) + d0 * 4096 + ks * 1024 + 512); \
        o[d0] = __builtin_amdgcn_mfma_f32_32x32x16_bf16((bf16x8){lo[0], lo[1], lo[2], lo[3], hh[0], hh[1], hh[2], hh[3]}, __builtin_bit_cast(bf16x8, pw[ks]), o[d0], 0, 0, 0); } } } while (0)
__device__ __forceinline__ void swa_step1(lds_cptr kpA, lds_cptr vpA, const int dqA_i, const int kindA, const bf16x8 (&qr)[4], f32x16 (&o)[2], float& mhat, float& l, const float slope2) {
    f32x16 a0, a1;
    const float dqA = (float)dqA_i;
    SWA_INIT(a0, a1, dqA, kindA);
#pragma unroll
    for (int d0 = 0; d0 < 4; ++d0) {
        const bf16x8 ka0 = *(const LAS bf16x8*)(kpA + d0 * 2048), ka1 = *(const LAS bf16x8*)(kpA + d0 * 2048 + 512);
        a0 = __builtin_amdgcn_mfma_f32_32x32x16_bf16(ka0, qr[d0], a0, 0, 0, 0); a1 = __builtin_amdgcn_mfma_f32_32x32x16_bf16(ka1, qr[d0], a1, 0, 0, 0);
    }
    float rm = fmax3(a0[0], a1[0], a0[1]);
#pragma unroll
    for (int r = 1; r < 16; ++r) rm = (r < 15) ? fmax3(rm, a1[r], a0[r + 1]) : __builtin_fmaxf(rm, a1[r]);
    rm = swap_max(rm);
    if (__any(rm > THR)) {
        const float dl = __builtin_fmaxf(rm, 0.f); mhat += dl;
#pragma unroll
        for (int r = 0; r < 16; ++r) { a0[r] -= dl; a1[r] -= dl; }
        const float f = __builtin_amdgcn_exp2f(-dl); l *= f;
#pragma unroll
        for (int r = 0; r < 16; ++r) { o[0][r] *= f; o[1][r] *= f; }
    }
    float sacc = 0.f; u32x4 pwA[4];
    SWA_EXPPK(pwA[0], a0, 0); SWA_EXPPK(pwA[1], a0, 1); SWA_EXPPK(pwA[2], a1, 0); SWA_EXPPK(pwA[3], a1, 1);
    l += sacc;
    SWA_PV(vpA, pwA);
}
__device__ __forceinline__ void swa_step2(lds_cptr kpA, lds_cptr vpA, const int dqA_i, const int kindA, lds_cptr kpB, lds_cptr vpB, const int dqB_i, const int kindB,
                                          const bf16x8 (&qr)[4], f32x16 (&o)[2], float& mhat, float& l, const float slope2) {
    f32x16 a0, a1, b0, b1;
    const float dqA = (float)dqA_i, dqB = (float)dqB_i;
    SWA_INIT(a0, a1, dqA, kindA); SWA_INIT(b0, b1, dqB, kindB);
#pragma unroll
    for (int d0 = 0; d0 < 4; ++d0) {
        const bf16x8 ka0 = *(const LAS bf16x8*)(kpA + d0 * 2048), ka1 = *(const LAS bf16x8*)(kpA + d0 * 2048 + 512);
        const bf16x8 kb0 = *(const LAS bf16x8*)(kpB + d0 * 2048), kb1 = *(const LAS bf16x8*)(kpB + d0 * 2048 + 512);
        a0 = __builtin_amdgcn_mfma_f32_32x32x16_bf16(ka0, qr[d0], a0, 0, 0, 0); a1 = __builtin_amdgcn_mfma_f32_32x32x16_bf16(ka1, qr[d0], a1, 0, 0, 0);
        b0 = __builtin_amdgcn_mfma_f32_32x32x16_bf16(kb0, qr[d0], b0, 0, 0, 0); b1 = __builtin_amdgcn_mfma_f32_32x32x16_bf16(kb1, qr[d0], b1, 0, 0, 0);
    }
    float rm = fmax3(a0[0], a1[0], b0[0]), rn = b1[0];
#pragma unroll
    for (int r = 1; r < 16; ++r) { rm = fmax3(rm, a0[r], a1[r]); rn = fmax3(rn, b0[r], b1[r]); }
    rm = swap_max(__builtin_fmaxf(rm, rn));
    if (__any(rm > THR)) {
        const float dl = __builtin_fmaxf(rm, 0.f); mhat += dl;
#pragma unroll
        for (int r = 0; r < 16; ++r) { a0[r] -= dl; a1[r] -= dl; b0[r] -= dl; b1[r] -= dl; }
        const float f = __builtin_amdgcn_exp2f(-dl); l *= f;
#pragma unroll
        for (int r = 0; r < 16; ++r) { o[0][r] *= f; o[1][r] *= f; }
    }
    float sacc = 0.f; u32x4 pwA[4], pwB[4];
    SWA_EXPPK(pwA[0], a0, 0); SWA_EXPPK(pwA[1], a0, 1); SWA_EXPPK(pwA[2], a1, 0); SWA_EXPPK(pwA[3], a1, 1);
    SWA_EXPPK(pwB[0], b0, 0); SWA_EXPPK(pwB[1], b0, 1); SWA_EXPPK(pwB[2], b1, 0); SWA_EXPPK(pwB[3], b1, 1);
    l += sacc;
    SWA_PV(vpA, pwA); SWA_PV(vpB, pwB);
}
#undef SWA_INIT
#undef SWA_EXPPK
#undef SWA_PV
__device__ __forceinline__ void swa_issue(const int b, const int hh, const int qb, const int rb, bf16x8 (&qd)[4], const bf16_t* __restrict__ QKV, const unsigned lds0, const int wid, const int lane) {
    typedef Cfg<0> C; constexpr int PITCH = SWA_N;
    const int r32 = lane & 31, hi = lane >> 5, g = wid >> 1, qs = wid & 1, hq = hh * 4 + g, iw = qb * 64 + qs * 32, qcol = hq * 64, kcol = 1024 + hh * 64, vcol = 1280 + hh * 64;
    const bf16_t* base = QKV + (size_t)b * SEQ * PITCH;
    const unsigned koff = (unsigned)(lane * PITCH + kcol + wid * 8) * 2u;
    const unsigned voff = (unsigned)((16 * (wid & 3) + (lane >> 2)) * PITCH + vcol + (wid >> 2) * 32 + (lane & 3) * 8) * 2u;
    const unsigned kdst = lds0 + wid * 1024, vdst = lds0 + C::VOFF + wid * 1024;
    { const bf16_t* Qw = base + (size_t)(iw + r32) * PITCH + qcol;
#pragma unroll
      for (int d0 = 0; d0 < 4; ++d0) qd[d0] = *(const bf16x8*)(Qw + d0 * 16 + hi * 8); }
#define SWA_DMA(t, j) do { const char* tb_ = (const char*)base + (size_t)(t) * 64 * PITCH * 2; const unsigned so_ = (unsigned)((rb + (j)) & 7) * C::SLOTB; \
        glds16(tb_ + koff, (unsigned)__builtin_amdgcn_readfirstlane(kdst + so_)); glds16(tb_ + voff, (unsigned)__builtin_amdgcn_readfirstlane(vdst + so_)); } while (0)
    SWA_DMA(qb, 0);
    if (qb >= 1) SWA_DMA(qb - 1, 1); if (qb <= 126) SWA_DMA(qb + 1, 2);
    if (qb >= 2) SWA_DMA(qb - 2, 3); if (qb <= 125) SWA_DMA(qb + 2, 4);
#undef SWA_DMA
}
__device__ __forceinline__ void swa_unit(const int b, const int hh, const int qb, const int rb, const bool prefetched, const bool has_next, const int nb, const int nhh, const int nqb,
                                         bf16x8 (&qn)[4], const bf16_t* __restrict__ QKV, bf16_t* __restrict__ O, const float* __restrict__ sink,
                                         LAS unsigned char* shm, const int wid, const int lane_in) {
    typedef Cfg<0> C;
    constexpr int DV32 = 2;
    int lane = lane_in; asm volatile("" : "+v"(lane));
    const int r32 = lane & 31, hi = lane >> 5;
    const int g = wid >> 1, qs = wid & 1, hq = hh * 4 + g, iw = qb * 64 + qs * 32;
    const float slope2 = __builtin_amdgcn_exp2f(-0.5f * (float)(hq + 1)) * LOG2E;
    const unsigned lds0 = (unsigned)(uintptr_t)shm;
    if (!prefetched) swa_issue(b, hh, qb, rb, qn, QKV, lds0, wid, lane);
    bf16x8 qr[4];
#pragma unroll
    for (int d0 = 0; d0 < 4; ++d0) qr[d0] = qn[d0];
    const bool hasL1 = qb >= 1, hasR1 = qb <= 126, hasL2 = qb >= 2, hasR2 = qb <= 125;
    const int n1 = (hasL1 ? 1 : 0) + (hasR1 ? 1 : 0), n2 = (hasL2 ? 1 : 0) + (hasR2 ? 1 : 0);
    f32x16 o[DV32];
#pragma unroll
    for (int d0 = 0; d0 < DV32; ++d0)
#pragma unroll
        for (int r = 0; r < 16; ++r) o[d0][r] = 0.f;
    float mhat = sink[hq] * LOG2E, l = (hi == 0) ? 1.f : 0.f;
    const lds_cptr shm3 = (lds_cptr)shm;
    const lds_cptr kp0 = shm3 + hi * 1024 + r32 * 16;
    const lds_cptr vp0 = shm3 + C::VOFF + ((lane >> 4) & 1) * 32 + (lane & 3) * 8 + (4 * hi + ((lane & 15) >> 2)) * 64;
#define POS(j) ((unsigned)((rb + (j)) & 7) * C::SLOTB)
    const int dqd = iw + r32 - 4 * hi - qb * 64;
    ATT_WAIT_BAR(0);
    swa_step1(kp0 + POS(0), vp0 + POS(0), dqd, 2, qr, o, mhat, l, slope2);
    if (hasL1 && hasR1) swa_step2(kp0 + POS(1), vp0 + POS(1), dqd + 64, 0, kp0 + POS(2), vp0 + POS(2), dqd - 64, 1, qr, o, mhat, l, slope2);
    else if (hasL1) swa_step1(kp0 + POS(1), vp0 + POS(1), dqd + 64, 0, qr, o, mhat, l, slope2);
    else if (hasR1) swa_step1(kp0 + POS(2), vp0 + POS(2), dqd - 64, 1, qr, o, mhat, l, slope2);
    asm volatile("s_waitcnt lgkmcnt(0)\n\ts_barrier" ::: "memory");
    if (has_next) swa_issue(nb, nhh, nqb, rb + 5, qn, QKV, lds0, wid, lane);
    if (hasL2 && hasR2) swa_step2(kp0 + POS(3), vp0 + POS(3), dqd + 128, 3, kp0 + POS(4), vp0 + POS(4), dqd - 128, 4, qr, o, mhat, l, slope2);
    else if (hasL2) swa_step1(kp0 + POS(3), vp0 + POS(3), dqd + 128, 3, qr, o, mhat, l, slope2);
    else if (hasR2) swa_step1(kp0 + POS(4), vp0 + POS(4), dqd - 128, 4, qr, o, mhat, l, slope2);
#undef POS
    l = swap_sum(l);
    const float rl = 1.f / l;
    bf16_t* Ow = O + (size_t)(b * SEQ + iw + r32) * D + hq * 64 + 8 * hi;
#pragma unroll
    for (int d0 = 0; d0 < DV32; ++d0)
#pragma unroll
        for (int ge = 0; ge < 4; ge += 2) { u32x2 A, B;
            A.x = cvtpk(o[d0][4 * ge] * rl, o[d0][4 * ge + 1] * rl); A.y = cvtpk(o[d0][4 * ge + 2] * rl, o[d0][4 * ge + 3] * rl);
            B.x = cvtpk(o[d0][4 * ge + 4] * rl, o[d0][4 * ge + 5] * rl); B.y = cvtpk(o[d0][4 * ge + 6] * rl, o[d0][4 * ge + 7] * rl);
            *(u32x4*)(Ow + d0 * 32 + 8 * ge) = pair_rows(A, B); }
}

struct DiffConsts { float lam_full; const float* subln; };

template <int MODE>
__device__ __forceinline__ void attn_unit(const int b, const int hh, const int qb, const bf16_t* __restrict__ QKV, bf16_t* __restrict__ O, const float* __restrict__ sink,
                                          const DiffConsts dc, LAS unsigned char* shm, const int wid, const int lane_in) {
    typedef Cfg<MODE> C;
    constexpr int DV32 = C::DV32, PITCH = C::PITCH;
    int lane = lane_in; asm volatile("" : "+v"(lane));
    const int r32 = lane & 31, hi = lane >> 5;
    int iw, qcol, kcol, vcol, t_lo, NT, hq = 0, cmap = 0, qs;
    float slope2;
    if (MODE == 0) { const int g = wid >> 1; qs = wid & 1; hq = hh * 4 + g; iw = qb * 64 + qs * 32; qcol = hq * 64; kcol = 1024 + hh * 64; vcol = 1280 + hh * 64;
        t_lo = qb - 2 < 0 ? 0 : qb - 2; const int t_hi = qb + 2 > 127 ? 127 : qb + 2; NT = t_hi - t_lo + 1; slope2 = __builtin_amdgcn_exp2f(-0.5f * (float)(hq + 1)) * LOG2E; }
    else { qs = wid & 3; cmap = wid >> 2; iw = qb * 128 + qs * 32; qcol = (hh * 2 + cmap) * 64; kcol = 1024 + hh * 128; vcol = 2048 + hh * 128; t_lo = 0; NT = SEQ / 64;
        slope2 = __builtin_amdgcn_exp2f(-(float)(hh + 1)) * LOG2E; }
    const bf16_t* base = QKV + (size_t)b * SEQ * PITCH;
    const unsigned lds0 = (unsigned)(uintptr_t)shm;
    const unsigned koff = (unsigned)(lane * PITCH + kcol + wid * 8) * 2u;
    const unsigned voff = (unsigned)((16 * (wid & 3) + (lane >> 2)) * PITCH + vcol + (wid >> 2) * 32 + (lane & 3) * 8) * 2u;
    const unsigned kdst = lds0 + wid * 1024, vdst = lds0 + C::VOFF + wid * 1024;
#define ATT_DMA(t, slot) do { const char* tb_ = (const char*)base + (size_t)(t) * 64 * PITCH * 2; const unsigned so_ = (unsigned)(slot) * C::SLOTB; \
        glds16(tb_ + koff, (unsigned)__builtin_amdgcn_readfirstlane(kdst + so_)); \
        if (MODE == 1) glds16(tb_ + koff + 128, (unsigned)__builtin_amdgcn_readfirstlane(kdst + so_ + 8192)); \
        glds16(tb_ + voff, (unsigned)__builtin_amdgcn_readfirstlane(vdst + so_)); \
        if (MODE == 1) glds16(tb_ + voff + 128, (unsigned)__builtin_amdgcn_readfirstlane(vdst + so_ + 8192)); } while (0)
    ATT_DMA(t_lo, 0);
    if (NT > 1) ATT_DMA(t_lo + 1, 1);
    bf16x8 qr[4];
    { const bf16_t* Qw = base + (size_t)(iw + r32) * PITCH + qcol;
#pragma unroll
      for (int d0 = 0; d0 < 4; ++d0) qr[d0] = *(const bf16x8*)(Qw + d0 * 16 + hi * 8); }
    f32x16 o[DV32];
#pragma unroll
    for (int d0 = 0; d0 < DV32; ++d0)
#pragma unroll
        for (int r = 0; r < 16; ++r) o[d0][r] = 0.f;
    float mhat = 0.f, l = 0.f; bool first = true;
    if (MODE == 0) { mhat = sink[hq] * LOG2E; l = (hi == 0) ? 1.f : 0.f; first = false; }
    const lds_cptr shm3 = (lds_cptr)shm;
    const lds_cptr kp0 = shm3 + (MODE == 1 ? cmap * 8192 : 0) + hi * 1024 + r32 * 16;
    const lds_cptr vp0 = shm3 + C::VOFF + ((lane >> 4) & 1) * 32 + (lane & 3) * 8 + (4 * hi + ((lane & 15) >> 2)) * 64;
    int slot = 0;
    for (int it = 0; it < NT; ++it) {
        if (it + 1 < NT) { if (MODE == 1) { ATT_WAIT_BAR(4); } else { ATT_WAIT_BAR(2); } } else { ATT_WAIT_BAR(0); }
        if (it + 2 < NT) { const int s2 = slot == 0 ? 2 : slot - 1; ATT_DMA(t_lo + it + 2, s2); }
        const int k0 = (t_lo + it) * 64;
        const int kind = (MODE == 0) ? ((t_lo + it == qb - 1) ? 0 : ((t_lo + it == qb + 1) ? 1 : 2)) : ((k0 + 63 < iw) ? 0 : ((k0 > iw + 31) ? 1 : 2));
        tile_step<MODE>(kp0 + slot * C::SLOTB, vp0 + slot * C::SLOTB, qr, o, mhat, l, first, slope2, iw + r32 - k0 - 4 * hi, kind, hi);
        slot = slot == 2 ? 0 : slot + 1;
    }
#undef ATT_DMA
    l = swap_sum(l);
    const float rl = 1.f / l;
    if (MODE == 0) {
        bf16_t* Ow = O + (size_t)(b * SEQ + iw + r32) * D + hq * 64 + 8 * hi;
#pragma unroll
        for (int d0 = 0; d0 < DV32; ++d0)
#pragma unroll
            for (int ge = 0; ge < 4; ge += 2) { u32x2 A, B;
                A.x = cvtpk(o[d0][4 * ge] * rl, o[d0][4 * ge + 1] * rl); A.y = cvtpk(o[d0][4 * ge + 2] * rl, o[d0][4 * ge + 3] * rl);
                B.x = cvtpk(o[d0][4 * ge + 4] * rl, o[d0][4 * ge + 5] * rl); B.y = cvtpk(o[d0][4 * ge + 6] * rl, o[d0][4 * ge + 7] * rl);
                *(u32x4*)(Ow + d0 * 32 + 8 * ge) = pair_rows(A, B); }
        ATT_WAIT_BAR(0);
    } else {
        LAS float* cb = (LAS float*)shm + qs * 4096;
        ATT_WAIT_BAR(0);
        if (cmap == 1) {
#pragma unroll
            for (int r = 0; r < 16; ++r) { const int row = CRI(r) + 4 * hi; const float rr = __shfl(rl, row) * dc.lam_full;
#pragma unroll
                for (int d0 = 0; d0 < DV32; ++d0) cb[row * 128 + d0 * 32 + r32] = o[d0][r] * rr; }
        }
        ATT_WAIT_BAR(0);
        if (cmap == 0) {
            bf16_t* Ow = O + (size_t)(b * SEQ + iw) * D + hh * 128 + r32;
            float gsub[DV32];
#pragma unroll
            for (int d0 = 0; d0 < DV32; ++d0) gsub[d0] = dc.subln[d0 * 32 + r32] * (1.f - LAMBDA_INIT);
#pragma unroll
            for (int r = 0; r < 16; ++r) { const int row = CRI(r) + 4 * hi; const float rr = __shfl(rl, row);
                float v[DV32]; float ss = 0.f;
#pragma unroll
                for (int d0 = 0; d0 < DV32; ++d0) { v[d0] = o[d0][r] * rr - cb[row * 128 + d0 * 32 + r32]; ss += v[d0] * v[d0]; }
                ss += __shfl_xor(ss, 1); ss += __shfl_xor(ss, 2); ss += __shfl_xor(ss, 4); ss += __shfl_xor(ss, 8); ss += __shfl_xor(ss, 16);
                const float sc = __builtin_amdgcn_rsqf(ss * (1.f / 128.f) + 1e-5f);
#pragma unroll
                for (int d0 = 0; d0 < DV32; ++d0) Ow[(size_t)row * D + d0 * 32] = (bf16_t)f2bf(v[d0] * sc * gsub[d0]); }
        }
        ATT_WAIT_BAR(0);
    }
}

#define SBAR() __builtin_amdgcn_sched_barrier(0)
#define PIN(x) asm volatile("" : "+v"(x))
#define MF(a, b, c) __builtin_amdgcn_mfma_f32_32x32x16_bf16(a, b, c, 0, 0, 0)
template <int VAR>
__device__ __forceinline__ void diff_unit(const int b, const int hh, const int qb, const bf16_t* __restrict__ QKV, bf16_t* __restrict__ O, const float kmax,
                                          const DiffConsts dc, LAS unsigned char* shm, const int wid, const int lane_in, unsigned* qhead, const int qlist) {
    constexpr int DV32 = 4, PITCH = DIFF_N, KSLOT = 16384, VRING = 4 * 16384;
    int lane = lane_in; asm volatile("" : "+v"(lane));
    const int r32 = lane & 31, hi = lane >> 5;
    const int qs = wid & 3, cmap = wid >> 2, i0 = qb * 128, iw = i0 + qs * 32, qcol = (hh * 2 + cmap) * 64, kcol = 1024 + hh * 128, vcol = 2048 + hh * 128;
    const float slope2 = __builtin_amdgcn_exp2f(-(float)(hh + 1)) * LOG2E;
    const bf16_t* base = QKV + (size_t)b * SEQ * PITCH;
    const unsigned lds0 = (unsigned)(uintptr_t)shm;
    const unsigned koff = (unsigned)(lane * PITCH + kcol + wid * 8) * 2u;
    const unsigned voff = (unsigned)((16 * (wid & 3) + (lane >> 2)) * PITCH + vcol + (wid >> 2) * 32 + (lane & 3) * 8) * 2u;
    const unsigned kdst = lds0 + wid * 1024, vdst = lds0 + VRING + wid * 1024;
#define DMA_K(t, slot) do { const char* tb_ = (const char*)base + (size_t)(t) * 64 * PITCH * 2; const unsigned so_ = (unsigned)(slot) * KSLOT; \
        glds16(tb_ + koff, (unsigned)__builtin_amdgcn_readfirstlane(kdst + so_)); glds16(tb_ + koff + 128, (unsigned)__builtin_amdgcn_readfirstlane(kdst + so_ + 8192)); } while (0)
#define DMA_V(t, slot) do { const char* tb_ = (const char*)base + (size_t)(t) * 64 * PITCH * 2; const unsigned so_ = (unsigned)(slot) * KSLOT; \
        glds16(tb_ + voff, (unsigned)__builtin_amdgcn_readfirstlane(vdst + so_)); glds16(tb_ + voff + 128, (unsigned)__builtin_amdgcn_readfirstlane(vdst + so_ + 8192)); } while (0)
    const int td0 = 2 * qb;
    int nL = td0;
#define TILE_OF(idx) ((idx) < 2 ? td0 + (idx) : ((idx) - 2 < nL ? td0 - 1 - ((idx) - 2) : td0 + 2 + ((idx) - 2 - nL)))
    DMA_K(td0, 0); DMA_V(td0, 0); DMA_K(td0 + 1, 1); DMA_V(td0 + 1, 1); DMA_K(TILE_OF(2), 2);
    bf16x8 qr[4]; float nq2 = 0.f;
    { const bf16_t* Qw = base + (size_t)(iw + r32) * PITCH + qcol;
#pragma unroll
      for (int d0 = 0; d0 < 4; ++d0) { qr[d0] = *(const bf16x8*)(Qw + d0 * 16 + hi * 8);
#pragma unroll
          for (int j = 0; j < 8; ++j) { const float f = bf2f((unsigned short)qr[d0][j]); nq2 += f * f; } } }
    nq2 = swap_sum(nq2);
    f32x16 o[DV32];
#pragma unroll
    for (int d0 = 0; d0 < DV32; ++d0)
#pragma unroll
        for (int r = 0; r < 16; ++r) o[d0][r] = 0.f;
    float mhat = 0.f, l = 0.f;
    const lds_cptr shm3 = (lds_cptr)shm;
    const lds_cptr kp0 = shm3 + cmap * 8192 + hi * 1024 + r32 * 16;
    const lds_cptr vp0 = shm3 + VRING + ((lane >> 4) & 1) * 32 + (lane & 3) * 8 + (4 * hi + ((lane & 15) >> 2)) * 64;
    LAS float* wsf = (LAS float*)(shm + 7 * KSLOT);
    ATT_WAIT_BAR(2);
    DMA_K(TILE_OF(3), 3); DMA_V(TILE_OF(2), 2);
    { f32x16 a0, a1, b0, b1; const float dqA = (float)(iw + r32 - td0 * 64 - 4 * hi), dqB = dqA - 64.f;
#pragma unroll
      for (int r = 0; r < 16; ++r) { a0[r] = -slope2 * __builtin_fabsf(dqA - CRF(r)); a1[r] = -slope2 * __builtin_fabsf(dqA - CRF(r) - 32.f);
                                     b0[r] = -slope2 * __builtin_fabsf(dqB - CRF(r)); b1[r] = -slope2 * __builtin_fabsf(dqB - CRF(r) - 32.f); }
#pragma unroll
      for (int d0 = 0; d0 < 4; ++d0) {
          const bf16x8 ka0 = *(const LAS bf16x8*)(kp0 + d0 * 2048), ka1 = *(const LAS bf16x8*)(kp0 + d0 * 2048 + 512);
          const bf16x8 kb0 = *(const LAS bf16x8*)(kp0 + KSLOT + d0 * 2048), kb1 = *(const LAS bf16x8*)(kp0 + KSLOT + d0 * 2048 + 512);
          a0 = MF(ka0, qr[d0], a0); a1 = MF(ka1, qr[d0], a1); b0 = MF(kb0, qr[d0], b0); b1 = MF(kb1, qr[d0], b1); }
      float rm = fmax3(a0[0], a1[0], b0[0]), rn = b1[0];
#pragma unroll
      for (int r = 1; r < 16; ++r) { rm = fmax3(rm, a0[r], a1[r]); rn = fmax3(rn, b0[r], b1[r]); }
      mhat = swap_max(__builtin_fmaxf(rm, rn));
      float sacc = 0.f; u32x4 pwA[4], pwB[4];
#define DG_EXPPK(dst, src, s) do { float e_[8]; _Pragma("unroll") for (int j = 0; j < 8; ++j) { e_[j] = __builtin_amdgcn_exp2f(src[8 * (s) + j] - mhat); sacc += e_[j]; } \
        dst = (u32x4){cvtpk(e_[0], e_[1]), cvtpk(e_[2], e_[3]), cvtpk(e_[4], e_[5]), cvtpk(e_[6], e_[7])}; } while (0)
      DG_EXPPK(pwA[0], a0, 0); DG_EXPPK(pwA[1], a0, 1); DG_EXPPK(pwA[2], a1, 0); DG_EXPPK(pwA[3], a1, 1);
      DG_EXPPK(pwB[0], b0, 0); DG_EXPPK(pwB[1], b0, 1); DG_EXPPK(pwB[2], b1, 0); DG_EXPPK(pwB[3], b1, 1);
#undef DG_EXPPK
      l = sacc;
#pragma unroll
      for (int d0 = 0; d0 < DV32; ++d0) {
#pragma unroll
          for (int ks = 0; ks < 4; ++ks) { const s16x4 lo = vtr(vp0 + d0 * 4096 + ks * 1024), hh_ = vtr(vp0 + d0 * 4096 + ks * 1024 + 512);
              o[d0] = MF(((bf16x8){lo[0], lo[1], lo[2], lo[3], hh_[0], hh_[1], hh_[2], hh_[3]}), __builtin_bit_cast(bf16x8, pwA[ks]), o[d0]); }
#pragma unroll
          for (int ks = 0; ks < 4; ++ks) { const s16x4 lo = vtr(vp0 + KSLOT + d0 * 4096 + ks * 1024), hh_ = vtr(vp0 + KSLOT + d0 * 4096 + ks * 1024 + 512);
              o[d0] = MF(((bf16x8){lo[0], lo[1], lo[2], lo[3], hh_[0], hh_[1], hh_[2], hh_[3]}), __builtin_bit_cast(bf16x8, pwB[ks]), o[d0]); } } }
    { float a = sqrtf(nq2) * kmax - mhat;
#pragma unroll
      for (int o_ = 1; o_ < 32; o_ <<= 1) a = __builtin_fmaxf(a, __shfl_xor(a, o_));
      if (lane == 0) wsf[wid] = a; }
    ATT_WAIT_BAR(2);
    int NT; bool nochk;
    { float amax = wsf[0];
#pragma unroll
      for (int w = 1; w < 8; ++w) amax = __builtin_fmaxf(amax, wsf[w]);
      const float dist = (SKIP_T + __builtin_fmaxf(amax, 0.f)) / slope2;
      const float lo_f = ((float)(i0 - 63) - dist) * (1.f / 64.f), hi_f = ((float)(i0 + 127) + dist) * (1.f / 64.f);
      int t_lo = lo_f <= 0.f ? 0 : (int)lo_f, t_hi = hi_f >= 127.f ? 127 : (int)hi_f;
      if (t_lo > td0 - 2) t_lo = td0 - 2 < 0 ? 0 : td0 - 2; if (t_hi < td0 + 3) t_hi = td0 + 3 > 127 ? 127 : td0 + 3;
      t_lo = __builtin_amdgcn_readfirstlane(t_lo); t_hi = __builtin_amdgcn_readfirstlane(t_hi);
      nL = td0 - t_lo; NT = 2 + nL + (t_hi - (td0 + 1)); if (VAR & 256) NT = 2;
      nochk = __builtin_amdgcn_readfirstlane(amax <= 64.f ? 1 : 0) != 0; }
    if (4 < NT) DMA_K(TILE_OF(4), 0);
    f32x16 xa0, xa1, xb0, xb1; u32x4 pw0, pw1, pw2, pw3; bf16x8 kf0, kf1, kf2, kf3; s16x4 vl0, vh0, vl1, vh1, vl2, vh2, vl3, vh3;
    float sl_n, base_n, rf = 1.f; bool resc = false;
#define KRD(dst, f) do { if ((VAR & 4) && (f) >= 4) break; dst = *(const LAS bf16x8*)(kp_ + ((f) >> 1) * 2048 + ((f) & 1) * 512); } while (0)
#define VRD(lo, hh_, i) do { if ((VAR & 2) && (i) >= 4) break; lo = vtr(vp_ + ((i) >> 2) * 4096 + ((i) & 3) * 1024); hh_ = vtr(vp_ + ((i) >> 2) * 4096 + ((i) & 3) * 1024 + 512); } while (0)
#define KRN(dst, f) dst = *(const LAS bf16x8*)(kn_ + ((f) >> 1) * 2048 + ((f) & 1) * 512)
#define VFR(lo, hh_) (bf16x8){lo[0], lo[1], lo[2], lo[3], hh_[0], hh_[1], hh_[2], hh_[3]}
#define SET_NEXT(idx) do { const int tn_ = TILE_OF(idx); const bool left_ = (idx) - 2 < nL; sl_n = left_ ? slope2 : -slope2; \
        base_n = __builtin_fmaf(-sl_n, (float)(iw + r32 - tn_ * 64 - 4 * hi), -mhat); } while (0)
#define CINIT(X0, X1) do { _Pragma("unroll") for (int r = 0; r < 16; ++r) { X0[r] = __builtin_fmaf(sl_n, CRF(r), base_n); X1[r] = __builtin_fmaf(sl_n, CRF(r) + 32.f, base_n); } } while (0)
#define GA(Sx, KF, qf, RD, P, e, PW, w0, w1) do { Sx = MF(KF, qf, Sx); RD; if (!(VAR & 32)) { sacc += P[e]; sacc += P[e + 1]; sacc += P[e + 2]; sacc += P[e + 3]; PIN(sacc); \
        PW[w0] = cvtpk(P[e], P[e + 1]); PW[w1] = cvtpk(P[e + 2], P[e + 3]); } PIN(PW); SBAR(); } while (0)
#define PHASE_A(S0, S1, P0, P1) do { float sacc = 0.f; \
        GA(S0, kf0, qr[0], KRD(kf0, 4), P0, 0,  pw0, 0, 1); GA(S1, kf1, qr[0], KRD(kf1, 5), P0, 4,  pw0, 2, 3); \
        GA(S0, kf2, qr[1], KRD(kf2, 6), P0, 8,  pw1, 0, 1); GA(S1, kf3, qr[1], KRD(kf3, 7), P0, 12, pw1, 2, 3); \
        GA(S0, kf0, qr[2], VRD(vl0, vh0, 0), P1, 0,  pw2, 0, 1); GA(S1, kf1, qr[2], VRD(vl1, vh1, 1), P1, 4,  pw2, 2, 3); \
        GA(S0, kf2, qr[3], VRD(vl2, vh2, 2), P1, 8,  pw3, 0, 1); GA(S1, kf3, qr[3], VRD(vl3, vh3, 3), P1, 12, pw3, 2, 3); \
        l += sacc; } while (0)
#define QK_ONLY(S0, S1) do { \
        S0 = MF(kf0, qr[0], S0); KRD(kf0, 4); S1 = MF(kf1, qr[0], S1); KRD(kf1, 5); S0 = MF(kf2, qr[1], S0); KRD(kf2, 6); S1 = MF(kf3, qr[1], S1); KRD(kf3, 7); SBAR(); \
        S0 = MF(kf0, qr[2], S0); S1 = MF(kf1, qr[2], S1); S0 = MF(kf2, qr[3], S0); S1 = MF(kf3, qr[3], S1); SBAR(); } while (0)
#define DECIDE(S0, S1) do { if (VAR & 64) break; asm volatile("s_nop 15\n\ts_nop 7" : "+v"(S0), "+v"(S1));   \
        float ma_ = max3f(S0[0], S0[1], S1[0]), mb_ = max3f(S0[2], S0[3], S1[1]); ma_ = max3f(ma_, S1[2], S1[3]); \
        _Pragma("unroll") for (int r = 4; r < 16; r += 4) { ma_ = max3f(ma_, S0[r], S0[r + 1]); mb_ = max3f(mb_, S0[r + 2], S0[r + 3]); ma_ = max3f(ma_, S1[r], S1[r + 1]); mb_ = max3f(mb_, S1[r + 2], S1[r + 3]); } \
        float rm_ = max3f(ma_, mb_, mb_); rm_ = swap_max(rm_); resc = false; \
        if (__builtin_expect(__any(rm_ > THR), 0)) { const float dl_ = __builtin_fmaxf(rm_, 0.f); mhat += dl_; \
            _Pragma("unroll") for (int r = 0; r < 16; ++r) { S0[r] -= dl_; S1[r] -= dl_; } \
            rf = __builtin_amdgcn_exp2f(-dl_); l *= rf; resc = true; } } while (0)
#define RESCALE_O() do { if (resc) { _Pragma("unroll") for (int r = 0; r < 16; ++r) { \
            _Pragma("unroll") for (int d0 = 0; d0 < DV32; ++d0) o[d0][r] *= rf; } resc = false; } } while (0)
#define EXP2(x) ((VAR & 1) ? (x) * 0.001f : __builtin_amdgcn_exp2f(x))
#define GB(Ox, PW, VL, VH, RD, S, e, C, crf) do { if (!(VAR & 512)) Ox = MF(VFR(VL, VH), __builtin_bit_cast(bf16x8, PW), Ox); RD; S[e] = EXP2(S[e]); S[e + 1] = EXP2(S[e + 1]); PIN(S); \
        if (!(VAR & 16)) { C[e] = fmamk<__builtin_bit_cast(unsigned, CRF(e) + (crf))>(sl_n, base_n); C[e + 1] = fmamk<__builtin_bit_cast(unsigned, CRF(e + 1) + (crf))>(sl_n, base_n); } PIN(C); SBAR(); } while (0)
#define PHASE_B(S0, S1, C0, C1) do { \
        GB(o[0], pw0, vl0, vh0, VRD(vl0, vh0, 4),  S0, 0,  C0, 0.f);  GB(o[0], pw1, vl1, vh1, VRD(vl1, vh1, 5),  S0, 2,  C0, 0.f); \
        GB(o[0], pw2, vl2, vh2, VRD(vl2, vh2, 6),  S0, 4,  C0, 0.f);  GB(o[0], pw3, vl3, vh3, VRD(vl3, vh3, 7),  S0, 6,  C0, 0.f); \
        GB(o[1], pw0, vl0, vh0, VRD(vl0, vh0, 8),  S0, 8,  C0, 0.f);  GB(o[1], pw1, vl1, vh1, VRD(vl1, vh1, 9),  S0, 10, C0, 0.f); \
        GB(o[1], pw2, vl2, vh2, VRD(vl2, vh2, 10), S0, 12, C0, 0.f);  GB(o[1], pw3, vl3, vh3, VRD(vl3, vh3, 11), S0, 14, C0, 0.f); \
        GB(o[2], pw0, vl0, vh0, VRD(vl0, vh0, 12), S1, 0,  C1, 32.f); GB(o[2], pw1, vl1, vh1, VRD(vl1, vh1, 13), S1, 2,  C1, 32.f); \
        GB(o[2], pw2, vl2, vh2, VRD(vl2, vh2, 14), S1, 4,  C1, 32.f); GB(o[2], pw3, vl3, vh3, VRD(vl3, vh3, 15), S1, 6,  C1, 32.f); \
        GB(o[3], pw0, vl0, vh0, KRN(kf0, 0),       S1, 8,  C1, 32.f); GB(o[3], pw1, vl1, vh1, KRN(kf1, 1),       S1, 10, C1, 32.f); \
        GB(o[3], pw2, vl2, vh2, KRN(kf2, 2),       S1, 12, C1, 32.f); GB(o[3], pw3, vl3, vh3, KRN(kf3, 3),       S1, 14, C1, 32.f); } while (0)
#define ROT3(s) ((s) == 2 ? 0 : (s) + 1)
#define ROT4(s) (((s) + 1) & 3)
#define STEP(S0, S1, P0, P1, it, CHK) do { \
        asm volatile("" : "+s"(sk), "+s"(sv)); \
        const int skm_ = (sk + 3) & 3, skp_ = ROT4(sk), svpp_ = sv == 0 ? 2 : sv - 1;   \
        const lds_cptr kp_ = kp0 + sk * KSLOT; const lds_cptr kn_ = kp0 + skp_ * KSLOT; const lds_cptr vp_ = vp0 + sv * KSLOT; \
        if (!(VAR & 8) && (it) + 3 < NT) DMA_K(TILE_OF((it) + 3), skm_); \
        SET_NEXT((it) + 1); SBAR(); \
        __builtin_amdgcn_s_setprio(1); PHASE_A(S0, S1, P0, P1); __builtin_amdgcn_s_setprio(0); \
        if (!(VAR & 8) && (it) + 1 < NT) DMA_V(TILE_OF((it) + 1), svpp_); \
        if (CHK) { DECIDE(S0, S1); if (resc) SET_NEXT((it) + 1); } SBAR(); \
        __builtin_amdgcn_s_setprio(1); PHASE_B(S0, S1, P0, P1); __builtin_amdgcn_s_setprio(0); \
        if (CHK) RESCALE_O(); sk = skp_; sv = ROT3(sv); } while (0)
    if (NT > 2) {
        { const lds_cptr kp_ = kp0 + 2 * KSLOT; const lds_cptr kn_ = kp0 + 3 * KSLOT;
          KRD(kf0, 0); KRD(kf1, 1); KRD(kf2, 2); KRD(kf3, 3);
          if (5 < NT) DMA_K(TILE_OF(5), 1); if (3 < NT) DMA_V(TILE_OF(3), 0);
          SET_NEXT(2); CINIT(xa0, xa1); SBAR();
          QK_ONLY(xa0, xa1);
          if (!nochk) { DECIDE(xa0, xa1); RESCALE_O(); }
#pragma unroll
          for (int r = 0; r < 16; ++r) { xa0[r] = EXP2(xa0[r]); xa1[r] = EXP2(xa1[r]); }
          SET_NEXT(3); CINIT(xb0, xb1);
          KRN(kf0, 0); KRN(kf1, 1); KRN(kf2, 2); KRN(kf3, 3); }
#define PIPE_LOOP(CHK_) do { \
        int it = 3, sk = 3, sv = 2; \
        _Pragma("unroll 1") \
        for (; it + 1 < NT; it += 2) { \
            if (!(VAR & 128)) { if (it + 2 < NT) { ATT_WAIT_BAR(4); } else { ATT_WAIT_BAR(2); } } \
            STEP(xb0, xb1, xa0, xa1, it, CHK_); \
            if (!(VAR & 128)) { if (it + 3 < NT) { ATT_WAIT_BAR(4); } else { ATT_WAIT_BAR(2); } } \
            STEP(xa0, xa1, xb0, xb1, it + 1, CHK_); \
        } \
        if (it < NT) { \
            ATT_WAIT_BAR(2); \
            STEP(xb0, xb1, xa0, xa1, it, CHK_); \
 \
            { float sacc = 0.f; \
        _Pragma("unroll") \
              for (int r = 0; r < 16; ++r) sacc += xb0[r] + xb1[r]; \
              l += sacc; \
              pw0 = (u32x4){cvtpk(xb0[0], xb0[1]), cvtpk(xb0[2], xb0[3]), cvtpk(xb0[4], xb0[5]), cvtpk(xb0[6], xb0[7])}; pw1 = (u32x4){cvtpk(xb0[8], xb0[9]), cvtpk(xb0[10], xb0[11]), cvtpk(xb0[12], xb0[13]), cvtpk(xb0[14], xb0[15])}; \
              pw2 = (u32x4){cvtpk(xb1[0], xb1[1]), cvtpk(xb1[2], xb1[3]), cvtpk(xb1[4], xb1[5]), cvtpk(xb1[6], xb1[7])}; pw3 = (u32x4){cvtpk(xb1[8], xb1[9]), cvtpk(xb1[10], xb1[11]), cvtpk(xb1[12], xb1[13]), cvtpk(xb1[14], xb1[15])}; } \
        } else { \
            { float sacc = 0.f; \
        _Pragma("unroll") \
              for (int r = 0; r < 16; ++r) sacc += xa0[r] + xa1[r]; \
              l += sacc; \
              pw0 = (u32x4){cvtpk(xa0[0], xa0[1]), cvtpk(xa0[2], xa0[3]), cvtpk(xa0[4], xa0[5]), cvtpk(xa0[6], xa0[7])}; pw1 = (u32x4){cvtpk(xa0[8], xa0[9]), cvtpk(xa0[10], xa0[11]), cvtpk(xa0[12], xa0[13]), cvtpk(xa0[14], xa0[15])}; \
              pw2 = (u32x4){cvtpk(xa1[0], xa1[1]), cvtpk(xa1[2], xa1[3]), cvtpk(xa1[4], xa1[5]), cvtpk(xa1[6], xa1[7])}; pw3 = (u32x4){cvtpk(xa1[8], xa1[9]), cvtpk(xa1[10], xa1[11]), cvtpk(xa1[12], xa1[13]), cvtpk(xa1[14], xa1[15])}; } \
        } \
    } while (0)
        PIPE_LOOP(!nochk);
#undef PIPE_LOOP
        ATT_WAIT_BAR(0);
        { const int sl_ = (NT - 1) % 3; const lds_cptr vp_ = vp0 + sl_ * KSLOT;
#pragma unroll
          for (int d0 = 0; d0 < DV32; ++d0) {
              VRD(vl0, vh0, d0 * 4); VRD(vl1, vh1, d0 * 4 + 1); VRD(vl2, vh2, d0 * 4 + 2); VRD(vl3, vh3, d0 * 4 + 3);
              o[d0] = MF(VFR(vl0, vh0), __builtin_bit_cast(bf16x8, pw0), o[d0]); o[d0] = MF(VFR(vl1, vh1), __builtin_bit_cast(bf16x8, pw1), o[d0]);
              o[d0] = MF(VFR(vl2, vh2), __builtin_bit_cast(bf16x8, pw2), o[d0]); o[d0] = MF(VFR(vl3, vh3), __builtin_bit_cast(bf16x8, pw3), o[d0]); } }
    }
#undef TILE_OF
#undef DMA_K
#undef DMA_V
#undef KRD
#undef VRD
#undef VFR
#undef SET_NEXT
#undef CINIT
#undef GA
#undef PHASE_A
#undef QK_ONLY
#undef DECIDE
#undef RESCALE_O
#undef EXP2
#undef GB
#undef PHASE_B
#undef STEP
#undef ROT3
#undef ROT4
#undef KRN
    l = swap_sum(l);
    const float rl = 1.f / l;
    LAS f32x4* cb4 = (LAS f32x4*)shm + qs * 1024 + lane;
    ATT_WAIT_BAR(0);
    if (VAR & 1024) { if (lane == 0 && rl == 12345.f) O[0] = 0; return; }
    int tk = 0;
    if (wid == 4 && lane == 0) tk = (int)__hip_atomic_fetch_add(qhead, 1u, __ATOMIC_RELAXED, __HIP_MEMORY_SCOPE_AGENT);
    if (cmap == 1) { const float rr = rl * dc.lam_full;
#pragma unroll
        for (int d0 = 0; d0 < DV32; ++d0)
#pragma unroll
            for (int g = 0; g < 4; ++g) cb4[(d0 * 4 + g) * 64] = (f32x4){o[d0][4 * g] * rr, o[d0][4 * g + 1] * rr, o[d0][4 * g + 2] * rr, o[d0][4 * g + 3] * rr};
    }
    asm volatile("s_waitcnt lgkmcnt(0)\n\ts_barrier" ::: "memory");
    if (wid == 4) { const int k_ = __builtin_amdgcn_readfirstlane(tk); if (lane == 0) *(LAS int*)(shm + 7 * KSLOT + 64) = qlist * 65536 + k_; }
    if (cmap == 0) {
        float ss = 0.f;
#pragma unroll
        for (int d0 = 0; d0 < DV32; ++d0)
#pragma unroll
            for (int g = 0; g < 4; ++g) { const f32x4 x = cb4[(d0 * 4 + g) * 64];
#pragma unroll
                for (int j = 0; j < 4; ++j) { const float v = o[d0][4 * g + j] * rl - x[j]; o[d0][4 * g + j] = v; ss += v * v; } }
        ss = swap_sum(ss);
        const float sc = __builtin_amdgcn_rsqf(ss * (1.f / 128.f) + 1e-5f);
        const LAS f32x4* gt4 = (const LAS f32x4*)(shm + 7 * KSLOT + 256) + hi;
        bf16_t* Ow = O + (size_t)(b * SEQ + iw + r32) * D + hh * 128 + 8 * hi;
#pragma unroll
        for (int d0 = 0; d0 < DV32; ++d0)
#pragma unroll
            for (int ge = 0; ge < 4; ge += 2) { const f32x4 ga = gt4[d0 * 8 + 2 * ge] * sc, gb = gt4[d0 * 8 + 2 * ge + 2] * sc; u32x2 A, B;
                A.x = cvtpk(o[d0][4 * ge] * ga.x, o[d0][4 * ge + 1] * ga.y); A.y = cvtpk(o[d0][4 * ge + 2] * ga.z, o[d0][4 * ge + 3] * ga.w);
                B.x = cvtpk(o[d0][4 * ge + 4] * gb.x, o[d0][4 * ge + 5] * gb.y); B.y = cvtpk(o[d0][4 * ge + 6] * gb.z, o[d0][4 * ge + 7] * gb.w);
                *(u32x4*)(Ow + d0 * 32 + 8 * ge) = pair_rows(A, B); }
    }
    asm volatile("s_waitcnt lgkmcnt(0)\n\ts_barrier" ::: "memory");
}
#undef SBAR
#undef PIN
#undef MF
#undef ATT_WAIT_BAR
}

typedef GAS unsigned gu32;
#define RLX_AGENT __ATOMIC_RELAXED, __HIP_MEMORY_SCOPE_AGENT
#define LDS_WAIT() asm volatile("s_waitcnt lgkmcnt(0)" ::: "memory")
#define VM_WAIT() asm volatile("s_waitcnt vmcnt(0)" ::: "memory")
#define XB_TMO      128
#define XB_XCNT(j)  (256  + 64 * (j))
#define XB_XSUB(j)  (1280 + 64 * (j))
#define XB_XGEN(j)  (2304 + 64 * (j))
#define XB_TOP      3328
#define XB_TOPGEN   3392
#define XCD_BAR_WORDS 3456
#define XB_SPIN_CAP (1u << 18)
__device__ __forceinline__ unsigned xb_ld(unsigned* p)              { return __hip_atomic_load(p, __ATOMIC_RELAXED, __HIP_MEMORY_SCOPE_AGENT); }
__device__ __forceinline__ unsigned xb_add(unsigned* p, unsigned v) { return __hip_atomic_fetch_add(p, v, __ATOMIC_RELAXED, __HIP_MEMORY_SCOPE_AGENT); }
__device__ __forceinline__ unsigned xb_xcc_id() { return (unsigned)__builtin_amdgcn_s_getreg((3 << 11) | 20) & 0xFu; }
#define XB_SPIN(cond, bar) do { unsigned _sp = 0; while (cond) { __builtin_amdgcn_s_sleep(1); \
    if ((++_sp & 255u) == 0u) { if (xb_ld(&(bar)[XB_TMO])) break; if (_sp > XB_SPIN_CAP) { atomicAdd(&(bar)[XB_TMO], 1u); break; } } } } while (0)
struct XcdBarrier { unsigned* bar; unsigned x; volatile LAS unsigned* st; };
__device__ __forceinline__ XcdBarrier xcd_barrier_post(unsigned* bar, volatile LAS unsigned* st, const bool leader) {
    XcdBarrier b; b.bar = bar; b.x = xb_xcc_id(); b.st = st;
    if (leader) (void)xb_add(&bar[XB_XCNT(b.x)], 1u);
    return b;
}
__device__ __forceinline__ void xcd_barrier_complete(unsigned* bar, unsigned x, unsigned& nloc, unsigned& nx) {
    const unsigned G = gridDim.x * gridDim.y * gridDim.z;
    unsigned sum, cnt, mine, sp = 0u;
    for (;;) {
        sum = 0u; cnt = 0u; mine = 0u;
#pragma unroll
        for (unsigned j = 0; j < 16; ++j) { const unsigned c = xb_ld(&bar[XB_XCNT(j)]); sum += c; cnt += (c > 0u) ? 1u : 0u; mine = (j == x) ? c : mine; }
        if (sum == G) break;
        __builtin_amdgcn_s_sleep(1);
        if ((++sp & 255u) == 0u) { if (xb_ld(&bar[XB_TMO])) break; if (sp > XB_SPIN_CAP) { atomicAdd(&bar[XB_TMO], 1u); break; } }
    }
    nloc = mine > 0u ? mine : 1u; nx = cnt > 0u ? cnt : 1u;
}
__device__ __forceinline__ void xcd_barrier(const XcdBarrier& b, const bool leader) {
    asm volatile("s_waitcnt vmcnt(0)" ::: "memory");
    __syncthreads();
    if (leader) {
        unsigned* bar = b.bar;
        __builtin_amdgcn_s_waitcnt(0);
        unsigned nloc = b.st[0], nx = b.st[1];
        if (nloc == 0u) { xcd_barrier_complete(bar, b.x, nloc, nx); b.st[0] = nloc; b.st[1] = nx; }
        const unsigned old = xb_add(&bar[XB_XSUB(b.x)], 1u);
        const unsigned gen = old / nloc;
        if (old + 1u == (gen + 1u) * nloc) {
            __builtin_amdgcn_fence(__ATOMIC_RELEASE, "agent");
            asm volatile("s_waitcnt vmcnt(0)" ::: "memory");
            const unsigned og = xb_add(&bar[XB_TOP], 1u);
            const unsigned tg = og / nx;
            if (og + 1u == (tg + 1u) * nx) xb_add(&bar[XB_TOPGEN], 1u);
            else XB_SPIN(xb_ld(&bar[XB_TOPGEN]) == tg, bar);
            __builtin_amdgcn_fence(__ATOMIC_ACQUIRE, "agent");
            xb_add(&bar[XB_XGEN(b.x)], 1u);
            asm volatile("s_waitcnt vmcnt(0)" ::: "memory");
        } else {
            XB_SPIN(xb_ld(&bar[XB_XGEN(b.x)]) == gen, bar);
            __builtin_amdgcn_fence(__ATOMIC_ACQUIRE, "agent");
            asm volatile("s_waitcnt vmcnt(0)" ::: "memory");
        }
    }
    __syncthreads();
}

struct Args { const float* in[18]; float* out; unsigned char* ws; int ph_lo, ph_hi, use_cg, pad; };
enum { I_X = 0, I_NMIX, I_NFFN, I_SWA_QKV, I_SWA_WO, I_SWA_SINK, I_DIFF_QKV, I_DIFF_WO, I_DIFF_LAM, I_DIFF_SUBLN, I_WG, I_BG, I_WR, I_BR, I_GATE, I_UP, I_DOWN, I_FNORM };
typedef const __attribute__((address_space(4))) Args* CArgs;
__device__ __forceinline__ CArgs kargs() { CArgs p = (CArgs)__builtin_amdgcn_kernarg_segment_ptr(); asm volatile("" : "+s"(p)); return p; }
__device__ __forceinline__ int vcu_of(int G) { const int bx = blockIdx.x; return (G % 8 == 0) ? (bx % 8) * (G / 8) + bx / 8 : bx; }

__device__ __forceinline__ void tr_item(const float* W, int N, int k0, int n0, bf16_t* dst, int ldd, LAS float* scr, int lane) {
    f32x4 v[8];
#pragma unroll
    for (int i = 0; i < 8; ++i) v[i] = *(const f32x4*)(W + (size_t)(k0 + 8 * i + (lane >> 3)) * N + n0 + (lane & 7) * 4);
#pragma unroll
    for (int i = 0; i < 8; ++i) { LAS float* p = scr + (8 * i + (lane >> 3)) * 33 + (lane & 7) * 4; p[0] = v[i].x; p[1] = v[i].y; p[2] = v[i].z; p[3] = v[i].w; }
    LDS_WAIT(); asm volatile("" ::: "memory");
    const int c = lane & 7;
#pragma unroll
    for (int j = 0; j < 4; ++j) { const int n = (lane >> 3) + 8 * j; const LAS float* s = scr + (8 * c) * 33 + n;
        u32x4 o; o.x = pk2(s[0 * 33], s[1 * 33]); o.y = pk2(s[2 * 33], s[3 * 33]); o.z = pk2(s[4 * 33], s[5 * 33]); o.w = pk2(s[6 * 33], s[7 * 33]);
        *(GAS u32x4*)(dst + (size_t)n * ldd + k0 + 8 * c) = o; }
    LDS_WAIT(); asm volatile("" ::: "memory");
}
__device__ __forceinline__ void rms_row_to_bf16(const float* xrow, const float* g, bf16_t* orow, int lane) {
    const GAS f32x4* xr = (const GAS f32x4*)xrow + lane; const GAS f32x4* gr = (const GAS f32x4*)g + lane;
    f32x4 v[4]; float s = 0.f;
#pragma unroll
    for (int j = 0; j < 4; ++j) { v[j] = xr[64 * j]; s += (v[j].x * v[j].x + v[j].y * v[j].y) + (v[j].z * v[j].z + v[j].w * v[j].w); }
    const float rstd = 1.f / sqrtf(wave_sum(s) * (1.f / D) + 1e-6f);
    GAS u32x2* o8 = (GAS u32x2*)orow + lane;
#pragma unroll
    for (int j = 0; j < 4; ++j) { const f32x4 gg = gr[64 * j]; u32x2 w; w.x = pk2(v[j].x * rstd * gg.x, v[j].y * rstd * gg.y); w.y = pk2(v[j].z * rstd * gg.z, v[j].w * rstd * gg.w); o8[64 * j] = w; }
}

__device__ __forceinline__ void phase_prologue(LAS unsigned char* lds_in, const int wave_in) {
    int lane = lane_id(); asm volatile("" : "+v"(lane)); int wave = wave_in; asm volatile("" : "+s"(wave)); LAS unsigned char* lds = lds_in; asm volatile("" : "+s"(lds));
    const CArgs a = kargs(); unsigned char* ws = a->ws;
    const int G = gridDim.x, vcu = vcu_of(G);
    LAS float* scr = (LAS float*)(lds + wave * 16384);
    const int gw = vcu * NWAVES + wave, NGW = G * NWAVES;
    bf16_t* swa_qkv_t = (bf16_t*)(ws + WS_SWA_QKV_T); bf16_t* swa_wo_t = (bf16_t*)(ws + WS_SWA_WO_T);
    bf16_t* diff_qkv_t = (bf16_t*)(ws + WS_DIFF_QKV_T); bf16_t* diff_wo_t = (bf16_t*)(ws + WS_DIFF_WO_T);
    constexpr int I0 = 16 * 48, I1 = 16 * 32, I2 = 16 * 96, I3 = 16 * 32, IM = 64 * 768, NITEMS = I0 + I1 + I2 + I3 + IM;
    const int JSe = (NITEMS / NGW) < 16 ? (NITEMS / NGW) : 16;
    struct TrItem { const float* src; int N; unsigned char* dstb; int ldb; int f8; };
    auto decode = [&](int it) -> TrItem {
        int r = it; const float* W; int N, k0, n0, ldd; bf16_t* dst; bf16_t* mbase = nullptr; int f8 = 0;
        if (r < I0) { const int kb = r / 48, nb = r % 48; W = a->in[I_SWA_QKV]; N = SWA_N; k0 = 64 * kb; n0 = 32 * nb; dst = swa_qkv_t + (size_t)n0 * D; ldd = D; mbase = swa_qkv_t; f8 = F8_QKV & 1; }
        else if ((r -= I0) < I1) { const int kb = r / 32, nb = r % 32; W = a->in[I_SWA_WO]; N = D; k0 = 64 * kb; n0 = 32 * nb; dst = swa_wo_t + (size_t)n0 * D; ldd = D; }
        else if ((r -= I1) < I2) { const int kb = r / 96, nb = r % 96; W = a->in[I_DIFF_QKV]; N = DIFF_N; k0 = 64 * kb; n0 = 32 * nb; dst = diff_qkv_t + (size_t)n0 * D; ldd = D; mbase = diff_qkv_t; f8 = (F8_QKV >> 1) & 1; }
        else if ((r -= I2) < I3) { const int kb = r / 32, nb = r % 32; W = a->in[I_DIFF_WO]; N = D; k0 = 64 * kb; n0 = 32 * nb; dst = diff_wo_t + (size_t)n0 * D; ldd = D; }
        else { r -= I3; const int le = r / 768, q = r % 768;
            bf16_t* gu = (bf16_t*)(ws + WS_WMOE + (size_t)le * 3 * MiB); bf16_t* dn = gu + (size_t)D * D;
            const bool l1 = le >= 32 || F8_L0;
            if (q < 256) { const int kb = q / 16, c0 = 32 * (q % 16); W = a->in[I_GATE] + (size_t)le * D * DEXP; N = DEXP; k0 = 64 * kb; n0 = c0; dst = gu + (size_t)((c0 >> 7) * 256 + (c0 & 127)) * D; ldd = D; mbase = gu; f8 = ((F8_STAGE & 2) && l1); }
            else if (q < 512) { const int qq = q - 256; const int kb = qq / 16, c0 = 32 * (qq % 16); W = a->in[I_UP] + (size_t)le * D * DEXP; N = DEXP; k0 = 64 * kb; n0 = c0; dst = gu + (size_t)((c0 >> 7) * 256 + 128 + (c0 & 127)) * D; ldd = D; mbase = gu; f8 = ((F8_STAGE & 2) && l1); }
            else { const int qq = q - 512; const int kb = qq / 32, nb = qq % 32; W = a->in[I_DOWN] + (size_t)le * DEXP * D; N = D; k0 = 64 * kb; n0 = 32 * nb; dst = dn + (size_t)n0 * DEXP; ldd = DEXP; mbase = dn; f8 = ((F8_STAGE & 1) && l1); } }
        TrItem t; t.src = W + (size_t)(k0 + (lane >> 3)) * N + n0 + (lane & 7) * 4; t.N = N; t.f8 = f8;
        t.dstb = f8 ? (unsigned char*)mbase + (size_t)(dst - mbase) + k0 + 8 * (lane & 7) : (unsigned char*)(dst + k0 + 8 * (lane & 7)); t.ldb = f8 ? ldd : 2 * ldd; return t;
    };
    {
        f32x4 va[8], vb[8]; TrItem ca, cb;
#define TR_LOAD(v, t) do { _Pragma("unroll") for (int i = 0; i < 8; ++i) v[i] = *(const f32x4*)((t).src + (size_t)(8 * i) * (t).N); } while (0)
#define TR_FINISH(v, t) do { \
            _Pragma("unroll") for (int i = 0; i < 8; ++i) { LAS float* p = scr + (8 * i + (lane >> 3)) * 33 + (lane & 7) * 4; p[0] = v[i].x; p[1] = v[i].y; p[2] = v[i].z; p[3] = v[i].w; } \
            LDS_WAIT(); asm volatile("" ::: "memory"); \
            if ((t).f8) { _Pragma("unroll") for (int j = 0; j < 4; ++j) { const int n = (lane >> 3) + 8 * j; const LAS float* s = scr + (8 * (lane & 7)) * 33 + n; \
                u32x2 o8; o8.x = pk4_fp8(64.f * s[0 * 33], 64.f * s[1 * 33], 64.f * s[2 * 33], 64.f * s[3 * 33]); o8.y = pk4_fp8(64.f * s[4 * 33], 64.f * s[5 * 33], 64.f * s[6 * 33], 64.f * s[7 * 33]); \
                *(GAS u32x2*)((t).dstb + (size_t)n * (t).ldb) = o8; } } \
            else { _Pragma("unroll") for (int j = 0; j < 4; ++j) { const int n = (lane >> 3) + 8 * j; const LAS float* s = scr + (8 * (lane & 7)) * 33 + n; \
                u32x4 o; o.x = pk2(s[0 * 33], s[1 * 33]); o.y = pk2(s[2 * 33], s[3 * 33]); o.z = pk2(s[4 * 33], s[5 * 33]); o.w = pk2(s[6 * 33], s[7 * 33]); \
                *(GAS u32x4*)((t).dstb + (size_t)n * (t).ldb) = o; } } \
            LDS_WAIT(); asm volatile("" ::: "memory"); } while (0)
        const int n_my = JSe;
        if (n_my > 0) { ca = decode(gw); TR_LOAD(va, ca); }
#pragma unroll 1
        for (int j = 0; j < n_my; j += 2) {
            const int j1 = j + 1 < n_my ? j + 1 : n_my - 1, j2 = j + 2 < n_my ? j + 2 : n_my - 1;
            cb = decode(gw + j1 * NGW); TR_LOAD(vb, cb);
            TR_FINISH(va, ca);
            ca = decode(gw + j2 * NGW); TR_LOAD(va, ca);
            if (j + 1 < n_my) { TR_FINISH(vb, cb); }
        }
    }
    { bf16_t* wr_t = (bf16_t*)(ws + WS_WR); const int gt = gw * 64 + lane, NGT = NGW * 64;
      for (int i = gt; i < 2 * 36 * D; i += NGT) { const int l = i / (36 * D), rem = i % (36 * D), c = rem / D, k = rem % D;
          const float w = c < 4 ? a->in[I_WG][(size_t)l * D * 4 + k * 4 + c] : a->in[I_WR][(size_t)l * D * 32 + k * 32 + (c - 4)];
          const unsigned h = f2bf(w); const float r = w - __uint_as_float(h << 16);
          wr_t[(size_t)l * 2 * 36 * D + rem] = (bf16_t)h; wr_t[(size_t)l * 2 * 36 * D + 36 * D + rem] = (bf16_t)f2bf(r); } }
    bf16_t* XN = (bf16_t*)XNB(a);
    auto rows4 = [&](const int mb) {
        const float* xb = a->in[I_X] + (size_t)mb * D; const GAS f32x4* gr = (const GAS f32x4*)a->in[I_NMIX] + lane;
        f32x4 v[4][4];
#pragma unroll
        for (int r = 0; r < 4; ++r)
#pragma unroll
            for (int j = 0; j < 4; ++j) v[r][j] = ((const GAS f32x4*)(xb + (size_t)r * D) + lane)[64 * j];
        f32x4 gg[4];
#pragma unroll
        for (int j = 0; j < 4; ++j) gg[j] = gr[64 * j];
#pragma unroll
        for (int r = 0; r < 4; ++r) { float s = 0.f;
#pragma unroll
            for (int j = 0; j < 4; ++j) s += (v[r][j].x * v[r][j].x + v[r][j].y * v[r][j].y) + (v[r][j].z * v[r][j].z + v[r][j].w * v[r][j].w);
            const float rstd = 1.f / sqrtf(wave_sum(s) * (1.f / D) + 1e-6f);
            if (F8_QKV & 1) { GAS unsigned* o4 = (GAS unsigned*)((unsigned char*)XN + (size_t)(mb + r) * D) + lane;
#pragma unroll
                for (int j = 0; j < 4; ++j) { const f32x4 n = v[r][j] * (4.f * rstd) * gg[j]; o4[64 * j] = pk4_fp8(n.x, n.y, n.z, n.w); } }
            else { GAS u32x2* o8 = (GAS u32x2*)(XN + (size_t)(mb + r) * D) + lane;
#pragma unroll
                for (int j = 0; j < 4; ++j) { const f32x4 n = v[r][j] * rstd * gg[j]; u32x2 w; w.x = pk2(n.x, n.y); w.y = pk2(n.z, n.w); o8[64 * j] = w; } } }
    };
    {
        unsigned* pq = (unsigned*)(ws + WS_CTL) + CW_PQ;
        LAS int* tw = (LAS int*)(lds + LDSCTL_OFF + 10240);
        const int D0 = JSe * NGW, NBT = (NITEMS - D0 + 15) / 16, NB = NBT + M / 32;
        f32x4 va[8], vb[8]; TrItem ca, cb;
        int tk = 0, p = 0;
        if (wave == 0) { if (lane == 0) tk = (int)__hip_atomic_fetch_add(pq, 1u, __ATOMIC_RELAXED, __HIP_MEMORY_SCOPE_AGENT); tk = __builtin_amdgcn_readfirstlane(tk); if (lane == 0) tw[0] = tk; }
        __syncthreads();
#pragma unroll 1
        for (;;) {
            const int code = __builtin_amdgcn_readfirstlane(tw[p]); if (code >= NB) break;
            if (wave == 0 && lane == 0) tk = (int)__hip_atomic_fetch_add(pq, 1u, __ATOMIC_RELAXED, __HIP_MEMORY_SCOPE_AGENT);
            if (code < NBT) { const int i0 = D0 + code * 16 + wave * 2;
                if (i0 < NITEMS) { const bool two = i0 + 1 < NITEMS; ca = decode(i0); TR_LOAD(va, ca); cb = decode(two ? i0 + 1 : i0); TR_LOAD(vb, cb); TR_FINISH(va, ca); if (two) { TR_FINISH(vb, cb); } } }
            else rows4((code - NBT) * 32 + wave * 4);
            if (wave == 0) { const int t = __builtin_amdgcn_readfirstlane(tk); if (lane == 0) tw[p ^ 1] = t; }
            __syncthreads(); p ^= 1;
        }
    }
#undef TR_LOAD
#undef TR_FINISH
}

template <int RV, bool F8OUT>
__device__ __forceinline__ void phase_router(LAS unsigned char* lds_in, int layer, const int wave_in, const bool dry) {
    int lane = lane_id(); asm volatile("" : "+v"(lane)); int wave = wave_in; asm volatile("" : "+s"(wave)); LAS unsigned char* lds = lds_in; asm volatile("" : "+s"(lds));
    const CArgs a = kargs(); unsigned char* ws = a->ws;
    const int G = gridDim.x, vcu = vcu_of(G);
    const int gw = vcu * NWAVES + wave, NGW = G * NWAVES;
    const float* g = a->in[I_NFFN] + layer * D;
    const bf16_t* wth = (const bf16_t*)(ws + WS_WR) + (size_t)layer * 2 * 36 * D; const bf16_t* wtl = wth + 36 * D;
    const float* bg = a->in[I_BG] + layer * 4; const float* br = a->in[I_BR] + layer * 32;
    bf16_t* XN = (bf16_t*)(dry ? ws + WS_SCR : XNB(a)); const bf16_t* xin = (const bf16_t*)(ws + WS_XR); float* rstd_tok = (float*)(ws + (dry ? WS_SCR + 80 * MiB : WS_RSTD));
    unsigned* cnt = (unsigned*)(ws + WS_CTL) + CW_CNT + (dry ? 2 : layer) * 1024;
    int* ltok = (int*)(ws + (dry ? WS_SCR + 64 * MiB : WS_LTOK)); float* lw = (float*)(ws + (dry ? WS_SCR + 68 * MiB : WS_LW)); i32x4* tinfo = (i32x4*)(ws + (dry ? WS_SCR + 72 * MiB : WS_TINFO));
    LAS float* lgs = (LAS float*)(lds + 98304 + wave * 4096);
    LAS float* rsl = lgs + 768;
    const int row = lane & 15, kg = lane >> 4;
    const bool c2ok = row < 4;
    LAS unsigned* lcnt = (LAS unsigned*)(lds + TP_OFF); LAS unsigned* lbase = lcnt + 32;
    const int tid = wave * 64 + lane;
    if (OPROJ_PAIR && G == 256 && N_LAUNCHES == 1 && !dry) {
        if (wave == 0 && lane == 0) { unsigned* fl = (unsigned*)(ws + WS_CTL) + CW_PAIR + layer * 128 + (vcu >> 1); unsigned sp = 0;
            while (__hip_atomic_load(fl, __ATOMIC_RELAXED, __HIP_MEMORY_SCOPE_AGENT) < 2u) { __builtin_amdgcn_s_sleep(1); if (++sp > (1u << 22)) break; }
            __builtin_amdgcn_fence(__ATOMIC_ACQUIRE, "agent"); asm volatile("s_waitcnt vmcnt(0)" ::: "memory"); }
        __syncthreads(); }
#pragma unroll 1
    for (int bt0 = 0; bt0 < M / 16; bt0 += NGW) {
        const int bt = bt0 + gw; const bool live = bt < M / 16;
        const int t0 = (live ? bt : 0) * 16;
        if (tid < 32) lcnt[tid] = 0u;
        const char* grow = (const char*)g + kg * 32;
        char* orow = (char*)(XN + (size_t)(t0 + row) * D) + kg * 16;
        const char* w0 = (const char*)(wth + (size_t)row * D) + kg * 16;
        f32x4 acc0 = {0.f, 0.f, 0.f, 0.f}, acc1 = acc0, acc2 = acc0; float ss = 0.f;
        const unsigned m2 = c2ok ? 0xffffffffu : 0u;
        {
            u32x4 xq[3] = {}; f32x4 ga[3] = {}, gb[3] = {};
            const char* xbase = (const char*)(xin + (size_t)t0 * D); const unsigned xoff = (unsigned)(row * D * 2 + kg * 16);
            const char* gbase = (const char*)g; const unsigned goff = (unsigned)(kg * 32);
            const char* wb0h = (const char*)wth; const char* wb0l = wb0h + 36 * D * 2; const char* wb1h = wb0h + 16 * D * 2; const char* wb1l = wb0h + 52 * D * 2;
            char* obase = live ? (char*)XN + (size_t)t0 * D * (F8OUT ? 1 : 2) : (char*)(ws + WS_SCR + 100 * MiB); const unsigned ooff = F8OUT ? (unsigned)(row * D + kg * 8) : (unsigned)(row * D * 2 + kg * 16);
            const unsigned woff = (unsigned)((row * D + kg * 8) * 2) + (unsigned)wave * 64u, woff2 = (unsigned)(((32 + (row & 3)) * D + kg * 8) * 2) + (unsigned)wave * 64u;
            LAS unsigned char* bfill = lds + wave * 6144 + lane * 16;
            const LAS unsigned char* bread = lds + lane * 16;
            u32x4 fr0, fr1, fr2, fr3, fr4, fr5;
#define RT_BLOAD(c) do { fr0 = *(const u32x4*)(wb0h + woff + (c) * 512); fr1 = *(const u32x4*)(wb0l + woff + (c) * 512); fr2 = *(const u32x4*)(wb1h + woff + (c) * 512); \
            fr3 = *(const u32x4*)(wb1l + woff + (c) * 512); fr4 = *(const u32x4*)(wb0h + woff2 + (c) * 512); fr5 = *(const u32x4*)(wb0l + woff2 + (c) * 512); } while (0)
#define RT_BWRITE(buf) do { fr4.x &= m2; fr4.y &= m2; fr4.z &= m2; fr4.w &= m2; fr5.x &= m2; fr5.y &= m2; fr5.z &= m2; fr5.w &= m2; \
            *(LAS u32x4*)(bfill + (buf) * 49152) = fr0; *(LAS u32x4*)(bfill + (buf) * 49152 + 1024) = fr1; *(LAS u32x4*)(bfill + (buf) * 49152 + 2048) = fr2; \
            *(LAS u32x4*)(bfill + (buf) * 49152 + 3072) = fr3; *(LAS u32x4*)(bfill + (buf) * 49152 + 4096) = fr4; *(LAS u32x4*)(bfill + (buf) * 49152 + 5120) = fr5; } while (0)
#define RT_BAR() asm volatile("s_waitcnt lgkmcnt(0)\n\ts_barrier" ::: "memory")
#define RT_LOAD(st, s) do { if (!(RV & 2)) { xq[st] = *(const u32x4*)(xbase + xoff + (s) * 64); } \
            ga[st] = *(const f32x4*)(gbase + goff + (s) * 128); gb[st] = *(const f32x4*)(gbase + goff + (s) * 128 + 16); } while (0)
            RT_BLOAD(0); RT_LOAD(0, 0); RT_LOAD(1, 1);
            RT_BWRITE(0); RT_BLOAD(1);
            RT_BAR();
#pragma unroll
            for (int s = 0; s < 32; ++s) {
                const int st = s % 3, c = s >> 3, sl = s & 7;
                if (sl == 0 && c + 1 < 4) { RT_BWRITE((c + 1) & 1); if (c + 2 < 4) { RT_BLOAD(c + 2); } }
                if (s + 2 < 32) { RT_LOAD((s + 2) % 3, s + 2); }
                __builtin_amdgcn_sched_barrier(0);
                const LAS unsigned char* bp = bread + (c & 1) * 49152 + sl * 6144;
                const bf16x8 b0h = *(const LAS bf16x8*)(bp), b0l = *(const LAS bf16x8*)(bp + 1024), b1h = *(const LAS bf16x8*)(bp + 2048), b1l = *(const LAS bf16x8*)(bp + 3072),
                             b2h = *(const LAS bf16x8*)(bp + 4096), b2l = *(const LAS bf16x8*)(bp + 5120);
                const u32x4 xq_ = xq[st];
                const f32x4 xa_ = {__uint_as_float(xq_.x << 16), __uint_as_float(xq_.x & 0xffff0000u), __uint_as_float(xq_.y << 16), __uint_as_float(xq_.y & 0xffff0000u)};
                const f32x4 xb_ = {__uint_as_float(xq_.z << 16), __uint_as_float(xq_.z & 0xffff0000u), __uint_as_float(xq_.w << 16), __uint_as_float(xq_.w & 0xffff0000u)};
                ss += (xa_.x * xa_.x + xa_.y * xa_.y) + (xa_.z * xa_.z + xa_.w * xa_.w) + (xb_.x * xb_.x + xb_.y * xb_.y) + (xb_.z * xb_.z + xb_.w * xb_.w);
                const f32x4 ya = xa_ * ga[st], yb = xb_ * gb[st];
                u32x4 hi; hi.x = cvtpk(ya.x, ya.y); hi.y = cvtpk(ya.z, ya.w); hi.z = cvtpk(yb.x, yb.y); hi.w = cvtpk(yb.z, yb.w);
                u32x4 lo; lo.x = cvtpk(ya.x - __uint_as_float(hi.x << 16), ya.y - __uint_as_float(hi.x & 0xffff0000u)); lo.y = cvtpk(ya.z - __uint_as_float(hi.y << 16), ya.w - __uint_as_float(hi.y & 0xffff0000u));
                lo.z = cvtpk(yb.x - __uint_as_float(hi.z << 16), yb.y - __uint_as_float(hi.z & 0xffff0000u)); lo.w = cvtpk(yb.z - __uint_as_float(hi.w << 16), yb.w - __uint_as_float(hi.w & 0xffff0000u));
                if constexpr (F8OUT) { u32x2 q8; q8.x = pk4_fp8(4.f * ya.x, 4.f * ya.y, 4.f * ya.z, 4.f * ya.w); q8.y = pk4_fp8(4.f * yb.x, 4.f * yb.y, 4.f * yb.z, 4.f * yb.w); *(u32x2*)(obase + ooff + s * 32) = q8; }
                else if (!(RV & 1)) *(u32x4*)(obase + ooff + s * 64) = hi;
                const bf16x8 ah = __builtin_bit_cast(bf16x8, hi), al = __builtin_bit_cast(bf16x8, lo);
                acc0 = __builtin_amdgcn_mfma_f32_16x16x32_bf16(ah, b0h, acc0, 0, 0, 0); acc0 = __builtin_amdgcn_mfma_f32_16x16x32_bf16(ah, b0l, acc0, 0, 0, 0); acc0 = __builtin_amdgcn_mfma_f32_16x16x32_bf16(al, b0h, acc0, 0, 0, 0);
                acc1 = __builtin_amdgcn_mfma_f32_16x16x32_bf16(ah, b1h, acc1, 0, 0, 0); acc1 = __builtin_amdgcn_mfma_f32_16x16x32_bf16(ah, b1l, acc1, 0, 0, 0); acc1 = __builtin_amdgcn_mfma_f32_16x16x32_bf16(al, b1h, acc1, 0, 0, 0);
                acc2 = __builtin_amdgcn_mfma_f32_16x16x32_bf16(ah, b2h, acc2, 0, 0, 0); acc2 = __builtin_amdgcn_mfma_f32_16x16x32_bf16(ah, b2l, acc2, 0, 0, 0); acc2 = __builtin_amdgcn_mfma_f32_16x16x32_bf16(al, b2h, acc2, 0, 0, 0);
                __builtin_amdgcn_sched_barrier(0);
                if (sl == 7 && c + 1 < 4) { RT_BAR(); }
            }
            RT_BAR();
#undef RT_LOAD
#undef RT_BLOAD
#undef RT_BWRITE
#undef RT_BAR
        }
        ss += __shfl_xor(ss, 16); ss += __shfl_xor(ss, 32);
        const float rstd = 1.f / sqrtf(ss * (1.f / D) + 1e-6f);
        if (kg == 0) { rsl[row] = rstd; if (live) rstd_tok[t0 + row] = rstd; }
#pragma unroll
        for (int j = 0; j < 4; ++j) { lgs[(4 * kg + j) * 48 + row] = acc0[j]; lgs[(4 * kg + j) * 48 + 16 + row] = acc1[j]; lgs[(4 * kg + j) * 48 + 32 + row] = acc2[j]; }
        LDS_WAIT(); asm volatile("" ::: "memory");
        int e1 = 0, e2 = 0, lp1 = 0, lp2 = 0; float w1 = 0.f, w2 = 0.f;
        const bool act = live && lane < 16 && !(RV & 4);
        __syncthreads();
        if (act) {
            const float rs = rsl[lane];
            float acc[36];
#pragma unroll
            for (int q = 0; q < 9; ++q) { const f32x4 x = *(const LAS f32x4*)(lgs + lane * 48 + 4 * q); acc[4 * q] = x.x * rs; acc[4 * q + 1] = x.y * rs; acc[4 * q + 2] = x.z * rs; acc[4 * q + 3] = x.w * rs; }
            float lgv[4]; int gs = 0;
#pragma unroll
            for (int c = 0; c < 4; ++c) lgv[c] = acc[c] + bg[c];
            float mx = lgv[0];
#pragma unroll
            for (int c = 1; c < 4; ++c) if (lgv[c] > mx) { mx = lgv[c]; gs = c; }
            float den = 0.f;
#pragma unroll
            for (int c = 0; c < 4; ++c) den += __expf(lgv[c] - mx);
            const float pg = 1.f / den;
            float le[8];
#pragma unroll
            for (int k = 0; k < 8; ++k) { const float a0 = acc[4 + k] + br[k], a1 = acc[12 + k] + br[8 + k], a2 = acc[20 + k] + br[16 + k], a3 = acc[28 + k] + br[24 + k];
                le[k] = gs == 0 ? a0 : (gs == 1 ? a1 : (gs == 2 ? a2 : a3)); }
            int i1 = 0; float m1 = le[0];
#pragma unroll
            for (int k = 1; k < 8; ++k) if (le[k] > m1) { m1 = le[k]; i1 = k; }
            int i2 = -1; float m2 = -INFINITY;
#pragma unroll
            for (int k = 0; k < 8; ++k) if (k != i1 && (i2 < 0 || le[k] > m2)) { m2 = le[k]; i2 = k; }
            const float ex = __expf(m2 - m1); const float tp1 = 1.f / (1.f + ex), tp2 = ex * tp1;
            w1 = pg * tp1; w2 = pg * tp2; e1 = gs * 8 + i1; e2 = gs * 8 + i2;
            lp1 = (int)__hip_atomic_fetch_add(lcnt + e1, 1u, __ATOMIC_RELAXED, __HIP_MEMORY_SCOPE_WORKGROUP);
            lp2 = (int)__hip_atomic_fetch_add(lcnt + e2, 1u, __ATOMIC_RELAXED, __HIP_MEMORY_SCOPE_WORKGROUP);
        }
        __syncthreads();
        if (tid < 32) { const unsigned c = lcnt[tid]; lbase[tid] = c ? __hip_atomic_fetch_add(cnt + 32 * tid, c, __ATOMIC_RELAXED, __HIP_MEMORY_SCOPE_AGENT) : 0u; }
        __syncthreads();
        if (act) {
            const int t = t0 + lane; const int p1 = (int)lbase[e1] + lp1, p2 = (int)lbase[e2] + lp2;
            ltok[(size_t)e1 * M + p1] = t; lw[(size_t)e1 * M + p1] = w1; ltok[(size_t)e2 * M + p2] = t; lw[(size_t)e2 * M + p2] = w2;
            tinfo[t] = (i32x4){e1, p1, e2, p2};
        }
        LDS_WAIT(); asm volatile("" ::: "memory");
        __syncthreads();
    }
}

__device__ __forceinline__ void moe_tables(LAS unsigned char* lds, unsigned char* ws, int layer, const int wave, const int lane) {
    LAS int* TP = (LAS int*)(lds + TP_OFF); LAS int* CNT = TP + 40;
    unsigned* cnt = (unsigned*)(ws + WS_CTL) + CW_CNT + layer * 1024;
    const int tid = wave * 64 + lane;
    __syncthreads();
    if (tid < 32) CNT[tid] = (int)__hip_atomic_load(cnt + 32 * tid, RLX_AGENT);
    __syncthreads();
    if (tid == 0) { int s = 0; for (int e = 0; e < 32; ++e) { TP[e] = s; s += (CNT[e] + 255) >> 8; } TP[32] = s; }
    __syncthreads();
}

__device__ __forceinline__ void phase_combine(LAS unsigned char* lds_in, int layer, const int wave_in, const bool dry) {
    int lane = lane_id(); asm volatile("" : "+v"(lane)); int wave = wave_in; asm volatile("" : "+s"(wave)); LAS unsigned char* lds = lds_in; asm volatile("" : "+s"(lds));
    const CArgs a = kargs(); unsigned char* ws = a->ws;
    moe_tables(lds, ws, layer, wave, lane);
    const bool final_ = layer == 1; const float* gnext = layer == 0 ? a->in[I_NMIX] + D : a->in[I_FNORM]; float* xout = a->out; bf16_t* xr16 = (bf16_t*)(ws + WS_XR);
    const int G = gridDim.x, vcu = vcu_of(G);
    const int gw = vcu * NWAVES + wave, NGW = G * NWAVES;
    const LAS int* TP = (const LAS int*)(lds + TP_OFF);
    const bf16_t* Y = (const bf16_t*)(ws + WS_Y); const i32x4* tinfo = (const i32x4*)(ws + WS_TINFO); bf16_t* XN = (bf16_t*)XNB(a);
#pragma unroll 1
    for (int tb = gw * 4; tb < M; tb += NGW * 4) {
        size_t s1[4], s2[4];
#pragma unroll
        for (int r = 0; r < 4; ++r) { const i32x4 ti = tinfo[tb + r]; s1[r] = (size_t)TP[ti.x] * 256 + ti.y; s2[r] = (size_t)TP[ti.z] * 256 + ti.w; }
        f32x4 v[4][4]; u32x2 p[4][4], q[4][4], xv[4][4];
#pragma unroll
        for (int r = 0; r < 4; ++r) {
            const GAS u32x2* xr = (const GAS u32x2*)(xr16 + (size_t)(tb + r) * D) + lane;
            const GAS u32x2* y1 = (const GAS u32x2*)(Y + s1[r] * D) + lane; const GAS u32x2* y2 = (const GAS u32x2*)(Y + s2[r] * D) + lane;
#pragma unroll
            for (int j = 0; j < 4; ++j) { xv[r][j] = xr[64 * j]; p[r][j] = y1[64 * j]; q[r][j] = y2[64 * j]; }
        }
        f32x4 gg[4];
#pragma unroll
        for (int j = 0; j < 4; ++j) gg[j] = ((const GAS f32x4*)gnext + lane)[64 * j];
#pragma unroll
        for (int r = 0; r < 4; ++r) {
            float s = 0.f;
#pragma unroll
            for (int j = 0; j < 4; ++j) { const u32x2 pp = p[r][j], qq = q[r][j], xx = xv[r][j];
                v[r][j] = (f32x4){__uint_as_float(xx.x << 16), __uint_as_float(xx.x & 0xffff0000u), __uint_as_float(xx.y << 16), __uint_as_float(xx.y & 0xffff0000u)};
                f32x4 ya, yb; ya.x = __uint_as_float(pp.x << 16); ya.y = __uint_as_float(pp.x & 0xffff0000u); ya.z = __uint_as_float(pp.y << 16); ya.w = __uint_as_float(pp.y & 0xffff0000u);
                yb.x = __uint_as_float(qq.x << 16); yb.y = __uint_as_float(qq.x & 0xffff0000u); yb.z = __uint_as_float(qq.y << 16); yb.w = __uint_as_float(qq.y & 0xffff0000u);
                v[r][j] = v[r][j] + (ya + yb); s += (v[r][j].x * v[r][j].x + v[r][j].y * v[r][j].y) + (v[r][j].z * v[r][j].z + v[r][j].w * v[r][j].w); }
            const float rstd = 1.f / sqrtf(wave_sum(s) * (1.f / D) + 1e-6f);
            GAS f32x4* xw = (GAS f32x4*)(xout + (size_t)(tb + r) * D) + lane; GAS u32x2* xw16 = (GAS u32x2*)(xr16 + (size_t)(tb + r) * D) + lane;
            if (final_) {
#pragma unroll
                for (int j = 0; j < 4; ++j) if (!dry) xw[64 * j] = v[r][j] * rstd * gg[j];
            } else {
                if (F8_QKV & 2) { GAS unsigned* o4 = (GAS unsigned*)((unsigned char*)XN + (size_t)(tb + r) * D) + lane;
#pragma unroll
                    for (int j = 0; j < 4; ++j) { if (!dry) { u32x2 w; w.x = pk2(v[r][j].x, v[r][j].y); w.y = pk2(v[r][j].z, v[r][j].w); xw16[64 * j] = w; } const f32x4 n = v[r][j] * (4.f * rstd) * gg[j]; o4[64 * j] = pk4_fp8(n.x, n.y, n.z, n.w); } }
                else { GAS u32x2* o8 = (GAS u32x2*)(XN + (size_t)(tb + r) * D) + lane;
#pragma unroll
                    for (int j = 0; j < 4; ++j) { if (!dry) { u32x2 w; w.x = pk2(v[r][j].x, v[r][j].y); w.y = pk2(v[r][j].z, v[r][j].w); xw16[64 * j] = w; } const f32x4 n = v[r][j] * rstd * gg[j]; u32x2 w; w.x = pk2(n.x, n.y); w.y = pk2(n.z, n.w); o8[64 * j] = w; } }
            }
        }
    }
}

__device__ __forceinline__ float diff_lambda_full(const float* lam, int lane) {
    const float a = wave_sum(lam[lane] * lam[64 + lane]), b = wave_sum(lam[128 + lane] * lam[192 + lane]);
    return __expf(a) - __expf(b) + LAMBDA_INIT;
}

__device__ __forceinline__ void phase_qkv(LAS unsigned char* lds_in, int layer, const int wave_in) {
    int lane = lane_id(); asm volatile("" : "+v"(lane)); int wave = wave_in; asm volatile("" : "+s"(wave)); LAS unsigned char* lds = lds_in; asm volatile("" : "+s"(lds));
    const CArgs a = kargs(); unsigned char* ws = a->ws;
    const int N = layer == 0 ? SWA_N : DIFF_N;
    pg8::DenseOrder S; S.init(M, N, (int)gridDim.x, (int)blockIdx.x);
    pg8::EpiQKV E{(bf16_t*)(ws + WS_QKV), N, 1024, QSCALE, layer == 1 ? (unsigned*)(ws + WS_CTL) + CW_KMAX : nullptr};
    if ((F8_QKV >> layer) & 1) { pg8::Gemm g{(const bf16_t*)XNB(a), (const bf16_t*)(ws + (layer == 0 ? WS_SWA_QKV_T : WS_DIFF_QKV_T)), D / 2, 0x79797979u, 0x7d7d7d7du};
        pg8::gemm_phase<pg8::EpiQKV, pg8::DenseOrder, false, true, true>(lds, g, S, E, wave, lane); }
    else { pg8::Gemm g{(const bf16_t*)XNB(a), (const bf16_t*)(ws + (layer == 0 ? WS_SWA_QKV_T : WS_DIFF_QKV_T)), D};
        pg8::gemm_phase<pg8::EpiQKV, pg8::DenseOrder, false, true>(lds, g, S, E, wave, lane); }
}
__device__ __forceinline__ void phase_oproj(LAS unsigned char* lds_in, int layer, const int wave_in) {
    int lane = lane_id(); asm volatile("" : "+v"(lane)); int wave = wave_in; asm volatile("" : "+s"(wave)); LAS unsigned char* lds = lds_in; asm volatile("" : "+s"(lds));
    const CArgs a = kargs(); unsigned char* ws = a->ws;
    pg8::Gemm g{(const bf16_t*)(ws + WS_O), (const bf16_t*)(ws + (layer == 0 ? WS_SWA_WO_T : WS_DIFF_WO_T)), D};
    pg8::DenseOrder S; S.init(M, D, (int)gridDim.x, (int)blockIdx.x);
    const bool pairmode = OPROJ_PAIR && gridDim.x == 256; const int vcu = vcu_of((int)gridDim.x);
    if (pairmode) S.pair = vcu;
    pg8::EpiResid E{layer == 0 ? a->in[I_X] : nullptr, (const bf16_t*)(ws + WS_XR), (bf16_t*)(ws + WS_XR)};
    pg8::gemm_phase<pg8::EpiResid, pg8::DenseOrder, false, true>(lds, g, S, E, wave, lane);
    if (pairmode) {
        if (wave == 0 && lane == 0) (void)__hip_atomic_fetch_add((unsigned*)(ws + WS_CTL) + CW_PAIR + layer * 128 + (vcu >> 1), 1u, __ATOMIC_RELAXED, __HIP_MEMORY_SCOPE_AGENT); }
}
__device__ __forceinline__ void phase_moe1(LAS unsigned char* lds_in, int layer, const int wave_in) {
    int lane = lane_id(); asm volatile("" : "+v"(lane)); int wave = wave_in; asm volatile("" : "+s"(wave)); LAS unsigned char* lds = lds_in; asm volatile("" : "+s"(lds));
    const CArgs a = kargs(); unsigned char* ws = a->ws;
    moe_tables(lds, ws, layer, wave, lane);
    const LAS int* TP = (const LAS int*)(lds + TP_OFF); const LAS int* CNT = TP + 40;
    if ((F8_STAGE & 2) && (layer == 1 || F8_L0)) {
        pg8::Gemm g{(const bf16_t*)XNB(a), (const bf16_t*)(ws + WS_WMOE + (size_t)layer * 96 * MiB), D / 2, 0x79797979u, 0x7d7d7d7du};
        pg8::MoeOrder S{TP, CNT, (const int*)(ws + WS_LTOK), (int)gridDim.x, (int)blockIdx.x, 12, 0};
        if (F8_STAGE & 1) { pg8::EpiSwiGLU<true> E{(bf16_t*)(ws + WS_H), (const int*)(ws + WS_LTOK), (const float*)(ws + WS_RSTD), CNT};
            pg8::gemm_phase<pg8::EpiSwiGLU<true>, pg8::MoeOrder, true, true, true>(lds, g, S, E, wave, relaunder(lane)); }
        else { pg8::EpiSwiGLU<false> E{(bf16_t*)(ws + WS_H), (const int*)(ws + WS_LTOK), (const float*)(ws + WS_RSTD), CNT};
            pg8::gemm_phase<pg8::EpiSwiGLU<false>, pg8::MoeOrder, true, true, true>(lds, g, S, E, wave, relaunder(lane)); }
    } else if ((F8_STAGE & 1) && layer == 1) {
        pg8::Gemm g{(const bf16_t*)XNB(a), (const bf16_t*)(ws + WS_WMOE + (size_t)layer * 96 * MiB), D};
        pg8::MoeOrder S{TP, CNT, (const int*)(ws + WS_LTOK), (int)gridDim.x, (int)blockIdx.x, 6, 0};
        pg8::EpiSwiGLU<true> E{(bf16_t*)(ws + WS_H), (const int*)(ws + WS_LTOK), (const float*)(ws + WS_RSTD), CNT};
        pg8::gemm_phase<pg8::EpiSwiGLU<true>, pg8::MoeOrder, true, true>(lds, g, S, E, wave, relaunder(lane));
    } else {
        pg8::Gemm g{(const bf16_t*)XNB(a), (const bf16_t*)(ws + WS_WMOE + (size_t)layer * 96 * MiB), D};
        pg8::MoeOrder S{TP, CNT, (const int*)(ws + WS_LTOK), (int)gridDim.x, (int)blockIdx.x, 6, 0};
        pg8::EpiSwiGLU<false> E{(bf16_t*)(ws + WS_H), (const int*)(ws + WS_LTOK), (const float*)(ws + WS_RSTD), CNT};
        pg8::gemm_phase<pg8::EpiSwiGLU<false>, pg8::MoeOrder, true, true>(lds, g, S, E, wave, relaunder(lane));
    }
}
__device__ __forceinline__ void phase_moe2(LAS unsigned char* lds_in, int layer, const int wave_in) {
    int lane = lane_id(); asm volatile("" : "+v"(lane)); int wave = wave_in; asm volatile("" : "+s"(wave)); LAS unsigned char* lds = lds_in; asm volatile("" : "+s"(lds));
    const CArgs a = kargs(); unsigned char* ws = a->ws;
    moe_tables(lds, ws, layer, wave, lane);
    const LAS int* TP = (const LAS int*)(lds + TP_OFF); const LAS int* CNT = TP + 40;
    pg8::EpiDown E{(bf16_t*)(ws + WS_Y), (const float*)(ws + WS_LW)};
    if ((F8_STAGE & 1) && layer == 1) {
        pg8::Gemm g{(const bf16_t*)(ws + WS_H), (const bf16_t*)(ws + WS_WMOE + (size_t)layer * 96 * MiB), DEXP / 2, 0x79797979u, 0x7c7c7c7cu};
        pg8::MoeOrder S{TP, CNT, (const int*)(ws + WS_LTOK), (int)gridDim.x, (int)blockIdx.x, 24, 16};
        pg8::gemm_phase<pg8::EpiDown, pg8::MoeOrder, false, true, true>(lds, g, S, E, wave, relaunder(lane));
    } else {
        pg8::Gemm g{(const bf16_t*)(ws + WS_H), (const bf16_t*)(ws + WS_WMOE + (size_t)layer * 96 * MiB), DEXP};
        pg8::MoeOrder S{TP, CNT, (const int*)(ws + WS_LTOK), (int)gridDim.x, (int)blockIdx.x, 12, 8};
        pg8::gemm_phase<pg8::EpiDown, pg8::MoeOrder, false, true>(lds, g, S, E, wave, relaunder(lane));
    }
}
__device__ __forceinline__ void phase_attn(LAS unsigned char* lds_in, int layer, const int wave_in, const bool dry) {
    int lane = lane_id(); asm volatile("" : "+v"(lane)); int wave = wave_in; asm volatile("" : "+s"(wave)); LAS unsigned char* lds = lds_in; asm volatile("" : "+s"(lds));
    const CArgs a = kargs(); unsigned char* ws = a->ws;
    const int G = gridDim.x, vcu = vcu_of(G);
    const bf16_t* QKV = (const bf16_t*)(ws + WS_QKV); bf16_t* OB = (bf16_t*)(ws + WS_O);
    if (layer == 0) {
        att::DiffConsts dc{0.f, nullptr}; const float* sink = a->in[I_SWA_SINK];
        bf16x8 qn[4] = {}; int rb = 0;
#pragma unroll 1
        for (int i = 0; i < 2048; ++i) { const int id = vcu + G * i; if (id >= 2048) break; const int bk = id >> 7, qb = id & 127;
            const int nid = id + G; const bool has_next = nid < 2048; const int nbk = nid >> 7, nqb = nid & 127;
            att::swa_unit(bk >> 2, bk & 3, qb, rb, i != 0, has_next, nbk >> 2, nbk & 3, nqb, qn, QKV, OB, sink, lds, wave, lane); rb = (rb + 5) & 7; }
        asm volatile("s_waitcnt lgkmcnt(0)\n\ts_barrier" ::: "memory");
    } else {
        att::DiffConsts dc{diff_lambda_full(a->in[I_DIFF_LAM], lane), a->in[I_DIFF_SUBLN]};
        if (wave == 0) { LAS float* gt = (LAS float*)(lds + 7 * 16384 + 256); const float sgs = 1.f - LAMBDA_INIT;
            gt[lane] = a->in[I_DIFF_SUBLN][lane] * sgs; gt[64 + lane] = a->in[I_DIFF_SUBLN][64 + lane] * sgs; }
        const unsigned* kmaxsq = (const unsigned*)(ws + WS_CTL) + CW_KMAX;
        unsigned* qh = (unsigned*)(ws + WS_CTL) + CW_Q;
        LAS int* nxt = (LAS int*)(lds + 7 * 16384 + 64);
        int xq = ((vcu * 8) / G) & 7, left = 8;
        if (wave == 4) { int t0 = 0; if (lane == 0) t0 = (int)__hip_atomic_fetch_add(qh + xq * 1024, 1u, __ATOMIC_RELAXED, __HIP_MEMORY_SCOPE_AGENT);
            t0 = __builtin_amdgcn_readfirstlane(t0); if (lane == 0) nxt[0] = xq * 65536 + t0; }
        __syncthreads();
#pragma unroll 1
        for (;;) {
            int code = __builtin_amdgcn_readfirstlane(nxt[0]);
            if ((code & 65535) >= 256) {
                __syncthreads();
                if (wave == 4) { int k = code & 65535; xq = code >> 16;
                    while (k >= 256) { if (--left == 0) { k = 65535; break; } xq = (xq + 1) & 7; int t2 = 0;
                        if (lane == 0) t2 = (int)__hip_atomic_fetch_add(qh + xq * 1024, 1u, __ATOMIC_RELAXED, __HIP_MEMORY_SCOPE_AGENT); k = __builtin_amdgcn_readfirstlane(t2); }
                    if (lane == 0) nxt[0] = xq * 65536 + k; }
                __syncthreads();
                code = __builtin_amdgcn_readfirstlane(nxt[0]);
                if ((code & 65535) >= 256) break;
            }
            const int xl = code >> 16, k = code & 65535, h = 7 - (k >> 5), bq = xl * 32 + (k & 31), b = bq >> 6, qb = bq & 63;
            const int cm = wave >> 2, gi = b * 32 + 2 * (2 * h + cm);
            const float kmax = sqrtf(__uint_as_float(__hip_atomic_load(kmaxsq + gi, RLX_AGENT)) + __uint_as_float(__hip_atomic_load(kmaxsq + gi + 1, RLX_AGENT))) * 1.01f;
            if (ATT_PROBE_VARIANT != 0 && dry) att::diff_unit<ATT_PROBE_VARIANT>(b, h, qb, QKV, (bf16_t*)XNB(a), kmax, dc, lds, wave, lane, qh + xl * 1024, xl);
            else att::diff_unit<0>(b, h, qb, QKV, OB, kmax, dc, lds, wave, lane, qh + xl * 1024, xl); }
    }
}

__global__ void __launch_bounds__(NWAVES * 64, 2) mega_fwd(Args args_by_value) {
    extern __shared__ __attribute__((aligned(16))) unsigned char lds_raw[];
    LAS unsigned char* lds = (LAS unsigned char*)lds_raw;
    const int wave = __builtin_amdgcn_readfirstlane((int)(threadIdx.x >> 6));
    int lo, hi;
    { const CArgs a = kargs(); lo = a->ph_lo; hi = a->ph_hi;
      if (a->use_cg) cg::this_grid().sync(); }
    { const int tid = wave * 64 + lane_id();
      for (int u = tid; u < (LDS_BYTES - LDSCTL_OFF) / 4; u += NWAVES * 64) ((LAS unsigned*)(lds + LDSCTL_OFF))[u] = 0u; }
    __syncthreads();
    if (N_LAUNCHES == 1) { const CArgs a = kargs(); (void)xcd_barrier_post((unsigned*)(a->ws + WS_CTL) + CW_BAR, (volatile LAS unsigned*)(lds + MISC_OFF) + 8, wave == 0 && lane_id() == 0); }
    int rep_left = REP_COUNT;
    unsigned long long tp_prev = 0, tp_acc = 0;
    if (TPROBE_MASK != 0) tp_prev = __builtin_amdgcn_s_memrealtime();
#pragma unroll 1
    for (int ph = lo; ph < hi; ++ph) {
        const int layer = ph >= 8 ? 1 : 0, kind = ph == 0 ? 0 : ph - 7 * layer;
        const bool dry = REP_COUNT > 0 && ph == REP_PHASE && rep_left > 0;
        switch (kind) {
            case 0: phase_prologue(lds, wave); break;
            case 1: phase_qkv(lds, layer, wave); break;
            case 2: phase_attn(lds, layer, wave, dry); break;
            case 3: phase_oproj(lds, layer, wave); break;
            case 4: if (ROUTER_PROBE != 0 && dry) phase_router<ROUTER_PROBE, false>(lds, layer, wave, dry); else if ((F8_STAGE & 2) && (layer == 1 || F8_L0)) phase_router<0, true>(lds, layer, wave, dry); else phase_router<0, false>(lds, layer, wave, dry); break;
            case 5: phase_moe1(lds, layer, wave); break;
            case 6: phase_moe2(lds, layer, wave); break;
            default: phase_combine(lds, layer, wave, dry); break;
        }
        if (ph + 1 < hi && !(OPROJ_PAIR && kind == 3 && gridDim.x == 256 && N_LAUNCHES == 1)) { const CArgs a = kargs(); XcdBarrier bar; bar.bar = (unsigned*)(a->ws + WS_CTL) + CW_BAR; bar.x = xb_xcc_id(); bar.st = (volatile LAS unsigned*)(lds + MISC_OFF) + 8;
            xcd_barrier(bar, wave == 0 && lane_id() == 0);
        }
        if (TPROBE_MASK != 0) { const unsigned long long tn = __builtin_amdgcn_s_memrealtime(); if ((TPROBE_MASK >> ph) & 1) tp_acc += tn - tp_prev; tp_prev = tn; }
        if (REP_COUNT > 0 && ph == REP_PHASE && rep_left > 0) { --rep_left; --ph; }
        if (EXTRA_BARRIERS > 0 && ph == 3) { for (int xb = 0; xb < EXTRA_BARRIERS; ++xb) { const CArgs a = kargs(); XcdBarrier bar; bar.bar = (unsigned*)(a->ws + WS_CTL) + CW_BAR; bar.x = xb_xcc_id(); bar.st = (volatile LAS unsigned*)(lds + MISC_OFF) + 8; xcd_barrier(bar, wave == 0 && lane_id() == 0); } }
    }
    if (TPROBE_MASK != 0 && blockIdx.x == 0 && wave == 0) { const unsigned long long t0 = __builtin_amdgcn_s_memrealtime(); while (__builtin_amdgcn_s_memrealtime() - t0 < TPROBE_K * tp_acc) __builtin_amdgcn_s_sleep(8); }
}

extern "C" void kernel_launch(void* const* d_in, const int* in_sizes, int n_in, void* d_out, int out_size, void* d_ws, size_t ws_size, hipStream_t stream) {
    static int grid = 0;
    if (grid == 0) {
        if (n_in != 18 || in_sizes[0] != M * D || out_size != M * D || ws_size < WS_END) {
            fprintf(stderr, "kernel_launch: unexpected shapes: n_in %d in0 %d out %d ws %zu (need %zu)\n", n_in, n_in > 0 ? in_sizes[0] : -1, out_size, ws_size, (size_t)WS_END); grid = -1; return; }
        int dev = 0, cus = 0, per_cu = 0;
        if (hipGetDevice(&dev) != hipSuccess || hipDeviceGetAttribute(&cus, hipDeviceAttributeMultiprocessorCount, dev) != hipSuccess) { fprintf(stderr, "kernel_launch: device query failed\n"); grid = -1; return; }
        if (hipFuncSetAttribute((const void*)mega_fwd, hipFuncAttributeMaxDynamicSharedMemorySize, LDS_BYTES) != hipSuccess) { fprintf(stderr, "kernel_launch: hipFuncSetAttribute failed\n"); grid = -1; return; }
        if (hipOccupancyMaxActiveBlocksPerMultiprocessor(&per_cu, (const void*)mega_fwd, NWAVES * 64, LDS_BYTES) != hipSuccess || per_cu < 1) { fprintf(stderr, "kernel_launch: occupancy query says %d\n", per_cu); per_cu = 1; }
        (void)hipGetLastError();
        grid = cus;
    }
    if (grid < 0) return;
    (void)hipMemsetAsync((char*)d_ws + WS_CTL, 0, CTL_ZERO_BYTES, stream);
    Args a{};
    for (int i = 0; i < 18; ++i) a.in[i] = (const float*)d_in[i];
    a.out = (float*)d_out; a.ws = (unsigned char*)d_ws; a.use_cg = 0; a.pad = 0;
    if (N_LAUNCHES == 1) {
        a.ph_lo = 0; a.ph_hi = N_PHASES;
        void* kargs_[] = {&a};
        hipError_t e = hipLaunchCooperativeKernel((const void*)mega_fwd, dim3(grid), dim3(NWAVES * 64), kargs_, LDS_BYTES, stream);
        if (e != hipSuccess) fprintf(stderr, "kernel_launch: cooperative launch failed: %s (grid %d)\n", hipGetErrorString(e), grid);
    } else {
        for (int p = 0; p < N_PHASES; ++p) { a.ph_lo = p; a.ph_hi = p + 1; hipLaunchKernelGGL(mega_fwd, dim3(grid), dim3(NWAVES * 64), LDS_BYTES, stream, a); }
    }
}
```
